# Optimizing an MI355X kernel written in HIP

```python
import math
import jax, jax.numpy as jnp
from jax import lax
import numpy as np

D_MODEL = 1024
BATCH = 16
SEQ = 4096
DEPTH = 4

F32 = jnp.float32
N_BRANCHES = 4
BRANCH_WIDTH = 512
NORM_EPS = 1e-6
CHUNK = 64
GLA_HEADS = 4
GLA_DK = 64
GLA_DV = BRANCH_WIDTH // GLA_HEADS
GLA_KEY = GLA_HEADS * GLA_DK
GLA_RANK = 16
GLA_GATE_TEMP = 16.0
RET_HEADS = 4
RET_DK = 64
RET_DV = BRANCH_WIDTH // RET_HEADS
RET_KEY = RET_HEADS * RET_DK
ROPE_BASE = 10000.0
LRU_BLOCKS = 8
LRU_BLOCK_DIM = BRANCH_WIDTH // LRU_BLOCKS
CONV_WIDTH = 4
LRU_C = 8.0
S5_GROUP = 16
S5_GROUPS = BRANCH_WIDTH // S5_GROUP
S5_STATE = 64
S5_BLOCK = 128
IN_SIZES = (GLA_KEY, GLA_KEY, BRANCH_WIDTH, GLA_RANK, BRANCH_WIDTH,
            RET_KEY, RET_KEY, BRANCH_WIDTH, BRANCH_WIDTH,
            BRANCH_WIDTH, BRANCH_WIDTH,
            BRANCH_WIDTH, BRANCH_WIDTH)
IN_COLS = sum(IN_SIZES)

kernel_name = 'hybrid_gla_retnet_rglru_s5_gated_merge'


def rmsnorm(x, gain):
    xf = x.astype(F32)
    y = xf * lax.rsqrt(jnp.mean(xf * xf, axis=-1, keepdims=True) + NORM_EPS)
    return (y * gain.astype(F32)).astype(x.dtype)


def split_columns(proj):
    offsets, acc = [], 0
    for s in IN_SIZES[:-1]:
        acc += s
        offsets.append(acc)
    return jnp.split(proj, offsets, axis=-1)


def to_chunks(t, heads):
    b, s, w = t.shape
    return t.reshape(b, s // CHUNK, CHUNK, heads, w // heads).transpose(0, 3, 1, 2, 4)


def from_chunks(t):
    b, h, n, c, d = t.shape
    return t.transpose(0, 2, 3, 1, 4).reshape(b, n * c, h * d)


def scan_chunk_states(kv, decay):
    def step(state, inp):
        kv_n, dec_n = inp
        return state * dec_n + kv_n, state
    init = jnp.zeros(kv.shape[:2] + kv.shape[3:], F32)
    _, prev = lax.scan(step, init, (jnp.moveaxis(kv, 2, 0), jnp.moveaxis(decay, 2, 0)))
    return jnp.moveaxis(prev, 0, 2)


def gla_mix(q, k, v, lr, w_lr, b_lr, norm_gain):
    z = jnp.einsum('bsr,rk->bsk', lr.astype(F32), w_lr.astype(F32)) + b_lr.astype(F32)
    log_a = jax.nn.log_sigmoid(z) / GLA_GATE_TEMP
    qc = to_chunks(q.astype(F32), GLA_HEADS) * GLA_DK ** -0.5
    kc = to_chunks(k.astype(F32), GLA_HEADS)
    vc = to_chunks(v.astype(F32), GLA_HEADS)
    cum = jnp.cumsum(to_chunks(log_a, GLA_HEADS), axis=3)
    last = cum[..., -1:, :]
    q_dec = qc * jnp.exp(cum)
    k_dec = kc * jnp.exp(-cum)
    k_tail = kc * jnp.exp(last - cum)
    causal = jnp.tril(jnp.ones((CHUNK, CHUNK), dtype=bool))
    scores = jnp.where(causal, jnp.einsum('bhnid,bhnjd->bhnij', q_dec, k_dec), 0.0)
    o = jnp.einsum('bhnij,bhnjv->bhniv', scores, vc)
    kv = jnp.einsum('bhncd,bhncv->bhndv', k_tail, vc)
    s_prev = scan_chunk_states(kv, jnp.exp(last[..., 0, :])[..., None])
    o = o + jnp.einsum('bhncd,bhndv->bhncv', q_dec, s_prev)
    o = o * lax.rsqrt(jnp.mean(o * o, axis=-1, keepdims=True) + NORM_EPS)
    o = o * norm_gain.astype(F32).reshape(GLA_HEADS, 1, 1, GLA_DV)
    return from_chunks(o)


def rotary(t):
    s, d = t.shape[1], t.shape[-1]
    half = d // 2
    inv = ROPE_BASE ** (-jnp.arange(half, dtype=F32) / half)
    ang = jnp.arange(s, dtype=F32)[:, None] * inv[None, :]
    cos = jnp.cos(ang)[None, :, None, :]
    sin = jnp.sin(ang)[None, :, None, :]
    t1, t2 = t[..., :half], t[..., half:]
    return jnp.concatenate([t1 * cos - t2 * sin, t1 * sin + t2 * cos], axis=-1)


def retention_mix(q, k, v, gn_gain, gn_bias):
    b, s, _ = q.shape
    n = s // CHUNK
    qr = rotary(q.astype(F32).reshape(b, s, RET_HEADS, RET_DK)).reshape(b, s, RET_KEY)
    kr = rotary(k.astype(F32).reshape(b, s, RET_HEADS, RET_DK)).reshape(b, s, RET_KEY) * RET_DK ** -0.5
    qc = to_chunks(qr, RET_HEADS)
    kc = to_chunks(kr, RET_HEADS)
    vc = to_chunks(v.astype(F32), RET_HEADS)
    log_gamma = jnp.log1p(-jnp.exp2(-5.0 - jnp.arange(RET_HEADS, dtype=F32)))
    pos = jnp.arange(CHUNK, dtype=F32)
    rel = pos[:, None] - pos[None, :]
    intra = jnp.where(rel >= 0, jnp.exp(jnp.maximum(rel, 0.0)[None] * log_gamma[:, None, None]), 0.0)
    scores = jnp.einsum('bhnid,bhnjd->bhnij', qc, kc) * intra[:, None]
    o = jnp.einsum('bhnij,bhnjv->bhniv', scores, vc)
    k_w = jnp.exp((CHUNK - 1.0 - pos)[None, :] * log_gamma[:, None])
    kv = jnp.einsum('bhncd,hc,bhncv->bhndv', kc, k_w, vc)
    chunk_decay = jnp.broadcast_to(jnp.exp(CHUNK * log_gamma)[None, :, None, None, None], (1, RET_HEADS, n, 1, 1))
    s_prev = scan_chunk_states(kv, chunk_decay)
    q_w = jnp.exp((pos + 1.0)[None, :] * log_gamma[:, None])
    o = o + jnp.einsum('bhncd,bhndv,hc->bhncv', qc, s_prev, q_w)
    mean = jnp.mean(o, axis=-1, keepdims=True)
    var = jnp.mean(jnp.square(o - mean), axis=-1, keepdims=True)
    o = (o - mean) * lax.rsqrt(var + NORM_EPS)
    o = o * gn_gain.astype(F32).reshape(RET_HEADS, 1, 1, RET_DV) + gn_bias.astype(F32).reshape(RET_HEADS, 1, 1, RET_DV)
    return from_chunks(o)


def linear_combine(left, right):
    a1, b1 = left
    a2, b2 = right
    return a1 * a2, a2 * b1 + b2


def rglru_mix(x, conv_w, conv_b, w_a, b_a, w_x, b_x, lam):
    b, s, w = x.shape
    xf = x.astype(F32)
    xc = lax.conv_general_dilated(xf, conv_w.astype(F32)[:, None, :], window_strides=(1,),
                                  padding=[(CONV_WIDTH - 1, 0)], dimension_numbers=('NWC', 'WIO', 'NWC'),
                                  feature_group_count=w) + conv_b.astype(F32)
    xb = xc.reshape(b, s, LRU_BLOCKS, LRU_BLOCK_DIM)
    r = jax.nn.sigmoid(jnp.einsum('bsni,nij->bsnj', xb, w_a.astype(F32)).reshape(b, s, w) + b_a.astype(F32))
    i = jax.nn.sigmoid(jnp.einsum('bsni,nij->bsnj', xb, w_x.astype(F32)).reshape(b, s, w) + b_x.astype(F32))
    log_a = -LRU_C * r * jax.nn.softplus(-lam.astype(F32))
    a = jnp.exp(log_a)
    gated = xc * i * jnp.sqrt(-jnp.expm1(2.0 * log_a))
    _, h = lax.associative_scan(linear_combine, (a, gated), axis=1)
    return h


def complex_linear_combine(left, right):
    ar1, ai1, br1, bi1 = left
    ar2, ai2, br2, bi2 = right
    return (ar1 * ar2 - ai1 * ai2, ar1 * ai2 + ai1 * ar2,
            ar2 * br1 - ai2 * bi1 + br2, ar2 * bi1 + ai2 * br1 + bi2)


def s5_scan(u, a_re, a_im, b_re, b_im, c_re, c_im, d, log_dt):
    b, s, w = u.shape
    a_re, a_im = a_re.astype(F32), a_im.astype(F32)
    b_re, b_im = b_re.astype(F32), b_im.astype(F32)
    c_re, c_im = c_re.astype(F32), c_im.astype(F32)
    step = jnp.exp(log_dt.astype(F32))[:, None]
    mag = jnp.exp(step * a_re)
    ab_re = mag * jnp.cos(step * a_im)
    ab_im = mag * jnp.sin(step * a_im)
    den = a_re * a_re + a_im * a_im
    f_re = ((ab_re - 1.0) * a_re + ab_im * a_im) / den
    f_im = (ab_im * a_re - (ab_re - 1.0) * a_im) / den
    bb_re = f_re[..., None] * b_re - f_im[..., None] * b_im
    bb_im = f_re[..., None] * b_im + f_im[..., None] * b_re
    d_g = d.astype(F32).reshape(S5_GROUPS, S5_GROUP)
    a_blk_re = jnp.broadcast_to(ab_re, (b, S5_BLOCK, S5_GROUPS, S5_STATE))
    a_blk_im = jnp.broadcast_to(ab_im, (b, S5_BLOCK, S5_GROUPS, S5_STATE))
    ub = jnp.moveaxis(u.astype(F32).reshape(b, s // S5_BLOCK, S5_BLOCK, S5_GROUPS, S5_GROUP), 1, 0)

    def block_step(carry, u_blk):
        h_re, h_im = carry
        bu_re = jnp.einsum('blgi,gpi->blgp', u_blk, bb_re)
        bu_im = jnp.einsum('blgi,gpi->blgp', u_blk, bb_im)
        bu_re = bu_re.at[:, 0].add(ab_re * h_re - ab_im * h_im)
        bu_im = bu_im.at[:, 0].add(ab_re * h_im + ab_im * h_re)
        _, _, hs_re, hs_im = lax.associative_scan(complex_linear_combine, (a_blk_re, a_blk_im, bu_re, bu_im), axis=1)
        y = (jnp.einsum('blgp,gip->blgi', hs_re, c_re) - jnp.einsum('blgp,gip->blgi', hs_im, c_im)
             + d_g * u_blk)
        return (hs_re[:, -1], hs_im[:, -1]), y

    init = (jnp.zeros((b, S5_GROUPS, S5_STATE), F32), jnp.zeros((b, S5_GROUPS, S5_STATE), F32))
    _, ys = lax.scan(block_step, init, ub)
    return jnp.moveaxis(ys, 0, 1).reshape(b, s, w)


def setup_inputs(seed: int = 0) -> dict:
    key = jax.random.key(seed)
    ks = jax.random.split(key, 32)

    def nrm(k, shape, scale):
        return scale * jax.random.normal(k, shape, F32)

    W = BRANCH_WIDTH
    a_pow = jax.random.uniform(ks[14], (DEPTH, W), F32, 0.9, 0.999)
    p = a_pow ** (1.0 / LRU_C)
    return {
        'x': nrm(ks[0], (BATCH, SEQ, D_MODEL), 1.0),
        'norm_gain': 1.0 + nrm(ks[1], (DEPTH, D_MODEL), 0.02),
        'w_in': nrm(ks[2], (DEPTH, D_MODEL, IN_COLS), D_MODEL ** -0.5),
        'gla_w_lr': nrm(ks[3], (DEPTH, GLA_RANK, GLA_KEY), GLA_RANK ** -0.5),
        'gla_b_lr': nrm(ks[4], (DEPTH, GLA_KEY), 0.1),
        'gla_norm_gain': 1.0 + nrm(ks[5], (DEPTH, W), 0.02),
        'ret_norm_gain': 1.0 + nrm(ks[6], (DEPTH, W), 0.02),
        'ret_norm_bias': nrm(ks[7], (DEPTH, W), 0.02),
        'lru_conv_w': nrm(ks[8], (DEPTH, CONV_WIDTH, W), CONV_WIDTH ** -0.5),
        'lru_conv_b': nrm(ks[9], (DEPTH, W), 0.02),
        'lru_w_a': nrm(ks[10], (DEPTH, LRU_BLOCKS, LRU_BLOCK_DIM, LRU_BLOCK_DIM), LRU_BLOCK_DIM ** -0.5),
        'lru_b_a': nrm(ks[11], (DEPTH, W), 0.02),
        'lru_w_x': nrm(ks[12], (DEPTH, LRU_BLOCKS, LRU_BLOCK_DIM, LRU_BLOCK_DIM), LRU_BLOCK_DIM ** -0.5),
        'lru_b_x': nrm(ks[13], (DEPTH, W), 0.02),
        'lru_lambda': jnp.log(p) - jnp.log1p(-p),
        's5_a_re': -0.5 + nrm(ks[15], (DEPTH, S5_GROUPS, S5_STATE), 0.01),
        's5_a_im': jnp.pi * jnp.arange(S5_STATE, dtype=F32) + nrm(ks[16], (DEPTH, S5_GROUPS, S5_STATE), 0.01),
        's5_b_re': nrm(ks[17], (DEPTH, S5_GROUPS, S5_STATE, S5_GROUP), (2.0 * S5_GROUP) ** -0.5),
        's5_b_im': nrm(ks[18], (DEPTH, S5_GROUPS, S5_STATE, S5_GROUP), (2.0 * S5_GROUP) ** -0.5),
        's5_c_re': nrm(ks[19], (DEPTH, S5_GROUPS, S5_GROUP, S5_STATE), (2.0 * S5_STATE) ** -0.5),
        's5_c_im': nrm(ks[20], (DEPTH, S5_GROUPS, S5_GROUP, S5_STATE), (2.0 * S5_STATE) ** -0.5),
        's5_d': nrm(ks[21], (DEPTH, W), 1.0),
        's5_log_dt': jax.random.uniform(ks[22], (DEPTH, S5_GROUPS), F32, math.log(0.001), math.log(0.1)),
        's5_glu_w': nrm(ks[23], (DEPTH, W, W), W ** -0.5),
        's5_glu_b': nrm(ks[24], (DEPTH, W), 0.02),
        'w_merge_gate': nrm(ks[25], (DEPTH, N_BRANCHES, D_MODEL, D_MODEL), D_MODEL ** -0.5),
        'w_branch': nrm(ks[26], (DEPTH, N_BRANCHES, W, D_MODEL), W ** -0.5),
        'w_out': nrm(ks[27], (DEPTH, D_MODEL, D_MODEL), D_MODEL ** -0.5),
        'final_norm_gain': 1.0 + nrm(ks[28], (D_MODEL,), 0.02),
    }


def reference(x, norm_gain, w_in, gla_w_lr, gla_b_lr, gla_norm_gain, ret_norm_gain, ret_norm_bias,
              lru_conv_w, lru_conv_b, lru_w_a, lru_b_a, lru_w_x, lru_b_x, lru_lambda,
              s5_a_re, s5_a_im, s5_b_re, s5_b_im, s5_c_re, s5_c_im, s5_d, s5_log_dt, s5_glu_w, s5_glu_b,
              w_merge_gate, w_branch, w_out, final_norm_gain):
    dt = x.dtype
    h = x
    for l in range(DEPTH):
        u = rmsnorm(h, norm_gain[l])
        proj = u @ w_in[l]
        (gq, gk, gv, glr, gg, rq, rk, rv, rg, lx, lg, su, sg) = split_columns(proj)
        o_gla = gla_mix(gq, gk, gv, glr, gla_w_lr[l], gla_b_lr[l], gla_norm_gain[l]).astype(dt) * jax.nn.silu(gg)
        o_ret = retention_mix(rq, rk, rv, ret_norm_gain[l], ret_norm_bias[l]).astype(dt) * jax.nn.silu(rg)
        o_lru = rglru_mix(lx, lru_conv_w[l], lru_conv_b[l], lru_w_a[l], lru_b_a[l], lru_w_x[l], lru_b_x[l],
                          lru_lambda[l]).astype(dt) * jax.nn.silu(lg)
        y5 = jax.nn.gelu(s5_scan(su, s5_a_re[l], s5_a_im[l], s5_b_re[l], s5_b_im[l], s5_c_re[l], s5_c_im[l],
                                 s5_d[l], s5_log_dt[l])).astype(dt)
        y5 = y5 * jax.nn.sigmoid(y5 @ s5_glu_w[l] + s5_glu_b[l])
        o_s5 = y5 * jax.nn.silu(sg)
        merged = jnp.zeros_like(h)
        for bi, o in enumerate((o_gla, o_ret, o_lru, o_s5)):
            gate = jax.nn.sigmoid(u @ w_merge_gate[l, bi])
            merged = merged + gate * (o @ w_branch[l, bi])
        h = h + merged @ w_out[l]
    return rmsnorm(h, final_norm_gain)
```

```cpp
#include <hip/hip_runtime.h>
#include <cstdio>
#include <cstdint>

#ifndef NAIVE_MIX
#define NAIVE_MIX 1
#endif
#ifndef PH_MASK
#define PH_MASK 0xFFFF
#endif
#define PHON(k) (((PH_MASK) >> (k)) & 1)
#ifndef TRIVIAL_MIX
#define TRIVIAL_MIX 0
#endif
#ifndef SIMPLE_GEMM
#define SIMPLE_GEMM 0
#endif
#ifndef OPT_GLARET
#define OPT_GLARET 1
#endif
#ifndef OPT_LRU
#define OPT_LRU 1
#endif
#ifndef OPT_S5
#define OPT_S5 1
#endif
#ifndef REP_MIX
#define REP_MIX 1
#endif
#ifndef REP_GEMM
#define REP_GEMM 1
#endif
#ifndef PROBE_MIX
#define PROBE_MIX 1
#endif
#ifndef PROBE_G1
#define PROBE_G1 1
#endif
#ifndef PROBE_MMASK
#define PROBE_MMASK 0
#endif
#ifndef ONE_LAUNCH
#define ONE_LAUNCH 1
#endif

namespace pg8 {
#define PG8_LAS __attribute__((address_space(3)))
typedef unsigned short bf16_t;
typedef short bf16x8 __attribute__((ext_vector_type(8)));
typedef float f32x4 __attribute__((ext_vector_type(4)));
typedef unsigned u32x4 __attribute__((ext_vector_type(4)));
typedef unsigned u32x2 __attribute__((ext_vector_type(2)));
constexpr int BM = 256, BK = 64, HALF = 128, HTB = HALF * BK * 2, STAGE_BYTES = 8 * HTB, NXCD = 8, WGM = 8;

__host__ __device__ __forceinline__ int lds_byte(int r, int c) { const int st = (r >> 4) * 2 + (c >> 5), rr = r & 15, cc = c & 31, ob = rr * 64 + cc * 2; return st * 1024 + (ob ^ (((ob >> 9) & 1) << 5)); }
__host__ __device__ __forceinline__ void stage_rc(int b, int& R, int& C) { const int st = b / 1024, sb = b % 1024, swz = sb ^ (((sb >> 9) & 1) << 5); R = (st >> 1) * 16 + swz / 64; C = (st & 1) * 32 + (swz % 64) / 2; }
__host__ __device__ __forceinline__ int perm32(int rho) { const int n = rho >> 4, i = rho & 15; return 8 * (i >> 2) + 4 * n + (i & 3); }

struct Unit { int pm, pn, z; };
struct Gemm { const bf16_t* A; const bf16_t* Bt; int M, N, K, lda, ldb; size_t zA, zB; };

struct StaticOrder {
    int nM, nN, nwg, G, c, zsh;
    __host__ __device__ void init(int M, int N, int G_, int c_, int zsh_ = 0, int bn_ = BM) { nM = M / BM; nN = N / bn_; nwg = nM * nN; G = G_; c = c_; zsh = zsh_; }
    __host__ __device__ bool next(int i, Unit& u) const {
        const int ti = i >> zsh; u.z = i & ((1 << zsh) - 1);
        const long L = (long)ti * G + c; if (L >= nwg) return false;
        int wgid = (int)L; { const int q = nwg / NXCD, r = nwg % NXCD, xcd = wgid % NXCD, off = wgid / NXCD; wgid = (xcd < r ? xcd * (q + 1) : r * (q + 1) + (xcd - r) * q) + off; }
        const int nig = WGM * nN, gid = wgid / nig, fm = gid * WGM, gsz = (nM - fm) < WGM ? (nM - fm) : WGM;
        u.pm = fm + ((wgid % nig) % gsz); u.pn = (wgid % nig) / gsz; return true;
    }
    __device__ __forceinline__ void a_ready(const Unit&) const {}
    __device__ __forceinline__ void done(const Unit&) const {}
};

typedef float f32x2_ __attribute__((ext_vector_type(2)));
typedef __bf16 bf16x2_ __attribute__((ext_vector_type(2)));
__device__ __forceinline__ unsigned cvt_pk_bf16(float lo, float hi) { const f32x2_ v = {lo, hi}; const bf16x2_ b = __builtin_convertvector(v, bf16x2_); return __builtin_bit_cast(unsigned, b); }

template <class Epi, class Sched, bool ALIGN_EPI = false, bool SP2 = false, bool HALFN = false>
__device__ __forceinline__ void gemm_phase(PG8_LAS unsigned char* lds, const Gemm g, const Sched& S, const Epi& E) {
    int tid = threadIdx.x; asm volatile("" : "+v"(tid));
    const int wid = __builtin_amdgcn_readfirstlane(tid >> 6), lane = tid & 63, wr = wid >> 2, wc = wid & 3, fr = lane & 15, fq = lane >> 4;
    const int K = g.K, nt = K / BK;
    unsigned voffA[2], voffB[2];
#pragma unroll
    for (int i = 0; i < 2; ++i) { int R, C; stage_rc(tid * 16 + i * 8192, R, C); const int Rb = Epi::PERM ? ((R & ~31) + perm32(R & 31)) : R;
        voffA[i] = (unsigned)(R * g.lda + C) * 2u; voffB[i] = (unsigned)(Rb * g.ldb + C) * 2u; }
    const size_t kstep = (size_t)(BK * 2);
    const size_t hstepA = (size_t)HALF * g.lda * 2, hstepB = (size_t)HALF * g.ldb * 2;
    const size_t tstepA = 2 * hstepA, tstepB = HALFN ? hstepB : 2 * hstepB;
    const unsigned ldsw = (unsigned)wid * 1024u;
    unsigned aoff = (unsigned)lds_byte(wr * 64 + fr, fq * 8), boff = (unsigned)lds_byte(wc * 32 + fr, fq * 8) + 4u * HTB;
    asm volatile("" : "+v"(aoff), "+v"(boff));
#define PG8_SA(b, h) (((b) * 2 + (h)) * HTB)
#define PG8_SB(b, h) ((4 + (b) * 2 + (h)) * HTB)
#define PG8_STAGE(bufoff, gbase, voff) do { _Pragma("unroll") for (int _i = 0; _i < 2; ++_i) \
        __builtin_amdgcn_global_load_lds((const unsigned*)((const char*)(gbase) + (voff)[_i]), (PG8_LAS unsigned*)(lds + (bufoff) + ldsw + _i * 8192), 16, 0, 0); } while (0)
#define PG8_LDA(dst, b, h) do { _Pragma("unroll") for (int m = 0; m < 4; ++m) _Pragma("unroll") for (int k = 0; k < 2; ++k) dst[m][k] = *(const PG8_LAS bf16x8*)(lds + aoff + (PG8_SA(b, h) + m * 2048 + k * 1024)); } while (0)
#define PG8_LDB(dst, b, h) do { _Pragma("unroll") for (int n = 0; n < 2; ++n) _Pragma("unroll") for (int k = 0; k < 2; ++k) dst[n][k] = *(const PG8_LAS bf16x8*)(lds + boff + (((b) * 2 + (h)) * HTB + n * 2048 + k * 1024)); } while (0)
#define PG8_MMA(ai, bj, At, Bt) do { __builtin_amdgcn_s_setprio(1); _Pragma("unroll") for (int m = 0; m < 4; ++m) _Pragma("unroll") for (int n = 0; n < 2; ++n) _Pragma("unroll") for (int k = 0; k < 2; ++k) \
        acc[ai][bj][m][n] = __builtin_amdgcn_mfma_f32_16x16x32_bf16(Bt[n][k], At[m][k], acc[ai][bj][m][n], 0, 0, 0); __builtin_amdgcn_s_setprio(0); } while (0)
#define PG8_WAIT_V(n) asm volatile("s_waitcnt vmcnt(" #n ")" ::: "memory")
#define PG8_WAIT_L(n) asm volatile("s_waitcnt lgkmcnt(" #n ")" ::: "memory")
#define PG8_BAR __builtin_amdgcn_s_barrier()
#define PG8_SCHED __builtin_amdgcn_sched_barrier(0)
    Unit cur, nxt; int ui = 0;
    if (!S.next(0, cur)) return;
    f32x4 acc[2][2][4][2];
#pragma unroll
    for (int a = 0; a < 2; ++a)
#pragma unroll
        for (int b = 0; b < 2; ++b)
#pragma unroll
            for (int m = 0; m < 4; ++m)
#pragma unroll
                for (int n = 0; n < 2; ++n) acc[a][b][m][n] = (f32x4){0.f, 0.f, 0.f, 0.f};
    bf16x8 At[4][2], B0[2][2], B1[2][2];
    const char* cA = (const char*)g.A + (size_t)cur.pm * tstepA + (size_t)cur.z * g.zA; const char* cB = (const char*)g.Bt + (size_t)cur.pn * tstepB + (size_t)cur.z * g.zB;
    S.a_ready(cur);
    if constexpr (SP2 && HALFN) {
        PG8_STAGE(PG8_SB(0, 0), cB, voffB); PG8_STAGE(PG8_SA(0, 0), cA, voffA); PG8_STAGE(PG8_SA(0, 1), cA + hstepA, voffA);
        if (wr == 1) PG8_BAR;
        PG8_WAIT_V(2); PG8_BAR;
        PG8_STAGE(PG8_SB(1, 0), cB + kstep, voffB); PG8_STAGE(PG8_SA(1, 0), cA + kstep, voffA);
        PG8_WAIT_V(4); PG8_BAR;
    } else if constexpr (SP2) {
        PG8_STAGE(PG8_SB(0, 0), cB, voffB); PG8_STAGE(PG8_SB(0, 1), cB + hstepB, voffB); PG8_STAGE(PG8_SA(0, 0), cA, voffA); PG8_STAGE(PG8_SA(0, 1), cA + hstepA, voffA);
        if (wr == 1) PG8_BAR;
        PG8_WAIT_V(2); PG8_BAR;
        PG8_STAGE(PG8_SB(1, 0), cB + kstep, voffB); PG8_STAGE(PG8_SA(1, 0), cA + kstep, voffA); PG8_STAGE(PG8_SB(1, 1), cB + hstepB + kstep, voffB);
        PG8_WAIT_V(6); PG8_BAR;
    } else {
        PG8_STAGE(PG8_SB(0, 0), cB, voffB); PG8_STAGE(PG8_SA(0, 0), cA, voffA); PG8_STAGE(PG8_SB(0, 1), cB + hstepB, voffB); PG8_STAGE(PG8_SA(0, 1), cA + hstepA, voffA);
        if (wr == 1) PG8_BAR;
        PG8_WAIT_V(4); PG8_BAR;
        PG8_STAGE(PG8_SB(1, 0), cB + kstep, voffB); PG8_STAGE(PG8_SA(1, 0), cA + kstep, voffA); PG8_STAGE(PG8_SB(1, 1), cB + hstepB + kstep, voffB);
        PG8_WAIT_V(6); PG8_BAR;
    }
    for (;;) {
        const bool has_next = S.next(ui + 1, nxt);
        const char* nA = has_next ? (const char*)g.A + (size_t)nxt.pm * tstepA + (size_t)nxt.z * g.zA : cA; const char* nB = has_next ? (const char*)g.Bt + (size_t)nxt.pn * tstepB + (size_t)nxt.z * g.zB : cB;
        for (int t = 0; t < nt; t += 2) {
            const bool last = (t == nt - 2);
            const char* a1 = cA + (size_t)(t + 1) * kstep;
            const char* a2 = last ? nA : cA + (size_t)(t + 2) * kstep; const char* b2 = last ? nB : cB + (size_t)(t + 2) * kstep;
            const char* a3 = a2 + kstep; const char* b3 = b2 + kstep;
            if (last && has_next) S.a_ready(nxt);
            if constexpr (SP2 && HALFN) {
            PG8_LDB(B0, 0, 0); PG8_SCHED; PG8_LDA(At, 0, 0); PG8_STAGE(PG8_SA(1, 1), a1 + hstepA, voffA);
            PG8_WAIT_V(6); PG8_WAIT_L(0); PG8_BAR; PG8_MMA(0, 0, At, B0); PG8_BAR; PG8_SCHED;
            PG8_LDA(At, 0, 1); PG8_STAGE(PG8_SB(0, 0), b2, voffB); PG8_STAGE(PG8_SA(0, 0), a2, voffA);
            PG8_WAIT_V(6); PG8_WAIT_L(0); PG8_BAR; PG8_MMA(1, 0, At, B0); PG8_BAR; PG8_SCHED;
            PG8_LDB(B0, 1, 0); PG8_SCHED; PG8_LDA(At, 1, 0); PG8_STAGE(PG8_SA(0, 1), a2 + hstepA, voffA);
            PG8_WAIT_V(6); PG8_WAIT_L(0); PG8_BAR; PG8_MMA(0, 0, At, B0); PG8_BAR; PG8_SCHED;
            PG8_LDA(At, 1, 1); PG8_STAGE(PG8_SB(1, 0), b3, voffB); PG8_STAGE(PG8_SA(1, 0), a3, voffA);
            PG8_WAIT_V(6); PG8_WAIT_L(0); PG8_BAR; PG8_MMA(1, 0, At, B0); PG8_BAR; PG8_SCHED;
            } else if constexpr (SP2) {
            PG8_LDB(B0, 0, 0); PG8_LDB(B1, 0, 1); PG8_SCHED; PG8_LDA(At, 0, 0); PG8_STAGE(PG8_SA(1, 1), a1 + hstepA, voffA);
            PG8_WAIT_V(8); PG8_WAIT_L(0); PG8_BAR; PG8_MMA(0, 0, At, B0); PG8_MMA(0, 1, At, B1); PG8_BAR; PG8_SCHED;
            PG8_LDA(At, 0, 1); PG8_STAGE(PG8_SB(0, 0), b2, voffB); PG8_STAGE(PG8_SB(0, 1), b2 + hstepB, voffB); PG8_STAGE(PG8_SA(0, 0), a2, voffA);
            PG8_WAIT_V(8); PG8_WAIT_L(0); PG8_BAR; PG8_MMA(1, 0, At, B0); PG8_MMA(1, 1, At, B1); PG8_BAR; PG8_SCHED;
            PG8_LDB(B0, 1, 0); PG8_LDB(B1, 1, 1); PG8_SCHED; PG8_LDA(At, 1, 0); PG8_STAGE(PG8_SA(0, 1), a2 + hstepA, voffA);
            PG8_WAIT_V(8); PG8_WAIT_L(0); PG8_BAR; PG8_MMA(0, 0, At, B0); PG8_MMA(0, 1, At, B1); PG8_BAR; PG8_SCHED;
            PG8_LDA(At, 1, 1); PG8_STAGE(PG8_SB(1, 0), b3, voffB); PG8_STAGE(PG8_SB(1, 1), b3 + hstepB, voffB); PG8_STAGE(PG8_SA(1, 0), a3, voffA);
            PG8_WAIT_V(8); PG8_WAIT_L(0); PG8_BAR; PG8_MMA(1, 0, At, B0); PG8_MMA(1, 1, At, B1); PG8_BAR; PG8_SCHED;
            } else {
            PG8_LDB(B0, 0, 0); PG8_SCHED; PG8_LDA(At, 0, 0); PG8_STAGE(PG8_SA(1, 1), a1 + hstepA, voffA);
            PG8_WAIT_L(8); PG8_BAR; PG8_WAIT_L(0); PG8_MMA(0, 0, At, B0); PG8_BAR; PG8_SCHED;
            PG8_LDB(B1, 0, 1); PG8_STAGE(PG8_SB(0, 0), b2, voffB);
            PG8_BAR; PG8_WAIT_L(0); PG8_MMA(0, 1, At, B1); PG8_BAR;
            PG8_LDA(At, 0, 1); PG8_STAGE(PG8_SA(0, 0), a2, voffA);
            PG8_BAR; PG8_WAIT_L(0); PG8_MMA(1, 0, At, B0); PG8_BAR; PG8_SCHED;
            PG8_STAGE(PG8_SB(0, 1), b2 + hstepB, voffB);
            PG8_WAIT_V(6); PG8_BAR; PG8_MMA(1, 1, At, B1); PG8_BAR;
            PG8_LDB(B0, 1, 0); PG8_SCHED; PG8_LDA(At, 1, 0); PG8_STAGE(PG8_SA(0, 1), a2 + hstepA, voffA);
            PG8_WAIT_L(8); PG8_BAR; PG8_WAIT_L(0); PG8_MMA(0, 0, At, B0); PG8_BAR; PG8_SCHED;
            PG8_LDB(B1, 1, 1); PG8_STAGE(PG8_SB(1, 0), b3, voffB);
            PG8_BAR; PG8_WAIT_L(0); PG8_MMA(0, 1, At, B1); PG8_BAR;
            PG8_LDA(At, 1, 1); PG8_STAGE(PG8_SA(1, 0), a3, voffA);
            PG8_BAR; PG8_WAIT_L(0); PG8_MMA(1, 0, At, B0); PG8_BAR; PG8_SCHED;
            PG8_STAGE(PG8_SB(1, 1), b3 + hstepB, voffB);
            PG8_WAIT_V(6); PG8_BAR; PG8_MMA(1, 1, At, B1); PG8_BAR;
            }
        }
        if constexpr (ALIGN_EPI) { if (wr == 0) PG8_BAR; }
        { int fr_e = fr, fq_e = fq; asm volatile("" : "+v"(fr_e), "+v"(fq_e));
          E(acc, cur, wr, wc, fr_e, fq_e); }
        if (!has_next) break;
        if (!HALFN && !(Epi::KEEP && cur.z != 3)) {
#pragma unroll
        for (int a = 0; a < 2; ++a)
#pragma unroll
            for (int b = 0; b < 2; ++b)
#pragma unroll
                for (int m = 0; m < 4; ++m)
#pragma unroll
                    for (int n = 0; n < 2; ++n) acc[a][b][m][n] = (f32x4){0.f, 0.f, 0.f, 0.f};
        }
        cur = nxt; cA = nA; cB = nB; ++ui;
        if constexpr (ALIGN_EPI) { if (wr == 1) PG8_BAR; }
    }
    PG8_WAIT_V(0);
    if constexpr (!ALIGN_EPI) { if (wr == 0) PG8_BAR; }
    PG8_BAR;
#undef PG8_SA
#undef PG8_SB
#undef PG8_STAGE
#undef PG8_LDA
#undef PG8_LDB
#undef PG8_MMA
#undef PG8_WAIT_V
#undef PG8_WAIT_L
#undef PG8_BAR
#undef PG8_SCHED
}

template <class Epi, class Sched>
__device__ __forceinline__ void gemm_simple(const Gemm g, const Sched& S, const Epi& E) {
    int tid = threadIdx.x; asm volatile("" : "+v"(tid));
    const int wid = __builtin_amdgcn_readfirstlane(tid >> 6), lane = tid & 63, wr = wid >> 2, wc = wid & 3, fr = lane & 15, fq = lane >> 4;
    Unit cur;
    for (int ui = 0; S.next(ui, cur); ++ui) {
        f32x4 acc[2][2][4][2];
#pragma unroll
        for (int a = 0; a < 2; ++a)
#pragma unroll
            for (int b = 0; b < 2; ++b)
#pragma unroll
                for (int m = 0; m < 4; ++m)
#pragma unroll
                    for (int n = 0; n < 2; ++n) acc[a][b][m][n] = (f32x4){0.f, 0.f, 0.f, 0.f};
        const bf16_t* A = (const bf16_t*)((const char*)g.A + (size_t)cur.z * g.zA) + (size_t)(cur.pm * 256 + wr * 64 + fr) * g.lda + fq * 8;
        const bf16_t* B = (const bf16_t*)((const char*)g.Bt + (size_t)cur.z * g.zB) + (size_t)(cur.pn * 256 + wc * 32) * g.ldb + fq * 8;
        for (int k0 = 0; k0 < g.K; k0 += 32) {
            bf16x8 Af[2][4], Bf[2][2];
#pragma unroll
            for (int ai = 0; ai < 2; ++ai)
#pragma unroll
                for (int m = 0; m < 4; ++m) Af[ai][m] = *(const bf16x8*)(A + (size_t)(ai * 128 + m * 16) * g.lda + k0);
#pragma unroll
            for (int bj = 0; bj < 2; ++bj)
#pragma unroll
                for (int n = 0; n < 2; ++n) { const int rr = Epi::PERM ? perm32(16 * n + fr) : (16 * n + fr); Bf[bj][n] = *(const bf16x8*)(B + (size_t)(bj * 128 + rr) * g.ldb + k0); }
#pragma unroll
            for (int ai = 0; ai < 2; ++ai)
#pragma unroll
                for (int bj = 0; bj < 2; ++bj)
#pragma unroll
                    for (int m = 0; m < 4; ++m)
#pragma unroll
                        for (int n = 0; n < 2; ++n) acc[ai][bj][m][n] = __builtin_amdgcn_mfma_f32_16x16x32_bf16(Bf[bj][n], Af[ai][m], acc[ai][bj][m][n], 0, 0, 0);
        }
        E(acc, cur, wr, wc, fr, fq);
    }
}
}

using pg8::bf16_t; using pg8::f32x4; using pg8::u32x4; using pg8::u32x2; using pg8::bf16x8; using pg8::cvt_pk_bf16;
#define LAS __attribute__((address_space(3)))

constexpr int D = 1024, SEQ = 4096, NB = 16, DEPTH = 4, BW = 512;
constexpr int NGRP = 2, BG = NB / NGRP, TG = BG * SEQ;
constexpr int N_IN = 21 * 256, N_MG = 4096, N_ALL = N_IN + N_MG;
constexpr int PLD = 20 * 256;
constexpr int P_GQ = 0, P_GK = 256, P_GV = 512, P_GG = 1024, P_RQ = 1536, P_RK = 1792, P_RV = 2048, P_RG = 2560, P_LX = 3072, P_LG = 3584, P_SU = 4096, P_SG = 4608;
constexpr int OLD = 2048;
constexpr float NORM_EPS = 1e-6f;

constexpr size_t MiB = 1u << 20;
constexpr size_t WS_CTL = 0, CTL_BYTES = 2 * MiB;
constexpr size_t WS_ROT = 2 * MiB;
constexpr size_t WS_SMALL = 3 * MiB, SMALL_STRIDE = 1 * MiB;
constexpr size_t WS_W = 8 * MiB, W_STRIDE = 26 * MiB;
constexpr size_t WO_IN = 0, WO_BR = (size_t)N_ALL * D * 2, WO_OUT = WO_BR + (size_t)4 * D * BW * 2, WO_GLU = WO_OUT + (size_t)D * D * 2, WO_END = WO_GLU + (size_t)BW * BW * 2;
static_assert(WO_END <= W_STRIDE, "weights");
constexpr size_t WS_U = 112 * MiB;
constexpr size_t WS_P = 176 * MiB;
constexpr size_t WS_LA = 496 * MiB;
constexpr size_t WS_O = 528 * MiB;
constexpr size_t WS_Y5 = 656 * MiB;
constexpr size_t WS_PG = 688 * MiB;
constexpr size_t WS_ST = 944 * MiB;
constexpr size_t WS_END = 1008 * MiB;
constexpr int SM_ABR = 0, SM_ABI = 2048, SM_BBR = 4096, SM_BBI = 4096 + 32768, SM_SP8 = 4096 + 65536, SM_END_F = SM_SP8 + 512;
constexpr int SM_A128 = SM_END_F;
constexpr size_t SM_LRUW_BYTES = 512 * 1024, SM_CT_BYTES = 640 * 1024, SM_BBT_BYTES = 768 * 1024;
static_assert((size_t)(SM_END_F + 4096) * 4 <= SM_LRUW_BYTES, "small");

constexpr int CW_BAR = 4096;
#define XB_TMO      128
#define XB_XCNT(j)  (256  + 64 * (j))
#define XB_XSUB(j)  (1280 + 64 * (j))
#define XB_XGEN(j)  (2304 + 64 * (j))
#define XB_TOP      3328
#define XB_TOPGEN   3392
#define XCD_BAR_WORDS 3456
#define XB_SPIN_CAP (1u << 18)

__device__ __forceinline__ unsigned xb_ld(unsigned* p)              { return __hip_atomic_load(p, __ATOMIC_RELAXED, __HIP_MEMORY_SCOPE_AGENT); }
__device__ __forceinline__ unsigned xb_add(unsigned* p, unsigned v) { return __hip_atomic_fetch_add(p, v, __ATOMIC_RELAXED, __HIP_MEMORY_SCOPE_AGENT); }
__device__ __forceinline__ unsigned xb_xcc_id() { return (unsigned)__builtin_amdgcn_s_getreg((3 << 11) | 20) & 0xFu; }
#define XB_SPIN(cond, bar) do { unsigned _sp = 0; while (cond) { __builtin_amdgcn_s_sleep(1); \
    if ((++_sp & 255u) == 0u) { if (xb_ld(&(bar)[XB_TMO])) break; if (_sp > XB_SPIN_CAP) { atomicAdd(&(bar)[XB_TMO], 1u); break; } } } } while (0)
struct XcdBarrier { unsigned* bar; unsigned x; volatile LAS unsigned* st; };
__device__ __forceinline__ XcdBarrier xcd_barrier_post(unsigned* bar, volatile LAS unsigned* st) {
    XcdBarrier b; b.bar = bar; b.x = xb_xcc_id(); b.st = st;
    if (threadIdx.x == 0) (void)xb_add(&bar[XB_XCNT(b.x)], 1u);
    return b;
}
__device__ __forceinline__ void xcd_barrier_complete(unsigned* bar, unsigned x, unsigned& nloc, unsigned& nx) {
    const unsigned G = gridDim.x * gridDim.y * gridDim.z;
    unsigned sum, cnt, mine, sp = 0u;
    for (;;) {
        sum = 0u; cnt = 0u; mine = 0u;
#pragma unroll
        for (unsigned j = 0; j < 16; ++j) { const unsigned c = xb_ld(&bar[XB_XCNT(j)]); sum += c; cnt += (c > 0u) ? 1u : 0u; mine = (j == x) ? c : mine; }
        if (sum == G) break;
        __builtin_amdgcn_s_sleep(1);
        if ((++sp & 255u) == 0u) { if (xb_ld(&bar[XB_TMO])) break; if (sp > XB_SPIN_CAP) { atomicAdd(&bar[XB_TMO], 1u); break; } }
    }
    nloc = mine > 0u ? mine : 1u; nx = cnt > 0u ? cnt : 1u;
}
__device__ __forceinline__ void xcd_barrier(const XcdBarrier& b) {
    asm volatile("s_waitcnt vmcnt(0)" ::: "memory");
    __syncthreads();
    if (threadIdx.x == 0) {
        unsigned* bar = b.bar;
        __builtin_amdgcn_s_waitcnt(0);
        unsigned nloc = b.st[0], nx = b.st[1];
        if (nloc == 0u) { xcd_barrier_complete(bar, b.x, nloc, nx); b.st[0] = nloc; b.st[1] = nx; }
        const unsigned old = xb_add(&bar[XB_XSUB(b.x)], 1u);
        const unsigned gen = old / nloc;
        if (old + 1u == (gen + 1u) * nloc) {
            __builtin_amdgcn_fence(__ATOMIC_RELEASE, "agent");
            asm volatile("s_waitcnt vmcnt(0)" ::: "memory");
            const unsigned og = xb_add(&bar[XB_TOP], 1u);
            const unsigned tg = og / nx;
            if (og + 1u == (tg + 1u) * nx) xb_add(&bar[XB_TOPGEN], 1u);
            else XB_SPIN(xb_ld(&bar[XB_TOPGEN]) == tg, bar);
            __builtin_amdgcn_fence(__ATOMIC_ACQUIRE, "agent");
            xb_add(&bar[XB_XGEN(b.x)], 1u);
            asm volatile("s_waitcnt vmcnt(0)" ::: "memory");
        } else {
            XB_SPIN(xb_ld(&bar[XB_XGEN(b.x)]) == gen, bar);
            __builtin_amdgcn_fence(__ATOMIC_ACQUIRE, "agent");
            asm volatile("s_waitcnt vmcnt(0)" ::: "memory");
        }
    }
    __syncthreads();
}

__device__ __forceinline__ float bf2f(bf16_t b) { return __uint_as_float(((unsigned)b) << 16); }
__device__ __forceinline__ float bflo(unsigned w) { return __uint_as_float(w << 16); }
__device__ __forceinline__ float bfhi(unsigned w) { return __uint_as_float(w & 0xffff0000u); }
__device__ __forceinline__ bf16_t f2bf(float f) { return (bf16_t)(cvt_pk_bf16(f, 0.f) & 0xffffu); }
__device__ __forceinline__ float sigmoid_f(float x) { return __builtin_amdgcn_rcpf(1.f + __expf(-x)); }
__device__ __forceinline__ float silu_f(float x) { return x * sigmoid_f(x); }
__device__ __forceinline__ float gelu_tanh_f(float x) { const float u = 0.7978845608028654f * (x + 0.044715f * x * x * x); const float t = 1.f - 2.f * __builtin_amdgcn_rcpf(1.f + __expf(2.f * u)); return 0.5f * x * (1.f + t); }
__device__ __forceinline__ float wave_sum(float v) {
#pragma unroll
    for (int o = 1; o < 64; o <<= 1) v += __shfl_xor(v, o);
    return v;
}

#define KENTRY() do { __builtin_amdgcn_fence(__ATOMIC_ACQUIRE, "agent"); asm volatile("s_waitcnt vmcnt(0)" ::: "memory"); } while (0)
#define KEXIT() do { asm volatile("s_waitcnt vmcnt(0)" ::: "memory"); __builtin_amdgcn_fence(__ATOMIC_RELEASE, "agent"); asm volatile("s_waitcnt vmcnt(0)" ::: "memory"); } while (0)
#if SIMPLE_GEMM
#define GEMM_CALL(EPI) pg8::gemm_simple<EPI, pg8::StaticOrder>(g, S, E)
#else
#if REP_GEMM == 2
#define GEMM_CALL(EPI) do { pg8::gemm_phase<EPI, pg8::StaticOrder, true, true>(lds, g, S, E); xcd_barrier(bar); pg8::gemm_phase<EPI, pg8::StaticOrder, true, true>(lds, g, S, E); } while (0)
#else
#define GEMM_CALL(EPI) pg8::gemm_phase<EPI, pg8::StaticOrder, true, true>(lds, g, S, E)
#endif
#endif
struct Args {
    const float* in[29]; float* out; unsigned char* ws;
    int s_lo, s_hi, li, fin, mmask, pad2;
};
enum { I_X = 0, I_NG, I_WIN, I_GWLR, I_GBLR, I_GNG, I_RNG, I_RNB, I_LCW, I_LCB, I_LWA, I_LBA, I_LWX, I_LBX, I_LLAM,
       I_SARE, I_SAIM, I_SBRE, I_SBIM, I_SCRE, I_SCIM, I_SD, I_SLDT, I_SGW, I_SGB, I_WMG, I_WBR, I_WOUT, I_FNG };

struct EpiIn {
    static constexpr bool PERM = true, AFTER_DRAIN = false, KEEP = false;
    bf16_t* P; float* LA; const float* blr; const float* rot; bf16_t* PG;
    __device__ __forceinline__ void operator()(f32x4 (&acc)[2][2][4][2], const pg8::Unit& u, int wr, int wc, int fr, int fq) const {
        const int pn = u.pn, row0 = u.pm * 256 + wr * 64 + fr, cl = wc * 32 + 8 * fq;
        if (pn >= 21) {
            const int c0 = (pn - 21) * 256 + cl;
#pragma unroll
            for (int ai = 0; ai < 2; ++ai)
#pragma unroll
                for (int m = 0; m < 4; ++m) { int row = row0 + ai * 128 + m * 16; asm volatile("" : "+v"(row));
#pragma unroll
                    for (int bj = 0; bj < 2; ++bj) { f32x4 v0 = acc[ai][bj][m][0], v1 = acc[ai][bj][m][1];
#pragma unroll
                        for (int j = 0; j < 4; ++j) { v0[j] = sigmoid_f(v0[j]); v1[j] = sigmoid_f(v1[j]); }
                        u32x4 w; w.x = cvt_pk_bf16(v0[0], v0[1]); w.y = cvt_pk_bf16(v0[2], v0[3]); w.z = cvt_pk_bf16(v1[0], v1[1]); w.w = cvt_pk_bf16(v1[2], v1[3]);
                        __builtin_nontemporal_store(w, (u32x4*)(PG + (size_t)row * N_MG + c0 + bj * 128)); } }
        } else if (pn == 4) {
#pragma unroll
            for (int bj = 0; bj < 2; ++bj) { const int c = cl + bj * 128; const f32x4 b0 = *(const f32x4*)(blr + c), b1 = *(const f32x4*)(blr + c + 4);
#pragma unroll
                for (int ai = 0; ai < 2; ++ai) {
#pragma unroll
                    for (int n = 0; n < 2; ++n)
#pragma unroll
                        for (int j = 0; j < 4; ++j) { float run = 0.f; const float bb = n ? b1[j] : b0[j];
#pragma unroll
                            for (int m = 0; m < 4; ++m) { const float z = acc[ai][bj][m][n][j] + bb; const float x = -(fmaxf(-z, 0.f) + __logf(1.f + __expf(-fabsf(z)))) * 0.0625f; float ls = x, rs = x;
#define DPP_ADD(acc_, ctrl_) acc_ += __builtin_bit_cast(float, __builtin_amdgcn_update_dpp(0, __builtin_bit_cast(int, acc_), ctrl_, 0xf, 0xf, true))
                                DPP_ADD(ls, 0x111); DPP_ADD(ls, 0x112); DPP_ADD(ls, 0x114); DPP_ADD(ls, 0x118);
                                DPP_ADD(rs, 0x101); DPP_ADD(rs, 0x102); DPP_ADD(rs, 0x104); DPP_ADD(rs, 0x108);
#undef DPP_ADD
                                acc[ai][bj][m][n][j] = run + ls; run += ls + rs - x; } }
#pragma unroll
                    for (int m = 0; m < 4; ++m) { int row = row0 + ai * 128 + m * 16; asm volatile("" : "+v"(row)); float* d = LA + (size_t)row * 256 + c; *(f32x4*)d = acc[ai][bj][m][0]; *(f32x4*)(d + 4) = acc[ai][bj][m][1]; } } }
        } else if (pn == 7 || pn == 8) {
            const float sc = pn == 8 ? 0.125f : 1.f; const int dcol = (pn - 1) * 256;
#pragma unroll
            for (int ai = 0; ai < 2; ++ai)
#pragma unroll
                for (int m = 0; m < 4; ++m) { int row = row0 + ai * 128 + m * 16; asm volatile("" : "+v"(row)); const int pos = row & (SEQ - 1);
#pragma unroll
                    for (int bj = 0; bj < 2; ++bj) { const int c = cl + bj * 128, i0 = (c & 63) >> 1; const float* rt = rot + ((size_t)pos * 32 + i0) * 2;
                        const f32x4 cs0 = *(const f32x4*)rt, cs1 = *(const f32x4*)(rt + 4); const f32x4 v0 = acc[ai][bj][m][0] * sc, v1 = acc[ai][bj][m][1] * sc;
                        u32x4 w; w.x = cvt_pk_bf16(v0[0] * cs0[0] - v0[1] * cs0[1], v0[0] * cs0[1] + v0[1] * cs0[0]); w.y = cvt_pk_bf16(v0[2] * cs0[2] - v0[3] * cs0[3], v0[2] * cs0[3] + v0[3] * cs0[2]);
                        w.z = cvt_pk_bf16(v1[0] * cs1[0] - v1[1] * cs1[1], v1[0] * cs1[1] + v1[1] * cs1[0]); w.w = cvt_pk_bf16(v1[2] * cs1[2] - v1[3] * cs1[3], v1[2] * cs1[3] + v1[3] * cs1[2]);
                        __builtin_nontemporal_store(w, (u32x4*)(P + (size_t)row * PLD + dcol + c)); } }
        } else {
            const bool silu = (pn == 5 || pn == 6 || pn == 11 || pn == 12 || pn == 15 || pn == 16 || pn == 19 || pn == 20);
            const float sc = pn == 0 ? 0.125f : 1.f; const int dcol = (pn < 4 ? pn : pn - 1) * 256;
#pragma unroll
            for (int ai = 0; ai < 2; ++ai)
#pragma unroll
                for (int m = 0; m < 4; ++m) { int row = row0 + ai * 128 + m * 16; asm volatile("" : "+v"(row));
#pragma unroll
                    for (int bj = 0; bj < 2; ++bj) { f32x4 v0 = acc[ai][bj][m][0] * sc, v1 = acc[ai][bj][m][1] * sc;
                        if (silu) {
#pragma unroll
                            for (int j = 0; j < 4; ++j) { v0[j] = silu_f(v0[j]); v1[j] = silu_f(v1[j]); } }
                        u32x4 w; w.x = cvt_pk_bf16(v0[0], v0[1]); w.y = cvt_pk_bf16(v0[2], v0[3]); w.z = cvt_pk_bf16(v1[0], v1[1]); w.w = cvt_pk_bf16(v1[2], v1[3]);
                        __builtin_nontemporal_store(w, (u32x4*)(P + (size_t)row * PLD + dcol + cl + bj * 128)); } }
        }
    }
};
struct EpiSig {
    static constexpr bool PERM = true, AFTER_DRAIN = false, KEEP = false;
    bf16_t* PG;
    __device__ __forceinline__ void operator()(const f32x4 (&acc)[2][2][4][2], const pg8::Unit& u, int wr, int wc, int fr, int fq) const {
        const int row0 = u.pm * 256 + wr * 64 + fr, c0 = u.pn * 256 + wc * 32 + 8 * fq;
#pragma unroll
        for (int ai = 0; ai < 2; ++ai)
#pragma unroll
            for (int m = 0; m < 4; ++m) { const int row = row0 + ai * 128 + m * 16;
#pragma unroll
                for (int bj = 0; bj < 2; ++bj) { f32x4 v0 = acc[ai][bj][m][0], v1 = acc[ai][bj][m][1];
#pragma unroll
                    for (int j = 0; j < 4; ++j) { v0[j] = sigmoid_f(v0[j]); v1[j] = sigmoid_f(v1[j]); }
                    u32x4 w; w.x = cvt_pk_bf16(v0[0], v0[1]); w.y = cvt_pk_bf16(v0[2], v0[3]); w.z = cvt_pk_bf16(v1[0], v1[1]); w.w = cvt_pk_bf16(v1[2], v1[3]);
                    *(u32x4*)(PG + (size_t)row * N_MG + c0 + bj * 128) = w; } }
    }
};
struct EpiGlu {
    static constexpr bool PERM = true, AFTER_DRAIN = false, KEEP = false;
    const bf16_t* Y5; const bf16_t* P; const float* gb; bf16_t* O;
    __device__ __forceinline__ void operator()(const f32x4 (&acc)[2][2][4][2], const pg8::Unit& u, int wr, int wc, int fr, int fq) const {
        const int row0 = u.pm * 256 + wr * 64 + fr, c0 = u.pn * 256 + wc * 32 + 8 * fq;
#pragma unroll
        for (int bj = 0; bj < 2; ++bj) { const int c = c0 + bj * 128; const f32x4 b0 = *(const f32x4*)(gb + c), b1 = *(const f32x4*)(gb + c + 4);
#pragma unroll
            for (int ai = 0; ai < 2; ++ai)
#pragma unroll
                for (int m = 0; m < 4; ++m) { const int row = row0 + ai * 128 + m * 16;
                    const u32x4 y = *(const u32x4*)(Y5 + (size_t)row * BW + c), s = *(const u32x4*)(P + (size_t)row * PLD + P_SG + c);
                    const f32x4 v0 = acc[ai][bj][m][0] + b0, v1 = acc[ai][bj][m][1] + b1;
                    u32x4 w;
                    w.x = cvt_pk_bf16(bflo(y.x) * sigmoid_f(v0[0]) * bflo(s.x), bfhi(y.x) * sigmoid_f(v0[1]) * bfhi(s.x));
                    w.y = cvt_pk_bf16(bflo(y.y) * sigmoid_f(v0[2]) * bflo(s.y), bfhi(y.y) * sigmoid_f(v0[3]) * bfhi(s.y));
                    w.z = cvt_pk_bf16(bflo(y.z) * sigmoid_f(v1[0]) * bflo(s.z), bfhi(y.z) * sigmoid_f(v1[1]) * bfhi(s.z));
                    w.w = cvt_pk_bf16(bflo(y.w) * sigmoid_f(v1[2]) * bflo(s.w), bfhi(y.w) * sigmoid_f(v1[3]) * bfhi(s.w));
                    *(u32x4*)(O + (size_t)row * OLD + 1536 + c) = w; } }
    }
};
struct EpiBr {
    static constexpr bool PERM = true, AFTER_DRAIN = false, KEEP = false;
    const bf16_t* PG; bf16_t* MRG;
    __device__ __forceinline__ void operator()(f32x4 (&acc)[2][2][4][2], const pg8::Unit& u, int wr, int wc, int fr, int fq) const {
        const int row0 = u.pm * 256 + wr * 64 + fr, c = u.pn * 128 + wc * 32 + 8 * fq, z = u.z;
#pragma unroll
        for (int ai = 0; ai < 2; ++ai)
#pragma unroll
            for (int m = 0; m < 4; ++m) { const int row = row0 + ai * 128 + m * 16;
                const u32x4 gt = __builtin_nontemporal_load((const u32x4*)(PG + (size_t)row * N_MG + z * 1024 + c));
                f32x4& p0 = acc[ai][0][m][0]; f32x4& p1 = acc[ai][0][m][1]; f32x4& s0 = acc[ai][1][m][0]; f32x4& s1 = acc[ai][1][m][1];
                if (z == 0) { s0 = (f32x4){0.f, 0.f, 0.f, 0.f}; s1 = s0; }
                s0[0] += p0[0] * bflo(gt.x); s0[1] += p0[1] * bfhi(gt.x); s0[2] += p0[2] * bflo(gt.y); s0[3] += p0[3] * bfhi(gt.y);
                s1[0] += p1[0] * bflo(gt.z); s1[1] += p1[1] * bfhi(gt.z); s1[2] += p1[2] * bflo(gt.w); s1[3] += p1[3] * bfhi(gt.w);
                p0 = (f32x4){0.f, 0.f, 0.f, 0.f}; p1 = p0;
                if (z == 3) { u32x4 w; w.x = cvt_pk_bf16(s0[0], s0[1]); w.y = cvt_pk_bf16(s0[2], s0[3]); w.z = cvt_pk_bf16(s1[0], s1[1]); w.w = cvt_pk_bf16(s1[2], s1[3]);
                    *(u32x4*)(MRG + (size_t)row * D + c) = w; } }
    }
};
struct EpiOut {
    static constexpr bool PERM = true, AFTER_DRAIN = false, KEEP = false;
    bf16_t* DL;
    __device__ __forceinline__ void operator()(const f32x4 (&acc)[2][2][4][2], const pg8::Unit& u, int wr, int wc, int fr, int fq) const {
        const int row0 = u.pm * 256 + wr * 64 + fr, c0 = u.pn * 256 + wc * 32 + 8 * fq;
#pragma unroll
        for (int ai = 0; ai < 2; ++ai)
#pragma unroll
            for (int m = 0; m < 4; ++m) { const int row = row0 + ai * 128 + m * 16;
#pragma unroll
                for (int bj = 0; bj < 2; ++bj) { const f32x4 v0 = acc[ai][bj][m][0], v1 = acc[ai][bj][m][1];
                    u32x4 w; w.x = cvt_pk_bf16(v0[0], v0[1]); w.y = cvt_pk_bf16(v0[2], v0[3]); w.z = cvt_pk_bf16(v1[0], v1[1]); w.w = cvt_pk_bf16(v1[2], v1[3]);
                    *(u32x4*)(DL + (size_t)row * D + c0 + bj * 128) = w; } }
    }
};

__device__ __forceinline__ int win_src_col(int r) {
    const int pn = r >> 8, j = r & 255;
    switch (pn) {
        case 0: return j; case 1: return 256 + j; case 2: case 3: return 512 + (r - 512);
        case 4: return -1;
        case 5: case 6: return 1040 + (r - 1280);
        case 7: return 1552 + 64 * (j >> 6) + ((j & 63) >> 1) + 32 * (j & 1);
        case 8: return 1808 + 64 * (j >> 6) + ((j & 63) >> 1) + 32 * (j & 1);
        case 9: case 10: return 2064 + (r - 2304);
        case 11: case 12: return 2576 + (r - 2816);
        case 13: case 14: return 3088 + (r - 3328);
        case 15: case 16: return 3600 + (r - 3840);
        case 17: case 18: return 4112 + (r - 4352);
        default: return 4624 + (r - 4864);
    }
}
__device__ __forceinline__ void tr_store8(bf16_t* dst, const float (&v)[8]) {
    u32x4 w; w.x = cvt_pk_bf16(v[0], v[1]); w.y = cvt_pk_bf16(v[2], v[3]); w.z = cvt_pk_bf16(v[4], v[5]); w.w = cvt_pk_bf16(v[6], v[7]); *(u32x4*)dst = w;
}
__device__ __forceinline__ void phase_prologue(const Args& a, int gtid, int gthreads) {
    unsigned char* ws = a.ws;
    for (int l = 0; l < DEPTH; ++l) {
        bf16_t* Wl = (bf16_t*)(ws + WS_W + (size_t)l * W_STRIDE);
        const float* win = a.in[I_WIN] + (size_t)l * D * 5136;
        const float* wlr = a.in[I_GWLR] + (size_t)l * 16 * 256;
        for (int idx = gtid; idx < N_IN * (D / 8); idx += gthreads) { const int n = idx % N_IN, kc = idx / N_IN; const int sc = win_src_col(n); float v[8];
            if (sc >= 0) {
#pragma unroll
                for (int i = 0; i < 8; ++i) v[i] = win[(size_t)(kc * 8 + i) * 5136 + sc];
            } else { const int j = n & 255;
#pragma unroll
                for (int i = 0; i < 8; ++i) { float s = 0.f; const float* wr_ = win + (size_t)(kc * 8 + i) * 5136 + 1024;
#pragma unroll
                    for (int r = 0; r < 16; ++r) s += wr_[r] * wlr[r * 256 + j];
                    v[i] = s; } }
            tr_store8(Wl + (size_t)n * D + kc * 8, v); }
        const float* wmg = a.in[I_WMG] + (size_t)l * 4 * D * D;
        for (int idx = gtid; idx < N_MG * (D / 8); idx += gthreads) { const int n = idx % N_MG, kc = idx / N_MG, bi = n >> 10, c = n & 1023; float v[8];
#pragma unroll
            for (int i = 0; i < 8; ++i) v[i] = wmg[((size_t)bi * D + kc * 8 + i) * D + c];
            tr_store8(Wl + (size_t)(N_IN + n) * D + kc * 8, v); }
        const float* wbr = a.in[I_WBR] + (size_t)l * 4 * BW * D; bf16_t* Wb = (bf16_t*)((unsigned char*)Wl + WO_BR);
        for (int idx = gtid; idx < 4 * D * (BW / 8); idx += gthreads) { const int n = idx % (4 * D), kc = idx / (4 * D), bi = n >> 10, c = n & 1023; float v[8];
#pragma unroll
            for (int i = 0; i < 8; ++i) v[i] = wbr[((size_t)bi * BW + kc * 8 + i) * D + c];
            tr_store8(Wb + (size_t)n * BW + kc * 8, v); }
        const float* wout = a.in[I_WOUT] + (size_t)l * D * D; bf16_t* Wo = (bf16_t*)((unsigned char*)Wl + WO_OUT);
        for (int idx = gtid; idx < D * (D / 8); idx += gthreads) { const int n = idx % D, kc = idx / D; float v[8];
#pragma unroll
            for (int i = 0; i < 8; ++i) v[i] = wout[(size_t)(kc * 8 + i) * D + n];
            tr_store8(Wo + (size_t)n * D + kc * 8, v); }
        const float* wglu = a.in[I_SGW] + (size_t)l * BW * BW; bf16_t* Wg = (bf16_t*)((unsigned char*)Wl + WO_GLU);
        for (int idx = gtid; idx < BW * (BW / 8); idx += gthreads) { const int n = idx % BW, kc = idx / BW; float v[8];
#pragma unroll
            for (int i = 0; i < 8; ++i) v[i] = wglu[(size_t)(kc * 8 + i) * BW + n];
            tr_store8(Wg + (size_t)n * BW + kc * 8, v); }
        float* sm = (float*)(ws + WS_SMALL + (size_t)l * SMALL_STRIDE);
        for (int idx = gtid; idx < 2048; idx += gthreads) { const int g = idx >> 6;
            const double step = exp((double)a.in[I_SLDT][l * 32 + g]); const double are = a.in[I_SARE][l * 2048 + idx], aim = a.in[I_SAIM][l * 2048 + idx];
            const double mag = exp(step * are), abr = mag * cos(step * aim), abi = mag * sin(step * aim), den = are * are + aim * aim;
            const double fre = ((abr - 1.0) * are + abi * aim) / den, fim = (abi * are - (abr - 1.0) * aim) / den;
            sm[SM_ABR + idx] = (float)abr; sm[SM_ABI + idx] = (float)abi;
            { const double m128 = exp(512.0 * step * are); sm[SM_A128 + idx * 2] = (float)(m128 * cos(512.0 * step * aim)); sm[SM_A128 + idx * 2 + 1] = (float)(m128 * sin(512.0 * step * aim)); }
            bf16_t* bbt = (bf16_t*)((unsigned char*)sm + SM_BBT_BYTES); const int p_ = idx & 63;
            for (int i = 0; i < 16; ++i) { const double br = a.in[I_SBRE][(size_t)l * 32768 + idx * 16 + i], bi = a.in[I_SBIM][(size_t)l * 32768 + idx * 16 + i];
                const float vr = (float)(fre * br - fim * bi), vi = (float)(fre * bi + fim * br);
                sm[SM_BBR + idx * 16 + i] = vr; sm[SM_BBI + idx * 16 + i] = vi; bbt[(g * 128 + 2 * p_) * 16 + i] = f2bf(vr); bbt[(g * 128 + 2 * p_ + 1) * 16 + i] = f2bf(vi); } }
        for (int idx = gtid; idx < 512; idx += gthreads) { const float lam = a.in[I_LLAM][l * 512 + idx]; const float nl = -lam;
            sm[SM_SP8 + idx] = 8.0f * (fmaxf(nl, 0.f) + log1pf(expf(-fabsf(nl)))); }
        { bf16_t* ct = (bf16_t*)((unsigned char*)sm + SM_CT_BYTES);
          for (int idx = gtid; idx < 32 * 16 * 128; idx += gthreads) { const int k = idx & 127, gi = idx >> 7;
              const float v = (k & 1) == 0 ? a.in[I_SCRE][(size_t)l * 32768 + gi * 64 + (k >> 1)] : -a.in[I_SCIM][(size_t)l * 32768 + gi * 64 + (k >> 1)]; ct[idx] = f2bf(v); } }
        bf16_t* lw = (bf16_t*)((unsigned char*)sm + SM_LRUW_BYTES);
        for (int idx = gtid; idx < 8 * 128 * 64; idx += gthreads) { const int i = idx & 63, jj = (idx >> 6) & 127, n = idx >> 13;
            const float v = jj < 64 ? a.in[I_LWA][(((size_t)l * 8 + n) * 64 + i) * 64 + jj] : a.in[I_LWX][(((size_t)l * 8 + n) * 64 + i) * 64 + (jj - 64)];
            lw[idx] = f2bf(v); }
    }
    float* rot = (float*)(ws + WS_ROT);
    for (int idx = gtid; idx < SEQ * 32; idx += gthreads) { const int i = idx & 31, s = idx >> 5;
        const double inv = pow(10000.0, -(double)i / 32.0), ang = (double)s * inv; rot[idx * 2] = (float)cos(ang); rot[idx * 2 + 1] = (float)sin(ang); }
}

template <bool F32OUT, bool ADD>
__device__ __forceinline__ void phase_norm(const float* hin, const bf16_t* delta, float* hout, const float* gain, bf16_t* uout, int gw, int ngw, int lane) {
    f32x4 gv[4];
#pragma unroll
    for (int j = 0; j < 4; ++j) gv[j] = *(const f32x4*)(gain + 4 * lane + 256 * j);
    for (int row = gw; row < TG; row += ngw) {
        const f32x4* xr = (const f32x4*)(hin + (size_t)row * D) + lane; f32x4 v[4]; float s = 0.f;
#pragma unroll
        for (int j = 0; j < 4; ++j) v[j] = __builtin_nontemporal_load(xr + 64 * j);
        if (ADD) { const u32x2* dr = (const u32x2*)(delta + (size_t)row * D) + lane;
#pragma unroll
            for (int j = 0; j < 4; ++j) { const u32x2 dw = __builtin_nontemporal_load(dr + 64 * j); v[j].x += bflo(dw.x); v[j].y += bfhi(dw.x); v[j].z += bflo(dw.y); v[j].w += bfhi(dw.y); } }
#pragma unroll
        for (int j = 0; j < 4; ++j) s += (v[j].x * v[j].x + v[j].y * v[j].y) + (v[j].z * v[j].z + v[j].w * v[j].w);
        const float rstd = rsqrtf(wave_sum(s) * (1.f / D) + NORM_EPS);
        if (F32OUT) { f32x4* o = (f32x4*)(hout + (size_t)row * D) + lane;
#pragma unroll
            for (int j = 0; j < 4; ++j) o[64 * j] = v[j] * rstd * gv[j];
        } else {
            if (ADD) { f32x4* o = (f32x4*)(hout + (size_t)row * D) + lane;
#pragma unroll
                for (int j = 0; j < 4; ++j) o[64 * j] = v[j]; }
            u32x2* o = (u32x2*)(uout + (size_t)row * D) + lane;
#pragma unroll
            for (int j = 0; j < 4; ++j) { const f32x4 y = v[j] * rstd * gv[j]; u32x2 w; w.x = cvt_pk_bf16(y.x, y.y); w.y = cvt_pk_bf16(y.z, y.w); o[64 * j] = w; } }
    }
}

constexpr int NSEGG = 8;
constexpr int NSEGL = 32;
constexpr int NSEGS = 8;
constexpr size_t ST_GSEG = 0;
constexpr size_t ST_GDS = ST_GSEG + (size_t)2 * BG * 4 * NSEGG * 8192;
constexpr size_t ST_LRU = ST_GDS + (size_t)2 * BG * 4 * NSEGG * 64;
constexpr size_t ST_S5 = ST_LRU + (size_t)BG * NSEGL * 512 * 2;
constexpr size_t ST_END_F = ST_S5 + (size_t)BG * NSEGS * 32 * 128;
static_assert(ST_END_F * 4 <= 64 * MiB, "state scratch");
typedef short s16x4 __attribute__((ext_vector_type(4)));

__device__ __forceinline__ bf16x8 lds_tr_frag(LAS const unsigned char* base, int row_stride_bytes, int lane) {
    const int g = lane >> 4, idx = lane & 15, q = idx >> 2, p = idx & 3;
    LAS const unsigned char* a0 = base + (8 * g + q) * row_stride_bytes + 8 * p;
    const s16x4 r0 = __builtin_amdgcn_ds_read_tr16_b64_v4i16((LAS s16x4*)a0);
    const s16x4 r1 = __builtin_amdgcn_ds_read_tr16_b64_v4i16((LAS s16x4*)(a0 + 4 * row_stride_bytes));
    bf16x8 f; f[0] = r0[0]; f[1] = r0[1]; f[2] = r0[2]; f[3] = r0[3]; f[4] = r1[0]; f[5] = r1[1]; f[6] = r1[2]; f[7] = r1[3]; return f;
}
#define WGSYNC() do { asm volatile("s_waitcnt lgkmcnt(0)" ::: "memory"); __builtin_amdgcn_s_barrier(); asm volatile("" ::: "memory"); } while (0)

constexpr int GL_QD = 0, GL_KD = 9216, GL_KT = 18432, GL_V = 27648, GL_ST = 45056, GL_LAST = 63488, GL_RED = 63744, GL_RED2 = 64256;
struct GlaP { const bf16_t* P; const float* LA; const float* gain; const float* bias; bf16_t* O; float* SSEG; float* DSUM; };
__device__ __forceinline__ bf16x8 lds_tr_frag2(LAS const unsigned char* base, int row_stride_bytes, int lane, int mulg, int second_off) {
    const int g = lane >> 4, idx = lane & 15, q = idx >> 2, p = idx & 3;
    LAS const unsigned char* a0 = base + (mulg * g + q) * row_stride_bytes + 8 * p;
    const s16x4 r0 = __builtin_amdgcn_ds_read_tr16_b64_v4i16((LAS s16x4*)a0);
    const s16x4 r1 = __builtin_amdgcn_ds_read_tr16_b64_v4i16((LAS s16x4*)(a0 + second_off * row_stride_bytes));
    bf16x8 f; f[0] = r0[0]; f[1] = r0[1]; f[2] = r0[2]; f[3] = r0[3]; f[4] = r1[0]; f[5] = r1[1]; f[6] = r1[2]; f[7] = r1[3]; return f;
}
__device__ __forceinline__ bf16x8 pack8(const f32x4 a, const f32x4 b) { u32x4 w; w.x = cvt_pk_bf16(a[0], a[1]); w.y = cvt_pk_bf16(a[2], a[3]); w.z = cvt_pk_bf16(b[0], b[1]); w.w = cvt_pk_bf16(b[2], b[3]); return __builtin_bit_cast(bf16x8, w); }

template <bool PASSC>
__device__ __forceinline__ void glaret_item(LAS unsigned char* lds, const GlaP& gp, const bool gla, const int b, const int h, const int seg, const int sidx  ) {
    int tid = threadIdx.x; asm volatile("" : "+v"(tid));
    const int w = __builtin_amdgcn_readfirstlane(tid >> 6), l = tid & 63, fr = l & 15, fq = l >> 4;
    const int qoff = gla ? P_GQ : P_RQ, koff = gla ? P_GK : P_RK, voff = gla ? P_GV : P_RV, goff = gla ? P_GG : P_RG, ooff = gla ? 0 : 512;
    const float lg = __logf(1.f - exp2f(-5.f - (float)h));
    f32x4 accs[4];
#pragma unroll
    for (int dt = 0; dt < 4; ++dt) accs[dt] = (f32x4){0.f, 0.f, 0.f, 0.f};
    float dsum[8];
#pragma unroll
    for (int e = 0; e < 8; ++e) dsum[e] = 0.f;
    if (PASSC) {
        for (int sp = 0; sp < seg; ++sp) {
            const float* sg = gp.SSEG + (size_t)(sidx + sp) * 8192 + tid * 16; const float* dsm = gp.DSUM + (size_t)(sidx + sp) * 64;
#pragma unroll
            for (int dt = 0; dt < 4; ++dt) { const f32x4 dv = *(const f32x4*)(dsm + 16 * dt + 4 * fq), sv = *(const f32x4*)(sg + 4 * dt);
#pragma unroll
                for (int r = 0; r < 4; ++r) accs[dt][r] = accs[dt][r] * __expf(dv[r]) + sv[r]; }
        }
#pragma unroll
        for (int dt = 0; dt < 4; ++dt) { u32x2 wv; wv.x = cvt_pk_bf16(accs[dt][0], accs[dt][1]); wv.y = cvt_pk_bf16(accs[dt][2], accs[dt][3]);
            *(LAS u32x2*)(lds + GL_ST + (16 * w + fr) * 144 + 32 * dt + 8 * fq) = wv; }
    }
    const int it = w & 3, ch = w >> 2;
    f32x4 gnv[4], bsv[4];
#pragma unroll
    for (int ct = 0; ct < 4; ++ct) { const int c = 128 * h + 64 * ch + 16 * ct + 4 * fq; gnv[ct] = PASSC ? *(const f32x4*)(gp.gain + c) : (f32x4){0.f, 0.f, 0.f, 0.f};
        bsv[ct] = (PASSC && !gla) ? *(const f32x4*)(gp.bias + c) : (f32x4){0.f, 0.f, 0.f, 0.f}; }
    u32x4 rq = (u32x4){0u, 0u, 0u, 0u}, rk, rv[2]; f32x4 rla[2], rll[2]; u32x2 gnx[4];
    const float rq_s = __expf((float)(l + 1) * lg), rk_s = __expf(-(float)(l + 1) * lg), rt_s = __expf((float)(63 - l) * lg);
#define GL_ISSUE(n_) do { const size_t r0_ = (size_t)b * SEQ + seg * 512 + (n_) * 64; \
        { const bf16_t* pr_ = gp.P + (r0_ + l) * PLD + 64 * h + 8 * w; if (PASSC) rq = *(const u32x4*)(pr_ + qoff); rk = *(const u32x4*)(pr_ + koff); \
          if (gla) { const float* lp_ = gp.LA + (r0_ + l) * 256 + 64 * h + 8 * w; rla[0] = *(const f32x4*)lp_; rla[1] = *(const f32x4*)(lp_ + 4); const float* ll_ = gp.LA + (r0_ + 63) * 256 + 64 * h + 8 * w; rll[0] = *(const f32x4*)ll_; rll[1] = *(const f32x4*)(ll_ + 4); } \
          else { rla[0] = (f32x4){0.f, 0.f, 0.f, 0.f}; rla[1] = rla[0]; rll[0] = rla[0]; rll[1] = rla[0]; } } \
        _Pragma("unroll") for (int e_ = 0; e_ < 2; ++e_) { const int p_ = tid + 512 * e_, i_ = p_ >> 4, part_ = p_ & 15; \
            rv[e_] = *(const u32x4*)(gp.P + (r0_ + i_) * PLD + voff + 128 * h + 8 * part_); } \
        if (PASSC) { _Pragma("unroll") for (int ct_ = 0; ct_ < 4; ++ct_) gnx[ct_] = *(const u32x2*)(gp.P + (r0_ + 16 * it + fr) * PLD + goff + 128 * h + 64 * ch + 16 * ct_ + 4 * fq); } } while (0)
    GL_ISSUE(0);
    for (int n = 0; n < 8; ++n) {
        const size_t row0 = (size_t)b * SEQ + seg * 512 + n * 64;
#pragma unroll
        for (int e = 0; e < 2; ++e) { const int p = tid + 512 * e, i = p >> 4, part = p & 15; *(LAS u32x4*)(lds + GL_V + i * 272 + part * 16) = rv[e]; }
        { float cum[8], lastv[8];
          const float kk[8] = {bflo(rk.x), bfhi(rk.x), bflo(rk.y), bfhi(rk.y), bflo(rk.z), bfhi(rk.z), bflo(rk.w), bfhi(rk.w)};
          float eq[8], ek[8], et[8];
          if (gla) {
#pragma unroll
              for (int e = 0; e < 8; ++e) { cum[e] = e < 4 ? rla[0][e] : rla[1][e - 4]; lastv[e] = e < 4 ? rll[0][e] : rll[1][e - 4];
                  eq[e] = __expf(cum[e]); ek[e] = __builtin_amdgcn_rcpf(eq[e]); et[e] = __expf(lastv[e]) * ek[e]; }
          } else {
#pragma unroll
              for (int e = 0; e < 8; ++e) { lastv[e] = 64.f * lg; eq[e] = rq_s; ek[e] = rk_s; et[e] = rt_s; } }
#pragma unroll
          for (int e = 0; e < 8; ++e) *(LAS bf16_t*)(lds + GL_KT + (8 * w + e) * 144 + l * 2) = f2bf(kk[e] * et[e]);
          if (PASSC) { const float qq[8] = {bflo(rq.x), bfhi(rq.x), bflo(rq.y), bfhi(rq.y), bflo(rq.z), bfhi(rq.z), bflo(rq.w), bfhi(rq.w)};
              u32x4 qw, kw;
              qw.x = cvt_pk_bf16(qq[0] * eq[0], qq[1] * eq[1]); qw.y = cvt_pk_bf16(qq[2] * eq[2], qq[3] * eq[3]); qw.z = cvt_pk_bf16(qq[4] * eq[4], qq[5] * eq[5]); qw.w = cvt_pk_bf16(qq[6] * eq[6], qq[7] * eq[7]);
              kw.x = cvt_pk_bf16(kk[0] * ek[0], kk[1] * ek[1]); kw.y = cvt_pk_bf16(kk[2] * ek[2], kk[3] * ek[3]); kw.z = cvt_pk_bf16(kk[4] * ek[4], kk[5] * ek[5]); kw.w = cvt_pk_bf16(kk[6] * ek[6], kk[7] * ek[7]);
              *(LAS u32x4*)(lds + GL_QD + l * 144 + 16 * w) = qw; *(LAS u32x4*)(lds + GL_KD + l * 144 + 16 * w) = kw; }
          if (l == 63) {
#pragma unroll
              for (int e = 0; e < 8; ++e) *(LAS float*)(lds + GL_LAST + (8 * w + e) * 4) = lastv[e]; }
#pragma unroll
          for (int e = 0; e < 8; ++e) dsum[e] += lastv[e]; }
        u32x2 gates[4];
        if (PASSC) {
#pragma unroll
            for (int ct = 0; ct < 4; ++ct) gates[ct] = gnx[ct]; }
        if (n < 7) GL_ISSUE(n + 1);
        WGSYNC();
        f32x4 acco[4];
        if (PASSC) {
            bf16x8 qf[2];
#pragma unroll
            for (int ks = 0; ks < 2; ++ks) qf[ks] = *(LAS const bf16x8*)(lds + GL_QD + (16 * it + fr) * 144 + 16 * fq + 64 * ks);
            f32x4 sc[4];
#pragma unroll
            for (int jt = 0; jt < 4; ++jt) { sc[jt] = (f32x4){0.f, 0.f, 0.f, 0.f};
                if (jt <= it) {
#pragma unroll
                    for (int ks = 0; ks < 2; ++ks) { const bf16x8 kf = *(LAS const bf16x8*)(lds + GL_KD + (16 * jt + fr) * 144 + 16 * fq + 64 * ks);
                        sc[jt] = __builtin_amdgcn_mfma_f32_16x16x32_bf16(kf, qf[ks], sc[jt], 0, 0, 0); }
                    if (jt == it) {
#pragma unroll
                        for (int r = 0; r < 4; ++r) sc[jt][r] = (4 * fq + r <= fr) ? sc[jt][r] : 0.f; } } }
            const bf16x8 pf0 = pack8(sc[0], sc[1]), pf1 = pack8(sc[2], sc[3]);
#pragma unroll
            for (int ct = 0; ct < 4; ++ct) { const int c0 = 64 * ch + 16 * ct; acco[ct] = (f32x4){0.f, 0.f, 0.f, 0.f};
                { const bf16x8 vf = lds_tr_frag2(lds + GL_V + c0 * 2, 272, l, 4, 16); acco[ct] = __builtin_amdgcn_mfma_f32_16x16x32_bf16(vf, pf0, acco[ct], 0, 0, 0); }
                if (it >= 2) { const bf16x8 vf = lds_tr_frag2(lds + GL_V + 32 * 272 + c0 * 2, 272, l, 4, 16); acco[ct] = __builtin_amdgcn_mfma_f32_16x16x32_bf16(vf, pf1, acco[ct], 0, 0, 0); }
#pragma unroll
                for (int ks = 0; ks < 2; ++ks) { const bf16x8 sf = *(LAS const bf16x8*)(lds + GL_ST + (c0 + fr) * 144 + 16 * fq + 64 * ks);
                    acco[ct] = __builtin_amdgcn_mfma_f32_16x16x32_bf16(sf, qf[ks], acco[ct], 0, 0, 0); } }
        }
#pragma unroll
        for (int dt = 0; dt < 4; ++dt) { const f32x4 lv = *(LAS const f32x4*)(lds + GL_LAST + (16 * dt + 4 * fq) * 4);
#pragma unroll
            for (int r = 0; r < 4; ++r) accs[dt][r] *= __expf(lv[r]); }
#pragma unroll
        for (int ks = 0; ks < 2; ++ks) { const bf16x8 vf = lds_tr_frag2(lds + GL_V + (32 * ks) * 272 + (16 * w) * 2, 272, l, 8, 4);
#pragma unroll
            for (int dt = 0; dt < 4; ++dt) { const bf16x8 kf = *(LAS const bf16x8*)(lds + GL_KT + (16 * dt + fr) * 144 + 16 * fq + 64 * ks);
                accs[dt] = __builtin_amdgcn_mfma_f32_16x16x32_bf16(kf, vf, accs[dt], 0, 0, 0); } }
        if (PASSC) {
            float ss = 0.f, sm_ = 0.f;
#pragma unroll
            for (int ct = 0; ct < 4; ++ct)
#pragma unroll
                for (int r = 0; r < 4; ++r) { ss += acco[ct][r] * acco[ct][r]; sm_ += acco[ct][r]; }
            ss += __shfl_xor(ss, 16); ss += __shfl_xor(ss, 32); sm_ += __shfl_xor(sm_, 16); sm_ += __shfl_xor(sm_, 32);
            if (fq == 0) { *(LAS float*)(lds + GL_RED + ((16 * it + fr) * 2 + ch) * 4) = ss; *(LAS float*)(lds + GL_RED2 + ((16 * it + fr) * 2 + ch) * 4) = sm_; }
        }
        WGSYNC();
        if (PASSC) {
            const int i = 16 * it + fr;
            const float ssum = *(LAS const float*)(lds + GL_RED + (i * 2) * 4) + *(LAS const float*)(lds + GL_RED + (i * 2 + 1) * 4);
            const float msum = *(LAS const float*)(lds + GL_RED2 + (i * 2) * 4) + *(LAS const float*)(lds + GL_RED2 + (i * 2 + 1) * 4);
            float mean, rstd;
            if (gla) { mean = 0.f; rstd = rsqrtf(ssum * (1.f / 128.f) + NORM_EPS); }
            else { mean = msum * (1.f / 128.f); const float var = fmaxf(ssum * (1.f / 128.f) - mean * mean, 0.f); rstd = rsqrtf(var + NORM_EPS); }
#pragma unroll
            for (int ct = 0; ct < 4; ++ct) { const int c = 128 * h + 64 * ch + 16 * ct + 4 * fq; const f32x4 gn = gnv[ct], bs = bsv[ct];
                const float g0 = bflo(gates[ct].x), g1 = bfhi(gates[ct].x), g2 = bflo(gates[ct].y), g3 = bfhi(gates[ct].y);
                u32x2 ow; ow.x = cvt_pk_bf16(((acco[ct][0] - mean) * rstd * gn[0] + bs[0]) * g0, ((acco[ct][1] - mean) * rstd * gn[1] + bs[1]) * g1);
                ow.y = cvt_pk_bf16(((acco[ct][2] - mean) * rstd * gn[2] + bs[2]) * g2, ((acco[ct][3] - mean) * rstd * gn[3] + bs[3]) * g3);
                *(u32x2*)(gp.O + (row0 + i) * OLD + ooff + c) = ow; }
#pragma unroll
            for (int dt = 0; dt < 4; ++dt) { u32x2 wv; wv.x = cvt_pk_bf16(accs[dt][0], accs[dt][1]); wv.y = cvt_pk_bf16(accs[dt][2], accs[dt][3]);
                *(LAS u32x2*)(lds + GL_ST + (16 * w + fr) * 144 + 32 * dt + 8 * fq) = wv; }
        }
    }
#undef GL_ISSUE
    if (!PASSC) {
        float* sg = gp.SSEG + (size_t)(sidx + seg) * 8192 + tid * 16;
#pragma unroll
        for (int dt = 0; dt < 4; ++dt) *(f32x4*)(sg + 4 * dt) = accs[dt];
        if (l == 0) {
#pragma unroll
            for (int e = 0; e < 8; ++e) gp.DSUM[(size_t)(sidx + seg) * 64 + 8 * w + e] = dsum[e]; }
    }
    WGSYNC();
}

constexpr int LR_XC = 0, LR_XCF = 2304, LR_AA = 6400, LR_GG = 10496, LR_WAVE = 14592;
struct LruP { const bf16_t* P; const float* cw; const float* cb; const float* ba; const float* bx; const float* sp8; const bf16_t* lw; bf16_t* O; float* LST; };
template <bool PASSC>
__device__ __forceinline__ void lru_wave(LAS unsigned char* lw_, const LruP& lp, const int b, const int seg, const int n, const int l) {
    const int fr = l & 15, fq = l >> 4, ch = 64 * n + l;
    bf16x8 wB[8][2];
#pragma unroll
    for (int jt = 0; jt < 8; ++jt)
#pragma unroll
        for (int ks = 0; ks < 2; ++ks) wB[jt][ks] = *(const bf16x8*)(lp.lw + ((size_t)(n * 128 + 16 * jt + fr)) * 64 + 8 * fq + 32 * ks);
    const float w0 = lp.cw[ch], w1 = lp.cw[512 + ch], w2 = lp.cw[1024 + ch], w3 = lp.cw[1536 + ch], cbv = lp.cb[ch];
    float bav[4], bxv[4], spv[4];
#pragma unroll
    for (int jt = 0; jt < 4; ++jt) { const int c2 = 64 * n + 16 * jt + fr; bav[jt] = lp.ba[c2]; bxv[jt] = lp.bx[c2]; spv[jt] = lp.sp8[c2]; }
    const size_t rowb = (size_t)b * SEQ + seg * 128;
    float xm3 = 0.f, xm2 = 0.f, xm1 = 0.f;
    if (seg > 0) { xm3 = bf2f(lp.P[(rowb - 3) * PLD + P_LX + ch]); xm2 = bf2f(lp.P[(rowb - 2) * PLD + P_LX + ch]); xm1 = bf2f(lp.P[(rowb - 1) * PLD + P_LX + ch]); }
    float hst = 0.f, ap = 1.f;
    if (PASSC) { const float* st = lp.LST + ((size_t)b * NSEGL * 512 + ch) * 2;
        pg8::f32x2_ ah[31];
#pragma unroll
        for (int e = 0; e < 31; ++e) { const int sp = e < seg ? e : 0; ah[e] = *(const pg8::f32x2_*)(st + (size_t)sp * 1024); }
#pragma unroll
        for (int e = 0; e < 31; ++e) if (e < seg) hst = ah[e][0] * hst + ah[e][1]; }
    bf16_t xn[16], gn[16];
#pragma unroll
    for (int t = 0; t < 16; ++t) { xn[t] = lp.P[(rowb + t) * PLD + P_LX + ch]; gn[t] = PASSC ? lp.P[(rowb + t) * PLD + P_LG + ch] : (bf16_t)0; }
    for (int sb = 0; sb < 8; ++sb) {
        const size_t r0 = rowb + sb * 16;
        float xf[16], gr[16];
#pragma unroll
        for (int t = 0; t < 16; ++t) { xf[t] = bf2f(xn[t]); gr[t] = bf2f(gn[t]); }
        if (sb < 7) {
#pragma unroll
            for (int t = 0; t < 16; ++t) { xn[t] = lp.P[(r0 + 16 + t) * PLD + P_LX + ch]; if (PASSC) gn[t] = lp.P[(r0 + 16 + t) * PLD + P_LG + ch]; } }
#pragma unroll
        for (int t = 0; t < 16; ++t) { const float x0 = xf[t]; const float xc = cbv + w0 * xm3 + w1 * xm2 + w2 * xm1 + w3 * x0; xm3 = xm2; xm2 = xm1; xm1 = x0;
            *(LAS bf16_t*)(lw_ + LR_XC + t * 144 + l * 2) = f2bf(xc); *(LAS float*)(lw_ + LR_XCF + t * 256 + l * 4) = xc; }
        __builtin_amdgcn_wave_barrier();
        f32x4 acc[8];
#pragma unroll
        for (int jt = 0; jt < 8; ++jt) acc[jt] = (f32x4){0.f, 0.f, 0.f, 0.f};
#pragma unroll
        for (int ks = 0; ks < 2; ++ks) { const bf16x8 af = *(LAS const bf16x8*)(lw_ + LR_XC + fr * 144 + 16 * fq + 64 * ks);
#pragma unroll
            for (int jt = 0; jt < 8; ++jt) acc[jt] = __builtin_amdgcn_mfma_f32_16x16x32_bf16(af, wB[jt][ks], acc[jt], 0, 0, 0); }
#pragma unroll
        for (int jt = 0; jt < 4; ++jt)
#pragma unroll
            for (int r = 0; r < 4; ++r) { const int tok = 4 * fq + r, j = 16 * jt + fr;
                const float rg = sigmoid_f(acc[jt][r] + bav[jt]), ig = sigmoid_f(acc[4 + jt][r] + bxv[jt]);
                const float log_a = -rg * spv[jt]; const float av = __expf(log_a);
                const float xcv = *(LAS const float*)(lw_ + LR_XCF + tok * 256 + j * 4);
                *(LAS float*)(lw_ + LR_AA + tok * 256 + j * 4) = av; const float em = fmaf(-av, av, 1.f);
                *(LAS float*)(lw_ + LR_GG + tok * 256 + j * 4) = xcv * ig * sqrtf(fmaxf(em, 0.f)); }
        __builtin_amdgcn_wave_barrier();
#pragma unroll
        for (int t = 0; t < 16; ++t) { const float av = *(LAS const float*)(lw_ + LR_AA + t * 256 + l * 4), gv = *(LAS const float*)(lw_ + LR_GG + t * 256 + l * 4);
            hst = av * hst + gv; ap *= av;
            if (PASSC) lp.O[(r0 + t) * OLD + 1024 + ch] = f2bf(hst * gr[t]); }
        __builtin_amdgcn_wave_barrier();
    }
    if (!PASSC) { float* st = lp.LST + (((size_t)b * NSEGL + seg) * 512 + ch) * 2; st[0] = ap; st[1] = hst; }
}

constexpr int S5_BU = 0, S5_X = 8448, S5_WAVE = 8448 + 4352;
struct S5P { const bf16_t* P; const float* sm; const bf16_t* ct; const bf16_t* bbt; const float* a128; const float* dd; bf16_t* Y5; float* SST; };
template <bool PASSC>
__device__ __forceinline__ void s5_wave(LAS unsigned char* lw_, const S5P& sp_, const int b, const int seg, const int g, const int l) {
    const int fr = l & 15, fq = l >> 4;
    const bf16x8 zf = (bf16x8){0, 0, 0, 0, 0, 0, 0, 0};
    bf16x8 bbf[8];
#pragma unroll
    for (int mt = 0; mt < 8; ++mt) bbf[mt] = fq < 2 ? *(const bf16x8*)(sp_.bbt + ((size_t)(g * 128 + 16 * mt + fr)) * 16 + 8 * fq) : zf;
    const float abr = sp_.sm[SM_ABR + g * 64 + l], abi = sp_.sm[SM_ABI + g * 64 + l];
    float xr = 0.f, xi = 0.f;
    bf16x8 cf[4]; f32x4 dv4 = (f32x4){0.f, 0.f, 0.f, 0.f};
    if (PASSC) {
        const float ar = sp_.a128[(g * 64 + l) * 2], ai = sp_.a128[(g * 64 + l) * 2 + 1];
        const float* st = sp_.SST + ((size_t)b * NSEGS * 32 + g) * 128 + l;
        for (int sp0 = 0; sp0 < seg; sp0 += 8) { float er[8], ei[8];
#pragma unroll
            for (int e = 0; e < 8; ++e) { const int sp = sp0 + e < seg ? sp0 + e : seg - 1; er[e] = st[(size_t)sp * 4096]; ei[e] = st[(size_t)sp * 4096 + 64]; }
#pragma unroll
            for (int e = 0; e < 8; ++e) if (sp0 + e < seg) { const float nr = ar * xr - ai * xi + er[e], ni = ar * xi + ai * xr + ei[e]; xr = nr; xi = ni; } }
#pragma unroll
        for (int ks = 0; ks < 4; ++ks) cf[ks] = *(const bf16x8*)(sp_.ct + ((size_t)(g * 16 + fr)) * 128 + 8 * fq + 32 * ks);
        dv4 = *(const f32x4*)(sp_.dd + 16 * g + 4 * fq);
    }
    const size_t rowb = (size_t)b * SEQ + seg * 512;
    bf16x8 ufn = fq < 2 ? *(const bf16x8*)(sp_.P + (rowb + fr) * PLD + P_SU + 16 * g + 8 * fq) : zf;
    u32x2 usn = PASSC ? *(const u32x2*)(sp_.P + (rowb + fr) * PLD + P_SU + 16 * g + 4 * fq) : (u32x2){0u, 0u};
    for (int sb = 0; sb < 32; ++sb) {
        const size_t r0 = rowb + sb * 16;
        const bf16x8 uf = ufn; const u32x2 us = usn;
        if (sb < 31) { ufn = fq < 2 ? *(const bf16x8*)(sp_.P + (r0 + 16 + fr) * PLD + P_SU + 16 * g + 8 * fq) : zf;
            if (PASSC) usn = *(const u32x2*)(sp_.P + (r0 + 16 + fr) * PLD + P_SU + 16 * g + 4 * fq); }
#pragma unroll
        for (int mt = 0; mt < 8; ++mt) { f32x4 bu = (f32x4){0.f, 0.f, 0.f, 0.f}; bu = __builtin_amdgcn_mfma_f32_16x16x32_bf16(bbf[mt], uf, bu, 0, 0, 0);
            *(LAS f32x4*)(lw_ + S5_BU + fr * 528 + (16 * mt + 4 * fq) * 4) = bu; }
        __builtin_amdgcn_wave_barrier();
        pg8::f32x2_ buv[16];
#pragma unroll
        for (int t = 0; t < 16; ++t) buv[t] = *(LAS const pg8::f32x2_*)(lw_ + S5_BU + t * 528 + l * 8);
#pragma unroll
        for (int t = 0; t < 16; ++t) {
            const pg8::f32x2_ bu = buv[t];
            const float nr = abr * xr - abi * xi + bu[0], ni = abr * xi + abi * xr + bu[1]; xr = nr; xi = ni;
            if (PASSC) *(LAS unsigned*)(lw_ + S5_X + t * 272 + l * 4) = cvt_pk_bf16(xr, xi);
        }
        __builtin_amdgcn_wave_barrier();
        if (PASSC) {
            f32x4 acc = (f32x4){0.f, 0.f, 0.f, 0.f};
#pragma unroll
            for (int ks = 0; ks < 4; ++ks) { const bf16x8 xf = *(LAS const bf16x8*)(lw_ + S5_X + fr * 272 + 16 * fq + 64 * ks);
                acc = __builtin_amdgcn_mfma_f32_16x16x32_bf16(cf[ks], xf, acc, 0, 0, 0); }
            u32x2 yw; yw.x = cvt_pk_bf16(gelu_tanh_f(acc[0] + dv4[0] * bflo(us.x)), gelu_tanh_f(acc[1] + dv4[1] * bfhi(us.x))); yw.y = cvt_pk_bf16(gelu_tanh_f(acc[2] + dv4[2] * bflo(us.y)), gelu_tanh_f(acc[3] + dv4[3] * bfhi(us.y)));
            *(u32x2*)(sp_.Y5 + (r0 + fr) * BW + 16 * g + 4 * fq) = yw;
            __builtin_amdgcn_wave_barrier();
        }
    }
    if (!PASSC) { float* st = sp_.SST + (((size_t)b * NSEGS + seg) * 32 + g) * 128 + l; st[0] = xr; st[64] = xi; }
}

template <bool PASSC>
__device__ __forceinline__ void phase_mixers(LAS unsigned char* lds, const Args& a, const int l, const int G) {
    const int mmask = a.mmask;
    unsigned char* ws = a.ws; const float* sm = (const float*)(ws + WS_SMALL + (size_t)l * SMALL_STRIDE);
    const bf16_t* P = (const bf16_t*)(ws + WS_P); float* ST = (float*)(ws + WS_ST);
#if OPT_GLARET
    if (mmask & 1) { GlaP gp0{P, (const float*)(ws + WS_LA), a.in[I_GNG] + l * 512, nullptr, (bf16_t*)(ws + WS_O), ST + ST_GSEG, ST + ST_GDS};
      GlaP gp1{P, (const float*)(ws + WS_LA), a.in[I_RNG] + l * 512, a.in[I_RNB] + l * 512, (bf16_t*)(ws + WS_O), ST + ST_GSEG, ST + ST_GDS};
      for (int itx = blockIdx.x; itx < 2 * BG * 4 * NSEGG; itx += G) { const int mix = itx / (BG * 4 * NSEGG), rest = itx % (BG * 4 * NSEGG), b = rest / (4 * NSEGG), h = (rest / NSEGG) & 3, seg = rest % NSEGG;
          const int sidx = ((mix * BG + b) * 4 + h) * NSEGG;
          if (!PASSC && seg == NSEGG - 1) continue;
          if (mix == 0) glaret_item<PASSC>(lds, gp0, true, b, h, seg, sidx); else glaret_item<PASSC>(lds, gp1, false, b, h, seg, sidx); } }
#endif
    int tid = threadIdx.x; asm volatile("" : "+v"(tid));
    const int w = __builtin_amdgcn_readfirstlane(tid >> 6), ln = tid & 63;
#if OPT_LRU
    if (mmask & 2) { LruP lp{P, a.in[I_LCW] + l * 2048, a.in[I_LCB] + l * 512, a.in[I_LBA] + l * 512, a.in[I_LBX] + l * 512, sm + SM_SP8, (const bf16_t*)((const unsigned char*)sm + SM_LRUW_BYTES), (bf16_t*)(ws + WS_O), ST + ST_LRU};
      for (int itx = blockIdx.x; itx < BG * NSEGL; itx += G) { if (!PASSC && itx % NSEGL == NSEGL - 1) continue; lru_wave<PASSC>(lds + w * LR_WAVE, lp, itx / NSEGL, itx % NSEGL, w, ln); } }
#endif
#if OPT_S5
    if (mmask & 4) { S5P sp_{P, sm, (const bf16_t*)((const unsigned char*)sm + SM_CT_BYTES), (const bf16_t*)((const unsigned char*)sm + SM_BBT_BYTES), sm + SM_A128, a.in[I_SD] + l * 512, (bf16_t*)(ws + WS_Y5), ST + ST_S5};
      for (int itx = blockIdx.x; itx < BG * NSEGS * 4; itx += G) { if (!PASSC && (itx >> 2) % NSEGS == NSEGS - 1) continue; s5_wave<PASSC>(lds + w * LR_WAVE, sp_, itx / (NSEGS * 4), (itx >> 2) % NSEGS, 8 * (itx & 3) + w, ln); } }
#endif
    WGSYNC();
}

constexpr int NPH = 8, NSTEPS = 1 + NGRP * DEPTH * NPH;
constexpr int LDS_BYTES = 147456, LDS_MISC = 131072 + 320;

__global__ void __launch_bounds__(512, 2) mk_fwd(Args a) {
    __shared__ __attribute__((aligned(16))) unsigned char lds_raw[LDS_BYTES];
    LAS unsigned char* lds = (LAS unsigned char*)lds_raw;
    volatile LAS unsigned* MISC = (volatile LAS unsigned*)(lds + LDS_MISC);
    const int G = gridDim.x;
    if (threadIdx.x < 32) MISC[threadIdx.x] = 0u;
    __syncthreads();
    unsigned* ctl = (unsigned*)(a.ws + WS_CTL);
    XcdBarrier bar = xcd_barrier_post(ctl + CW_BAR + a.li * XCD_BAR_WORDS, MISC + 8);
    const int ngw = G * 8, gthreads = G * 512;
#define LTID(v) int v = threadIdx.x; asm volatile("" : "+v"(v))
#define IN(s) (a.s_lo <= (s) && (s) < a.s_hi)
#define SEAM(s) do { if ((s) + 1 < a.s_hi) xcd_barrier(bar); } while (0)
    if (PHON(8) && IN(0)) { LTID(t_); phase_prologue(a, blockIdx.x * 512 + t_, gthreads); SEAM(0); }
    for (int gl = 0; gl < NGRP * DEPTH; ++gl) {
        const int grp = gl >> 2, l = gl & 3, s0 = 1 + gl * NPH;
        if (a.s_hi <= s0 || a.s_lo >= s0 + NPH) continue;
        unsigned char* ws = a.ws;
        const bf16_t* Wl = (const bf16_t*)(ws + WS_W + (size_t)l * W_STRIDE);
        const float* sm = (const float*)(ws + WS_SMALL + (size_t)l * SMALL_STRIDE);
        bf16_t* U = (bf16_t*)(ws + WS_U); bf16_t* P = (bf16_t*)(ws + WS_P); float* LA = (float*)(ws + WS_LA);
        bf16_t* O = (bf16_t*)(ws + WS_O); bf16_t* Y5 = (bf16_t*)(ws + WS_Y5); bf16_t* PGb = (bf16_t*)(ws + WS_PG);
        const float* xg = a.in[I_X] + (size_t)grp * TG * D; float* og = a.out + (size_t)grp * TG * D;
        const float* hin = (l <= 1) ? xg : og;
        bf16_t* DLT = (bf16_t*)(ws + WS_O);
        (void)sm;
        if (PHON(0) && IN(s0 + 0)) { LTID(t_); const int gw_ = blockIdx.x * 8 + __builtin_amdgcn_readfirstlane(t_ >> 6);
            if (l == 0) phase_norm<false, false>(hin, DLT, og, a.in[I_NG] + l * D, U, gw_, ngw, t_ & 63); else phase_norm<false, true>(hin, DLT, og, a.in[I_NG] + l * D, U, gw_, ngw, t_ & 63);
            SEAM(s0 + 0); }
        if (PHON(1) && IN(s0 + 1)) {
            pg8::Gemm g{U, Wl, TG, N_ALL, D, D, D, 0, 0}; pg8::StaticOrder S; S.init(TG, N_ALL, G, (int)blockIdx.x);
            EpiIn E{P, LA, a.in[I_GBLR] + l * 256, (const float*)(ws + WS_ROT), PGb};
            GEMM_CALL(EpiIn);
            SEAM(s0 + 1);
        }
#if REP_MIX == 2
        if (IN(s0 + 2)) { phase_mixers<false>(lds, a, l, G); xcd_barrier(bar); phase_mixers<false>(lds, a, l, G); SEAM(s0 + 2); }
        if (IN(s0 + 3)) { phase_mixers<true>(lds, a, l, G); xcd_barrier(bar); phase_mixers<true>(lds, a, l, G); SEAM(s0 + 3); }
#else
        if (PHON(2) && IN(s0 + 2)) { phase_mixers<false>(lds, a, l, G); SEAM(s0 + 2); }
        if (PHON(3) && IN(s0 + 3)) { phase_mixers<true>(lds, a, l, G); SEAM(s0 + 3); }
#endif
#if TRIVIAL_MIX
        if (IN(s0 + 2)) { LTID(t_);
            for (int row = blockIdx.x; row < TG; row += G) { const int c = t_; const bf16_t* p = P + (size_t)row * PLD;
                const float la = __expf(LA[(size_t)row * 256 + (c & 255)]);
                O[(size_t)row * OLD + c] = f2bf(bf2f(p[P_GV + c]) * bf2f(p[P_GG + c]) * (bf2f(p[P_GQ + (c & 255)]) + bf2f(p[P_GK + (c & 255)])) * la);
                O[(size_t)row * OLD + 512 + c] = f2bf(bf2f(p[P_RV + c]) * bf2f(p[P_RG + c]) * (bf2f(p[P_RQ + (c & 255)]) + bf2f(p[P_RK + (c & 255)])));
                O[(size_t)row * OLD + 1024 + c] = f2bf(bf2f(p[P_LX + c]) * bf2f(p[P_LG + c]));
                Y5[(size_t)row * BW + c] = p[P_SU + c]; }
            SEAM(s0 + 2); }
#endif
        if (PHON(4) && IN(s0 + 4)) {
            { pg8::Gemm g{Y5, (const bf16_t*)((const unsigned char*)Wl + WO_GLU), TG, BW, BW, BW, BW, 0, 0}; pg8::StaticOrder S; S.init(TG, BW, G, (int)blockIdx.x);
              EpiGlu E{Y5, P, a.in[I_SGB] + l * BW, O};
              GEMM_CALL(EpiGlu); }
            SEAM(s0 + 4);
        }
        if (PHON(6) && IN(s0 + 6)) {
            { pg8::Gemm g{O, (const bf16_t*)((const unsigned char*)Wl + WO_BR), TG, D, BW, OLD, BW, (size_t)BW * 2, (size_t)D * BW * 2}; pg8::StaticOrder S; S.init(TG, D, G, (int)blockIdx.x, 2, 128);
              EpiBr E{PGb, U};
              pg8::gemm_phase<EpiBr, pg8::StaticOrder, true, true, true>(lds, g, S, E); }
            SEAM(s0 + 6);
        }
        if (PHON(7) && IN(s0 + 7)) {
            if (a.fin != 2) { pg8::Gemm g{U, (const bf16_t*)((const unsigned char*)Wl + WO_OUT), TG, D, D, D, D, 0, 0}; pg8::StaticOrder S; S.init(TG, D, G, (int)blockIdx.x);
              EpiOut E{DLT};
              GEMM_CALL(EpiOut); }
            if (l == 3 && a.fin) { if (a.fin == 1) xcd_barrier(bar); LTID(t_); phase_norm<true, true>(og, DLT, og, a.in[I_FNG], U, blockIdx.x * 8 + __builtin_amdgcn_readfirstlane(t_ >> 6), ngw, t_ & 63); }
            SEAM(s0 + 7);
        }
    }
#undef IN
#undef SEAM
}

__device__ __forceinline__ float block_sum_128(float v, float* red) {
    v = wave_sum(v); __syncthreads(); if ((threadIdx.x & 63) == 0) red[threadIdx.x >> 6] = v; __syncthreads(); return red[0] + red[1];
}
template <bool GLA>
__global__ void __launch_bounds__(128) naive_glaret(const bf16_t* P, const float* LA, const float* gain, const float* bias, bf16_t* O) {
    const int b = blockIdx.x >> 2, h = blockIdx.x & 3, c = threadIdx.x;
    __shared__ float sq[64], sk[64], sa[64], red[2];
    float S[64];
#pragma unroll
    for (int d = 0; d < 64; ++d) S[d] = 0.f;
    const int qoff = GLA ? P_GQ : P_RQ, koff = GLA ? P_GK : P_RK, voff = GLA ? P_GV : P_RV, goff = GLA ? P_GG : P_RG;
    const float gamma = 1.f - exp2f(-5.f - (float)h);
    const float gn = gain[128 * h + c], bs = GLA ? 0.f : bias[128 * h + c];
    for (int t = 0; t < SEQ; ++t) {
        const size_t row = (size_t)b * SEQ + t;
        if (c < 64) { sq[c] = bf2f(P[row * PLD + qoff + 64 * h + c]); sk[c] = bf2f(P[row * PLD + koff + 64 * h + c]); sa[c] = GLA ? __expf(LA[row * 256 + 64 * h + c]) : gamma; }
        __syncthreads();
        const float v = bf2f(P[row * PLD + voff + 128 * h + c]); float o = 0.f;
#pragma unroll
        for (int d = 0; d < 64; ++d) { S[d] = sa[d] * S[d] + sk[d] * v; o += sq[d] * S[d]; }
        float r;
        if (GLA) { const float ss = block_sum_128(o * o, red); r = o * rsqrtf(ss * (1.f / 128.f) + NORM_EPS) * gn; }
        else { const float mean = block_sum_128(o, red) * (1.f / 128.f); const float dv = o - mean; const float var = block_sum_128(dv * dv, red) * (1.f / 128.f); r = dv * rsqrtf(var + NORM_EPS) * gn + bs; }
        r *= bf2f(P[row * PLD + goff + 128 * h + c]);
        O[row * OLD + (GLA ? 0 : 512) + 128 * h + c] = f2bf(r);
        __syncthreads();
    }
}
__global__ void __launch_bounds__(512) naive_lru_gates(const bf16_t* P, const float* cw, const float* cb, const float* wa, const float* ba, const float* wx, const float* bx, const float* sp8, float* Aout, float* Gout) {
    const int row = blockIdx.x, c = threadIdx.x, t = row & (SEQ - 1);
    __shared__ float xs[512];
    float xc = cb[c];
#pragma unroll
    for (int j = 0; j < 4; ++j) { const int tt = t - 3 + j; if (tt >= 0) xc += cw[j * 512 + c] * bf2f(P[(size_t)(row - 3 + j) * PLD + P_LX + c]); }
    xs[c] = xc; __syncthreads();
    const int n = c >> 6, j = c & 63; float ra = ba[c], ri = bx[c];
    for (int i = 0; i < 64; ++i) { const float x = xs[64 * n + i]; ra += x * wa[(n * 64 + i) * 64 + j]; ri += x * wx[(n * 64 + i) * 64 + j]; }
    const float r = 1.f / (1.f + expf(-ra)), ig = 1.f / (1.f + expf(-ri));
    const float log_a = -r * sp8[c]; const float av = expf(log_a);
    Aout[(size_t)row * 512 + c] = av; Gout[(size_t)row * 512 + c] = xc * ig * sqrtf(-expm1f(2.f * log_a));
}
__global__ void __launch_bounds__(256) naive_lru_scan(const float* Ain, const float* Gin, const bf16_t* P, bf16_t* O) {
    const int idx = blockIdx.x * 256 + threadIdx.x, b = idx >> 9, c = idx & 511; float h = 0.f;
    for (int t = 0; t < SEQ; ++t) { const size_t row = (size_t)b * SEQ + t; h = Ain[row * 512 + c] * h + Gin[row * 512 + c];
        O[row * OLD + 1024 + c] = f2bf(h * bf2f(P[row * PLD + P_LG + c])); }
}
__global__ void __launch_bounds__(64) naive_s5(const bf16_t* P, const float* sm, const float* cre, const float* cim, const float* dd, bf16_t* Y5) {
    const int b = blockIdx.x >> 5, g = blockIdx.x & 31, lane = threadIdx.x, i = lane & 15, q = lane >> 4;
    __shared__ float xs[128];
    float bbr[16], bbi[16], cr[16], ci[16];
#pragma unroll
    for (int j = 0; j < 16; ++j) { bbr[j] = sm[SM_BBR + (g * 64 + lane) * 16 + j]; bbi[j] = sm[SM_BBI + (g * 64 + lane) * 16 + j];
        cr[j] = cre[(g * 16 + i) * 64 + 16 * q + j]; ci[j] = cim[(g * 16 + i) * 64 + 16 * q + j]; }
    const float abr = sm[SM_ABR + g * 64 + lane], abi = sm[SM_ABI + g * 64 + lane], dv = dd[16 * g + i];
    float xr = 0.f, xi = 0.f;
    for (int t = 0; t < SEQ; ++t) {
        const size_t row = (size_t)b * SEQ + t; const bf16_t* up = P + row * PLD + P_SU + 16 * g;
        const u32x4 u0 = *(const u32x4*)up, u1 = *(const u32x4*)(up + 8);
        const float uu[16] = {bflo(u0.x), bfhi(u0.x), bflo(u0.y), bfhi(u0.y), bflo(u0.z), bfhi(u0.z), bflo(u0.w), bfhi(u0.w), bflo(u1.x), bfhi(u1.x), bflo(u1.y), bfhi(u1.y), bflo(u1.z), bfhi(u1.z), bflo(u1.w), bfhi(u1.w)};
        float br = 0.f, bi = 0.f;
#pragma unroll
        for (int j = 0; j < 16; ++j) { br += bbr[j] * uu[j]; bi += bbi[j] * uu[j]; }
        const float nr = abr * xr - abi * xi + br, ni = abr * xi + abi * xr + bi; xr = nr; xi = ni;
        xs[lane] = xr; xs[64 + lane] = xi; __syncthreads();
        float y = 0.f;
#pragma unroll
        for (int j = 0; j < 16; ++j) y += cr[j] * xs[16 * q + j] - ci[j] * xs[64 + 16 * q + j];
        y += __shfl_xor(y, 16); y += __shfl_xor(y, 32);
        y += dv * bf2f(up[i]);
        if (q == 0) Y5[row * BW + 16 * g + i] = f2bf(gelu_tanh_f(y));
        __syncthreads();
    }
}


__global__ void __launch_bounds__(512) trivial_mix(const bf16_t* P, const float* LA, bf16_t* O, bf16_t* Y5) {
    const size_t row = blockIdx.x; const int c = threadIdx.x; const bf16_t* p = P + row * PLD;
    const float la = __expf(LA[row * 256 + (c & 255)]);
    O[row * OLD + c] = f2bf(bf2f(p[P_GV + c]) * bf2f(p[P_GG + c]) * (bf2f(p[P_GQ + (c & 255)]) + bf2f(p[P_GK + (c & 255)])) * la);
    O[row * OLD + 512 + c] = f2bf(bf2f(p[P_RV + c]) * bf2f(p[P_RG + c]) * (bf2f(p[P_RQ + (c & 255)]) + bf2f(p[P_RK + (c & 255)])));
    O[row * OLD + 1024 + c] = f2bf(bf2f(p[P_LX + c]) * bf2f(p[P_LG + c]));
    Y5[row * BW + c] = p[P_SU + c];
}
extern "C" void kernel_launch(void* const* d_in, const int* in_sizes, int n_in, void* d_out, int out_size, void* d_ws, size_t ws_size, hipStream_t stream) {
    static int grid = 0;
    if (grid == 0) {
        static const int exp_sizes[29] = {67108864, 4096, 21037056, 16384, 1024, 2048, 2048, 2048, 8192, 2048, 131072, 2048, 131072, 2048, 2048, 8192, 8192, 131072, 131072, 131072, 131072, 2048, 128, 1048576, 2048, 16777216, 8388608, 4194304, 1024};
        bool ok_sizes = (n_in == 29); if (ok_sizes) for (int i = 0; i < 29; ++i) if (in_sizes[i] != exp_sizes[i]) { fprintf(stderr, "kernel_launch: input %d has %d elements, expected %d\n", i, in_sizes[i], exp_sizes[i]); ok_sizes = false; }
        if (!ok_sizes || out_size != NB * SEQ * D || ws_size < WS_END) { fprintf(stderr, "kernel_launch: unexpected shapes (n_in %d out %d ws %zu)\n", n_in, out_size, ws_size); grid = -1; return; }
        int dev = 0, cus = 0, per_cu = 0;
        hipGetDevice(&dev); hipDeviceGetAttribute(&cus, hipDeviceAttributeMultiprocessorCount, dev);
        hipOccupancyMaxActiveBlocksPerMultiprocessor(&per_cu, (const void*)mk_fwd, 512, 0);
        (void)hipGetLastError();
        grid = cus > 0 ? cus : 256;
        if (per_cu < 1) fprintf(stderr, "kernel_launch: occupancy query says %d\n", per_cu);
    }
    if (grid < 0) return;
    hipMemsetAsync((char*)d_ws + WS_CTL, 0, CTL_BYTES, stream);
    Args a{};
    for (int i = 0; i < 29; ++i) a.in[i] = (const float*)d_in[i];
    a.out = (float*)d_out; a.ws = (unsigned char*)d_ws;
    unsigned char* ws = (unsigned char*)d_ws;
    int li = 0;
    auto run = [&](int lo, int hi, int fin = 1, int mm = 7) { a.s_lo = lo; a.s_hi = hi; a.li = li++; a.fin = fin; a.mmask = mm; a.pad2 = 0; hipLaunchKernelGGL(mk_fwd, dim3(grid), dim3(512), 0, stream, a); };
#if ONE_LAUNCH
    run(0, NSTEPS);
#else
    run(0, 1);
    for (int gl = 0; gl < NGRP * DEPTH; ++gl) {
        const int l = gl & 3, s0 = 1 + gl * NPH;
        run(s0 + 0, s0 + 1); for (int rp = 0; rp < PROBE_G1; ++rp) run(s0 + 1, s0 + 2);
        {
            const bf16_t* P = (const bf16_t*)(ws + WS_P); const float* LA = (const float*)(ws + WS_LA); bf16_t* O = (bf16_t*)(ws + WS_O); bf16_t* Y5 = (bf16_t*)(ws + WS_Y5);
            float* MACC = (float*)(ws + WS_PG); const float* sm = (const float*)(ws + WS_SMALL + (size_t)l * SMALL_STRIDE);
#if !OPT_GLARET
            hipLaunchKernelGGL(naive_glaret<true>, dim3(BG * 4), dim3(128), 0, stream, P, LA, a.in[I_GNG] + l * 512, (const float*)nullptr, O);
            hipLaunchKernelGGL(naive_glaret<false>, dim3(BG * 4), dim3(128), 0, stream, P, LA, a.in[I_RNG] + l * 512, a.in[I_RNB] + l * 512, O);
#endif
#if !OPT_LRU
            hipLaunchKernelGGL(naive_lru_gates, dim3(TG), dim3(512), 0, stream, P, a.in[I_LCW] + l * 2048, a.in[I_LCB] + l * 512, a.in[I_LWA] + (size_t)l * 32768, a.in[I_LBA] + l * 512,
                               a.in[I_LWX] + (size_t)l * 32768, a.in[I_LBX] + l * 512, sm + SM_SP8, MACC, MACC + (size_t)TG * 512);
            hipLaunchKernelGGL(naive_lru_scan, dim3(BG * 512 / 256), dim3(256), 0, stream, (const float*)MACC, (const float*)(MACC + (size_t)TG * 512), P, O);
#endif
#if !OPT_S5
            hipLaunchKernelGGL(naive_s5, dim3(BG * 32), dim3(64), 0, stream, P, sm, a.in[I_SCRE] + (size_t)l * 32768, a.in[I_SCIM] + (size_t)l * 32768, a.in[I_SD] + l * 512, Y5);
#endif
            (void)P; (void)LA; (void)O; (void)Y5; (void)MACC; (void)sm;
        }
        for (int rp = 0; rp < PROBE_MIX; ++rp) { run(s0 + 2, s0 + 3); run(s0 + 3, s0 + 4); }
#if PROBE_MMASK
        run(s0 + 2, s0 + 3, 1, PROBE_MMASK); run(s0 + 3, s0 + 4, 1, PROBE_MMASK);
#endif
        run(s0 + 4, s0 + 5); run(s0 + 6, s0 + 7); run(s0 + 7, s0 + 8, 0); if (l == 3) run(s0 + 7, s0 + 8, 2);
    }
#endif
}
```

```cpp
#include <hip/hip_runtime.h>
#include <cstdio>
#include <cstdint>


namespace pg8 {
#define PG8_LAS __attribute__((address_space(3)))
typedef unsigned short bf16_t;
typedef short bf16x8 __attribute__((ext_vector_type(8)));
typedef float f32x4 __attribute__((ext_vector_type(4)));
typedef unsigned u32x4 __attribute__((ext_vector_type(4)));
typedef unsigned u32x2 __attribute__((ext_vector_type(2)));
constexpr int BM = 256, BK = 64, HALF = 128, HTB = HALF * BK * 2, STAGE_BYTES = 8 * HTB, NXCD = 8, WGM = 8;

__host__ __device__ __forceinline__ int lds_byte(int r, int c) { const int st = (r >> 4) * 2 + (c >> 5), rr = r & 15, cc = c & 31, ob = rr * 64 + cc * 2; return st * 1024 + (ob ^ (((ob >> 9) & 1) << 5)); }
__host__ __device__ __forceinline__ void stage_rc(int b, int& R, int& C) { const int st = b / 1024, sb = b % 1024, swz = sb ^ (((sb >> 9) & 1) << 5); R = (st >> 1) * 16 + swz / 64; C = (st & 1) * 32 + (swz % 64) / 2; }
__host__ __device__ __forceinline__ int perm32(int rho) { const int n = rho >> 4, i = rho & 15; return 8 * (i >> 2) + 4 * n + (i & 3); }

struct Unit { int pm, pn, z; };
struct Gemm { const bf16_t* A; const bf16_t* Bt; int M, N, K, lda, ldb; size_t zA, zB; };

struct StaticOrder {
    int nM, nN, nwg, G, c, zsh;
    __host__ __device__ void init(int M, int N, int G_, int c_, int zsh_ = 0, int bn_ = BM) { nM = M / BM; nN = N / bn_; nwg = nM * nN; G = G_; c = c_; zsh = zsh_; }
    __host__ __device__ bool next(int i, Unit& u) const {
        const int ti = i >> zsh; u.z = i & ((1 << zsh) - 1);
        const long L = (long)ti * G + c; if (L >= nwg) return false;
        int wgid = (int)L; { const int q = nwg / NXCD, r = nwg % NXCD, xcd = wgid % NXCD, off = wgid / NXCD; wgid = (xcd < r ? xcd * (q + 1) : r * (q + 1) + (xcd - r) * q) + off; }
        const int nig = WGM * nN, gid = wgid / nig, fm = gid * WGM, gsz = (nM - fm) < WGM ? (nM - fm) : WGM;
        u.pm = fm + ((wgid % nig) % gsz); u.pn = (wgid % nig) / gsz; return true;
    }
    __device__ __forceinline__ void a_ready(const Unit&) const {}
    __device__ __forceinline__ void done(const Unit&) const {}
};

typedef float f32x2_ __attribute__((ext_vector_type(2)));
typedef __bf16 bf16x2_ __attribute__((ext_vector_type(2)));
__device__ __forceinline__ unsigned cvt_pk_bf16(float lo, float hi) { const f32x2_ v = {lo, hi}; const bf16x2_ b = __builtin_convertvector(v, bf16x2_); return __builtin_bit_cast(unsigned, b); }

template <class Epi, class Sched, bool ALIGN_EPI = false, bool SP2 = false, bool HALFN = false>
__device__ __forceinline__ void gemm_phase(PG8_LAS unsigned char* lds, const Gemm g, const Sched& S, const Epi& E) {
    int tid = threadIdx.x; asm volatile("" : "+v"(tid));
    const int wid = __builtin_amdgcn_readfirstlane(tid >> 6), lane = tid & 63, wr = wid >> 2, wc = wid & 3, fr = lane & 15, fq = lane >> 4;
    const int K = g.K, nt = K / BK;
    unsigned voffA[2], voffB[2];
#pragma unroll
    for (int i = 0; i < 2; ++i) { int R, C; stage_rc(tid * 16 + i * 8192, R, C); const int Rb = Epi::PERM ? ((R & ~31) + perm32(R & 31)) : R;
        voffA[i] = (unsigned)(R * g.lda + C) * 2u; voffB[i] = (unsigned)(Rb * g.ldb + C) * 2u; }
    const size_t kstep = (size_t)(BK * 2);
    const size_t hstepA = (size_t)HALF * g.lda * 2, hstepB = (size_t)HALF * g.ldb * 2;
    const size_t tstepA = 2 * hstepA, tstepB = HALFN ? hstepB : 2 * hstepB;
    const unsigned ldsw = (unsigned)wid * 1024u;
    unsigned aoff = (unsigned)lds_byte(wr * 64 + fr, fq * 8), boff = (unsigned)lds_byte(wc * 32 + fr, fq * 8) + 4u * HTB;
    asm volatile("" : "+v"(aoff), "+v"(boff));
#define PG8_SA(b, h) (((b) * 2 + (h)) * HTB)
#define PG8_SB(b, h) ((4 + (b) * 2 + (h)) * HTB)
#define PG8_STAGE(bufoff, gbase, voff) do { _Pragma("unroll") for (int _i = 0; _i < 2; ++_i) \
        __builtin_amdgcn_global_load_lds((const unsigned*)((const char*)(gbase) + (voff)[_i]), (PG8_LAS unsigned*)(lds + (bufoff) + ldsw + _i * 8192), 16, 0, 0); } while (0)
#define PG8_LDA(dst, b, h) do { _Pragma("unroll") for (int m = 0; m < 4; ++m) _Pragma("unroll") for (int k = 0; k < 2; ++k) dst[m][k] = *(const PG8_LAS bf16x8*)(lds + aoff + (PG8_SA(b, h) + m * 2048 + k * 1024)); } while (0)
#define PG8_LDB(dst, b, h) do { _Pragma("unroll") for (int n = 0; n < 2; ++n) _Pragma("unroll") for (int k = 0; k < 2; ++k) dst[n][k] = *(const PG8_LAS bf16x8*)(lds + boff + (((b) * 2 + (h)) * HTB + n * 2048 + k * 1024)); } while (0)
#define PG8_MMA(ai, bj, At, Bt) do { __builtin_amdgcn_s_setprio(1); _Pragma("unroll") for (int m = 0; m < 4; ++m) _Pragma("unroll") for (int n = 0; n < 2; ++n) _Pragma("unroll") for (int k = 0; k < 2; ++k) \
        acc[ai][bj][m][n] = __builtin_amdgcn_mfma_f32_16x16x32_bf16(Bt[n][k], At[m][k], acc[ai][bj][m][n], 0, 0, 0); __builtin_amdgcn_s_setprio(0); } while (0)
#define PG8_WAIT_V(n) asm volatile("s_waitcnt vmcnt(" #n ")" ::: "memory")
#define PG8_WAIT_L(n) asm volatile("s_waitcnt lgkmcnt(" #n ")" ::: "memory")
#define PG8_BAR __builtin_amdgcn_s_barrier()
#define PG8_SCHED __builtin_amdgcn_sched_barrier(0)
    Unit cur, nxt; int ui = 0;
    if (!S.next(0, cur)) return;
    f32x4 acc[2][2][4][2];
#pragma unroll
    for (int a = 0; a < 2; ++a)
#pragma unroll
        for (int b = 0; b < 2; ++b)
#pragma unroll
            for (int m = 0; m < 4; ++m)
#pragma unroll
                for (int n = 0; n < 2; ++n) acc[a][b][m][n] = (f32x4){0.f, 0.f, 0.f, 0.f};
    bf16x8 At[4][2], B0[2][2], B1[2][2];
    const char* cA = (const char*)g.A + (size_t)cur.pm * tstepA + (size_t)cur.z * g.zA; const char* cB = (const char*)g.Bt + (size_t)cur.pn * tstepB + (size_t)cur.z * g.zB;
    S.a_ready(cur);
    if constexpr (SP2 && HALFN) {
        PG8_STAGE(PG8_SB(0, 0), cB, voffB); PG8_STAGE(PG8_SA(0, 0), cA, voffA); PG8_STAGE(PG8_SA(0, 1), cA + hstepA, voffA);
        if (wr == 1) PG8_BAR;
        PG8_WAIT_V(2); PG8_BAR;
        PG8_STAGE(PG8_SB(1, 0), cB + kstep, voffB); PG8_STAGE(PG8_SA(1, 0), cA + kstep, voffA);
        PG8_WAIT_V(4); PG8_BAR;
    } else if constexpr (SP2) {
        PG8_STAGE(PG8_SB(0, 0), cB, voffB); PG8_STAGE(PG8_SB(0, 1), cB + hstepB, voffB); PG8_STAGE(PG8_SA(0, 0), cA, voffA); PG8_STAGE(PG8_SA(0, 1), cA + hstepA, voffA);
        if (wr == 1) PG8_BAR;
        PG8_WAIT_V(2); PG8_BAR;
        PG8_STAGE(PG8_SB(1, 0), cB + kstep, voffB); PG8_STAGE(PG8_SA(1, 0), cA + kstep, voffA); PG8_STAGE(PG8_SB(1, 1), cB + hstepB + kstep, voffB);
        PG8_WAIT_V(6); PG8_BAR;
    } else {
        PG8_STAGE(PG8_SB(0, 0), cB, voffB); PG8_STAGE(PG8_SA(0, 0), cA, voffA); PG8_STAGE(PG8_SB(0, 1), cB + hstepB, voffB); PG8_STAGE(PG8_SA(0, 1), cA + hstepA, voffA);
        if (wr == 1) PG8_BAR;
        PG8_WAIT_V(4); PG8_BAR;
        PG8_STAGE(PG8_SB(1, 0), cB + kstep, voffB); PG8_STAGE(PG8_SA(1, 0), cA + kstep, voffA); PG8_STAGE(PG8_SB(1, 1), cB + hstepB + kstep, voffB);
        PG8_WAIT_V(6); PG8_BAR;
    }
    for (;;) {
        const bool has_next = S.next(ui + 1, nxt);
        const char* nA = has_next ? (const char*)g.A + (size_t)nxt.pm * tstepA + (size_t)nxt.z * g.zA : cA; const char* nB = has_next ? (const char*)g.Bt + (size_t)nxt.pn * tstepB + (size_t)nxt.z * g.zB : cB;
        for (int t = 0; t < nt; t += 2) {
            const bool last = (t == nt - 2);
            const char* a1 = cA + (size_t)(t + 1) * kstep;
            const char* a2 = last ? nA : cA + (size_t)(t + 2) * kstep; const char* b2 = last ? nB : cB + (size_t)(t + 2) * kstep;
            const char* a3 = a2 + kstep; const char* b3 = b2 + kstep;
            if (last && has_next) S.a_ready(nxt);
            if constexpr (SP2 && HALFN) {
            PG8_LDB(B0, 0, 0); PG8_SCHED; PG8_LDA(At, 0, 0); PG8_STAGE(PG8_SA(1, 1), a1 + hstepA, voffA);
            PG8_WAIT_V(6); PG8_WAIT_L(0); PG8_BAR; PG8_MMA(0, 0, At, B0); PG8_BAR; PG8_SCHED;
            PG8_LDA(At, 0, 1); PG8_STAGE(PG8_SB(0, 0), b2, voffB); PG8_STAGE(PG8_SA(0, 0), a2, voffA);
            PG8_WAIT_V(6); PG8_WAIT_L(0); PG8_BAR; PG8_MMA(1, 0, At, B0); PG8_BAR; PG8_SCHED;
            PG8_LDB(B0, 1, 0); PG8_SCHED; PG8_LDA(At, 1, 0); PG8_STAGE(PG8_SA(0, 1), a2 + hstepA, voffA);
            PG8_WAIT_V(6); PG8_WAIT_L(0); PG8_BAR; PG8_MMA(0, 0, At, B0); PG8_BAR; PG8_SCHED;
            PG8_LDA(At, 1, 1); PG8_STAGE(PG8_SB(1, 0), b3, voffB); PG8_STAGE(PG8_SA(1, 0), a3, voffA);
            PG8_WAIT_V(6); PG8_WAIT_L(0); PG8_BAR; PG8_MMA(1, 0, At, B0); PG8_BAR; PG8_SCHED;
            } else if constexpr (SP2) {
            PG8_LDB(B0, 0, 0); PG8_LDB(B1, 0, 1); PG8_SCHED; PG8_LDA(At, 0, 0); PG8_STAGE(PG8_SA(1, 1), a1 + hstepA, voffA);
            PG8_WAIT_V(8); PG8_WAIT_L(0); PG8_BAR; PG8_MMA(0, 0, At, B0); PG8_MMA(0, 1, At, B1); PG8_BAR; PG8_SCHED;
            PG8_LDA(At, 0, 1); PG8_STAGE(PG8_SB(0, 0), b2, voffB); PG8_STAGE(PG8_SB(0, 1), b2 + hstepB, voffB); PG8_STAGE(PG8_SA(0, 0), a2, voffA);
            PG8_WAIT_V(8); PG8_WAIT_L(0); PG8_BAR; PG8_MMA(1, 0, At, B0); PG8_MMA(1, 1, At, B1); PG8_BAR; PG8_SCHED;
            PG8_LDB(B0, 1, 0); PG8_LDB(B1, 1, 1); PG8_SCHED; PG8_LDA(At, 1, 0); PG8_STAGE(PG8_SA(0, 1), a2 + hstepA, voffA);
            PG8_WAIT_V(8); PG8_WAIT_L(0); PG8_BAR; PG8_MMA(0, 0, At, B0); PG8_MMA(0, 1, At, B1); PG8_BAR; PG8_SCHED;
            PG8_LDA(At, 1, 1); PG8_STAGE(PG8_SB(1, 0), b3, voffB); PG8_STAGE(PG8_SB(1, 1), b3 + hstepB, voffB); PG8_STAGE(PG8_SA(1, 0), a3, voffA);
            PG8_WAIT_V(8); PG8_WAIT_L(0); PG8_BAR; PG8_MMA(1, 0, At, B0); PG8_MMA(1, 1, At, B1); PG8_BAR; PG8_SCHED;
            } else {
            PG8_LDB(B0, 0, 0); PG8_SCHED; PG8_LDA(At, 0, 0); PG8_STAGE(PG8_SA(1, 1), a1 + hstepA, voffA);
            PG8_WAIT_L(8); PG8_BAR; PG8_WAIT_L(0); PG8_MMA(0, 0, At, B0); PG8_BAR; PG8_SCHED;
            PG8_LDB(B1, 0, 1); PG8_STAGE(PG8_SB(0, 0), b2, voffB);
            PG8_BAR; PG8_WAIT_L(0); PG8_MMA(0, 1, At, B1); PG8_BAR;
            PG8_LDA(At, 0, 1); PG8_STAGE(PG8_SA(0, 0), a2, voffA);
            PG8_BAR; PG8_WAIT_L(0); PG8_MMA(1, 0, At, B0); PG8_BAR; PG8_SCHED;
            PG8_STAGE(PG8_SB(0, 1), b2 + hstepB, voffB);
            PG8_WAIT_V(6); PG8_BAR; PG8_MMA(1, 1, At, B1); PG8_BAR;
            PG8_LDB(B0, 1, 0); PG8_SCHED; PG8_LDA(At, 1, 0); PG8_STAGE(PG8_SA(0, 1), a2 + hstepA, voffA);
            PG8_WAIT_L(8); PG8_BAR; PG8_WAIT_L(0); PG8_MMA(0, 0, At, B0); PG8_BAR; PG8_SCHED;
            PG8_LDB(B1, 1, 1); PG8_STAGE(PG8_SB(1, 0), b3, voffB);
            PG8_BAR; PG8_WAIT_L(0); PG8_MMA(0, 1, At, B1); PG8_BAR;
            PG8_LDA(At, 1, 1); PG8_STAGE(PG8_SA(1, 0), a3, voffA);
            PG8_BAR; PG8_WAIT_L(0); PG8_MMA(1, 0, At, B0); PG8_BAR; PG8_SCHED;
            PG8_STAGE(PG8_SB(1, 1), b3 + hstepB, voffB);
            PG8_WAIT_V(6); PG8_BAR; PG8_MMA(1, 1, At, B1); PG8_BAR;
            }
        }
        if constexpr (ALIGN_EPI) { if (wr == 0) PG8_BAR; }
        { int fr_e = fr, fq_e = fq; asm volatile("" : "+v"(fr_e), "+v"(fq_e));
          E(acc, cur, wr, wc, fr_e, fq_e); }
        if (!has_next) break;
        if (!HALFN && !(Epi::KEEP && cur.z != 3)) {
#pragma unroll
        for (int a = 0; a < 2; ++a)
#pragma unroll
            for (int b = 0; b < 2; ++b)
#pragma unroll
                for (int m = 0; m < 4; ++m)
#pragma unroll
                    for (int n = 0; n < 2; ++n) acc[a][b][m][n] = (f32x4){0.f, 0.f, 0.f, 0.f};
        }
        cur = nxt; cA = nA; cB = nB; ++ui;
        if constexpr (ALIGN_EPI) { if (wr == 1) PG8_BAR; }
    }
    PG8_WAIT_V(0);
    if constexpr (!ALIGN_EPI) { if (wr == 0) PG8_BAR; }
    PG8_BAR;
#undef PG8_SA
#undef PG8_SB
#undef PG8_STAGE
#undef PG8_LDA
#undef PG8_LDB
#undef PG8_MMA
#undef PG8_WAIT_V
#undef PG8_WAIT_L
#undef PG8_BAR
#undef PG8_SCHED
}

}

using pg8::bf16_t; using pg8::f32x4; using pg8::u32x4; using pg8::u32x2; using pg8::bf16x8; using pg8::cvt_pk_bf16;
#define LAS __attribute__((address_space(3)))

constexpr int D = 1024, SEQ = 4096, NB = 16, DEPTH = 4, BW = 512;
constexpr int NGRP = 2, BG = NB / NGRP, TG = BG * SEQ;
constexpr int N_IN = 21 * 256, N_MG = 4096, N_ALL = N_IN + N_MG;
constexpr int PLD = 20 * 256;
constexpr int P_GQ = 0, P_GK = 256, P_GV = 512, P_GG = 1024, P_RQ = 1536, P_RK = 1792, P_RV = 2048, P_RG = 2560, P_LX = 3072, P_LG = 3584, P_SU = 4096, P_SG = 4608;
constexpr int OLD = 2048;
constexpr float NORM_EPS = 1e-6f;

constexpr size_t MiB = 1u << 20;
constexpr size_t WS_CTL = 0, CTL_BYTES = 2 * MiB;
constexpr size_t WS_ROT = 2 * MiB;
constexpr size_t WS_SMALL = 3 * MiB, SMALL_STRIDE = 1 * MiB;
constexpr size_t WS_W = 8 * MiB, W_STRIDE = 26 * MiB;
constexpr size_t WO_IN = 0, WO_BR = (size_t)N_ALL * D * 2, WO_OUT = WO_BR + (size_t)4 * D * BW * 2, WO_GLU = WO_OUT + (size_t)D * D * 2, WO_END = WO_GLU + (size_t)BW * BW * 2;
static_assert(WO_END <= W_STRIDE, "weights");
constexpr size_t WS_U = 112 * MiB;
constexpr size_t WS_P = 176 * MiB;
constexpr size_t WS_LA = 496 * MiB;
constexpr size_t WS_O = 528 * MiB;
constexpr size_t WS_Y5 = 656 * MiB;
constexpr size_t WS_PG = 688 * MiB;
constexpr size_t WS_ST = 944 * MiB;
constexpr size_t WS_END = 1008 * MiB;
constexpr int SM_ABR = 0, SM_ABI = 2048, SM_BBR = 4096, SM_BBI = 4096 + 32768, SM_SP8 = 4096 + 65536, SM_END_F = SM_SP8 + 512;
constexpr int SM_A128 = SM_END_F;
constexpr size_t SM_LRUW_BYTES = 512 * 1024, SM_CT_BYTES = 640 * 1024, SM_BBT_BYTES = 768 * 1024;
static_assert((size_t)(SM_END_F + 4096) * 4 <= SM_LRUW_BYTES, "small");

constexpr int CW_BAR = 4096;
#define XB_TMO      128
#define XB_XCNT(j)  (256  + 64 * (j))
#define XB_XSUB(j)  (1280 + 64 * (j))
#define XB_XGEN(j)  (2304 + 64 * (j))
#define XB_TOP      3328
#define XB_TOPGEN   3392
#define XCD_BAR_WORDS 3456
#define XB_SPIN_CAP (1u << 18)

__device__ __forceinline__ unsigned xb_ld(unsigned* p)              { return __hip_atomic_load(p, __ATOMIC_RELAXED, __HIP_MEMORY_SCOPE_AGENT); }
__device__ __forceinline__ unsigned xb_add(unsigned* p, unsigned v) { return __hip_atomic_fetch_add(p, v, __ATOMIC_RELAXED, __HIP_MEMORY_SCOPE_AGENT); }
__device__ __forceinline__ unsigned xb_xcc_id() { return (unsigned)__builtin_amdgcn_s_getreg((3 << 11) | 20) & 0xFu; }
#define XB_SPIN(cond, bar) do { unsigned _sp = 0; while (cond) { __builtin_amdgcn_s_sleep(1); \
    if ((++_sp & 255u) == 0u) { if (xb_ld(&(bar)[XB_TMO])) break; if (_sp > XB_SPIN_CAP) { atomicAdd(&(bar)[XB_TMO], 1u); break; } } } } while (0)
struct XcdBarrier { unsigned* bar; unsigned x; volatile LAS unsigned* st; };
__device__ __forceinline__ XcdBarrier xcd_barrier_post(unsigned* bar, volatile LAS unsigned* st) {
    XcdBarrier b; b.bar = bar; b.x = xb_xcc_id(); b.st = st;
    if (threadIdx.x == 0) (void)xb_add(&bar[XB_XCNT(b.x)], 1u);
    return b;
}
__device__ __forceinline__ void xcd_barrier_complete(unsigned* bar, unsigned x, unsigned& nloc, unsigned& nx) {
    const unsigned G = gridDim.x * gridDim.y * gridDim.z;
    unsigned sum, cnt, mine, sp = 0u;
    for (;;) {
        sum = 0u; cnt = 0u; mine = 0u;
#pragma unroll
        for (unsigned j = 0; j < 16; ++j) { const unsigned c = xb_ld(&bar[XB_XCNT(j)]); sum += c; cnt += (c > 0u) ? 1u : 0u; mine = (j == x) ? c : mine; }
        if (sum == G) break;
        __builtin_amdgcn_s_sleep(1);
        if ((++sp & 255u) == 0u) { if (xb_ld(&bar[XB_TMO])) break; if (sp > XB_SPIN_CAP) { atomicAdd(&bar[XB_TMO], 1u); break; } }
    }
    nloc = mine > 0u ? mine : 1u; nx = cnt > 0u ? cnt : 1u;
}
__device__ __forceinline__ void xcd_barrier(const XcdBarrier& b) {
    asm volatile("s_waitcnt vmcnt(0)" ::: "memory");
    __syncthreads();
    if (threadIdx.x == 0) {
        unsigned* bar = b.bar;
        __builtin_amdgcn_s_waitcnt(0);
        unsigned nloc = b.st[0], nx = b.st[1];
        if (nloc == 0u) { xcd_barrier_complete(bar, b.x, nloc, nx); b.st[0] = nloc; b.st[1] = nx; }
        const unsigned old = xb_add(&bar[XB_XSUB(b.x)], 1u);
        const unsigned gen = old / nloc;
        if (old + 1u == (gen + 1u) * nloc) {
            __builtin_amdgcn_fence(__ATOMIC_RELEASE, "agent");
            asm volatile("s_waitcnt vmcnt(0)" ::: "memory");
            const unsigned og = xb_add(&bar[XB_TOP], 1u);
            const unsigned tg = og / nx;
            if (og + 1u == (tg + 1u) * nx) xb_add(&bar[XB_TOPGEN], 1u);
            else XB_SPIN(xb_ld(&bar[XB_TOPGEN]) == tg, bar);
            __builtin_amdgcn_fence(__ATOMIC_ACQUIRE, "agent");
            xb_add(&bar[XB_XGEN(b.x)], 1u);
            asm volatile("s_waitcnt vmcnt(0)" ::: "memory");
        } else {
            XB_SPIN(xb_ld(&bar[XB_XGEN(b.x)]) == gen, bar);
            __builtin_amdgcn_fence(__ATOMIC_ACQUIRE, "agent");
            asm volatile("s_waitcnt vmcnt(0)" ::: "memory");
        }
    }
    __syncthreads();
}

__device__ __forceinline__ float bf2f(bf16_t b) { return __uint_as_float(((unsigned)b) << 16); }
__device__ __forceinline__ float bflo(unsigned w) { return __uint_as_float(w << 16); }
__device__ __forceinline__ float bfhi(unsigned w) { return __uint_as_float(w & 0xffff0000u); }
__device__ __forceinline__ bf16_t f2bf(float f) { return (bf16_t)(cvt_pk_bf16(f, 0.f) & 0xffffu); }
__device__ __forceinline__ float sigmoid_f(float x) { return __builtin_amdgcn_rcpf(1.f + __expf(-x)); }
__device__ __forceinline__ float silu_f(float x) { return x * sigmoid_f(x); }
__device__ __forceinline__ float gelu_tanh_f(float x) { const float u = 0.7978845608028654f * (x + 0.044715f * x * x * x); const float t = 1.f - 2.f * __builtin_amdgcn_rcpf(1.f + __expf(2.f * u)); return 0.5f * x * (1.f + t); }
__device__ __forceinline__ float wave_sum(float v) {
#pragma unroll
    for (int o = 1; o < 64; o <<= 1) v += __shfl_xor(v, o);
    return v;
}

#define GEMM_CALL(EPI) pg8::gemm_phase<EPI, pg8::StaticOrder, true, true>(lds, g, S, E)
struct Args {
    const float* in[29]; float* out; unsigned char* ws;
    int s_lo, s_hi, li, fin, mmask, pad2;
};
enum { I_X = 0, I_NG, I_WIN, I_GWLR, I_GBLR, I_GNG, I_RNG, I_RNB, I_LCW, I_LCB, I_LWA, I_LBA, I_LWX, I_LBX, I_LLAM,
       I_SARE, I_SAIM, I_SBRE, I_SBIM, I_SCRE, I_SCIM, I_SD, I_SLDT, I_SGW, I_SGB, I_WMG, I_WBR, I_WOUT, I_FNG };

struct EpiIn {
    static constexpr bool PERM = true, AFTER_DRAIN = false, KEEP = false;
    bf16_t* P; float* LA; const float* blr; const float* rot; bf16_t* PG;
    __device__ __forceinline__ void operator()(f32x4 (&acc)[2][2][4][2], const pg8::Unit& u, int wr, int wc, int fr, int fq) const {
        const int pn = u.pn, row0 = u.pm * 256 + wr * 64 + fr, cl = wc * 32 + 8 * fq;
        if (pn >= 21) {
            const int c0 = (pn - 21) * 256 + cl;
#pragma unroll
            for (int ai = 0; ai < 2; ++ai)
#pragma unroll
                for (int m = 0; m < 4; ++m) { int row = row0 + ai * 128 + m * 16; asm volatile("" : "+v"(row));
#pragma unroll
                    for (int bj = 0; bj < 2; ++bj) { f32x4 v0 = acc[ai][bj][m][0], v1 = acc[ai][bj][m][1];
#pragma unroll
                        for (int j = 0; j < 4; ++j) { v0[j] = sigmoid_f(v0[j]); v1[j] = sigmoid_f(v1[j]); }
                        u32x4 w; w.x = cvt_pk_bf16(v0[0], v0[1]); w.y = cvt_pk_bf16(v0[2], v0[3]); w.z = cvt_pk_bf16(v1[0], v1[1]); w.w = cvt_pk_bf16(v1[2], v1[3]);
                        __builtin_nontemporal_store(w, (u32x4*)(PG + (size_t)row * N_MG + c0 + bj * 128)); } }
        } else if (pn == 4) {
#pragma unroll
            for (int bj = 0; bj < 2; ++bj) { const int c = cl + bj * 128; const f32x4 b0 = *(const f32x4*)(blr + c), b1 = *(const f32x4*)(blr + c + 4);
#pragma unroll
                for (int ai = 0; ai < 2; ++ai) {
#pragma unroll
                    for (int n = 0; n < 2; ++n)
#pragma unroll
                        for (int j = 0; j < 4; ++j) { float run = 0.f; const float bb = n ? b1[j] : b0[j];
#pragma unroll
                            for (int m = 0; m < 4; ++m) { const float z = acc[ai][bj][m][n][j] + bb; const float x = -(fmaxf(-z, 0.f) + __logf(1.f + __expf(-fabsf(z)))) * 0.0625f; float ls = x, rs = x;
#define DPP_ADD(acc_, ctrl_) acc_ += __builtin_bit_cast(float, __builtin_amdgcn_update_dpp(0, __builtin_bit_cast(int, acc_), ctrl_, 0xf, 0xf, true))
                                DPP_ADD(ls, 0x111); DPP_ADD(ls, 0x112); DPP_ADD(ls, 0x114); DPP_ADD(ls, 0x118);
                                DPP_ADD(rs, 0x101); DPP_ADD(rs, 0x102); DPP_ADD(rs, 0x104); DPP_ADD(rs, 0x108);
#undef DPP_ADD
                                acc[ai][bj][m][n][j] = run + ls; run += ls + rs - x; } }
#pragma unroll
                    for (int m = 0; m < 4; ++m) { int row = row0 + ai * 128 + m * 16; asm volatile("" : "+v"(row)); float* d = LA + (size_t)row * 256 + c; *(f32x4*)d = acc[ai][bj][m][0]; *(f32x4*)(d + 4) = acc[ai][bj][m][1]; } } }
        } else if (pn == 7 || pn == 8) {
            const float sc = pn == 8 ? 0.125f : 1.f; const int dcol = (pn - 1) * 256;
#pragma unroll
            for (int ai = 0; ai < 2; ++ai)
#pragma unroll
                for (int m = 0; m < 4; ++m) { int row = row0 + ai * 128 + m * 16; asm volatile("" : "+v"(row)); const int pos = row & (SEQ - 1);
#pragma unroll
                    for (int bj = 0; bj < 2; ++bj) { const int c = cl + bj * 128, i0 = (c & 63) >> 1; const float* rt = rot + ((size_t)pos * 32 + i0) * 2;
                        const f32x4 cs0 = *(const f32x4*)rt, cs1 = *(const f32x4*)(rt + 4); const f32x4 v0 = acc[ai][bj][m][0] * sc, v1 = acc[ai][bj][m][1] * sc;
                        u32x4 w; w.x = cvt_pk_bf16(v0[0] * cs0[0] - v0[1] * cs0[1], v0[0] * cs0[1] + v0[1] * cs0[0]); w.y = cvt_pk_bf16(v0[2] * cs0[2] - v0[3] * cs0[3], v0[2] * cs0[3] + v0[3] * cs0[2]);
                        w.z = cvt_pk_bf16(v1[0] * cs1[0] - v1[1] * cs1[1], v1[0] * cs1[1] + v1[1] * cs1[0]); w.w = cvt_pk_bf16(v1[2] * cs1[2] - v1[3] * cs1[3], v1[2] * cs1[3] + v1[3] * cs1[2]);
                        __builtin_nontemporal_store(w, (u32x4*)(P + (size_t)row * PLD + dcol + c)); } }
        } else {
            const bool silu = (pn == 5 || pn == 6 || pn == 11 || pn == 12 || pn == 15 || pn == 16 || pn == 19 || pn == 20);
            const float sc = pn == 0 ? 0.125f : 1.f; const int dcol = (pn < 4 ? pn : pn - 1) * 256;
#pragma unroll
            for (int ai = 0; ai < 2; ++ai)
#pragma unroll
                for (int m = 0; m < 4; ++m) { int row = row0 + ai * 128 + m * 16; asm volatile("" : "+v"(row));
#pragma unroll
                    for (int bj = 0; bj < 2; ++bj) { f32x4 v0 = acc[ai][bj][m][0] * sc, v1 = acc[ai][bj][m][1] * sc;
                        if (silu) {
#pragma unroll
                            for (int j = 0; j < 4; ++j) { v0[j] = silu_f(v0[j]); v1[j] = silu_f(v1[j]); } }
                        u32x4 w; w.x = cvt_pk_bf16(v0[0], v0[1]); w.y = cvt_pk_bf16(v0[2], v0[3]); w.z = cvt_pk_bf16(v1[0], v1[1]); w.w = cvt_pk_bf16(v1[2], v1[3]);
                        __builtin_nontemporal_store(w, (u32x4*)(P + (size_t)row * PLD + dcol + cl + bj * 128)); } }
        }
    }
};
struct EpiSig {
    static constexpr bool PERM = true, AFTER_DRAIN = false, KEEP = false;
    bf16_t* PG;
    __device__ __forceinline__ void operator()(const f32x4 (&acc)[2][2][4][2], const pg8::Unit& u, int wr, int wc, int fr, int fq) const {
        const int row0 = u.pm * 256 + wr * 64 + fr, c0 = u.pn * 256 + wc * 32 + 8 * fq;
#pragma unroll
        for (int ai = 0; ai < 2; ++ai)
#pragma unroll
            for (int m = 0; m < 4; ++m) { const int row = row0 + ai * 128 + m * 16;
#pragma unroll
                for (int bj = 0; bj < 2; ++bj) { f32x4 v0 = acc[ai][bj][m][0], v1 = acc[ai][bj][m][1];
#pragma unroll
                    for (int j = 0; j < 4; ++j) { v0[j] = sigmoid_f(v0[j]); v1[j] = sigmoid_f(v1[j]); }
                    u32x4 w; w.x = cvt_pk_bf16(v0[0], v0[1]); w.y = cvt_pk_bf16(v0[2], v0[3]); w.z = cvt_pk_bf16(v1[0], v1[1]); w.w = cvt_pk_bf16(v1[2], v1[3]);
                    *(u32x4*)(PG + (size_t)row * N_MG + c0 + bj * 128) = w; } }
    }
};
struct EpiGlu {
    static constexpr bool PERM = true, AFTER_DRAIN = false, KEEP = false;
    const bf16_t* Y5; const bf16_t* P; const float* gb; bf16_t* O;
    __device__ __forceinline__ void operator()(const f32x4 (&acc)[2][2][4][2], const pg8::Unit& u, int wr, int wc, int fr, int fq) const {
        const int row0 = u.pm * 256 + wr * 64 + fr, c0 = u.pn * 256 + wc * 32 + 8 * fq;
#pragma unroll
        for (int bj = 0; bj < 2; ++bj) { const int c = c0 + bj * 128; const f32x4 b0 = *(const f32x4*)(gb + c), b1 = *(const f32x4*)(gb + c + 4);
#pragma unroll
            for (int ai = 0; ai < 2; ++ai)
#pragma unroll
                for (int m = 0; m < 4; ++m) { const int row = row0 + ai * 128 + m * 16;
                    const u32x4 y = *(const u32x4*)(Y5 + (size_t)row * BW + c), s = *(const u32x4*)(P + (size_t)row * PLD + P_SG + c);
                    const f32x4 v0 = acc[ai][bj][m][0] + b0, v1 = acc[ai][bj][m][1] + b1;
                    u32x4 w;
                    w.x = cvt_pk_bf16(bflo(y.x) * sigmoid_f(v0[0]) * bflo(s.x), bfhi(y.x) * sigmoid_f(v0[1]) * bfhi(s.x));
                    w.y = cvt_pk_bf16(bflo(y.y) * sigmoid_f(v0[2]) * bflo(s.y), bfhi(y.y) * sigmoid_f(v0[3]) * bfhi(s.y));
                    w.z = cvt_pk_bf16(bflo(y.z) * sigmoid_f(v1[0]) * bflo(s.z), bfhi(y.z) * sigmoid_f(v1[1]) * bfhi(s.z));
                    w.w = cvt_pk_bf16(bflo(y.w) * sigmoid_f(v1[2]) * bflo(s.w), bfhi(y.w) * sigmoid_f(v1[3]) * bfhi(s.w));
                    *(u32x4*)(O + (size_t)row * OLD + 1536 + c) = w; } }
    }
};
struct EpiBr {
    static constexpr bool PERM = true, AFTER_DRAIN = false, KEEP = false;
    const bf16_t* PG; bf16_t* MRG;
    __device__ __forceinline__ void operator()(f32x4 (&acc)[2][2][4][2], const pg8::Unit& u, int wr, int wc, int fr, int fq) const {
        const int row0 = u.pm * 256 + wr * 64 + fr, c = u.pn * 128 + wc * 32 + 8 * fq, z = u.z;
#pragma unroll
        for (int ai = 0; ai < 2; ++ai)
#pragma unroll
            for (int m = 0; m < 4; ++m) { const int row = row0 + ai * 128 + m * 16;
                const u32x4 gt = __builtin_nontemporal_load((const u32x4*)(PG + (size_t)row * N_MG + z * 1024 + c));
                f32x4& p0 = acc[ai][0][m][0]; f32x4& p1 = acc[ai][0][m][1]; f32x4& s0 = acc[ai][1][m][0]; f32x4& s1 = acc[ai][1][m][1];
                if (z == 0) { s0 = (f32x4){0.f, 0.f, 0.f, 0.f}; s1 = s0; }
                s0[0] += p0[0] * bflo(gt.x); s0[1] += p0[1] * bfhi(gt.x); s0[2] += p0[2] * bflo(gt.y); s0[3] += p0[3] * bfhi(gt.y);
                s1[0] += p1[0] * bflo(gt.z); s1[1] += p1[1] * bfhi(gt.z); s1[2] += p1[2] * bflo(gt.w); s1[3] += p1[3] * bfhi(gt.w);
                p0 = (f32x4){0.f, 0.f, 0.f, 0.f}; p1 = p0;
                if (z == 3) { u32x4 w; w.x = cvt_pk_bf16(s0[0], s0[1]); w.y = cvt_pk_bf16(s0[2], s0[3]); w.z = cvt_pk_bf16(s1[0], s1[1]); w.w = cvt_pk_bf16(s1[2], s1[3]);
                    *(u32x4*)(MRG + (size_t)row * D + c) = w; } }
    }
};
struct EpiOut {
    static constexpr bool PERM = true, AFTER_DRAIN = false, KEEP = false;
    bf16_t* DL;
    __device__ __forceinline__ void operator()(const f32x4 (&acc)[2][2][4][2], const pg8::Unit& u, int wr, int wc, int fr, int fq) const {
        const int row0 = u.pm * 256 + wr * 64 + fr, c0 = u.pn * 256 + wc * 32 + 8 * fq;
#pragma unroll
        for (int ai = 0; ai < 2; ++ai)
#pragma unroll
            for (int m = 0; m < 4; ++m) { const int row = row0 + ai * 128 + m * 16;
#pragma unroll
                for (int bj = 0; bj < 2; ++bj) { const f32x4 v0 = acc[ai][bj][m][0], v1 = acc[ai][bj][m][1];
                    u32x4 w; w.x = cvt_pk_bf16(v0[0], v0[1]); w.y = cvt_pk_bf16(v0[2], v0[3]); w.z = cvt_pk_bf16(v1[0], v1[1]); w.w = cvt_pk_bf16(v1[2], v1[3]);
                    *(u32x4*)(DL + (size_t)row * D + c0 + bj * 128) = w; } }
    }
};

__device__ __forceinline__ int win_src_col(int r) {
    const int pn = r >> 8, j = r & 255;
    switch (pn) {
        case 0: return j; case 1: return 256 + j; case 2: case 3: return 512 + (r - 512);
        case 4: return -1;
        case 5: case 6: return 1040 + (r - 1280);
        case 7: return 1552 + 64 * (j >> 6) + ((j & 63) >> 1) + 32 * (j & 1);
        case 8: return 1808 + 64 * (j >> 6) + ((j & 63) >> 1) + 32 * (j & 1);
        case 9: case 10: return 2064 + (r - 2304);
        case 11: case 12: return 2576 + (r - 2816);
        case 13: case 14: return 3088 + (r - 3328);
        case 15: case 16: return 3600 + (r - 3840);
        case 17: case 18: return 4112 + (r - 4352);
        default: return 4624 + (r - 4864);
    }
}
__device__ __forceinline__ void tr_store8(bf16_t* dst, const float (&v)[8]) {
    u32x4 w; w.x = cvt_pk_bf16(v[0], v[1]); w.y = cvt_pk_bf16(v[2], v[3]); w.z = cvt_pk_bf16(v[4], v[5]); w.w = cvt_pk_bf16(v[6], v[7]); *(u32x4*)dst = w;
}
__device__ __forceinline__ void phase_prologue(const Args& a, int gtid, int gthreads) {
    unsigned char* ws = a.ws;
    for (int l = 0; l < DEPTH; ++l) {
        bf16_t* Wl = (bf16_t*)(ws + WS_W + (size_t)l * W_STRIDE);
        const float* win = a.in[I_WIN] + (size_t)l * D * 5136;
        const float* wlr = a.in[I_GWLR] + (size_t)l * 16 * 256;
        for (int idx = gtid; idx < N_IN * (D / 8); idx += gthreads) { const int n = idx % N_IN, kc = idx / N_IN; const int sc = win_src_col(n); float v[8];
            if (sc >= 0) {
#pragma unroll
                for (int i = 0; i < 8; ++i) v[i] = win[(size_t)(kc * 8 + i) * 5136 + sc];
            } else { const int j = n & 255;
#pragma unroll
                for (int i = 0; i < 8; ++i) { float s = 0.f; const float* wr_ = win + (size_t)(kc * 8 + i) * 5136 + 1024;
#pragma unroll
                    for (int r = 0; r < 16; ++r) s += wr_[r] * wlr[r * 256 + j];
                    v[i] = s; } }
            tr_store8(Wl + (size_t)n * D + kc * 8, v); }
        const float* wmg = a.in[I_WMG] + (size_t)l * 4 * D * D;
        for (int idx = gtid; idx < N_MG * (D / 8); idx += gthreads) { const int n = idx % N_MG, kc = idx / N_MG, bi = n >> 10, c = n & 1023; float v[8];
#pragma unroll
            for (int i = 0; i < 8; ++i) v[i] = wmg[((size_t)bi * D + kc * 8 + i) * D + c];
            tr_store8(Wl + (size_t)(N_IN + n) * D + kc * 8, v); }
        const float* wbr = a.in[I_WBR] + (size_t)l * 4 * BW * D; bf16_t* Wb = (bf16_t*)((unsigned char*)Wl + WO_BR);
        for (int idx = gtid; idx < 4 * D * (BW / 8); idx += gthreads) { const int n = idx % (4 * D), kc = idx / (4 * D), bi = n >> 10, c = n & 1023; float v[8];
#pragma unroll
            for (int i = 0; i < 8; ++i) v[i] = wbr[((size_t)bi * BW + kc * 8 + i) * D + c];
            tr_store8(Wb + (size_t)n * BW + kc * 8, v); }
        const float* wout = a.in[I_WOUT] + (size_t)l * D * D; bf16_t* Wo = (bf16_t*)((unsigned char*)Wl + WO_OUT);
        for (int idx = gtid; idx < D * (D / 8); idx += gthreads) { const int n = idx % D, kc = idx / D; float v[8];
#pragma unroll
            for (int i = 0; i < 8; ++i) v[i] = wout[(size_t)(kc * 8 + i) * D + n];
            tr_store8(Wo + (size_t)n * D + kc * 8, v); }
        const float* wglu = a.in[I_SGW] + (size_t)l * BW * BW; bf16_t* Wg = (bf16_t*)((unsigned char*)Wl + WO_GLU);
        for (int idx = gtid; idx < BW * (BW / 8); idx += gthreads) { const int n = idx % BW, kc = idx / BW; float v[8];
#pragma unroll
            for (int i = 0; i < 8; ++i) v[i] = wglu[(size_t)(kc * 8 + i) * BW + n];
            tr_store8(Wg + (size_t)n * BW + kc * 8, v); }
        float* sm = (float*)(ws + WS_SMALL + (size_t)l * SMALL_STRIDE);
        for (int idx = gtid; idx < 2048; idx += gthreads) { const int g = idx >> 6;
            const double step = exp((double)a.in[I_SLDT][l * 32 + g]); const double are = a.in[I_SARE][l * 2048 + idx], aim = a.in[I_SAIM][l * 2048 + idx];
            const double mag = exp(step * are), abr = mag * cos(step * aim), abi = mag * sin(step * aim), den = are * are + aim * aim;
            const double fre = ((abr - 1.0) * are + abi * aim) / den, fim = (abi * are - (abr - 1.0) * aim) / den;
            sm[SM_ABR + idx] = (float)abr; sm[SM_ABI + idx] = (float)abi;
            { const double m128 = exp(512.0 * step * are); sm[SM_A128 + idx * 2] = (float)(m128 * cos(512.0 * step * aim)); sm[SM_A128 + idx * 2 + 1] = (float)(m128 * sin(512.0 * step * aim)); }
            bf16_t* bbt = (bf16_t*)((unsigned char*)sm + SM_BBT_BYTES); const int p_ = idx & 63;
            for (int i = 0; i < 16; ++i) { const double br = a.in[I_SBRE][(size_t)l * 32768 + idx * 16 + i], bi = a.in[I_SBIM][(size_t)l * 32768 + idx * 16 + i];
                const float vr = (float)(fre * br - fim * bi), vi = (float)(fre * bi + fim * br);
                sm[SM_BBR + idx * 16 + i] = vr; sm[SM_BBI + idx * 16 + i] = vi; bbt[(g * 128 + 2 * p_) * 16 + i] = f2bf(vr); bbt[(g * 128 + 2 * p_ + 1) * 16 + i] = f2bf(vi); } }
        for (int idx = gtid; idx < 512; idx += gthreads) { const float lam = a.in[I_LLAM][l * 512 + idx]; const float nl = -lam;
            sm[SM_SP8 + idx] = 8.0f * (fmaxf(nl, 0.f) + log1pf(expf(-fabsf(nl)))); }
        { bf16_t* ct = (bf16_t*)((unsigned char*)sm + SM_CT_BYTES);
          for (int idx = gtid; idx < 32 * 16 * 128; idx += gthreads) { const int k = idx & 127, gi = idx >> 7;
              const float v = (k & 1) == 0 ? a.in[I_SCRE][(size_t)l * 32768 + gi * 64 + (k >> 1)] : -a.in[I_SCIM][(size_t)l * 32768 + gi * 64 + (k >> 1)]; ct[idx] = f2bf(v); } }
        bf16_t* lw = (bf16_t*)((unsigned char*)sm + SM_LRUW_BYTES);
        for (int idx = gtid; idx < 8 * 128 * 64; idx += gthreads) { const int i = idx & 63, jj = (idx >> 6) & 127, n = idx >> 13;
            const float v = jj < 64 ? a.in[I_LWA][(((size_t)l * 8 + n) * 64 + i) * 64 + jj] : a.in[I_LWX][(((size_t)l * 8 + n) * 64 + i) * 64 + (jj - 64)];
            lw[idx] = f2bf(v); }
    }
    float* rot = (float*)(ws + WS_ROT);
    for (int idx = gtid; idx < SEQ * 32; idx += gthreads) { const int i = idx & 31, s = idx >> 5;
        const double inv = pow(10000.0, -(double)i / 32.0), ang = (double)s * inv; rot[idx * 2] = (float)cos(ang); rot[idx * 2 + 1] = (float)sin(ang); }
}

template <bool F32OUT, bool ADD>
__device__ __forceinline__ void phase_norm(const float* hin, const bf16_t* delta, float* hout, const float* gain, bf16_t* uout, int gw, int ngw, int lane) {
    f32x4 gv[4];
#pragma unroll
    for (int j = 0; j < 4; ++j) gv[j] = *(const f32x4*)(gain + 4 * lane + 256 * j);
    for (int row = gw; row < TG; row += ngw) {
        const f32x4* xr = (const f32x4*)(hin + (size_t)row * D) + lane; f32x4 v[4]; float s = 0.f;
#pragma unroll
        for (int j = 0; j < 4; ++j) v[j] = __builtin_nontemporal_load(xr + 64 * j);
        if (ADD) { const u32x2* dr = (const u32x2*)(delta + (size_t)row * D) + lane;
#pragma unroll
            for (int j = 0; j < 4; ++j) { const u32x2 dw = __builtin_nontemporal_load(dr + 64 * j); v[j].x += bflo(dw.x); v[j].y += bfhi(dw.x); v[j].z += bflo(dw.y); v[j].w += bfhi(dw.y); } }
#pragma unroll
        for (int j = 0; j < 4; ++j) s += (v[j].x * v[j].x + v[j].y * v[j].y) + (v[j].z * v[j].z + v[j].w * v[j].w);
        const float rstd = rsqrtf(wave_sum(s) * (1.f / D) + NORM_EPS);
        if (F32OUT) { f32x4* o = (f32x4*)(hout + (size_t)row * D) + lane;
#pragma unroll
            for (int j = 0; j < 4; ++j) o[64 * j] = v[j] * rstd * gv[j];
        } else {
            if (ADD) { f32x4* o = (f32x4*)(hout + (size_t)row * D) + lane;
#pragma unroll
                for (int j = 0; j < 4; ++j) o[64 * j] = v[j]; }
            u32x2* o = (u32x2*)(uout + (size_t)row * D) + lane;
#pragma unroll
            for (int j = 0; j < 4; ++j) { const f32x4 y = v[j] * rstd * gv[j]; u32x2 w; w.x = cvt_pk_bf16(y.x, y.y); w.y = cvt_pk_bf16(y.z, y.w); o[64 * j] = w; } }
    }
}

constexpr int NSEGG = 8;
constexpr int NSEGL = 32;
constexpr int NSEGS = 8;
constexpr size_t ST_GSEG = 0;
constexpr size_t ST_GDS = ST_GSEG + (size_t)2 * BG * 4 * NSEGG * 8192;
constexpr size_t ST_LRU = ST_GDS + (size_t)2 * BG * 4 * NSEGG * 64;
constexpr size_t ST_S5 = ST_LRU + (size_t)BG * NSEGL * 512 * 2;
constexpr size_t ST_END_F = ST_S5 + (size_t)BG * NSEGS * 32 * 128;
static_assert(ST_END_F * 4 <= 64 * MiB, "state scratch");
typedef short s16x4 __attribute__((ext_vector_type(4)));

__device__ __forceinline__ bf16x8 lds_tr_frag(LAS const unsigned char* base, int row_stride_bytes, int lane) {
    const int g = lane >> 4, idx = lane & 15, q = idx >> 2, p = idx & 3;
    LAS const unsigned char* a0 = base + (8 * g + q) * row_stride_bytes + 8 * p;
    const s16x4 r0 = __builtin_amdgcn_ds_read_tr16_b64_v4i16((LAS s16x4*)a0);
    const s16x4 r1 = __builtin_amdgcn_ds_read_tr16_b64_v4i16((LAS s16x4*)(a0 + 4 * row_stride_bytes));
    bf16x8 f; f[0] = r0[0]; f[1] = r0[1]; f[2] = r0[2]; f[3] = r0[3]; f[4] = r1[0]; f[5] = r1[1]; f[6] = r1[2]; f[7] = r1[3]; return f;
}
#define WGSYNC() do { asm volatile("s_waitcnt lgkmcnt(0)" ::: "memory"); __builtin_amdgcn_s_barrier(); asm volatile("" ::: "memory"); } while (0)

constexpr int GL_QD = 0, GL_KD = 9216, GL_KT = 18432, GL_V = 27648, GL_ST = 45056, GL_LAST = 63488, GL_RED = 63744, GL_RED2 = 64256;
struct GlaP { const bf16_t* P; const float* LA; const float* gain; const float* bias; bf16_t* O; float* SSEG; float* DSUM; };
__device__ __forceinline__ bf16x8 lds_tr_frag2(LAS const unsigned char* base, int row_stride_bytes, int lane, int mulg, int second_off) {
    const int g = lane >> 4, idx = lane & 15, q = idx >> 2, p = idx & 3;
    LAS const unsigned char* a0 = base + (mulg * g + q) * row_stride_bytes + 8 * p;
    const s16x4 r0 = __builtin_amdgcn_ds_read_tr16_b64_v4i16((LAS s16x4*)a0);
    const s16x4 r1 = __builtin_amdgcn_ds_read_tr16_b64_v4i16((LAS s16x4*)(a0 + second_off * row_stride_bytes));
    bf16x8 f; f[0] = r0[0]; f[1] = r0[1]; f[2] = r0[2]; f[3] = r0[3]; f[4] = r1[0]; f[5] = r1[1]; f[6] = r1[2]; f[7] = r1[3]; return f;
}
__device__ __forceinline__ bf16x8 pack8(const f32x4 a, const f32x4 b) { u32x4 w; w.x = cvt_pk_bf16(a[0], a[1]); w.y = cvt_pk_bf16(a[2], a[3]); w.z = cvt_pk_bf16(b[0], b[1]); w.w = cvt_pk_bf16(b[2], b[3]); return __builtin_bit_cast(bf16x8, w); }

template <bool PASSC>
__device__ __forceinline__ void glaret_item(LAS unsigned char* lds, const GlaP& gp, const bool gla, const int b, const int h, const int seg, const int sidx  ) {
    int tid = threadIdx.x; asm volatile("" : "+v"(tid));
    const int w = __builtin_amdgcn_readfirstlane(tid >> 6), l = tid & 63, fr = l & 15, fq = l >> 4;
    const int qoff = gla ? P_GQ : P_RQ, koff = gla ? P_GK : P_RK, voff = gla ? P_GV : P_RV, goff = gla ? P_GG : P_RG, ooff = gla ? 0 : 512;
    const float lg = __logf(1.f - exp2f(-5.f - (float)h));
    f32x4 accs[4];
#pragma unroll
    for (int dt = 0; dt < 4; ++dt) accs[dt] = (f32x4){0.f, 0.f, 0.f, 0.f};
    float dsum[8];
#pragma unroll
    for (int e = 0; e < 8; ++e) dsum[e] = 0.f;
    if (PASSC) {
        for (int sp = 0; sp < seg; ++sp) {
            const float* sg = gp.SSEG + (size_t)(sidx + sp) * 8192 + tid * 16; const float* dsm = gp.DSUM + (size_t)(sidx + sp) * 64;
#pragma unroll
            for (int dt = 0; dt < 4; ++dt) { const f32x4 dv = *(const f32x4*)(dsm + 16 * dt + 4 * fq), sv = *(const f32x4*)(sg + 4 * dt);
#pragma unroll
                for (int r = 0; r < 4; ++r) accs[dt][r] = accs[dt][r] * __expf(dv[r]) + sv[r]; }
        }
#pragma unroll
        for (int dt = 0; dt < 4; ++dt) { u32x2 wv; wv.x = cvt_pk_bf16(accs[dt][0], accs[dt][1]); wv.y = cvt_pk_bf16(accs[dt][2], accs[dt][3]);
            *(LAS u32x2*)(lds + GL_ST + (16 * w + fr) * 144 + 32 * dt + 8 * fq) = wv; }
    }
    const int it = w & 3, ch = w >> 2;
    f32x4 gnv[4], bsv[4];
#pragma unroll
    for (int ct = 0; ct < 4; ++ct) { const int c = 128 * h + 64 * ch + 16 * ct + 4 * fq; gnv[ct] = PASSC ? *(const f32x4*)(gp.gain + c) : (f32x4){0.f, 0.f, 0.f, 0.f};
        bsv[ct] = (PASSC && !gla) ? *(const f32x4*)(gp.bias + c) : (f32x4){0.f, 0.f, 0.f, 0.f}; }
    u32x4 rq = (u32x4){0u, 0u, 0u, 0u}, rk, rv[2]; f32x4 rla[2], rll[2]; u32x2 gnx[4];
    const float rq_s = __expf((float)(l + 1) * lg), rk_s = __expf(-(float)(l + 1) * lg), rt_s = __expf((float)(63 - l) * lg);
#define GL_ISSUE(n_) do { const size_t r0_ = (size_t)b * SEQ + seg * 512 + (n_) * 64; \
        { const bf16_t* pr_ = gp.P + (r0_ + l) * PLD + 64 * h + 8 * w; if (PASSC) rq = *(const u32x4*)(pr_ + qoff); rk = *(const u32x4*)(pr_ + koff); \
          if (gla) { const float* lp_ = gp.LA + (r0_ + l) * 256 + 64 * h + 8 * w; rla[0] = *(const f32x4*)lp_; rla[1] = *(const f32x4*)(lp_ + 4); const float* ll_ = gp.LA + (r0_ + 63) * 256 + 64 * h + 8 * w; rll[0] = *(const f32x4*)ll_; rll[1] = *(const f32x4*)(ll_ + 4); } \
          else { rla[0] = (f32x4){0.f, 0.f, 0.f, 0.f}; rla[1] = rla[0]; rll[0] = rla[0]; rll[1] = rla[0]; } } \
        _Pragma("unroll") for (int e_ = 0; e_ < 2; ++e_) { const int p_ = tid + 512 * e_, i_ = p_ >> 4, part_ = p_ & 15; \
            rv[e_] = *(const u32x4*)(gp.P + (r0_ + i_) * PLD + voff + 128 * h + 8 * part_); } \
        if (PASSC) { _Pragma("unroll") for (int ct_ = 0; ct_ < 4; ++ct_) gnx[ct_] = *(const u32x2*)(gp.P + (r0_ + 16 * it + fr) * PLD + goff + 128 * h + 64 * ch + 16 * ct_ + 4 * fq); } } while (0)
    GL_ISSUE(0);
    for (int n = 0; n < 8; ++n) {
        const size_t row0 = (size_t)b * SEQ + seg * 512 + n * 64;
#pragma unroll
        for (int e = 0; e < 2; ++e) { const int p = tid + 512 * e, i = p >> 4, part = p & 15; *(LAS u32x4*)(lds + GL_V + i * 272 + part * 16) = rv[e]; }
        { float cum[8], lastv[8];
          const float kk[8] = {bflo(rk.x), bfhi(rk.x), bflo(rk.y), bfhi(rk.y), bflo(rk.z), bfhi(rk.z), bflo(rk.w), bfhi(rk.w)};
          float eq[8], ek[8], et[8];
          if (gla) {
#pragma unroll
              for (int e = 0; e < 8; ++e) { cum[e] = e < 4 ? rla[0][e] : rla[1][e - 4]; lastv[e] = e < 4 ? rll[0][e] : rll[1][e - 4];
                  eq[e] = __expf(cum[e]); ek[e] = __builtin_amdgcn_rcpf(eq[e]); et[e] = __expf(lastv[e]) * ek[e]; }
          } else {
#pragma unroll
              for (int e = 0; e < 8; ++e) { lastv[e] = 64.f * lg; eq[e] = rq_s; ek[e] = rk_s; et[e] = rt_s; } }
#pragma unroll
          for (int e = 0; e < 8; ++e) *(LAS bf16_t*)(lds + GL_KT + (8 * w + e) * 144 + l * 2) = f2bf(kk[e] * et[e]);
          if (PASSC) { const float qq[8] = {bflo(rq.x), bfhi(rq.x), bflo(rq.y), bfhi(rq.y), bflo(rq.z), bfhi(rq.z), bflo(rq.w), bfhi(rq.w)};
              u32x4 qw, kw;
              qw.x = cvt_pk_bf16(qq[0] * eq[0], qq[1] * eq[1]); qw.y = cvt_pk_bf16(qq[2] * eq[2], qq[3] * eq[3]); qw.z = cvt_pk_bf16(qq[4] * eq[4], qq[5] * eq[5]); qw.w = cvt_pk_bf16(qq[6] * eq[6], qq[7] * eq[7]);
              kw.x = cvt_pk_bf16(kk[0] * ek[0], kk[1] * ek[1]); kw.y = cvt_pk_bf16(kk[2] * ek[2], kk[3] * ek[3]); kw.z = cvt_pk_bf16(kk[4] * ek[4], kk[5] * ek[5]); kw.w = cvt_pk_bf16(kk[6] * ek[6], kk[7] * ek[7]);
              *(LAS u32x4*)(lds + GL_QD + l * 144 + 16 * w) = qw; *(LAS u32x4*)(lds + GL_KD + l * 144 + 16 * w) = kw; }
          if (l == 63) {
#pragma unroll
              for (int e = 0; e < 8; ++e) *(LAS float*)(lds + GL_LAST + (8 * w + e) * 4) = lastv[e]; }
#pragma unroll
          for (int e = 0; e < 8; ++e) dsum[e] += lastv[e]; }
        u32x2 gates[4];
        if (PASSC) {
#pragma unroll
            for (int ct = 0; ct < 4; ++ct) gates[ct] = gnx[ct]; }
        if (n < 7) GL_ISSUE(n + 1);
        WGSYNC();
        f32x4 acco[4];
        if (PASSC) {
            bf16x8 qf[2];
#pragma unroll
            for (int ks = 0; ks < 2; ++ks) qf[ks] = *(LAS const bf16x8*)(lds + GL_QD + (16 * it + fr) * 144 + 16 * fq + 64 * ks);
            f32x4 sc[4];
#pragma unroll
            for (int jt = 0; jt < 4; ++jt) { sc[jt] = (f32x4){0.f, 0.f, 0.f, 0.f};
                if (jt <= it) {
#pragma unroll
                    for (int ks = 0; ks < 2; ++ks) { const bf16x8 kf = *(LAS const bf16x8*)(lds + GL_KD + (16 * jt + fr) * 144 + 16 * fq + 64 * ks);
                        sc[jt] = __builtin_amdgcn_mfma_f32_16x16x32_bf16(kf, qf[ks], sc[jt], 0, 0, 0); }
                    if (jt == it) {
#pragma unroll
                        for (int r = 0; r < 4; ++r) sc[jt][r] = (4 * fq + r <= fr) ? sc[jt][r] : 0.f; } } }
            const bf16x8 pf0 = pack8(sc[0], sc[1]), pf1 = pack8(sc[2], sc[3]);
#pragma unroll
            for (int ct = 0; ct < 4; ++ct) { const int c0 = 64 * ch + 16 * ct; acco[ct] = (f32x4){0.f, 0.f, 0.f, 0.f};
                { const bf16x8 vf = lds_tr_frag2(lds + GL_V + c0 * 2, 272, l, 4, 16); acco[ct] = __builtin_amdgcn_mfma_f32_16x16x32_bf16(vf, pf0, acco[ct], 0, 0, 0); }
                if (it >= 2) { const bf16x8 vf = lds_tr_frag2(lds + GL_V + 32 * 272 + c0 * 2, 272, l, 4, 16); acco[ct] = __builtin_amdgcn_mfma_f32_16x16x32_bf16(vf, pf1, acco[ct], 0, 0, 0); }
#pragma unroll
                for (int ks = 0; ks < 2; ++ks) { const bf16x8 sf = *(LAS const bf16x8*)(lds + GL_ST + (c0 + fr) * 144 + 16 * fq + 64 * ks);
                    acco[ct] = __builtin_amdgcn_mfma_f32_16x16x32_bf16(sf, qf[ks], acco[ct], 0, 0, 0); } }
        }
#pragma unroll
        for (int dt = 0; dt < 4; ++dt) { const f32x4 lv = *(LAS const f32x4*)(lds + GL_LAST + (16 * dt + 4 * fq) * 4);
#pragma unroll
            for (int r = 0; r < 4; ++r) accs[dt][r] *= __expf(lv[r]); }
#pragma unroll
        for (int ks = 0; ks < 2; ++ks) { const bf16x8 vf = lds_tr_frag2(lds + GL_V + (32 * ks) * 272 + (16 * w) * 2, 272, l, 8, 4);
#pragma unroll
            for (int dt = 0; dt < 4; ++dt) { const bf16x8 kf = *(LAS const bf16x8*)(lds + GL_KT + (16 * dt + fr) * 144 + 16 * fq + 64 * ks);
                accs[dt] = __builtin_amdgcn_mfma_f32_16x16x32_bf16(kf, vf, accs[dt], 0, 0, 0); } }
        if (PASSC) {
            float ss = 0.f, sm_ = 0.f;
#pragma unroll
            for (int ct = 0; ct < 4; ++ct)
#pragma unroll
                for (int r = 0; r < 4; ++r) { ss += acco[ct][r] * acco[ct][r]; sm_ += acco[ct][r]; }
            ss += __shfl_xor(ss, 16); ss += __shfl_xor(ss, 32); sm_ += __shfl_xor(sm_, 16); sm_ += __shfl_xor(sm_, 32);
            if (fq == 0) { *(LAS float*)(lds + GL_RED + ((16 * it + fr) * 2 + ch) * 4) = ss; *(LAS float*)(lds + GL_RED2 + ((16 * it + fr) * 2 + ch) * 4) = sm_; }
        }
        WGSYNC();
        if (PASSC) {
            const int i = 16 * it + fr;
            const float ssum = *(LAS const float*)(lds + GL_RED + (i * 2) * 4) + *(LAS const float*)(lds + GL_RED + (i * 2 + 1) * 4);
            const float msum = *(LAS const float*)(lds + GL_RED2 + (i * 2) * 4) + *(LAS const float*)(lds + GL_RED2 + (i * 2 + 1) * 4);
            float mean, rstd;
            if (gla) { mean = 0.f; rstd = rsqrtf(ssum * (1.f / 128.f) + NORM_EPS); }
            else { mean = msum * (1.f / 128.f); const float var = fmaxf(ssum * (1.f / 128.f) - mean * mean, 0.f); rstd = rsqrtf(var + NORM_EPS); }
#pragma unroll
            for (int ct = 0; ct < 4; ++ct) { const int c = 128 * h + 64 * ch + 16 * ct + 4 * fq; const f32x4 gn = gnv[ct], bs = bsv[ct];
                const float g0 = bflo(gates[ct].x), g1 = bfhi(gates[ct].x), g2 = bflo(gates[ct].y), g3 = bfhi(gates[ct].y);
                u32x2 ow; ow.x = cvt_pk_bf16(((acco[ct][0] - mean) * rstd * gn[0] + bs[0]) * g0, ((acco[ct][1] - mean) * rstd * gn[1] + bs[1]) * g1);
                ow.y = cvt_pk_bf16(((acco[ct][2] - mean) * rstd * gn[2] + bs[2]) * g2, ((acco[ct][3] - mean) * rstd * gn[3] + bs[3]) * g3);
                *(u32x2*)(gp.O + (row0 + i) * OLD + ooff + c) = ow; }
#pragma unroll
            for (int dt = 0; dt < 4; ++dt) { u32x2 wv; wv.x = cvt_pk_bf16(accs[dt][0], accs[dt][1]); wv.y = cvt_pk_bf16(accs[dt][2], accs[dt][3]);
                *(LAS u32x2*)(lds + GL_ST + (16 * w + fr) * 144 + 32 * dt + 8 * fq) = wv; }
        }
    }
#undef GL_ISSUE
    if (!PASSC) {
        float* sg = gp.SSEG + (size_t)(sidx + seg) * 8192 + tid * 16;
#pragma unroll
        for (int dt = 0; dt < 4; ++dt) *(f32x4*)(sg + 4 * dt) = accs[dt];
        if (l == 0) {
#pragma unroll
            for (int e = 0; e < 8; ++e) gp.DSUM[(size_t)(sidx + seg) * 64 + 8 * w + e] = dsum[e]; }
    }
    WGSYNC();
}

constexpr int LR_XC = 0, LR_XCF = 2304, LR_AA = 6400, LR_GG = 10496, LR_WAVE = 14592;
struct LruP { const bf16_t* P; const float* cw; const float* cb; const float* ba; const float* bx; const float* sp8; const bf16_t* lw; bf16_t* O; float* LST; };
template <bool PASSC>
__device__ __forceinline__ void lru_wave(LAS unsigned char* lw_, const LruP& lp, const int b, const int seg, const int n, const int l) {
    const int fr = l & 15, fq = l >> 4, ch = 64 * n + l;
    bf16x8 wB[8][2];
#pragma unroll
    for (int jt = 0; jt < 8; ++jt)
#pragma unroll
        for (int ks = 0; ks < 2; ++ks) wB[jt][ks] = *(const bf16x8*)(lp.lw + ((size_t)(n * 128 + 16 * jt + fr)) * 64 + 8 * fq + 32 * ks);
    const float w0 = lp.cw[ch], w1 = lp.cw[512 + ch], w2 = lp.cw[1024 + ch], w3 = lp.cw[1536 + ch], cbv = lp.cb[ch];
    float bav[4], bxv[4], spv[4];
#pragma unroll
    for (int jt = 0; jt < 4; ++jt) { const int c2 = 64 * n + 16 * jt + fr; bav[jt] = lp.ba[c2]; bxv[jt] = lp.bx[c2]; spv[jt] = lp.sp8[c2]; }
    const size_t rowb = (size_t)b * SEQ + seg * 128;
    float xm3 = 0.f, xm2 = 0.f, xm1 = 0.f;
    if (seg > 0) { xm3 = bf2f(lp.P[(rowb - 3) * PLD + P_LX + ch]); xm2 = bf2f(lp.P[(rowb - 2) * PLD + P_LX + ch]); xm1 = bf2f(lp.P[(rowb - 1) * PLD + P_LX + ch]); }
    float hst = 0.f, ap = 1.f;
    if (PASSC) { const float* st = lp.LST + ((size_t)b * NSEGL * 512 + ch) * 2;
        pg8::f32x2_ ah[31];
#pragma unroll
        for (int e = 0; e < 31; ++e) { const int sp = e < seg ? e : 0; ah[e] = *(const pg8::f32x2_*)(st + (size_t)sp * 1024); }
#pragma unroll
        for (int e = 0; e < 31; ++e) if (e < seg) hst = ah[e][0] * hst + ah[e][1]; }
    bf16_t xn[16], gn[16];
#pragma unroll
    for (int t = 0; t < 16; ++t) { xn[t] = lp.P[(rowb + t) * PLD + P_LX + ch]; gn[t] = PASSC ? lp.P[(rowb + t) * PLD + P_LG + ch] : (bf16_t)0; }
    for (int sb = 0; sb < 8; ++sb) {
        const size_t r0 = rowb + sb * 16;
        float xf[16], gr[16];
#pragma unroll
        for (int t = 0; t < 16; ++t) { xf[t] = bf2f(xn[t]); gr[t] = bf2f(gn[t]); }
        if (sb < 7) {
#pragma unroll
            for (int t = 0; t < 16; ++t) { xn[t] = lp.P[(r0 + 16 + t) * PLD + P_LX + ch]; if (PASSC) gn[t] = lp.P[(r0 + 16 + t) * PLD + P_LG + ch]; } }
#pragma unroll
        for (int t = 0; t < 16; ++t) { const float x0 = xf[t]; const float xc = cbv + w0 * xm3 + w1 * xm2 + w2 * xm1 + w3 * x0; xm3 = xm2; xm2 = xm1; xm1 = x0;
            *(LAS bf16_t*)(lw_ + LR_XC + t * 144 + l * 2) = f2bf(xc); *(LAS float*)(lw_ + LR_XCF + t * 256 + l * 4) = xc; }
        __builtin_amdgcn_wave_barrier();
        f32x4 acc[8];
#pragma unroll
        for (int jt = 0; jt < 8; ++jt) acc[jt] = (f32x4){0.f, 0.f, 0.f, 0.f};
#pragma unroll
        for (int ks = 0; ks < 2; ++ks) { const bf16x8 af = *(LAS const bf16x8*)(lw_ + LR_XC + fr * 144 + 16 * fq + 64 * ks);
#pragma unroll
            for (int jt = 0; jt < 8; ++jt) acc[jt] = __builtin_amdgcn_mfma_f32_16x16x32_bf16(af, wB[jt][ks], acc[jt], 0, 0, 0); }
#pragma unroll
        for (int jt = 0; jt < 4; ++jt)
#pragma unroll
            for (int r = 0; r < 4; ++r) { const int tok = 4 * fq + r, j = 16 * jt + fr;
                const float rg = sigmoid_f(acc[jt][r] + bav[jt]), ig = sigmoid_f(acc[4 + jt][r] + bxv[jt]);
                const float log_a = -rg * spv[jt]; const float av = __expf(log_a);
                const float xcv = *(LAS const float*)(lw_ + LR_XCF + tok * 256 + j * 4);
                *(LAS float*)(lw_ + LR_AA + tok * 256 + j * 4) = av; const float em = fmaf(-av, av, 1.f);
                *(LAS float*)(lw_ + LR_GG + tok * 256 + j * 4) = xcv * ig * sqrtf(fmaxf(em, 0.f)); }
        __builtin_amdgcn_wave_barrier();
#pragma unroll
        for (int t = 0; t < 16; ++t) { const float av = *(LAS const float*)(lw_ + LR_AA + t * 256 + l * 4), gv = *(LAS const float*)(lw_ + LR_GG + t * 256 + l * 4);
            hst = av * hst + gv; ap *= av;
            if (PASSC) lp.O[(r0 + t) * OLD + 1024 + ch] = f2bf(hst * gr[t]); }
        __builtin_amdgcn_wave_barrier();
    }
    if (!PASSC) { float* st = lp.LST + (((size_t)b * NSEGL + seg) * 512 + ch) * 2; st[0] = ap; st[1] = hst; }
}

constexpr int S5_BU = 0, S5_X = 8448, S5_WAVE = 8448 + 4352;
struct S5P { const bf16_t* P; const float* sm; const bf16_t* ct; const bf16_t* bbt; const float* a128; const float* dd; bf16_t* Y5; float* SST; };
template <bool PASSC>
__device__ __forceinline__ void s5_wave(LAS unsigned char* lw_, const S5P& sp_, const int b, const int seg, const int g, const int l) {
    const int fr = l & 15, fq = l >> 4;
    const bf16x8 zf = (bf16x8){0, 0, 0, 0, 0, 0, 0, 0};
    bf16x8 bbf[8];
#pragma unroll
    for (int mt = 0; mt < 8; ++mt) bbf[mt] = fq < 2 ? *(const bf16x8*)(sp_.bbt + ((size_t)(g * 128 + 16 * mt + fr)) * 16 + 8 * fq) : zf;
    const float abr = sp_.sm[SM_ABR + g * 64 + l], abi = sp_.sm[SM_ABI + g * 64 + l];
    float xr = 0.f, xi = 0.f;
    bf16x8 cf[4]; f32x4 dv4 = (f32x4){0.f, 0.f, 0.f, 0.f};
    if (PASSC) {
        const float ar = sp_.a128[(g * 64 + l) * 2], ai = sp_.a128[(g * 64 + l) * 2 + 1];
        const float* st = sp_.SST + ((size_t)b * NSEGS * 32 + g) * 128 + l;
        for (int sp0 = 0; sp0 < seg; sp0 += 8) { float er[8], ei[8];
#pragma unroll
            for (int e = 0; e < 8; ++e) { const int sp = sp0 + e < seg ? sp0 + e : seg - 1; er[e] = st[(size_t)sp * 4096]; ei[e] = st[(size_t)sp * 4096 + 64]; }
#pragma unroll
            for (int e = 0; e < 8; ++e) if (sp0 + e < seg) { const float nr = ar * xr - ai * xi + er[e], ni = ar * xi + ai * xr + ei[e]; xr = nr; xi = ni; } }
#pragma unroll
        for (int ks = 0; ks < 4; ++ks) cf[ks] = *(const bf16x8*)(sp_.ct + ((size_t)(g * 16 + fr)) * 128 + 8 * fq + 32 * ks);
        dv4 = *(const f32x4*)(sp_.dd + 16 * g + 4 * fq);
    }
    const size_t rowb = (size_t)b * SEQ + seg * 512;
    bf16x8 ufn = fq < 2 ? *(const bf16x8*)(sp_.P + (rowb + fr) * PLD + P_SU + 16 * g + 8 * fq) : zf;
    u32x2 usn = PASSC ? *(const u32x2*)(sp_.P + (rowb + fr) * PLD + P_SU + 16 * g + 4 * fq) : (u32x2){0u, 0u};
    for (int sb = 0; sb < 32; ++sb) {
        const size_t r0 = rowb + sb * 16;
        const bf16x8 uf = ufn; const u32x2 us = usn;
        if (sb < 31) { ufn = fq < 2 ? *(const bf16x8*)(sp_.P + (r0 + 16 + fr) * PLD + P_SU + 16 * g + 8 * fq) : zf;
            if (PASSC) usn = *(const u32x2*)(sp_.P + (r0 + 16 + fr) * PLD + P_SU + 16 * g + 4 * fq); }
#pragma unroll
        for (int mt = 0; mt < 8; ++mt) { f32x4 bu = (f32x4){0.f, 0.f, 0.f, 0.f}; bu = __builtin_amdgcn_mfma_f32_16x16x32_bf16(bbf[mt], uf, bu, 0, 0, 0);
            *(LAS f32x4*)(lw_ + S5_BU + fr * 528 + (16 * mt + 4 * fq) * 4) = bu; }
        __builtin_amdgcn_wave_barrier();
        pg8::f32x2_ buv[16];
#pragma unroll
        for (int t = 0; t < 16; ++t) buv[t] = *(LAS const pg8::f32x2_*)(lw_ + S5_BU + t * 528 + l * 8);
#pragma unroll
        for (int t = 0; t < 16; ++t) {
            const pg8::f32x2_ bu = buv[t];
            const float nr = abr * xr - abi * xi + bu[0], ni = abr * xi + abi * xr + bu[1]; xr = nr; xi = ni;
            if (PASSC) *(LAS unsigned*)(lw_ + S5_X + t * 272 + l * 4) = cvt_pk_bf16(xr, xi);
        }
        __builtin_amdgcn_wave_barrier();
        if (PASSC) {
            f32x4 acc = (f32x4){0.f, 0.f, 0.f, 0.f};
#pragma unroll
            for (int ks = 0; ks < 4; ++ks) { const bf16x8 xf = *(LAS const bf16x8*)(lw_ + S5_X + fr * 272 + 16 * fq + 64 * ks);
                acc = __builtin_amdgcn_mfma_f32_16x16x32_bf16(cf[ks], xf, acc, 0, 0, 0); }
            u32x2 yw; yw.x = cvt_pk_bf16(gelu_tanh_f(acc[0] + dv4[0] * bflo(us.x)), gelu_tanh_f(acc[1] + dv4[1] * bfhi(us.x))); yw.y = cvt_pk_bf16(gelu_tanh_f(acc[2] + dv4[2] * bflo(us.y)), gelu_tanh_f(acc[3] + dv4[3] * bfhi(us.y)));
            *(u32x2*)(sp_.Y5 + (r0 + fr) * BW + 16 * g + 4 * fq) = yw;
            __builtin_amdgcn_wave_barrier();
        }
    }
    if (!PASSC) { float* st = sp_.SST + (((size_t)b * NSEGS + seg) * 32 + g) * 128 + l; st[0] = xr; st[64] = xi; }
}

template <bool PASSC>
__device__ __forceinline__ void phase_mixers(LAS unsigned char* lds, const Args& a, const int l, const int G) {
    const int mmask = a.mmask;
    unsigned char* ws = a.ws; const float* sm = (const float*)(ws + WS_SMALL + (size_t)l * SMALL_STRIDE);
    const bf16_t* P = (const bf16_t*)(ws + WS_P); float* ST = (float*)(ws + WS_ST);
    if (mmask & 1) { GlaP gp0{P, (const float*)(ws + WS_LA), a.in[I_GNG] + l * 512, nullptr, (bf16_t*)(ws + WS_O), ST + ST_GSEG, ST + ST_GDS};
      GlaP gp1{P, (const float*)(ws + WS_LA), a.in[I_RNG] + l * 512, a.in[I_RNB] + l * 512, (bf16_t*)(ws + WS_O), ST + ST_GSEG, ST + ST_GDS};
      for (int itx = blockIdx.x; itx < 2 * BG * 4 * NSEGG; itx += G) { const int mix = itx / (BG * 4 * NSEGG), rest = itx % (BG * 4 * NSEGG), b = rest / (4 * NSEGG), h = (rest / NSEGG) & 3, seg = rest % NSEGG;
          const int sidx = ((mix * BG + b) * 4 + h) * NSEGG;
          if (!PASSC && seg == NSEGG - 1) continue;
          if (mix == 0) glaret_item<PASSC>(lds, gp0, true, b, h, seg, sidx); else glaret_item<PASSC>(lds, gp1, false, b, h, seg, sidx); } }
    int tid = threadIdx.x; asm volatile("" : "+v"(tid));
    const int w = __builtin_amdgcn_readfirstlane(tid >> 6), ln = tid & 63;
    if (mmask & 2) { LruP lp{P, a.in[I_LCW] + l * 2048, a.in[I_LCB] + l * 512, a.in[I_LBA] + l * 512, a.in[I_LBX] + l * 512, sm + SM_SP8, (const bf16_t*)((const unsigned char*)sm + SM_LRUW_BYTES), (bf16_t*)(ws + WS_O), ST + ST_LRU};
      for (int itx = blockIdx.x; itx < BG * NSEGL; itx += G) { if (!PASSC && itx % NSEGL == NSEGL - 1) continue; lru_wave<PASSC>(lds + w * LR_WAVE, lp, itx / NSEGL, itx % NSEGL, w, ln); } }
    if (mmask & 4) { S5P sp_{P, sm, (const bf16_t*)((const unsigned char*)sm + SM_CT_BYTES), (const bf16_t*)((const unsigned char*)sm + SM_BBT_BYTES), sm + SM_A128, a.in[I_SD] + l * 512, (bf16_t*)(ws + WS_Y5), ST + ST_S5};
      for (int itx = blockIdx.x; itx < BG * NSEGS * 4; itx += G) { if (!PASSC && (itx >> 2) % NSEGS == NSEGS - 1) continue; s5_wave<PASSC>(lds + w * LR_WAVE, sp_, itx / (NSEGS * 4), (itx >> 2) % NSEGS, 8 * (itx & 3) + w, ln); } }
    WGSYNC();
}

constexpr int NPH = 8, NSTEPS = 1 + NGRP * DEPTH * NPH;
constexpr int LDS_BYTES = 147456, LDS_MISC = 131072 + 320;

__global__ void __launch_bounds__(512, 2) mk_fwd(Args a) {
    __shared__ __attribute__((aligned(16))) unsigned char lds_raw[LDS_BYTES];
    LAS unsigned char* lds = (LAS unsigned char*)lds_raw;
    volatile LAS unsigned* MISC = (volatile LAS unsigned*)(lds + LDS_MISC);
    const int G = gridDim.x;
    if (threadIdx.x < 32) MISC[threadIdx.x] = 0u;
    __syncthreads();
    unsigned* ctl = (unsigned*)(a.ws + WS_CTL);
    XcdBarrier bar = xcd_barrier_post(ctl + CW_BAR + a.li * XCD_BAR_WORDS, MISC + 8);
    const int ngw = G * 8, gthreads = G * 512;
#define LTID(v) int v = threadIdx.x; asm volatile("" : "+v"(v))
#define IN(s) (a.s_lo <= (s) && (s) < a.s_hi)
#define SEAM(s) do { if ((s) + 1 < a.s_hi) xcd_barrier(bar); } while (0)
    if (IN(0)) { LTID(t_); phase_prologue(a, blockIdx.x * 512 + t_, gthreads); SEAM(0); }
    for (int gl = 0; gl < NGRP * DEPTH; ++gl) {
        const int grp = gl >> 2, l = gl & 3, s0 = 1 + gl * NPH;
        if (a.s_hi <= s0 || a.s_lo >= s0 + NPH) continue;
        unsigned char* ws = a.ws;
        const bf16_t* Wl = (const bf16_t*)(ws + WS_W + (size_t)l * W_STRIDE);
        const float* sm = (const float*)(ws + WS_SMALL + (size_t)l * SMALL_STRIDE);
        bf16_t* U = (bf16_t*)(ws + WS_U); bf16_t* P = (bf16_t*)(ws + WS_P); float* LA = (float*)(ws + WS_LA);
        bf16_t* O = (bf16_t*)(ws + WS_O); bf16_t* Y5 = (bf16_t*)(ws + WS_Y5); bf16_t* PGb = (bf16_t*)(ws + WS_PG);
        const float* xg = a.in[I_X] + (size_t)grp * TG * D; float* og = a.out + (size_t)grp * TG * D;
        const float* hin = (l <= 1) ? xg : og;
        bf16_t* DLT = (bf16_t*)(ws + WS_O);
        (void)sm;
        if (IN(s0 + 0)) { LTID(t_); const int gw_ = blockIdx.x * 8 + __builtin_amdgcn_readfirstlane(t_ >> 6);
            if (l == 0) phase_norm<false, false>(hin, DLT, og, a.in[I_NG] + l * D, U, gw_, ngw, t_ & 63); else phase_norm<false, true>(hin, DLT, og, a.in[I_NG] + l * D, U, gw_, ngw, t_ & 63);
            SEAM(s0 + 0); }
        if (IN(s0 + 1)) {
            pg8::Gemm g{U, Wl, TG, N_ALL, D, D, D, 0, 0}; pg8::StaticOrder S; S.init(TG, N_ALL, G, (int)blockIdx.x);
            EpiIn E{P, LA, a.in[I_GBLR] + l * 256, (const float*)(ws + WS_ROT), PGb};
            GEMM_CALL(EpiIn);
            SEAM(s0 + 1);
        }
        if (IN(s0 + 2)) { phase_mixers<false>(lds, a, l, G); SEAM(s0 + 2); }
        if (IN(s0 + 3)) { phase_mixers<true>(lds, a, l, G); SEAM(s0 + 3); }
        if (IN(s0 + 4)) {
            { pg8::Gemm g{Y5, (const bf16_t*)((const unsigned char*)Wl + WO_GLU), TG, BW, BW, BW, BW, 0, 0}; pg8::StaticOrder S; S.init(TG, BW, G, (int)blockIdx.x);
              EpiGlu E{Y5, P, a.in[I_SGB] + l * BW, O};
              GEMM_CALL(EpiGlu); }
            SEAM(s0 + 4);
        }
        if (IN(s0 + 6)) {
            { pg8::Gemm g{O, (const bf16_t*)((const unsigned char*)Wl + WO_BR), TG, D, BW, OLD, BW, (size_t)BW * 2, (size_t)D * BW * 2}; pg8::StaticOrder S; S.init(TG, D, G, (int)blockIdx.x, 2, 128);
              EpiBr E{PGb, U};
              pg8::gemm_phase<EpiBr, pg8::StaticOrder, true, true, true>(lds, g, S, E); }
            SEAM(s0 + 6);
        }
        if (IN(s0 + 7)) {
            if (a.fin != 2) { pg8::Gemm g{U, (const bf16_t*)((const unsigned char*)Wl + WO_OUT), TG, D, D, D, D, 0, 0}; pg8::StaticOrder S; S.init(TG, D, G, (int)blockIdx.x);
              EpiOut E{DLT};
              GEMM_CALL(EpiOut); }
            if (l == 3 && a.fin) { if (a.fin == 1) xcd_barrier(bar); LTID(t_); phase_norm<true, true>(og, DLT, og, a.in[I_FNG], U, blockIdx.x * 8 + __builtin_amdgcn_readfirstlane(t_ >> 6), ngw, t_ & 63); }
            SEAM(s0 + 7);
        }
    }
#undef IN
#undef SEAM
}

extern "C" void kernel_launch(void* const* d_in, const int* in_sizes, int n_in, void* d_out, int out_size, void* d_ws, size_t ws_size, hipStream_t stream) {
    static int grid = 0;
    if (grid == 0) {
        static const int exp_sizes[29] = {67108864, 4096, 21037056, 16384, 1024, 2048, 2048, 2048, 8192, 2048, 131072, 2048, 131072, 2048, 2048, 8192, 8192, 131072, 131072, 131072, 131072, 2048, 128, 1048576, 2048, 16777216, 8388608, 4194304, 1024};
        bool ok_sizes = (n_in == 29); if (ok_sizes) for (int i = 0; i < 29; ++i) if (in_sizes[i] != exp_sizes[i]) { fprintf(stderr, "kernel_launch: input %d has %d elements, expected %d\n", i, in_sizes[i], exp_sizes[i]); ok_sizes = false; }
        if (!ok_sizes || out_size != NB * SEQ * D || ws_size < WS_END) { fprintf(stderr, "kernel_launch: unexpected shapes (n_in %d out %d ws %zu)\n", n_in, out_size, ws_size); grid = -1; return; }
        int dev = 0, cus = 0, per_cu = 0;
        hipGetDevice(&dev); hipDeviceGetAttribute(&cus, hipDeviceAttributeMultiprocessorCount, dev);
        hipOccupancyMaxActiveBlocksPerMultiprocessor(&per_cu, (const void*)mk_fwd, 512, 0);
        (void)hipGetLastError();
        grid = cus > 0 ? cus : 256;
        if (per_cu < 1) fprintf(stderr, "kernel_launch: occupancy query says %d\n", per_cu);
    }
    if (grid < 0) return;
    hipMemsetAsync((char*)d_ws + WS_CTL, 0, CTL_BYTES, stream);
    Args a{};
    for (int i = 0; i < 29; ++i) a.in[i] = (const float*)d_in[i];
    a.out = (float*)d_out; a.ws = (unsigned char*)d_ws;
    unsigned char* ws = (unsigned char*)d_ws;
    int li = 0;
    auto run = [&](int lo, int hi, int fin = 1, int mm = 7) { a.s_lo = lo; a.s_hi = hi; a.li = li++; a.fin = fin; a.mmask = mm; a.pad2 = 0; hipLaunchKernelGGL(mk_fwd, dim3(grid), dim3(512), 0, stream, a); };
    run(0, NSTEPS);
}
```

```cpp
#include <hip/hip_runtime.h>
#ifndef WGM_G1
#define WGM_G1 4
#endif
#ifndef WGM_G2
#define WGM_G2 8
#endif
#ifndef WGM_G3
#define WGM_G3 8
#endif
#ifndef WGM_GLU
#define WGM_GLU 8
#endif
#include <cstdio>
#include <cstdint>


namespace pg8 {
#define PG8_LAS __attribute__((address_space(3)))
typedef unsigned short bf16_t;
typedef short bf16x8 __attribute__((ext_vector_type(8)));
typedef float f32x4 __attribute__((ext_vector_type(4)));
typedef unsigned u32x4 __attribute__((ext_vector_type(4)));
typedef unsigned u32x2 __attribute__((ext_vector_type(2)));
constexpr int BM = 256, BK = 64, HALF = 128, HTB = HALF * BK * 2, STAGE_BYTES = 8 * HTB, NXCD = 8;

__host__ __device__ __forceinline__ int lds_byte(int r, int c) { const int st = (r >> 4) * 2 + (c >> 5), rr = r & 15, cc = c & 31, ob = rr * 64 + cc * 2; return st * 1024 + (ob ^ (((ob >> 9) & 1) << 5)); }
__host__ __device__ __forceinline__ void stage_rc(int b, int& R, int& C) { const int st = b / 1024, sb = b % 1024, swz = sb ^ (((sb >> 9) & 1) << 5); R = (st >> 1) * 16 + swz / 64; C = (st & 1) * 32 + (swz % 64) / 2; }
__host__ __device__ __forceinline__ int perm32(int rho) { const int n = rho >> 4, i = rho & 15; return 8 * (i >> 2) + 4 * n + (i & 3); }

struct Unit { int pm, pn, z; };
struct Gemm { const bf16_t* A; const bf16_t* Bt; int M, N, K, lda, ldb; size_t zA, zB; };

struct StaticOrder {
    int nM, nN, nwg, G, c, zsh, WGM;
    __host__ __device__ void init(int M, int N, int G_, int c_, int zsh_ = 0, int bn_ = BM, int wgm_ = 4) { nM = M / BM; nN = N / bn_; nwg = nM * nN; G = G_; c = c_; zsh = zsh_; WGM = wgm_; }
    __host__ __device__ bool next(int i, Unit& u) const {
        const int ti = i >> zsh; u.z = i & ((1 << zsh) - 1);
        const long L = (long)ti * G + c; if (L >= nwg) return false;
        int wgid = (int)L; { const int q = nwg / NXCD, r = nwg % NXCD, xcd = wgid % NXCD, off = wgid / NXCD; wgid = (xcd < r ? xcd * (q + 1) : r * (q + 1) + (xcd - r) * q) + off; }
        const int nig = WGM * nN, gid = wgid / nig, fm = gid * WGM, gsz = (nM - fm) < WGM ? (nM - fm) : WGM;
        u.pm = fm + ((wgid % nig) % gsz); u.pn = (wgid % nig) / gsz; return true;
    }
    __device__ __forceinline__ void a_ready(const Unit&) const {}
    __device__ __forceinline__ void done(const Unit&) const {}
};

typedef float f32x2_ __attribute__((ext_vector_type(2)));
typedef __bf16 bf16x2_ __attribute__((ext_vector_type(2)));
__device__ __forceinline__ unsigned cvt_pk_bf16(float lo, float hi) { const f32x2_ v = {lo, hi}; const bf16x2_ b = __builtin_convertvector(v, bf16x2_); return __builtin_bit_cast(unsigned, b); }

template <class Epi, class Sched, bool ALIGN_EPI = false, bool SP2 = false, bool HALFN = false>
__device__ __forceinline__ void gemm_phase(PG8_LAS unsigned char* lds, const Gemm g, const Sched& S, const Epi& E) {
    int tid = threadIdx.x; asm volatile("" : "+v"(tid));
    const int wid = __builtin_amdgcn_readfirstlane(tid >> 6), lane = tid & 63, wr = wid >> 2, wc = wid & 3, fr = lane & 15, fq = lane >> 4;
    const int K = g.K, nt = K / BK;
    unsigned voffA[2], voffB[2];
#pragma unroll
    for (int i = 0; i < 2; ++i) { int R, C; stage_rc(tid * 16 + i * 8192, R, C); const int Rb = Epi::PERM ? ((R & ~31) + perm32(R & 31)) : R;
        voffA[i] = (unsigned)(R * g.lda + C) * 2u; voffB[i] = (unsigned)(Rb * g.ldb + C) * 2u; }
    const size_t kstep = (size_t)(BK * 2);
    const size_t hstepA = (size_t)HALF * g.lda * 2, hstepB = (size_t)HALF * g.ldb * 2;
    const size_t tstepA = 2 * hstepA, tstepB = HALFN ? hstepB : 2 * hstepB;
    const unsigned ldsw = (unsigned)wid * 1024u;
    unsigned aoff = (unsigned)lds_byte(wr * 64 + fr, fq * 8), boff = (unsigned)lds_byte(wc * 32 + fr, fq * 8) + 4u * HTB;
    asm volatile("" : "+v"(aoff), "+v"(boff));
#define PG8_SA(b, h) (((b) * 2 + (h)) * HTB)
#define PG8_SB(b, h) ((4 + (b) * 2 + (h)) * HTB)
#define PG8_STAGE(bufoff, gbase, voff) do { _Pragma("unroll") for (int _i = 0; _i < 2; ++_i) \
        __builtin_amdgcn_global_load_lds((const unsigned*)((const char*)(gbase) + (voff)[_i]), (PG8_LAS unsigned*)(lds + (bufoff) + ldsw + _i * 8192), 16, 0, 0); } while (0)
#define PG8_LDA(dst, b, h) do { _Pragma("unroll") for (int m = 0; m < 4; ++m) _Pragma("unroll") for (int k = 0; k < 2; ++k) dst[m][k] = *(const PG8_LAS bf16x8*)(lds + aoff + (PG8_SA(b, h) + m * 2048 + k * 1024)); } while (0)
#define PG8_LDB(dst, b, h) do { _Pragma("unroll") for (int n = 0; n < 2; ++n) _Pragma("unroll") for (int k = 0; k < 2; ++k) dst[n][k] = *(const PG8_LAS bf16x8*)(lds + boff + (((b) * 2 + (h)) * HTB + n * 2048 + k * 1024)); } while (0)
#define PG8_MMA(ai, bj, At, Bt) do { __builtin_amdgcn_s_setprio(1); _Pragma("unroll") for (int m = 0; m < 4; ++m) _Pragma("unroll") for (int n = 0; n < 2; ++n) _Pragma("unroll") for (int k = 0; k < 2; ++k) \
        acc[ai][bj][m][n] = __builtin_amdgcn_mfma_f32_16x16x32_bf16(Bt[n][k], At[m][k], acc[ai][bj][m][n], 0, 0, 0); __builtin_amdgcn_s_setprio(0); } while (0)
#define PG8_WAIT_V(n) asm volatile("s_waitcnt vmcnt(" #n ")" ::: "memory")
#define PG8_WAIT_L(n) asm volatile("s_waitcnt lgkmcnt(" #n ")" ::: "memory")
#define PG8_BAR __builtin_amdgcn_s_barrier()
#define PG8_SCHED __builtin_amdgcn_sched_barrier(0)
    Unit cur, nxt; int ui = 0;
    if (!S.next(0, cur)) return;
    f32x4 acc[2][2][4][2];
#pragma unroll
    for (int a = 0; a < 2; ++a)
#pragma unroll
        for (int b = 0; b < 2; ++b)
#pragma unroll
            for (int m = 0; m < 4; ++m)
#pragma unroll
                for (int n = 0; n < 2; ++n) acc[a][b][m][n] = (f32x4){0.f, 0.f, 0.f, 0.f};
    bf16x8 At[4][2], B0[2][2], B1[2][2];
    const char* cA = (const char*)g.A + (size_t)cur.pm * tstepA + (size_t)cur.z * g.zA; const char* cB = (const char*)g.Bt + (size_t)cur.pn * tstepB + (size_t)cur.z * g.zB;
    S.a_ready(cur);
    if constexpr (SP2 && HALFN) {
        PG8_STAGE(PG8_SB(0, 0), cB, voffB); PG8_STAGE(PG8_SA(0, 0), cA, voffA); PG8_STAGE(PG8_SA(0, 1), cA + hstepA, voffA);
        if (wr == 1) PG8_BAR;
        PG8_WAIT_V(2); PG8_BAR;
        PG8_STAGE(PG8_SB(1, 0), cB + kstep, voffB); PG8_STAGE(PG8_SA(1, 0), cA + kstep, voffA);
        PG8_WAIT_V(4); PG8_BAR;
    } else if constexpr (SP2) {
        PG8_STAGE(PG8_SB(0, 0), cB, voffB); PG8_STAGE(PG8_SB(0, 1), cB + hstepB, voffB); PG8_STAGE(PG8_SA(0, 0), cA, voffA); PG8_STAGE(PG8_SA(0, 1), cA + hstepA, voffA);
        if (wr == 1) PG8_BAR;
        PG8_WAIT_V(2); PG8_BAR;
        PG8_STAGE(PG8_SB(1, 0), cB + kstep, voffB); PG8_STAGE(PG8_SA(1, 0), cA + kstep, voffA); PG8_STAGE(PG8_SB(1, 1), cB + hstepB + kstep, voffB);
        PG8_WAIT_V(6); PG8_BAR;
    } else {
        PG8_STAGE(PG8_SB(0, 0), cB, voffB); PG8_STAGE(PG8_SA(0, 0), cA, voffA); PG8_STAGE(PG8_SB(0, 1), cB + hstepB, voffB); PG8_STAGE(PG8_SA(0, 1), cA + hstepA, voffA);
        if (wr == 1) PG8_BAR;
        PG8_WAIT_V(4); PG8_BAR;
        PG8_STAGE(PG8_SB(1, 0), cB + kstep, voffB); PG8_STAGE(PG8_SA(1, 0), cA + kstep, voffA); PG8_STAGE(PG8_SB(1, 1), cB + hstepB + kstep, voffB);
        PG8_WAIT_V(6); PG8_BAR;
    }
    for (;;) {
        const bool has_next = S.next(ui + 1, nxt);
        const char* nA = has_next ? (const char*)g.A + (size_t)nxt.pm * tstepA + (size_t)nxt.z * g.zA : cA; const char* nB = has_next ? (const char*)g.Bt + (size_t)nxt.pn * tstepB + (size_t)nxt.z * g.zB : cB;
        for (int t = 0; t < nt; t += 2) {
            const bool last = (t == nt - 2);
            const char* a1 = cA + (size_t)(t + 1) * kstep;
            const char* a2 = last ? nA : cA + (size_t)(t + 2) * kstep; const char* b2 = last ? nB : cB + (size_t)(t + 2) * kstep;
            const char* a3 = a2 + kstep; const char* b3 = b2 + kstep;
            if (last && has_next) S.a_ready(nxt);
            if constexpr (SP2 && HALFN) {
            PG8_LDB(B0, 0, 0); PG8_SCHED; PG8_LDA(At, 0, 0); PG8_STAGE(PG8_SA(1, 1), a1 + hstepA, voffA);
            PG8_WAIT_V(6); PG8_WAIT_L(0); PG8_BAR; PG8_MMA(0, 0, At, B0); PG8_BAR; PG8_SCHED;
            PG8_LDA(At, 0, 1); PG8_STAGE(PG8_SB(0, 0), b2, voffB); PG8_STAGE(PG8_SA(0, 0), a2, voffA);
            PG8_WAIT_V(6); PG8_WAIT_L(0); PG8_BAR; PG8_MMA(1, 0, At, B0); PG8_BAR; PG8_SCHED;
            PG8_LDB(B0, 1, 0); PG8_SCHED; PG8_LDA(At, 1, 0); PG8_STAGE(PG8_SA(0, 1), a2 + hstepA, voffA);
            PG8_WAIT_V(6); PG8_WAIT_L(0); PG8_BAR; PG8_MMA(0, 0, At, B0); PG8_BAR; PG8_SCHED;
            PG8_LDA(At, 1, 1); PG8_STAGE(PG8_SB(1, 0), b3, voffB); PG8_STAGE(PG8_SA(1, 0), a3, voffA);
            PG8_WAIT_V(6); PG8_WAIT_L(0); PG8_BAR; PG8_MMA(1, 0, At, B0); PG8_BAR; PG8_SCHED;
            } else if constexpr (SP2) {
            PG8_LDB(B0, 0, 0); PG8_LDB(B1, 0, 1); PG8_SCHED; PG8_LDA(At, 0, 0); PG8_STAGE(PG8_SA(1, 1), a1 + hstepA, voffA);
            PG8_WAIT_V(8); PG8_WAIT_L(0); PG8_BAR; PG8_MMA(0, 0, At, B0); PG8_MMA(0, 1, At, B1); PG8_BAR; PG8_SCHED;
            PG8_LDA(At, 0, 1); PG8_STAGE(PG8_SB(0, 0), b2, voffB); PG8_STAGE(PG8_SB(0, 1), b2 + hstepB, voffB); PG8_STAGE(PG8_SA(0, 0), a2, voffA);
            PG8_WAIT_V(8); PG8_WAIT_L(0); PG8_BAR; PG8_MMA(1, 0, At, B0); PG8_MMA(1, 1, At, B1); PG8_BAR; PG8_SCHED;
            PG8_LDB(B0, 1, 0); PG8_LDB(B1, 1, 1); PG8_SCHED; PG8_LDA(At, 1, 0); PG8_STAGE(PG8_SA(0, 1), a2 + hstepA, voffA);
            PG8_WAIT_V(8); PG8_WAIT_L(0); PG8_BAR; PG8_MMA(0, 0, At, B0); PG8_MMA(0, 1, At, B1); PG8_BAR; PG8_SCHED;
            PG8_LDA(At, 1, 1); PG8_STAGE(PG8_SB(1, 0), b3, voffB); PG8_STAGE(PG8_SB(1, 1), b3 + hstepB, voffB); PG8_STAGE(PG8_SA(1, 0), a3, voffA);
            PG8_WAIT_V(8); PG8_WAIT_L(0); PG8_BAR; PG8_MMA(1, 0, At, B0); PG8_MMA(1, 1, At, B1); PG8_BAR; PG8_SCHED;
            } else {
            PG8_LDB(B0, 0, 0); PG8_SCHED; PG8_LDA(At, 0, 0); PG8_STAGE(PG8_SA(1, 1), a1 + hstepA, voffA);
            PG8_WAIT_L(8); PG8_BAR; PG8_WAIT_L(0); PG8_MMA(0, 0, At, B0); PG8_BAR; PG8_SCHED;
            PG8_LDB(B1, 0, 1); PG8_STAGE(PG8_SB(0, 0), b2, voffB);
            PG8_BAR; PG8_WAIT_L(0); PG8_MMA(0, 1, At, B1); PG8_BAR;
            PG8_LDA(At, 0, 1); PG8_STAGE(PG8_SA(0, 0), a2, voffA);
            PG8_BAR; PG8_WAIT_L(0); PG8_MMA(1, 0, At, B0); PG8_BAR; PG8_SCHED;
            PG8_STAGE(PG8_SB(0, 1), b2 + hstepB, voffB);
            PG8_WAIT_V(6); PG8_BAR; PG8_MMA(1, 1, At, B1); PG8_BAR;
            PG8_LDB(B0, 1, 0); PG8_SCHED; PG8_LDA(At, 1, 0); PG8_STAGE(PG8_SA(0, 1), a2 + hstepA, voffA);
            PG8_WAIT_L(8); PG8_BAR; PG8_WAIT_L(0); PG8_MMA(0, 0, At, B0); PG8_BAR; PG8_SCHED;
            PG8_LDB(B1, 1, 1); PG8_STAGE(PG8_SB(1, 0), b3, voffB);
            PG8_BAR; PG8_WAIT_L(0); PG8_MMA(0, 1, At, B1); PG8_BAR;
            PG8_LDA(At, 1, 1); PG8_STAGE(PG8_SA(1, 0), a3, voffA);
            PG8_BAR; PG8_WAIT_L(0); PG8_MMA(1, 0, At, B0); PG8_BAR; PG8_SCHED;
            PG8_STAGE(PG8_SB(1, 1), b3 + hstepB, voffB);
            PG8_WAIT_V(6); PG8_BAR; PG8_MMA(1, 1, At, B1); PG8_BAR;
            }
        }
        if constexpr (ALIGN_EPI) { if (wr == 0) PG8_BAR; }
        { int fr_e = fr, fq_e = fq; asm volatile("" : "+v"(fr_e), "+v"(fq_e));
          E(acc, cur, wr, wc, fr_e, fq_e); }
        if (!has_next) break;
        if (!HALFN && !(Epi::KEEP && cur.z != 3)) {
#pragma unroll
        for (int a = 0; a < 2; ++a)
#pragma unroll
            for (int b = 0; b < 2; ++b)
#pragma unroll
                for (int m = 0; m < 4; ++m)
#pragma unroll
                    for (int n = 0; n < 2; ++n) acc[a][b][m][n] = (f32x4){0.f, 0.f, 0.f, 0.f};
        }
        cur = nxt; cA = nA; cB = nB; ++ui;
        if constexpr (ALIGN_EPI) { if (wr == 1) PG8_BAR; }
    }
    PG8_WAIT_V(0);
    if constexpr (!ALIGN_EPI) { if (wr == 0) PG8_BAR; }
    PG8_BAR;
#undef PG8_SA
#undef PG8_SB
#undef PG8_STAGE
#undef PG8_LDA
#undef PG8_LDB
#undef PG8_MMA
#undef PG8_WAIT_V
#undef PG8_WAIT_L
#undef PG8_BAR
#undef PG8_SCHED
}

}

using pg8::bf16_t; using pg8::f32x4; using pg8::u32x4; using pg8::u32x2; using pg8::bf16x8; using pg8::cvt_pk_bf16;
#define LAS __attribute__((address_space(3)))

constexpr int D = 1024, SEQ = 4096, NB = 16, DEPTH = 4, BW = 512;
constexpr int NGRP = 2, BG = NB / NGRP, TG = BG * SEQ;
constexpr int N_IN = 21 * 256, N_MG = 4096, N_ALL = N_IN + N_MG;
constexpr int PLD = 20 * 256;
constexpr int P_GQ = 0, P_GK = 256, P_GV = 512, P_GG = 1024, P_RQ = 1536, P_RK = 1792, P_RV = 2048, P_RG = 2560, P_LX = 3072, P_LG = 3584, P_SU = 4096, P_SG = 4608;
constexpr int OLD = 2048;
constexpr float NORM_EPS = 1e-6f;

constexpr size_t MiB = 1u << 20;
constexpr size_t WS_CTL = 0, CTL_BYTES = 2 * MiB;
constexpr size_t WS_ROT = 2 * MiB;
constexpr size_t WS_SMALL = 3 * MiB, SMALL_STRIDE = 1 * MiB;
constexpr size_t WS_W = 8 * MiB, W_STRIDE = 26 * MiB;
constexpr size_t WO_IN = 0, WO_BR = (size_t)N_ALL * D * 2, WO_OUT = WO_BR + (size_t)4 * D * BW * 2, WO_GLU = WO_OUT + (size_t)D * D * 2, WO_END = WO_GLU + (size_t)BW * BW * 2;
static_assert(WO_END <= W_STRIDE, "weights");
constexpr size_t WS_U = 112 * MiB;
constexpr size_t WS_P = 176 * MiB;
constexpr size_t WS_LA = 496 * MiB;
constexpr size_t WS_O = 528 * MiB;
constexpr size_t WS_Y5 = 656 * MiB;
constexpr size_t WS_PG = 688 * MiB;
constexpr size_t WS_ST = 944 * MiB;
constexpr size_t WS_END = 1008 * MiB;
constexpr int SM_ABR = 0, SM_ABI = 2048, SM_BBR = 4096, SM_BBI = 4096 + 32768, SM_SP8 = 4096 + 65536, SM_END_F = SM_SP8 + 512;
constexpr int SM_A128 = SM_END_F;
constexpr size_t SM_LRUW_BYTES = 512 * 1024, SM_CT_BYTES = 640 * 1024, SM_BBT_BYTES = 768 * 1024;
static_assert((size_t)(SM_END_F + 4096) * 4 <= SM_LRUW_BYTES, "small");

constexpr int CW_BAR = 4096;
#define XB_TMO      128
#define XB_XCNT(j)  (256  + 64 * (j))
#define XB_XSUB(j)  (1280 + 64 * (j))
#define XB_XGEN(j)  (2304 + 64 * (j))
#define XB_TOP      3328
#define XB_TOPGEN   3392
#define XCD_BAR_WORDS 3456
#define XB_SPIN_CAP (1u << 18)

__device__ __forceinline__ unsigned xb_ld(unsigned* p)              { return __hip_atomic_load(p, __ATOMIC_RELAXED, __HIP_MEMORY_SCOPE_AGENT); }
__device__ __forceinline__ unsigned xb_add(unsigned* p, unsigned v) { return __hip_atomic_fetch_add(p, v, __ATOMIC_RELAXED, __HIP_MEMORY_SCOPE_AGENT); }
__device__ __forceinline__ unsigned xb_xcc_id() { return (unsigned)__builtin_amdgcn_s_getreg((3 << 11) | 20) & 0xFu; }
#define XB_SPIN(cond, bar) do { unsigned _sp = 0; while (cond) { __builtin_amdgcn_s_sleep(1); \
    if ((++_sp & 255u) == 0u) { if (xb_ld(&(bar)[XB_TMO])) break; if (_sp > XB_SPIN_CAP) { atomicAdd(&(bar)[XB_TMO], 1u); break; } } } } while (0)
struct XcdBarrier { unsigned* bar; unsigned x; volatile LAS unsigned* st; };
__device__ __forceinline__ XcdBarrier xcd_barrier_post(unsigned* bar, volatile LAS unsigned* st) {
    XcdBarrier b; b.bar = bar; b.x = xb_xcc_id(); b.st = st;
    if (threadIdx.x == 0) (void)xb_add(&bar[XB_XCNT(b.x)], 1u);
    return b;
}
__device__ __forceinline__ void xcd_barrier_complete(unsigned* bar, unsigned x, unsigned& nloc, unsigned& nx) {
    const unsigned G = gridDim.x * gridDim.y * gridDim.z;
    unsigned sum, cnt, mine, sp = 0u;
    for (;;) {
        sum = 0u; cnt = 0u; mine = 0u;
#pragma unroll
        for (unsigned j = 0; j < 16; ++j) { const unsigned c = xb_ld(&bar[XB_XCNT(j)]); sum += c; cnt += (c > 0u) ? 1u : 0u; mine = (j == x) ? c : mine; }
        if (sum == G) break;
        __builtin_amdgcn_s_sleep(1);
        if ((++sp & 255u) == 0u) { if (xb_ld(&bar[XB_TMO])) break; if (sp > XB_SPIN_CAP) { atomicAdd(&bar[XB_TMO], 1u); break; } }
    }
    nloc = mine > 0u ? mine : 1u; nx = cnt > 0u ? cnt : 1u;
}
__device__ __forceinline__ void xcd_barrier(const XcdBarrier& b) {
    asm volatile("s_waitcnt vmcnt(0)" ::: "memory");
    __syncthreads();
    if (threadIdx.x == 0) {
        unsigned* bar = b.bar;
        __builtin_amdgcn_s_waitcnt(0);
        unsigned nloc = b.st[0], nx = b.st[1];
        if (nloc == 0u) { xcd_barrier_complete(bar, b.x, nloc, nx); b.st[0] = nloc; b.st[1] = nx; }
        const unsigned old = xb_add(&bar[XB_XSUB(b.x)], 1u);
        const unsigned gen = old / nloc;
        if (old + 1u == (gen + 1u) * nloc) {
            __builtin_amdgcn_fence(__ATOMIC_RELEASE, "agent");
            asm volatile("s_waitcnt vmcnt(0)" ::: "memory");
            const unsigned og = xb_add(&bar[XB_TOP], 1u);
            const unsigned tg = og / nx;
            if (og + 1u == (tg + 1u) * nx) xb_add(&bar[XB_TOPGEN], 1u);
            else XB_SPIN(xb_ld(&bar[XB_TOPGEN]) == tg, bar);
            __builtin_amdgcn_fence(__ATOMIC_ACQUIRE, "agent");
            xb_add(&bar[XB_XGEN(b.x)], 1u);
            asm volatile("s_waitcnt vmcnt(0)" ::: "memory");
        } else {
            XB_SPIN(xb_ld(&bar[XB_XGEN(b.x)]) == gen, bar);
            __builtin_amdgcn_fence(__ATOMIC_ACQUIRE, "agent");
            asm volatile("s_waitcnt vmcnt(0)" ::: "memory");
        }
    }
    __syncthreads();
}

__device__ __forceinline__ float bf2f(bf16_t b) { return __uint_as_float(((unsigned)b) << 16); }
__device__ __forceinline__ float bflo(unsigned w) { return __uint_as_float(w << 16); }
__device__ __forceinline__ float bfhi(unsigned w) { return __uint_as_float(w & 0xffff0000u); }
__device__ __forceinline__ bf16_t f2bf(float f) { return (bf16_t)(cvt_pk_bf16(f, 0.f) & 0xffffu); }
__device__ __forceinline__ float sigmoid_f(float x) { return __builtin_amdgcn_rcpf(1.f + __expf(-x)); }
__device__ __forceinline__ float silu_f(float x) { return x * sigmoid_f(x); }
__device__ __forceinline__ float gelu_tanh_f(float x) { const float u = 0.7978845608028654f * (x + 0.044715f * x * x * x); const float t = 1.f - 2.f * __builtin_amdgcn_rcpf(1.f + __expf(2.f * u)); return 0.5f * x * (1.f + t); }
__device__ __forceinline__ float wave_sum(float v) {
#pragma unroll
    for (int o = 1; o < 64; o <<= 1) v += __shfl_xor(v, o);
    return v;
}

#define GEMM_CALL(EPI) pg8::gemm_phase<EPI, pg8::StaticOrder, true, true>(lds, g, S, E)
struct Args {
    const float* in[29]; float* out; unsigned char* ws;
    int s_lo, s_hi, li, fin, mmask, pad2;
};
enum { I_X = 0, I_NG, I_WIN, I_GWLR, I_GBLR, I_GNG, I_RNG, I_RNB, I_LCW, I_LCB, I_LWA, I_LBA, I_LWX, I_LBX, I_LLAM,
       I_SARE, I_SAIM, I_SBRE, I_SBIM, I_SCRE, I_SCIM, I_SD, I_SLDT, I_SGW, I_SGB, I_WMG, I_WBR, I_WOUT, I_FNG };

struct EpiIn {
    static constexpr bool PERM = true, AFTER_DRAIN = false, KEEP = false;
    bf16_t* P; float* LA; const float* blr; const float* rot; bf16_t* PG;
    __device__ __forceinline__ void operator()(f32x4 (&acc)[2][2][4][2], const pg8::Unit& u, int wr, int wc, int fr, int fq) const {
        const int pn = u.pn, row0 = u.pm * 256 + wr * 64 + fr, cl = wc * 32 + 8 * fq;
        if (pn >= 21) {
            const int c0 = (pn - 21) * 256 + cl;
#pragma unroll
            for (int ai = 0; ai < 2; ++ai)
#pragma unroll
                for (int m = 0; m < 4; ++m) { int row = row0 + ai * 128 + m * 16; asm volatile("" : "+v"(row));
#pragma unroll
                    for (int bj = 0; bj < 2; ++bj) { f32x4 v0 = acc[ai][bj][m][0], v1 = acc[ai][bj][m][1];
#pragma unroll
                        for (int j = 0; j < 4; ++j) { v0[j] = sigmoid_f(v0[j]); v1[j] = sigmoid_f(v1[j]); }
                        u32x4 w; w.x = cvt_pk_bf16(v0[0], v0[1]); w.y = cvt_pk_bf16(v0[2], v0[3]); w.z = cvt_pk_bf16(v1[0], v1[1]); w.w = cvt_pk_bf16(v1[2], v1[3]);
                        __builtin_nontemporal_store(w, (u32x4*)(PG + (size_t)row * N_MG + c0 + bj * 128)); } }
        } else if (pn == 4) {
#pragma unroll
            for (int bj = 0; bj < 2; ++bj) { const int c = cl + bj * 128; const f32x4 b0 = *(const f32x4*)(blr + c), b1 = *(const f32x4*)(blr + c + 4);
#pragma unroll
                for (int ai = 0; ai < 2; ++ai) {
#pragma unroll
                    for (int n = 0; n < 2; ++n)
#pragma unroll
                        for (int j = 0; j < 4; ++j) { float run = 0.f; const float bb = n ? b1[j] : b0[j];
#pragma unroll
                            for (int m = 0; m < 4; ++m) { const float z = acc[ai][bj][m][n][j] + bb; const float x = -(fmaxf(-z, 0.f) + __logf(1.f + __expf(-fabsf(z)))) * 0.0625f; float ls = x, rs = x;
#define DPP_ADD(acc_, ctrl_) acc_ += __builtin_bit_cast(float, __builtin_amdgcn_update_dpp(0, __builtin_bit_cast(int, acc_), ctrl_, 0xf, 0xf, true))
                                DPP_ADD(ls, 0x111); DPP_ADD(ls, 0x112); DPP_ADD(ls, 0x114); DPP_ADD(ls, 0x118);
                                DPP_ADD(rs, 0x101); DPP_ADD(rs, 0x102); DPP_ADD(rs, 0x104); DPP_ADD(rs, 0x108);
#undef DPP_ADD
                                acc[ai][bj][m][n][j] = run + ls; run += ls + rs - x; } }
#pragma unroll
                    for (int m = 0; m < 4; ++m) { int row = row0 + ai * 128 + m * 16; asm volatile("" : "+v"(row)); float* d = LA + (size_t)row * 256 + c; *(f32x4*)d = acc[ai][bj][m][0]; *(f32x4*)(d + 4) = acc[ai][bj][m][1]; } } }
        } else if (pn == 7 || pn == 8) {
            const float sc = pn == 8 ? 0.125f : 1.f; const int dcol = (pn - 1) * 256;
#pragma unroll
            for (int ai = 0; ai < 2; ++ai)
#pragma unroll
                for (int m = 0; m < 4; ++m) { int row = row0 + ai * 128 + m * 16; asm volatile("" : "+v"(row)); const int pos = row & (SEQ - 1);
#pragma unroll
                    for (int bj = 0; bj < 2; ++bj) { const int c = cl + bj * 128, i0 = (c & 63) >> 1; const float* rt = rot + ((size_t)pos * 32 + i0) * 2;
                        const f32x4 cs0 = *(const f32x4*)rt, cs1 = *(const f32x4*)(rt + 4); const f32x4 v0 = acc[ai][bj][m][0] * sc, v1 = acc[ai][bj][m][1] * sc;
                        u32x4 w; w.x = cvt_pk_bf16(v0[0] * cs0[0] - v0[1] * cs0[1], v0[0] * cs0[1] + v0[1] * cs0[0]); w.y = cvt_pk_bf16(v0[2] * cs0[2] - v0[3] * cs0[3], v0[2] * cs0[3] + v0[3] * cs0[2]);
                        w.z = cvt_pk_bf16(v1[0] * cs1[0] - v1[1] * cs1[1], v1[0] * cs1[1] + v1[1] * cs1[0]); w.w = cvt_pk_bf16(v1[2] * cs1[2] - v1[3] * cs1[3], v1[2] * cs1[3] + v1[3] * cs1[2]);
                        __builtin_nontemporal_store(w, (u32x4*)(P + (size_t)row * PLD + dcol + c)); } }
        } else {
            const bool silu = (pn == 5 || pn == 6 || pn == 11 || pn == 12 || pn == 15 || pn == 16 || pn == 19 || pn == 20);
            const float sc = pn == 0 ? 0.125f : 1.f; const int dcol = (pn < 4 ? pn : pn - 1) * 256;
#pragma unroll
            for (int ai = 0; ai < 2; ++ai)
#pragma unroll
                for (int m = 0; m < 4; ++m) { int row = row0 + ai * 128 + m * 16; asm volatile("" : "+v"(row));
#pragma unroll
                    for (int bj = 0; bj < 2; ++bj) { f32x4 v0 = acc[ai][bj][m][0] * sc, v1 = acc[ai][bj][m][1] * sc;
                        if (silu) {
#pragma unroll
                            for (int j = 0; j < 4; ++j) { v0[j] = silu_f(v0[j]); v1[j] = silu_f(v1[j]); } }
                        u32x4 w; w.x = cvt_pk_bf16(v0[0], v0[1]); w.y = cvt_pk_bf16(v0[2], v0[3]); w.z = cvt_pk_bf16(v1[0], v1[1]); w.w = cvt_pk_bf16(v1[2], v1[3]);
                        __builtin_nontemporal_store(w, (u32x4*)(P + (size_t)row * PLD + dcol + cl + bj * 128)); } }
        }
    }
};
struct EpiSig {
    static constexpr bool PERM = true, AFTER_DRAIN = false, KEEP = false;
    bf16_t* PG;
    __device__ __forceinline__ void operator()(const f32x4 (&acc)[2][2][4][2], const pg8::Unit& u, int wr, int wc, int fr, int fq) const {
        const int row0 = u.pm * 256 + wr * 64 + fr, c0 = u.pn * 256 + wc * 32 + 8 * fq;
#pragma unroll
        for (int ai = 0; ai < 2; ++ai)
#pragma unroll
            for (int m = 0; m < 4; ++m) { const int row = row0 + ai * 128 + m * 16;
#pragma unroll
                for (int bj = 0; bj < 2; ++bj) { f32x4 v0 = acc[ai][bj][m][0], v1 = acc[ai][bj][m][1];
#pragma unroll
                    for (int j = 0; j < 4; ++j) { v0[j] = sigmoid_f(v0[j]); v1[j] = sigmoid_f(v1[j]); }
                    u32x4 w; w.x = cvt_pk_bf16(v0[0], v0[1]); w.y = cvt_pk_bf16(v0[2], v0[3]); w.z = cvt_pk_bf16(v1[0], v1[1]); w.w = cvt_pk_bf16(v1[2], v1[3]);
                    *(u32x4*)(PG + (size_t)row * N_MG + c0 + bj * 128) = w; } }
    }
};
struct EpiGlu {
    static constexpr bool PERM = true, AFTER_DRAIN = false, KEEP = false;
    const bf16_t* Y5; const bf16_t* P; const float* gb; bf16_t* O;
    __device__ __forceinline__ void operator()(const f32x4 (&acc)[2][2][4][2], const pg8::Unit& u, int wr, int wc, int fr, int fq) const {
        const int row0 = u.pm * 256 + wr * 64 + fr, c0 = u.pn * 256 + wc * 32 + 8 * fq;
#pragma unroll
        for (int bj = 0; bj < 2; ++bj) { const int c = c0 + bj * 128; const f32x4 b0 = *(const f32x4*)(gb + c), b1 = *(const f32x4*)(gb + c + 4);
#pragma unroll
            for (int ai = 0; ai < 2; ++ai)
#pragma unroll
                for (int m = 0; m < 4; ++m) { const int row = row0 + ai * 128 + m * 16;
                    const u32x4 y = *(const u32x4*)(Y5 + (size_t)row * BW + c), s = *(const u32x4*)(P + (size_t)row * PLD + P_SG + c);
                    const f32x4 v0 = acc[ai][bj][m][0] + b0, v1 = acc[ai][bj][m][1] + b1;
                    u32x4 w;
                    w.x = cvt_pk_bf16(bflo(y.x) * sigmoid_f(v0[0]) * bflo(s.x), bfhi(y.x) * sigmoid_f(v0[1]) * bfhi(s.x));
                    w.y = cvt_pk_bf16(bflo(y.y) * sigmoid_f(v0[2]) * bflo(s.y), bfhi(y.y) * sigmoid_f(v0[3]) * bfhi(s.y));
                    w.z = cvt_pk_bf16(bflo(y.z) * sigmoid_f(v1[0]) * bflo(s.z), bfhi(y.z) * sigmoid_f(v1[1]) * bfhi(s.z));
                    w.w = cvt_pk_bf16(bflo(y.w) * sigmoid_f(v1[2]) * bflo(s.w), bfhi(y.w) * sigmoid_f(v1[3]) * bfhi(s.w));
                    *(u32x4*)(O + (size_t)row * OLD + 1536 + c) = w; } }
    }
};
struct EpiBr {
    static constexpr bool PERM = true, AFTER_DRAIN = false, KEEP = false;
    const bf16_t* PG; bf16_t* MRG;
    __device__ __forceinline__ void operator()(f32x4 (&acc)[2][2][4][2], const pg8::Unit& u, int wr, int wc, int fr, int fq) const {
        const int row0 = u.pm * 256 + wr * 64 + fr, c = u.pn * 128 + wc * 32 + 8 * fq, z = u.z;
#pragma unroll
        for (int ai = 0; ai < 2; ++ai)
#pragma unroll
            for (int m = 0; m < 4; ++m) { const int row = row0 + ai * 128 + m * 16;
                const u32x4 gt = __builtin_nontemporal_load((const u32x4*)(PG + (size_t)row * N_MG + z * 1024 + c));
                f32x4& p0 = acc[ai][0][m][0]; f32x4& p1 = acc[ai][0][m][1]; f32x4& s0 = acc[ai][1][m][0]; f32x4& s1 = acc[ai][1][m][1];
                if (z == 0) { s0 = (f32x4){0.f, 0.f, 0.f, 0.f}; s1 = s0; }
                s0[0] += p0[0] * bflo(gt.x); s0[1] += p0[1] * bfhi(gt.x); s0[2] += p0[2] * bflo(gt.y); s0[3] += p0[3] * bfhi(gt.y);
                s1[0] += p1[0] * bflo(gt.z); s1[1] += p1[1] * bfhi(gt.z); s1[2] += p1[2] * bflo(gt.w); s1[3] += p1[3] * bfhi(gt.w);
                p0 = (f32x4){0.f, 0.f, 0.f, 0.f}; p1 = p0;
                if (z == 3) { u32x4 w; w.x = cvt_pk_bf16(s0[0], s0[1]); w.y = cvt_pk_bf16(s0[2], s0[3]); w.z = cvt_pk_bf16(s1[0], s1[1]); w.w = cvt_pk_bf16(s1[2], s1[3]);
                    *(u32x4*)(MRG + (size_t)row * D + c) = w; } }
    }
};
struct EpiOut {
    static constexpr bool PERM = true, AFTER_DRAIN = false, KEEP = false;
    bf16_t* DL;
    __device__ __forceinline__ void operator()(const f32x4 (&acc)[2][2][4][2], const pg8::Unit& u, int wr, int wc, int fr, int fq) const {
        const int row0 = u.pm * 256 + wr * 64 + fr, c0 = u.pn * 256 + wc * 32 + 8 * fq;
#pragma unroll
        for (int ai = 0; ai < 2; ++ai)
#pragma unroll
            for (int m = 0; m < 4; ++m) { const int row = row0 + ai * 128 + m * 16;
#pragma unroll
                for (int bj = 0; bj < 2; ++bj) { const f32x4 v0 = acc[ai][bj][m][0], v1 = acc[ai][bj][m][1];
                    u32x4 w; w.x = cvt_pk_bf16(v0[0], v0[1]); w.y = cvt_pk_bf16(v0[2], v0[3]); w.z = cvt_pk_bf16(v1[0], v1[1]); w.w = cvt_pk_bf16(v1[2], v1[3]);
                    *(u32x4*)(DL + (size_t)row * D + c0 + bj * 128) = w; } }
    }
};

__device__ __forceinline__ int win_src_col(int r) {
    const int pn = r >> 8, j = r & 255;
    switch (pn) {
        case 0: return j; case 1: return 256 + j; case 2: case 3: return 512 + (r - 512);
        case 4: return -1;
        case 5: case 6: return 1040 + (r - 1280);
        case 7: return 1552 + 64 * (j >> 6) + ((j & 63) >> 1) + 32 * (j & 1);
        case 8: return 1808 + 64 * (j >> 6) + ((j & 63) >> 1) + 32 * (j & 1);
        case 9: case 10: return 2064 + (r - 2304);
        case 11: case 12: return 2576 + (r - 2816);
        case 13: case 14: return 3088 + (r - 3328);
        case 15: case 16: return 3600 + (r - 3840);
        case 17: case 18: return 4112 + (r - 4352);
        default: return 4624 + (r - 4864);
    }
}
__device__ __forceinline__ void tr_store8(bf16_t* dst, const float (&v)[8]) {
    u32x4 w; w.x = cvt_pk_bf16(v[0], v[1]); w.y = cvt_pk_bf16(v[2], v[3]); w.z = cvt_pk_bf16(v[4], v[5]); w.w = cvt_pk_bf16(v[6], v[7]); *(u32x4*)dst = w;
}
__device__ __forceinline__ void phase_prologue(const Args& a, int gtid, int gthreads) {
    unsigned char* ws = a.ws;
    for (int l = 0; l < DEPTH; ++l) {
        bf16_t* Wl = (bf16_t*)(ws + WS_W + (size_t)l * W_STRIDE);
        const float* win = a.in[I_WIN] + (size_t)l * D * 5136;
        const float* wlr = a.in[I_GWLR] + (size_t)l * 16 * 256;
        for (int idx = gtid; idx < N_IN * (D / 8); idx += gthreads) { const int n = idx % N_IN, kc = idx / N_IN; const int sc = win_src_col(n); float v[8];
            if (sc >= 0) {
#pragma unroll
                for (int i = 0; i < 8; ++i) v[i] = win[(size_t)(kc * 8 + i) * 5136 + sc];
            } else { const int j = n & 255;
#pragma unroll
                for (int i = 0; i < 8; ++i) { float s = 0.f; const float* wr_ = win + (size_t)(kc * 8 + i) * 5136 + 1024;
#pragma unroll
                    for (int r = 0; r < 16; ++r) s += wr_[r] * wlr[r * 256 + j];
                    v[i] = s; } }
            tr_store8(Wl + (size_t)n * D + kc * 8, v); }
        const float* wmg = a.in[I_WMG] + (size_t)l * 4 * D * D;
        for (int idx = gtid; idx < N_MG * (D / 8); idx += gthreads) { const int n = idx % N_MG, kc = idx / N_MG, bi = n >> 10, c = n & 1023; float v[8];
#pragma unroll
            for (int i = 0; i < 8; ++i) v[i] = wmg[((size_t)bi * D + kc * 8 + i) * D + c];
            tr_store8(Wl + (size_t)(N_IN + n) * D + kc * 8, v); }
        const float* wbr = a.in[I_WBR] + (size_t)l * 4 * BW * D; bf16_t* Wb = (bf16_t*)((unsigned char*)Wl + WO_BR);
        for (int idx = gtid; idx < 4 * D * (BW / 8); idx += gthreads) { const int n = idx % (4 * D), kc = idx / (4 * D), bi = n >> 10, c = n & 1023; float v[8];
#pragma unroll
            for (int i = 0; i < 8; ++i) v[i] = wbr[((size_t)bi * BW + kc * 8 + i) * D + c];
            tr_store8(Wb + (size_t)n * BW + kc * 8, v); }
        const float* wout = a.in[I_WOUT] + (size_t)l * D * D; bf16_t* Wo = (bf16_t*)((unsigned char*)Wl + WO_OUT);
        for (int idx = gtid; idx < D * (D / 8); idx += gthreads) { const int n = idx % D, kc = idx / D; float v[8];
#pragma unroll
            for (int i = 0; i < 8; ++i) v[i] = wout[(size_t)(kc * 8 + i) * D + n];
            tr_store8(Wo + (size_t)n * D + kc * 8, v); }
        const float* wglu = a.in[I_SGW] + (size_t)l * BW * BW; bf16_t* Wg = (bf16_t*)((unsigned char*)Wl + WO_GLU);
        for (int idx = gtid; idx < BW * (BW / 8); idx += gthreads) { const int n = idx % BW, kc = idx / BW; float v[8];
#pragma unroll
            for (int i = 0; i < 8; ++i) v[i] = wglu[(size_t)(kc * 8 + i) * BW + n];
            tr_store8(Wg + (size_t)n * BW + kc * 8, v); }
        float* sm = (float*)(ws + WS_SMALL + (size_t)l * SMALL_STRIDE);
        for (int idx = gtid; idx < 2048; idx += gthreads) { const int g = idx >> 6;
            const double step = exp((double)a.in[I_SLDT][l * 32 + g]); const double are = a.in[I_SARE][l * 2048 + idx], aim = a.in[I_SAIM][l * 2048 + idx];
            const double mag = exp(step * are), abr = mag * cos(step * aim), abi = mag * sin(step * aim), den = are * are + aim * aim;
            const double fre = ((abr - 1.0) * are + abi * aim) / den, fim = (abi * are - (abr - 1.0) * aim) / den;
            sm[SM_ABR + idx] = (float)abr; sm[SM_ABI + idx] = (float)abi;
            { const double m128 = exp(512.0 * step * are); sm[SM_A128 + idx * 2] = (float)(m128 * cos(512.0 * step * aim)); sm[SM_A128 + idx * 2 + 1] = (float)(m128 * sin(512.0 * step * aim)); }
            bf16_t* bbt = (bf16_t*)((unsigned char*)sm + SM_BBT_BYTES); const int p_ = idx & 63;
            for (int i = 0; i < 16; ++i) { const double br = a.in[I_SBRE][(size_t)l * 32768 + idx * 16 + i], bi = a.in[I_SBIM][(size_t)l * 32768 + idx * 16 + i];
                const float vr = (float)(fre * br - fim * bi), vi = (float)(fre * bi + fim * br);
                sm[SM_BBR + idx * 16 + i] = vr; sm[SM_BBI + idx * 16 + i] = vi; bbt[(g * 128 + 2 * p_) * 16 + i] = f2bf(vr); bbt[(g * 128 + 2 * p_ + 1) * 16 + i] = f2bf(vi); } }
        for (int idx = gtid; idx < 512; idx += gthreads) { const float lam = a.in[I_LLAM][l * 512 + idx]; const float nl = -lam;
            sm[SM_SP8 + idx] = 8.0f * (fmaxf(nl, 0.f) + log1pf(expf(-fabsf(nl)))); }
        { bf16_t* ct = (bf16_t*)((unsigned char*)sm + SM_CT_BYTES);
          for (int idx = gtid; idx < 32 * 16 * 128; idx += gthreads) { const int k = idx & 127, gi = idx >> 7;
              const float v = (k & 1) == 0 ? a.in[I_SCRE][(size_t)l * 32768 + gi * 64 + (k >> 1)] : -a.in[I_SCIM][(size_t)l * 32768 + gi * 64 + (k >> 1)]; ct[idx] = f2bf(v); } }
        bf16_t* lw = (bf16_t*)((unsigned char*)sm + SM_LRUW_BYTES);
        for (int idx = gtid; idx < 8 * 128 * 64; idx += gthreads) { const int i = idx & 63, jj = (idx >> 6) & 127, n = idx >> 13;
            const float v = jj < 64 ? a.in[I_LWA][(((size_t)l * 8 + n) * 64 + i) * 64 + jj] : a.in[I_LWX][(((size_t)l * 8 + n) * 64 + i) * 64 + (jj - 64)];
            lw[idx] = f2bf(v); }
    }
    float* rot = (float*)(ws + WS_ROT);
    for (int idx = gtid; idx < SEQ * 32; idx += gthreads) { const int i = idx & 31, s = idx >> 5;
        const double inv = pow(10000.0, -(double)i / 32.0), ang = (double)s * inv; rot[idx * 2] = (float)cos(ang); rot[idx * 2 + 1] = (float)sin(ang); }
}

template <bool F32OUT, bool ADD>
__device__ __forceinline__ void phase_norm(const float* hin, const bf16_t* delta, float* hout, const float* gain, bf16_t* uout, int gw, int ngw, int lane) {
    f32x4 gv[4];
#pragma unroll
    for (int j = 0; j < 4; ++j) gv[j] = *(const f32x4*)(gain + 4 * lane + 256 * j);
    for (int row = gw; row < TG; row += ngw) {
        const f32x4* xr = (const f32x4*)(hin + (size_t)row * D) + lane; f32x4 v[4]; float s = 0.f;
#pragma unroll
        for (int j = 0; j < 4; ++j) v[j] = __builtin_nontemporal_load(xr + 64 * j);
        if (ADD) { const u32x2* dr = (const u32x2*)(delta + (size_t)row * D) + lane;
#pragma unroll
            for (int j = 0; j < 4; ++j) { const u32x2 dw = __builtin_nontemporal_load(dr + 64 * j); v[j].x += bflo(dw.x); v[j].y += bfhi(dw.x); v[j].z += bflo(dw.y); v[j].w += bfhi(dw.y); } }
#pragma unroll
        for (int j = 0; j < 4; ++j) s += (v[j].x * v[j].x + v[j].y * v[j].y) + (v[j].z * v[j].z + v[j].w * v[j].w);
        const float rstd = rsqrtf(wave_sum(s) * (1.f / D) + NORM_EPS);
        if (F32OUT) { f32x4* o = (f32x4*)(hout + (size_t)row * D) + lane;
#pragma unroll
            for (int j = 0; j < 4; ++j) o[64 * j] = v[j] * rstd * gv[j];
        } else {
            if (ADD) { f32x4* o = (f32x4*)(hout + (size_t)row * D) + lane;
#pragma unroll
                for (int j = 0; j < 4; ++j) o[64 * j] = v[j]; }
            u32x2* o = (u32x2*)(uout + (size_t)row * D) + lane;
#pragma unroll
            for (int j = 0; j < 4; ++j) { const f32x4 y = v[j] * rstd * gv[j]; u32x2 w; w.x = cvt_pk_bf16(y.x, y.y); w.y = cvt_pk_bf16(y.z, y.w); o[64 * j] = w; } }
    }
}

constexpr int NSEGG = 8;
constexpr int NSEGL = 32;
constexpr int NSEGS = 8;
constexpr size_t ST_GSEG = 0;
constexpr size_t ST_GDS = ST_GSEG + (size_t)2 * BG * 4 * NSEGG * 8192;
constexpr size_t ST_LRU = ST_GDS + (size_t)2 * BG * 4 * NSEGG * 64;
constexpr size_t ST_S5 = ST_LRU + (size_t)BG * NSEGL * 512 * 2;
constexpr size_t ST_END_F = ST_S5 + (size_t)BG * NSEGS * 32 * 128;
static_assert(ST_END_F * 4 <= 64 * MiB, "state scratch");
typedef short s16x4 __attribute__((ext_vector_type(4)));

__device__ __forceinline__ bf16x8 lds_tr_frag(LAS const unsigned char* base, int row_stride_bytes, int lane) {
    const int g = lane >> 4, idx = lane & 15, q = idx >> 2, p = idx & 3;
    LAS const unsigned char* a0 = base + (8 * g + q) * row_stride_bytes + 8 * p;
    const s16x4 r0 = __builtin_amdgcn_ds_read_tr16_b64_v4i16((LAS s16x4*)a0);
    const s16x4 r1 = __builtin_amdgcn_ds_read_tr16_b64_v4i16((LAS s16x4*)(a0 + 4 * row_stride_bytes));
    bf16x8 f; f[0] = r0[0]; f[1] = r0[1]; f[2] = r0[2]; f[3] = r0[3]; f[4] = r1[0]; f[5] = r1[1]; f[6] = r1[2]; f[7] = r1[3]; return f;
}
#define WGSYNC() do { asm volatile("s_waitcnt lgkmcnt(0)" ::: "memory"); __builtin_amdgcn_s_barrier(); asm volatile("" ::: "memory"); } while (0)

constexpr int GL_QD = 0, GL_KD = 9216, GL_KT = 18432, GL_V = 27648, GL_ST = 45056, GL_LAST = 63488, GL_RED = 63744, GL_RED2 = 64256;
struct GlaP { const bf16_t* P; const float* LA; const float* gain; const float* bias; bf16_t* O; float* SSEG; float* DSUM; };
__device__ __forceinline__ bf16x8 lds_tr_frag2(LAS const unsigned char* base, int row_stride_bytes, int lane, int mulg, int second_off) {
    const int g = lane >> 4, idx = lane & 15, q = idx >> 2, p = idx & 3;
    LAS const unsigned char* a0 = base + (mulg * g + q) * row_stride_bytes + 8 * p;
    const s16x4 r0 = __builtin_amdgcn_ds_read_tr16_b64_v4i16((LAS s16x4*)a0);
    const s16x4 r1 = __builtin_amdgcn_ds_read_tr16_b64_v4i16((LAS s16x4*)(a0 + second_off * row_stride_bytes));
    bf16x8 f; f[0] = r0[0]; f[1] = r0[1]; f[2] = r0[2]; f[3] = r0[3]; f[4] = r1[0]; f[5] = r1[1]; f[6] = r1[2]; f[7] = r1[3]; return f;
}
__device__ __forceinline__ bf16x8 pack8(const f32x4 a, const f32x4 b) { u32x4 w; w.x = cvt_pk_bf16(a[0], a[1]); w.y = cvt_pk_bf16(a[2], a[3]); w.z = cvt_pk_bf16(b[0], b[1]); w.w = cvt_pk_bf16(b[2], b[3]); return __builtin_bit_cast(bf16x8, w); }

template <bool PASSC>
__device__ __forceinline__ void glaret_item(LAS unsigned char* lds, const GlaP& gp, const bool gla, const int b, const int h, const int seg, const int sidx  ) {
    int tid = threadIdx.x; asm volatile("" : "+v"(tid));
    const int w = __builtin_amdgcn_readfirstlane(tid >> 6), l = tid & 63, fr = l & 15, fq = l >> 4;
    const int qoff = gla ? P_GQ : P_RQ, koff = gla ? P_GK : P_RK, voff = gla ? P_GV : P_RV, goff = gla ? P_GG : P_RG, ooff = gla ? 0 : 512;
    const float lg = __logf(1.f - exp2f(-5.f - (float)h));
    f32x4 accs[4];
#pragma unroll
    for (int dt = 0; dt < 4; ++dt) accs[dt] = (f32x4){0.f, 0.f, 0.f, 0.f};
    float dsum[8];
#pragma unroll
    for (int e = 0; e < 8; ++e) dsum[e] = 0.f;
    if (PASSC) {
        for (int sp = 0; sp < seg; ++sp) {
            const float* sg = gp.SSEG + (size_t)(sidx + sp) * 8192 + tid * 16; const float* dsm = gp.DSUM + (size_t)(sidx + sp) * 64;
#pragma unroll
            for (int dt = 0; dt < 4; ++dt) { const f32x4 dv = *(const f32x4*)(dsm + 16 * dt + 4 * fq), sv = *(const f32x4*)(sg + 4 * dt);
#pragma unroll
                for (int r = 0; r < 4; ++r) accs[dt][r] = accs[dt][r] * __expf(dv[r]) + sv[r]; }
        }
#pragma unroll
        for (int dt = 0; dt < 4; ++dt) { u32x2 wv; wv.x = cvt_pk_bf16(accs[dt][0], accs[dt][1]); wv.y = cvt_pk_bf16(accs[dt][2], accs[dt][3]);
            *(LAS u32x2*)(lds + GL_ST + (16 * w + fr) * 144 + 32 * dt + 8 * fq) = wv; }
    }
    const int it = w & 3, ch = w >> 2;
    f32x4 gnv[4], bsv[4];
#pragma unroll
    for (int ct = 0; ct < 4; ++ct) { const int c = 128 * h + 64 * ch + 16 * ct + 4 * fq; gnv[ct] = PASSC ? *(const f32x4*)(gp.gain + c) : (f32x4){0.f, 0.f, 0.f, 0.f};
        bsv[ct] = (PASSC && !gla) ? *(const f32x4*)(gp.bias + c) : (f32x4){0.f, 0.f, 0.f, 0.f}; }
    u32x4 rq = (u32x4){0u, 0u, 0u, 0u}, rk, rv[2]; f32x4 rla[2], rll[2]; u32x2 gnx[4];
    const float rq_s = __expf((float)(l + 1) * lg), rk_s = __expf(-(float)(l + 1) * lg), rt_s = __expf((float)(63 - l) * lg);
#define GL_ISSUE(n_) do { const size_t r0_ = (size_t)b * SEQ + seg * 512 + (n_) * 64; \
        { const bf16_t* pr_ = gp.P + (r0_ + l) * PLD + 64 * h + 8 * w; if (PASSC) rq = *(const u32x4*)(pr_ + qoff); rk = *(const u32x4*)(pr_ + koff); \
          if (gla) { const float* lp_ = gp.LA + (r0_ + l) * 256 + 64 * h + 8 * w; rla[0] = *(const f32x4*)lp_; rla[1] = *(const f32x4*)(lp_ + 4); const float* ll_ = gp.LA + (r0_ + 63) * 256 + 64 * h + 8 * w; rll[0] = *(const f32x4*)ll_; rll[1] = *(const f32x4*)(ll_ + 4); } \
          else { rla[0] = (f32x4){0.f, 0.f, 0.f, 0.f}; rla[1] = rla[0]; rll[0] = rla[0]; rll[1] = rla[0]; } } \
        _Pragma("unroll") for (int e_ = 0; e_ < 2; ++e_) { const int p_ = tid + 512 * e_, i_ = p_ >> 4, part_ = p_ & 15; \
            rv[e_] = *(const u32x4*)(gp.P + (r0_ + i_) * PLD + voff + 128 * h + 8 * part_); } \
        if (PASSC) { _Pragma("unroll") for (int ct_ = 0; ct_ < 4; ++ct_) gnx[ct_] = *(const u32x2*)(gp.P + (r0_ + 16 * it + fr) * PLD + goff + 128 * h + 64 * ch + 16 * ct_ + 4 * fq); } } while (0)
    GL_ISSUE(0);
    for (int n = 0; n < 8; ++n) {
        const size_t row0 = (size_t)b * SEQ + seg * 512 + n * 64;
#pragma unroll
        for (int e = 0; e < 2; ++e) { const int p = tid + 512 * e, i = p >> 4, part = p & 15; *(LAS u32x4*)(lds + GL_V + i * 272 + part * 16) = rv[e]; }
        { float cum[8], lastv[8];
          const float kk[8] = {bflo(rk.x), bfhi(rk.x), bflo(rk.y), bfhi(rk.y), bflo(rk.z), bfhi(rk.z), bflo(rk.w), bfhi(rk.w)};
          float eq[8], ek[8], et[8];
          if (gla) {
#pragma unroll
              for (int e = 0; e < 8; ++e) { cum[e] = e < 4 ? rla[0][e] : rla[1][e - 4]; lastv[e] = e < 4 ? rll[0][e] : rll[1][e - 4];
                  eq[e] = __expf(cum[e]); ek[e] = __builtin_amdgcn_rcpf(eq[e]); et[e] = __expf(lastv[e]) * ek[e]; }
          } else {
#pragma unroll
              for (int e = 0; e < 8; ++e) { lastv[e] = 64.f * lg; eq[e] = rq_s; ek[e] = rk_s; et[e] = rt_s; } }
#pragma unroll
          for (int e = 0; e < 8; ++e) *(LAS bf16_t*)(lds + GL_KT + (8 * w + e) * 144 + l * 2) = f2bf(kk[e] * et[e]);
          if (PASSC) { const float qq[8] = {bflo(rq.x), bfhi(rq.x), bflo(rq.y), bfhi(rq.y), bflo(rq.z), bfhi(rq.z), bflo(rq.w), bfhi(rq.w)};
              u32x4 qw, kw;
              qw.x = cvt_pk_bf16(qq[0] * eq[0], qq[1] * eq[1]); qw.y = cvt_pk_bf16(qq[2] * eq[2], qq[3] * eq[3]); qw.z = cvt_pk_bf16(qq[4] * eq[4], qq[5] * eq[5]); qw.w = cvt_pk_bf16(qq[6] * eq[6], qq[7] * eq[7]);
              kw.x = cvt_pk_bf16(kk[0] * ek[0], kk[1] * ek[1]); kw.y = cvt_pk_bf16(kk[2] * ek[2], kk[3] * ek[3]); kw.z = cvt_pk_bf16(kk[4] * ek[4], kk[5] * ek[5]); kw.w = cvt_pk_bf16(kk[6] * ek[6], kk[7] * ek[7]);
              *(LAS u32x4*)(lds + GL_QD + l * 144 + 16 * w) = qw; *(LAS u32x4*)(lds + GL_KD + l * 144 + 16 * w) = kw; }
          if (l == 63) {
#pragma unroll
              for (int e = 0; e < 8; ++e) *(LAS float*)(lds + GL_LAST + (8 * w + e) * 4) = lastv[e]; }
#pragma unroll
          for (int e = 0; e < 8; ++e) dsum[e] += lastv[e]; }
        u32x2 gates[4];
        if (PASSC) {
#pragma unroll
            for (int ct = 0; ct < 4; ++ct) gates[ct] = gnx[ct]; }
        if (n < 7) GL_ISSUE(n + 1);
        WGSYNC();
        f32x4 acco[4];
        if (PASSC) {
            bf16x8 qf[2];
#pragma unroll
            for (int ks = 0; ks < 2; ++ks) qf[ks] = *(LAS const bf16x8*)(lds + GL_QD + (16 * it + fr) * 144 + 16 * fq + 64 * ks);
            f32x4 sc[4];
#pragma unroll
            for (int jt = 0; jt < 4; ++jt) { sc[jt] = (f32x4){0.f, 0.f, 0.f, 0.f};
                if (jt <= it) {
#pragma unroll
                    for (int ks = 0; ks < 2; ++ks) { const bf16x8 kf = *(LAS const bf16x8*)(lds + GL_KD + (16 * jt + fr) * 144 + 16 * fq + 64 * ks);
                        sc[jt] = __builtin_amdgcn_mfma_f32_16x16x32_bf16(kf, qf[ks], sc[jt], 0, 0, 0); }
                    if (jt == it) {
#pragma unroll
                        for (int r = 0; r < 4; ++r) sc[jt][r] = (4 * fq + r <= fr) ? sc[jt][r] : 0.f; } } }
            const bf16x8 pf0 = pack8(sc[0], sc[1]), pf1 = pack8(sc[2], sc[3]);
#pragma unroll
            for (int ct = 0; ct < 4; ++ct) { const int c0 = 64 * ch + 16 * ct; acco[ct] = (f32x4){0.f, 0.f, 0.f, 0.f};
                { const bf16x8 vf = lds_tr_frag2(lds + GL_V + c0 * 2, 272, l, 4, 16); acco[ct] = __builtin_amdgcn_mfma_f32_16x16x32_bf16(vf, pf0, acco[ct], 0, 0, 0); }
                if (it >= 2) { const bf16x8 vf = lds_tr_frag2(lds + GL_V + 32 * 272 + c0 * 2, 272, l, 4, 16); acco[ct] = __builtin_amdgcn_mfma_f32_16x16x32_bf16(vf, pf1, acco[ct], 0, 0, 0); }
#pragma unroll
                for (int ks = 0; ks < 2; ++ks) { const bf16x8 sf = *(LAS const bf16x8*)(lds + GL_ST + (c0 + fr) * 144 + 16 * fq + 64 * ks);
                    acco[ct] = __builtin_amdgcn_mfma_f32_16x16x32_bf16(sf, qf[ks], acco[ct], 0, 0, 0); } }
        }
#pragma unroll
        for (int dt = 0; dt < 4; ++dt) { const f32x4 lv = *(LAS const f32x4*)(lds + GL_LAST + (16 * dt + 4 * fq) * 4);
#pragma unroll
            for (int r = 0; r < 4; ++r) accs[dt][r] *= __expf(lv[r]); }
#pragma unroll
        for (int ks = 0; ks < 2; ++ks) { const bf16x8 vf = lds_tr_frag2(lds + GL_V + (32 * ks) * 272 + (16 * w) * 2, 272, l, 8, 4);
#pragma unroll
            for (int dt = 0; dt < 4; ++dt) { const bf16x8 kf = *(LAS const bf16x8*)(lds + GL_KT + (16 * dt + fr) * 144 + 16 * fq + 64 * ks);
                accs[dt] = __builtin_amdgcn_mfma_f32_16x16x32_bf16(kf, vf, accs[dt], 0, 0, 0); } }
        if (PASSC) {
            float ss = 0.f, sm_ = 0.f;
#pragma unroll
            for (int ct = 0; ct < 4; ++ct)
#pragma unroll
                for (int r = 0; r < 4; ++r) { ss += acco[ct][r] * acco[ct][r]; sm_ += acco[ct][r]; }
            ss += __shfl_xor(ss, 16); ss += __shfl_xor(ss, 32); sm_ += __shfl_xor(sm_, 16); sm_ += __shfl_xor(sm_, 32);
            if (fq == 0) { *(LAS float*)(lds + GL_RED + ((16 * it + fr) * 2 + ch) * 4) = ss; *(LAS float*)(lds + GL_RED2 + ((16 * it + fr) * 2 + ch) * 4) = sm_; }
        }
        WGSYNC();
        if (PASSC) {
            const int i = 16 * it + fr;
            const float ssum = *(LAS const float*)(lds + GL_RED + (i * 2) * 4) + *(LAS const float*)(lds + GL_RED + (i * 2 + 1) * 4);
            const float msum = *(LAS const float*)(lds + GL_RED2 + (i * 2) * 4) + *(LAS const float*)(lds + GL_RED2 + (i * 2 + 1) * 4);
            float mean, rstd;
            if (gla) { mean = 0.f; rstd = rsqrtf(ssum * (1.f / 128.f) + NORM_EPS); }
            else { mean = msum * (1.f / 128.f); const float var = fmaxf(ssum * (1.f / 128.f) - mean * mean, 0.f); rstd = rsqrtf(var + NORM_EPS); }
#pragma unroll
            for (int ct = 0; ct < 4; ++ct) { const int c = 128 * h + 64 * ch + 16 * ct + 4 * fq; const f32x4 gn = gnv[ct], bs = bsv[ct];
                const float g0 = bflo(gates[ct].x), g1 = bfhi(gates[ct].x), g2 = bflo(gates[ct].y), g3 = bfhi(gates[ct].y);
                u32x2 ow; ow.x = cvt_pk_bf16(((acco[ct][0] - mean) * rstd * gn[0] + bs[0]) * g0, ((acco[ct][1] - mean) * rstd * gn[1] + bs[1]) * g1);
                ow.y = cvt_pk_bf16(((acco[ct][2] - mean) * rstd * gn[2] + bs[2]) * g2, ((acco[ct][3] - mean) * rstd * gn[3] + bs[3]) * g3);
                *(u32x2*)(gp.O + (row0 + i) * OLD + ooff + c) = ow; }
#pragma unroll
            for (int dt = 0; dt < 4; ++dt) { u32x2 wv; wv.x = cvt_pk_bf16(accs[dt][0], accs[dt][1]); wv.y = cvt_pk_bf16(accs[dt][2], accs[dt][3]);
                *(LAS u32x2*)(lds + GL_ST + (16 * w + fr) * 144 + 32 * dt + 8 * fq) = wv; }
        }
    }
#undef GL_ISSUE
    if (!PASSC) {
        float* sg = gp.SSEG + (size_t)(sidx + seg) * 8192 + tid * 16;
#pragma unroll
        for (int dt = 0; dt < 4; ++dt) *(f32x4*)(sg + 4 * dt) = accs[dt];
        if (l == 0) {
#pragma unroll
            for (int e = 0; e < 8; ++e) gp.DSUM[(size_t)(sidx + seg) * 64 + 8 * w + e] = dsum[e]; }
    }
    WGSYNC();
}

constexpr int LR_XC = 0, LR_XCF = 2304, LR_AA = 6400, LR_GG = 10496, LR_WAVE = 14592;
struct LruP { const bf16_t* P; const float* cw; const float* cb; const float* ba; const float* bx; const float* sp8; const bf16_t* lw; bf16_t* O; float* LST; };
template <bool PASSC>
__device__ __forceinline__ void lru_wave(LAS unsigned char* lw_, const LruP& lp, const int b, const int seg, const int n, const int l) {
    const int fr = l & 15, fq = l >> 4, ch = 64 * n + l;
    bf16x8 wB[8][2];
#pragma unroll
    for (int jt = 0; jt < 8; ++jt)
#pragma unroll
        for (int ks = 0; ks < 2; ++ks) wB[jt][ks] = *(const bf16x8*)(lp.lw + ((size_t)(n * 128 + 16 * jt + fr)) * 64 + 8 * fq + 32 * ks);
    const float w0 = lp.cw[ch], w1 = lp.cw[512 + ch], w2 = lp.cw[1024 + ch], w3 = lp.cw[1536 + ch], cbv = lp.cb[ch];
    float bav[4], bxv[4], spv[4];
#pragma unroll
    for (int jt = 0; jt < 4; ++jt) { const int c2 = 64 * n + 16 * jt + fr; bav[jt] = lp.ba[c2]; bxv[jt] = lp.bx[c2]; spv[jt] = lp.sp8[c2]; }
    const size_t rowb = (size_t)b * SEQ + seg * 128;
    float xm3 = 0.f, xm2 = 0.f, xm1 = 0.f;
    if (seg > 0) { xm3 = bf2f(lp.P[(rowb - 3) * PLD + P_LX + ch]); xm2 = bf2f(lp.P[(rowb - 2) * PLD + P_LX + ch]); xm1 = bf2f(lp.P[(rowb - 1) * PLD + P_LX + ch]); }
    float hst = 0.f, ap = 1.f;
    if (PASSC) { const float* st = lp.LST + ((size_t)b * NSEGL * 512 + ch) * 2;
        pg8::f32x2_ ah[31];
#pragma unroll
        for (int e = 0; e < 31; ++e) { const int sp = e < seg ? e : 0; ah[e] = *(const pg8::f32x2_*)(st + (size_t)sp * 1024); }
#pragma unroll
        for (int e = 0; e < 31; ++e) if (e < seg) hst = ah[e][0] * hst + ah[e][1]; }
    bf16_t xn[16], gn[16];
#pragma unroll
    for (int t = 0; t < 16; ++t) { xn[t] = lp.P[(rowb + t) * PLD + P_LX + ch]; gn[t] = PASSC ? lp.P[(rowb + t) * PLD + P_LG + ch] : (bf16_t)0; }
    for (int sb = 0; sb < 8; ++sb) {
        const size_t r0 = rowb + sb * 16;
        float xf[16], gr[16];
#pragma unroll
        for (int t = 0; t < 16; ++t) { xf[t] = bf2f(xn[t]); gr[t] = bf2f(gn[t]); }
        if (sb < 7) {
#pragma unroll
            for (int t = 0; t < 16; ++t) { xn[t] = lp.P[(r0 + 16 + t) * PLD + P_LX + ch]; if (PASSC) gn[t] = lp.P[(r0 + 16 + t) * PLD + P_LG + ch]; } }
#pragma unroll
        for (int t = 0; t < 16; ++t) { const float x0 = xf[t]; const float xc = cbv + w0 * xm3 + w1 * xm2 + w2 * xm1 + w3 * x0; xm3 = xm2; xm2 = xm1; xm1 = x0;
            *(LAS bf16_t*)(lw_ + LR_XC + t * 144 + l * 2) = f2bf(xc); *(LAS float*)(lw_ + LR_XCF + t * 256 + l * 4) = xc; }
        __builtin_amdgcn_wave_barrier();
        f32x4 acc[8];
#pragma unroll
        for (int jt = 0; jt < 8; ++jt) acc[jt] = (f32x4){0.f, 0.f, 0.f, 0.f};
#pragma unroll
        for (int ks = 0; ks < 2; ++ks) { const bf16x8 af = *(LAS const bf16x8*)(lw_ + LR_XC + fr * 144 + 16 * fq + 64 * ks);
#pragma unroll
            for (int jt = 0; jt < 8; ++jt) acc[jt] = __builtin_amdgcn_mfma_f32_16x16x32_bf16(af, wB[jt][ks], acc[jt], 0, 0, 0); }
#pragma unroll
        for (int jt = 0; jt < 4; ++jt)
#pragma unroll
            for (int r = 0; r < 4; ++r) { const int tok = 4 * fq + r, j = 16 * jt + fr;
                const float rg = sigmoid_f(acc[jt][r] + bav[jt]), ig = sigmoid_f(acc[4 + jt][r] + bxv[jt]);
                const float log_a = -rg * spv[jt]; const float av = __expf(log_a);
                const float xcv = *(LAS const float*)(lw_ + LR_XCF + tok * 256 + j * 4);
                *(LAS float*)(lw_ + LR_AA + tok * 256 + j * 4) = av; const float em = fmaf(-av, av, 1.f);
                *(LAS float*)(lw_ + LR_GG + tok * 256 + j * 4) = xcv * ig * sqrtf(fmaxf(em, 0.f)); }
        __builtin_amdgcn_wave_barrier();
#pragma unroll
        for (int t = 0; t < 16; ++t) { const float av = *(LAS const float*)(lw_ + LR_AA + t * 256 + l * 4), gv = *(LAS const float*)(lw_ + LR_GG + t * 256 + l * 4);
            hst = av * hst + gv; ap *= av;
            if (PASSC) lp.O[(r0 + t) * OLD + 1024 + ch] = f2bf(hst * gr[t]); }
        __builtin_amdgcn_wave_barrier();
    }
    if (!PASSC) { float* st = lp.LST + (((size_t)b * NSEGL + seg) * 512 + ch) * 2; st[0] = ap; st[1] = hst; }
}

constexpr int S5_BU = 0, S5_X = 8448, S5_WAVE = 8448 + 4352;
struct S5P { const bf16_t* P; const float* sm; const bf16_t* ct; const bf16_t* bbt; const float* a128; const float* dd; bf16_t* Y5; float* SST; };
template <bool PASSC>
__device__ __forceinline__ void s5_wave(LAS unsigned char* lw_, const S5P& sp_, const int b, const int seg, const int g, const int l) {
    const int fr = l & 15, fq = l >> 4;
    const bf16x8 zf = (bf16x8){0, 0, 0, 0, 0, 0, 0, 0};
    bf16x8 bbf[8];
#pragma unroll
    for (int mt = 0; mt < 8; ++mt) bbf[mt] = fq < 2 ? *(const bf16x8*)(sp_.bbt + ((size_t)(g * 128 + 16 * mt + fr)) * 16 + 8 * fq) : zf;
    const float abr = sp_.sm[SM_ABR + g * 64 + l], abi = sp_.sm[SM_ABI + g * 64 + l];
    float xr = 0.f, xi = 0.f;
    bf16x8 cf[4]; f32x4 dv4 = (f32x4){0.f, 0.f, 0.f, 0.f};
    if (PASSC) {
        const float ar = sp_.a128[(g * 64 + l) * 2], ai = sp_.a128[(g * 64 + l) * 2 + 1];
        const float* st = sp_.SST + ((size_t)b * NSEGS * 32 + g) * 128 + l;
        for (int sp0 = 0; sp0 < seg; sp0 += 8) { float er[8], ei[8];
#pragma unroll
            for (int e = 0; e < 8; ++e) { const int sp = sp0 + e < seg ? sp0 + e : seg - 1; er[e] = st[(size_t)sp * 4096]; ei[e] = st[(size_t)sp * 4096 + 64]; }
#pragma unroll
            for (int e = 0; e < 8; ++e) if (sp0 + e < seg) { const float nr = ar * xr - ai * xi + er[e], ni = ar * xi + ai * xr + ei[e]; xr = nr; xi = ni; } }
#pragma unroll
        for (int ks = 0; ks < 4; ++ks) cf[ks] = *(const bf16x8*)(sp_.ct + ((size_t)(g * 16 + fr)) * 128 + 8 * fq + 32 * ks);
        dv4 = *(const f32x4*)(sp_.dd + 16 * g + 4 * fq);
    }
    const size_t rowb = (size_t)b * SEQ + seg * 512;
    bf16x8 ufn = fq < 2 ? *(const bf16x8*)(sp_.P + (rowb + fr) * PLD + P_SU + 16 * g + 8 * fq) : zf;
    u32x2 usn = PASSC ? *(const u32x2*)(sp_.P + (rowb + fr) * PLD + P_SU + 16 * g + 4 * fq) : (u32x2){0u, 0u};
    for (int sb = 0; sb < 32; ++sb) {
        const size_t r0 = rowb + sb * 16;
        const bf16x8 uf = ufn; const u32x2 us = usn;
        if (sb < 31) { ufn = fq < 2 ? *(const bf16x8*)(sp_.P + (r0 + 16 + fr) * PLD + P_SU + 16 * g + 8 * fq) : zf;
            if (PASSC) usn = *(const u32x2*)(sp_.P + (r0 + 16 + fr) * PLD + P_SU + 16 * g + 4 * fq); }
#pragma unroll
        for (int mt = 0; mt < 8; ++mt) { f32x4 bu = (f32x4){0.f, 0.f, 0.f, 0.f}; bu = __builtin_amdgcn_mfma_f32_16x16x32_bf16(bbf[mt], uf, bu, 0, 0, 0);
            *(LAS f32x4*)(lw_ + S5_BU + fr * 528 + (16 * mt + 4 * fq) * 4) = bu; }
        __builtin_amdgcn_wave_barrier();
        pg8::f32x2_ buv[16];
#pragma unroll
        for (int t = 0; t < 16; ++t) buv[t] = *(LAS const pg8::f32x2_*)(lw_ + S5_BU + t * 528 + l * 8);
#pragma unroll
        for (int t = 0; t < 16; ++t) {
            const pg8::f32x2_ bu = buv[t];
            const float nr = abr * xr - abi * xi + bu[0], ni = abr * xi + abi * xr + bu[1]; xr = nr; xi = ni;
            if (PASSC) *(LAS unsigned*)(lw_ + S5_X + t * 272 + l * 4) = cvt_pk_bf16(xr, xi);
        }
        __builtin_amdgcn_wave_barrier();
        if (PASSC) {
            f32x4 acc = (f32x4){0.f, 0.f, 0.f, 0.f};
#pragma unroll
            for (int ks = 0; ks < 4; ++ks) { const bf16x8 xf = *(LAS const bf16x8*)(lw_ + S5_X + fr * 272 + 16 * fq + 64 * ks);
                acc = __builtin_amdgcn_mfma_f32_16x16x32_bf16(cf[ks], xf, acc, 0, 0, 0); }
            u32x2 yw; yw.x = cvt_pk_bf16(gelu_tanh_f(acc[0] + dv4[0] * bflo(us.x)), gelu_tanh_f(acc[1] + dv4[1] * bfhi(us.x))); yw.y = cvt_pk_bf16(gelu_tanh_f(acc[2] + dv4[2] * bflo(us.y)), gelu_tanh_f(acc[3] + dv4[3] * bfhi(us.y)));
            *(u32x2*)(sp_.Y5 + (r0 + fr) * BW + 16 * g + 4 * fq) = yw;
            __builtin_amdgcn_wave_barrier();
        }
    }
    if (!PASSC) { float* st = sp_.SST + (((size_t)b * NSEGS + seg) * 32 + g) * 128 + l; st[0] = xr; st[64] = xi; }
}

template <bool PASSC>
__device__ __forceinline__ void phase_mixers(LAS unsigned char* lds, const Args& a, const int l, const int G) {
    const int mmask = a.mmask;
    unsigned char* ws = a.ws; const float* sm = (const float*)(ws + WS_SMALL + (size_t)l * SMALL_STRIDE);
    const bf16_t* P = (const bf16_t*)(ws + WS_P); float* ST = (float*)(ws + WS_ST);
    if (mmask & 1) { GlaP gp0{P, (const float*)(ws + WS_LA), a.in[I_GNG] + l * 512, nullptr, (bf16_t*)(ws + WS_O), ST + ST_GSEG, ST + ST_GDS};
      GlaP gp1{P, (const float*)(ws + WS_LA), a.in[I_RNG] + l * 512, a.in[I_RNB] + l * 512, (bf16_t*)(ws + WS_O), ST + ST_GSEG, ST + ST_GDS};
      for (int itx = blockIdx.x; itx < 2 * BG * 4 * NSEGG; itx += G) { const int mix = itx / (BG * 4 * NSEGG), rest = itx % (BG * 4 * NSEGG), b = rest / (4 * NSEGG), h = (rest / NSEGG) & 3, seg = rest % NSEGG;
          const int sidx = ((mix * BG + b) * 4 + h) * NSEGG;
          if (!PASSC && seg == NSEGG - 1) continue;
          if (mix == 0) glaret_item<PASSC>(lds, gp0, true, b, h, seg, sidx); else glaret_item<PASSC>(lds, gp1, false, b, h, seg, sidx); } }
    int tid = threadIdx.x; asm volatile("" : "+v"(tid));
    const int w = __builtin_amdgcn_readfirstlane(tid >> 6), ln = tid & 63;
    if (mmask & 2) { LruP lp{P, a.in[I_LCW] + l * 2048, a.in[I_LCB] + l * 512, a.in[I_LBA] + l * 512, a.in[I_LBX] + l * 512, sm + SM_SP8, (const bf16_t*)((const unsigned char*)sm + SM_LRUW_BYTES), (bf16_t*)(ws + WS_O), ST + ST_LRU};
      for (int itx = blockIdx.x; itx < BG * NSEGL; itx += G) { if (!PASSC && itx % NSEGL == NSEGL - 1) continue; lru_wave<PASSC>(lds + w * LR_WAVE, lp, itx / NSEGL, itx % NSEGL, w, ln); } }
    if (mmask & 4) { S5P sp_{P, sm, (const bf16_t*)((const unsigned char*)sm + SM_CT_BYTES), (const bf16_t*)((const unsigned char*)sm + SM_BBT_BYTES), sm + SM_A128, a.in[I_SD] + l * 512, (bf16_t*)(ws + WS_Y5), ST + ST_S5};
      for (int itx = blockIdx.x; itx < BG * NSEGS * 4; itx += G) { if (!PASSC && (itx >> 2) % NSEGS == NSEGS - 1) continue; s5_wave<PASSC>(lds + w * LR_WAVE, sp_, itx / (NSEGS * 4), (itx >> 2) % NSEGS, 8 * (itx & 3) + w, ln); } }
    WGSYNC();
}

constexpr int NPH = 8, NSTEPS = 1 + NGRP * DEPTH * NPH;
constexpr int LDS_BYTES = 147456, LDS_MISC = 131072 + 320;

__global__ void __launch_bounds__(512, 2) mk_fwd(Args a) {
    __shared__ __attribute__((aligned(16))) unsigned char lds_raw[LDS_BYTES];
    LAS unsigned char* lds = (LAS unsigned char*)lds_raw;
    volatile LAS unsigned* MISC = (volatile LAS unsigned*)(lds + LDS_MISC);
    const int G = gridDim.x;
    if (threadIdx.x < 32) MISC[threadIdx.x] = 0u;
    __syncthreads();
    unsigned* ctl = (unsigned*)(a.ws + WS_CTL);
    XcdBarrier bar = xcd_barrier_post(ctl + CW_BAR + a.li * XCD_BAR_WORDS, MISC + 8);
    const int ngw = G * 8, gthreads = G * 512;
#define LTID(v) int v = threadIdx.x; asm volatile("" : "+v"(v))
#define IN(s) (a.s_lo <= (s) && (s) < a.s_hi)
#define SEAM(s) do { if ((s) + 1 < a.s_hi) xcd_barrier(bar); } while (0)
    if (IN(0)) { LTID(t_); phase_prologue(a, blockIdx.x * 512 + t_, gthreads); SEAM(0); }
    for (int gl = 0; gl < NGRP * DEPTH; ++gl) {
        const int grp = gl >> 2, l = gl & 3, s0 = 1 + gl * NPH;
        if (a.s_hi <= s0 || a.s_lo >= s0 + NPH) continue;
        unsigned char* ws = a.ws;
        const bf16_t* Wl = (const bf16_t*)(ws + WS_W + (size_t)l * W_STRIDE);
        const float* sm = (const float*)(ws + WS_SMALL + (size_t)l * SMALL_STRIDE);
        bf16_t* U = (bf16_t*)(ws + WS_U); bf16_t* P = (bf16_t*)(ws + WS_P); float* LA = (float*)(ws + WS_LA);
        bf16_t* O = (bf16_t*)(ws + WS_O); bf16_t* Y5 = (bf16_t*)(ws + WS_Y5); bf16_t* PGb = (bf16_t*)(ws + WS_PG);
        const float* xg = a.in[I_X] + (size_t)grp * TG * D; float* og = a.out + (size_t)grp * TG * D;
        const float* hin = (l <= 1) ? xg : og;
        bf16_t* DLT = (bf16_t*)(ws + WS_O);
        (void)sm;
        if (IN(s0 + 0)) { LTID(t_); const int gw_ = blockIdx.x * 8 + __builtin_amdgcn_readfirstlane(t_ >> 6);
            if (l == 0) phase_norm<false, false>(hin, DLT, og, a.in[I_NG] + l * D, U, gw_, ngw, t_ & 63); else phase_norm<false, true>(hin, DLT, og, a.in[I_NG] + l * D, U, gw_, ngw, t_ & 63);
            SEAM(s0 + 0); }
        if (IN(s0 + 1)) {
            pg8::Gemm g{U, Wl, TG, N_ALL, D, D, D, 0, 0}; pg8::StaticOrder S; S.init(TG, N_ALL, G, (int)blockIdx.x, 0, 256, WGM_G1);
            EpiIn E{P, LA, a.in[I_GBLR] + l * 256, (const float*)(ws + WS_ROT), PGb};
            GEMM_CALL(EpiIn);
            SEAM(s0 + 1);
        }
        if (IN(s0 + 2)) { phase_mixers<false>(lds, a, l, G); SEAM(s0 + 2); }
        if (IN(s0 + 3)) { phase_mixers<true>(lds, a, l, G); SEAM(s0 + 3); }
        if (IN(s0 + 4)) {
            { pg8::Gemm g{Y5, (const bf16_t*)((const unsigned char*)Wl + WO_GLU), TG, BW, BW, BW, BW, 0, 0}; pg8::StaticOrder S; S.init(TG, BW, G, (int)blockIdx.x, 0, 256, WGM_GLU);
              EpiGlu E{Y5, P, a.in[I_SGB] + l * BW, O};
              GEMM_CALL(EpiGlu); }
            SEAM(s0 + 4);
        }
        if (IN(s0 + 6)) {
            { pg8::Gemm g{O, (const bf16_t*)((const unsigned char*)Wl + WO_BR), TG, D, BW, OLD, BW, (size_t)BW * 2, (size_t)D * BW * 2}; pg8::StaticOrder S; S.init(TG, D, G, (int)blockIdx.x, 2, 128, WGM_G2);
              EpiBr E{PGb, U};
              pg8::gemm_phase<EpiBr, pg8::StaticOrder, true, true, true>(lds, g, S, E); }
            SEAM(s0 + 6);
        }
        if (IN(s0 + 7)) {
            if (a.fin != 2) { pg8::Gemm g{U, (const bf16_t*)((const unsigned char*)Wl + WO_OUT), TG, D, D, D, D, 0, 0}; pg8::StaticOrder S; S.init(TG, D, G, (int)blockIdx.x, 0, 256, WGM_G3);
              EpiOut E{DLT};
              GEMM_CALL(EpiOut); }
            if (l == 3 && a.fin) { if (a.fin == 1) xcd_barrier(bar); LTID(t_); phase_norm<true, true>(og, DLT, og, a.in[I_FNG], U, blockIdx.x * 8 + __builtin_amdgcn_readfirstlane(t_ >> 6), ngw, t_ & 63); }
            SEAM(s0 + 7);
        }
    }
#undef IN
#undef SEAM
}

extern "C" void kernel_launch(void* const* d_in, const int* in_sizes, int n_in, void* d_out, int out_size, void* d_ws, size_t ws_size, hipStream_t stream) {
    static int grid = 0;
    if (grid == 0) {
        static const int exp_sizes[29] = {67108864, 4096, 21037056, 16384, 1024, 2048, 2048, 2048, 8192, 2048, 131072, 2048, 131072, 2048, 2048, 8192, 8192, 131072, 131072, 131072, 131072, 2048, 128, 1048576, 2048, 16777216, 8388608, 4194304, 1024};
        bool ok_sizes = (n_in == 29); if (ok_sizes) for (int i = 0; i < 29; ++i) if (in_sizes[i] != exp_sizes[i]) { fprintf(stderr, "kernel_launch: input %d has %d elements, expected %d\n", i, in_sizes[i], exp_sizes[i]); ok_sizes = false; }
        if (!ok_sizes || out_size != NB * SEQ * D || ws_size < WS_END) { fprintf(stderr, "kernel_launch: unexpected shapes (n_in %d out %d ws %zu)\n", n_in, out_size, ws_size); grid = -1; return; }
        int dev = 0, cus = 0, per_cu = 0;
        hipGetDevice(&dev); hipDeviceGetAttribute(&cus, hipDeviceAttributeMultiprocessorCount, dev);
        hipOccupancyMaxActiveBlocksPerMultiprocessor(&per_cu, (const void*)mk_fwd, 512, 0);
        (void)hipGetLastError();
        grid = cus > 0 ? cus : 256;
        if (per_cu < 1) fprintf(stderr, "kernel_launch: occupancy query says %d\n", per_cu);
    }
    if (grid < 0) return;
    hipMemsetAsync((char*)d_ws + WS_CTL, 0, CTL_BYTES, stream);
    Args a{};
    for (int i = 0; i < 29; ++i) a.in[i] = (const float*)d_in[i];
    a.out = (float*)d_out; a.ws = (unsigned char*)d_ws;
    unsigned char* ws = (unsigned char*)d_ws;
    int li = 0;
    auto run = [&](int lo, int hi, int fin = 1, int mm = 7) { a.s_lo = lo; a.s_hi = hi; a.li = li++; a.fin = fin; a.mmask = mm; a.pad2 = 0; hipLaunchKernelGGL(mk_fwd, dim3(grid), dim3(512), 0, stream, a); };
    run(0, NSTEPS);
}
```

```cpp
#include <hip/hip_runtime.h>
#ifndef WGM_G1
#define WGM_G1 4
#endif
#ifndef WGM_G2
#define WGM_G2 8
#endif
#ifndef WGM_G3
#define WGM_G3 8
#endif
#ifndef WGM_GLU
#define WGM_GLU 8
#endif
#include <cstdio>
#include <cstdint>


namespace pg8 {
#define PG8_LAS __attribute__((address_space(3)))
typedef unsigned short bf16_t;
typedef short bf16x8 __attribute__((ext_vector_type(8)));
typedef float f32x4 __attribute__((ext_vector_type(4)));
typedef unsigned u32x4 __attribute__((ext_vector_type(4)));
typedef unsigned u32x2 __attribute__((ext_vector_type(2)));
constexpr int BM = 256, BK = 64, HALF = 128, HTB = HALF * BK * 2, STAGE_BYTES = 8 * HTB, NXCD = 8;

__host__ __device__ __forceinline__ int lds_byte(int r, int c) { const int st = (r >> 4) * 2 + (c >> 5), rr = r & 15, cc = c & 31, ob = rr * 64 + cc * 2; return st * 1024 + (ob ^ (((ob >> 9) & 1) << 5)); }
__host__ __device__ __forceinline__ void stage_rc(int b, int& R, int& C) { const int st = b / 1024, sb = b % 1024, swz = sb ^ (((sb >> 9) & 1) << 5); R = (st >> 1) * 16 + swz / 64; C = (st & 1) * 32 + (swz % 64) / 2; }
__host__ __device__ __forceinline__ int perm32(int rho) { const int n = rho >> 4, i = rho & 15; return 8 * (i >> 2) + 4 * n + (i & 3); }

struct Unit { int pm, pn, z; };
struct Gemm { const bf16_t* A; const bf16_t* Bt; int M, N, K, lda, ldb; size_t zA, zB; };

struct StaticOrder {
    int nM, nN, nwg, G, c, zsh, WGM;
    __host__ __device__ void init(int M, int N, int G_, int c_, int zsh_ = 0, int bn_ = BM, int wgm_ = 4) { nM = M / BM; nN = N / bn_; nwg = nM * nN; G = G_; c = c_; zsh = zsh_; WGM = wgm_; }
    __host__ __device__ bool next(int i, Unit& u) const {
        const int ti = i >> zsh; u.z = i & ((1 << zsh) - 1);
        const long L = (long)ti * G + c; if (L >= nwg) return false;
        int wgid = (int)L; { const int q = nwg / NXCD, r = nwg % NXCD, xcd = wgid % NXCD, off = wgid / NXCD; wgid = (xcd < r ? xcd * (q + 1) : r * (q + 1) + (xcd - r) * q) + off; }
        const int nig = WGM * nN, gid = wgid / nig, fm = gid * WGM, gsz = (nM - fm) < WGM ? (nM - fm) : WGM;
        u.pm = fm + ((wgid % nig) % gsz); u.pn = (wgid % nig) / gsz; return true;
    }
    __device__ __forceinline__ void a_ready(const Unit&) const {}
    __device__ __forceinline__ void done(const Unit&) const {}
};

typedef float f32x2_ __attribute__((ext_vector_type(2)));
typedef __bf16 bf16x2_ __attribute__((ext_vector_type(2)));
__device__ __forceinline__ unsigned cvt_pk_bf16(float lo, float hi) { const f32x2_ v = {lo, hi}; const bf16x2_ b = __builtin_convertvector(v, bf16x2_); return __builtin_bit_cast(unsigned, b); }

template <class Epi, class Sched, bool ALIGN_EPI = false, bool SP2 = false, bool HALFN = false>
__device__ __forceinline__ void gemm_phase(PG8_LAS unsigned char* lds, const Gemm g, const Sched& S, const Epi& E) {
    int tid = threadIdx.x; asm volatile("" : "+v"(tid));
    const int wid = __builtin_amdgcn_readfirstlane(tid >> 6), lane = tid & 63, wr = wid >> 2, wc = wid & 3, fr = lane & 15, fq = lane >> 4;
    const int K = g.K, nt = K / BK;
    unsigned voffA[2], voffB[2];
#pragma unroll
    for (int i = 0; i < 2; ++i) { int R, C; stage_rc(tid * 16 + i * 8192, R, C); const int Rb = Epi::PERM ? ((R & ~31) + perm32(R & 31)) : R;
        voffA[i] = (unsigned)(R * g.lda + C) * 2u; voffB[i] = (unsigned)(Rb * g.ldb + C) * 2u; }
    const size_t kstep = (size_t)(BK * 2);
    const size_t hstepA = (size_t)HALF * g.lda * 2, hstepB = (size_t)HALF * g.ldb * 2;
    const size_t tstepA = 2 * hstepA, tstepB = HALFN ? hstepB : 2 * hstepB;
    const unsigned ldsw = (unsigned)wid * 1024u;
    unsigned aoff = (unsigned)lds_byte(wr * 64 + fr, fq * 8), boff = (unsigned)lds_byte(wc * 32 + fr, fq * 8) + 4u * HTB;
    asm volatile("" : "+v"(aoff), "+v"(boff));
#define PG8_SA(b, h) (((b) * 2 + (h)) * HTB)
#define PG8_SB(b, h) ((4 + (b) * 2 + (h)) * HTB)
#define PG8_STAGE(bufoff, gbase, voff) do { _Pragma("unroll") for (int _i = 0; _i < 2; ++_i) \
        __builtin_amdgcn_global_load_lds((const unsigned*)((const char*)(gbase) + (voff)[_i]), (PG8_LAS unsigned*)(lds + (bufoff) + ldsw + _i * 8192), 16, 0, 0); } while (0)
#define PG8_LDA(dst, b, h) do { _Pragma("unroll") for (int m = 0; m < 4; ++m) _Pragma("unroll") for (int k = 0; k < 2; ++k) dst[m][k] = *(const PG8_LAS bf16x8*)(lds + aoff + (PG8_SA(b, h) + m * 2048 + k * 1024)); } while (0)
#define PG8_LDB(dst, b, h) do { _Pragma("unroll") for (int n = 0; n < 2; ++n) _Pragma("unroll") for (int k = 0; k < 2; ++k) dst[n][k] = *(const PG8_LAS bf16x8*)(lds + boff + (((b) * 2 + (h)) * HTB + n * 2048 + k * 1024)); } while (0)
#define PG8_MMA(ai, bj, At, Bt) do { __builtin_amdgcn_s_setprio(1); _Pragma("unroll") for (int m = 0; m < 4; ++m) _Pragma("unroll") for (int n = 0; n < 2; ++n) _Pragma("unroll") for (int k = 0; k < 2; ++k) \
        acc[ai][bj][m][n] = __builtin_amdgcn_mfma_f32_16x16x32_bf16(Bt[n][k], At[m][k], acc[ai][bj][m][n], 0, 0, 0); __builtin_amdgcn_s_setprio(0); } while (0)
#define PG8_WAIT_V(n) asm volatile("s_waitcnt vmcnt(" #n ")" ::: "memory")
#define PG8_WAIT_L(n) asm volatile("s_waitcnt lgkmcnt(" #n ")" ::: "memory")
#define PG8_BAR __builtin_amdgcn_s_barrier()
#define PG8_SCHED __builtin_amdgcn_sched_barrier(0)
    Unit cur, nxt; int ui = 0;
    if (!S.next(0, cur)) return;
    f32x4 acc[2][2][4][2];
#pragma unroll
    for (int a = 0; a < 2; ++a)
#pragma unroll
        for (int b = 0; b < 2; ++b)
#pragma unroll
            for (int m = 0; m < 4; ++m)
#pragma unroll
                for (int n = 0; n < 2; ++n) acc[a][b][m][n] = (f32x4){0.f, 0.f, 0.f, 0.f};
    bf16x8 At[4][2], B0[2][2], B1[2][2];
    const char* cA = (const char*)g.A + (size_t)cur.pm * tstepA + (size_t)cur.z * g.zA; const char* cB = (const char*)g.Bt + (size_t)cur.pn * tstepB + (size_t)cur.z * g.zB;
    S.a_ready(cur);
    if constexpr (SP2 && HALFN) {
        PG8_STAGE(PG8_SB(0, 0), cB, voffB); PG8_STAGE(PG8_SA(0, 0), cA, voffA); PG8_STAGE(PG8_SA(0, 1), cA + hstepA, voffA);
        if (wr == 1) PG8_BAR;
        PG8_WAIT_V(2); PG8_BAR;
        PG8_STAGE(PG8_SB(1, 0), cB + kstep, voffB); PG8_STAGE(PG8_SA(1, 0), cA + kstep, voffA);
        PG8_WAIT_V(4); PG8_BAR;
    } else if constexpr (SP2) {
        PG8_STAGE(PG8_SB(0, 0), cB, voffB); PG8_STAGE(PG8_SB(0, 1), cB + hstepB, voffB); PG8_STAGE(PG8_SA(0, 0), cA, voffA); PG8_STAGE(PG8_SA(0, 1), cA + hstepA, voffA);
        if (wr == 1) PG8_BAR;
        PG8_WAIT_V(2); PG8_BAR;
        PG8_STAGE(PG8_SB(1, 0), cB + kstep, voffB); PG8_STAGE(PG8_SA(1, 0), cA + kstep, voffA); PG8_STAGE(PG8_SB(1, 1), cB + hstepB + kstep, voffB);
        PG8_WAIT_V(6); PG8_BAR;
    } else {
        PG8_STAGE(PG8_SB(0, 0), cB, voffB); PG8_STAGE(PG8_SA(0, 0), cA, voffA); PG8_STAGE(PG8_SB(0, 1), cB + hstepB, voffB); PG8_STAGE(PG8_SA(0, 1), cA + hstepA, voffA);
        if (wr == 1) PG8_BAR;
        PG8_WAIT_V(4); PG8_BAR;
        PG8_STAGE(PG8_SB(1, 0), cB + kstep, voffB); PG8_STAGE(PG8_SA(1, 0), cA + kstep, voffA); PG8_STAGE(PG8_SB(1, 1), cB + hstepB + kstep, voffB);
        PG8_WAIT_V(6); PG8_BAR;
    }
    for (;;) {
        const bool has_next = S.next(ui + 1, nxt);
        const char* nA = has_next ? (const char*)g.A + (size_t)nxt.pm * tstepA + (size_t)nxt.z * g.zA : cA; const char* nB = has_next ? (const char*)g.Bt + (size_t)nxt.pn * tstepB + (size_t)nxt.z * g.zB : cB;
        for (int t = 0; t < nt; t += 2) {
            const bool last = (t == nt - 2);
            const char* a1 = cA + (size_t)(t + 1) * kstep;
            const char* a2 = last ? nA : cA + (size_t)(t + 2) * kstep; const char* b2 = last ? nB : cB + (size_t)(t + 2) * kstep;
            const char* a3 = a2 + kstep; const char* b3 = b2 + kstep;
            if (last && has_next) S.a_ready(nxt);
            if constexpr (SP2 && HALFN) {
            PG8_LDB(B0, 0, 0); PG8_SCHED; PG8_LDA(At, 0, 0); PG8_STAGE(PG8_SA(1, 1), a1 + hstepA, voffA);
            PG8_WAIT_V(6); PG8_WAIT_L(0); PG8_BAR; PG8_MMA(0, 0, At, B0); PG8_BAR; PG8_SCHED;
            PG8_LDA(At, 0, 1); PG8_STAGE(PG8_SB(0, 0), b2, voffB); PG8_STAGE(PG8_SA(0, 0), a2, voffA);
            PG8_WAIT_V(6); PG8_WAIT_L(0); PG8_BAR; PG8_MMA(1, 0, At, B0); PG8_BAR; PG8_SCHED;
            PG8_LDB(B0, 1, 0); PG8_SCHED; PG8_LDA(At, 1, 0); PG8_STAGE(PG8_SA(0, 1), a2 + hstepA, voffA);
            PG8_WAIT_V(6); PG8_WAIT_L(0); PG8_BAR; PG8_MMA(0, 0, At, B0); PG8_BAR; PG8_SCHED;
            PG8_LDA(At, 1, 1); PG8_STAGE(PG8_SB(1, 0), b3, voffB); PG8_STAGE(PG8_SA(1, 0), a3, voffA);
            PG8_WAIT_V(6); PG8_WAIT_L(0); PG8_BAR; PG8_MMA(1, 0, At, B0); PG8_BAR; PG8_SCHED;
            } else if constexpr (SP2) {
            PG8_LDB(B0, 0, 0); PG8_LDB(B1, 0, 1); PG8_SCHED; PG8_LDA(At, 0, 0); PG8_STAGE(PG8_SA(1, 1), a1 + hstepA, voffA);
            PG8_WAIT_V(8); PG8_WAIT_L(0); PG8_BAR; PG8_MMA(0, 0, At, B0); PG8_MMA(0, 1, At, B1); PG8_BAR; PG8_SCHED;
            PG8_LDA(At, 0, 1); PG8_STAGE(PG8_SB(0, 0), b2, voffB); PG8_STAGE(PG8_SB(0, 1), b2 + hstepB, voffB); PG8_STAGE(PG8_SA(0, 0), a2, voffA);
            PG8_WAIT_V(8); PG8_WAIT_L(0); PG8_BAR; PG8_MMA(1, 0, At, B0); PG8_MMA(1, 1, At, B1); PG8_BAR; PG8_SCHED;
            PG8_LDB(B0, 1, 0); PG8_LDB(B1, 1, 1); PG8_SCHED; PG8_LDA(At, 1, 0); PG8_STAGE(PG8_SA(0, 1), a2 + hstepA, voffA);
            PG8_WAIT_V(8); PG8_WAIT_L(0); PG8_BAR; PG8_MMA(0, 0, At, B0); PG8_MMA(0, 1, At, B1); PG8_BAR; PG8_SCHED;
            PG8_LDA(At, 1, 1); PG8_STAGE(PG8_SB(1, 0), b3, voffB); PG8_STAGE(PG8_SB(1, 1), b3 + hstepB, voffB); PG8_STAGE(PG8_SA(1, 0), a3, voffA);
            PG8_WAIT_V(8); PG8_WAIT_L(0); PG8_BAR; PG8_MMA(1, 0, At, B0); PG8_MMA(1, 1, At, B1); PG8_BAR; PG8_SCHED;
            } else {
            PG8_LDB(B0, 0, 0); PG8_SCHED; PG8_LDA(At, 0, 0); PG8_STAGE(PG8_SA(1, 1), a1 + hstepA, voffA);
            PG8_WAIT_L(8); PG8_BAR; PG8_WAIT_L(0); PG8_MMA(0, 0, At, B0); PG8_BAR; PG8_SCHED;
            PG8_LDB(B1, 0, 1); PG8_STAGE(PG8_SB(0, 0), b2, voffB);
            PG8_BAR; PG8_WAIT_L(0); PG8_MMA(0, 1, At, B1); PG8_BAR;
            PG8_LDA(At, 0, 1); PG8_STAGE(PG8_SA(0, 0), a2, voffA);
            PG8_BAR; PG8_WAIT_L(0); PG8_MMA(1, 0, At, B0); PG8_BAR; PG8_SCHED;
            PG8_STAGE(PG8_SB(0, 1), b2 + hstepB, voffB);
            PG8_WAIT_V(6); PG8_BAR; PG8_MMA(1, 1, At, B1); PG8_BAR;
            PG8_LDB(B0, 1, 0); PG8_SCHED; PG8_LDA(At, 1, 0); PG8_STAGE(PG8_SA(0, 1), a2 + hstepA, voffA);
            PG8_WAIT_L(8); PG8_BAR; PG8_WAIT_L(0); PG8_MMA(0, 0, At, B0); PG8_BAR; PG8_SCHED;
            PG8_LDB(B1, 1, 1); PG8_STAGE(PG8_SB(1, 0), b3, voffB);
            PG8_BAR; PG8_WAIT_L(0); PG8_MMA(0, 1, At, B1); PG8_BAR;
            PG8_LDA(At, 1, 1); PG8_STAGE(PG8_SA(1, 0), a3, voffA);
            PG8_BAR; PG8_WAIT_L(0); PG8_MMA(1, 0, At, B0); PG8_BAR; PG8_SCHED;
            PG8_STAGE(PG8_SB(1, 1), b3 + hstepB, voffB);
            PG8_WAIT_V(6); PG8_BAR; PG8_MMA(1, 1, At, B1); PG8_BAR;
            }
        }
        if constexpr (ALIGN_EPI) { if (wr == 0) PG8_BAR; }
        { int fr_e = fr, fq_e = fq; asm volatile("" : "+v"(fr_e), "+v"(fq_e));
          E(acc, cur, wr, wc, fr_e, fq_e); }
        if (!has_next) break;
        if (!HALFN && !(Epi::KEEP && cur.z != 3)) {
#pragma unroll
        for (int a = 0; a < 2; ++a)
#pragma unroll
            for (int b = 0; b < 2; ++b)
#pragma unroll
                for (int m = 0; m < 4; ++m)
#pragma unroll
                    for (int n = 0; n < 2; ++n) acc[a][b][m][n] = (f32x4){0.f, 0.f, 0.f, 0.f};
        }
        cur = nxt; cA = nA; cB = nB; ++ui;
        if constexpr (ALIGN_EPI) { if (wr == 1) PG8_BAR; }
    }
    PG8_WAIT_V(0);
    if constexpr (!ALIGN_EPI) { if (wr == 0) PG8_BAR; }
    PG8_BAR;
#undef PG8_SA
#undef PG8_SB
#undef PG8_STAGE
#undef PG8_LDA
#undef PG8_LDB
#undef PG8_MMA
#undef PG8_WAIT_V
#undef PG8_WAIT_L
#undef PG8_BAR
#undef PG8_SCHED
}

}

using pg8::bf16_t; using pg8::f32x4; using pg8::u32x4; using pg8::u32x2; using pg8::bf16x8; using pg8::cvt_pk_bf16;
#define LAS __attribute__((address_space(3)))

constexpr int D = 1024, SEQ = 4096, NB = 16, DEPTH = 4, BW = 512;
constexpr int NGRP = 2, BG = NB / NGRP, TG = BG * SEQ;
constexpr int N_IN = 21 * 256, N_MG = 4096, N_ALL = N_IN + N_MG;
constexpr int PLD = 20 * 256;
constexpr int P_GQ = 0, P_GK = 256, P_GV = 512, P_GG = 1024, P_RQ = 1536, P_RK = 1792, P_RV = 2048, P_RG = 2560, P_LX = 3072, P_LG = 3584, P_SU = 4096, P_SG = 4608;
constexpr int OLD = 2048;
constexpr float NORM_EPS = 1e-6f;

constexpr size_t MiB = 1u << 20;
constexpr size_t WS_CTL = 0, CTL_BYTES = 2 * MiB;
constexpr size_t WS_ROT = 2 * MiB;
constexpr size_t WS_SMALL = 3 * MiB, SMALL_STRIDE = 1 * MiB;
constexpr size_t WS_W = 8 * MiB, W_STRIDE = 26 * MiB;
constexpr size_t WO_IN = 0, WO_BR = (size_t)N_ALL * D * 2, WO_OUT = WO_BR + (size_t)4 * D * BW * 2, WO_GLU = WO_OUT + (size_t)D * D * 2, WO_END = WO_GLU + (size_t)BW * BW * 2;
static_assert(WO_END <= W_STRIDE, "weights");
constexpr size_t WS_U = 112 * MiB;
constexpr size_t WS_P = 176 * MiB;
constexpr size_t WS_LA = 496 * MiB;
constexpr size_t WS_O = 528 * MiB;
constexpr size_t WS_Y5 = 656 * MiB;
constexpr size_t WS_PG = 688 * MiB;
constexpr size_t WS_ST = 944 * MiB;
constexpr size_t WS_END = 1008 * MiB;
constexpr int SM_ABR = 0, SM_ABI = 2048, SM_BBR = 4096, SM_BBI = 4096 + 32768, SM_SP8 = 4096 + 65536, SM_END_F = SM_SP8 + 512;
constexpr int SM_A128 = SM_END_F;
constexpr size_t SM_LRUW_BYTES = 512 * 1024, SM_CT_BYTES = 640 * 1024, SM_BBT_BYTES = 768 * 1024;
static_assert((size_t)(SM_END_F + 4096) * 4 <= SM_LRUW_BYTES, "small");

constexpr int CW_BAR = 4096;
#define XB_TMO      128
#define XB_XCNT(j)  (256  + 64 * (j))
#define XB_XSUB(j)  (1280 + 64 * (j))
#define XB_XGEN(j)  (2304 + 64 * (j))
#define XB_TOP      3328
#define XB_TOPGEN   3392
#define XCD_BAR_WORDS 3456
#define XB_SPIN_CAP (1u << 18)

__device__ __forceinline__ unsigned xb_ld(unsigned* p)              { return __hip_atomic_load(p, __ATOMIC_RELAXED, __HIP_MEMORY_SCOPE_AGENT); }
__device__ __forceinline__ unsigned xb_add(unsigned* p, unsigned v) { return __hip_atomic_fetch_add(p, v, __ATOMIC_RELAXED, __HIP_MEMORY_SCOPE_AGENT); }
__device__ __forceinline__ unsigned xb_xcc_id() { return (unsigned)__builtin_amdgcn_s_getreg((3 << 11) | 20) & 0xFu; }
#define XB_SPIN(cond, bar) do { unsigned _sp = 0; while (cond) { __builtin_amdgcn_s_sleep(1); \
    if ((++_sp & 255u) == 0u) { if (xb_ld(&(bar)[XB_TMO])) break; if (_sp > XB_SPIN_CAP) { atomicAdd(&(bar)[XB_TMO], 1u); break; } } } } while (0)
struct XcdBarrier { unsigned* bar; unsigned x; volatile LAS unsigned* st; };
__device__ __forceinline__ XcdBarrier xcd_barrier_post(unsigned* bar, volatile LAS unsigned* st) {
    XcdBarrier b; b.bar = bar; b.x = xb_xcc_id(); b.st = st;
    if (threadIdx.x == 0) (void)xb_add(&bar[XB_XCNT(b.x)], 1u);
    return b;
}
__device__ __forceinline__ void xcd_barrier_complete(unsigned* bar, unsigned x, unsigned& nloc, unsigned& nx) {
    const unsigned G = gridDim.x * gridDim.y * gridDim.z;
    unsigned sum, cnt, mine, sp = 0u;
    for (;;) {
        sum = 0u; cnt = 0u; mine = 0u;
#pragma unroll
        for (unsigned j = 0; j < 16; ++j) { const unsigned c = xb_ld(&bar[XB_XCNT(j)]); sum += c; cnt += (c > 0u) ? 1u : 0u; mine = (j == x) ? c : mine; }
        if (sum == G) break;
        __builtin_amdgcn_s_sleep(1);
        if ((++sp & 255u) == 0u) { if (xb_ld(&bar[XB_TMO])) break; if (sp > XB_SPIN_CAP) { atomicAdd(&bar[XB_TMO], 1u); break; } }
    }
    nloc = mine > 0u ? mine : 1u; nx = cnt > 0u ? cnt : 1u;
}
__device__ __forceinline__ void xcd_barrier(const XcdBarrier& b) {
    asm volatile("s_waitcnt vmcnt(0)" ::: "memory");
    __syncthreads();
    if (threadIdx.x == 0) {
        unsigned* bar = b.bar;
        __builtin_amdgcn_s_waitcnt(0);
        unsigned nloc = b.st[0], nx = b.st[1];
        if (nloc == 0u) { xcd_barrier_complete(bar, b.x, nloc, nx); b.st[0] = nloc; b.st[1] = nx; }
        const unsigned old = xb_add(&bar[XB_XSUB(b.x)], 1u);
        const unsigned gen = old / nloc;
        if (old + 1u == (gen + 1u) * nloc) {
            __builtin_amdgcn_fence(__ATOMIC_RELEASE, "agent");
            asm volatile("s_waitcnt vmcnt(0)" ::: "memory");
            const unsigned og = xb_add(&bar[XB_TOP], 1u);
            const unsigned tg = og / nx;
            if (og + 1u == (tg + 1u) * nx) xb_add(&bar[XB_TOPGEN], 1u);
            else XB_SPIN(xb_ld(&bar[XB_TOPGEN]) == tg, bar);
            __builtin_amdgcn_fence(__ATOMIC_ACQUIRE, "agent");
            xb_add(&bar[XB_XGEN(b.x)], 1u);
            asm volatile("s_waitcnt vmcnt(0)" ::: "memory");
        } else {
            XB_SPIN(xb_ld(&bar[XB_XGEN(b.x)]) == gen, bar);
            __builtin_amdgcn_fence(__ATOMIC_ACQUIRE, "agent");
            asm volatile("s_waitcnt vmcnt(0)" ::: "memory");
        }
    }
    __syncthreads();
}

__device__ __forceinline__ float bf2f(bf16_t b) { return __uint_as_float(((unsigned)b) << 16); }
__device__ __forceinline__ float bflo(unsigned w) { return __uint_as_float(w << 16); }
__device__ __forceinline__ float bfhi(unsigned w) { return __uint_as_float(w & 0xffff0000u); }
__device__ __forceinline__ bf16_t f2bf(float f) { return (bf16_t)(cvt_pk_bf16(f, 0.f) & 0xffffu); }
__device__ __forceinline__ float sigmoid_f(float x) { return __builtin_amdgcn_rcpf(1.f + __expf(-x)); }
__device__ __forceinline__ float silu_f(float x) { return x * sigmoid_f(x); }
__device__ __forceinline__ float gelu_tanh_f(float x) { const float u = 0.7978845608028654f * (x + 0.044715f * x * x * x); const float t = 1.f - 2.f * __builtin_amdgcn_rcpf(1.f + __expf(2.f * u)); return 0.5f * x * (1.f + t); }
__device__ __forceinline__ float wave_sum(float v) {
#pragma unroll
    for (int o = 1; o < 64; o <<= 1) v += __shfl_xor(v, o);
    return v;
}

#define GEMM_CALL(EPI) pg8::gemm_phase<EPI, pg8::StaticOrder, true, true>(lds, g, S, E)
struct Args {
    const float* in[29]; float* out; unsigned char* ws;
    int s_lo, s_hi, li, fin, mmask, pad2;
};
enum { I_X = 0, I_NG, I_WIN, I_GWLR, I_GBLR, I_GNG, I_RNG, I_RNB, I_LCW, I_LCB, I_LWA, I_LBA, I_LWX, I_LBX, I_LLAM,
       I_SARE, I_SAIM, I_SBRE, I_SBIM, I_SCRE, I_SCIM, I_SD, I_SLDT, I_SGW, I_SGB, I_WMG, I_WBR, I_WOUT, I_FNG };

struct EpiIn {
    static constexpr bool PERM = true, AFTER_DRAIN = false, KEEP = false;
    bf16_t* P; float* LA; const float* blr; const float* rot; bf16_t* PG;
    __device__ __forceinline__ void operator()(f32x4 (&acc)[2][2][4][2], const pg8::Unit& u, int wr, int wc, int fr, int fq) const {
        const int pn = u.pn, row0 = u.pm * 256 + wr * 64 + fr, cl = wc * 32 + 8 * fq;
        if (pn >= 21) {
            const int c0 = (pn - 21) * 256 + cl;
#pragma unroll
            for (int ai = 0; ai < 2; ++ai)
#pragma unroll
                for (int m = 0; m < 4; ++m) { int row = row0 + ai * 128 + m * 16; asm volatile("" : "+v"(row));
#pragma unroll
                    for (int bj = 0; bj < 2; ++bj) { f32x4 v0 = acc[ai][bj][m][0], v1 = acc[ai][bj][m][1];
#pragma unroll
                        for (int j = 0; j < 4; ++j) { v0[j] = sigmoid_f(v0[j]); v1[j] = sigmoid_f(v1[j]); }
                        u32x4 w; w.x = cvt_pk_bf16(v0[0], v0[1]); w.y = cvt_pk_bf16(v0[2], v0[3]); w.z = cvt_pk_bf16(v1[0], v1[1]); w.w = cvt_pk_bf16(v1[2], v1[3]);
                        __builtin_nontemporal_store(w, (u32x4*)(PG + (size_t)row * N_MG + c0 + bj * 128)); } }
        } else if (pn == 4) {
#pragma unroll
            for (int bj = 0; bj < 2; ++bj) { const int c = cl + bj * 128; const f32x4 b0 = *(const f32x4*)(blr + c), b1 = *(const f32x4*)(blr + c + 4);
#pragma unroll
                for (int ai = 0; ai < 2; ++ai) {
#pragma unroll
                    for (int n = 0; n < 2; ++n)
#pragma unroll
                        for (int j = 0; j < 4; ++j) { float run = 0.f; const float bb = n ? b1[j] : b0[j];
#pragma unroll
                            for (int m = 0; m < 4; ++m) { const float z = acc[ai][bj][m][n][j] + bb; const float x = -(fmaxf(-z, 0.f) + __logf(1.f + __expf(-fabsf(z)))) * 0.0625f; float ls = x, rs = x;
#define DPP_ADD(acc_, ctrl_) acc_ += __builtin_bit_cast(float, __builtin_amdgcn_update_dpp(0, __builtin_bit_cast(int, acc_), ctrl_, 0xf, 0xf, true))
                                DPP_ADD(ls, 0x111); DPP_ADD(ls, 0x112); DPP_ADD(ls, 0x114); DPP_ADD(ls, 0x118);
                                DPP_ADD(rs, 0x101); DPP_ADD(rs, 0x102); DPP_ADD(rs, 0x104); DPP_ADD(rs, 0x108);
#undef DPP_ADD
                                acc[ai][bj][m][n][j] = run + ls; run += ls + rs - x; } }
#pragma unroll
                    for (int m = 0; m < 4; ++m) { int row = row0 + ai * 128 + m * 16; asm volatile("" : "+v"(row)); float* d = LA + (size_t)row * 256 + c; *(f32x4*)d = acc[ai][bj][m][0]; *(f32x4*)(d + 4) = acc[ai][bj][m][1]; } } }
        } else if (pn == 7 || pn == 8) {
            const float sc = pn == 8 ? 0.125f : 1.f; const int dcol = (pn - 1) * 256;
#pragma unroll
            for (int ai = 0; ai < 2; ++ai)
#pragma unroll
                for (int m = 0; m < 4; ++m) { int row = row0 + ai * 128 + m * 16; asm volatile("" : "+v"(row)); const int pos = row & (SEQ - 1);
#pragma unroll
                    for (int bj = 0; bj < 2; ++bj) { const int c = cl + bj * 128, i0 = (c & 63) >> 1; const float* rt = rot + ((size_t)pos * 32 + i0) * 2;
                        const f32x4 cs0 = *(const f32x4*)rt, cs1 = *(const f32x4*)(rt + 4); const f32x4 v0 = acc[ai][bj][m][0] * sc, v1 = acc[ai][bj][m][1] * sc;
                        u32x4 w; w.x = cvt_pk_bf16(v0[0] * cs0[0] - v0[1] * cs0[1], v0[0] * cs0[1] + v0[1] * cs0[0]); w.y = cvt_pk_bf16(v0[2] * cs0[2] - v0[3] * cs0[3], v0[2] * cs0[3] + v0[3] * cs0[2]);
                        w.z = cvt_pk_bf16(v1[0] * cs1[0] - v1[1] * cs1[1], v1[0] * cs1[1] + v1[1] * cs1[0]); w.w = cvt_pk_bf16(v1[2] * cs1[2] - v1[3] * cs1[3], v1[2] * cs1[3] + v1[3] * cs1[2]);
                        __builtin_nontemporal_store(w, (u32x4*)(P + (size_t)row * PLD + dcol + c)); } }
        } else {
            const bool silu = (pn == 5 || pn == 6 || pn == 11 || pn == 12 || pn == 15 || pn == 16 || pn == 19 || pn == 20);
            const float sc = pn == 0 ? 0.125f : 1.f; const int dcol = (pn < 4 ? pn : pn - 1) * 256;
#pragma unroll
            for (int ai = 0; ai < 2; ++ai)
#pragma unroll
                for (int m = 0; m < 4; ++m) { int row = row0 + ai * 128 + m * 16; asm volatile("" : "+v"(row));
#pragma unroll
                    for (int bj = 0; bj < 2; ++bj) { f32x4 v0 = acc[ai][bj][m][0] * sc, v1 = acc[ai][bj][m][1] * sc;
                        if (silu) {
#pragma unroll
                            for (int j = 0; j < 4; ++j) { v0[j] = silu_f(v0[j]); v1[j] = silu_f(v1[j]); } }
                        u32x4 w; w.x = cvt_pk_bf16(v0[0], v0[1]); w.y = cvt_pk_bf16(v0[2], v0[3]); w.z = cvt_pk_bf16(v1[0], v1[1]); w.w = cvt_pk_bf16(v1[2], v1[3]);
                        __builtin_nontemporal_store(w, (u32x4*)(P + (size_t)row * PLD + dcol + cl + bj * 128)); } }
        }
    }
};
struct EpiSig {
    static constexpr bool PERM = true, AFTER_DRAIN = false, KEEP = false;
    bf16_t* PG;
    __device__ __forceinline__ void operator()(const f32x4 (&acc)[2][2][4][2], const pg8::Unit& u, int wr, int wc, int fr, int fq) const {
        const int row0 = u.pm * 256 + wr * 64 + fr, c0 = u.pn * 256 + wc * 32 + 8 * fq;
#pragma unroll
        for (int ai = 0; ai < 2; ++ai)
#pragma unroll
            for (int m = 0; m < 4; ++m) { const int row = row0 + ai * 128 + m * 16;
#pragma unroll
                for (int bj = 0; bj < 2; ++bj) { f32x4 v0 = acc[ai][bj][m][0], v1 = acc[ai][bj][m][1];
#pragma unroll
                    for (int j = 0; j < 4; ++j) { v0[j] = sigmoid_f(v0[j]); v1[j] = sigmoid_f(v1[j]); }
                    u32x4 w; w.x = cvt_pk_bf16(v0[0], v0[1]); w.y = cvt_pk_bf16(v0[2], v0[3]); w.z = cvt_pk_bf16(v1[0], v1[1]); w.w = cvt_pk_bf16(v1[2], v1[3]);
                    *(u32x4*)(PG + (size_t)row * N_MG + c0 + bj * 128) = w; } }
    }
};
struct EpiGlu {
    static constexpr bool PERM = true, AFTER_DRAIN = false, KEEP = false;
    const bf16_t* Y5; const bf16_t* P; const float* gb; bf16_t* O;
    __device__ __forceinline__ void operator()(const f32x4 (&acc)[2][2][4][2], const pg8::Unit& u, int wr, int wc, int fr, int fq) const {
        const int row0 = u.pm * 256 + wr * 64 + fr, c0 = u.pn * 256 + wc * 32 + 8 * fq;
#pragma unroll
        for (int bj = 0; bj < 2; ++bj) { const int c = c0 + bj * 128; const f32x4 b0 = *(const f32x4*)(gb + c), b1 = *(const f32x4*)(gb + c + 4);
#pragma unroll
            for (int ai = 0; ai < 2; ++ai)
#pragma unroll
                for (int m = 0; m < 4; ++m) { const int row = row0 + ai * 128 + m * 16;
                    const u32x4 y = *(const u32x4*)(Y5 + (size_t)row * BW + c), s = *(const u32x4*)(P + (size_t)row * PLD + P_SG + c);
                    const f32x4 v0 = acc[ai][bj][m][0] + b0, v1 = acc[ai][bj][m][1] + b1;
                    u32x4 w;
                    w.x = cvt_pk_bf16(bflo(y.x) * sigmoid_f(v0[0]) * bflo(s.x), bfhi(y.x) * sigmoid_f(v0[1]) * bfhi(s.x));
                    w.y = cvt_pk_bf16(bflo(y.y) * sigmoid_f(v0[2]) * bflo(s.y), bfhi(y.y) * sigmoid_f(v0[3]) * bfhi(s.y));
                    w.z = cvt_pk_bf16(bflo(y.z) * sigmoid_f(v1[0]) * bflo(s.z), bfhi(y.z) * sigmoid_f(v1[1]) * bfhi(s.z));
                    w.w = cvt_pk_bf16(bflo(y.w) * sigmoid_f(v1[2]) * bflo(s.w), bfhi(y.w) * sigmoid_f(v1[3]) * bfhi(s.w));
                    *(u32x4*)(O + (size_t)row * OLD + 1536 + c) = w; } }
    }
};
struct EpiBr {
    static constexpr bool PERM = true, AFTER_DRAIN = false, KEEP = false;
    const bf16_t* PG; bf16_t* MRG;
    __device__ __forceinline__ void operator()(f32x4 (&acc)[2][2][4][2], const pg8::Unit& u, int wr, int wc, int fr, int fq) const {
        const int row0 = u.pm * 256 + wr * 64 + fr, c = u.pn * 128 + wc * 32 + 8 * fq, z = u.z;
#pragma unroll
        for (int ai = 0; ai < 2; ++ai)
#pragma unroll
            for (int m = 0; m < 4; ++m) { const int row = row0 + ai * 128 + m * 16;
                const u32x4 gt = __builtin_nontemporal_load((const u32x4*)(PG + (size_t)row * N_MG + z * 1024 + c));
                f32x4& p0 = acc[ai][0][m][0]; f32x4& p1 = acc[ai][0][m][1]; f32x4& s0 = acc[ai][1][m][0]; f32x4& s1 = acc[ai][1][m][1];
                if (z == 0) { s0 = (f32x4){0.f, 0.f, 0.f, 0.f}; s1 = s0; }
                s0[0] += p0[0] * bflo(gt.x); s0[1] += p0[1] * bfhi(gt.x); s0[2] += p0[2] * bflo(gt.y); s0[3] += p0[3] * bfhi(gt.y);
                s1[0] += p1[0] * bflo(gt.z); s1[1] += p1[1] * bfhi(gt.z); s1[2] += p1[2] * bflo(gt.w); s1[3] += p1[3] * bfhi(gt.w);
                p0 = (f32x4){0.f, 0.f, 0.f, 0.f}; p1 = p0;
                if (z == 3) { u32x4 w; w.x = cvt_pk_bf16(s0[0], s0[1]); w.y = cvt_pk_bf16(s0[2], s0[3]); w.z = cvt_pk_bf16(s1[0], s1[1]); w.w = cvt_pk_bf16(s1[2], s1[3]);
                    *(u32x4*)(MRG + (size_t)row * D + c) = w; } }
    }
};
struct EpiOut {
    static constexpr bool PERM = true, AFTER_DRAIN = false, KEEP = false;
    bf16_t* DL;
    __device__ __forceinline__ void operator()(const f32x4 (&acc)[2][2][4][2], const pg8::Unit& u, int wr, int wc, int fr, int fq) const {
        const int row0 = u.pm * 256 + wr * 64 + fr, c0 = u.pn * 256 + wc * 32 + 8 * fq;
#pragma unroll
        for (int ai = 0; ai < 2; ++ai)
#pragma unroll
            for (int m = 0; m < 4; ++m) { const int row = row0 + ai * 128 + m * 16;
#pragma unroll
                for (int bj = 0; bj < 2; ++bj) { const f32x4 v0 = acc[ai][bj][m][0], v1 = acc[ai][bj][m][1];
                    u32x4 w; w.x = cvt_pk_bf16(v0[0], v0[1]); w.y = cvt_pk_bf16(v0[2], v0[3]); w.z = cvt_pk_bf16(v1[0], v1[1]); w.w = cvt_pk_bf16(v1[2], v1[3]);
                    *(u32x4*)(DL + (size_t)row * D + c0 + bj * 128) = w; } }
    }
};

__device__ __forceinline__ int win_src_col(int r) {
    const int pn = r >> 8, j = r & 255;
    switch (pn) {
        case 0: return j; case 1: return 256 + j; case 2: case 3: return 512 + (r - 512);
        case 4: return -1;
        case 5: case 6: return 1040 + (r - 1280);
        case 7: return 1552 + 64 * (j >> 6) + ((j & 63) >> 1) + 32 * (j & 1);
        case 8: return 1808 + 64 * (j >> 6) + ((j & 63) >> 1) + 32 * (j & 1);
        case 9: case 10: return 2064 + (r - 2304);
        case 11: case 12: return 2576 + (r - 2816);
        case 13: case 14: return 3088 + (r - 3328);
        case 15: case 16: return 3600 + (r - 3840);
        case 17: case 18: return 4112 + (r - 4352);
        default: return 4624 + (r - 4864);
    }
}
__device__ __forceinline__ void tr_store8(bf16_t* dst, const float (&v)[8]) {
    u32x4 w; w.x = cvt_pk_bf16(v[0], v[1]); w.y = cvt_pk_bf16(v[2], v[3]); w.z = cvt_pk_bf16(v[4], v[5]); w.w = cvt_pk_bf16(v[6], v[7]); *(u32x4*)dst = w;
}
__device__ __forceinline__ void phase_prologue(const Args& a, int gtid, int gthreads) {
    unsigned char* ws = a.ws;
    for (int l = 0; l < DEPTH; ++l) {
        bf16_t* Wl = (bf16_t*)(ws + WS_W + (size_t)l * W_STRIDE);
        const float* win = a.in[I_WIN] + (size_t)l * D * 5136;
        const float* wlr = a.in[I_GWLR] + (size_t)l * 16 * 256;
        for (int idx = gtid; idx < N_IN * (D / 8); idx += gthreads) { const int n = idx % N_IN, kc = idx / N_IN; const int sc = win_src_col(n); float v[8];
            if (sc >= 0) {
#pragma unroll
                for (int i = 0; i < 8; ++i) v[i] = win[(size_t)(kc * 8 + i) * 5136 + sc];
            } else { const int j = n & 255;
#pragma unroll
                for (int i = 0; i < 8; ++i) { float s = 0.f; const float* wr_ = win + (size_t)(kc * 8 + i) * 5136 + 1024;
#pragma unroll
                    for (int r = 0; r < 16; ++r) s += wr_[r] * wlr[r * 256 + j];
                    v[i] = s; } }
            tr_store8(Wl + (size_t)n * D + kc * 8, v); }
        const float* wmg = a.in[I_WMG] + (size_t)l * 4 * D * D;
        for (int idx = gtid; idx < N_MG * (D / 8); idx += gthreads) { const int n = idx % N_MG, kc = idx / N_MG, bi = n >> 10, c = n & 1023; float v[8];
#pragma unroll
            for (int i = 0; i < 8; ++i) v[i] = wmg[((size_t)bi * D + kc * 8 + i) * D + c];
            tr_store8(Wl + (size_t)(N_IN + n) * D + kc * 8, v); }
        const float* wbr = a.in[I_WBR] + (size_t)l * 4 * BW * D; bf16_t* Wb = (bf16_t*)((unsigned char*)Wl + WO_BR);
        for (int idx = gtid; idx < 4 * D * (BW / 8); idx += gthreads) { const int n = idx % (4 * D), kc = idx / (4 * D), bi = n >> 10, c = n & 1023; float v[8];
#pragma unroll
            for (int i = 0; i < 8; ++i) v[i] = wbr[((size_t)bi * BW + kc * 8 + i) * D + c];
            tr_store8(Wb + (size_t)n * BW + kc * 8, v); }
        const float* wout = a.in[I_WOUT] + (size_t)l * D * D; bf16_t* Wo = (bf16_t*)((unsigned char*)Wl + WO_OUT);
        for (int idx = gtid; idx < D * (D / 8); idx += gthreads) { const int n = idx % D, kc = idx / D; float v[8];
#pragma unroll
            for (int i = 0; i < 8; ++i) v[i] = wout[(size_t)(kc * 8 + i) * D + n];
            tr_store8(Wo + (size_t)n * D + kc * 8, v); }
        const float* wglu = a.in[I_SGW] + (size_t)l * BW * BW; bf16_t* Wg = (bf16_t*)((unsigned char*)Wl + WO_GLU);
        for (int idx = gtid; idx < BW * (BW / 8); idx += gthreads) { const int n = idx % BW, kc = idx / BW; float v[8];
#pragma unroll
            for (int i = 0; i < 8; ++i) v[i] = wglu[(size_t)(kc * 8 + i) * BW + n];
            tr_store8(Wg + (size_t)n * BW + kc * 8, v); }
        float* sm = (float*)(ws + WS_SMALL + (size_t)l * SMALL_STRIDE);
        for (int idx = gtid; idx < 2048; idx += gthreads) { const int g = idx >> 6;
            const double step = exp((double)a.in[I_SLDT][l * 32 + g]); const double are = a.in[I_SARE][l * 2048 + idx], aim = a.in[I_SAIM][l * 2048 + idx];
            const double mag = exp(step * are), abr = mag * cos(step * aim), abi = mag * sin(step * aim), den = are * are + aim * aim;
            const double fre = ((abr - 1.0) * are + abi * aim) / den, fim = (abi * are - (abr - 1.0) * aim) / den;
            sm[SM_ABR + idx] = (float)abr; sm[SM_ABI + idx] = (float)abi;
            { const double m128 = exp(512.0 * step * are); sm[SM_A128 + idx * 2] = (float)(m128 * cos(512.0 * step * aim)); sm[SM_A128 + idx * 2 + 1] = (float)(m128 * sin(512.0 * step * aim)); }
            bf16_t* bbt = (bf16_t*)((unsigned char*)sm + SM_BBT_BYTES); const int p_ = idx & 63;
            for (int i = 0; i < 16; ++i) { const double br = a.in[I_SBRE][(size_t)l * 32768 + idx * 16 + i], bi = a.in[I_SBIM][(size_t)l * 32768 + idx * 16 + i];
                const float vr = (float)(fre * br - fim * bi), vi = (float)(fre * bi + fim * br);
                sm[SM_BBR + idx * 16 + i] = vr; sm[SM_BBI + idx * 16 + i] = vi; bbt[(g * 128 + 2 * p_) * 16 + i] = f2bf(vr); bbt[(g * 128 + 2 * p_ + 1) * 16 + i] = f2bf(vi); } }
        for (int idx = gtid; idx < 512; idx += gthreads) { const float lam = a.in[I_LLAM][l * 512 + idx]; const float nl = -lam;
            sm[SM_SP8 + idx] = 8.0f * (fmaxf(nl, 0.f) + log1pf(expf(-fabsf(nl)))); }
        { bf16_t* ct = (bf16_t*)((unsigned char*)sm + SM_CT_BYTES);
          for (int idx = gtid; idx < 32 * 16 * 128; idx += gthreads) { const int k = idx & 127, gi = idx >> 7;
              const float v = (k & 1) == 0 ? a.in[I_SCRE][(size_t)l * 32768 + gi * 64 + (k >> 1)] : -a.in[I_SCIM][(size_t)l * 32768 + gi * 64 + (k >> 1)]; ct[idx] = f2bf(v); } }
        bf16_t* lw = (bf16_t*)((unsigned char*)sm + SM_LRUW_BYTES);
        for (int idx = gtid; idx < 8 * 128 * 64; idx += gthreads) { const int i = idx & 63, jj = (idx >> 6) & 127, n = idx >> 13;
            const float v = jj < 64 ? a.in[I_LWA][(((size_t)l * 8 + n) * 64 + i) * 64 + jj] : a.in[I_LWX][(((size_t)l * 8 + n) * 64 + i) * 64 + (jj - 64)];
            lw[idx] = f2bf(v); }
    }
    float* rot = (float*)(ws + WS_ROT);
    for (int idx = gtid; idx < SEQ * 32; idx += gthreads) { const int i = idx & 31, s = idx >> 5;
        const double inv = pow(10000.0, -(double)i / 32.0), ang = (double)s * inv; rot[idx * 2] = (float)cos(ang); rot[idx * 2 + 1] = (float)sin(ang); }
}

template <bool F32OUT, bool ADD>
__device__ __forceinline__ void phase_norm(const float* hin, const bf16_t* delta, float* hout, const float* gain, bf16_t* uout, int gw, int ngw, int lane) {
    f32x4 gv[4];
#pragma unroll
    for (int j = 0; j < 4; ++j) gv[j] = *(const f32x4*)(gain + 4 * lane + 256 * j);
    for (int row = gw; row < TG; row += ngw) {
        const f32x4* xr = (const f32x4*)(hin + (size_t)row * D) + lane; f32x4 v[4]; float s = 0.f;
#pragma unroll
        for (int j = 0; j < 4; ++j) v[j] = __builtin_nontemporal_load(xr + 64 * j);
        if (ADD) { const u32x2* dr = (const u32x2*)(delta + (size_t)row * D) + lane;
#pragma unroll
            for (int j = 0; j < 4; ++j) { const u32x2 dw = __builtin_nontemporal_load(dr + 64 * j); v[j].x += bflo(dw.x); v[j].y += bfhi(dw.x); v[j].z += bflo(dw.y); v[j].w += bfhi(dw.y); } }
#pragma unroll
        for (int j = 0; j < 4; ++j) s += (v[j].x * v[j].x + v[j].y * v[j].y) + (v[j].z * v[j].z + v[j].w * v[j].w);
        const float rstd = rsqrtf(wave_sum(s) * (1.f / D) + NORM_EPS);
        if (F32OUT) { f32x4* o = (f32x4*)(hout + (size_t)row * D) + lane;
#pragma unroll
            for (int j = 0; j < 4; ++j) o[64 * j] = v[j] * rstd * gv[j];
        } else {
            if (ADD) { f32x4* o = (f32x4*)(hout + (size_t)row * D) + lane;
#pragma unroll
                for (int j = 0; j < 4; ++j) o[64 * j] = v[j]; }
            u32x2* o = (u32x2*)(uout + (size_t)row * D) + lane;
#pragma unroll
            for (int j = 0; j < 4; ++j) { const f32x4 y = v[j] * rstd * gv[j]; u32x2 w; w.x = cvt_pk_bf16(y.x, y.y); w.y = cvt_pk_bf16(y.z, y.w); o[64 * j] = w; } }
    }
}

constexpr int NSEGG = 8;
constexpr int NSEGL = 32;
constexpr int NSEGS = 8;
constexpr size_t ST_GSEG = 0;
constexpr size_t ST_GDS = ST_GSEG + (size_t)2 * BG * 4 * NSEGG * 8192;
constexpr size_t ST_LRU = ST_GDS + (size_t)2 * BG * 4 * NSEGG * 64;
constexpr size_t ST_S5 = ST_LRU + (size_t)BG * NSEGL * 512 * 2;
constexpr size_t ST_END_F = ST_S5 + (size_t)BG * NSEGS * 32 * 128;
static_assert(ST_END_F * 4 <= 64 * MiB, "state scratch");
typedef short s16x4 __attribute__((ext_vector_type(4)));

__device__ __forceinline__ bf16x8 lds_tr_frag(LAS const unsigned char* base, int row_stride_bytes, int lane) {
    const int g = lane >> 4, idx = lane & 15, q = idx >> 2, p = idx & 3;
    LAS const unsigned char* a0 = base + (8 * g + q) * row_stride_bytes + 8 * p;
    const s16x4 r0 = __builtin_amdgcn_ds_read_tr16_b64_v4i16((LAS s16x4*)a0);
    const s16x4 r1 = __builtin_amdgcn_ds_read_tr16_b64_v4i16((LAS s16x4*)(a0 + 4 * row_stride_bytes));
    bf16x8 f; f[0] = r0[0]; f[1] = r0[1]; f[2] = r0[2]; f[3] = r0[3]; f[4] = r1[0]; f[5] = r1[1]; f[6] = r1[2]; f[7] = r1[3]; return f;
}
#define WGSYNC() do { asm volatile("s_waitcnt lgkmcnt(0)" ::: "memory"); __builtin_amdgcn_s_barrier(); asm volatile("" ::: "memory"); } while (0)

constexpr int GL_QD = 0, GL_KD = 9216, GL_KT = 18432, GL_V = 27648, GL_ST = 45056, GL_LAST = 63488, GL_RED = 63744, GL_RED2 = 64256;
struct GlaP { const bf16_t* P; const float* LA; const float* gain; const float* bias; bf16_t* O; float* SSEG; float* DSUM; };
__device__ __forceinline__ bf16x8 lds_tr_frag2(LAS const unsigned char* base, int row_stride_bytes, int lane, int mulg, int second_off) {
    const int g = lane >> 4, idx = lane & 15, q = idx >> 2, p = idx & 3;
    LAS const unsigned char* a0 = base + (mulg * g + q) * row_stride_bytes + 8 * p;
    const s16x4 r0 = __builtin_amdgcn_ds_read_tr16_b64_v4i16((LAS s16x4*)a0);
    const s16x4 r1 = __builtin_amdgcn_ds_read_tr16_b64_v4i16((LAS s16x4*)(a0 + second_off * row_stride_bytes));
    bf16x8 f; f[0] = r0[0]; f[1] = r0[1]; f[2] = r0[2]; f[3] = r0[3]; f[4] = r1[0]; f[5] = r1[1]; f[6] = r1[2]; f[7] = r1[3]; return f;
}
__device__ __forceinline__ bf16x8 pack8(const f32x4 a, const f32x4 b) { u32x4 w; w.x = cvt_pk_bf16(a[0], a[1]); w.y = cvt_pk_bf16(a[2], a[3]); w.z = cvt_pk_bf16(b[0], b[1]); w.w = cvt_pk_bf16(b[2], b[3]); return __builtin_bit_cast(bf16x8, w); }

template <bool PASSC>
__device__ __forceinline__ void glaret_item(LAS unsigned char* lds, const GlaP& gp, const bool gla, const int b, const int h, const int seg, const int sidx  ) {
    int tid = threadIdx.x; asm volatile("" : "+v"(tid));
    const int w = __builtin_amdgcn_readfirstlane(tid >> 6), l = tid & 63, fr = l & 15, fq = l >> 4;
    const int qoff = gla ? P_GQ : P_RQ, koff = gla ? P_GK : P_RK, voff = gla ? P_GV : P_RV, goff = gla ? P_GG : P_RG, ooff = gla ? 0 : 512;
    const float lg = __logf(1.f - exp2f(-5.f - (float)h));
    f32x4 accs[4];
#pragma unroll
    for (int dt = 0; dt < 4; ++dt) accs[dt] = (f32x4){0.f, 0.f, 0.f, 0.f};
    const int arow = 8 * w + (l >> 3), apart = l & 7;
    float dsum[8];
#pragma unroll
    for (int e = 0; e < 8; ++e) dsum[e] = 0.f;
    if (PASSC) {
        for (int sp = 0; sp < seg; ++sp) {
            const float* sg = gp.SSEG + (size_t)(sidx + sp) * 8192 + tid * 16; const float* dsm = gp.DSUM + (size_t)(sidx + sp) * 64;
#pragma unroll
            for (int dt = 0; dt < 4; ++dt) { const f32x4 dv = *(const f32x4*)(dsm + 16 * dt + 4 * fq), sv = *(const f32x4*)(sg + 4 * dt);
#pragma unroll
                for (int r = 0; r < 4; ++r) accs[dt][r] = accs[dt][r] * __expf(dv[r]) + sv[r]; }
        }
#pragma unroll
        for (int dt = 0; dt < 4; ++dt) { u32x2 wv; wv.x = cvt_pk_bf16(accs[dt][0], accs[dt][1]); wv.y = cvt_pk_bf16(accs[dt][2], accs[dt][3]);
            *(LAS u32x2*)(lds + GL_ST + (16 * w + fr) * 144 + 32 * dt + 8 * fq) = wv; }
    }
    const int it = w & 3, ch = w >> 2;
    f32x4 gnv[4], bsv[4];
#pragma unroll
    for (int ct = 0; ct < 4; ++ct) { const int c = 128 * h + 64 * ch + 16 * ct + 4 * fq; gnv[ct] = PASSC ? *(const f32x4*)(gp.gain + c) : (f32x4){0.f, 0.f, 0.f, 0.f};
        bsv[ct] = (PASSC && !gla) ? *(const f32x4*)(gp.bias + c) : (f32x4){0.f, 0.f, 0.f, 0.f}; }
    u32x4 rq = (u32x4){0u, 0u, 0u, 0u}, rk, rv[2]; f32x4 rla[2], rll[2]; u32x2 gnx[4];
    const float rq_s = __expf((float)(arow + 1) * lg), rk_s = __expf(-(float)(arow + 1) * lg), rt_s = __expf((float)(63 - arow) * lg);
#define GL_ISSUE(n_) do { const size_t r0_ = (size_t)b * SEQ + seg * 512 + (n_) * 64; \
        { const bf16_t* pr_ = gp.P + (r0_ + arow) * PLD + 64 * h + 8 * apart; if (PASSC) rq = *(const u32x4*)(pr_ + qoff); rk = *(const u32x4*)(pr_ + koff); \
          if (gla) { const float* lp_ = gp.LA + (r0_ + arow) * 256 + 64 * h + 8 * apart; rla[0] = *(const f32x4*)lp_; rla[1] = *(const f32x4*)(lp_ + 4); const float* ll_ = gp.LA + (r0_ + 63) * 256 + 64 * h + 8 * apart; rll[0] = *(const f32x4*)ll_; rll[1] = *(const f32x4*)(ll_ + 4); } \
          else { rla[0] = (f32x4){0.f, 0.f, 0.f, 0.f}; rla[1] = rla[0]; rll[0] = rla[0]; rll[1] = rla[0]; } } \
        _Pragma("unroll") for (int e_ = 0; e_ < 2; ++e_) { const int p_ = tid + 512 * e_, i_ = p_ >> 4, part_ = p_ & 15; \
            rv[e_] = *(const u32x4*)(gp.P + (r0_ + i_) * PLD + voff + 128 * h + 8 * part_); } \
        if (PASSC) { _Pragma("unroll") for (int ct_ = 0; ct_ < 4; ++ct_) gnx[ct_] = *(const u32x2*)(gp.P + (r0_ + 16 * it + fr) * PLD + goff + 128 * h + 64 * ch + 16 * ct_ + 4 * fq); } } while (0)
    GL_ISSUE(0);
    for (int n = 0; n < 8; ++n) {
        const size_t row0 = (size_t)b * SEQ + seg * 512 + n * 64;
#pragma unroll
        for (int e = 0; e < 2; ++e) { const int p = tid + 512 * e, i = p >> 4, part = p & 15; *(LAS u32x4*)(lds + GL_V + i * 272 + part * 16) = rv[e]; }
        { float cum[8], lastv[8];
          const float kk[8] = {bflo(rk.x), bfhi(rk.x), bflo(rk.y), bfhi(rk.y), bflo(rk.z), bfhi(rk.z), bflo(rk.w), bfhi(rk.w)};
          float eq[8], ek[8], et[8];
          if (gla) {
#pragma unroll
              for (int e = 0; e < 8; ++e) { cum[e] = e < 4 ? rla[0][e] : rla[1][e - 4]; lastv[e] = e < 4 ? rll[0][e] : rll[1][e - 4];
                  eq[e] = __expf(cum[e]); ek[e] = __builtin_amdgcn_rcpf(eq[e]); et[e] = __expf(lastv[e]) * ek[e]; }
          } else {
#pragma unroll
              for (int e = 0; e < 8; ++e) { lastv[e] = 64.f * lg; eq[e] = rq_s; ek[e] = rk_s; et[e] = rt_s; } }
#pragma unroll
          for (int e = 0; e < 8; ++e) *(LAS bf16_t*)(lds + GL_KT + (8 * apart + e) * 144 + arow * 2) = f2bf(kk[e] * et[e]);
          if (PASSC) { const float qq[8] = {bflo(rq.x), bfhi(rq.x), bflo(rq.y), bfhi(rq.y), bflo(rq.z), bfhi(rq.z), bflo(rq.w), bfhi(rq.w)};
              u32x4 qw, kw;
              qw.x = cvt_pk_bf16(qq[0] * eq[0], qq[1] * eq[1]); qw.y = cvt_pk_bf16(qq[2] * eq[2], qq[3] * eq[3]); qw.z = cvt_pk_bf16(qq[4] * eq[4], qq[5] * eq[5]); qw.w = cvt_pk_bf16(qq[6] * eq[6], qq[7] * eq[7]);
              kw.x = cvt_pk_bf16(kk[0] * ek[0], kk[1] * ek[1]); kw.y = cvt_pk_bf16(kk[2] * ek[2], kk[3] * ek[3]); kw.z = cvt_pk_bf16(kk[4] * ek[4], kk[5] * ek[5]); kw.w = cvt_pk_bf16(kk[6] * ek[6], kk[7] * ek[7]);
              *(LAS u32x4*)(lds + GL_QD + arow * 144 + 16 * apart) = qw; *(LAS u32x4*)(lds + GL_KD + arow * 144 + 16 * apart) = kw; }
          if (arow == 63) {
#pragma unroll
              for (int e = 0; e < 8; ++e) *(LAS float*)(lds + GL_LAST + (8 * apart + e) * 4) = lastv[e]; }
#pragma unroll
          for (int e = 0; e < 8; ++e) dsum[e] += lastv[e]; }
        u32x2 gates[4];
        if (PASSC) {
#pragma unroll
            for (int ct = 0; ct < 4; ++ct) gates[ct] = gnx[ct]; }
        if (n < 7) GL_ISSUE(n + 1);
        WGSYNC();
        f32x4 acco[4];
        if (PASSC) {
            bf16x8 qf[2];
#pragma unroll
            for (int ks = 0; ks < 2; ++ks) qf[ks] = *(LAS const bf16x8*)(lds + GL_QD + (16 * it + fr) * 144 + 16 * fq + 64 * ks);
            f32x4 sc[4];
#pragma unroll
            for (int jt = 0; jt < 4; ++jt) { sc[jt] = (f32x4){0.f, 0.f, 0.f, 0.f};
                if (jt <= it) {
#pragma unroll
                    for (int ks = 0; ks < 2; ++ks) { const bf16x8 kf = *(LAS const bf16x8*)(lds + GL_KD + (16 * jt + fr) * 144 + 16 * fq + 64 * ks);
                        sc[jt] = __builtin_amdgcn_mfma_f32_16x16x32_bf16(kf, qf[ks], sc[jt], 0, 0, 0); }
                    if (jt == it) {
#pragma unroll
                        for (int r = 0; r < 4; ++r) sc[jt][r] = (4 * fq + r <= fr) ? sc[jt][r] : 0.f; } } }
            const bf16x8 pf0 = pack8(sc[0], sc[1]), pf1 = pack8(sc[2], sc[3]);
#pragma unroll
            for (int ct = 0; ct < 4; ++ct) { const int c0 = 64 * ch + 16 * ct; acco[ct] = (f32x4){0.f, 0.f, 0.f, 0.f};
                { const bf16x8 vf = lds_tr_frag2(lds + GL_V + c0 * 2, 272, l, 4, 16); acco[ct] = __builtin_amdgcn_mfma_f32_16x16x32_bf16(vf, pf0, acco[ct], 0, 0, 0); }
                if (it >= 2) { const bf16x8 vf = lds_tr_frag2(lds + GL_V + 32 * 272 + c0 * 2, 272, l, 4, 16); acco[ct] = __builtin_amdgcn_mfma_f32_16x16x32_bf16(vf, pf1, acco[ct], 0, 0, 0); }
#pragma unroll
                for (int ks = 0; ks < 2; ++ks) { const bf16x8 sf = *(LAS const bf16x8*)(lds + GL_ST + (c0 + fr) * 144 + 16 * fq + 64 * ks);
                    acco[ct] = __builtin_amdgcn_mfma_f32_16x16x32_bf16(sf, qf[ks], acco[ct], 0, 0, 0); } }
        }
#pragma unroll
        for (int dt = 0; dt < 4; ++dt) { const f32x4 lv = *(LAS const f32x4*)(lds + GL_LAST + (16 * dt + 4 * fq) * 4);
#pragma unroll
            for (int r = 0; r < 4; ++r) accs[dt][r] *= __expf(lv[r]); }
#pragma unroll
        for (int ks = 0; ks < 2; ++ks) { const bf16x8 vf = lds_tr_frag2(lds + GL_V + (32 * ks) * 272 + (16 * w) * 2, 272, l, 8, 4);
#pragma unroll
            for (int dt = 0; dt < 4; ++dt) { const bf16x8 kf = *(LAS const bf16x8*)(lds + GL_KT + (16 * dt + fr) * 144 + 16 * fq + 64 * ks);
                accs[dt] = __builtin_amdgcn_mfma_f32_16x16x32_bf16(kf, vf, accs[dt], 0, 0, 0); } }
        if (PASSC) {
            float ss = 0.f, sm_ = 0.f;
#pragma unroll
            for (int ct = 0; ct < 4; ++ct)
#pragma unroll
                for (int r = 0; r < 4; ++r) { ss += acco[ct][r] * acco[ct][r]; sm_ += acco[ct][r]; }
            ss += __shfl_xor(ss, 16); ss += __shfl_xor(ss, 32); sm_ += __shfl_xor(sm_, 16); sm_ += __shfl_xor(sm_, 32);
            if (fq == 0) { *(LAS float*)(lds + GL_RED + ((16 * it + fr) * 2 + ch) * 4) = ss; *(LAS float*)(lds + GL_RED2 + ((16 * it + fr) * 2 + ch) * 4) = sm_; }
        }
        WGSYNC();
        if (PASSC) {
            const int i = 16 * it + fr;
            const float ssum = *(LAS const float*)(lds + GL_RED + (i * 2) * 4) + *(LAS const float*)(lds + GL_RED + (i * 2 + 1) * 4);
            const float msum = *(LAS const float*)(lds + GL_RED2 + (i * 2) * 4) + *(LAS const float*)(lds + GL_RED2 + (i * 2 + 1) * 4);
            float mean, rstd;
            if (gla) { mean = 0.f; rstd = rsqrtf(ssum * (1.f / 128.f) + NORM_EPS); }
            else { mean = msum * (1.f / 128.f); const float var = fmaxf(ssum * (1.f / 128.f) - mean * mean, 0.f); rstd = rsqrtf(var + NORM_EPS); }
#pragma unroll
            for (int ct = 0; ct < 4; ++ct) { const int c = 128 * h + 64 * ch + 16 * ct + 4 * fq; const f32x4 gn = gnv[ct], bs = bsv[ct];
                const float g0 = bflo(gates[ct].x), g1 = bfhi(gates[ct].x), g2 = bflo(gates[ct].y), g3 = bfhi(gates[ct].y);
                u32x2 ow; ow.x = cvt_pk_bf16(((acco[ct][0] - mean) * rstd * gn[0] + bs[0]) * g0, ((acco[ct][1] - mean) * rstd * gn[1] + bs[1]) * g1);
                ow.y = cvt_pk_bf16(((acco[ct][2] - mean) * rstd * gn[2] + bs[2]) * g2, ((acco[ct][3] - mean) * rstd * gn[3] + bs[3]) * g3);
                *(u32x2*)(gp.O + (row0 + i) * OLD + ooff + c) = ow; }
#pragma unroll
            for (int dt = 0; dt < 4; ++dt) { u32x2 wv; wv.x = cvt_pk_bf16(accs[dt][0], accs[dt][1]); wv.y = cvt_pk_bf16(accs[dt][2], accs[dt][3]);
                *(LAS u32x2*)(lds + GL_ST + (16 * w + fr) * 144 + 32 * dt + 8 * fq) = wv; }
        }
    }
#undef GL_ISSUE
    if (!PASSC) {
        float* sg = gp.SSEG + (size_t)(sidx + seg) * 8192 + tid * 16;
#pragma unroll
        for (int dt = 0; dt < 4; ++dt) *(f32x4*)(sg + 4 * dt) = accs[dt];
        if (tid < 8) {
#pragma unroll
            for (int e = 0; e < 8; ++e) gp.DSUM[(size_t)(sidx + seg) * 64 + 8 * apart + e] = dsum[e]; }
    }
    WGSYNC();
}

constexpr int LR_XC = 0, LR_XCF = 2304, LR_AA = 6400, LR_GG = 10496, LR_WAVE = 14592;
struct LruP { const bf16_t* P; const float* cw; const float* cb; const float* ba; const float* bx; const float* sp8; const bf16_t* lw; bf16_t* O; float* LST; };
template <bool PASSC>
__device__ __forceinline__ void lru_wave(LAS unsigned char* lw_, const LruP& lp, const int b, const int seg, const int n, const int l) {
    const int fr = l & 15, fq = l >> 4, ch = 64 * n + l;
    bf16x8 wB[8][2];
#pragma unroll
    for (int jt = 0; jt < 8; ++jt)
#pragma unroll
        for (int ks = 0; ks < 2; ++ks) wB[jt][ks] = *(const bf16x8*)(lp.lw + ((size_t)(n * 128 + 16 * jt + fr)) * 64 + 8 * fq + 32 * ks);
    const float w0 = lp.cw[ch], w1 = lp.cw[512 + ch], w2 = lp.cw[1024 + ch], w3 = lp.cw[1536 + ch], cbv = lp.cb[ch];
    float bav[4], bxv[4], spv[4];
#pragma unroll
    for (int jt = 0; jt < 4; ++jt) { const int c2 = 64 * n + 16 * jt + fr; bav[jt] = lp.ba[c2]; bxv[jt] = lp.bx[c2]; spv[jt] = lp.sp8[c2]; }
    const size_t rowb = (size_t)b * SEQ + seg * 128;
    float xm3 = 0.f, xm2 = 0.f, xm1 = 0.f;
    if (seg > 0) { xm3 = bf2f(lp.P[(rowb - 3) * PLD + P_LX + ch]); xm2 = bf2f(lp.P[(rowb - 2) * PLD + P_LX + ch]); xm1 = bf2f(lp.P[(rowb - 1) * PLD + P_LX + ch]); }
    float hst = 0.f, ap = 1.f;
    if (PASSC) { const float* st = lp.LST + ((size_t)b * NSEGL * 512 + ch) * 2;
        pg8::f32x2_ ah[31];
#pragma unroll
        for (int e = 0; e < 31; ++e) { const int sp = e < seg ? e : 0; ah[e] = *(const pg8::f32x2_*)(st + (size_t)sp * 1024); }
#pragma unroll
        for (int e = 0; e < 31; ++e) if (e < seg) hst = ah[e][0] * hst + ah[e][1]; }
    bf16_t xn[16], gn[16];
#pragma unroll
    for (int t = 0; t < 16; ++t) { xn[t] = lp.P[(rowb + t) * PLD + P_LX + ch]; gn[t] = PASSC ? lp.P[(rowb + t) * PLD + P_LG + ch] : (bf16_t)0; }
    for (int sb = 0; sb < 8; ++sb) {
        const size_t r0 = rowb + sb * 16;
        float xf[16], gr[16];
#pragma unroll
        for (int t = 0; t < 16; ++t) { xf[t] = bf2f(xn[t]); gr[t] = bf2f(gn[t]); }
        if (sb < 7) {
#pragma unroll
            for (int t = 0; t < 16; ++t) { xn[t] = lp.P[(r0 + 16 + t) * PLD + P_LX + ch]; if (PASSC) gn[t] = lp.P[(r0 + 16 + t) * PLD + P_LG + ch]; } }
#pragma unroll
        for (int t = 0; t < 16; ++t) { const float x0 = xf[t]; const float xc = cbv + w0 * xm3 + w1 * xm2 + w2 * xm1 + w3 * x0; xm3 = xm2; xm2 = xm1; xm1 = x0;
            *(LAS bf16_t*)(lw_ + LR_XC + t * 144 + l * 2) = f2bf(xc); *(LAS float*)(lw_ + LR_XCF + t * 256 + l * 4) = xc; }
        __builtin_amdgcn_wave_barrier();
        f32x4 acc[8];
#pragma unroll
        for (int jt = 0; jt < 8; ++jt) acc[jt] = (f32x4){0.f, 0.f, 0.f, 0.f};
#pragma unroll
        for (int ks = 0; ks < 2; ++ks) { const bf16x8 af = *(LAS const bf16x8*)(lw_ + LR_XC + fr * 144 + 16 * fq + 64 * ks);
#pragma unroll
            for (int jt = 0; jt < 8; ++jt) acc[jt] = __builtin_amdgcn_mfma_f32_16x16x32_bf16(af, wB[jt][ks], acc[jt], 0, 0, 0); }
#pragma unroll
        for (int jt = 0; jt < 4; ++jt)
#pragma unroll
            for (int r = 0; r < 4; ++r) { const int tok = 4 * fq + r, j = 16 * jt + fr;
                const float rg = sigmoid_f(acc[jt][r] + bav[jt]), ig = sigmoid_f(acc[4 + jt][r] + bxv[jt]);
                const float log_a = -rg * spv[jt]; const float av = __expf(log_a);
                const float xcv = *(LAS const float*)(lw_ + LR_XCF + tok * 256 + j * 4);
                *(LAS float*)(lw_ + LR_AA + tok * 256 + j * 4) = av; const float em = fmaf(-av, av, 1.f);
                *(LAS float*)(lw_ + LR_GG + tok * 256 + j * 4) = xcv * ig * sqrtf(fmaxf(em, 0.f)); }
        __builtin_amdgcn_wave_barrier();
#pragma unroll
        for (int t = 0; t < 16; ++t) { const float av = *(LAS const float*)(lw_ + LR_AA + t * 256 + l * 4), gv = *(LAS const float*)(lw_ + LR_GG + t * 256 + l * 4);
            hst = av * hst + gv; ap *= av;
            if (PASSC) lp.O[(r0 + t) * OLD + 1024 + ch] = f2bf(hst * gr[t]); }
        __builtin_amdgcn_wave_barrier();
    }
    if (!PASSC) { float* st = lp.LST + (((size_t)b * NSEGL + seg) * 512 + ch) * 2; st[0] = ap; st[1] = hst; }
}

constexpr int S5_BU = 0, S5_X = 8448, S5_WAVE = 8448 + 4352;
struct S5P { const bf16_t* P; const float* sm; const bf16_t* ct; const bf16_t* bbt; const float* a128; const float* dd; bf16_t* Y5; float* SST; };
template <bool PASSC>
__device__ __forceinline__ void s5_wave(LAS unsigned char* lw_, const S5P& sp_, const int b, const int seg, const int g, const int l) {
    const int fr = l & 15, fq = l >> 4;
    const bf16x8 zf = (bf16x8){0, 0, 0, 0, 0, 0, 0, 0};
    bf16x8 bbf[8];
#pragma unroll
    for (int mt = 0; mt < 8; ++mt) bbf[mt] = fq < 2 ? *(const bf16x8*)(sp_.bbt + ((size_t)(g * 128 + 16 * mt + fr)) * 16 + 8 * fq) : zf;
    const float abr = sp_.sm[SM_ABR + g * 64 + l], abi = sp_.sm[SM_ABI + g * 64 + l];
    float xr = 0.f, xi = 0.f;
    bf16x8 cf[4]; f32x4 dv4 = (f32x4){0.f, 0.f, 0.f, 0.f};
    if (PASSC) {
        const float ar = sp_.a128[(g * 64 + l) * 2], ai = sp_.a128[(g * 64 + l) * 2 + 1];
        const float* st = sp_.SST + ((size_t)b * NSEGS * 32 + g) * 128 + l;
        for (int sp0 = 0; sp0 < seg; sp0 += 8) { float er[8], ei[8];
#pragma unroll
            for (int e = 0; e < 8; ++e) { const int sp = sp0 + e < seg ? sp0 + e : seg - 1; er[e] = st[(size_t)sp * 4096]; ei[e] = st[(size_t)sp * 4096 + 64]; }
#pragma unroll
            for (int e = 0; e < 8; ++e) if (sp0 + e < seg) { const float nr = ar * xr - ai * xi + er[e], ni = ar * xi + ai * xr + ei[e]; xr = nr; xi = ni; } }
#pragma unroll
        for (int ks = 0; ks < 4; ++ks) cf[ks] = *(const bf16x8*)(sp_.ct + ((size_t)(g * 16 + fr)) * 128 + 8 * fq + 32 * ks);
        dv4 = *(const f32x4*)(sp_.dd + 16 * g + 4 * fq);
    }
    const size_t rowb = (size_t)b * SEQ + seg * 512;
    bf16x8 ufn = fq < 2 ? *(const bf16x8*)(sp_.P + (rowb + fr) * PLD + P_SU + 16 * g + 8 * fq) : zf;
    u32x2 usn = PASSC ? *(const u32x2*)(sp_.P + (rowb + fr) * PLD + P_SU + 16 * g + 4 * fq) : (u32x2){0u, 0u};
    for (int sb = 0; sb < 32; ++sb) {
        const size_t r0 = rowb + sb * 16;
        const bf16x8 uf = ufn; const u32x2 us = usn;
        if (sb < 31) { ufn = fq < 2 ? *(const bf16x8*)(sp_.P + (r0 + 16 + fr) * PLD + P_SU + 16 * g + 8 * fq) : zf;
            if (PASSC) usn = *(const u32x2*)(sp_.P + (r0 + 16 + fr) * PLD + P_SU + 16 * g + 4 * fq); }
#pragma unroll
        for (int mt = 0; mt < 8; ++mt) { f32x4 bu = (f32x4){0.f, 0.f, 0.f, 0.f}; bu = __builtin_amdgcn_mfma_f32_16x16x32_bf16(bbf[mt], uf, bu, 0, 0, 0);
            *(LAS f32x4*)(lw_ + S5_BU + fr * 528 + (16 * mt + 4 * fq) * 4) = bu; }
        __builtin_amdgcn_wave_barrier();
        pg8::f32x2_ buv[16];
#pragma unroll
        for (int t = 0; t < 16; ++t) buv[t] = *(LAS const pg8::f32x2_*)(lw_ + S5_BU + t * 528 + l * 8);
#pragma unroll
        for (int t = 0; t < 16; ++t) {
            const pg8::f32x2_ bu = buv[t];
            const float nr = abr * xr - abi * xi + bu[0], ni = abr * xi + abi * xr + bu[1]; xr = nr; xi = ni;
            if (PASSC) *(LAS unsigned*)(lw_ + S5_X + t * 272 + l * 4) = cvt_pk_bf16(xr, xi);
        }
        __builtin_amdgcn_wave_barrier();
        if (PASSC) {
            f32x4 acc = (f32x4){0.f, 0.f, 0.f, 0.f};
#pragma unroll
            for (int ks = 0; ks < 4; ++ks) { const bf16x8 xf = *(LAS const bf16x8*)(lw_ + S5_X + fr * 272 + 16 * fq + 64 * ks);
                acc = __builtin_amdgcn_mfma_f32_16x16x32_bf16(cf[ks], xf, acc, 0, 0, 0); }
            u32x2 yw; yw.x = cvt_pk_bf16(gelu_tanh_f(acc[0] + dv4[0] * bflo(us.x)), gelu_tanh_f(acc[1] + dv4[1] * bfhi(us.x))); yw.y = cvt_pk_bf16(gelu_tanh_f(acc[2] + dv4[2] * bflo(us.y)), gelu_tanh_f(acc[3] + dv4[3] * bfhi(us.y)));
            *(u32x2*)(sp_.Y5 + (r0 + fr) * BW + 16 * g + 4 * fq) = yw;
            __builtin_amdgcn_wave_barrier();
        }
    }
    if (!PASSC) { float* st = sp_.SST + (((size_t)b * NSEGS + seg) * 32 + g) * 128 + l; st[0] = xr; st[64] = xi; }
}

template <bool PASSC>
__device__ __forceinline__ void phase_mixers(LAS unsigned char* lds, const Args& a, const int l, const int G) {
    const int mmask = a.mmask;
    unsigned char* ws = a.ws; const float* sm = (const float*)(ws + WS_SMALL + (size_t)l * SMALL_STRIDE);
    const bf16_t* P = (const bf16_t*)(ws + WS_P); float* ST = (float*)(ws + WS_ST);
    if (mmask & 1) { GlaP gp0{P, (const float*)(ws + WS_LA), a.in[I_GNG] + l * 512, nullptr, (bf16_t*)(ws + WS_O), ST + ST_GSEG, ST + ST_GDS};
      GlaP gp1{P, (const float*)(ws + WS_LA), a.in[I_RNG] + l * 512, a.in[I_RNB] + l * 512, (bf16_t*)(ws + WS_O), ST + ST_GSEG, ST + ST_GDS};
      for (int itx = blockIdx.x; itx < 2 * BG * 4 * NSEGG; itx += G) { const int mix = itx / (BG * 4 * NSEGG), rest = itx % (BG * 4 * NSEGG), b = rest / (4 * NSEGG), h = (rest / NSEGG) & 3, seg = rest % NSEGG;
          const int sidx = ((mix * BG + b) * 4 + h) * NSEGG;
          if (!PASSC && seg == NSEGG - 1) continue;
          if (mix == 0) glaret_item<PASSC>(lds, gp0, true, b, h, seg, sidx); else glaret_item<PASSC>(lds, gp1, false, b, h, seg, sidx); } }
    int tid = threadIdx.x; asm volatile("" : "+v"(tid));
    const int w = __builtin_amdgcn_readfirstlane(tid >> 6), ln = tid & 63;
    if (mmask & 2) { LruP lp{P, a.in[I_LCW] + l * 2048, a.in[I_LCB] + l * 512, a.in[I_LBA] + l * 512, a.in[I_LBX] + l * 512, sm + SM_SP8, (const bf16_t*)((const unsigned char*)sm + SM_LRUW_BYTES), (bf16_t*)(ws + WS_O), ST + ST_LRU};
      for (int itx = blockIdx.x; itx < BG * NSEGL; itx += G) { if (!PASSC && itx % NSEGL == NSEGL - 1) continue; lru_wave<PASSC>(lds + w * LR_WAVE, lp, itx / NSEGL, itx % NSEGL, w, ln); } }
    if (mmask & 4) { S5P sp_{P, sm, (const bf16_t*)((const unsigned char*)sm + SM_CT_BYTES), (const bf16_t*)((const unsigned char*)sm + SM_BBT_BYTES), sm + SM_A128, a.in[I_SD] + l * 512, (bf16_t*)(ws + WS_Y5), ST + ST_S5};
      for (int itx = blockIdx.x; itx < BG * NSEGS * 4; itx += G) { if (!PASSC && (itx >> 2) % NSEGS == NSEGS - 1) continue; s5_wave<PASSC>(lds + w * LR_WAVE, sp_, itx / (NSEGS * 4), (itx >> 2) % NSEGS, 8 * (itx & 3) + w, ln); } }
    WGSYNC();
}

constexpr int NPH = 8, NSTEPS = 1 + NGRP * DEPTH * NPH;
constexpr int LDS_BYTES = 147456, LDS_MISC = 131072 + 320;

__global__ void __launch_bounds__(512, 2) mk_fwd(Args a) {
    __shared__ __attribute__((aligned(16))) unsigned char lds_raw[LDS_BYTES];
    LAS unsigned char* lds = (LAS unsigned char*)lds_raw;
    volatile LAS unsigned* MISC = (volatile LAS unsigned*)(lds + LDS_MISC);
    const int G = gridDim.x;
    if (threadIdx.x < 32) MISC[threadIdx.x] = 0u;
    __syncthreads();
    unsigned* ctl = (unsigned*)(a.ws + WS_CTL);
    XcdBarrier bar = xcd_barrier_post(ctl + CW_BAR + a.li * XCD_BAR_WORDS, MISC + 8);
    const int ngw = G * 8, gthreads = G * 512;
#define LTID(v) int v = threadIdx.x; asm volatile("" : "+v"(v))
#define IN(s) (a.s_lo <= (s) && (s) < a.s_hi)
#define SEAM(s) do { if ((s) + 1 < a.s_hi) xcd_barrier(bar); } while (0)
    if (IN(0)) { LTID(t_); phase_prologue(a, blockIdx.x * 512 + t_, gthreads); SEAM(0); }
    for (int gl = 0; gl < NGRP * DEPTH; ++gl) {
        const int grp = gl >> 2, l = gl & 3, s0 = 1 + gl * NPH;
        if (a.s_hi <= s0 || a.s_lo >= s0 + NPH) continue;
        unsigned char* ws = a.ws;
        const bf16_t* Wl = (const bf16_t*)(ws + WS_W + (size_t)l * W_STRIDE);
        const float* sm = (const float*)(ws + WS_SMALL + (size_t)l * SMALL_STRIDE);
        bf16_t* U = (bf16_t*)(ws + WS_U); bf16_t* P = (bf16_t*)(ws + WS_P); float* LA = (float*)(ws + WS_LA);
        bf16_t* O = (bf16_t*)(ws + WS_O); bf16_t* Y5 = (bf16_t*)(ws + WS_Y5); bf16_t* PGb = (bf16_t*)(ws + WS_PG);
        const float* xg = a.in[I_X] + (size_t)grp * TG * D; float* og = a.out + (size_t)grp * TG * D;
        const float* hin = (l <= 1) ? xg : og;
        bf16_t* DLT = (bf16_t*)(ws + WS_O);
        (void)sm;
        if (IN(s0 + 0)) { LTID(t_); const int gw_ = blockIdx.x * 8 + __builtin_amdgcn_readfirstlane(t_ >> 6);
            if (l == 0) phase_norm<false, false>(hin, DLT, og, a.in[I_NG] + l * D, U, gw_, ngw, t_ & 63); else phase_norm<false, true>(hin, DLT, og, a.in[I_NG] + l * D, U, gw_, ngw, t_ & 63);
            SEAM(s0 + 0); }
        if (IN(s0 + 1)) {
            pg8::Gemm g{U, Wl, TG, N_ALL, D, D, D, 0, 0}; pg8::StaticOrder S; S.init(TG, N_ALL, G, (int)blockIdx.x, 0, 256, WGM_G1);
            EpiIn E{P, LA, a.in[I_GBLR] + l * 256, (const float*)(ws + WS_ROT), PGb};
            GEMM_CALL(EpiIn);
            SEAM(s0 + 1);
        }
        if (IN(s0 + 2)) { phase_mixers<false>(lds, a, l, G); SEAM(s0 + 2); }
        if (IN(s0 + 3)) { phase_mixers<true>(lds, a, l, G); SEAM(s0 + 3); }
        if (IN(s0 + 4)) {
            { pg8::Gemm g{Y5, (const bf16_t*)((const unsigned char*)Wl + WO_GLU), TG, BW, BW, BW, BW, 0, 0}; pg8::StaticOrder S; S.init(TG, BW, G, (int)blockIdx.x, 0, 256, WGM_GLU);
              EpiGlu E{Y5, P, a.in[I_SGB] + l * BW, O};
              GEMM_CALL(EpiGlu); }
            SEAM(s0 + 4);
        }
        if (IN(s0 + 6)) {
            { pg8::Gemm g{O, (const bf16_t*)((const unsigned char*)Wl + WO_BR), TG, D, BW, OLD, BW, (size_t)BW * 2, (size_t)D * BW * 2}; pg8::StaticOrder S; S.init(TG, D, G, (int)blockIdx.x, 2, 128, WGM_G2);
              EpiBr E{PGb, U};
              pg8::gemm_phase<EpiBr, pg8::StaticOrder, true, true, true>(lds, g, S, E); }
            SEAM(s0 + 6);
        }
        if (IN(s0 + 7)) {
            if (a.fin != 2) { pg8::Gemm g{U, (const bf16_t*)((const unsigned char*)Wl + WO_OUT), TG, D, D, D, D, 0, 0}; pg8::StaticOrder S; S.init(TG, D, G, (int)blockIdx.x, 0, 256, WGM_G3);
              EpiOut E{DLT};
              GEMM_CALL(EpiOut); }
            if (l == 3 && a.fin) { if (a.fin == 1) xcd_barrier(bar); LTID(t_); phase_norm<true, true>(og, DLT, og, a.in[I_FNG], U, blockIdx.x * 8 + __builtin_amdgcn_readfirstlane(t_ >> 6), ngw, t_ & 63); }
            SEAM(s0 + 7);
        }
    }
#undef IN
#undef SEAM
}

extern "C" void kernel_launch(void* const* d_in, const int* in_sizes, int n_in, void* d_out, int out_size, void* d_ws, size_t ws_size, hipStream_t stream) {
    static int grid = 0;
    if (grid == 0) {
        static const int exp_sizes[29] = {67108864, 4096, 21037056, 16384, 1024, 2048, 2048, 2048, 8192, 2048, 131072, 2048, 131072, 2048, 2048, 8192, 8192, 131072, 131072, 131072, 131072, 2048, 128, 1048576, 2048, 16777216, 8388608, 4194304, 1024};
        bool ok_sizes = (n_in == 29); if (ok_sizes) for (int i = 0; i < 29; ++i) if (in_sizes[i] != exp_sizes[i]) { fprintf(stderr, "kernel_launch: input %d has %d elements, expected %d\n", i, in_sizes[i], exp_sizes[i]); ok_sizes = false; }
        if (!ok_sizes || out_size != NB * SEQ * D || ws_size < WS_END) { fprintf(stderr, "kernel_launch: unexpected shapes (n_in %d out %d ws %zu)\n", n_in, out_size, ws_size); grid = -1; return; }
        int dev = 0, cus = 0, per_cu = 0;
        hipGetDevice(&dev); hipDeviceGetAttribute(&cus, hipDeviceAttributeMultiprocessorCount, dev);
        hipOccupancyMaxActiveBlocksPerMultiprocessor(&per_cu, (const void*)mk_fwd, 512, 0);
        (void)hipGetLastError();
        grid = cus > 0 ? cus : 256;
        if (per_cu < 1) fprintf(stderr, "kernel_launch: occupancy query says %d\n", per_cu);
    }
    if (grid < 0) return;
    hipMemsetAsync((char*)d_ws + WS_CTL, 0, CTL_BYTES, stream);
    Args a{};
    for (int i = 0; i < 29; ++i) a.in[i] = (const float*)d_in[i];
    a.out = (float*)d_out; a.ws = (unsigned char*)d_ws;
    unsigned char* ws = (unsigned char*)d_ws;
    int li = 0;
    auto run = [&](int lo, int hi, int fin = 1, int mm = 7) { a.s_lo = lo; a.s_hi = hi; a.li = li++; a.fin = fin; a.mmask = mm; a.pad2 = 0; hipLaunchKernelGGL(mk_fwd, dim3(grid), dim3(512), 0, stream, a); };
    run(0, NSTEPS);
}
```

```cpp
#include <hip/hip_runtime.h>
#ifndef WGM_G1
#define WGM_G1 4
#endif
#ifndef WGM_G2
#define WGM_G2 8
#endif
#ifndef WGM_G3
#define WGM_G3 8
#endif
#ifndef WGM_GLU
#define WGM_GLU 8
#endif
#include <cstdio>
#include <cstdint>


namespace pg8 {
#define PG8_LAS __attribute__((address_space(3)))
typedef unsigned short bf16_t;
typedef short bf16x8 __attribute__((ext_vector_type(8)));
typedef float f32x4 __attribute__((ext_vector_type(4)));
typedef unsigned u32x4 __attribute__((ext_vector_type(4)));
typedef unsigned u32x2 __attribute__((ext_vector_type(2)));
constexpr int BM = 256, BK = 64, HALF = 128, HTB = HALF * BK * 2, STAGE_BYTES = 8 * HTB, NXCD = 8;

__host__ __device__ __forceinline__ int lds_byte(int r, int c) { const int st = (r >> 4) * 2 + (c >> 5), rr = r & 15, cc = c & 31, ob = rr * 64 + cc * 2; return st * 1024 + (ob ^ (((ob >> 9) & 1) << 5)); }
__host__ __device__ __forceinline__ void stage_rc(int b, int& R, int& C) { const int st = b / 1024, sb = b % 1024, swz = sb ^ (((sb >> 9) & 1) << 5); R = (st >> 1) * 16 + swz / 64; C = (st & 1) * 32 + (swz % 64) / 2; }
__host__ __device__ __forceinline__ int perm32(int rho) { const int n = rho >> 4, i = rho & 15; return 8 * (i >> 2) + 4 * n + (i & 3); }

struct Unit { int pm, pn, z; };
struct Gemm { const bf16_t* A; const bf16_t* Bt; int M, N, K, lda, ldb; size_t zA, zB; };

struct StaticOrder {
    int nM, nN, nwg, G, c, zsh, WGM;
    __host__ __device__ void init(int M, int N, int G_, int c_, int zsh_ = 0, int bn_ = BM, int wgm_ = 4) { nM = M / BM; nN = N / bn_; nwg = nM * nN; G = G_; c = c_; zsh = zsh_; WGM = wgm_; }
    __host__ __device__ bool next(int i, Unit& u) const {
        const int ti = i >> zsh; u.z = i & ((1 << zsh) - 1);
        const long L = (long)ti * G + c; if (L >= nwg) return false;
        int wgid = (int)L; { const int q = nwg / NXCD, r = nwg % NXCD, xcd = wgid % NXCD, off = wgid / NXCD; wgid = (xcd < r ? xcd * (q + 1) : r * (q + 1) + (xcd - r) * q) + off; }
        const int nig = WGM * nN, gid = wgid / nig, fm = gid * WGM, gsz = (nM - fm) < WGM ? (nM - fm) : WGM;
        u.pm = fm + ((wgid % nig) % gsz); u.pn = (wgid % nig) / gsz; return true;
    }
    __device__ __forceinline__ void a_ready(const Unit&) const {}
    __device__ __forceinline__ void done(const Unit&) const {}
};

typedef float f32x2_ __attribute__((ext_vector_type(2)));
typedef __bf16 bf16x2_ __attribute__((ext_vector_type(2)));
__device__ __forceinline__ unsigned cvt_pk_bf16(float lo, float hi) { const f32x2_ v = {lo, hi}; const bf16x2_ b = __builtin_convertvector(v, bf16x2_); return __builtin_bit_cast(unsigned, b); }

template <class Epi, class Sched, bool ALIGN_EPI = false, bool SP2 = false, bool HALFN = false>
__device__ __forceinline__ void gemm_phase(PG8_LAS unsigned char* lds, const Gemm g, const Sched& S, const Epi& E) {
    int tid = threadIdx.x; asm volatile("" : "+v"(tid));
    const int wid = __builtin_amdgcn_readfirstlane(tid >> 6), lane = tid & 63, wr = wid >> 2, wc = wid & 3, fr = lane & 15, fq = lane >> 4;
    const int K = g.K, nt = K / BK;
    unsigned voffA[2], voffB[2];
#pragma unroll
    for (int i = 0; i < 2; ++i) { int R, C; stage_rc(tid * 16 + i * 8192, R, C); const int Rb = Epi::PERM ? ((R & ~31) + perm32(R & 31)) : R;
        voffA[i] = (unsigned)(R * g.lda + C) * 2u; voffB[i] = (unsigned)(Rb * g.ldb + C) * 2u; }
    const size_t kstep = (size_t)(BK * 2);
    const size_t hstepA = (size_t)HALF * g.lda * 2, hstepB = (size_t)HALF * g.ldb * 2;
    const size_t tstepA = 2 * hstepA, tstepB = HALFN ? hstepB : 2 * hstepB;
    const unsigned ldsw = (unsigned)wid * 1024u;
    unsigned aoff = (unsigned)lds_byte(wr * 64 + fr, fq * 8), boff = (unsigned)lds_byte(wc * 32 + fr, fq * 8) + 4u * HTB;
    asm volatile("" : "+v"(aoff), "+v"(boff));
#define PG8_SA(b, h) (((b) * 2 + (h)) * HTB)
#define PG8_SB(b, h) ((4 + (b) * 2 + (h)) * HTB)
#define PG8_STAGE(bufoff, gbase, voff) do { _Pragma("unroll") for (int _i = 0; _i < 2; ++_i) \
        __builtin_amdgcn_global_load_lds((const unsigned*)((const char*)(gbase) + (voff)[_i]), (PG8_LAS unsigned*)(lds + (bufoff) + ldsw + _i * 8192), 16, 0, 0); } while (0)
#define PG8_LDA(dst, b, h) do { _Pragma("unroll") for (int m = 0; m < 4; ++m) _Pragma("unroll") for (int k = 0; k < 2; ++k) dst[m][k] = *(const PG8_LAS bf16x8*)(lds + aoff + (PG8_SA(b, h) + m * 2048 + k * 1024)); } while (0)
#define PG8_LDB(dst, b, h) do { _Pragma("unroll") for (int n = 0; n < 2; ++n) _Pragma("unroll") for (int k = 0; k < 2; ++k) dst[n][k] = *(const PG8_LAS bf16x8*)(lds + boff + (((b) * 2 + (h)) * HTB + n * 2048 + k * 1024)); } while (0)
#define PG8_MMA(ai, bj, At, Bt) do { __builtin_amdgcn_s_setprio(1); _Pragma("unroll") for (int m = 0; m < 4; ++m) _Pragma("unroll") for (int n = 0; n < 2; ++n) _Pragma("unroll") for (int k = 0; k < 2; ++k) \
        acc[ai][bj][m][n] = __builtin_amdgcn_mfma_f32_16x16x32_bf16(Bt[n][k], At[m][k], acc[ai][bj][m][n], 0, 0, 0); __builtin_amdgcn_s_setprio(0); } while (0)
#define PG8_WAIT_V(n) asm volatile("s_waitcnt vmcnt(" #n ")" ::: "memory")
#define PG8_WAIT_L(n) asm volatile("s_waitcnt lgkmcnt(" #n ")" ::: "memory")
#define PG8_BAR __builtin_amdgcn_s_barrier()
#define PG8_SCHED __builtin_amdgcn_sched_barrier(0)
    Unit cur, nxt; int ui = 0;
    if (!S.next(0, cur)) return;
    f32x4 acc[2][2][4][2];
#pragma unroll
    for (int a = 0; a < 2; ++a)
#pragma unroll
        for (int b = 0; b < 2; ++b)
#pragma unroll
            for (int m = 0; m < 4; ++m)
#pragma unroll
                for (int n = 0; n < 2; ++n) acc[a][b][m][n] = (f32x4){0.f, 0.f, 0.f, 0.f};
    bf16x8 At[4][2], B0[2][2], B1[2][2];
    const char* cA = (const char*)g.A + (size_t)cur.pm * tstepA + (size_t)cur.z * g.zA; const char* cB = (const char*)g.Bt + (size_t)cur.pn * tstepB + (size_t)cur.z * g.zB;
    S.a_ready(cur);
    if constexpr (SP2 && HALFN) {
        PG8_STAGE(PG8_SB(0, 0), cB, voffB); PG8_STAGE(PG8_SA(0, 0), cA, voffA); PG8_STAGE(PG8_SA(0, 1), cA + hstepA, voffA);
        if (wr == 1) PG8_BAR;
        PG8_WAIT_V(2); PG8_BAR;
        PG8_STAGE(PG8_SB(1, 0), cB + kstep, voffB); PG8_STAGE(PG8_SA(1, 0), cA + kstep, voffA);
        PG8_WAIT_V(4); PG8_BAR;
    } else if constexpr (SP2) {
        PG8_STAGE(PG8_SB(0, 0), cB, voffB); PG8_STAGE(PG8_SB(0, 1), cB + hstepB, voffB); PG8_STAGE(PG8_SA(0, 0), cA, voffA); PG8_STAGE(PG8_SA(0, 1), cA + hstepA, voffA);
        if (wr == 1) PG8_BAR;
        PG8_WAIT_V(2); PG8_BAR;
        PG8_STAGE(PG8_SB(1, 0), cB + kstep, voffB); PG8_STAGE(PG8_SA(1, 0), cA + kstep, voffA); PG8_STAGE(PG8_SB(1, 1), cB + hstepB + kstep, voffB);
        PG8_WAIT_V(6); PG8_BAR;
    } else {
        PG8_STAGE(PG8_SB(0, 0), cB, voffB); PG8_STAGE(PG8_SA(0, 0), cA, voffA); PG8_STAGE(PG8_SB(0, 1), cB + hstepB, voffB); PG8_STAGE(PG8_SA(0, 1), cA + hstepA, voffA);
        if (wr == 1) PG8_BAR;
        PG8_WAIT_V(4); PG8_BAR;
        PG8_STAGE(PG8_SB(1, 0), cB + kstep, voffB); PG8_STAGE(PG8_SA(1, 0), cA + kstep, voffA); PG8_STAGE(PG8_SB(1, 1), cB + hstepB + kstep, voffB);
        PG8_WAIT_V(6); PG8_BAR;
    }
    for (;;) {
        const bool has_next = S.next(ui + 1, nxt);
        const char* nA = has_next ? (const char*)g.A + (size_t)nxt.pm * tstepA + (size_t)nxt.z * g.zA : cA; const char* nB = has_next ? (const char*)g.Bt + (size_t)nxt.pn * tstepB + (size_t)nxt.z * g.zB : cB;
        for (int t = 0; t < nt; t += 2) {
            const bool last = (t == nt - 2);
            const char* a1 = cA + (size_t)(t + 1) * kstep;
            const char* a2 = last ? nA : cA + (size_t)(t + 2) * kstep; const char* b2 = last ? nB : cB + (size_t)(t + 2) * kstep;
            const char* a3 = a2 + kstep; const char* b3 = b2 + kstep;
            if (last && has_next) S.a_ready(nxt);
            if constexpr (SP2 && HALFN) {
            PG8_LDB(B0, 0, 0); PG8_SCHED; PG8_LDA(At, 0, 0); PG8_STAGE(PG8_SA(1, 1), a1 + hstepA, voffA);
            PG8_WAIT_V(6); PG8_WAIT_L(0); PG8_BAR; PG8_MMA(0, 0, At, B0); PG8_BAR; PG8_SCHED;
            PG8_LDA(At, 0, 1); PG8_STAGE(PG8_SB(0, 0), b2, voffB); PG8_STAGE(PG8_SA(0, 0), a2, voffA);
            PG8_WAIT_V(6); PG8_WAIT_L(0); PG8_BAR; PG8_MMA(1, 0, At, B0); PG8_BAR; PG8_SCHED;
            PG8_LDB(B0, 1, 0); PG8_SCHED; PG8_LDA(At, 1, 0); PG8_STAGE(PG8_SA(0, 1), a2 + hstepA, voffA);
            PG8_WAIT_V(6); PG8_WAIT_L(0); PG8_BAR; PG8_MMA(0, 0, At, B0); PG8_BAR; PG8_SCHED;
            PG8_LDA(At, 1, 1); PG8_STAGE(PG8_SB(1, 0), b3, voffB); PG8_STAGE(PG8_SA(1, 0), a3, voffA);
            PG8_WAIT_V(6); PG8_WAIT_L(0); PG8_BAR; PG8_MMA(1, 0, At, B0); PG8_BAR; PG8_SCHED;
            } else if constexpr (SP2) {
            PG8_LDB(B0, 0, 0); PG8_LDB(B1, 0, 1); PG8_SCHED; PG8_LDA(At, 0, 0); PG8_STAGE(PG8_SA(1, 1), a1 + hstepA, voffA);
            PG8_WAIT_V(8); PG8_WAIT_L(0); PG8_BAR; PG8_MMA(0, 0, At, B0); PG8_MMA(0, 1, At, B1); PG8_BAR; PG8_SCHED;
            PG8_LDA(At, 0, 1); PG8_STAGE(PG8_SB(0, 0), b2, voffB); PG8_STAGE(PG8_SB(0, 1), b2 + hstepB, voffB); PG8_STAGE(PG8_SA(0, 0), a2, voffA);
            PG8_WAIT_V(8); PG8_WAIT_L(0); PG8_BAR; PG8_MMA(1, 0, At, B0); PG8_MMA(1, 1, At, B1); PG8_BAR; PG8_SCHED;
            PG8_LDB(B0, 1, 0); PG8_LDB(B1, 1, 1); PG8_SCHED; PG8_LDA(At, 1, 0); PG8_STAGE(PG8_SA(0, 1), a2 + hstepA, voffA);
            PG8_WAIT_V(8); PG8_WAIT_L(0); PG8_BAR; PG8_MMA(0, 0, At, B0); PG8_MMA(0, 1, At, B1); PG8_BAR; PG8_SCHED;
            PG8_LDA(At, 1, 1); PG8_STAGE(PG8_SB(1, 0), b3, voffB); PG8_STAGE(PG8_SB(1, 1), b3 + hstepB, voffB); PG8_STAGE(PG8_SA(1, 0), a3, voffA);
            PG8_WAIT_V(8); PG8_WAIT_L(0); PG8_BAR; PG8_MMA(1, 0, At, B0); PG8_MMA(1, 1, At, B1); PG8_BAR; PG8_SCHED;
            } else {
            PG8_LDB(B0, 0, 0); PG8_SCHED; PG8_LDA(At, 0, 0); PG8_STAGE(PG8_SA(1, 1), a1 + hstepA, voffA);
            PG8_WAIT_L(8); PG8_BAR; PG8_WAIT_L(0); PG8_MMA(0, 0, At, B0); PG8_BAR; PG8_SCHED;
            PG8_LDB(B1, 0, 1); PG8_STAGE(PG8_SB(0, 0), b2, voffB);
            PG8_BAR; PG8_WAIT_L(0); PG8_MMA(0, 1, At, B1); PG8_BAR;
            PG8_LDA(At, 0, 1); PG8_STAGE(PG8_SA(0, 0), a2, voffA);
            PG8_BAR; PG8_WAIT_L(0); PG8_MMA(1, 0, At, B0); PG8_BAR; PG8_SCHED;
            PG8_STAGE(PG8_SB(0, 1), b2 + hstepB, voffB);
            PG8_WAIT_V(6); PG8_BAR; PG8_MMA(1, 1, At, B1); PG8_BAR;
            PG8_LDB(B0, 1, 0); PG8_SCHED; PG8_LDA(At, 1, 0); PG8_STAGE(PG8_SA(0, 1), a2 + hstepA, voffA);
            PG8_WAIT_L(8); PG8_BAR; PG8_WAIT_L(0); PG8_MMA(0, 0, At, B0); PG8_BAR; PG8_SCHED;
            PG8_LDB(B1, 1, 1); PG8_STAGE(PG8_SB(1, 0), b3, voffB);
            PG8_BAR; PG8_WAIT_L(0); PG8_MMA(0, 1, At, B1); PG8_BAR;
            PG8_LDA(At, 1, 1); PG8_STAGE(PG8_SA(1, 0), a3, voffA);
            PG8_BAR; PG8_WAIT_L(0); PG8_MMA(1, 0, At, B0); PG8_BAR; PG8_SCHED;
            PG8_STAGE(PG8_SB(1, 1), b3 + hstepB, voffB);
            PG8_WAIT_V(6); PG8_BAR; PG8_MMA(1, 1, At, B1); PG8_BAR;
            }
        }
        if constexpr (ALIGN_EPI) { if (wr == 0) PG8_BAR; }
        { int fr_e = fr, fq_e = fq; asm volatile("" : "+v"(fr_e), "+v"(fq_e));
          E(acc, cur, wr, wc, fr_e, fq_e); }
        if (!has_next) break;
        if (!HALFN && !(Epi::KEEP && cur.z != 3)) {
#pragma unroll
        for (int a = 0; a < 2; ++a)
#pragma unroll
            for (int b = 0; b < 2; ++b)
#pragma unroll
                for (int m = 0; m < 4; ++m)
#pragma unroll
                    for (int n = 0; n < 2; ++n) acc[a][b][m][n] = (f32x4){0.f, 0.f, 0.f, 0.f};
        }
        cur = nxt; cA = nA; cB = nB; ++ui;
        if constexpr (ALIGN_EPI) { if (wr == 1) PG8_BAR; }
    }
    PG8_WAIT_V(0);
    if constexpr (!ALIGN_EPI) { if (wr == 0) PG8_BAR; }
    PG8_BAR;
#undef PG8_SA
#undef PG8_SB
#undef PG8_STAGE
#undef PG8_LDA
#undef PG8_LDB
#undef PG8_MMA
#undef PG8_WAIT_V
#undef PG8_WAIT_L
#undef PG8_BAR
#undef PG8_SCHED
}

}

using pg8::bf16_t; using pg8::f32x4; using pg8::u32x4; using pg8::u32x2; using pg8::bf16x8; using pg8::cvt_pk_bf16;
#define LAS __attribute__((address_space(3)))

constexpr int D = 1024, SEQ = 4096, NB = 16, DEPTH = 4, BW = 512;
constexpr int NGRP = 2, BG = NB / NGRP, TG = BG * SEQ;
constexpr int N_IN = 21 * 256, N_MG = 4096, N_ALL = N_IN + N_MG;
constexpr int PLD = 20 * 256;
constexpr int P_GQ = 0, P_GK = 256, P_GV = 512, P_GG = 1024, P_RQ = 1536, P_RK = 1792, P_RV = 2048, P_RG = 2560, P_LX = 3072, P_LG = 3584, P_SU = 4096, P_SG = 4608;
constexpr int OLD = 2048;
constexpr float NORM_EPS = 1e-6f;

constexpr size_t MiB = 1u << 20;
constexpr size_t WS_CTL = 0, CTL_BYTES = 2 * MiB;
constexpr size_t WS_ROT = 2 * MiB;
constexpr size_t WS_SMALL = 3 * MiB, SMALL_STRIDE = 1 * MiB;
constexpr size_t WS_W = 8 * MiB, W_STRIDE = 26 * MiB;
constexpr size_t WO_IN = 0, WO_BR = (size_t)N_ALL * D * 2, WO_OUT = WO_BR + (size_t)4 * D * BW * 2, WO_GLU = WO_OUT + (size_t)D * D * 2, WO_END = WO_GLU + (size_t)BW * BW * 2;
static_assert(WO_END <= W_STRIDE, "weights");
constexpr size_t WS_U = 112 * MiB;
constexpr size_t WS_P = 176 * MiB;
constexpr size_t WS_LA = 496 * MiB;
constexpr size_t WS_O = 528 * MiB;
constexpr size_t WS_Y5 = 656 * MiB;
constexpr size_t WS_PG = 688 * MiB;
constexpr size_t WS_ST = 944 * MiB;
constexpr size_t WS_END = 1008 * MiB;
constexpr int SM_ABR = 0, SM_ABI = 2048, SM_BBR = 4096, SM_BBI = 4096 + 32768, SM_SP8 = 4096 + 65536, SM_END_F = SM_SP8 + 512;
constexpr int SM_A128 = SM_END_F;
constexpr size_t SM_LRUW_BYTES = 512 * 1024, SM_CT_BYTES = 640 * 1024, SM_BBT_BYTES = 768 * 1024;
static_assert((size_t)(SM_END_F + 4096) * 4 <= SM_LRUW_BYTES, "small");

constexpr int CW_BAR = 4096;
#define XB_TMO      128
#define XB_XCNT(j)  (256  + 64 * (j))
#define XB_XSUB(j)  (1280 + 64 * (j))
#define XB_XGEN(j)  (2304 + 64 * (j))
#define XB_TOP      3328
#define XB_TOPGEN   3392
#define XCD_BAR_WORDS 3456
#define XB_SPIN_CAP (1u << 18)

__device__ __forceinline__ unsigned xb_ld(unsigned* p)              { return __hip_atomic_load(p, __ATOMIC_RELAXED, __HIP_MEMORY_SCOPE_AGENT); }
__device__ __forceinline__ unsigned xb_add(unsigned* p, unsigned v) { return __hip_atomic_fetch_add(p, v, __ATOMIC_RELAXED, __HIP_MEMORY_SCOPE_AGENT); }
__device__ __forceinline__ unsigned xb_xcc_id() { return (unsigned)__builtin_amdgcn_s_getreg((3 << 11) | 20) & 0xFu; }
#define XB_SPIN(cond, bar) do { unsigned _sp = 0; while (cond) { __builtin_amdgcn_s_sleep(1); \
    if ((++_sp & 255u) == 0u) { if (xb_ld(&(bar)[XB_TMO])) break; if (_sp > XB_SPIN_CAP) { atomicAdd(&(bar)[XB_TMO], 1u); break; } } } } while (0)
struct XcdBarrier { unsigned* bar; unsigned x; volatile LAS unsigned* st; };
__device__ __forceinline__ XcdBarrier xcd_barrier_post(unsigned* bar, volatile LAS unsigned* st) {
    XcdBarrier b; b.bar = bar; b.x = xb_xcc_id(); b.st = st;
    if (threadIdx.x == 0) (void)xb_add(&bar[XB_XCNT(b.x)], 1u);
    return b;
}
__device__ __forceinline__ void xcd_barrier_complete(unsigned* bar, unsigned x, unsigned& nloc, unsigned& nx) {
    const unsigned G = gridDim.x * gridDim.y * gridDim.z;
    unsigned sum, cnt, mine, sp = 0u;
    for (;;) {
        sum = 0u; cnt = 0u; mine = 0u;
#pragma unroll
        for (unsigned j = 0; j < 16; ++j) { const unsigned c = xb_ld(&bar[XB_XCNT(j)]); sum += c; cnt += (c > 0u) ? 1u : 0u; mine = (j == x) ? c : mine; }
        if (sum == G) break;
        __builtin_amdgcn_s_sleep(1);
        if ((++sp & 255u) == 0u) { if (xb_ld(&bar[XB_TMO])) break; if (sp > XB_SPIN_CAP) { atomicAdd(&bar[XB_TMO], 1u); break; } }
    }
    nloc = mine > 0u ? mine : 1u; nx = cnt > 0u ? cnt : 1u;
}
__device__ __forceinline__ void xcd_barrier(const XcdBarrier& b) {
    asm volatile("s_waitcnt vmcnt(0)" ::: "memory");
    __syncthreads();
    if (threadIdx.x == 0) {
        unsigned* bar = b.bar;
        __builtin_amdgcn_s_waitcnt(0);
        unsigned nloc = b.st[0], nx = b.st[1];
        if (nloc == 0u) { xcd_barrier_complete(bar, b.x, nloc, nx); b.st[0] = nloc; b.st[1] = nx; }
        const unsigned old = xb_add(&bar[XB_XSUB(b.x)], 1u);
        const unsigned gen = old / nloc;
        if (old + 1u == (gen + 1u) * nloc) {
            __builtin_amdgcn_fence(__ATOMIC_RELEASE, "agent");
            asm volatile("s_waitcnt vmcnt(0)" ::: "memory");
            const unsigned og = xb_add(&bar[XB_TOP], 1u);
            const unsigned tg = og / nx;
            if (og + 1u == (tg + 1u) * nx) xb_add(&bar[XB_TOPGEN], 1u);
            else XB_SPIN(xb_ld(&bar[XB_TOPGEN]) == tg, bar);
            __builtin_amdgcn_fence(__ATOMIC_ACQUIRE, "agent");
            xb_add(&bar[XB_XGEN(b.x)], 1u);
            asm volatile("s_waitcnt vmcnt(0)" ::: "memory");
        } else {
            XB_SPIN(xb_ld(&bar[XB_XGEN(b.x)]) == gen, bar);
            __builtin_amdgcn_fence(__ATOMIC_ACQUIRE, "agent");
            asm volatile("s_waitcnt vmcnt(0)" ::: "memory");
        }
    }
    __syncthreads();
}

__device__ __forceinline__ float bf2f(bf16_t b) { return __uint_as_float(((unsigned)b) << 16); }
__device__ __forceinline__ float bflo(unsigned w) { return __uint_as_float(w << 16); }
__device__ __forceinline__ float bfhi(unsigned w) { return __uint_as_float(w & 0xffff0000u); }
__device__ __forceinline__ bf16_t f2bf(float f) { return (bf16_t)(cvt_pk_bf16(f, 0.f) & 0xffffu); }
__device__ __forceinline__ float sigmoid_f(float x) { return __builtin_amdgcn_rcpf(1.f + __expf(-x)); }
__device__ __forceinline__ float silu_f(float x) { return x * sigmoid_f(x); }
__device__ __forceinline__ unsigned unorm8(float x) { return (unsigned)(x * 255.f + 0.5f); }
__device__ __forceinline__ float gelu_tanh_f(float x) { const float u = 0.7978845608028654f * (x + 0.044715f * x * x * x); const float t = 1.f - 2.f * __builtin_amdgcn_rcpf(1.f + __expf(2.f * u)); return 0.5f * x * (1.f + t); }
__device__ __forceinline__ float wave_sum(float v) {
#pragma unroll
    for (int o = 1; o < 64; o <<= 1) v += __shfl_xor(v, o);
    return v;
}

#define GEMM_CALL(EPI) pg8::gemm_phase<EPI, pg8::StaticOrder, true, true>(lds, g, S, E)
struct Args {
    const float* in[29]; float* out; unsigned char* ws;
    int s_lo, s_hi, li, fin, mmask, pad2;
};
enum { I_X = 0, I_NG, I_WIN, I_GWLR, I_GBLR, I_GNG, I_RNG, I_RNB, I_LCW, I_LCB, I_LWA, I_LBA, I_LWX, I_LBX, I_LLAM,
       I_SARE, I_SAIM, I_SBRE, I_SBIM, I_SCRE, I_SCIM, I_SD, I_SLDT, I_SGW, I_SGB, I_WMG, I_WBR, I_WOUT, I_FNG };

struct EpiIn {
    static constexpr bool PERM = true, AFTER_DRAIN = false, KEEP = false;
    bf16_t* P; float* LA; const float* blr; const float* rot; unsigned char* PG;
    __device__ __forceinline__ void operator()(f32x4 (&acc)[2][2][4][2], const pg8::Unit& u, int wr, int wc, int fr, int fq) const {
        const int pn = u.pn, row0 = u.pm * 256 + wr * 64 + fr, cl = wc * 32 + 8 * fq;
        if (pn >= 21) {
#pragma unroll
            for (int ai = 0; ai < 2; ++ai)
#pragma unroll
                for (int m = 0; m < 4; ++m) { int row = row0 + ai * 128 + m * 16; asm volatile("" : "+v"(row));
                    u32x4 w;
#pragma unroll
                    for (int bj = 0; bj < 2; ++bj) { const f32x4 v0 = acc[ai][bj][m][0], v1 = acc[ai][bj][m][1];
                        const unsigned lo = unorm8(sigmoid_f(v0[0])) | (unorm8(sigmoid_f(v0[1])) << 8) | (unorm8(sigmoid_f(v0[2])) << 16) | (unorm8(sigmoid_f(v0[3])) << 24);
                        const unsigned hi = unorm8(sigmoid_f(v1[0])) | (unorm8(sigmoid_f(v1[1])) << 8) | (unorm8(sigmoid_f(v1[2])) << 16) | (unorm8(sigmoid_f(v1[3])) << 24);
                        if (bj == 0) { w.x = lo; w.y = hi; } else { w.z = lo; w.w = hi; } }
                    __builtin_nontemporal_store(w, (u32x4*)(PG + (size_t)row * N_MG + (pn - 21) * 256 + 2 * cl)); }
        } else if (pn == 4) {
#pragma unroll
            for (int bj = 0; bj < 2; ++bj) { const int c = cl + bj * 128; const f32x4 b0 = *(const f32x4*)(blr + c), b1 = *(const f32x4*)(blr + c + 4);
#pragma unroll
                for (int ai = 0; ai < 2; ++ai) {
#pragma unroll
                    for (int n = 0; n < 2; ++n)
#pragma unroll
                        for (int j = 0; j < 4; ++j) { float run = 0.f; const float bb = n ? b1[j] : b0[j];
#pragma unroll
                            for (int m = 0; m < 4; ++m) { const float z = acc[ai][bj][m][n][j] + bb; const float x = -(fmaxf(-z, 0.f) + __logf(1.f + __expf(-fabsf(z)))) * 0.0625f; float ls = x, rs = x;
#define DPP_ADD(acc_, ctrl_) acc_ += __builtin_bit_cast(float, __builtin_amdgcn_update_dpp(0, __builtin_bit_cast(int, acc_), ctrl_, 0xf, 0xf, true))
                                DPP_ADD(ls, 0x111); DPP_ADD(ls, 0x112); DPP_ADD(ls, 0x114); DPP_ADD(ls, 0x118);
                                DPP_ADD(rs, 0x101); DPP_ADD(rs, 0x102); DPP_ADD(rs, 0x104); DPP_ADD(rs, 0x108);
#undef DPP_ADD
                                acc[ai][bj][m][n][j] = run + ls; run += ls + rs - x; } }
#pragma unroll
                    for (int m = 0; m < 4; ++m) { int row = row0 + ai * 128 + m * 16; asm volatile("" : "+v"(row)); float* d = LA + (size_t)row * 256 + c; *(f32x4*)d = acc[ai][bj][m][0]; *(f32x4*)(d + 4) = acc[ai][bj][m][1]; } } }
        } else if (pn == 7 || pn == 8) {
            const float sc = pn == 8 ? 0.125f : 1.f; const int dcol = (pn - 1) * 256;
#pragma unroll
            for (int ai = 0; ai < 2; ++ai)
#pragma unroll
                for (int m = 0; m < 4; ++m) { int row = row0 + ai * 128 + m * 16; asm volatile("" : "+v"(row)); const int pos = row & (SEQ - 1);
#pragma unroll
                    for (int bj = 0; bj < 2; ++bj) { const int c = cl + bj * 128, i0 = (c & 63) >> 1; const float* rt = rot + ((size_t)pos * 32 + i0) * 2;
                        const f32x4 cs0 = *(const f32x4*)rt, cs1 = *(const f32x4*)(rt + 4); const f32x4 v0 = acc[ai][bj][m][0] * sc, v1 = acc[ai][bj][m][1] * sc;
                        u32x4 w; w.x = cvt_pk_bf16(v0[0] * cs0[0] - v0[1] * cs0[1], v0[0] * cs0[1] + v0[1] * cs0[0]); w.y = cvt_pk_bf16(v0[2] * cs0[2] - v0[3] * cs0[3], v0[2] * cs0[3] + v0[3] * cs0[2]);
                        w.z = cvt_pk_bf16(v1[0] * cs1[0] - v1[1] * cs1[1], v1[0] * cs1[1] + v1[1] * cs1[0]); w.w = cvt_pk_bf16(v1[2] * cs1[2] - v1[3] * cs1[3], v1[2] * cs1[3] + v1[3] * cs1[2]);
                        __builtin_nontemporal_store(w, (u32x4*)(P + (size_t)row * PLD + dcol + c)); } }
        } else {
            const bool silu = (pn == 5 || pn == 6 || pn == 11 || pn == 12 || pn == 15 || pn == 16 || pn == 19 || pn == 20);
            const float sc = pn == 0 ? 0.125f : 1.f; const int dcol = (pn < 4 ? pn : pn - 1) * 256;
#pragma unroll
            for (int ai = 0; ai < 2; ++ai)
#pragma unroll
                for (int m = 0; m < 4; ++m) { int row = row0 + ai * 128 + m * 16; asm volatile("" : "+v"(row));
#pragma unroll
                    for (int bj = 0; bj < 2; ++bj) { f32x4 v0 = acc[ai][bj][m][0] * sc, v1 = acc[ai][bj][m][1] * sc;
                        if (silu) {
#pragma unroll
                            for (int j = 0; j < 4; ++j) { v0[j] = silu_f(v0[j]); v1[j] = silu_f(v1[j]); } }
                        u32x4 w; w.x = cvt_pk_bf16(v0[0], v0[1]); w.y = cvt_pk_bf16(v0[2], v0[3]); w.z = cvt_pk_bf16(v1[0], v1[1]); w.w = cvt_pk_bf16(v1[2], v1[3]);
                        __builtin_nontemporal_store(w, (u32x4*)(P + (size_t)row * PLD + dcol + cl + bj * 128)); } }
        }
    }
};
struct EpiSig {
    static constexpr bool PERM = true, AFTER_DRAIN = false, KEEP = false;
    bf16_t* PG;
    __device__ __forceinline__ void operator()(const f32x4 (&acc)[2][2][4][2], const pg8::Unit& u, int wr, int wc, int fr, int fq) const {
        const int row0 = u.pm * 256 + wr * 64 + fr, c0 = u.pn * 256 + wc * 32 + 8 * fq;
#pragma unroll
        for (int ai = 0; ai < 2; ++ai)
#pragma unroll
            for (int m = 0; m < 4; ++m) { const int row = row0 + ai * 128 + m * 16;
#pragma unroll
                for (int bj = 0; bj < 2; ++bj) { f32x4 v0 = acc[ai][bj][m][0], v1 = acc[ai][bj][m][1];
#pragma unroll
                    for (int j = 0; j < 4; ++j) { v0[j] = sigmoid_f(v0[j]); v1[j] = sigmoid_f(v1[j]); }
                    u32x4 w; w.x = cvt_pk_bf16(v0[0], v0[1]); w.y = cvt_pk_bf16(v0[2], v0[3]); w.z = cvt_pk_bf16(v1[0], v1[1]); w.w = cvt_pk_bf16(v1[2], v1[3]);
                    *(u32x4*)(PG + (size_t)row * N_MG + c0 + bj * 128) = w; } }
    }
};
struct EpiGlu {
    static constexpr bool PERM = true, AFTER_DRAIN = false, KEEP = false;
    const bf16_t* Y5; const bf16_t* P; const float* gb; bf16_t* O;
    __device__ __forceinline__ void operator()(const f32x4 (&acc)[2][2][4][2], const pg8::Unit& u, int wr, int wc, int fr, int fq) const {
        const int row0 = u.pm * 256 + wr * 64 + fr, c0 = u.pn * 256 + wc * 32 + 8 * fq;
#pragma unroll
        for (int bj = 0; bj < 2; ++bj) { const int c = c0 + bj * 128; const f32x4 b0 = *(const f32x4*)(gb + c), b1 = *(const f32x4*)(gb + c + 4);
#pragma unroll
            for (int ai = 0; ai < 2; ++ai)
#pragma unroll
                for (int m = 0; m < 4; ++m) { const int row = row0 + ai * 128 + m * 16;
                    const u32x4 y = *(const u32x4*)(Y5 + (size_t)row * BW + c), s = *(const u32x4*)(P + (size_t)row * PLD + P_SG + c);
                    const f32x4 v0 = acc[ai][bj][m][0] + b0, v1 = acc[ai][bj][m][1] + b1;
                    u32x4 w;
                    w.x = cvt_pk_bf16(bflo(y.x) * sigmoid_f(v0[0]) * bflo(s.x), bfhi(y.x) * sigmoid_f(v0[1]) * bfhi(s.x));
                    w.y = cvt_pk_bf16(bflo(y.y) * sigmoid_f(v0[2]) * bflo(s.y), bfhi(y.y) * sigmoid_f(v0[3]) * bfhi(s.y));
                    w.z = cvt_pk_bf16(bflo(y.z) * sigmoid_f(v1[0]) * bflo(s.z), bfhi(y.z) * sigmoid_f(v1[1]) * bfhi(s.z));
                    w.w = cvt_pk_bf16(bflo(y.w) * sigmoid_f(v1[2]) * bflo(s.w), bfhi(y.w) * sigmoid_f(v1[3]) * bfhi(s.w));
                    *(u32x4*)(O + (size_t)row * OLD + 1536 + c) = w; } }
    }
};
struct EpiBr {
    static constexpr bool PERM = true, AFTER_DRAIN = false, KEEP = false;
    const unsigned char* PG; bf16_t* MRG;
    __device__ __forceinline__ void operator()(f32x4 (&acc)[2][2][4][2], const pg8::Unit& u, int wr, int wc, int fr, int fq) const {
        const int row0 = u.pm * 256 + wr * 64 + fr, c = u.pn * 128 + wc * 32 + 8 * fq, z = u.z;
        const int gpos = (z * 4 + (u.pn >> 1)) * 256 + wc * 64 + fq * 16 + (u.pn & 1) * 8;
#pragma unroll
        for (int ai = 0; ai < 2; ++ai)
#pragma unroll
            for (int m = 0; m < 4; ++m) { const int row = row0 + ai * 128 + m * 16;
                const u32x2 gt = __builtin_nontemporal_load((const u32x2*)(PG + (size_t)row * N_MG + gpos));
                f32x4& p0 = acc[ai][0][m][0]; f32x4& p1 = acc[ai][0][m][1]; f32x4& s0 = acc[ai][1][m][0]; f32x4& s1 = acc[ai][1][m][1];
                if (z == 0) { s0 = (f32x4){0.f, 0.f, 0.f, 0.f}; s1 = s0; }
                s0[0] += p0[0] * (float)(gt.x & 255u); s0[1] += p0[1] * (float)((gt.x >> 8) & 255u); s0[2] += p0[2] * (float)((gt.x >> 16) & 255u); s0[3] += p0[3] * (float)(gt.x >> 24);
                s1[0] += p1[0] * (float)(gt.y & 255u); s1[1] += p1[1] * (float)((gt.y >> 8) & 255u); s1[2] += p1[2] * (float)((gt.y >> 16) & 255u); s1[3] += p1[3] * (float)(gt.y >> 24);
                p0 = (f32x4){0.f, 0.f, 0.f, 0.f}; p1 = p0;
                if (z == 3) { const float q = 1.f / 255.f; s0 *= q; s1 *= q;
                    u32x4 w; w.x = cvt_pk_bf16(s0[0], s0[1]); w.y = cvt_pk_bf16(s0[2], s0[3]); w.z = cvt_pk_bf16(s1[0], s1[1]); w.w = cvt_pk_bf16(s1[2], s1[3]);
                    *(u32x4*)(MRG + (size_t)row * D + c) = w; } }
    }
};
struct EpiOut {
    static constexpr bool PERM = true, AFTER_DRAIN = false, KEEP = false;
    bf16_t* DL;
    __device__ __forceinline__ void operator()(const f32x4 (&acc)[2][2][4][2], const pg8::Unit& u, int wr, int wc, int fr, int fq) const {
        const int row0 = u.pm * 256 + wr * 64 + fr, c0 = u.pn * 256 + wc * 32 + 8 * fq;
#pragma unroll
        for (int ai = 0; ai < 2; ++ai)
#pragma unroll
            for (int m = 0; m < 4; ++m) { const int row = row0 + ai * 128 + m * 16;
#pragma unroll
                for (int bj = 0; bj < 2; ++bj) { const f32x4 v0 = acc[ai][bj][m][0], v1 = acc[ai][bj][m][1];
                    u32x4 w; w.x = cvt_pk_bf16(v0[0], v0[1]); w.y = cvt_pk_bf16(v0[2], v0[3]); w.z = cvt_pk_bf16(v1[0], v1[1]); w.w = cvt_pk_bf16(v1[2], v1[3]);
                    *(u32x4*)(DL + (size_t)row * D + c0 + bj * 128) = w; } }
    }
};

__device__ __forceinline__ int win_src_col(int r) {
    const int pn = r >> 8, j = r & 255;
    switch (pn) {
        case 0: return j; case 1: return 256 + j; case 2: case 3: return 512 + (r - 512);
        case 4: return -1;
        case 5: case 6: return 1040 + (r - 1280);
        case 7: return 1552 + 64 * (j >> 6) + ((j & 63) >> 1) + 32 * (j & 1);
        case 8: return 1808 + 64 * (j >> 6) + ((j & 63) >> 1) + 32 * (j & 1);
        case 9: case 10: return 2064 + (r - 2304);
        case 11: case 12: return 2576 + (r - 2816);
        case 13: case 14: return 3088 + (r - 3328);
        case 15: case 16: return 3600 + (r - 3840);
        case 17: case 18: return 4112 + (r - 4352);
        default: return 4624 + (r - 4864);
    }
}
__device__ __forceinline__ void tr_store8(bf16_t* dst, const float (&v)[8]) {
    u32x4 w; w.x = cvt_pk_bf16(v[0], v[1]); w.y = cvt_pk_bf16(v[2], v[3]); w.z = cvt_pk_bf16(v[4], v[5]); w.w = cvt_pk_bf16(v[6], v[7]); *(u32x4*)dst = w;
}
__device__ __forceinline__ void phase_prologue(const Args& a, int gtid, int gthreads) {
    unsigned char* ws = a.ws;
    for (int l = 0; l < DEPTH; ++l) {
        bf16_t* Wl = (bf16_t*)(ws + WS_W + (size_t)l * W_STRIDE);
        const float* win = a.in[I_WIN] + (size_t)l * D * 5136;
        const float* wlr = a.in[I_GWLR] + (size_t)l * 16 * 256;
        for (int idx = gtid; idx < N_IN * (D / 8); idx += gthreads) { const int n = idx % N_IN, kc = idx / N_IN; const int sc = win_src_col(n); float v[8];
            if (sc >= 0) {
#pragma unroll
                for (int i = 0; i < 8; ++i) v[i] = win[(size_t)(kc * 8 + i) * 5136 + sc];
            } else { const int j = n & 255;
#pragma unroll
                for (int i = 0; i < 8; ++i) { float s = 0.f; const float* wr_ = win + (size_t)(kc * 8 + i) * 5136 + 1024;
#pragma unroll
                    for (int r = 0; r < 16; ++r) s += wr_[r] * wlr[r * 256 + j];
                    v[i] = s; } }
            tr_store8(Wl + (size_t)n * D + kc * 8, v); }
        const float* wmg = a.in[I_WMG] + (size_t)l * 4 * D * D;
        for (int idx = gtid; idx < N_MG * (D / 8); idx += gthreads) { const int n = idx % N_MG, kc = idx / N_MG, bi = n >> 10, c = n & 1023; float v[8];
#pragma unroll
            for (int i = 0; i < 8; ++i) v[i] = wmg[((size_t)bi * D + kc * 8 + i) * D + c];
            tr_store8(Wl + (size_t)(N_IN + n) * D + kc * 8, v); }
        const float* wbr = a.in[I_WBR] + (size_t)l * 4 * BW * D; bf16_t* Wb = (bf16_t*)((unsigned char*)Wl + WO_BR);
        for (int idx = gtid; idx < 4 * D * (BW / 8); idx += gthreads) { const int n = idx % (4 * D), kc = idx / (4 * D), bi = n >> 10, c = n & 1023; float v[8];
#pragma unroll
            for (int i = 0; i < 8; ++i) v[i] = wbr[((size_t)bi * BW + kc * 8 + i) * D + c];
            tr_store8(Wb + (size_t)n * BW + kc * 8, v); }
        const float* wout = a.in[I_WOUT] + (size_t)l * D * D; bf16_t* Wo = (bf16_t*)((unsigned char*)Wl + WO_OUT);
        for (int idx = gtid; idx < D * (D / 8); idx += gthreads) { const int n = idx % D, kc = idx / D; float v[8];
#pragma unroll
            for (int i = 0; i < 8; ++i) v[i] = wout[(size_t)(kc * 8 + i) * D + n];
            tr_store8(Wo + (size_t)n * D + kc * 8, v); }
        const float* wglu = a.in[I_SGW] + (size_t)l * BW * BW; bf16_t* Wg = (bf16_t*)((unsigned char*)Wl + WO_GLU);
        for (int idx = gtid; idx < BW * (BW / 8); idx += gthreads) { const int n = idx % BW, kc = idx / BW; float v[8];
#pragma unroll
            for (int i = 0; i < 8; ++i) v[i] = wglu[(size_t)(kc * 8 + i) * BW + n];
            tr_store8(Wg + (size_t)n * BW + kc * 8, v); }
        float* sm = (float*)(ws + WS_SMALL + (size_t)l * SMALL_STRIDE);
        for (int idx = gtid; idx < 2048; idx += gthreads) { const int g = idx >> 6;
            const double step = exp((double)a.in[I_SLDT][l * 32 + g]); const double are = a.in[I_SARE][l * 2048 + idx], aim = a.in[I_SAIM][l * 2048 + idx];
            const double mag = exp(step * are), abr = mag * cos(step * aim), abi = mag * sin(step * aim), den = are * are + aim * aim;
            const double fre = ((abr - 1.0) * are + abi * aim) / den, fim = (abi * are - (abr - 1.0) * aim) / den;
            sm[SM_ABR + idx] = (float)abr; sm[SM_ABI + idx] = (float)abi;
            { const double m128 = exp(512.0 * step * are); sm[SM_A128 + idx * 2] = (float)(m128 * cos(512.0 * step * aim)); sm[SM_A128 + idx * 2 + 1] = (float)(m128 * sin(512.0 * step * aim)); }
            bf16_t* bbt = (bf16_t*)((unsigned char*)sm + SM_BBT_BYTES); const int p_ = idx & 63;
            for (int i = 0; i < 16; ++i) { const double br = a.in[I_SBRE][(size_t)l * 32768 + idx * 16 + i], bi = a.in[I_SBIM][(size_t)l * 32768 + idx * 16 + i];
                const float vr = (float)(fre * br - fim * bi), vi = (float)(fre * bi + fim * br);
                sm[SM_BBR + idx * 16 + i] = vr; sm[SM_BBI + idx * 16 + i] = vi; bbt[(g * 128 + 2 * p_) * 16 + i] = f2bf(vr); bbt[(g * 128 + 2 * p_ + 1) * 16 + i] = f2bf(vi); } }
        for (int idx = gtid; idx < 512; idx += gthreads) { const float lam = a.in[I_LLAM][l * 512 + idx]; const float nl = -lam;
            sm[SM_SP8 + idx] = 8.0f * (fmaxf(nl, 0.f) + log1pf(expf(-fabsf(nl)))); }
        { bf16_t* ct = (bf16_t*)((unsigned char*)sm + SM_CT_BYTES);
          for (int idx = gtid; idx < 32 * 16 * 128; idx += gthreads) { const int k = idx & 127, gi = idx >> 7;
              const float v = (k & 1) == 0 ? a.in[I_SCRE][(size_t)l * 32768 + gi * 64 + (k >> 1)] : -a.in[I_SCIM][(size_t)l * 32768 + gi * 64 + (k >> 1)]; ct[idx] = f2bf(v); } }
        bf16_t* lw = (bf16_t*)((unsigned char*)sm + SM_LRUW_BYTES);
        for (int idx = gtid; idx < 8 * 128 * 64; idx += gthreads) { const int i = idx & 63, jj = (idx >> 6) & 127, n = idx >> 13;
            const float v = jj < 64 ? a.in[I_LWA][(((size_t)l * 8 + n) * 64 + i) * 64 + jj] : a.in[I_LWX][(((size_t)l * 8 + n) * 64 + i) * 64 + (jj - 64)];
            lw[idx] = f2bf(v); }
    }
    float* rot = (float*)(ws + WS_ROT);
    for (int idx = gtid; idx < SEQ * 32; idx += gthreads) { const int i = idx & 31, s = idx >> 5;
        const double inv = pow(10000.0, -(double)i / 32.0), ang = (double)s * inv; rot[idx * 2] = (float)cos(ang); rot[idx * 2 + 1] = (float)sin(ang); }
}

template <bool F32OUT, bool ADD>
__device__ __forceinline__ void phase_norm(const float* hin, const bf16_t* delta, float* hout, const float* gain, bf16_t* uout, int gw, int ngw, int lane) {
    f32x4 gv[4];
#pragma unroll
    for (int j = 0; j < 4; ++j) gv[j] = *(const f32x4*)(gain + 4 * lane + 256 * j);
    for (int row = gw; row < TG; row += ngw) {
        const f32x4* xr = (const f32x4*)(hin + (size_t)row * D) + lane; f32x4 v[4]; float s = 0.f;
#pragma unroll
        for (int j = 0; j < 4; ++j) v[j] = __builtin_nontemporal_load(xr + 64 * j);
        if (ADD) { const u32x2* dr = (const u32x2*)(delta + (size_t)row * D) + lane;
#pragma unroll
            for (int j = 0; j < 4; ++j) { const u32x2 dw = __builtin_nontemporal_load(dr + 64 * j); v[j].x += bflo(dw.x); v[j].y += bfhi(dw.x); v[j].z += bflo(dw.y); v[j].w += bfhi(dw.y); } }
#pragma unroll
        for (int j = 0; j < 4; ++j) s += (v[j].x * v[j].x + v[j].y * v[j].y) + (v[j].z * v[j].z + v[j].w * v[j].w);
        const float rstd = rsqrtf(wave_sum(s) * (1.f / D) + NORM_EPS);
        if (F32OUT) { f32x4* o = (f32x4*)(hout + (size_t)row * D) + lane;
#pragma unroll
            for (int j = 0; j < 4; ++j) o[64 * j] = v[j] * rstd * gv[j];
        } else {
            if (ADD) { f32x4* o = (f32x4*)(hout + (size_t)row * D) + lane;
#pragma unroll
                for (int j = 0; j < 4; ++j) o[64 * j] = v[j]; }
            u32x2* o = (u32x2*)(uout + (size_t)row * D) + lane;
#pragma unroll
            for (int j = 0; j < 4; ++j) { const f32x4 y = v[j] * rstd * gv[j]; u32x2 w; w.x = cvt_pk_bf16(y.x, y.y); w.y = cvt_pk_bf16(y.z, y.w); o[64 * j] = w; } }
    }
}

constexpr int NSEGG = 8;
constexpr int NSEGL = 32;
constexpr int NSEGS = 8;
constexpr size_t ST_GSEG = 0;
constexpr size_t ST_GDS = ST_GSEG + (size_t)2 * BG * 4 * NSEGG * 8192;
constexpr size_t ST_LRU = ST_GDS + (size_t)2 * BG * 4 * NSEGG * 64;
constexpr size_t ST_S5 = ST_LRU + (size_t)BG * NSEGL * 512 * 2;
constexpr size_t ST_END_F = ST_S5 + (size_t)BG * NSEGS * 32 * 128;
static_assert(ST_END_F * 4 <= 64 * MiB, "state scratch");
typedef short s16x4 __attribute__((ext_vector_type(4)));

__device__ __forceinline__ bf16x8 lds_tr_frag(LAS const unsigned char* base, int row_stride_bytes, int lane) {
    const int g = lane >> 4, idx = lane & 15, q = idx >> 2, p = idx & 3;
    LAS const unsigned char* a0 = base + (8 * g + q) * row_stride_bytes + 8 * p;
    const s16x4 r0 = __builtin_amdgcn_ds_read_tr16_b64_v4i16((LAS s16x4*)a0);
    const s16x4 r1 = __builtin_amdgcn_ds_read_tr16_b64_v4i16((LAS s16x4*)(a0 + 4 * row_stride_bytes));
    bf16x8 f; f[0] = r0[0]; f[1] = r0[1]; f[2] = r0[2]; f[3] = r0[3]; f[4] = r1[0]; f[5] = r1[1]; f[6] = r1[2]; f[7] = r1[3]; return f;
}
#define WGSYNC() do { asm volatile("s_waitcnt lgkmcnt(0)" ::: "memory"); __builtin_amdgcn_s_barrier(); asm volatile("" ::: "memory"); } while (0)

constexpr int GL_QD = 0, GL_KD = 9216, GL_KT = 18432, GL_V = 27648, GL_ST = 45056, GL_LAST = 63488, GL_RED = 63744, GL_RED2 = 64256;
struct GlaP { const bf16_t* P; const float* LA; const float* gain; const float* bias; bf16_t* O; float* SSEG; float* DSUM; };
__device__ __forceinline__ bf16x8 lds_tr_frag2(LAS const unsigned char* base, int row_stride_bytes, int lane, int mulg, int second_off) {
    const int g = lane >> 4, idx = lane & 15, q = idx >> 2, p = idx & 3;
    LAS const unsigned char* a0 = base + (mulg * g + q) * row_stride_bytes + 8 * p;
    const s16x4 r0 = __builtin_amdgcn_ds_read_tr16_b64_v4i16((LAS s16x4*)a0);
    const s16x4 r1 = __builtin_amdgcn_ds_read_tr16_b64_v4i16((LAS s16x4*)(a0 + second_off * row_stride_bytes));
    bf16x8 f; f[0] = r0[0]; f[1] = r0[1]; f[2] = r0[2]; f[3] = r0[3]; f[4] = r1[0]; f[5] = r1[1]; f[6] = r1[2]; f[7] = r1[3]; return f;
}
__device__ __forceinline__ bf16x8 pack8(const f32x4 a, const f32x4 b) { u32x4 w; w.x = cvt_pk_bf16(a[0], a[1]); w.y = cvt_pk_bf16(a[2], a[3]); w.z = cvt_pk_bf16(b[0], b[1]); w.w = cvt_pk_bf16(b[2], b[3]); return __builtin_bit_cast(bf16x8, w); }

template <bool PASSC>
__device__ __forceinline__ void glaret_item(LAS unsigned char* lds, const GlaP& gp, const bool gla, const int b, const int h, const int seg, const int sidx  ) {
    int tid = threadIdx.x; asm volatile("" : "+v"(tid));
    const int w = __builtin_amdgcn_readfirstlane(tid >> 6), l = tid & 63, fr = l & 15, fq = l >> 4;
    const int qoff = gla ? P_GQ : P_RQ, koff = gla ? P_GK : P_RK, voff = gla ? P_GV : P_RV, goff = gla ? P_GG : P_RG, ooff = gla ? 0 : 512;
    const float lg = __logf(1.f - exp2f(-5.f - (float)h));
    f32x4 accs[4];
#pragma unroll
    for (int dt = 0; dt < 4; ++dt) accs[dt] = (f32x4){0.f, 0.f, 0.f, 0.f};
    const int arow = 8 * w + (l >> 3), apart = l & 7;
    float dsum[8];
#pragma unroll
    for (int e = 0; e < 8; ++e) dsum[e] = 0.f;
    if (PASSC) {
        for (int sp = 0; sp < seg; ++sp) {
            const float* sg = gp.SSEG + (size_t)(sidx + sp) * 8192 + tid * 16; const float* dsm = gp.DSUM + (size_t)(sidx + sp) * 64;
#pragma unroll
            for (int dt = 0; dt < 4; ++dt) { const f32x4 dv = *(const f32x4*)(dsm + 16 * dt + 4 * fq), sv = *(const f32x4*)(sg + 4 * dt);
#pragma unroll
                for (int r = 0; r < 4; ++r) accs[dt][r] = accs[dt][r] * __expf(dv[r]) + sv[r]; }
        }
#pragma unroll
        for (int dt = 0; dt < 4; ++dt) { u32x2 wv; wv.x = cvt_pk_bf16(accs[dt][0], accs[dt][1]); wv.y = cvt_pk_bf16(accs[dt][2], accs[dt][3]);
            *(LAS u32x2*)(lds + GL_ST + (16 * w + fr) * 144 + 32 * dt + 8 * fq) = wv; }
    }
    const int it = w & 3, ch = w >> 2;
    f32x4 gnv[4], bsv[4];
#pragma unroll
    for (int ct = 0; ct < 4; ++ct) { const int c = 128 * h + 64 * ch + 16 * ct + 4 * fq; gnv[ct] = PASSC ? *(const f32x4*)(gp.gain + c) : (f32x4){0.f, 0.f, 0.f, 0.f};
        bsv[ct] = (PASSC && !gla) ? *(const f32x4*)(gp.bias + c) : (f32x4){0.f, 0.f, 0.f, 0.f}; }
    u32x4 rq = (u32x4){0u, 0u, 0u, 0u}, rk, rv[2]; f32x4 rla[2], rll[2]; u32x2 gnx[4];
    const float rq_s = __expf((float)(arow + 1) * lg), rk_s = __expf(-(float)(arow + 1) * lg), rt_s = __expf((float)(63 - arow) * lg);
#define GL_ISSUE(n_) do { const size_t r0_ = (size_t)b * SEQ + seg * 512 + (n_) * 64; \
        { const bf16_t* pr_ = gp.P + (r0_ + arow) * PLD + 64 * h + 8 * apart; if (PASSC) rq = *(const u32x4*)(pr_ + qoff); rk = *(const u32x4*)(pr_ + koff); \
          if (gla) { const float* lp_ = gp.LA + (r0_ + arow) * 256 + 64 * h + 8 * apart; rla[0] = *(const f32x4*)lp_; rla[1] = *(const f32x4*)(lp_ + 4); const float* ll_ = gp.LA + (r0_ + 63) * 256 + 64 * h + 8 * apart; rll[0] = *(const f32x4*)ll_; rll[1] = *(const f32x4*)(ll_ + 4); } \
          else { rla[0] = (f32x4){0.f, 0.f, 0.f, 0.f}; rla[1] = rla[0]; rll[0] = rla[0]; rll[1] = rla[0]; } } \
        _Pragma("unroll") for (int e_ = 0; e_ < 2; ++e_) { const int p_ = tid + 512 * e_, i_ = p_ >> 4, part_ = p_ & 15; \
            rv[e_] = *(const u32x4*)(gp.P + (r0_ + i_) * PLD + voff + 128 * h + 8 * part_); } \
        if (PASSC) { _Pragma("unroll") for (int ct_ = 0; ct_ < 4; ++ct_) gnx[ct_] = *(const u32x2*)(gp.P + (r0_ + 16 * it + fr) * PLD + goff + 128 * h + 64 * ch + 16 * ct_ + 4 * fq); } } while (0)
    GL_ISSUE(0);
    for (int n = 0; n < 8; ++n) {
        const size_t row0 = (size_t)b * SEQ + seg * 512 + n * 64;
#pragma unroll
        for (int e = 0; e < 2; ++e) { const int p = tid + 512 * e, i = p >> 4, part = p & 15; *(LAS u32x4*)(lds + GL_V + i * 272 + part * 16) = rv[e]; }
        { float cum[8], lastv[8];
          const float kk[8] = {bflo(rk.x), bfhi(rk.x), bflo(rk.y), bfhi(rk.y), bflo(rk.z), bfhi(rk.z), bflo(rk.w), bfhi(rk.w)};
          float eq[8], ek[8], et[8];
          if (gla) {
#pragma unroll
              for (int e = 0; e < 8; ++e) { cum[e] = e < 4 ? rla[0][e] : rla[1][e - 4]; lastv[e] = e < 4 ? rll[0][e] : rll[1][e - 4];
                  eq[e] = __expf(cum[e]); ek[e] = __builtin_amdgcn_rcpf(eq[e]); et[e] = __expf(lastv[e]) * ek[e]; }
          } else {
#pragma unroll
              for (int e = 0; e < 8; ++e) { lastv[e] = 64.f * lg; eq[e] = rq_s; ek[e] = rk_s; et[e] = rt_s; } }
#pragma unroll
          for (int e = 0; e < 8; ++e) *(LAS bf16_t*)(lds + GL_KT + (8 * apart + e) * 144 + arow * 2) = f2bf(kk[e] * et[e]);
          if (PASSC) { const float qq[8] = {bflo(rq.x), bfhi(rq.x), bflo(rq.y), bfhi(rq.y), bflo(rq.z), bfhi(rq.z), bflo(rq.w), bfhi(rq.w)};
              u32x4 qw, kw;
              qw.x = cvt_pk_bf16(qq[0] * eq[0], qq[1] * eq[1]); qw.y = cvt_pk_bf16(qq[2] * eq[2], qq[3] * eq[3]); qw.z = cvt_pk_bf16(qq[4] * eq[4], qq[5] * eq[5]); qw.w = cvt_pk_bf16(qq[6] * eq[6], qq[7] * eq[7]);
              kw.x = cvt_pk_bf16(kk[0] * ek[0], kk[1] * ek[1]); kw.y = cvt_pk_bf16(kk[2] * ek[2], kk[3] * ek[3]); kw.z = cvt_pk_bf16(kk[4] * ek[4], kk[5] * ek[5]); kw.w = cvt_pk_bf16(kk[6] * ek[6], kk[7] * ek[7]);
              *(LAS u32x4*)(lds + GL_QD + arow * 144 + 16 * apart) = qw; *(LAS u32x4*)(lds + GL_KD + arow * 144 + 16 * apart) = kw; }
          if (arow == 63) {
#pragma unroll
              for (int e = 0; e < 8; ++e) *(LAS float*)(lds + GL_LAST + (8 * apart + e) * 4) = lastv[e]; }
#pragma unroll
          for (int e = 0; e < 8; ++e) dsum[e] += lastv[e]; }
        u32x2 gates[4];
        if (PASSC) {
#pragma unroll
            for (int ct = 0; ct < 4; ++ct) gates[ct] = gnx[ct]; }
        if (n < 7) GL_ISSUE(n + 1);
        WGSYNC();
        f32x4 acco[4];
        if (PASSC) {
            bf16x8 qf[2];
#pragma unroll
            for (int ks = 0; ks < 2; ++ks) qf[ks] = *(LAS const bf16x8*)(lds + GL_QD + (16 * it + fr) * 144 + 16 * fq + 64 * ks);
            f32x4 sc[4];
#pragma unroll
            for (int jt = 0; jt < 4; ++jt) { sc[jt] = (f32x4){0.f, 0.f, 0.f, 0.f};
                if (jt <= it) {
#pragma unroll
                    for (int ks = 0; ks < 2; ++ks) { const bf16x8 kf = *(LAS const bf16x8*)(lds + GL_KD + (16 * jt + fr) * 144 + 16 * fq + 64 * ks);
                        sc[jt] = __builtin_amdgcn_mfma_f32_16x16x32_bf16(kf, qf[ks], sc[jt], 0, 0, 0); }
                    if (jt == it) {
#pragma unroll
                        for (int r = 0; r < 4; ++r) sc[jt][r] = (4 * fq + r <= fr) ? sc[jt][r] : 0.f; } } }
            const bf16x8 pf0 = pack8(sc[0], sc[1]), pf1 = pack8(sc[2], sc[3]);
#pragma unroll
            for (int ct = 0; ct < 4; ++ct) { const int c0 = 64 * ch + 16 * ct; acco[ct] = (f32x4){0.f, 0.f, 0.f, 0.f};
                { const bf16x8 vf = lds_tr_frag2(lds + GL_V + c0 * 2, 272, l, 4, 16); acco[ct] = __builtin_amdgcn_mfma_f32_16x16x32_bf16(vf, pf0, acco[ct], 0, 0, 0); }
                if (it >= 2) { const bf16x8 vf = lds_tr_frag2(lds + GL_V + 32 * 272 + c0 * 2, 272, l, 4, 16); acco[ct] = __builtin_amdgcn_mfma_f32_16x16x32_bf16(vf, pf1, acco[ct], 0, 0, 0); }
#pragma unroll
                for (int ks = 0; ks < 2; ++ks) { const bf16x8 sf = *(LAS const bf16x8*)(lds + GL_ST + (c0 + fr) * 144 + 16 * fq + 64 * ks);
                    acco[ct] = __builtin_amdgcn_mfma_f32_16x16x32_bf16(sf, qf[ks], acco[ct], 0, 0, 0); } }
        }
#pragma unroll
        for (int dt = 0; dt < 4; ++dt) { const f32x4 lv = *(LAS const f32x4*)(lds + GL_LAST + (16 * dt + 4 * fq) * 4);
#pragma unroll
            for (int r = 0; r < 4; ++r) accs[dt][r] *= __expf(lv[r]); }
#pragma unroll
        for (int ks = 0; ks < 2; ++ks) { const bf16x8 vf = lds_tr_frag2(lds + GL_V + (32 * ks) * 272 + (16 * w) * 2, 272, l, 8, 4);
#pragma unroll
            for (int dt = 0; dt < 4; ++dt) { const bf16x8 kf = *(LAS const bf16x8*)(lds + GL_KT + (16 * dt + fr) * 144 + 16 * fq + 64 * ks);
                accs[dt] = __builtin_amdgcn_mfma_f32_16x16x32_bf16(kf, vf, accs[dt], 0, 0, 0); } }
        if (PASSC) {
            float ss = 0.f, sm_ = 0.f;
#pragma unroll
            for (int ct = 0; ct < 4; ++ct)
#pragma unroll
                for (int r = 0; r < 4; ++r) { ss += acco[ct][r] * acco[ct][r]; sm_ += acco[ct][r]; }
            ss += __shfl_xor(ss, 16); ss += __shfl_xor(ss, 32); sm_ += __shfl_xor(sm_, 16); sm_ += __shfl_xor(sm_, 32);
            if (fq == 0) { *(LAS float*)(lds + GL_RED + ((16 * it + fr) * 2 + ch) * 4) = ss; *(LAS float*)(lds + GL_RED2 + ((16 * it + fr) * 2 + ch) * 4) = sm_; }
        }
        WGSYNC();
        if (PASSC) {
            const int i = 16 * it + fr;
            const float ssum = *(LAS const float*)(lds + GL_RED + (i * 2) * 4) + *(LAS const float*)(lds + GL_RED + (i * 2 + 1) * 4);
            const float msum = *(LAS const float*)(lds + GL_RED2 + (i * 2) * 4) + *(LAS const float*)(lds + GL_RED2 + (i * 2 + 1) * 4);
            float mean, rstd;
            if (gla) { mean = 0.f; rstd = rsqrtf(ssum * (1.f / 128.f) + NORM_EPS); }
            else { mean = msum * (1.f / 128.f); const float var = fmaxf(ssum * (1.f / 128.f) - mean * mean, 0.f); rstd = rsqrtf(var + NORM_EPS); }
#pragma unroll
            for (int ct = 0; ct < 4; ++ct) { const int c = 128 * h + 64 * ch + 16 * ct + 4 * fq; const f32x4 gn = gnv[ct], bs = bsv[ct];
                const float g0 = bflo(gates[ct].x), g1 = bfhi(gates[ct].x), g2 = bflo(gates[ct].y), g3 = bfhi(gates[ct].y);
                u32x2 ow; ow.x = cvt_pk_bf16(((acco[ct][0] - mean) * rstd * gn[0] + bs[0]) * g0, ((acco[ct][1] - mean) * rstd * gn[1] + bs[1]) * g1);
                ow.y = cvt_pk_bf16(((acco[ct][2] - mean) * rstd * gn[2] + bs[2]) * g2, ((acco[ct][3] - mean) * rstd * gn[3] + bs[3]) * g3);
                *(u32x2*)(gp.O + (row0 + i) * OLD + ooff + c) = ow; }
#pragma unroll
            for (int dt = 0; dt < 4; ++dt) { u32x2 wv; wv.x = cvt_pk_bf16(accs[dt][0], accs[dt][1]); wv.y = cvt_pk_bf16(accs[dt][2], accs[dt][3]);
                *(LAS u32x2*)(lds + GL_ST + (16 * w + fr) * 144 + 32 * dt + 8 * fq) = wv; }
        }
    }
#undef GL_ISSUE
    if (!PASSC) {
        float* sg = gp.SSEG + (size_t)(sidx + seg) * 8192 + tid * 16;
#pragma unroll
        for (int dt = 0; dt < 4; ++dt) *(f32x4*)(sg + 4 * dt) = accs[dt];
        if (tid < 8) {
#pragma unroll
            for (int e = 0; e < 8; ++e) gp.DSUM[(size_t)(sidx + seg) * 64 + 8 * apart + e] = dsum[e]; }
    }
    WGSYNC();
}

constexpr int LR_XC = 0, LR_XCF = 2304, LR_AA = 6400, LR_GG = 10496, LR_WAVE = 14592;
struct LruP { const bf16_t* P; const float* cw; const float* cb; const float* ba; const float* bx; const float* sp8; const bf16_t* lw; bf16_t* O; float* LST; };
template <bool PASSC>
__device__ __forceinline__ void lru_wave(LAS unsigned char* lw_, const LruP& lp, const int b, const int seg, const int n, const int l) {
    const int fr = l & 15, fq = l >> 4, ch = 64 * n + l;
    bf16x8 wB[8][2];
#pragma unroll
    for (int jt = 0; jt < 8; ++jt)
#pragma unroll
        for (int ks = 0; ks < 2; ++ks) wB[jt][ks] = *(const bf16x8*)(lp.lw + ((size_t)(n * 128 + 16 * jt + fr)) * 64 + 8 * fq + 32 * ks);
    const float w0 = lp.cw[ch], w1 = lp.cw[512 + ch], w2 = lp.cw[1024 + ch], w3 = lp.cw[1536 + ch], cbv = lp.cb[ch];
    float bav[4], bxv[4], spv[4];
#pragma unroll
    for (int jt = 0; jt < 4; ++jt) { const int c2 = 64 * n + 16 * jt + fr; bav[jt] = lp.ba[c2]; bxv[jt] = lp.bx[c2]; spv[jt] = lp.sp8[c2]; }
    const size_t rowb = (size_t)b * SEQ + seg * 128;
    float xm3 = 0.f, xm2 = 0.f, xm1 = 0.f;
    if (seg > 0) { xm3 = bf2f(lp.P[(rowb - 3) * PLD + P_LX + ch]); xm2 = bf2f(lp.P[(rowb - 2) * PLD + P_LX + ch]); xm1 = bf2f(lp.P[(rowb - 1) * PLD + P_LX + ch]); }
    float hst = 0.f, ap = 1.f;
    if (PASSC) { const float* st = lp.LST + ((size_t)b * NSEGL * 512 + ch) * 2;
        pg8::f32x2_ ah[31];
#pragma unroll
        for (int e = 0; e < 31; ++e) { const int sp = e < seg ? e : 0; ah[e] = *(const pg8::f32x2_*)(st + (size_t)sp * 1024); }
#pragma unroll
        for (int e = 0; e < 31; ++e) if (e < seg) hst = ah[e][0] * hst + ah[e][1]; }
    bf16_t xn[16], gn[16];
#pragma unroll
    for (int t = 0; t < 16; ++t) { xn[t] = lp.P[(rowb + t) * PLD + P_LX + ch]; gn[t] = PASSC ? lp.P[(rowb + t) * PLD + P_LG + ch] : (bf16_t)0; }
    for (int sb = 0; sb < 8; ++sb) {
        const size_t r0 = rowb + sb * 16;
        float xf[16], gr[16];
#pragma unroll
        for (int t = 0; t < 16; ++t) { xf[t] = bf2f(xn[t]); gr[t] = bf2f(gn[t]); }
        if (sb < 7) {
#pragma unroll
            for (int t = 0; t < 16; ++t) { xn[t] = lp.P[(r0 + 16 + t) * PLD + P_LX + ch]; if (PASSC) gn[t] = lp.P[(r0 + 16 + t) * PLD + P_LG + ch]; } }
#pragma unroll
        for (int t = 0; t < 16; ++t) { const float x0 = xf[t]; const float xc = cbv + w0 * xm3 + w1 * xm2 + w2 * xm1 + w3 * x0; xm3 = xm2; xm2 = xm1; xm1 = x0;
            *(LAS bf16_t*)(lw_ + LR_XC + t * 144 + l * 2) = f2bf(xc); *(LAS float*)(lw_ + LR_XCF + t * 256 + l * 4) = xc; }
        __builtin_amdgcn_wave_barrier();
        f32x4 acc[8];
#pragma unroll
        for (int jt = 0; jt < 8; ++jt) acc[jt] = (f32x4){0.f, 0.f, 0.f, 0.f};
#pragma unroll
        for (int ks = 0; ks < 2; ++ks) { const bf16x8 af = *(LAS const bf16x8*)(lw_ + LR_XC + fr * 144 + 16 * fq + 64 * ks);
#pragma unroll
            for (int jt = 0; jt < 8; ++jt) acc[jt] = __builtin_amdgcn_mfma_f32_16x16x32_bf16(af, wB[jt][ks], acc[jt], 0, 0, 0); }
#pragma unroll
        for (int jt = 0; jt < 4; ++jt)
#pragma unroll
            for (int r = 0; r < 4; ++r) { const int tok = 4 * fq + r, j = 16 * jt + fr;
                const float rg = sigmoid_f(acc[jt][r] + bav[jt]), ig = sigmoid_f(acc[4 + jt][r] + bxv[jt]);
                const float log_a = -rg * spv[jt]; const float av = __expf(log_a);
                const float xcv = *(LAS const float*)(lw_ + LR_XCF + tok * 256 + j * 4);
                *(LAS float*)(lw_ + LR_AA + tok * 256 + j * 4) = av; const float em = fmaf(-av, av, 1.f);
                *(LAS float*)(lw_ + LR_GG + tok * 256 + j * 4) = xcv * ig * sqrtf(fmaxf(em, 0.f)); }
        __builtin_amdgcn_wave_barrier();
#pragma unroll
        for (int t = 0; t < 16; ++t) { const float av = *(LAS const float*)(lw_ + LR_AA + t * 256 + l * 4), gv = *(LAS const float*)(lw_ + LR_GG + t * 256 + l * 4);
            hst = av * hst + gv; ap *= av;
            if (PASSC) lp.O[(r0 + t) * OLD + 1024 + ch] = f2bf(hst * gr[t]); }
        __builtin_amdgcn_wave_barrier();
    }
    if (!PASSC) { float* st = lp.LST + (((size_t)b * NSEGL + seg) * 512 + ch) * 2; st[0] = ap; st[1] = hst; }
}

constexpr int S5_BU = 0, S5_X = 8448, S5_WAVE = 8448 + 4352;
struct S5P { const bf16_t* P; const float* sm; const bf16_t* ct; const bf16_t* bbt; const float* a128; const float* dd; bf16_t* Y5; float* SST; };
template <bool PASSC>
__device__ __forceinline__ void s5_wave(LAS unsigned char* lw_, const S5P& sp_, const int b, const int seg, const int g, const int l) {
    const int fr = l & 15, fq = l >> 4;
    const bf16x8 zf = (bf16x8){0, 0, 0, 0, 0, 0, 0, 0};
    bf16x8 bbf[8];
#pragma unroll
    for (int mt = 0; mt < 8; ++mt) bbf[mt] = fq < 2 ? *(const bf16x8*)(sp_.bbt + ((size_t)(g * 128 + 16 * mt + fr)) * 16 + 8 * fq) : zf;
    const float abr = sp_.sm[SM_ABR + g * 64 + l], abi = sp_.sm[SM_ABI + g * 64 + l];
    float xr = 0.f, xi = 0.f;
    bf16x8 cf[4]; f32x4 dv4 = (f32x4){0.f, 0.f, 0.f, 0.f};
    if (PASSC) {
        const float ar = sp_.a128[(g * 64 + l) * 2], ai = sp_.a128[(g * 64 + l) * 2 + 1];
        const float* st = sp_.SST + ((size_t)b * NSEGS * 32 + g) * 128 + l;
        for (int sp0 = 0; sp0 < seg; sp0 += 8) { float er[8], ei[8];
#pragma unroll
            for (int e = 0; e < 8; ++e) { const int sp = sp0 + e < seg ? sp0 + e : seg - 1; er[e] = st[(size_t)sp * 4096]; ei[e] = st[(size_t)sp * 4096 + 64]; }
#pragma unroll
            for (int e = 0; e < 8; ++e) if (sp0 + e < seg) { const float nr = ar * xr - ai * xi + er[e], ni = ar * xi + ai * xr + ei[e]; xr = nr; xi = ni; } }
#pragma unroll
        for (int ks = 0; ks < 4; ++ks) cf[ks] = *(const bf16x8*)(sp_.ct + ((size_t)(g * 16 + fr)) * 128 + 8 * fq + 32 * ks);
        dv4 = *(const f32x4*)(sp_.dd + 16 * g + 4 * fq);
    }
    const size_t rowb = (size_t)b * SEQ + seg * 512;
    bf16x8 ufn = fq < 2 ? *(const bf16x8*)(sp_.P + (rowb + fr) * PLD + P_SU + 16 * g + 8 * fq) : zf;
    u32x2 usn = PASSC ? *(const u32x2*)(sp_.P + (rowb + fr) * PLD + P_SU + 16 * g + 4 * fq) : (u32x2){0u, 0u};
    for (int sb = 0; sb < 32; ++sb) {
        const size_t r0 = rowb + sb * 16;
        const bf16x8 uf = ufn; const u32x2 us = usn;
        if (sb < 31) { ufn = fq < 2 ? *(const bf16x8*)(sp_.P + (r0 + 16 + fr) * PLD + P_SU + 16 * g + 8 * fq) : zf;
            if (PASSC) usn = *(const u32x2*)(sp_.P + (r0 + 16 + fr) * PLD + P_SU + 16 * g + 4 * fq); }
#pragma unroll
        for (int mt = 0; mt < 8; ++mt) { f32x4 bu = (f32x4){0.f, 0.f, 0.f, 0.f}; bu = __builtin_amdgcn_mfma_f32_16x16x32_bf16(bbf[mt], uf, bu, 0, 0, 0);
            *(LAS f32x4*)(lw_ + S5_BU + fr * 528 + (16 * mt + 4 * fq) * 4) = bu; }
        __builtin_amdgcn_wave_barrier();
        pg8::f32x2_ buv[16];
#pragma unroll
        for (int t = 0; t < 16; ++t) buv[t] = *(LAS const pg8::f32x2_*)(lw_ + S5_BU + t * 528 + l * 8);
#pragma unroll
        for (int t = 0; t < 16; ++t) {
            const pg8::f32x2_ bu = buv[t];
            const float nr = abr * xr - abi * xi + bu[0], ni = abr * xi + abi * xr + bu[1]; xr = nr; xi = ni;
            if (PASSC) *(LAS unsigned*)(lw_ + S5_X + t * 272 + l * 4) = cvt_pk_bf16(xr, xi);
        }
        __builtin_amdgcn_wave_barrier();
        if (PASSC) {
            f32x4 acc = (f32x4){0.f, 0.f, 0.f, 0.f};
#pragma unroll
            for (int ks = 0; ks < 4; ++ks) { const bf16x8 xf = *(LAS const bf16x8*)(lw_ + S5_X + fr * 272 + 16 * fq + 64 * ks);
                acc = __builtin_amdgcn_mfma_f32_16x16x32_bf16(cf[ks], xf, acc, 0, 0, 0); }
            u32x2 yw; yw.x = cvt_pk_bf16(gelu_tanh_f(acc[0] + dv4[0] * bflo(us.x)), gelu_tanh_f(acc[1] + dv4[1] * bfhi(us.x))); yw.y = cvt_pk_bf16(gelu_tanh_f(acc[2] + dv4[2] * bflo(us.y)), gelu_tanh_f(acc[3] + dv4[3] * bfhi(us.y)));
            *(u32x2*)(sp_.Y5 + (r0 + fr) * BW + 16 * g + 4 * fq) = yw;
            __builtin_amdgcn_wave_barrier();
        }
    }
    if (!PASSC) { float* st = sp_.SST + (((size_t)b * NSEGS + seg) * 32 + g) * 128 + l; st[0] = xr; st[64] = xi; }
}

template <bool PASSC>
__device__ __forceinline__ void phase_mixers(LAS unsigned char* lds, const Args& a, const int l, const int G) {
    const int mmask = a.mmask;
    unsigned char* ws = a.ws; const float* sm = (const float*)(ws + WS_SMALL + (size_t)l * SMALL_STRIDE);
    const bf16_t* P = (const bf16_t*)(ws + WS_P); float* ST = (float*)(ws + WS_ST);
    if (mmask & 1) { GlaP gp0{P, (const float*)(ws + WS_LA), a.in[I_GNG] + l * 512, nullptr, (bf16_t*)(ws + WS_O), ST + ST_GSEG, ST + ST_GDS};
      GlaP gp1{P, (const float*)(ws + WS_LA), a.in[I_RNG] + l * 512, a.in[I_RNB] + l * 512, (bf16_t*)(ws + WS_O), ST + ST_GSEG, ST + ST_GDS};
      for (int itx = blockIdx.x; itx < 2 * BG * 4 * NSEGG; itx += G) { const int mix = itx / (BG * 4 * NSEGG), rest = itx % (BG * 4 * NSEGG), b = rest / (4 * NSEGG), h = (rest / NSEGG) & 3, seg = rest % NSEGG;
          const int sidx = ((mix * BG + b) * 4 + h) * NSEGG;
          if (!PASSC && seg == NSEGG - 1) continue;
          if (mix == 0) glaret_item<PASSC>(lds, gp0, true, b, h, seg, sidx); else glaret_item<PASSC>(lds, gp1, false, b, h, seg, sidx); } }
    int tid = threadIdx.x; asm volatile("" : "+v"(tid));
    const int w = __builtin_amdgcn_readfirstlane(tid >> 6), ln = tid & 63;
    if (mmask & 2) { LruP lp{P, a.in[I_LCW] + l * 2048, a.in[I_LCB] + l * 512, a.in[I_LBA] + l * 512, a.in[I_LBX] + l * 512, sm + SM_SP8, (const bf16_t*)((const unsigned char*)sm + SM_LRUW_BYTES), (bf16_t*)(ws + WS_O), ST + ST_LRU};
      for (int itx = blockIdx.x; itx < BG * NSEGL; itx += G) { if (!PASSC && itx % NSEGL == NSEGL - 1) continue; lru_wave<PASSC>(lds + w * LR_WAVE, lp, itx / NSEGL, itx % NSEGL, w, ln); } }
    if (mmask & 4) { S5P sp_{P, sm, (const bf16_t*)((const unsigned char*)sm + SM_CT_BYTES), (const bf16_t*)((const unsigned char*)sm + SM_BBT_BYTES), sm + SM_A128, a.in[I_SD] + l * 512, (bf16_t*)(ws + WS_Y5), ST + ST_S5};
      for (int itx = blockIdx.x; itx < BG * NSEGS * 4; itx += G) { if (!PASSC && (itx >> 2) % NSEGS == NSEGS - 1) continue; s5_wave<PASSC>(lds + w * LR_WAVE, sp_, itx / (NSEGS * 4), (itx >> 2) % NSEGS, 8 * (itx & 3) + w, ln); } }
    WGSYNC();
}

constexpr int NPH = 8, NSTEPS = 1 + NGRP * DEPTH * NPH;
constexpr int LDS_BYTES = 147456, LDS_MISC = 131072 + 320;

__global__ void __launch_bounds__(512, 2) mk_fwd(Args a) {
    __shared__ __attribute__((aligned(16))) unsigned char lds_raw[LDS_BYTES];
    LAS unsigned char* lds = (LAS unsigned char*)lds_raw;
    volatile LAS unsigned* MISC = (volatile LAS unsigned*)(lds + LDS_MISC);
    const int G = gridDim.x;
    if (threadIdx.x < 32) MISC[threadIdx.x] = 0u;
    __syncthreads();
    unsigned* ctl = (unsigned*)(a.ws + WS_CTL);
    XcdBarrier bar = xcd_barrier_post(ctl + CW_BAR + a.li * XCD_BAR_WORDS, MISC + 8);
    const int ngw = G * 8, gthreads = G * 512;
#define LTID(v) int v = threadIdx.x; asm volatile("" : "+v"(v))
#define IN(s) (a.s_lo <= (s) && (s) < a.s_hi)
#define SEAM(s) do { if ((s) + 1 < a.s_hi) xcd_barrier(bar); } while (0)
    if (IN(0)) { LTID(t_); phase_prologue(a, blockIdx.x * 512 + t_, gthreads); SEAM(0); }
    for (int gl = 0; gl < NGRP * DEPTH; ++gl) {
        const int grp = gl >> 2, l = gl & 3, s0 = 1 + gl * NPH;
        if (a.s_hi <= s0 || a.s_lo >= s0 + NPH) continue;
        unsigned char* ws = a.ws;
        const bf16_t* Wl = (const bf16_t*)(ws + WS_W + (size_t)l * W_STRIDE);
        const float* sm = (const float*)(ws + WS_SMALL + (size_t)l * SMALL_STRIDE);
        bf16_t* U = (bf16_t*)(ws + WS_U); bf16_t* P = (bf16_t*)(ws + WS_P); float* LA = (float*)(ws + WS_LA);
        bf16_t* O = (bf16_t*)(ws + WS_O); bf16_t* Y5 = (bf16_t*)(ws + WS_Y5); unsigned char* PGb = ws + WS_PG;
        const float* xg = a.in[I_X] + (size_t)grp * TG * D; float* og = a.out + (size_t)grp * TG * D;
        const float* hin = (l <= 1) ? xg : og;
        bf16_t* DLT = (bf16_t*)(ws + WS_O);
        (void)sm;
        if (IN(s0 + 0)) { LTID(t_); const int gw_ = blockIdx.x * 8 + __builtin_amdgcn_readfirstlane(t_ >> 6);
            if (l == 0) phase_norm<false, false>(hin, DLT, og, a.in[I_NG] + l * D, U, gw_, ngw, t_ & 63); else phase_norm<false, true>(hin, DLT, og, a.in[I_NG] + l * D, U, gw_, ngw, t_ & 63);
            SEAM(s0 + 0); }
        if (IN(s0 + 1)) {
            pg8::Gemm g{U, Wl, TG, N_ALL, D, D, D, 0, 0}; pg8::StaticOrder S; S.init(TG, N_ALL, G, (int)blockIdx.x, 0, 256, WGM_G1);
            EpiIn E{P, LA, a.in[I_GBLR] + l * 256, (const float*)(ws + WS_ROT), PGb};
            GEMM_CALL(EpiIn);
            SEAM(s0 + 1);
        }
        if (IN(s0 + 2)) { phase_mixers<false>(lds, a, l, G); SEAM(s0 + 2); }
        if (IN(s0 + 3)) { phase_mixers<true>(lds, a, l, G); SEAM(s0 + 3); }
        if (IN(s0 + 4)) {
            { pg8::Gemm g{Y5, (const bf16_t*)((const unsigned char*)Wl + WO_GLU), TG, BW, BW, BW, BW, 0, 0}; pg8::StaticOrder S; S.init(TG, BW, G, (int)blockIdx.x, 0, 256, WGM_GLU);
              EpiGlu E{Y5, P, a.in[I_SGB] + l * BW, O};
              GEMM_CALL(EpiGlu); }
            SEAM(s0 + 4);
        }
        if (IN(s0 + 6)) {
            { pg8::Gemm g{O, (const bf16_t*)((const unsigned char*)Wl + WO_BR), TG, D, BW, OLD, BW, (size_t)BW * 2, (size_t)D * BW * 2}; pg8::StaticOrder S; S.init(TG, D, G, (int)blockIdx.x, 2, 128, WGM_G2);
              EpiBr E{PGb, U};
              pg8::gemm_phase<EpiBr, pg8::StaticOrder, true, true, true>(lds, g, S, E); }
            SEAM(s0 + 6);
        }
        if (IN(s0 + 7)) {
            if (a.fin != 2) { pg8::Gemm g{U, (const bf16_t*)((const unsigned char*)Wl + WO_OUT), TG, D, D, D, D, 0, 0}; pg8::StaticOrder S; S.init(TG, D, G, (int)blockIdx.x, 0, 256, WGM_G3);
              EpiOut E{DLT};
              GEMM_CALL(EpiOut); }
            if (l == 3 && a.fin) { if (a.fin == 1) xcd_barrier(bar); LTID(t_); phase_norm<true, true>(og, DLT, og, a.in[I_FNG], U, blockIdx.x * 8 + __builtin_amdgcn_readfirstlane(t_ >> 6), ngw, t_ & 63); }
            SEAM(s0 + 7);
        }
    }
#undef IN
#undef SEAM
}

extern "C" void kernel_launch(void* const* d_in, const int* in_sizes, int n_in, void* d_out, int out_size, void* d_ws, size_t ws_size, hipStream_t stream) {
    static int grid = 0;
    if (grid == 0) {
        static const int exp_sizes[29] = {67108864, 4096, 21037056, 16384, 1024, 2048, 2048, 2048, 8192, 2048, 131072, 2048, 131072, 2048, 2048, 8192, 8192, 131072, 131072, 131072, 131072, 2048, 128, 1048576, 2048, 16777216, 8388608, 4194304, 1024};
        bool ok_sizes = (n_in == 29); if (ok_sizes) for (int i = 0; i < 29; ++i) if (in_sizes[i] != exp_sizes[i]) { fprintf(stderr, "kernel_launch: input %d has %d elements, expected %d\n", i, in_sizes[i], exp_sizes[i]); ok_sizes = false; }
        if (!ok_sizes || out_size != NB * SEQ * D || ws_size < WS_END) { fprintf(stderr, "kernel_launch: unexpected shapes (n_in %d out %d ws %zu)\n", n_in, out_size, ws_size); grid = -1; return; }
        int dev = 0, cus = 0, per_cu = 0;
        hipGetDevice(&dev); hipDeviceGetAttribute(&cus, hipDeviceAttributeMultiprocessorCount, dev);
        hipOccupancyMaxActiveBlocksPerMultiprocessor(&per_cu, (const void*)mk_fwd, 512, 0);
        (void)hipGetLastError();
        grid = cus > 0 ? cus : 256;
        if (per_cu < 1) fprintf(stderr, "kernel_launch: occupancy query says %d\n", per_cu);
    }
    if (grid < 0) return;
    hipMemsetAsync((char*)d_ws + WS_CTL, 0, CTL_BYTES, stream);
    Args a{};
    for (int i = 0; i < 29; ++i) a.in[i] = (const float*)d_in[i];
    a.out = (float*)d_out; a.ws = (unsigned char*)d_ws;
    unsigned char* ws = (unsigned char*)d_ws;
    int li = 0;
    auto run = [&](int lo, int hi, int fin = 1, int mm = 7) { a.s_lo = lo; a.s_hi = hi; a.li = li++; a.fin = fin; a.mmask = mm; a.pad2 = 0; hipLaunchKernelGGL(mk_fwd, dim3(grid), dim3(512), 0, stream, a); };
    run(0, NSTEPS);
}
```

```cpp
#include <hip/hip_runtime.h>
#ifndef WGM_G1
#define WGM_G1 4
#endif
#ifndef WGM_G2
#define WGM_G2 8
#endif
#ifndef WGM_G3
#define WGM_G3 8
#endif
#ifndef WGM_GLU
#define WGM_GLU 8
#endif
#include <cstdio>
#include <cstdint>


namespace pg8 {
#define PG8_LAS __attribute__((address_space(3)))
typedef unsigned short bf16_t;
typedef short bf16x8 __attribute__((ext_vector_type(8)));
typedef float f32x4 __attribute__((ext_vector_type(4)));
typedef unsigned u32x4 __attribute__((ext_vector_type(4)));
typedef unsigned u32x2 __attribute__((ext_vector_type(2)));
constexpr int BM = 256, BK = 64, HALF = 128, HTB = HALF * BK * 2, STAGE_BYTES = 8 * HTB, NXCD = 8;

__host__ __device__ __forceinline__ int lds_byte(int r, int c) { const int st = (r >> 4) * 2 + (c >> 5), rr = r & 15, cc = c & 31, ob = rr * 64 + cc * 2; return st * 1024 + (ob ^ (((ob >> 9) & 1) << 5)); }
__host__ __device__ __forceinline__ void stage_rc(int b, int& R, int& C) { const int st = b / 1024, sb = b % 1024, swz = sb ^ (((sb >> 9) & 1) << 5); R = (st >> 1) * 16 + swz / 64; C = (st & 1) * 32 + (swz % 64) / 2; }
__host__ __device__ __forceinline__ int perm32(int rho) { const int n = rho >> 4, i = rho & 15; return 8 * (i >> 2) + 4 * n + (i & 3); }

struct Unit { int pm, pn, z; };
struct Gemm { const bf16_t* A; const bf16_t* Bt; int M, N, K, lda, ldb; size_t zA, zB; };

struct StaticOrder {
    int nM, nN, nwg, G, c, zsh, WGM;
    __host__ __device__ void init(int M, int N, int G_, int c_, int zsh_ = 0, int bn_ = BM, int wgm_ = 4) { nM = M / BM; nN = N / bn_; nwg = nM * nN; G = G_; c = c_; zsh = zsh_; WGM = wgm_; }
    __host__ __device__ bool next(int i, Unit& u) const {
        const int ti = i >> zsh; u.z = i & ((1 << zsh) - 1);
        const long L = (long)ti * G + c; if (L >= nwg) return false;
        int wgid = (int)L; { const int q = nwg / NXCD, r = nwg % NXCD, xcd = wgid % NXCD, off = wgid / NXCD; wgid = (xcd < r ? xcd * (q + 1) : r * (q + 1) + (xcd - r) * q) + off; }
        const int nig = WGM * nN, gid = wgid / nig, fm = gid * WGM, gsz = (nM - fm) < WGM ? (nM - fm) : WGM;
        u.pm = fm + ((wgid % nig) % gsz); u.pn = (wgid % nig) / gsz; return true;
    }
    __device__ __forceinline__ void a_ready(const Unit&) const {}
    __device__ __forceinline__ void done(const Unit&) const {}
};

typedef float f32x2_ __attribute__((ext_vector_type(2)));
typedef __bf16 bf16x2_ __attribute__((ext_vector_type(2)));
__device__ __forceinline__ unsigned cvt_pk_bf16(float lo, float hi) { const f32x2_ v = {lo, hi}; const bf16x2_ b = __builtin_convertvector(v, bf16x2_); return __builtin_bit_cast(unsigned, b); }

template <class Epi, class Sched, bool ALIGN_EPI = false, bool SP2 = false, bool HALFN = false>
__device__ __forceinline__ void gemm_phase(PG8_LAS unsigned char* lds, const Gemm g, const Sched& S, const Epi& E) {
    int tid = threadIdx.x; asm volatile("" : "+v"(tid));
    const int wid = __builtin_amdgcn_readfirstlane(tid >> 6), lane = tid & 63, wr = wid >> 2, wc = wid & 3, fr = lane & 15, fq = lane >> 4;
    const int K = g.K, nt = K / BK;
    unsigned voffA[2], voffB[2];
#pragma unroll
    for (int i = 0; i < 2; ++i) { int R, C; stage_rc(tid * 16 + i * 8192, R, C); const int Rb = Epi::PERM ? ((R & ~31) + perm32(R & 31)) : R;
        voffA[i] = (unsigned)(R * g.lda + C) * 2u; voffB[i] = (unsigned)(Rb * g.ldb + C) * 2u; }
    const size_t kstep = (size_t)(BK * 2);
    const size_t hstepA = (size_t)HALF * g.lda * 2, hstepB = (size_t)HALF * g.ldb * 2;
    const size_t tstepA = 2 * hstepA, tstepB = HALFN ? hstepB : 2 * hstepB;
    const unsigned ldsw = (unsigned)wid * 1024u;
    unsigned aoff = (unsigned)lds_byte(wr * 64 + fr, fq * 8), boff = (unsigned)lds_byte(wc * 32 + fr, fq * 8) + 4u * HTB;
    asm volatile("" : "+v"(aoff), "+v"(boff));
#define PG8_SA(b, h) (((b) * 2 + (h)) * HTB)
#define PG8_SB(b, h) ((4 + (b) * 2 + (h)) * HTB)
#define PG8_STAGE(bufoff, gbase, voff) do { _Pragma("unroll") for (int _i = 0; _i < 2; ++_i) \
        __builtin_amdgcn_global_load_lds((const unsigned*)((const char*)(gbase) + (voff)[_i]), (PG8_LAS unsigned*)(lds + (bufoff) + ldsw + _i * 8192), 16, 0, 0); } while (0)
#define PG8_LDA(dst, b, h) do { _Pragma("unroll") for (int m = 0; m < 4; ++m) _Pragma("unroll") for (int k = 0; k < 2; ++k) dst[m][k] = *(const PG8_LAS bf16x8*)(lds + aoff + (PG8_SA(b, h) + m * 2048 + k * 1024)); } while (0)
#define PG8_LDB(dst, b, h) do { _Pragma("unroll") for (int n = 0; n < 2; ++n) _Pragma("unroll") for (int k = 0; k < 2; ++k) dst[n][k] = *(const PG8_LAS bf16x8*)(lds + boff + (((b) * 2 + (h)) * HTB + n * 2048 + k * 1024)); } while (0)
#define PG8_MMA(ai, bj, At, Bt) do { __builtin_amdgcn_s_setprio(1); _Pragma("unroll") for (int m = 0; m < 4; ++m) _Pragma("unroll") for (int n = 0; n < 2; ++n) _Pragma("unroll") for (int k = 0; k < 2; ++k) \
        acc[ai][bj][m][n] = __builtin_amdgcn_mfma_f32_16x16x32_bf16(Bt[n][k], At[m][k], acc[ai][bj][m][n], 0, 0, 0); __builtin_amdgcn_s_setprio(0); } while (0)
#define PG8_WAIT_V(n) asm volatile("s_waitcnt vmcnt(" #n ")" ::: "memory")
#define PG8_WAIT_L(n) asm volatile("s_waitcnt lgkmcnt(" #n ")" ::: "memory")
#define PG8_BAR __builtin_amdgcn_s_barrier()
#define PG8_SCHED __builtin_amdgcn_sched_barrier(0)
    Unit cur, nxt; int ui = 0;
    if (!S.next(0, cur)) return;
    f32x4 acc[2][2][4][2];
#pragma unroll
    for (int a = 0; a < 2; ++a)
#pragma unroll
        for (int b = 0; b < 2; ++b)
#pragma unroll
            for (int m = 0; m < 4; ++m)
#pragma unroll
                for (int n = 0; n < 2; ++n) acc[a][b][m][n] = (f32x4){0.f, 0.f, 0.f, 0.f};
    bf16x8 At[4][2], B0[2][2], B1[2][2];
    const char* cA = (const char*)g.A + (size_t)cur.pm * tstepA + (size_t)cur.z * g.zA; const char* cB = (const char*)g.Bt + (size_t)cur.pn * tstepB + (size_t)cur.z * g.zB;
    S.a_ready(cur);
    if constexpr (SP2 && HALFN) {
        PG8_STAGE(PG8_SB(0, 0), cB, voffB); PG8_STAGE(PG8_SA(0, 0), cA, voffA); PG8_STAGE(PG8_SA(0, 1), cA + hstepA, voffA);
        if (wr == 1) PG8_BAR;
        PG8_WAIT_V(2); PG8_BAR;
        PG8_STAGE(PG8_SB(1, 0), cB + kstep, voffB); PG8_STAGE(PG8_SA(1, 0), cA + kstep, voffA);
        PG8_WAIT_V(4); PG8_BAR;
    } else if constexpr (SP2) {
        PG8_STAGE(PG8_SB(0, 0), cB, voffB); PG8_STAGE(PG8_SB(0, 1), cB + hstepB, voffB); PG8_STAGE(PG8_SA(0, 0), cA, voffA); PG8_STAGE(PG8_SA(0, 1), cA + hstepA, voffA);
        if (wr == 1) PG8_BAR;
        PG8_WAIT_V(2); PG8_BAR;
        PG8_STAGE(PG8_SB(1, 0), cB + kstep, voffB); PG8_STAGE(PG8_SA(1, 0), cA + kstep, voffA); PG8_STAGE(PG8_SB(1, 1), cB + hstepB + kstep, voffB);
        PG8_WAIT_V(6); PG8_BAR;
    } else {
        PG8_STAGE(PG8_SB(0, 0), cB, voffB); PG8_STAGE(PG8_SA(0, 0), cA, voffA); PG8_STAGE(PG8_SB(0, 1), cB + hstepB, voffB); PG8_STAGE(PG8_SA(0, 1), cA + hstepA, voffA);
        if (wr == 1) PG8_BAR;
        PG8_WAIT_V(4); PG8_BAR;
        PG8_STAGE(PG8_SB(1, 0), cB + kstep, voffB); PG8_STAGE(PG8_SA(1, 0), cA + kstep, voffA); PG8_STAGE(PG8_SB(1, 1), cB + hstepB + kstep, voffB);
        PG8_WAIT_V(6); PG8_BAR;
    }
    for (;;) {
        const bool has_next = S.next(ui + 1, nxt);
        const char* nA = has_next ? (const char*)g.A + (size_t)nxt.pm * tstepA + (size_t)nxt.z * g.zA : cA; const char* nB = has_next ? (const char*)g.Bt + (size_t)nxt.pn * tstepB + (size_t)nxt.z * g.zB : cB;
        for (int t = 0; t < nt; t += 2) {
            const bool last = (t == nt - 2);
            const char* a1 = cA + (size_t)(t + 1) * kstep;
            const char* a2 = last ? nA : cA + (size_t)(t + 2) * kstep; const char* b2 = last ? nB : cB + (size_t)(t + 2) * kstep;
            const char* a3 = a2 + kstep; const char* b3 = b2 + kstep;
            if (last && has_next) S.a_ready(nxt);
            if constexpr (SP2 && HALFN) {
            PG8_LDB(B0, 0, 0); PG8_SCHED; PG8_LDA(At, 0, 0); PG8_STAGE(PG8_SA(1, 1), a1 + hstepA, voffA);
            PG8_WAIT_V(6); PG8_WAIT_L(0); PG8_BAR; PG8_MMA(0, 0, At, B0); PG8_BAR; PG8_SCHED;
            PG8_LDA(At, 0, 1); PG8_STAGE(PG8_SB(0, 0), b2, voffB); PG8_STAGE(PG8_SA(0, 0), a2, voffA);
            PG8_WAIT_V(6); PG8_WAIT_L(0); PG8_BAR; PG8_MMA(1, 0, At, B0); PG8_BAR; PG8_SCHED;
            PG8_LDB(B0, 1, 0); PG8_SCHED; PG8_LDA(At, 1, 0); PG8_STAGE(PG8_SA(0, 1), a2 + hstepA, voffA);
            PG8_WAIT_V(6); PG8_WAIT_L(0); PG8_BAR; PG8_MMA(0, 0, At, B0); PG8_BAR; PG8_SCHED;
            PG8_LDA(At, 1, 1); PG8_STAGE(PG8_SB(1, 0), b3, voffB); PG8_STAGE(PG8_SA(1, 0), a3, voffA);
            PG8_WAIT_V(6); PG8_WAIT_L(0); PG8_BAR; PG8_MMA(1, 0, At, B0); PG8_BAR; PG8_SCHED;
            } else if constexpr (SP2) {
            PG8_LDB(B0, 0, 0); PG8_LDB(B1, 0, 1); PG8_SCHED; PG8_LDA(At, 0, 0); PG8_STAGE(PG8_SA(1, 1), a1 + hstepA, voffA);
            PG8_WAIT_V(8); PG8_WAIT_L(0); PG8_BAR; PG8_MMA(0, 0, At, B0); PG8_MMA(0, 1, At, B1); PG8_BAR; PG8_SCHED;
            PG8_LDA(At, 0, 1); PG8_STAGE(PG8_SB(0, 0), b2, voffB); PG8_STAGE(PG8_SB(0, 1), b2 + hstepB, voffB); PG8_STAGE(PG8_SA(0, 0), a2, voffA);
            PG8_WAIT_V(8); PG8_WAIT_L(0); PG8_BAR; PG8_MMA(1, 0, At, B0); PG8_MMA(1, 1, At, B1); PG8_BAR; PG8_SCHED;
            PG8_LDB(B0, 1, 0); PG8_LDB(B1, 1, 1); PG8_SCHED; PG8_LDA(At, 1, 0); PG8_STAGE(PG8_SA(0, 1), a2 + hstepA, voffA);
            PG8_WAIT_V(8); PG8_WAIT_L(0); PG8_BAR; PG8_MMA(0, 0, At, B0); PG8_MMA(0, 1, At, B1); PG8_BAR; PG8_SCHED;
            PG8_LDA(At, 1, 1); PG8_STAGE(PG8_SB(1, 0), b3, voffB); PG8_STAGE(PG8_SB(1, 1), b3 + hstepB, voffB); PG8_STAGE(PG8_SA(1, 0), a3, voffA);
            PG8_WAIT_V(8); PG8_WAIT_L(0); PG8_BAR; PG8_MMA(1, 0, At, B0); PG8_MMA(1, 1, At, B1); PG8_BAR; PG8_SCHED;
            } else {
            PG8_LDB(B0, 0, 0); PG8_SCHED; PG8_LDA(At, 0, 0); PG8_STAGE(PG8_SA(1, 1), a1 + hstepA, voffA);
            PG8_WAIT_L(8); PG8_BAR; PG8_WAIT_L(0); PG8_MMA(0, 0, At, B0); PG8_BAR; PG8_SCHED;
            PG8_LDB(B1, 0, 1); PG8_STAGE(PG8_SB(0, 0), b2, voffB);
            PG8_BAR; PG8_WAIT_L(0); PG8_MMA(0, 1, At, B1); PG8_BAR;
            PG8_LDA(At, 0, 1); PG8_STAGE(PG8_SA(0, 0), a2, voffA);
            PG8_BAR; PG8_WAIT_L(0); PG8_MMA(1, 0, At, B0); PG8_BAR; PG8_SCHED;
            PG8_STAGE(PG8_SB(0, 1), b2 + hstepB, voffB);
            PG8_WAIT_V(6); PG8_BAR; PG8_MMA(1, 1, At, B1); PG8_BAR;
            PG8_LDB(B0, 1, 0); PG8_SCHED; PG8_LDA(At, 1, 0); PG8_STAGE(PG8_SA(0, 1), a2 + hstepA, voffA);
            PG8_WAIT_L(8); PG8_BAR; PG8_WAIT_L(0); PG8_MMA(0, 0, At, B0); PG8_BAR; PG8_SCHED;
            PG8_LDB(B1, 1, 1); PG8_STAGE(PG8_SB(1, 0), b3, voffB);
            PG8_BAR; PG8_WAIT_L(0); PG8_MMA(0, 1, At, B1); PG8_BAR;
            PG8_LDA(At, 1, 1); PG8_STAGE(PG8_SA(1, 0), a3, voffA);
            PG8_BAR; PG8_WAIT_L(0); PG8_MMA(1, 0, At, B0); PG8_BAR; PG8_SCHED;
            PG8_STAGE(PG8_SB(1, 1), b3 + hstepB, voffB);
            PG8_WAIT_V(6); PG8_BAR; PG8_MMA(1, 1, At, B1); PG8_BAR;
            }
        }
        if constexpr (ALIGN_EPI) { if (wr == 0) PG8_BAR; }
        { int fr_e = fr, fq_e = fq; asm volatile("" : "+v"(fr_e), "+v"(fq_e));
          E(acc, cur, wr, wc, fr_e, fq_e); }
        if (!has_next) break;
        if (!HALFN && !(Epi::KEEP && cur.z != 3)) {
#pragma unroll
        for (int a = 0; a < 2; ++a)
#pragma unroll
            for (int b = 0; b < 2; ++b)
#pragma unroll
                for (int m = 0; m < 4; ++m)
#pragma unroll
                    for (int n = 0; n < 2; ++n) acc[a][b][m][n] = (f32x4){0.f, 0.f, 0.f, 0.f};
        }
        cur = nxt; cA = nA; cB = nB; ++ui;
        if constexpr (ALIGN_EPI) { if (wr == 1) PG8_BAR; }
    }
    PG8_WAIT_V(0);
    if constexpr (!ALIGN_EPI) { if (wr == 0) PG8_BAR; }
    PG8_BAR;
#undef PG8_SA
#undef PG8_SB
#undef PG8_STAGE
#undef PG8_LDA
#undef PG8_LDB
#undef PG8_MMA
#undef PG8_WAIT_V
#undef PG8_WAIT_L
#undef PG8_BAR
#undef PG8_SCHED
}

}

using pg8::bf16_t; using pg8::f32x4; using pg8::u32x4; using pg8::u32x2; using pg8::bf16x8; using pg8::cvt_pk_bf16;
#define LAS __attribute__((address_space(3)))

constexpr int D = 1024, SEQ = 4096, NB = 16, DEPTH = 4, BW = 512;
constexpr int NGRP = 2, BG = NB / NGRP, TG = BG * SEQ;
constexpr int N_IN = 21 * 256, N_MG = 4096, N_ALL = N_IN + N_MG;
constexpr int PLD = 20 * 256;
constexpr int P_GQ = 0, P_GK = 256, P_GV = 512, P_GG = 1024, P_RQ = 1536, P_RK = 1792, P_RV = 2048, P_RG = 2560, P_LX = 3072, P_LG = 3584, P_SU = 4096, P_SG = 4608;
constexpr int OLD = 2048;
constexpr float NORM_EPS = 1e-6f;

constexpr size_t MiB = 1u << 20;
constexpr size_t WS_CTL = 0, CTL_BYTES = 2 * MiB;
constexpr size_t WS_ROT = 2 * MiB;
constexpr size_t WS_SMALL = 3 * MiB, SMALL_STRIDE = 1 * MiB;
constexpr size_t WS_W = 8 * MiB, W_STRIDE = 26 * MiB;
constexpr size_t WO_IN = 0, WO_BR = (size_t)N_ALL * D * 2, WO_OUT = WO_BR + (size_t)4 * D * BW * 2, WO_GLU = WO_OUT + (size_t)D * D * 2, WO_END = WO_GLU + (size_t)BW * BW * 2;
static_assert(WO_END <= W_STRIDE, "weights");
constexpr size_t WS_U = 112 * MiB;
constexpr size_t WS_P = 176 * MiB;
constexpr size_t WS_LA = 496 * MiB;
constexpr size_t WS_O = 528 * MiB;
constexpr size_t WS_Y5 = 656 * MiB;
constexpr size_t WS_PG = 688 * MiB;
constexpr size_t WS_ST = 944 * MiB;
constexpr size_t WS_END = 1008 * MiB;
constexpr int SM_ABR = 0, SM_ABI = 2048, SM_BBR = 4096, SM_BBI = 4096 + 32768, SM_SP8 = 4096 + 65536, SM_END_F = SM_SP8 + 512;
constexpr int SM_A128 = SM_END_F;
constexpr size_t SM_LRUW_BYTES = 512 * 1024, SM_CT_BYTES = 640 * 1024, SM_BBT_BYTES = 768 * 1024;
static_assert((size_t)(SM_END_F + 4096) * 4 <= SM_LRUW_BYTES, "small");

constexpr int CW_BAR = 4096;
#define XB_TMO      128
#define XB_XCNT(j)  (256  + 64 * (j))
#define XB_XSUB(j)  (1280 + 64 * (j))
#define XB_XGEN(j)  (2304 + 64 * (j))
#define XB_TOP      3328
#define XB_TOPGEN   3392
#define XCD_BAR_WORDS 3456
#define XB_SPIN_CAP (1u << 18)

__device__ __forceinline__ unsigned xb_ld(unsigned* p)              { return __hip_atomic_load(p, __ATOMIC_RELAXED, __HIP_MEMORY_SCOPE_AGENT); }
__device__ __forceinline__ unsigned xb_add(unsigned* p, unsigned v) { return __hip_atomic_fetch_add(p, v, __ATOMIC_RELAXED, __HIP_MEMORY_SCOPE_AGENT); }
__device__ __forceinline__ unsigned xb_xcc_id() { return (unsigned)__builtin_amdgcn_s_getreg((3 << 11) | 20) & 0xFu; }
#define XB_SPIN(cond, bar) do { unsigned _sp = 0; while (cond) { __builtin_amdgcn_s_sleep(1); \
    if ((++_sp & 255u) == 0u) { if (xb_ld(&(bar)[XB_TMO])) break; if (_sp > XB_SPIN_CAP) { atomicAdd(&(bar)[XB_TMO], 1u); break; } } } } while (0)
struct XcdBarrier { unsigned* bar; unsigned x; volatile LAS unsigned* st; };
__device__ __forceinline__ XcdBarrier xcd_barrier_post(unsigned* bar, volatile LAS unsigned* st) {
    XcdBarrier b; b.bar = bar; b.x = xb_xcc_id(); b.st = st;
    if (threadIdx.x == 0) (void)xb_add(&bar[XB_XCNT(b.x)], 1u);
    return b;
}
__device__ __forceinline__ void xcd_barrier_complete(unsigned* bar, unsigned x, unsigned& nloc, unsigned& nx) {
    const unsigned G = gridDim.x * gridDim.y * gridDim.z;
    unsigned sum, cnt, mine, sp = 0u;
    for (;;) {
        sum = 0u; cnt = 0u; mine = 0u;
#pragma unroll
        for (unsigned j = 0; j < 16; ++j) { const unsigned c = xb_ld(&bar[XB_XCNT(j)]); sum += c; cnt += (c > 0u) ? 1u : 0u; mine = (j == x) ? c : mine; }
        if (sum == G) break;
        __builtin_amdgcn_s_sleep(1);
        if ((++sp & 255u) == 0u) { if (xb_ld(&bar[XB_TMO])) break; if (sp > XB_SPIN_CAP) { atomicAdd(&bar[XB_TMO], 1u); break; } }
    }
    nloc = mine > 0u ? mine : 1u; nx = cnt > 0u ? cnt : 1u;
}
__device__ __forceinline__ void xcd_barrier(const XcdBarrier& b) {
    asm volatile("s_waitcnt vmcnt(0)" ::: "memory");
    __syncthreads();
    if (threadIdx.x == 0) {
        unsigned* bar = b.bar;
        __builtin_amdgcn_s_waitcnt(0);
        unsigned nloc = b.st[0], nx = b.st[1];
        if (nloc == 0u) { xcd_barrier_complete(bar, b.x, nloc, nx); b.st[0] = nloc; b.st[1] = nx; }
        const unsigned old = xb_add(&bar[XB_XSUB(b.x)], 1u);
        const unsigned gen = old / nloc;
        if (old + 1u == (gen + 1u) * nloc) {
            __builtin_amdgcn_fence(__ATOMIC_RELEASE, "agent");
            asm volatile("s_waitcnt vmcnt(0)" ::: "memory");
            const unsigned og = xb_add(&bar[XB_TOP], 1u);
            const unsigned tg = og / nx;
            if (og + 1u == (tg + 1u) * nx) xb_add(&bar[XB_TOPGEN], 1u);
            else XB_SPIN(xb_ld(&bar[XB_TOPGEN]) == tg, bar);
            __builtin_amdgcn_fence(__ATOMIC_ACQUIRE, "agent");
            xb_add(&bar[XB_XGEN(b.x)], 1u);
            asm volatile("s_waitcnt vmcnt(0)" ::: "memory");
        } else {
            XB_SPIN(xb_ld(&bar[XB_XGEN(b.x)]) == gen, bar);
            __builtin_amdgcn_fence(__ATOMIC_ACQUIRE, "agent");
            asm volatile("s_waitcnt vmcnt(0)" ::: "memory");
        }
    }
    __syncthreads();
}

__device__ __forceinline__ float bf2f(bf16_t b) { return __uint_as_float(((unsigned)b) << 16); }
__device__ __forceinline__ float bflo(unsigned w) { return __uint_as_float(w << 16); }
__device__ __forceinline__ float bfhi(unsigned w) { return __uint_as_float(w & 0xffff0000u); }
__device__ __forceinline__ bf16_t f2bf(float f) { return (bf16_t)(cvt_pk_bf16(f, 0.f) & 0xffffu); }
__device__ __forceinline__ float sigmoid_f(float x) { return __builtin_amdgcn_rcpf(1.f + __expf(-x)); }
__device__ __forceinline__ float silu_f(float x) { return x * sigmoid_f(x); }
__device__ __forceinline__ float sig255(float t) { return __builtin_amdgcn_rcpf(__builtin_fmaf(__builtin_amdgcn_exp2f(t), 1.f / 255.f, 1.f / 255.f)); }
__device__ __forceinline__ float gelu_tanh_f(float x) { const float u = 0.7978845608028654f * (x + 0.044715f * x * x * x); const float t = 1.f - 2.f * __builtin_amdgcn_rcpf(1.f + __expf(2.f * u)); return 0.5f * x * (1.f + t); }
__device__ __forceinline__ float wave_sum(float v) {
#pragma unroll
    for (int o = 1; o < 64; o <<= 1) v += __shfl_xor(v, o);
    return v;
}

#define GEMM_CALL(EPI) pg8::gemm_phase<EPI, pg8::StaticOrder, true, true>(lds, g, S, E)
struct Args {
    const float* in[29]; float* out; unsigned char* ws;
    int s_lo, s_hi, li, fin, mmask, pad2;
};
enum { I_X = 0, I_NG, I_WIN, I_GWLR, I_GBLR, I_GNG, I_RNG, I_RNB, I_LCW, I_LCB, I_LWA, I_LBA, I_LWX, I_LBX, I_LLAM,
       I_SARE, I_SAIM, I_SBRE, I_SBIM, I_SCRE, I_SCIM, I_SD, I_SLDT, I_SGW, I_SGB, I_WMG, I_WBR, I_WOUT, I_FNG };

struct EpiIn {
    static constexpr bool PERM = true, AFTER_DRAIN = false, KEEP = false;
    bf16_t* P; float* LA; const float* blr; const float* rot; unsigned char* PG;
    __device__ __forceinline__ void operator()(f32x4 (&acc)[2][2][4][2], const pg8::Unit& u, int wr, int wc, int fr, int fq) const {
        const int pn = u.pn, row0 = u.pm * 256 + wr * 64 + fr, cl = wc * 32 + 8 * fq;
        if (pn >= 21) {
#pragma unroll
            for (int ai = 0; ai < 2; ++ai)
#pragma unroll
                for (int m = 0; m < 4; ++m) { int row = row0 + ai * 128 + m * 16; asm volatile("" : "+v"(row));
                    u32x4 w;
#pragma unroll
                    for (int bj = 0; bj < 2; ++bj) { const f32x4 v0 = acc[ai][bj][m][0], v1 = acc[ai][bj][m][1]; unsigned lo = 0u, hi = 0u;
#pragma unroll
                        for (int j = 0; j < 4; ++j) { lo = __builtin_amdgcn_cvt_pk_u8_f32(sig255(v0[j]), j, lo); hi = __builtin_amdgcn_cvt_pk_u8_f32(sig255(v1[j]), j, hi); }
                        if (bj == 0) { w.x = lo; w.y = hi; } else { w.z = lo; w.w = hi; } }
                    __builtin_nontemporal_store(w, (u32x4*)(PG + (size_t)row * N_MG + (pn - 21) * 256 + 2 * cl)); }
        } else if (pn == 4) {
#pragma unroll
            for (int bj = 0; bj < 2; ++bj) { const int c = cl + bj * 128; const f32x4 b0 = *(const f32x4*)(blr + c), b1 = *(const f32x4*)(blr + c + 4);
#pragma unroll
                for (int ai = 0; ai < 2; ++ai) {
#pragma unroll
                    for (int n = 0; n < 2; ++n)
#pragma unroll
                        for (int j = 0; j < 4; ++j) { float run = 0.f; const float bb = n ? b1[j] : b0[j];
#pragma unroll
                            for (int m = 0; m < 4; ++m) { const float z = acc[ai][bj][m][n][j] + bb; const float x = -(fmaxf(-z, 0.f) + __logf(1.f + __expf(-fabsf(z)))) * 0.0625f; float ls = x, rs = x;
#define DPP_ADD(acc_, ctrl_) acc_ += __builtin_bit_cast(float, __builtin_amdgcn_update_dpp(0, __builtin_bit_cast(int, acc_), ctrl_, 0xf, 0xf, true))
                                DPP_ADD(ls, 0x111); DPP_ADD(ls, 0x112); DPP_ADD(ls, 0x114); DPP_ADD(ls, 0x118);
                                DPP_ADD(rs, 0x101); DPP_ADD(rs, 0x102); DPP_ADD(rs, 0x104); DPP_ADD(rs, 0x108);
#undef DPP_ADD
                                acc[ai][bj][m][n][j] = run + ls; run += ls + rs - x; } }
#pragma unroll
                    for (int m = 0; m < 4; ++m) { int row = row0 + ai * 128 + m * 16; asm volatile("" : "+v"(row)); float* d = LA + (size_t)row * 256 + c; *(f32x4*)d = acc[ai][bj][m][0]; *(f32x4*)(d + 4) = acc[ai][bj][m][1]; } } }
        } else if (pn == 7 || pn == 8) {
            const float sc = pn == 8 ? 0.125f : 1.f; const int dcol = (pn - 1) * 256;
#pragma unroll
            for (int ai = 0; ai < 2; ++ai)
#pragma unroll
                for (int m = 0; m < 4; ++m) { int row = row0 + ai * 128 + m * 16; asm volatile("" : "+v"(row)); const int pos = row & (SEQ - 1);
#pragma unroll
                    for (int bj = 0; bj < 2; ++bj) { const int c = cl + bj * 128, i0 = (c & 63) >> 1; const float* rt = rot + ((size_t)pos * 32 + i0) * 2;
                        const f32x4 cs0 = *(const f32x4*)rt, cs1 = *(const f32x4*)(rt + 4); const f32x4 v0 = acc[ai][bj][m][0] * sc, v1 = acc[ai][bj][m][1] * sc;
                        u32x4 w; w.x = cvt_pk_bf16(v0[0] * cs0[0] - v0[1] * cs0[1], v0[0] * cs0[1] + v0[1] * cs0[0]); w.y = cvt_pk_bf16(v0[2] * cs0[2] - v0[3] * cs0[3], v0[2] * cs0[3] + v0[3] * cs0[2]);
                        w.z = cvt_pk_bf16(v1[0] * cs1[0] - v1[1] * cs1[1], v1[0] * cs1[1] + v1[1] * cs1[0]); w.w = cvt_pk_bf16(v1[2] * cs1[2] - v1[3] * cs1[3], v1[2] * cs1[3] + v1[3] * cs1[2]);
                        __builtin_nontemporal_store(w, (u32x4*)(P + (size_t)row * PLD + dcol + c)); } }
        } else {
            const bool silu = (pn == 5 || pn == 6 || pn == 11 || pn == 12 || pn == 15 || pn == 16 || pn == 19 || pn == 20);
            const float sc = pn == 0 ? 0.125f : 1.f; const int dcol = (pn < 4 ? pn : pn - 1) * 256;
#pragma unroll
            for (int ai = 0; ai < 2; ++ai)
#pragma unroll
                for (int m = 0; m < 4; ++m) { int row = row0 + ai * 128 + m * 16; asm volatile("" : "+v"(row));
#pragma unroll
                    for (int bj = 0; bj < 2; ++bj) { f32x4 v0 = acc[ai][bj][m][0] * sc, v1 = acc[ai][bj][m][1] * sc;
                        if (silu) {
#pragma unroll
                            for (int j = 0; j < 4; ++j) { v0[j] = silu_f(v0[j]); v1[j] = silu_f(v1[j]); } }
                        u32x4 w; w.x = cvt_pk_bf16(v0[0], v0[1]); w.y = cvt_pk_bf16(v0[2], v0[3]); w.z = cvt_pk_bf16(v1[0], v1[1]); w.w = cvt_pk_bf16(v1[2], v1[3]);
                        __builtin_nontemporal_store(w, (u32x4*)(P + (size_t)row * PLD + dcol + cl + bj * 128)); } }
        }
    }
};
struct EpiSig {
    static constexpr bool PERM = true, AFTER_DRAIN = false, KEEP = false;
    bf16_t* PG;
    __device__ __forceinline__ void operator()(const f32x4 (&acc)[2][2][4][2], const pg8::Unit& u, int wr, int wc, int fr, int fq) const {
        const int row0 = u.pm * 256 + wr * 64 + fr, c0 = u.pn * 256 + wc * 32 + 8 * fq;
#pragma unroll
        for (int ai = 0; ai < 2; ++ai)
#pragma unroll
            for (int m = 0; m < 4; ++m) { const int row = row0 + ai * 128 + m * 16;
#pragma unroll
                for (int bj = 0; bj < 2; ++bj) { f32x4 v0 = acc[ai][bj][m][0], v1 = acc[ai][bj][m][1];
#pragma unroll
                    for (int j = 0; j < 4; ++j) { v0[j] = sigmoid_f(v0[j]); v1[j] = sigmoid_f(v1[j]); }
                    u32x4 w; w.x = cvt_pk_bf16(v0[0], v0[1]); w.y = cvt_pk_bf16(v0[2], v0[3]); w.z = cvt_pk_bf16(v1[0], v1[1]); w.w = cvt_pk_bf16(v1[2], v1[3]);
                    *(u32x4*)(PG + (size_t)row * N_MG + c0 + bj * 128) = w; } }
    }
};
struct EpiGlu {
    static constexpr bool PERM = true, AFTER_DRAIN = false, KEEP = false;
    const bf16_t* Y5; const bf16_t* P; const float* gb; bf16_t* O;
    __device__ __forceinline__ void operator()(const f32x4 (&acc)[2][2][4][2], const pg8::Unit& u, int wr, int wc, int fr, int fq) const {
        const int row0 = u.pm * 256 + wr * 64 + fr, c0 = u.pn * 256 + wc * 32 + 8 * fq;
#pragma unroll
        for (int bj = 0; bj < 2; ++bj) { const int c = c0 + bj * 128; const f32x4 b0 = *(const f32x4*)(gb + c), b1 = *(const f32x4*)(gb + c + 4);
#pragma unroll
            for (int ai = 0; ai < 2; ++ai)
#pragma unroll
                for (int m = 0; m < 4; ++m) { const int row = row0 + ai * 128 + m * 16;
                    const u32x4 y = *(const u32x4*)(Y5 + (size_t)row * BW + c), s = *(const u32x4*)(P + (size_t)row * PLD + P_SG + c);
                    const f32x4 v0 = acc[ai][bj][m][0] + b0, v1 = acc[ai][bj][m][1] + b1;
                    u32x4 w;
                    w.x = cvt_pk_bf16(bflo(y.x) * sigmoid_f(v0[0]) * bflo(s.x), bfhi(y.x) * sigmoid_f(v0[1]) * bfhi(s.x));
                    w.y = cvt_pk_bf16(bflo(y.y) * sigmoid_f(v0[2]) * bflo(s.y), bfhi(y.y) * sigmoid_f(v0[3]) * bfhi(s.y));
                    w.z = cvt_pk_bf16(bflo(y.z) * sigmoid_f(v1[0]) * bflo(s.z), bfhi(y.z) * sigmoid_f(v1[1]) * bfhi(s.z));
                    w.w = cvt_pk_bf16(bflo(y.w) * sigmoid_f(v1[2]) * bflo(s.w), bfhi(y.w) * sigmoid_f(v1[3]) * bfhi(s.w));
                    *(u32x4*)(O + (size_t)row * OLD + 1536 + c) = w; } }
    }
};
struct EpiBr {
    static constexpr bool PERM = true, AFTER_DRAIN = false, KEEP = false;
    const unsigned char* PG; bf16_t* MRG;
    __device__ __forceinline__ void operator()(f32x4 (&acc)[2][2][4][2], const pg8::Unit& u, int wr, int wc, int fr, int fq) const {
        const int row0 = u.pm * 256 + wr * 64 + fr, c = u.pn * 128 + wc * 32 + 8 * fq, z = u.z;
        const int gpos = (z * 4 + (u.pn >> 1)) * 256 + wc * 64 + fq * 16 + (u.pn & 1) * 8;
#pragma unroll
        for (int ai = 0; ai < 2; ++ai)
#pragma unroll
            for (int m = 0; m < 4; ++m) { const int row = row0 + ai * 128 + m * 16;
                const u32x2 gt = __builtin_nontemporal_load((const u32x2*)(PG + (size_t)row * N_MG + gpos));
                f32x4& p0 = acc[ai][0][m][0]; f32x4& p1 = acc[ai][0][m][1]; f32x4& s0 = acc[ai][1][m][0]; f32x4& s1 = acc[ai][1][m][1];
                if (z == 0) { s0 = (f32x4){0.f, 0.f, 0.f, 0.f}; s1 = s0; }
                s0[0] += p0[0] * (float)(gt.x & 255u); s0[1] += p0[1] * (float)((gt.x >> 8) & 255u); s0[2] += p0[2] * (float)((gt.x >> 16) & 255u); s0[3] += p0[3] * (float)(gt.x >> 24);
                s1[0] += p1[0] * (float)(gt.y & 255u); s1[1] += p1[1] * (float)((gt.y >> 8) & 255u); s1[2] += p1[2] * (float)((gt.y >> 16) & 255u); s1[3] += p1[3] * (float)(gt.y >> 24);
                p0 = (f32x4){0.f, 0.f, 0.f, 0.f}; p1 = p0;
                if (z == 3) { const float q = 1.f / 255.f; s0 *= q; s1 *= q;
                    u32x4 w; w.x = cvt_pk_bf16(s0[0], s0[1]); w.y = cvt_pk_bf16(s0[2], s0[3]); w.z = cvt_pk_bf16(s1[0], s1[1]); w.w = cvt_pk_bf16(s1[2], s1[3]);
                    *(u32x4*)(MRG + (size_t)row * D + c) = w; } }
    }
};
struct EpiOut {
    static constexpr bool PERM = true, AFTER_DRAIN = false, KEEP = false;
    bf16_t* DL;
    __device__ __forceinline__ void operator()(const f32x4 (&acc)[2][2][4][2], const pg8::Unit& u, int wr, int wc, int fr, int fq) const {
        const int row0 = u.pm * 256 + wr * 64 + fr, c0 = u.pn * 256 + wc * 32 + 8 * fq;
#pragma unroll
        for (int ai = 0; ai < 2; ++ai)
#pragma unroll
            for (int m = 0; m < 4; ++m) { const int row = row0 + ai * 128 + m * 16;
#pragma unroll
                for (int bj = 0; bj < 2; ++bj) { const f32x4 v0 = acc[ai][bj][m][0], v1 = acc[ai][bj][m][1];
                    u32x4 w; w.x = cvt_pk_bf16(v0[0], v0[1]); w.y = cvt_pk_bf16(v0[2], v0[3]); w.z = cvt_pk_bf16(v1[0], v1[1]); w.w = cvt_pk_bf16(v1[2], v1[3]);
                    *(u32x4*)(DL + (size_t)row * D + c0 + bj * 128) = w; } }
    }
};

__device__ __forceinline__ int win_src_col(int r) {
    const int pn = r >> 8, j = r & 255;
    switch (pn) {
        case 0: return j; case 1: return 256 + j; case 2: case 3: return 512 + (r - 512);
        case 4: return -1;
        case 5: case 6: return 1040 + (r - 1280);
        case 7: return 1552 + 64 * (j >> 6) + ((j & 63) >> 1) + 32 * (j & 1);
        case 8: return 1808 + 64 * (j >> 6) + ((j & 63) >> 1) + 32 * (j & 1);
        case 9: case 10: return 2064 + (r - 2304);
        case 11: case 12: return 2576 + (r - 2816);
        case 13: case 14: return 3088 + (r - 3328);
        case 15: case 16: return 3600 + (r - 3840);
        case 17: case 18: return 4112 + (r - 4352);
        default: return 4624 + (r - 4864);
    }
}
__device__ __forceinline__ void tr_store8(bf16_t* dst, const float (&v)[8]) {
    u32x4 w; w.x = cvt_pk_bf16(v[0], v[1]); w.y = cvt_pk_bf16(v[2], v[3]); w.z = cvt_pk_bf16(v[4], v[5]); w.w = cvt_pk_bf16(v[6], v[7]); *(u32x4*)dst = w;
}
__device__ __forceinline__ void phase_prologue(const Args& a, int gtid, int gthreads) {
    unsigned char* ws = a.ws;
    for (int l = 0; l < DEPTH; ++l) {
        bf16_t* Wl = (bf16_t*)(ws + WS_W + (size_t)l * W_STRIDE);
        const float* win = a.in[I_WIN] + (size_t)l * D * 5136;
        const float* wlr = a.in[I_GWLR] + (size_t)l * 16 * 256;
        for (int idx = gtid; idx < N_IN * (D / 8); idx += gthreads) { const int n = idx % N_IN, kc = idx / N_IN; const int sc = win_src_col(n); float v[8];
            if (sc >= 0) {
#pragma unroll
                for (int i = 0; i < 8; ++i) v[i] = win[(size_t)(kc * 8 + i) * 5136 + sc];
            } else { const int j = n & 255;
#pragma unroll
                for (int i = 0; i < 8; ++i) { float s = 0.f; const float* wr_ = win + (size_t)(kc * 8 + i) * 5136 + 1024;
#pragma unroll
                    for (int r = 0; r < 16; ++r) s += wr_[r] * wlr[r * 256 + j];
                    v[i] = s; } }
            tr_store8(Wl + (size_t)n * D + kc * 8, v); }
        const float* wmg = a.in[I_WMG] + (size_t)l * 4 * D * D;
        for (int idx = gtid; idx < N_MG * (D / 8); idx += gthreads) { const int n = idx % N_MG, kc = idx / N_MG, bi = n >> 10, c = n & 1023; float v[8];
#pragma unroll
            for (int i = 0; i < 8; ++i) v[i] = wmg[((size_t)bi * D + kc * 8 + i) * D + c] * -1.4426950408889634f;
            tr_store8(Wl + (size_t)(N_IN + n) * D + kc * 8, v); }
        const float* wbr = a.in[I_WBR] + (size_t)l * 4 * BW * D; bf16_t* Wb = (bf16_t*)((unsigned char*)Wl + WO_BR);
        for (int idx = gtid; idx < 4 * D * (BW / 8); idx += gthreads) { const int n = idx % (4 * D), kc = idx / (4 * D), bi = n >> 10, c = n & 1023; float v[8];
#pragma unroll
            for (int i = 0; i < 8; ++i) v[i] = wbr[((size_t)bi * BW + kc * 8 + i) * D + c];
            tr_store8(Wb + (size_t)n * BW + kc * 8, v); }
        const float* wout = a.in[I_WOUT] + (size_t)l * D * D; bf16_t* Wo = (bf16_t*)((unsigned char*)Wl + WO_OUT);
        for (int idx = gtid; idx < D * (D / 8); idx += gthreads) { const int n = idx % D, kc = idx / D; float v[8];
#pragma unroll
            for (int i = 0; i < 8; ++i) v[i] = wout[(size_t)(kc * 8 + i) * D + n];
            tr_store8(Wo + (size_t)n * D + kc * 8, v); }
        const float* wglu = a.in[I_SGW] + (size_t)l * BW * BW; bf16_t* Wg = (bf16_t*)((unsigned char*)Wl + WO_GLU);
        for (int idx = gtid; idx < BW * (BW / 8); idx += gthreads) { const int n = idx % BW, kc = idx / BW; float v[8];
#pragma unroll
            for (int i = 0; i < 8; ++i) v[i] = wglu[(size_t)(kc * 8 + i) * BW + n];
            tr_store8(Wg + (size_t)n * BW + kc * 8, v); }
        float* sm = (float*)(ws + WS_SMALL + (size_t)l * SMALL_STRIDE);
        for (int idx = gtid; idx < 2048; idx += gthreads) { const int g = idx >> 6;
            const double step = exp((double)a.in[I_SLDT][l * 32 + g]); const double are = a.in[I_SARE][l * 2048 + idx], aim = a.in[I_SAIM][l * 2048 + idx];
            const double mag = exp(step * are), abr = mag * cos(step * aim), abi = mag * sin(step * aim), den = are * are + aim * aim;
            const double fre = ((abr - 1.0) * are + abi * aim) / den, fim = (abi * are - (abr - 1.0) * aim) / den;
            sm[SM_ABR + idx] = (float)abr; sm[SM_ABI + idx] = (float)abi;
            { const double m128 = exp(512.0 * step * are); sm[SM_A128 + idx * 2] = (float)(m128 * cos(512.0 * step * aim)); sm[SM_A128 + idx * 2 + 1] = (float)(m128 * sin(512.0 * step * aim)); }
            bf16_t* bbt = (bf16_t*)((unsigned char*)sm + SM_BBT_BYTES); const int p_ = idx & 63;
            for (int i = 0; i < 16; ++i) { const double br = a.in[I_SBRE][(size_t)l * 32768 + idx * 16 + i], bi = a.in[I_SBIM][(size_t)l * 32768 + idx * 16 + i];
                const float vr = (float)(fre * br - fim * bi), vi = (float)(fre * bi + fim * br);
                sm[SM_BBR + idx * 16 + i] = vr; sm[SM_BBI + idx * 16 + i] = vi; bbt[(g * 128 + 2 * p_) * 16 + i] = f2bf(vr); bbt[(g * 128 + 2 * p_ + 1) * 16 + i] = f2bf(vi); } }
        for (int idx = gtid; idx < 512; idx += gthreads) { const float lam = a.in[I_LLAM][l * 512 + idx]; const float nl = -lam;
            sm[SM_SP8 + idx] = 8.0f * (fmaxf(nl, 0.f) + log1pf(expf(-fabsf(nl)))); }
        { bf16_t* ct = (bf16_t*)((unsigned char*)sm + SM_CT_BYTES);
          for (int idx = gtid; idx < 32 * 16 * 128; idx += gthreads) { const int k = idx & 127, gi = idx >> 7;
              const float v = (k & 1) == 0 ? a.in[I_SCRE][(size_t)l * 32768 + gi * 64 + (k >> 1)] : -a.in[I_SCIM][(size_t)l * 32768 + gi * 64 + (k >> 1)]; ct[idx] = f2bf(v); } }
        bf16_t* lw = (bf16_t*)((unsigned char*)sm + SM_LRUW_BYTES);
        for (int idx = gtid; idx < 8 * 128 * 64; idx += gthreads) { const int i = idx & 63, jj = (idx >> 6) & 127, n = idx >> 13;
            const float v = jj < 64 ? a.in[I_LWA][(((size_t)l * 8 + n) * 64 + i) * 64 + jj] : a.in[I_LWX][(((size_t)l * 8 + n) * 64 + i) * 64 + (jj - 64)];
            lw[idx] = f2bf(v); }
    }
    float* rot = (float*)(ws + WS_ROT);
    for (int idx = gtid; idx < SEQ * 32; idx += gthreads) { const int i = idx & 31, s = idx >> 5;
        const double inv = pow(10000.0, -(double)i / 32.0), ang = (double)s * inv; rot[idx * 2] = (float)cos(ang); rot[idx * 2 + 1] = (float)sin(ang); }
}

template <bool F32OUT, bool ADD>
__device__ __forceinline__ void phase_norm(const float* hin, const bf16_t* delta, float* hout, const float* gain, bf16_t* uout, int gw, int ngw, int lane) {
    f32x4 gv[4];
#pragma unroll
    for (int j = 0; j < 4; ++j) gv[j] = *(const f32x4*)(gain + 4 * lane + 256 * j);
    for (int row = gw; row < TG; row += ngw) {
        const f32x4* xr = (const f32x4*)(hin + (size_t)row * D) + lane; f32x4 v[4]; float s = 0.f;
#pragma unroll
        for (int j = 0; j < 4; ++j) v[j] = __builtin_nontemporal_load(xr + 64 * j);
        if (ADD) { const u32x2* dr = (const u32x2*)(delta + (size_t)row * D) + lane;
#pragma unroll
            for (int j = 0; j < 4; ++j) { const u32x2 dw = __builtin_nontemporal_load(dr + 64 * j); v[j].x += bflo(dw.x); v[j].y += bfhi(dw.x); v[j].z += bflo(dw.y); v[j].w += bfhi(dw.y); } }
#pragma unroll
        for (int j = 0; j < 4; ++j) s += (v[j].x * v[j].x + v[j].y * v[j].y) + (v[j].z * v[j].z + v[j].w * v[j].w);
        const float rstd = rsqrtf(wave_sum(s) * (1.f / D) + NORM_EPS);
        if (F32OUT) { f32x4* o = (f32x4*)(hout + (size_t)row * D) + lane;
#pragma unroll
            for (int j = 0; j < 4; ++j) o[64 * j] = v[j] * rstd * gv[j];
        } else {
            if (ADD) { f32x4* o = (f32x4*)(hout + (size_t)row * D) + lane;
#pragma unroll
                for (int j = 0; j < 4; ++j) o[64 * j] = v[j]; }
            u32x2* o = (u32x2*)(uout + (size_t)row * D) + lane;
#pragma unroll
            for (int j = 0; j < 4; ++j) { const f32x4 y = v[j] * rstd * gv[j]; u32x2 w; w.x = cvt_pk_bf16(y.x, y.y); w.y = cvt_pk_bf16(y.z, y.w); o[64 * j] = w; } }
    }
}

constexpr int NSEGG = 8;
constexpr int NSEGL = 32;
constexpr int NSEGS = 8;
constexpr size_t ST_GSEG = 0;
constexpr size_t ST_GDS = ST_GSEG + (size_t)2 * BG * 4 * NSEGG * 8192;
constexpr size_t ST_LRU = ST_GDS + (size_t)2 * BG * 4 * NSEGG * 64;
constexpr size_t ST_S5 = ST_LRU + (size_t)BG * NSEGL * 512 * 2;
constexpr size_t ST_END_F = ST_S5 + (size_t)BG * NSEGS * 32 * 128;
static_assert(ST_END_F * 4 <= 64 * MiB, "state scratch");
typedef short s16x4 __attribute__((ext_vector_type(4)));

__device__ __forceinline__ bf16x8 lds_tr_frag(LAS const unsigned char* base, int row_stride_bytes, int lane) {
    const int g = lane >> 4, idx = lane & 15, q = idx >> 2, p = idx & 3;
    LAS const unsigned char* a0 = base + (8 * g + q) * row_stride_bytes + 8 * p;
    const s16x4 r0 = __builtin_amdgcn_ds_read_tr16_b64_v4i16((LAS s16x4*)a0);
    const s16x4 r1 = __builtin_amdgcn_ds_read_tr16_b64_v4i16((LAS s16x4*)(a0 + 4 * row_stride_bytes));
    bf16x8 f; f[0] = r0[0]; f[1] = r0[1]; f[2] = r0[2]; f[3] = r0[3]; f[4] = r1[0]; f[5] = r1[1]; f[6] = r1[2]; f[7] = r1[3]; return f;
}
#define WGSYNC() do { asm volatile("s_waitcnt lgkmcnt(0)" ::: "memory"); __builtin_amdgcn_s_barrier(); asm volatile("" ::: "memory"); } while (0)

constexpr int GL_QD = 0, GL_KD = 9216, GL_KT = 18432, GL_V = 27648, GL_ST = 45056, GL_LAST = 63488, GL_RED = 63744, GL_RED2 = 64256;
struct GlaP { const bf16_t* P; const float* LA; const float* gain; const float* bias; bf16_t* O; float* SSEG; float* DSUM; };
__device__ __forceinline__ bf16x8 lds_tr_frag2(LAS const unsigned char* base, int row_stride_bytes, int lane, int mulg, int second_off) {
    const int g = lane >> 4, idx = lane & 15, q = idx >> 2, p = idx & 3;
    LAS const unsigned char* a0 = base + (mulg * g + q) * row_stride_bytes + 8 * p;
    const s16x4 r0 = __builtin_amdgcn_ds_read_tr16_b64_v4i16((LAS s16x4*)a0);
    const s16x4 r1 = __builtin_amdgcn_ds_read_tr16_b64_v4i16((LAS s16x4*)(a0 + second_off * row_stride_bytes));
    bf16x8 f; f[0] = r0[0]; f[1] = r0[1]; f[2] = r0[2]; f[3] = r0[3]; f[4] = r1[0]; f[5] = r1[1]; f[6] = r1[2]; f[7] = r1[3]; return f;
}
__device__ __forceinline__ bf16x8 pack8(const f32x4 a, const f32x4 b) { u32x4 w; w.x = cvt_pk_bf16(a[0], a[1]); w.y = cvt_pk_bf16(a[2], a[3]); w.z = cvt_pk_bf16(b[0], b[1]); w.w = cvt_pk_bf16(b[2], b[3]); return __builtin_bit_cast(bf16x8, w); }

template <bool PASSC>
__device__ __forceinline__ void glaret_item(LAS unsigned char* lds, const GlaP& gp, const bool gla, const int b, const int h, const int seg, const int sidx  ) {
    int tid = threadIdx.x; asm volatile("" : "+v"(tid));
    const int w = __builtin_amdgcn_readfirstlane(tid >> 6), l = tid & 63, fr = l & 15, fq = l >> 4;
    const int qoff = gla ? P_GQ : P_RQ, koff = gla ? P_GK : P_RK, voff = gla ? P_GV : P_RV, goff = gla ? P_GG : P_RG, ooff = gla ? 0 : 512;
    const float lg = __logf(1.f - exp2f(-5.f - (float)h));
    f32x4 accs[4];
#pragma unroll
    for (int dt = 0; dt < 4; ++dt) accs[dt] = (f32x4){0.f, 0.f, 0.f, 0.f};
    const int arow = 8 * w + (l >> 3), apart = l & 7;
    float dsum[8];
#pragma unroll
    for (int e = 0; e < 8; ++e) dsum[e] = 0.f;
    if (PASSC) {
        for (int sp = 0; sp < seg; ++sp) {
            const float* sg = gp.SSEG + (size_t)(sidx + sp) * 8192 + tid * 16; const float* dsm = gp.DSUM + (size_t)(sidx + sp) * 64;
#pragma unroll
            for (int dt = 0; dt < 4; ++dt) { const f32x4 dv = *(const f32x4*)(dsm + 16 * dt + 4 * fq), sv = *(const f32x4*)(sg + 4 * dt);
#pragma unroll
                for (int r = 0; r < 4; ++r) accs[dt][r] = accs[dt][r] * __expf(dv[r]) + sv[r]; }
        }
#pragma unroll
        for (int dt = 0; dt < 4; ++dt) { u32x2 wv; wv.x = cvt_pk_bf16(accs[dt][0], accs[dt][1]); wv.y = cvt_pk_bf16(accs[dt][2], accs[dt][3]);
            *(LAS u32x2*)(lds + GL_ST + (16 * w + fr) * 144 + 32 * dt + 8 * fq) = wv; }
    }
    const int it = w & 3, ch = w >> 2;
    f32x4 gnv[4], bsv[4];
#pragma unroll
    for (int ct = 0; ct < 4; ++ct) { const int c = 128 * h + 64 * ch + 16 * ct + 4 * fq; gnv[ct] = PASSC ? *(const f32x4*)(gp.gain + c) : (f32x4){0.f, 0.f, 0.f, 0.f};
        bsv[ct] = (PASSC && !gla) ? *(const f32x4*)(gp.bias + c) : (f32x4){0.f, 0.f, 0.f, 0.f}; }
    u32x4 rq = (u32x4){0u, 0u, 0u, 0u}, rk, rv[2]; f32x4 rla[2], rll[2]; u32x2 gnx[4];
    const float rq_s = __expf((float)(arow + 1) * lg), rk_s = __expf(-(float)(arow + 1) * lg), rt_s = __expf((float)(63 - arow) * lg);
#define GL_ISSUE(n_) do { const size_t r0_ = (size_t)b * SEQ + seg * 512 + (n_) * 64; \
        { const bf16_t* pr_ = gp.P + (r0_ + arow) * PLD + 64 * h + 8 * apart; if (PASSC) rq = *(const u32x4*)(pr_ + qoff); rk = *(const u32x4*)(pr_ + koff); \
          if (gla) { const float* lp_ = gp.LA + (r0_ + arow) * 256 + 64 * h + 8 * apart; rla[0] = *(const f32x4*)lp_; rla[1] = *(const f32x4*)(lp_ + 4); const float* ll_ = gp.LA + (r0_ + 63) * 256 + 64 * h + 8 * apart; rll[0] = *(const f32x4*)ll_; rll[1] = *(const f32x4*)(ll_ + 4); } \
          else { rla[0] = (f32x4){0.f, 0.f, 0.f, 0.f}; rla[1] = rla[0]; rll[0] = rla[0]; rll[1] = rla[0]; } } \
        _Pragma("unroll") for (int e_ = 0; e_ < 2; ++e_) { const int p_ = tid + 512 * e_, i_ = p_ >> 4, part_ = p_ & 15; \
            rv[e_] = *(const u32x4*)(gp.P + (r0_ + i_) * PLD + voff + 128 * h + 8 * part_); } \
        if (PASSC) { _Pragma("unroll") for (int ct_ = 0; ct_ < 4; ++ct_) gnx[ct_] = *(const u32x2*)(gp.P + (r0_ + 16 * it + fr) * PLD + goff + 128 * h + 64 * ch + 16 * ct_ + 4 * fq); } } while (0)
    GL_ISSUE(0);
    for (int n = 0; n < 8; ++n) {
        const size_t row0 = (size_t)b * SEQ + seg * 512 + n * 64;
#pragma unroll
        for (int e = 0; e < 2; ++e) { const int p = tid + 512 * e, i = p >> 4, part = p & 15; *(LAS u32x4*)(lds + GL_V + i * 272 + part * 16) = rv[e]; }
        { float cum[8], lastv[8];
          const float kk[8] = {bflo(rk.x), bfhi(rk.x), bflo(rk.y), bfhi(rk.y), bflo(rk.z), bfhi(rk.z), bflo(rk.w), bfhi(rk.w)};
          float eq[8], ek[8], et[8];
          if (gla) {
#pragma unroll
              for (int e = 0; e < 8; ++e) { cum[e] = e < 4 ? rla[0][e] : rla[1][e - 4]; lastv[e] = e < 4 ? rll[0][e] : rll[1][e - 4];
                  eq[e] = __expf(cum[e]); ek[e] = __builtin_amdgcn_rcpf(eq[e]); et[e] = __expf(lastv[e]) * ek[e]; }
          } else {
#pragma unroll
              for (int e = 0; e < 8; ++e) { lastv[e] = 64.f * lg; eq[e] = rq_s; ek[e] = rk_s; et[e] = rt_s; } }
#pragma unroll
          for (int e = 0; e < 8; ++e) *(LAS bf16_t*)(lds + GL_KT + (8 * apart + e) * 144 + arow * 2) = f2bf(kk[e] * et[e]);
          if (PASSC) { const float qq[8] = {bflo(rq.x), bfhi(rq.x), bflo(rq.y), bfhi(rq.y), bflo(rq.z), bfhi(rq.z), bflo(rq.w), bfhi(rq.w)};
              u32x4 qw, kw;
              qw.x = cvt_pk_bf16(qq[0] * eq[0], qq[1] * eq[1]); qw.y = cvt_pk_bf16(qq[2] * eq[2], qq[3] * eq[3]); qw.z = cvt_pk_bf16(qq[4] * eq[4], qq[5] * eq[5]); qw.w = cvt_pk_bf16(qq[6] * eq[6], qq[7] * eq[7]);
              kw.x = cvt_pk_bf16(kk[0] * ek[0], kk[1] * ek[1]); kw.y = cvt_pk_bf16(kk[2] * ek[2], kk[3] * ek[3]); kw.z = cvt_pk_bf16(kk[4] * ek[4], kk[5] * ek[5]); kw.w = cvt_pk_bf16(kk[6] * ek[6], kk[7] * ek[7]);
              *(LAS u32x4*)(lds + GL_QD + arow * 144 + 16 * apart) = qw; *(LAS u32x4*)(lds + GL_KD + arow * 144 + 16 * apart) = kw; }
          if (arow == 63) {
#pragma unroll
              for (int e = 0; e < 8; ++e) *(LAS float*)(lds + GL_LAST + (8 * apart + e) * 4) = lastv[e]; }
#pragma unroll
          for (int e = 0; e < 8; ++e) dsum[e] += lastv[e]; }
        u32x2 gates[4];
        if (PASSC) {
#pragma unroll
            for (int ct = 0; ct < 4; ++ct) gates[ct] = gnx[ct]; }
        if (n < 7) GL_ISSUE(n + 1);
        WGSYNC();
        f32x4 acco[4];
        if (PASSC) {
            bf16x8 qf[2];
#pragma unroll
            for (int ks = 0; ks < 2; ++ks) qf[ks] = *(LAS const bf16x8*)(lds + GL_QD + (16 * it + fr) * 144 + 16 * fq + 64 * ks);
            f32x4 sc[4];
#pragma unroll
            for (int jt = 0; jt < 4; ++jt) { sc[jt] = (f32x4){0.f, 0.f, 0.f, 0.f};
                if (jt <= it) {
#pragma unroll
                    for (int ks = 0; ks < 2; ++ks) { const bf16x8 kf = *(LAS const bf16x8*)(lds + GL_KD + (16 * jt + fr) * 144 + 16 * fq + 64 * ks);
                        sc[jt] = __builtin_amdgcn_mfma_f32_16x16x32_bf16(kf, qf[ks], sc[jt], 0, 0, 0); }
                    if (jt == it) {
#pragma unroll
                        for (int r = 0; r < 4; ++r) sc[jt][r] = (4 * fq + r <= fr) ? sc[jt][r] : 0.f; } } }
            const bf16x8 pf0 = pack8(sc[0], sc[1]), pf1 = pack8(sc[2], sc[3]);
#pragma unroll
            for (int ct = 0; ct < 4; ++ct) { const int c0 = 64 * ch + 16 * ct; acco[ct] = (f32x4){0.f, 0.f, 0.f, 0.f};
                { const bf16x8 vf = lds_tr_frag2(lds + GL_V + c0 * 2, 272, l, 4, 16); acco[ct] = __builtin_amdgcn_mfma_f32_16x16x32_bf16(vf, pf0, acco[ct], 0, 0, 0); }
                if (it >= 2) { const bf16x8 vf = lds_tr_frag2(lds + GL_V + 32 * 272 + c0 * 2, 272, l, 4, 16); acco[ct] = __builtin_amdgcn_mfma_f32_16x16x32_bf16(vf, pf1, acco[ct], 0, 0, 0); }
#pragma unroll
                for (int ks = 0; ks < 2; ++ks) { const bf16x8 sf = *(LAS const bf16x8*)(lds + GL_ST + (c0 + fr) * 144 + 16 * fq + 64 * ks);
                    acco[ct] = __builtin_amdgcn_mfma_f32_16x16x32_bf16(sf, qf[ks], acco[ct], 0, 0, 0); } }
        }
#pragma unroll
        for (int dt = 0; dt < 4; ++dt) { const f32x4 lv = *(LAS const f32x4*)(lds + GL_LAST + (16 * dt + 4 * fq) * 4);
#pragma unroll
            for (int r = 0; r < 4; ++r) accs[dt][r] *= __expf(lv[r]); }
#pragma unroll
        for (int ks = 0; ks < 2; ++ks) { const bf16x8 vf = lds_tr_frag2(lds + GL_V + (32 * ks) * 272 + (16 * w) * 2, 272, l, 8, 4);
#pragma unroll
            for (int dt = 0; dt < 4; ++dt) { const bf16x8 kf = *(LAS const bf16x8*)(lds + GL_KT + (16 * dt + fr) * 144 + 16 * fq + 64 * ks);
                accs[dt] = __builtin_amdgcn_mfma_f32_16x16x32_bf16(kf, vf, accs[dt], 0, 0, 0); } }
        if (PASSC) {
            float ss = 0.f, sm_ = 0.f;
#pragma unroll
            for (int ct = 0; ct < 4; ++ct)
#pragma unroll
                for (int r = 0; r < 4; ++r) { ss += acco[ct][r] * acco[ct][r]; sm_ += acco[ct][r]; }
            ss += __shfl_xor(ss, 16); ss += __shfl_xor(ss, 32); sm_ += __shfl_xor(sm_, 16); sm_ += __shfl_xor(sm_, 32);
            if (fq == 0) { *(LAS float*)(lds + GL_RED + ((16 * it + fr) * 2 + ch) * 4) = ss; *(LAS float*)(lds + GL_RED2 + ((16 * it + fr) * 2 + ch) * 4) = sm_; }
        }
        WGSYNC();
        if (PASSC) {
            const int i = 16 * it + fr;
            const float ssum = *(LAS const float*)(lds + GL_RED + (i * 2) * 4) + *(LAS const float*)(lds + GL_RED + (i * 2 + 1) * 4);
            const float msum = *(LAS const float*)(lds + GL_RED2 + (i * 2) * 4) + *(LAS const float*)(lds + GL_RED2 + (i * 2 + 1) * 4);
            float mean, rstd;
            if (gla) { mean = 0.f; rstd = rsqrtf(ssum * (1.f / 128.f) + NORM_EPS); }
            else { mean = msum * (1.f / 128.f); const float var = fmaxf(ssum * (1.f / 128.f) - mean * mean, 0.f); rstd = rsqrtf(var + NORM_EPS); }
#pragma unroll
            for (int ct = 0; ct < 4; ++ct) { const int c = 128 * h + 64 * ch + 16 * ct + 4 * fq; const f32x4 gn = gnv[ct], bs = bsv[ct];
                const float g0 = bflo(gates[ct].x), g1 = bfhi(gates[ct].x), g2 = bflo(gates[ct].y), g3 = bfhi(gates[ct].y);
                u32x2 ow; ow.x = cvt_pk_bf16(((acco[ct][0] - mean) * rstd * gn[0] + bs[0]) * g0, ((acco[ct][1] - mean) * rstd * gn[1] + bs[1]) * g1);
                ow.y = cvt_pk_bf16(((acco[ct][2] - mean) * rstd * gn[2] + bs[2]) * g2, ((acco[ct][3] - mean) * rstd * gn[3] + bs[3]) * g3);
                *(u32x2*)(gp.O + (row0 + i) * OLD + ooff + c) = ow; }
#pragma unroll
            for (int dt = 0; dt < 4; ++dt) { u32x2 wv; wv.x = cvt_pk_bf16(accs[dt][0], accs[dt][1]); wv.y = cvt_pk_bf16(accs[dt][2], accs[dt][3]);
                *(LAS u32x2*)(lds + GL_ST + (16 * w + fr) * 144 + 32 * dt + 8 * fq) = wv; }
        }
    }
#undef GL_ISSUE
    if (!PASSC) {
        float* sg = gp.SSEG + (size_t)(sidx + seg) * 8192 + tid * 16;
#pragma unroll
        for (int dt = 0; dt < 4; ++dt) *(f32x4*)(sg + 4 * dt) = accs[dt];
        if (tid < 8) {
#pragma unroll
            for (int e = 0; e < 8; ++e) gp.DSUM[(size_t)(sidx + seg) * 64 + 8 * apart + e] = dsum[e]; }
    }
    WGSYNC();
}

constexpr int LR_XC = 0, LR_XCF = 2304, LR_AA = 6400, LR_GG = 10496, LR_WAVE = 14592;
struct LruP { const bf16_t* P; const float* cw; const float* cb; const float* ba; const float* bx; const float* sp8; const bf16_t* lw; bf16_t* O; float* LST; };
template <bool PASSC>
__device__ __forceinline__ void lru_wave(LAS unsigned char* lw_, const LruP& lp, const int b, const int seg, const int n, const int l) {
    const int fr = l & 15, fq = l >> 4, ch = 64 * n + l;
    bf16x8 wB[8][2];
#pragma unroll
    for (int jt = 0; jt < 8; ++jt)
#pragma unroll
        for (int ks = 0; ks < 2; ++ks) wB[jt][ks] = *(const bf16x8*)(lp.lw + ((size_t)(n * 128 + 16 * jt + fr)) * 64 + 8 * fq + 32 * ks);
    const float w0 = lp.cw[ch], w1 = lp.cw[512 + ch], w2 = lp.cw[1024 + ch], w3 = lp.cw[1536 + ch], cbv = lp.cb[ch];
    float bav[4], bxv[4], spv[4];
#pragma unroll
    for (int jt = 0; jt < 4; ++jt) { const int c2 = 64 * n + 16 * jt + fr; bav[jt] = lp.ba[c2]; bxv[jt] = lp.bx[c2]; spv[jt] = lp.sp8[c2]; }
    const size_t rowb = (size_t)b * SEQ + seg * 128;
    float xm3 = 0.f, xm2 = 0.f, xm1 = 0.f;
    if (seg > 0) { xm3 = bf2f(lp.P[(rowb - 3) * PLD + P_LX + ch]); xm2 = bf2f(lp.P[(rowb - 2) * PLD + P_LX + ch]); xm1 = bf2f(lp.P[(rowb - 1) * PLD + P_LX + ch]); }
    float hst = 0.f, ap = 1.f;
    if (PASSC) { const float* st = lp.LST + ((size_t)b * NSEGL * 512 + ch) * 2;
        pg8::f32x2_ ah[31];
#pragma unroll
        for (int e = 0; e < 31; ++e) { const int sp = e < seg ? e : 0; ah[e] = *(const pg8::f32x2_*)(st + (size_t)sp * 1024); }
#pragma unroll
        for (int e = 0; e < 31; ++e) if (e < seg) hst = ah[e][0] * hst + ah[e][1]; }
    bf16_t xn[16], gn[16];
#pragma unroll
    for (int t = 0; t < 16; ++t) { xn[t] = lp.P[(rowb + t) * PLD + P_LX + ch]; gn[t] = PASSC ? lp.P[(rowb + t) * PLD + P_LG + ch] : (bf16_t)0; }
    for (int sb = 0; sb < 8; ++sb) {
        const size_t r0 = rowb + sb * 16;
        float xf[16], gr[16];
#pragma unroll
        for (int t = 0; t < 16; ++t) { xf[t] = bf2f(xn[t]); gr[t] = bf2f(gn[t]); }
        if (sb < 7) {
#pragma unroll
            for (int t = 0; t < 16; ++t) { xn[t] = lp.P[(r0 + 16 + t) * PLD + P_LX + ch]; if (PASSC) gn[t] = lp.P[(r0 + 16 + t) * PLD + P_LG + ch]; } }
#pragma unroll
        for (int t = 0; t < 16; ++t) { const float x0 = xf[t]; const float xc = cbv + w0 * xm3 + w1 * xm2 + w2 * xm1 + w3 * x0; xm3 = xm2; xm2 = xm1; xm1 = x0;
            *(LAS bf16_t*)(lw_ + LR_XC + t * 144 + l * 2) = f2bf(xc); *(LAS float*)(lw_ + LR_XCF + t * 256 + l * 4) = xc; }
        __builtin_amdgcn_wave_barrier();
        f32x4 acc[8];
#pragma unroll
        for (int jt = 0; jt < 8; ++jt) acc[jt] = (f32x4){0.f, 0.f, 0.f, 0.f};
#pragma unroll
        for (int ks = 0; ks < 2; ++ks) { const bf16x8 af = *(LAS const bf16x8*)(lw_ + LR_XC + fr * 144 + 16 * fq + 64 * ks);
#pragma unroll
            for (int jt = 0; jt < 8; ++jt) acc[jt] = __builtin_amdgcn_mfma_f32_16x16x32_bf16(af, wB[jt][ks], acc[jt], 0, 0, 0); }
#pragma unroll
        for (int jt = 0; jt < 4; ++jt)
#pragma unroll
            for (int r = 0; r < 4; ++r) { const int tok = 4 * fq + r, j = 16 * jt + fr;
                const float rg = sigmoid_f(acc[jt][r] + bav[jt]), ig = sigmoid_f(acc[4 + jt][r] + bxv[jt]);
                const float log_a = -rg * spv[jt]; const float av = __expf(log_a);
                const float xcv = *(LAS const float*)(lw_ + LR_XCF + tok * 256 + j * 4);
                *(LAS float*)(lw_ + LR_AA + tok * 256 + j * 4) = av; const float em = fmaf(-av, av, 1.f);
                *(LAS float*)(lw_ + LR_GG + tok * 256 + j * 4) = xcv * ig * sqrtf(fmaxf(em, 0.f)); }
        __builtin_amdgcn_wave_barrier();
#pragma unroll
        for (int t = 0; t < 16; ++t) { const float av = *(LAS const float*)(lw_ + LR_AA + t * 256 + l * 4), gv = *(LAS const float*)(lw_ + LR_GG + t * 256 + l * 4);
            hst = av * hst + gv; ap *= av;
            if (PASSC) lp.O[(r0 + t) * OLD + 1024 + ch] = f2bf(hst * gr[t]); }
        __builtin_amdgcn_wave_barrier();
    }
    if (!PASSC) { float* st = lp.LST + (((size_t)b * NSEGL + seg) * 512 + ch) * 2; st[0] = ap; st[1] = hst; }
}

constexpr int S5_BU = 0, S5_X = 8448, S5_WAVE = 8448 + 4352;
struct S5P { const bf16_t* P; const float* sm; const bf16_t* ct; const bf16_t* bbt; const float* a128; const float* dd; bf16_t* Y5; float* SST; };
template <bool PASSC>
__device__ __forceinline__ void s5_wave(LAS unsigned char* lw_, const S5P& sp_, const int b, const int seg, const int g, const int l) {
    const int fr = l & 15, fq = l >> 4;
    const bf16x8 zf = (bf16x8){0, 0, 0, 0, 0, 0, 0, 0};
    bf16x8 bbf[8];
#pragma unroll
    for (int mt = 0; mt < 8; ++mt) bbf[mt] = fq < 2 ? *(const bf16x8*)(sp_.bbt + ((size_t)(g * 128 + 16 * mt + fr)) * 16 + 8 * fq) : zf;
    const float abr = sp_.sm[SM_ABR + g * 64 + l], abi = sp_.sm[SM_ABI + g * 64 + l];
    float xr = 0.f, xi = 0.f;
    bf16x8 cf[4]; f32x4 dv4 = (f32x4){0.f, 0.f, 0.f, 0.f};
    if (PASSC) {
        const float ar = sp_.a128[(g * 64 + l) * 2], ai = sp_.a128[(g * 64 + l) * 2 + 1];
        const float* st = sp_.SST + ((size_t)b * NSEGS * 32 + g) * 128 + l;
        for (int sp0 = 0; sp0 < seg; sp0 += 8) { float er[8], ei[8];
#pragma unroll
            for (int e = 0; e < 8; ++e) { const int sp = sp0 + e < seg ? sp0 + e : seg - 1; er[e] = st[(size_t)sp * 4096]; ei[e] = st[(size_t)sp * 4096 + 64]; }
#pragma unroll
            for (int e = 0; e < 8; ++e) if (sp0 + e < seg) { const float nr = ar * xr - ai * xi + er[e], ni = ar * xi + ai * xr + ei[e]; xr = nr; xi = ni; } }
#pragma unroll
        for (int ks = 0; ks < 4; ++ks) cf[ks] = *(const bf16x8*)(sp_.ct + ((size_t)(g * 16 + fr)) * 128 + 8 * fq + 32 * ks);
        dv4 = *(const f32x4*)(sp_.dd + 16 * g + 4 * fq);
    }
    const size_t rowb = (size_t)b * SEQ + seg * 512;
    bf16x8 ufn = fq < 2 ? *(const bf16x8*)(sp_.P + (rowb + fr) * PLD + P_SU + 16 * g + 8 * fq) : zf;
    u32x2 usn = PASSC ? *(const u32x2*)(sp_.P + (rowb + fr) * PLD + P_SU + 16 * g + 4 * fq) : (u32x2){0u, 0u};
    for (int sb = 0; sb < 32; ++sb) {
        const size_t r0 = rowb + sb * 16;
        const bf16x8 uf = ufn; const u32x2 us = usn;
        if (sb < 31) { ufn = fq < 2 ? *(const bf16x8*)(sp_.P + (r0 + 16 + fr) * PLD + P_SU + 16 * g + 8 * fq) : zf;
            if (PASSC) usn = *(const u32x2*)(sp_.P + (r0 + 16 + fr) * PLD + P_SU + 16 * g + 4 * fq); }
#pragma unroll
        for (int mt = 0; mt < 8; ++mt) { f32x4 bu = (f32x4){0.f, 0.f, 0.f, 0.f}; bu = __builtin_amdgcn_mfma_f32_16x16x32_bf16(bbf[mt], uf, bu, 0, 0, 0);
            *(LAS f32x4*)(lw_ + S5_BU + fr * 528 + (16 * mt + 4 * fq) * 4) = bu; }
        __builtin_amdgcn_wave_barrier();
        pg8::f32x2_ buv[16];
#pragma unroll
        for (int t = 0; t < 16; ++t) buv[t] = *(LAS const pg8::f32x2_*)(lw_ + S5_BU + t * 528 + l * 8);
#pragma unroll
        for (int t = 0; t < 16; ++t) {
            const pg8::f32x2_ bu = buv[t];
            const float nr = abr * xr - abi * xi + bu[0], ni = abr * xi + abi * xr + bu[1]; xr = nr; xi = ni;
            if (PASSC) *(LAS unsigned*)(lw_ + S5_X + t * 272 + l * 4) = cvt_pk_bf16(xr, xi);
        }
        __builtin_amdgcn_wave_barrier();
        if (PASSC) {
            f32x4 acc = (f32x4){0.f, 0.f, 0.f, 0.f};
#pragma unroll
            for (int ks = 0; ks < 4; ++ks) { const bf16x8 xf = *(LAS const bf16x8*)(lw_ + S5_X + fr * 272 + 16 * fq + 64 * ks);
                acc = __builtin_amdgcn_mfma_f32_16x16x32_bf16(cf[ks], xf, acc, 0, 0, 0); }
            u32x2 yw; yw.x = cvt_pk_bf16(gelu_tanh_f(acc[0] + dv4[0] * bflo(us.x)), gelu_tanh_f(acc[1] + dv4[1] * bfhi(us.x))); yw.y = cvt_pk_bf16(gelu_tanh_f(acc[2] + dv4[2] * bflo(us.y)), gelu_tanh_f(acc[3] + dv4[3] * bfhi(us.y)));
            *(u32x2*)(sp_.Y5 + (r0 + fr) * BW + 16 * g + 4 * fq) = yw;
            __builtin_amdgcn_wave_barrier();
        }
    }
    if (!PASSC) { float* st = sp_.SST + (((size_t)b * NSEGS + seg) * 32 + g) * 128 + l; st[0] = xr; st[64] = xi; }
}

template <bool PASSC>
__device__ __forceinline__ void phase_mixers(LAS unsigned char* lds, const Args& a, const int l, const int G) {
    const int mmask = a.mmask;
    unsigned char* ws = a.ws; const float* sm = (const float*)(ws + WS_SMALL + (size_t)l * SMALL_STRIDE);
    const bf16_t* P = (const bf16_t*)(ws + WS_P); float* ST = (float*)(ws + WS_ST);
    if (mmask & 1) { GlaP gp0{P, (const float*)(ws + WS_LA), a.in[I_GNG] + l * 512, nullptr, (bf16_t*)(ws + WS_O), ST + ST_GSEG, ST + ST_GDS};
      GlaP gp1{P, (const float*)(ws + WS_LA), a.in[I_RNG] + l * 512, a.in[I_RNB] + l * 512, (bf16_t*)(ws + WS_O), ST + ST_GSEG, ST + ST_GDS};
      for (int itx = blockIdx.x; itx < 2 * BG * 4 * NSEGG; itx += G) { const int mix = itx / (BG * 4 * NSEGG), rest = itx % (BG * 4 * NSEGG), b = rest / (4 * NSEGG), h = (rest / NSEGG) & 3, seg = rest % NSEGG;
          const int sidx = ((mix * BG + b) * 4 + h) * NSEGG;
          if (!PASSC && seg == NSEGG - 1) continue;
          if (mix == 0) glaret_item<PASSC>(lds, gp0, true, b, h, seg, sidx); else glaret_item<PASSC>(lds, gp1, false, b, h, seg, sidx); } }
    int tid = threadIdx.x; asm volatile("" : "+v"(tid));
    const int w = __builtin_amdgcn_readfirstlane(tid >> 6), ln = tid & 63;
    if (mmask & 2) { LruP lp{P, a.in[I_LCW] + l * 2048, a.in[I_LCB] + l * 512, a.in[I_LBA] + l * 512, a.in[I_LBX] + l * 512, sm + SM_SP8, (const bf16_t*)((const unsigned char*)sm + SM_LRUW_BYTES), (bf16_t*)(ws + WS_O), ST + ST_LRU};
      for (int itx = blockIdx.x; itx < BG * NSEGL; itx += G) { if (!PASSC && itx % NSEGL == NSEGL - 1) continue; lru_wave<PASSC>(lds + w * LR_WAVE, lp, itx / NSEGL, itx % NSEGL, w, ln); } }
    if (mmask & 4) { S5P sp_{P, sm, (const bf16_t*)((const unsigned char*)sm + SM_CT_BYTES), (const bf16_t*)((const unsigned char*)sm + SM_BBT_BYTES), sm + SM_A128, a.in[I_SD] + l * 512, (bf16_t*)(ws + WS_Y5), ST + ST_S5};
      for (int itx = blockIdx.x; itx < BG * NSEGS * 4; itx += G) { if (!PASSC && (itx >> 2) % NSEGS == NSEGS - 1) continue; s5_wave<PASSC>(lds + w * LR_WAVE, sp_, itx / (NSEGS * 4), (itx >> 2) % NSEGS, 8 * (itx & 3) + w, ln); } }
    WGSYNC();
}

constexpr int NPH = 8, NSTEPS = 1 + NGRP * DEPTH * NPH;
constexpr int LDS_BYTES = 147456, LDS_MISC = 131072 + 320;

__global__ void __launch_bounds__(512, 2) mk_fwd(Args a) {
    __shared__ __attribute__((aligned(16))) unsigned char lds_raw[LDS_BYTES];
    LAS unsigned char* lds = (LAS unsigned char*)lds_raw;
    volatile LAS unsigned* MISC = (volatile LAS unsigned*)(lds + LDS_MISC);
    const int G = gridDim.x;
    if (threadIdx.x < 32) MISC[threadIdx.x] = 0u;
    __syncthreads();
    unsigned* ctl = (unsigned*)(a.ws + WS_CTL);
    XcdBarrier bar = xcd_barrier_post(ctl + CW_BAR + a.li * XCD_BAR_WORDS, MISC + 8);
    const int ngw = G * 8, gthreads = G * 512;
#define LTID(v) int v = threadIdx.x; asm volatile("" : "+v"(v))
#define IN(s) (a.s_lo <= (s) && (s) < a.s_hi)
#define SEAM(s) do { if ((s) + 1 < a.s_hi) xcd_barrier(bar); } while (0)
    if (IN(0)) { LTID(t_); phase_prologue(a, blockIdx.x * 512 + t_, gthreads); SEAM(0); }
    for (int gl = 0; gl < NGRP * DEPTH; ++gl) {
        const int grp = gl >> 2, l = gl & 3, s0 = 1 + gl * NPH;
        if (a.s_hi <= s0 || a.s_lo >= s0 + NPH) continue;
        unsigned char* ws = a.ws;
        const bf16_t* Wl = (const bf16_t*)(ws + WS_W + (size_t)l * W_STRIDE);
        const float* sm = (const float*)(ws + WS_SMALL + (size_t)l * SMALL_STRIDE);
        bf16_t* U = (bf16_t*)(ws + WS_U); bf16_t* P = (bf16_t*)(ws + WS_P); float* LA = (float*)(ws + WS_LA);
        bf16_t* O = (bf16_t*)(ws + WS_O); bf16_t* Y5 = (bf16_t*)(ws + WS_Y5); unsigned char* PGb = ws + WS_PG;
        const float* xg = a.in[I_X] + (size_t)grp * TG * D; float* og = a.out + (size_t)grp * TG * D;
        const float* hin = (l <= 1) ? xg : og;
        bf16_t* DLT = (bf16_t*)(ws + WS_O);
        (void)sm;
        if (IN(s0 + 0)) { LTID(t_); const int gw_ = blockIdx.x * 8 + __builtin_amdgcn_readfirstlane(t_ >> 6);
            if (l == 0) phase_norm<false, false>(hin, DLT, og, a.in[I_NG] + l * D, U, gw_, ngw, t_ & 63); else phase_norm<false, true>(hin, DLT, og, a.in[I_NG] + l * D, U, gw_, ngw, t_ & 63);
            SEAM(s0 + 0); }
        if (IN(s0 + 1)) {
            pg8::Gemm g{U, Wl, TG, N_ALL, D, D, D, 0, 0}; pg8::StaticOrder S; S.init(TG, N_ALL, G, (int)blockIdx.x, 0, 256, WGM_G1);
            EpiIn E{P, LA, a.in[I_GBLR] + l * 256, (const float*)(ws + WS_ROT), PGb};
            GEMM_CALL(EpiIn);
            SEAM(s0 + 1);
        }
        if (IN(s0 + 2)) { phase_mixers<false>(lds, a, l, G); SEAM(s0 + 2); }
        if (IN(s0 + 3)) { phase_mixers<true>(lds, a, l, G); SEAM(s0 + 3); }
        if (IN(s0 + 4)) {
            { pg8::Gemm g{Y5, (const bf16_t*)((const unsigned char*)Wl + WO_GLU), TG, BW, BW, BW, BW, 0, 0}; pg8::StaticOrder S; S.init(TG, BW, G, (int)blockIdx.x, 0, 256, WGM_GLU);
              EpiGlu E{Y5, P, a.in[I_SGB] + l * BW, O};
              GEMM_CALL(EpiGlu); }
            SEAM(s0 + 4);
        }
        if (IN(s0 + 6)) {
            { pg8::Gemm g{O, (const bf16_t*)((const unsigned char*)Wl + WO_BR), TG, D, BW, OLD, BW, (size_t)BW * 2, (size_t)D * BW * 2}; pg8::StaticOrder S; S.init(TG, D, G, (int)blockIdx.x, 2, 128, WGM_G2);
              EpiBr E{PGb, U};
              pg8::gemm_phase<EpiBr, pg8::StaticOrder, true, true, true>(lds, g, S, E); }
            SEAM(s0 + 6);
        }
        if (IN(s0 + 7)) {
            if (a.fin != 2) { pg8::Gemm g{U, (const bf16_t*)((const unsigned char*)Wl + WO_OUT), TG, D, D, D, D, 0, 0}; pg8::StaticOrder S; S.init(TG, D, G, (int)blockIdx.x, 0, 256, WGM_G3);
              EpiOut E{DLT};
              GEMM_CALL(EpiOut); }
            if (l == 3 && a.fin) { if (a.fin == 1) xcd_barrier(bar); LTID(t_); phase_norm<true, true>(og, DLT, og, a.in[I_FNG], U, blockIdx.x * 8 + __builtin_amdgcn_readfirstlane(t_ >> 6), ngw, t_ & 63); }
            SEAM(s0 + 7);
        }
    }
#undef IN
#undef SEAM
}

extern "C" void kernel_launch(void* const* d_in, const int* in_sizes, int n_in, void* d_out, int out_size, void* d_ws, size_t ws_size, hipStream_t stream) {
    static int grid = 0;
    if (grid == 0) {
        static const int exp_sizes[29] = {67108864, 4096, 21037056, 16384, 1024, 2048, 2048, 2048, 8192, 2048, 131072, 2048, 131072, 2048, 2048, 8192, 8192, 131072, 131072, 131072, 131072, 2048, 128, 1048576, 2048, 16777216, 8388608, 4194304, 1024};
        bool ok_sizes = (n_in == 29); if (ok_sizes) for (int i = 0; i < 29; ++i) if (in_sizes[i] != exp_sizes[i]) { fprintf(stderr, "kernel_launch: input %d has %d elements, expected %d\n", i, in_sizes[i], exp_sizes[i]); ok_sizes = false; }
        if (!ok_sizes || out_size != NB * SEQ * D || ws_size < WS_END) { fprintf(stderr, "kernel_launch: unexpected shapes (n_in %d out %d ws %zu)\n", n_in, out_size, ws_size); grid = -1; return; }
        int dev = 0, cus = 0, per_cu = 0;
        hipGetDevice(&dev); hipDeviceGetAttribute(&cus, hipDeviceAttributeMultiprocessorCount, dev);
        hipOccupancyMaxActiveBlocksPerMultiprocessor(&per_cu, (const void*)mk_fwd, 512, 0);
        (void)hipGetLastError();
        grid = cus > 0 ? cus : 256;
        if (per_cu < 1) fprintf(stderr, "kernel_launch: occupancy query says %d\n", per_cu);
    }
    if (grid < 0) return;
    hipMemsetAsync((char*)d_ws + WS_CTL, 0, CTL_BYTES, stream);
    Args a{};
    for (int i = 0; i < 29; ++i) a.in[i] = (const float*)d_in[i];
    a.out = (float*)d_out; a.ws = (unsigned char*)d_ws;
    unsigned char* ws = (unsigned char*)d_ws;
    int li = 0;
    auto run = [&](int lo, int hi, int fin = 1, int mm = 7) { a.s_lo = lo; a.s_hi = hi; a.li = li++; a.fin = fin; a.mmask = mm; a.pad2 = 0; hipLaunchKernelGGL(mk_fwd, dim3(grid), dim3(512), 0, stream, a); };
    run(0, NSTEPS);
}
```

```cpp
#include <hip/hip_runtime.h>
#ifndef WGM_G1
#define WGM_G1 4
#endif
#ifndef WGM_G2
#define WGM_G2 8
#endif
#ifndef WGM_G3
#define WGM_G3 8
#endif
#ifndef WGM_GLU
#define WGM_GLU 8
#endif
#include <cstdio>
#include <cstdint>
#if defined(__HIP_DEVICE_COMPILE__)
#pragma clang attribute push(__attribute__((target("no-packed-fp32-ops"))), apply_to = function)
#endif


namespace pg8 {
#define PG8_LAS __attribute__((address_space(3)))
typedef unsigned short bf16_t;
typedef short bf16x8 __attribute__((ext_vector_type(8)));
typedef float f32x4 __attribute__((ext_vector_type(4)));
typedef unsigned u32x4 __attribute__((ext_vector_type(4)));
typedef unsigned u32x2 __attribute__((ext_vector_type(2)));
constexpr int BM = 256, BK = 64, HALF = 128, HTB = HALF * BK * 2, STAGE_BYTES = 8 * HTB, NXCD = 8;

__host__ __device__ __forceinline__ int lds_byte(int r, int c) { const int st = (r >> 4) * 2 + (c >> 5), rr = r & 15, cc = c & 31, ob = rr * 64 + cc * 2; return st * 1024 + (ob ^ (((ob >> 9) & 1) << 5)); }
__host__ __device__ __forceinline__ void stage_rc(int b, int& R, int& C) { const int st = b / 1024, sb = b % 1024, swz = sb ^ (((sb >> 9) & 1) << 5); R = (st >> 1) * 16 + swz / 64; C = (st & 1) * 32 + (swz % 64) / 2; }
__host__ __device__ __forceinline__ int perm32(int rho) { const int n = rho >> 4, i = rho & 15; return 8 * (i >> 2) + 4 * n + (i & 3); }

struct Unit { int pm, pn, z; };
struct Gemm { const bf16_t* A; const bf16_t* Bt; int M, N, K, lda, ldb; size_t zA, zB; };

struct StaticOrder {
    int nM, nN, nwg, G, c, zsh, WGM;
    __host__ __device__ void init(int M, int N, int G_, int c_, int zsh_ = 0, int bn_ = BM, int wgm_ = 4) { nM = M / BM; nN = N / bn_; nwg = nM * nN; G = G_; c = c_; zsh = zsh_; WGM = wgm_; }
    __host__ __device__ bool next(int i, Unit& u) const {
        const int ti = i >> zsh; u.z = i & ((1 << zsh) - 1);
        const long L = (long)ti * G + c; if (L >= nwg) return false;
        int wgid = (int)L; { const int q = nwg / NXCD, r = nwg % NXCD, xcd = wgid % NXCD, off = wgid / NXCD; wgid = (xcd < r ? xcd * (q + 1) : r * (q + 1) + (xcd - r) * q) + off; }
        const int nig = WGM * nN, gid = wgid / nig, fm = gid * WGM, gsz = (nM - fm) < WGM ? (nM - fm) : WGM;
        u.pm = fm + ((wgid % nig) % gsz); u.pn = (wgid % nig) / gsz; return true;
    }
    __device__ __forceinline__ void a_ready(const Unit&) const {}
    __device__ __forceinline__ void done(const Unit&) const {}
};

typedef float f32x2_ __attribute__((ext_vector_type(2)));
typedef __bf16 bf16x2_ __attribute__((ext_vector_type(2)));
__device__ __forceinline__ unsigned cvt_pk_bf16(float lo, float hi) { const f32x2_ v = {lo, hi}; const bf16x2_ b = __builtin_convertvector(v, bf16x2_); return __builtin_bit_cast(unsigned, b); }

template <class Epi, class Sched, bool ALIGN_EPI = false, bool SP2 = false, bool HALFN = false>
__device__ __forceinline__ void gemm_phase(PG8_LAS unsigned char* lds, const Gemm g, const Sched& S, const Epi& E) {
    int tid = threadIdx.x; asm volatile("" : "+v"(tid));
    const int wid = __builtin_amdgcn_readfirstlane(tid >> 6), lane = tid & 63, wr = wid >> 2, wc = wid & 3, fr = lane & 15, fq = lane >> 4;
    const int K = g.K, nt = K / BK;
    unsigned voffA[2], voffB[2];
#pragma unroll
    for (int i = 0; i < 2; ++i) { int R, C; stage_rc(tid * 16 + i * 8192, R, C); const int Rb = Epi::PERM ? ((R & ~31) + perm32(R & 31)) : R;
        voffA[i] = (unsigned)(R * g.lda + C) * 2u; voffB[i] = (unsigned)(Rb * g.ldb + C) * 2u; }
    const size_t kstep = (size_t)(BK * 2);
    const size_t hstepA = (size_t)HALF * g.lda * 2, hstepB = (size_t)HALF * g.ldb * 2;
    const size_t tstepA = 2 * hstepA, tstepB = HALFN ? hstepB : 2 * hstepB;
    const unsigned ldsw = (unsigned)wid * 1024u;
    unsigned aoff = (unsigned)lds_byte(wr * 64 + fr, fq * 8), boff = (unsigned)lds_byte(wc * 32 + fr, fq * 8) + 4u * HTB;
    asm volatile("" : "+v"(aoff), "+v"(boff));
#define PG8_SA(b, h) (((b) * 2 + (h)) * HTB)
#define PG8_SB(b, h) ((4 + (b) * 2 + (h)) * HTB)
#define PG8_STAGE(bufoff, gbase, voff) do { _Pragma("unroll") for (int _i = 0; _i < 2; ++_i) \
        __builtin_amdgcn_global_load_lds((const unsigned*)((const char*)(gbase) + (voff)[_i]), (PG8_LAS unsigned*)(lds + (bufoff) + ldsw + _i * 8192), 16, 0, 0); } while (0)
#define PG8_LDA(dst, b, h) do { _Pragma("unroll") for (int m = 0; m < 4; ++m) _Pragma("unroll") for (int k = 0; k < 2; ++k) dst[m][k] = *(const PG8_LAS bf16x8*)(lds + aoff + (PG8_SA(b, h) + m * 2048 + k * 1024)); } while (0)
#define PG8_LDB(dst, b, h) do { _Pragma("unroll") for (int n = 0; n < 2; ++n) _Pragma("unroll") for (int k = 0; k < 2; ++k) dst[n][k] = *(const PG8_LAS bf16x8*)(lds + boff + (((b) * 2 + (h)) * HTB + n * 2048 + k * 1024)); } while (0)
#define PG8_MMA(ai, bj, At, Bt) do { __builtin_amdgcn_s_setprio(1); _Pragma("unroll") for (int m = 0; m < 4; ++m) _Pragma("unroll") for (int n = 0; n < 2; ++n) _Pragma("unroll") for (int k = 0; k < 2; ++k) \
        acc[ai][bj][m][n] = __builtin_amdgcn_mfma_f32_16x16x32_bf16(Bt[n][k], At[m][k], acc[ai][bj][m][n], 0, 0, 0); __builtin_amdgcn_s_setprio(0); } while (0)
#define PG8_WAIT_V(n) asm volatile("s_waitcnt vmcnt(" #n ")" ::: "memory")
#define PG8_WAIT_L(n) asm volatile("s_waitcnt lgkmcnt(" #n ")" ::: "memory")
#define PG8_BAR __builtin_amdgcn_s_barrier()
#define PG8_SCHED __builtin_amdgcn_sched_barrier(0)
    Unit cur, nxt; int ui = 0;
    if (!S.next(0, cur)) return;
    f32x4 acc[2][2][4][2];
#pragma unroll
    for (int a = 0; a < 2; ++a)
#pragma unroll
        for (int b = 0; b < 2; ++b)
#pragma unroll
            for (int m = 0; m < 4; ++m)
#pragma unroll
                for (int n = 0; n < 2; ++n) acc[a][b][m][n] = (f32x4){0.f, 0.f, 0.f, 0.f};
    bf16x8 At[4][2], B0[2][2], B1[2][2];
    const char* cA = (const char*)g.A + (size_t)cur.pm * tstepA + (size_t)cur.z * g.zA; const char* cB = (const char*)g.Bt + (size_t)cur.pn * tstepB + (size_t)cur.z * g.zB;
    S.a_ready(cur);
    if constexpr (SP2 && HALFN) {
        PG8_STAGE(PG8_SB(0, 0), cB, voffB); PG8_STAGE(PG8_SA(0, 0), cA, voffA); PG8_STAGE(PG8_SA(0, 1), cA + hstepA, voffA);
        if (wr == 1) PG8_BAR;
        PG8_WAIT_V(2); PG8_BAR;
        PG8_STAGE(PG8_SB(1, 0), cB + kstep, voffB); PG8_STAGE(PG8_SA(1, 0), cA + kstep, voffA);
        PG8_WAIT_V(4); PG8_BAR;
    } else if constexpr (SP2) {
        PG8_STAGE(PG8_SB(0, 0), cB, voffB); PG8_STAGE(PG8_SB(0, 1), cB + hstepB, voffB); PG8_STAGE(PG8_SA(0, 0), cA, voffA); PG8_STAGE(PG8_SA(0, 1), cA + hstepA, voffA);
        if (wr == 1) PG8_BAR;
        PG8_WAIT_V(2); PG8_BAR;
        PG8_STAGE(PG8_SB(1, 0), cB + kstep, voffB); PG8_STAGE(PG8_SA(1, 0), cA + kstep, voffA); PG8_STAGE(PG8_SB(1, 1), cB + hstepB + kstep, voffB);
        PG8_WAIT_V(6); PG8_BAR;
    } else {
        PG8_STAGE(PG8_SB(0, 0), cB, voffB); PG8_STAGE(PG8_SA(0, 0), cA, voffA); PG8_STAGE(PG8_SB(0, 1), cB + hstepB, voffB); PG8_STAGE(PG8_SA(0, 1), cA + hstepA, voffA);
        if (wr == 1) PG8_BAR;
        PG8_WAIT_V(4); PG8_BAR;
        PG8_STAGE(PG8_SB(1, 0), cB + kstep, voffB); PG8_STAGE(PG8_SA(1, 0), cA + kstep, voffA); PG8_STAGE(PG8_SB(1, 1), cB + hstepB + kstep, voffB);
        PG8_WAIT_V(6); PG8_BAR;
    }
    for (;;) {
        const bool has_next = S.next(ui + 1, nxt);
        const char* nA = has_next ? (const char*)g.A + (size_t)nxt.pm * tstepA + (size_t)nxt.z * g.zA : cA; const char* nB = has_next ? (const char*)g.Bt + (size_t)nxt.pn * tstepB + (size_t)nxt.z * g.zB : cB;
        for (int t = 0; t < nt; t += 2) {
            const bool last = (t == nt - 2);
            const char* a1 = cA + (size_t)(t + 1) * kstep;
            const char* a2 = last ? nA : cA + (size_t)(t + 2) * kstep; const char* b2 = last ? nB : cB + (size_t)(t + 2) * kstep;
            const char* a3 = a2 + kstep; const char* b3 = b2 + kstep;
            if (last && has_next) S.a_ready(nxt);
            if constexpr (SP2 && HALFN) {
            PG8_LDB(B0, 0, 0); PG8_SCHED; PG8_LDA(At, 0, 0); PG8_STAGE(PG8_SA(1, 1), a1 + hstepA, voffA);
            PG8_WAIT_V(6); PG8_WAIT_L(0); PG8_BAR; PG8_MMA(0, 0, At, B0); PG8_BAR; PG8_SCHED;
            PG8_LDA(At, 0, 1); PG8_STAGE(PG8_SB(0, 0), b2, voffB); PG8_STAGE(PG8_SA(0, 0), a2, voffA);
            PG8_WAIT_V(6); PG8_WAIT_L(0); PG8_BAR; PG8_MMA(1, 0, At, B0); PG8_BAR; PG8_SCHED;
            PG8_LDB(B0, 1, 0); PG8_SCHED; PG8_LDA(At, 1, 0); PG8_STAGE(PG8_SA(0, 1), a2 + hstepA, voffA);
            PG8_WAIT_V(6); PG8_WAIT_L(0); PG8_BAR; PG8_MMA(0, 0, At, B0); PG8_BAR; PG8_SCHED;
            PG8_LDA(At, 1, 1); PG8_STAGE(PG8_SB(1, 0), b3, voffB); PG8_STAGE(PG8_SA(1, 0), a3, voffA);
            PG8_WAIT_V(6); PG8_WAIT_L(0); PG8_BAR; PG8_MMA(1, 0, At, B0); PG8_BAR; PG8_SCHED;
            } else if constexpr (SP2) {
            PG8_LDB(B0, 0, 0); PG8_LDB(B1, 0, 1); PG8_SCHED; PG8_LDA(At, 0, 0); PG8_STAGE(PG8_SA(1, 1), a1 + hstepA, voffA);
            PG8_WAIT_V(8); PG8_WAIT_L(0); PG8_BAR; PG8_MMA(0, 0, At, B0); PG8_MMA(0, 1, At, B1); PG8_BAR; PG8_SCHED;
            PG8_LDA(At, 0, 1); PG8_STAGE(PG8_SB(0, 0), b2, voffB); PG8_STAGE(PG8_SB(0, 1), b2 + hstepB, voffB); PG8_STAGE(PG8_SA(0, 0), a2, voffA);
            PG8_WAIT_V(8); PG8_WAIT_L(0); PG8_BAR; PG8_MMA(1, 0, At, B0); PG8_MMA(1, 1, At, B1); PG8_BAR; PG8_SCHED;
            PG8_LDB(B0, 1, 0); PG8_LDB(B1, 1, 1); PG8_SCHED; PG8_LDA(At, 1, 0); PG8_STAGE(PG8_SA(0, 1), a2 + hstepA, voffA);
            PG8_WAIT_V(8); PG8_WAIT_L(0); PG8_BAR; PG8_MMA(0, 0, At, B0); PG8_MMA(0, 1, At, B1); PG8_BAR; PG8_SCHED;
            PG8_LDA(At, 1, 1); PG8_STAGE(PG8_SB(1, 0), b3, voffB); PG8_STAGE(PG8_SB(1, 1), b3 + hstepB, voffB); PG8_STAGE(PG8_SA(1, 0), a3, voffA);
            PG8_WAIT_V(8); PG8_WAIT_L(0); PG8_BAR; PG8_MMA(1, 0, At, B0); PG8_MMA(1, 1, At, B1); PG8_BAR; PG8_SCHED;
            } else {
            PG8_LDB(B0, 0, 0); PG8_SCHED; PG8_LDA(At, 0, 0); PG8_STAGE(PG8_SA(1, 1), a1 + hstepA, voffA);
            PG8_WAIT_L(8); PG8_BAR; PG8_WAIT_L(0); PG8_MMA(0, 0, At, B0); PG8_BAR; PG8_SCHED;
            PG8_LDB(B1, 0, 1); PG8_STAGE(PG8_SB(0, 0), b2, voffB);
            PG8_BAR; PG8_WAIT_L(0); PG8_MMA(0, 1, At, B1); PG8_BAR;
            PG8_LDA(At, 0, 1); PG8_STAGE(PG8_SA(0, 0), a2, voffA);
            PG8_BAR; PG8_WAIT_L(0); PG8_MMA(1, 0, At, B0); PG8_BAR; PG8_SCHED;
            PG8_STAGE(PG8_SB(0, 1), b2 + hstepB, voffB);
            PG8_WAIT_V(6); PG8_BAR; PG8_MMA(1, 1, At, B1); PG8_BAR;
            PG8_LDB(B0, 1, 0); PG8_SCHED; PG8_LDA(At, 1, 0); PG8_STAGE(PG8_SA(0, 1), a2 + hstepA, voffA);
            PG8_WAIT_L(8); PG8_BAR; PG8_WAIT_L(0); PG8_MMA(0, 0, At, B0); PG8_BAR; PG8_SCHED;
            PG8_LDB(B1, 1, 1); PG8_STAGE(PG8_SB(1, 0), b3, voffB);
            PG8_BAR; PG8_WAIT_L(0); PG8_MMA(0, 1, At, B1); PG8_BAR;
            PG8_LDA(At, 1, 1); PG8_STAGE(PG8_SA(1, 0), a3, voffA);
            PG8_BAR; PG8_WAIT_L(0); PG8_MMA(1, 0, At, B0); PG8_BAR; PG8_SCHED;
            PG8_STAGE(PG8_SB(1, 1), b3 + hstepB, voffB);
            PG8_WAIT_V(6); PG8_BAR; PG8_MMA(1, 1, At, B1); PG8_BAR;
            }
        }
        if constexpr (ALIGN_EPI) { if (wr == 0) PG8_BAR; }
        { int fr_e = fr, fq_e = fq; asm volatile("" : "+v"(fr_e), "+v"(fq_e));
          E(acc, cur, wr, wc, fr_e, fq_e); }
        if (!has_next) break;
        if (!HALFN && !(Epi::KEEP && cur.z != 3)) {
#pragma unroll
        for (int a = 0; a < 2; ++a)
#pragma unroll
            for (int b = 0; b < 2; ++b)
#pragma unroll
                for (int m = 0; m < 4; ++m)
#pragma unroll
                    for (int n = 0; n < 2; ++n) acc[a][b][m][n] = (f32x4){0.f, 0.f, 0.f, 0.f};
        }
        cur = nxt; cA = nA; cB = nB; ++ui;
        if constexpr (ALIGN_EPI) { if (wr == 1) PG8_BAR; }
    }
    PG8_WAIT_V(0);
    if constexpr (!ALIGN_EPI) { if (wr == 0) PG8_BAR; }
    PG8_BAR;
#undef PG8_SA
#undef PG8_SB
#undef PG8_STAGE
#undef PG8_LDA
#undef PG8_LDB
#undef PG8_MMA
#undef PG8_WAIT_V
#undef PG8_WAIT_L
#undef PG8_BAR
#undef PG8_SCHED
}

}

using pg8::bf16_t; using pg8::f32x4; using pg8::u32x4; using pg8::u32x2; using pg8::bf16x8; using pg8::cvt_pk_bf16;
#define LAS __attribute__((address_space(3)))

constexpr int D = 1024, SEQ = 4096, NB = 16, DEPTH = 4, BW = 512;
constexpr int NGRP = 2, BG = NB / NGRP, TG = BG * SEQ;
constexpr int N_IN = 21 * 256, N_MG = 4096, N_ALL = N_IN + N_MG;
constexpr int PLD = 20 * 256;
constexpr int P_GQ = 0, P_GK = 256, P_GV = 512, P_GG = 1024, P_RQ = 1536, P_RK = 1792, P_RV = 2048, P_RG = 2560, P_LX = 3072, P_LG = 3584, P_SU = 4096, P_SG = 4608;
constexpr int OLD = 2048;
constexpr float NORM_EPS = 1e-6f;

constexpr size_t MiB = 1u << 20;
constexpr size_t WS_CTL = 0, CTL_BYTES = 2 * MiB;
constexpr size_t WS_ROT = 2 * MiB;
constexpr size_t WS_SMALL = 3 * MiB, SMALL_STRIDE = 1 * MiB;
constexpr size_t WS_W = 8 * MiB, W_STRIDE = 26 * MiB;
constexpr size_t WO_IN = 0, WO_BR = (size_t)N_ALL * D * 2, WO_OUT = WO_BR + (size_t)4 * D * BW * 2, WO_GLU = WO_OUT + (size_t)D * D * 2, WO_END = WO_GLU + (size_t)BW * BW * 2;
static_assert(WO_END <= W_STRIDE, "weights");
constexpr size_t WS_U = 112 * MiB;
constexpr size_t WS_P = 176 * MiB;
constexpr size_t WS_LA = 496 * MiB;
constexpr size_t WS_O = 528 * MiB;
constexpr size_t WS_Y5 = 656 * MiB;
constexpr size_t WS_PG = 688 * MiB;
constexpr size_t WS_S5D = 816 * MiB;
constexpr size_t WS_S5M = 820 * MiB, S5M_BYTES = 86016;
constexpr size_t WS_SU2 = 832 * MiB;
constexpr size_t WS_ST = 944 * MiB;
constexpr size_t WS_END = 1008 * MiB;
constexpr int SM_ABR = 0, SM_ABI = 2048, SM_BBR = 4096, SM_BBI = 4096 + 32768, SM_SP8 = 4096 + 65536, SM_END_F = SM_SP8 + 512;
constexpr int SM_A128 = SM_END_F;
constexpr int SM_A8 = SM_A128 + 4096;
constexpr size_t SM_LRUW_BYTES = 512 * 1024, SM_CT_BYTES = 640 * 1024, SM_BBT_BYTES = 768 * 1024;
static_assert((size_t)(SM_END_F + 8192) * 4 <= SM_LRUW_BYTES, "small");

constexpr int CW_BAR = 4096;
#define XB_TMO      128
#define XB_XCNT(j)  (256  + 64 * (j))
#define XB_XSUB(j)  (1280 + 64 * (j))
#define XB_XGEN(j)  (2304 + 64 * (j))
#define XB_TOP      3328
#define XB_TOPGEN   3392
#define XCD_BAR_WORDS 3456
#define XB_SPIN_CAP (1u << 18)

__device__ __forceinline__ void wg_syncthreads() { __builtin_amdgcn_fence(__ATOMIC_RELEASE, "workgroup"); __builtin_amdgcn_s_barrier(); __builtin_amdgcn_fence(__ATOMIC_ACQUIRE, "workgroup"); }
__device__ __forceinline__ unsigned xb_ld(unsigned* p)              { return __hip_atomic_load(p, __ATOMIC_RELAXED, __HIP_MEMORY_SCOPE_AGENT); }
__device__ __forceinline__ unsigned xb_add(unsigned* p, unsigned v) { return __hip_atomic_fetch_add(p, v, __ATOMIC_RELAXED, __HIP_MEMORY_SCOPE_AGENT); }
__device__ __forceinline__ unsigned xb_xcc_id() { return (unsigned)__builtin_amdgcn_s_getreg((3 << 11) | 20) & 0xFu; }
#define XB_SPIN(cond, bar) do { unsigned _sp = 0; while (cond) { __builtin_amdgcn_s_sleep(1); \
    if ((++_sp & 255u) == 0u) { if (xb_ld(&(bar)[XB_TMO])) break; if (_sp > XB_SPIN_CAP) { (void)xb_add(&(bar)[XB_TMO], 1u); break; } } } } while (0)
struct XcdBarrier { unsigned* bar; unsigned x; volatile LAS unsigned* st; };
__device__ __forceinline__ XcdBarrier xcd_barrier_post(unsigned* bar, volatile LAS unsigned* st) {
    XcdBarrier b; b.bar = bar; b.x = xb_xcc_id(); b.st = st;
    if (threadIdx.x == 0) (void)xb_add(&bar[XB_XCNT(b.x)], 1u);
    return b;
}
__device__ __forceinline__ void xcd_barrier_complete(unsigned* bar, unsigned x, unsigned& nloc, unsigned& nx) {
    const unsigned G = gridDim.x * gridDim.y * gridDim.z;
    unsigned sum, cnt, mine, sp = 0u;
    for (;;) {
        sum = 0u; cnt = 0u; mine = 0u;
#pragma unroll
        for (unsigned j = 0; j < 16; ++j) { const unsigned c = xb_ld(&bar[XB_XCNT(j)]); sum += c; cnt += (c > 0u) ? 1u : 0u; mine = (j == x) ? c : mine; }
        if (sum == G) break;
        __builtin_amdgcn_s_sleep(1);
        if ((++sp & 255u) == 0u) { if (xb_ld(&bar[XB_TMO])) break; if (sp > XB_SPIN_CAP) { (void)xb_add(&bar[XB_TMO], 1u); break; } }
    }
    nloc = mine > 0u ? mine : 1u; nx = cnt > 0u ? cnt : 1u;
}
__device__ __forceinline__ void xcd_barrier(const XcdBarrier& b) {
    asm volatile("s_waitcnt vmcnt(0)" ::: "memory");
    wg_syncthreads();
    if (threadIdx.x == 0) {
        unsigned* bar = b.bar;
        __builtin_amdgcn_s_waitcnt(0);
        unsigned nloc = b.st[0], nx = b.st[1];
        if (nloc == 0u) { xcd_barrier_complete(bar, b.x, nloc, nx); b.st[0] = nloc; b.st[1] = nx; }
        const unsigned old = xb_add(&bar[XB_XSUB(b.x)], 1u);
        const unsigned gen = old / nloc;
        if (old + 1u == (gen + 1u) * nloc) {
            __builtin_amdgcn_fence(__ATOMIC_RELEASE, "agent");
            asm volatile("s_waitcnt vmcnt(0)" ::: "memory");
            const unsigned og = xb_add(&bar[XB_TOP], 1u);
            const unsigned tg = og / nx;
            if (og + 1u == (tg + 1u) * nx) xb_add(&bar[XB_TOPGEN], 1u);
            else XB_SPIN(xb_ld(&bar[XB_TOPGEN]) == tg, bar);
            __builtin_amdgcn_fence(__ATOMIC_ACQUIRE, "agent");
            xb_add(&bar[XB_XGEN(b.x)], 1u);
            asm volatile("s_waitcnt vmcnt(0)" ::: "memory");
        } else {
            XB_SPIN(xb_ld(&bar[XB_XGEN(b.x)]) == gen, bar);
            __builtin_amdgcn_fence(__ATOMIC_ACQUIRE, "agent");
            asm volatile("s_waitcnt vmcnt(0)" ::: "memory");
        }
    }
    wg_syncthreads();
}

__device__ __forceinline__ float bf2f(bf16_t b) { return __builtin_bit_cast(float, ((unsigned)b) << 16); }
__device__ __forceinline__ float bflo(unsigned w) { return __builtin_bit_cast(float, w << 16); }
__device__ __forceinline__ float bfhi(unsigned w) { return __builtin_bit_cast(float, w & 0xffff0000u); }
__device__ __forceinline__ bf16_t f2bf(float f) { return (bf16_t)(cvt_pk_bf16(f, 0.f) & 0xffffu); }
__device__ __forceinline__ float sigmoid_f(float x) { return __builtin_amdgcn_rcpf(1.f + __expf(-x)); }
__device__ __forceinline__ float silu_f(float x) { return x * sigmoid_f(x); }
__device__ __forceinline__ float silu_t(float t) { return t * __builtin_amdgcn_rcpf(__builtin_fmaf(__builtin_amdgcn_exp2f(t), -1.4426950408889634f, -1.4426950408889634f)); }
__device__ __forceinline__ float sig255(float t) { return __builtin_amdgcn_rcpf(__builtin_fmaf(__builtin_amdgcn_exp2f(t), 1.f / 255.f, 1.f / 255.f)); }
__device__ __forceinline__ float gelu_tanh_f(float x) { const float u = 0.7978845608028654f * (x + 0.044715f * x * x * x); const float t = 1.f - 2.f * __builtin_amdgcn_rcpf(1.f + __expf(2.f * u)); return 0.5f * x * (1.f + t); }
__device__ __forceinline__ float shfl_xor_f(float v, int m) { const int ln = (int)__builtin_amdgcn_mbcnt_hi(~0u, __builtin_amdgcn_mbcnt_lo(~0u, 0u)); return __builtin_bit_cast(float, __builtin_amdgcn_ds_bpermute((ln ^ m) << 2, __builtin_bit_cast(int, v))); }
__device__ __forceinline__ float wave_sum(float v) {
#pragma unroll
    for (int o = 1; o < 64; o <<= 1) v += shfl_xor_f(v, o);
    return v;
}

#define GEMM_CALL(EPI) pg8::gemm_phase<EPI, pg8::StaticOrder, true, true>(lds, g, S, E)
struct Args {
    const float* in[29]; float* out; unsigned char* ws;
    int s_lo, s_hi, li, fin, mmask, pad2;
};
enum { I_X = 0, I_NG, I_WIN, I_GWLR, I_GBLR, I_GNG, I_RNG, I_RNB, I_LCW, I_LCB, I_LWA, I_LBA, I_LWX, I_LBX, I_LLAM,
       I_SARE, I_SAIM, I_SBRE, I_SBIM, I_SCRE, I_SCIM, I_SD, I_SLDT, I_SGW, I_SGB, I_WMG, I_WBR, I_WOUT, I_FNG };

struct EpiIn {
    static constexpr bool PERM = true, AFTER_DRAIN = false, KEEP = false;
    bf16_t* P; float* LA; const float* blr; const float* rot; unsigned char* PG; bf16_t* SU;
    __device__ __forceinline__ void operator()(f32x4 (&acc)[2][2][4][2], const pg8::Unit& u, int wr, int wc, int fr, int fq) const {
        const int pn = u.pn, row0 = u.pm * 256 + wr * 64 + fr, cl = wc * 32 + 8 * fq;
        if (pn >= 21) {
#pragma unroll
            for (int ai = 0; ai < 2; ++ai)
#pragma unroll
                for (int m = 0; m < 4; ++m) { int row = row0 + ai * 128 + m * 16; asm volatile("" : "+v"(row));
                    u32x4 w;
#pragma unroll
                    for (int bj = 0; bj < 2; ++bj) { const f32x4 v0 = acc[ai][bj][m][0], v1 = acc[ai][bj][m][1]; unsigned lo = 0u, hi = 0u;
#pragma unroll
                        for (int j = 0; j < 4; ++j) { lo = __builtin_amdgcn_cvt_pk_u8_f32(sig255(v0[j]), j, lo); hi = __builtin_amdgcn_cvt_pk_u8_f32(sig255(v1[j]), j, hi); }
                        if (bj == 0) { w.x = lo; w.y = hi; } else { w.z = lo; w.w = hi; } }
                    __builtin_nontemporal_store(w, (u32x4*)(PG + (size_t)row * N_MG + (pn - 21) * 256 + 2 * cl)); }
        } else if (pn == 4) {
#pragma unroll
            for (int bj = 0; bj < 2; ++bj) { const int c = cl + bj * 128; const f32x4 b0 = *(const f32x4*)(blr + c), b1 = *(const f32x4*)(blr + c + 4);
#pragma unroll
                for (int ai = 0; ai < 2; ++ai) {
#pragma unroll
                    for (int n = 0; n < 2; ++n)
#pragma unroll
                        for (int j = 0; j < 4; ++j) { float run = 0.f; const float bb = n ? b1[j] : b0[j];
#pragma unroll
                            for (int m = 0; m < 4; ++m) { const float z = acc[ai][bj][m][n][j] + bb; const float x = -(fmaxf(-z, 0.f) + __logf(1.f + __expf(-fabsf(z)))) * 0.0625f; float ls = x, rs = x;
#define DPP_ADD(acc_, ctrl_) acc_ += __builtin_bit_cast(float, __builtin_amdgcn_update_dpp(0, __builtin_bit_cast(int, acc_), ctrl_, 0xf, 0xf, true))
                                DPP_ADD(ls, 0x111); DPP_ADD(ls, 0x112); DPP_ADD(ls, 0x114); DPP_ADD(ls, 0x118);
                                DPP_ADD(rs, 0x101); DPP_ADD(rs, 0x102); DPP_ADD(rs, 0x104); DPP_ADD(rs, 0x108);
#undef DPP_ADD
                                acc[ai][bj][m][n][j] = run + ls; run += ls + rs - x; } }
#pragma unroll
                    for (int m = 0; m < 4; ++m) { int row = row0 + ai * 128 + m * 16; asm volatile("" : "+v"(row)); float* d = LA + ((size_t)(c >> 6) * TG + row) * 64 + (c & 63); *(f32x4*)d = acc[ai][bj][m][0]; *(f32x4*)(d + 4) = acc[ai][bj][m][1]; } } }
        } else if (pn == 7 || pn == 8) {
            const int dcol = (pn - 1) * 256;
#pragma unroll
            for (int ai = 0; ai < 2; ++ai)
#pragma unroll
                for (int m = 0; m < 4; ++m) { int row = row0 + ai * 128 + m * 16; asm volatile("" : "+v"(row)); const int pos = row & (SEQ - 1);
#pragma unroll
                    for (int bj = 0; bj < 2; ++bj) { const int c = cl + bj * 128, i0 = (c & 63) >> 1; const float* rt = rot + ((size_t)pos * 32 + i0) * 2;
                        const f32x4 cs0 = *(const f32x4*)rt, cs1 = *(const f32x4*)(rt + 4); const f32x4 v0 = acc[ai][bj][m][0], v1 = acc[ai][bj][m][1];
                        u32x4 w; w.x = cvt_pk_bf16(v0[0] * cs0[0] - v0[1] * cs0[1], v0[0] * cs0[1] + v0[1] * cs0[0]); w.y = cvt_pk_bf16(v0[2] * cs0[2] - v0[3] * cs0[3], v0[2] * cs0[3] + v0[3] * cs0[2]);
                        w.z = cvt_pk_bf16(v1[0] * cs1[0] - v1[1] * cs1[1], v1[0] * cs1[1] + v1[1] * cs1[0]); w.w = cvt_pk_bf16(v1[2] * cs1[2] - v1[3] * cs1[3], v1[2] * cs1[3] + v1[3] * cs1[2]);
                        __builtin_nontemporal_store(w, (u32x4*)(P + (size_t)(dcol + (c & ~63)) * TG + (size_t)row * 64 + (c & 63))); } }
        } else {
            const bool silu = (pn == 5 || pn == 6 || pn == 11 || pn == 12 || pn == 15 || pn == 16 || pn == 19 || pn == 20);
            const int dcol = (pn < 4 ? pn : pn - 1) * 256;
            const int wsh = (pn >= 19) ? 9 : ((pn == 2 || pn == 3 || pn == 5 || pn == 6 || (pn >= 9 && pn <= 12)) ? 7 : 6);
#pragma unroll
            for (int ai = 0; ai < 2; ++ai)
#pragma unroll
                for (int m = 0; m < 4; ++m) { int row = row0 + ai * 128 + m * 16; asm volatile("" : "+v"(row));
#pragma unroll
                    for (int bj = 0; bj < 2; ++bj) { f32x4 v0 = acc[ai][bj][m][0], v1 = acc[ai][bj][m][1];
                        if (silu) {
#pragma unroll
                            for (int j = 0; j < 4; ++j) { v0[j] = silu_t(v0[j]); v1[j] = silu_t(v1[j]); } }
                        u32x4 w; w.x = cvt_pk_bf16(v0[0], v0[1]); w.y = cvt_pk_bf16(v0[2], v0[3]); w.z = cvt_pk_bf16(v1[0], v1[1]); w.w = cvt_pk_bf16(v1[2], v1[3]);
                        if (pn == 17 || pn == 18) { const int cc = (pn - 17) * 256 + cl + bj * 128;
                            __builtin_nontemporal_store(w, (u32x4*)(SU + ((size_t)(cc >> 4) * TG + row) * 16 + (cc & 15))); }
                        else { const int col = dcol + cl + bj * 128; __builtin_nontemporal_store(w, (u32x4*)(P + (size_t)(col >> wsh << wsh) * TG + ((size_t)row << wsh) + (col & ((1 << wsh) - 1)))); } } }
        }
    }
};
struct EpiSig {
    static constexpr bool PERM = true, AFTER_DRAIN = false, KEEP = false;
    bf16_t* PG;
    __device__ __forceinline__ void operator()(const f32x4 (&acc)[2][2][4][2], const pg8::Unit& u, int wr, int wc, int fr, int fq) const {
        const int row0 = u.pm * 256 + wr * 64 + fr, c0 = u.pn * 256 + wc * 32 + 8 * fq;
#pragma unroll
        for (int ai = 0; ai < 2; ++ai)
#pragma unroll
            for (int m = 0; m < 4; ++m) { const int row = row0 + ai * 128 + m * 16;
#pragma unroll
                for (int bj = 0; bj < 2; ++bj) { f32x4 v0 = acc[ai][bj][m][0], v1 = acc[ai][bj][m][1];
#pragma unroll
                    for (int j = 0; j < 4; ++j) { v0[j] = sigmoid_f(v0[j]); v1[j] = sigmoid_f(v1[j]); }
                    u32x4 w; w.x = cvt_pk_bf16(v0[0], v0[1]); w.y = cvt_pk_bf16(v0[2], v0[3]); w.z = cvt_pk_bf16(v1[0], v1[1]); w.w = cvt_pk_bf16(v1[2], v1[3]);
                    *(u32x4*)(PG + (size_t)row * N_MG + c0 + bj * 128) = w; } }
    }
};
struct EpiGlu {
    static constexpr bool PERM = true, AFTER_DRAIN = false, KEEP = false;
    const bf16_t* Y5; const bf16_t* P; const float* gb; bf16_t* O;
    __device__ __forceinline__ void operator()(const f32x4 (&acc)[2][2][4][2], const pg8::Unit& u, int wr, int wc, int fr, int fq) const {
        const int row0 = u.pm * 256 + wr * 64 + fr, c0 = u.pn * 256 + wc * 32 + 8 * fq;
#pragma unroll
        for (int bj = 0; bj < 2; ++bj) { const int c = c0 + bj * 128; const f32x4 b0 = *(const f32x4*)(gb + c), b1 = *(const f32x4*)(gb + c + 4);
#pragma unroll
            for (int ai = 0; ai < 2; ++ai)
#pragma unroll
                for (int m = 0; m < 4; ++m) { const int row = row0 + ai * 128 + m * 16;
                    const u32x4 y = *(const u32x4*)(Y5 + (size_t)row * BW + c), s = *(const u32x4*)(P + (size_t)P_SG * TG + (size_t)row * 512 + c);
                    const f32x4 v0 = acc[ai][bj][m][0] + b0, v1 = acc[ai][bj][m][1] + b1;
                    u32x4 w;
                    w.x = cvt_pk_bf16(bflo(y.x) * sigmoid_f(v0[0]) * bflo(s.x), bfhi(y.x) * sigmoid_f(v0[1]) * bfhi(s.x));
                    w.y = cvt_pk_bf16(bflo(y.y) * sigmoid_f(v0[2]) * bflo(s.y), bfhi(y.y) * sigmoid_f(v0[3]) * bfhi(s.y));
                    w.z = cvt_pk_bf16(bflo(y.z) * sigmoid_f(v1[0]) * bflo(s.z), bfhi(y.z) * sigmoid_f(v1[1]) * bfhi(s.z));
                    w.w = cvt_pk_bf16(bflo(y.w) * sigmoid_f(v1[2]) * bflo(s.w), bfhi(y.w) * sigmoid_f(v1[3]) * bfhi(s.w));
                    *(u32x4*)(O + (size_t)row * OLD + 1536 + c) = w; } }
    }
};
struct EpiBr {
    static constexpr bool PERM = true, AFTER_DRAIN = false, KEEP = false;
    const unsigned char* PG; bf16_t* MRG;
    __device__ __forceinline__ void operator()(f32x4 (&acc)[2][2][4][2], const pg8::Unit& u, int wr, int wc, int fr, int fq) const {
        const int row0 = u.pm * 256 + wr * 64 + fr, c = u.pn * 128 + wc * 32 + 8 * fq, z = u.z;
        const int gpos = (z * 4 + (u.pn >> 1)) * 256 + wc * 64 + fq * 16 + (u.pn & 1) * 8;
#pragma unroll
        for (int ai = 0; ai < 2; ++ai)
#pragma unroll
            for (int m = 0; m < 4; ++m) { const int row = row0 + ai * 128 + m * 16;
                const u32x2 gt = __builtin_nontemporal_load((const u32x2*)(PG + (size_t)row * N_MG + gpos));
                f32x4& p0 = acc[ai][0][m][0]; f32x4& p1 = acc[ai][0][m][1]; f32x4& s0 = acc[ai][1][m][0]; f32x4& s1 = acc[ai][1][m][1];
                if (z == 0) { s0 = (f32x4){0.f, 0.f, 0.f, 0.f}; s1 = s0; }
                s0[0] += p0[0] * (float)(gt.x & 255u); s0[1] += p0[1] * (float)((gt.x >> 8) & 255u); s0[2] += p0[2] * (float)((gt.x >> 16) & 255u); s0[3] += p0[3] * (float)(gt.x >> 24);
                s1[0] += p1[0] * (float)(gt.y & 255u); s1[1] += p1[1] * (float)((gt.y >> 8) & 255u); s1[2] += p1[2] * (float)((gt.y >> 16) & 255u); s1[3] += p1[3] * (float)(gt.y >> 24);
                p0 = (f32x4){0.f, 0.f, 0.f, 0.f}; p1 = p0;
                if (z == 3) { const float q = 1.f / 255.f; s0 *= q; s1 *= q;
                    u32x4 w; w.x = cvt_pk_bf16(s0[0], s0[1]); w.y = cvt_pk_bf16(s0[2], s0[3]); w.z = cvt_pk_bf16(s1[0], s1[1]); w.w = cvt_pk_bf16(s1[2], s1[3]);
                    *(u32x4*)(MRG + (size_t)row * D + c) = w; } }
    }
};
struct EpiOut {
    static constexpr bool PERM = true, AFTER_DRAIN = false, KEEP = false;
    bf16_t* DL;
    __device__ __forceinline__ void operator()(const f32x4 (&acc)[2][2][4][2], const pg8::Unit& u, int wr, int wc, int fr, int fq) const {
        const int row0 = u.pm * 256 + wr * 64 + fr, c0 = u.pn * 256 + wc * 32 + 8 * fq;
#pragma unroll
        for (int ai = 0; ai < 2; ++ai)
#pragma unroll
            for (int m = 0; m < 4; ++m) { const int row = row0 + ai * 128 + m * 16;
#pragma unroll
                for (int bj = 0; bj < 2; ++bj) { const f32x4 v0 = acc[ai][bj][m][0], v1 = acc[ai][bj][m][1];
                    u32x4 w; w.x = cvt_pk_bf16(v0[0], v0[1]); w.y = cvt_pk_bf16(v0[2], v0[3]); w.z = cvt_pk_bf16(v1[0], v1[1]); w.w = cvt_pk_bf16(v1[2], v1[3]);
                    *(u32x4*)(DL + (size_t)row * D + c0 + bj * 128) = w; } }
    }
};

__device__ __forceinline__ int win_src_col(int r) {
    const int pn = r >> 8, j = r & 255;
    switch (pn) {
        case 0: return j; case 1: return 256 + j; case 2: case 3: return 512 + (r - 512);
        case 4: return -1;
        case 5: case 6: return 1040 + (r - 1280);
        case 7: return 1552 + 64 * (j >> 6) + ((j & 63) >> 1) + 32 * (j & 1);
        case 8: return 1808 + 64 * (j >> 6) + ((j & 63) >> 1) + 32 * (j & 1);
        case 9: case 10: return 2064 + (r - 2304);
        case 11: case 12: return 2576 + (r - 2816);
        case 13: case 14: return 3088 + (r - 3328);
        case 15: case 16: return 3600 + (r - 3840);
        case 17: case 18: return 4112 + (r - 4352);
        default: return 4624 + (r - 4864);
    }
}
__device__ __forceinline__ void tr_store8(bf16_t* dst, const float (&v)[8]) {
    u32x4 w; w.x = cvt_pk_bf16(v[0], v[1]); w.y = cvt_pk_bf16(v[2], v[3]); w.z = cvt_pk_bf16(v[4], v[5]); w.w = cvt_pk_bf16(v[6], v[7]); *(u32x4*)dst = w;
}
__device__ __forceinline__ void phase_prologue(const Args& a, int gtid, int gthreads) {
    unsigned char* ws = a.ws;
    for (int l = 0; l < DEPTH; ++l) {
        bf16_t* Wl = (bf16_t*)(ws + WS_W + (size_t)l * W_STRIDE);
        const float* win = a.in[I_WIN] + (size_t)l * D * 5136;
        const float* wlr = a.in[I_GWLR] + (size_t)l * 16 * 256;
        for (int idx = gtid; idx < N_IN * (D / 8); idx += gthreads) { const int n = idx % N_IN, kc = idx / N_IN; const int sc = win_src_col(n); float v[8];
            if (sc >= 0) { const int pn_ = n >> 8; const float ws_ = (pn_ == 5 || pn_ == 6 || pn_ == 11 || pn_ == 12 || pn_ == 15 || pn_ == 16 || pn_ == 19 || pn_ == 20) ? -1.4426950408889634f : ((pn_ == 0 || pn_ == 8) ? 0.125f : 1.f);
#pragma unroll
                for (int i = 0; i < 8; ++i) v[i] = win[(size_t)(kc * 8 + i) * 5136 + sc] * ws_;
            } else { const int j = n & 255;
#pragma unroll
                for (int i = 0; i < 8; ++i) { float s = 0.f; const float* wr_ = win + (size_t)(kc * 8 + i) * 5136 + 1024;
#pragma unroll
                    for (int r = 0; r < 16; ++r) s += wr_[r] * wlr[r * 256 + j];
                    v[i] = s; } }
            tr_store8(Wl + (size_t)n * D + kc * 8, v); }
        const float* wmg = a.in[I_WMG] + (size_t)l * 4 * D * D;
        for (int idx = gtid; idx < N_MG * (D / 8); idx += gthreads) { const int n = idx % N_MG, kc = idx / N_MG, bi = n >> 10, c = n & 1023; float v[8];
#pragma unroll
            for (int i = 0; i < 8; ++i) v[i] = wmg[((size_t)bi * D + kc * 8 + i) * D + c] * -1.4426950408889634f;
            tr_store8(Wl + (size_t)(N_IN + n) * D + kc * 8, v); }
        const float* wbr = a.in[I_WBR] + (size_t)l * 4 * BW * D; bf16_t* Wb = (bf16_t*)((unsigned char*)Wl + WO_BR);
        for (int idx = gtid; idx < 4 * D * (BW / 8); idx += gthreads) { const int n = idx % (4 * D), kc = idx / (4 * D), bi = n >> 10, c = n & 1023; float v[8];
#pragma unroll
            for (int i = 0; i < 8; ++i) v[i] = wbr[((size_t)bi * BW + kc * 8 + i) * D + c];
            tr_store8(Wb + (size_t)n * BW + kc * 8, v); }
        const float* wout = a.in[I_WOUT] + (size_t)l * D * D; bf16_t* Wo = (bf16_t*)((unsigned char*)Wl + WO_OUT);
        for (int idx = gtid; idx < D * (D / 8); idx += gthreads) { const int n = idx % D, kc = idx / D; float v[8];
#pragma unroll
            for (int i = 0; i < 8; ++i) v[i] = wout[(size_t)(kc * 8 + i) * D + n];
            tr_store8(Wo + (size_t)n * D + kc * 8, v); }
        const float* wglu = a.in[I_SGW] + (size_t)l * BW * BW; bf16_t* Wg = (bf16_t*)((unsigned char*)Wl + WO_GLU);
        for (int idx = gtid; idx < BW * (BW / 8); idx += gthreads) { const int n = idx % BW, kc = idx / BW; float v[8];
#pragma unroll
            for (int i = 0; i < 8; ++i) v[i] = wglu[(size_t)(kc * 8 + i) * BW + n];
            tr_store8(Wg + (size_t)n * BW + kc * 8, v); }
        float* sm = (float*)(ws + WS_SMALL + (size_t)l * SMALL_STRIDE);
        for (int idx = gtid; idx < 2048; idx += gthreads) { const int g = idx >> 6;
            const double step = exp((double)a.in[I_SLDT][l * 32 + g]); const double are = a.in[I_SARE][l * 2048 + idx], aim = a.in[I_SAIM][l * 2048 + idx];
            const double mag = exp(step * are), abr = mag * cos(step * aim), abi = mag * sin(step * aim), den = are * are + aim * aim;
            const double fre = ((abr - 1.0) * are + abi * aim) / den, fim = (abi * are - (abr - 1.0) * aim) / den;
            sm[SM_ABR + idx] = (float)abr; sm[SM_ABI + idx] = (float)abi;
            double* s5d = (double*)(ws + WS_S5D) + ((size_t)l * 2048 + idx) * 50;
            { double pr = 1.0, pi = 0.0;
              for (int j = 0; j <= 8; ++j) { s5d[2 * j] = pr; s5d[2 * j + 1] = pi; const double nr = pr * abr - pi * abi, ni = pr * abi + pi * abr; pr = nr; pi = ni; }
              sm[SM_A8 + idx * 2] = (float)s5d[16]; sm[SM_A8 + idx * 2 + 1] = (float)s5d[17]; }
            { const double m128 = exp(512.0 * step * are); sm[SM_A128 + idx * 2] = (float)(m128 * cos(512.0 * step * aim)); sm[SM_A128 + idx * 2 + 1] = (float)(m128 * sin(512.0 * step * aim)); }
            bf16_t* bbt = (bf16_t*)((unsigned char*)sm + SM_BBT_BYTES); const int p_ = idx & 63;
            for (int i = 0; i < 16; ++i) { const double br = a.in[I_SBRE][(size_t)l * 32768 + idx * 16 + i], bi = a.in[I_SBIM][(size_t)l * 32768 + idx * 16 + i];
                s5d[18 + 2 * i] = fre * br - fim * bi; s5d[18 + 2 * i + 1] = fre * bi + fim * br;
                const float vr = (float)(fre * br - fim * bi), vi = (float)(fre * bi + fim * br);
                sm[SM_BBR + idx * 16 + i] = vr; sm[SM_BBI + idx * 16 + i] = vi; bbt[(g * 128 + 2 * p_) * 16 + i] = f2bf(vr); bbt[(g * 128 + 2 * p_ + 1) * 16 + i] = f2bf(vi); } }
        for (int idx = gtid; idx < 512; idx += gthreads) { const float lam = a.in[I_LLAM][l * 512 + idx]; const float nl = -lam;
            sm[SM_SP8 + idx] = 8.0f * (fmaxf(nl, 0.f) + log1pf(expf(-fabsf(nl)))); }
        { bf16_t* ct = (bf16_t*)((unsigned char*)sm + SM_CT_BYTES);
          for (int idx = gtid; idx < 32 * 16 * 128; idx += gthreads) { const int k = idx & 127, gi = idx >> 7;
              const float v = (k & 1) == 0 ? a.in[I_SCRE][(size_t)l * 32768 + gi * 64 + (k >> 1)] : -a.in[I_SCIM][(size_t)l * 32768 + gi * 64 + (k >> 1)]; ct[idx] = f2bf(v); } }
        bf16_t* lw = (bf16_t*)((unsigned char*)sm + SM_LRUW_BYTES);
        for (int idx = gtid; idx < 8 * 128 * 64; idx += gthreads) { const int i = idx & 63, jj = (idx >> 6) & 127, n = idx >> 13;
            const float v = jj < 64 ? a.in[I_LWA][(((size_t)l * 8 + n) * 64 + i) * 64 + jj] : a.in[I_LWX][(((size_t)l * 8 + n) * 64 + i) * 64 + (jj - 64)];
            lw[idx] = f2bf(v * -1.4426950408889634f); }
    }
    float* rot = (float*)(ws + WS_ROT);
    for (int idx = gtid; idx < SEQ * 32; idx += gthreads) { const int i = idx & 31, s = idx >> 5;
        const double inv = pow(10000.0, -(double)i / 32.0), ang = (double)s * inv; rot[idx * 2] = (float)cos(ang); rot[idx * 2 + 1] = (float)sin(ang); }
}

__device__ __forceinline__ void phase_prologue2(const Args& a, int gtid, int gthreads) {
    unsigned char* ws = a.ws;
    for (int l = 0; l < DEPTH; ++l) {
        const double* s5d = (const double*)(ws + WS_S5D) + (size_t)l * 2048 * 50;
        const float* scre = a.in[I_SCRE] + (size_t)l * 32768; const float* scim = a.in[I_SCIM] + (size_t)l * 32768;
        for (int it = gtid; it < 32 * 5376; it += gthreads) { const int g = it / 5376, r = it % 5376, f = r >> 6, ln = r & 63, fr = ln & 15, fq = ln >> 4;
            int mat, mt, ks;
            if (f < 32) { mat = 0; mt = f >> 2; ks = f & 3; } else if (f < 64) { mat = 1; mt = (f - 32) >> 2; ks = (f - 32) & 3; }
            else { mat = 2; const int ff = f - 64; mt = ff < 1 ? 0 : ff < 2 ? 1 : ff < 4 ? 2 : ff < 6 ? 3 : ff < 9 ? 4 : ff < 12 ? 5 : ff < 16 ? 6 : 7;
                const int cb = mt < 1 ? 0 : mt < 2 ? 1 : mt < 3 ? 2 : mt < 4 ? 4 : mt < 5 ? 6 : mt < 6 ? 9 : mt < 7 ? 12 : 16; ks = ff - cb; }
            const int m = 16 * mt + fr, k0 = 32 * ks + 8 * fq; float v[8];
            if (mat == 0) { const int p = m >> 1, ri = m & 1, sq = k0 >> 4, c0 = k0 & 15; const double* sd = s5d + (size_t)(g * 64 + p) * 50; const double ar = sd[2 * (7 - sq)], ai = sd[2 * (7 - sq) + 1];
#pragma unroll
                for (int e = 0; e < 8; ++e) { const double br = sd[18 + 2 * (c0 + e)], bi = sd[18 + 2 * (c0 + e) + 1]; v[e] = (float)(ri ? ar * bi + ai * br : ar * br - ai * bi); } }
            else if (mat == 1) { const int t = m >> 4, i = m & 15;
#pragma unroll
                for (int e = 0; e < 8; ++e) { const int k = k0 + e, p = k >> 1, ri = k & 1; const double* sd = s5d + (size_t)(g * 64 + p) * 50; const double ar = sd[2 * (t + 1)], ai = sd[2 * (t + 1) + 1];
                    const double cr = scre[(g * 16 + i) * 64 + p], ci = scim[(g * 16 + i) * 64 + p]; v[e] = (float)(ri ? -(cr * ai + ci * ar) : cr * ar - ci * ai); } }
            else { const int t = m >> 4, i = m & 15, sq = k0 >> 4, c0 = k0 & 15; double ac[8];
#pragma unroll
                for (int e = 0; e < 8; ++e) ac[e] = 0.0;
                if (sq <= t) { const int j = t - sq;
                    for (int p = 0; p < 64; ++p) { const double* sd = s5d + (size_t)(g * 64 + p) * 50; const double ar = sd[2 * j], ai = sd[2 * j + 1];
                        const double cr = scre[(g * 16 + i) * 64 + p], ci = scim[(g * 16 + i) * 64 + p]; const double wr = cr * ar - ci * ai, wi = cr * ai + ci * ar;
#pragma unroll
                        for (int e = 0; e < 8; ++e) ac[e] += wr * sd[18 + 2 * (c0 + e)] - wi * sd[18 + 2 * (c0 + e) + 1]; } }
#pragma unroll
                for (int e = 0; e < 8; ++e) v[e] = (float)ac[e]; }
            tr_store8((bf16_t*)(ws + WS_S5M + (size_t)(l * 32 + g) * S5M_BYTES + (size_t)r * 16), v); }
    }
}

template <bool F32OUT, bool ADD>
__device__ __forceinline__ void phase_norm(const float* hin, const bf16_t* delta, float* hout, const float* gain, bf16_t* uout, int gw, int ngw, int lane) {
    f32x4 gv[4];
#pragma unroll
    for (int j = 0; j < 4; ++j) gv[j] = *(const f32x4*)(gain + 4 * lane + 256 * j);
    for (int row = gw; row < TG; row += ngw) {
        const f32x4* xr = (const f32x4*)(hin + (size_t)row * D) + lane; f32x4 v[4]; float s = 0.f;
#pragma unroll
        for (int j = 0; j < 4; ++j) v[j] = __builtin_nontemporal_load(xr + 64 * j);
        if (ADD) { const u32x2* dr = (const u32x2*)(delta + (size_t)row * D) + lane;
#pragma unroll
            for (int j = 0; j < 4; ++j) { const u32x2 dw = __builtin_nontemporal_load(dr + 64 * j); v[j].x += bflo(dw.x); v[j].y += bfhi(dw.x); v[j].z += bflo(dw.y); v[j].w += bfhi(dw.y); } }
#pragma unroll
        for (int j = 0; j < 4; ++j) s += (v[j].x * v[j].x + v[j].y * v[j].y) + (v[j].z * v[j].z + v[j].w * v[j].w);
        const float rstd = rsqrtf(wave_sum(s) * (1.f / D) + NORM_EPS);
        if (F32OUT) { f32x4* o = (f32x4*)(hout + (size_t)row * D) + lane;
#pragma unroll
            for (int j = 0; j < 4; ++j) o[64 * j] = v[j] * rstd * gv[j];
        } else {
            if (ADD) { f32x4* o = (f32x4*)(hout + (size_t)row * D) + lane;
#pragma unroll
                for (int j = 0; j < 4; ++j) o[64 * j] = v[j]; }
            u32x2* o = (u32x2*)(uout + (size_t)row * D) + lane;
#pragma unroll
            for (int j = 0; j < 4; ++j) { const f32x4 y = v[j] * rstd * gv[j]; u32x2 w; w.x = cvt_pk_bf16(y.x, y.y); w.y = cvt_pk_bf16(y.z, y.w); o[64 * j] = w; } }
    }
}

constexpr int NSEGG = 8;
constexpr int NSEGL = 32;
constexpr int NSEGS = 8;
constexpr size_t ST_GSEG = 0;
constexpr size_t ST_GDS = ST_GSEG + (size_t)2 * BG * 4 * NSEGG * 8192;
constexpr size_t ST_LRU = ST_GDS + (size_t)2 * BG * 4 * NSEGG * 64;
constexpr size_t ST_S5 = ST_LRU + (size_t)BG * NSEGL * 512 * 2;
constexpr size_t ST_END_F = ST_S5 + (size_t)BG * NSEGS * 32 * 128;
static_assert(ST_END_F * 4 <= 64 * MiB, "state scratch");
typedef short s16x4 __attribute__((ext_vector_type(4)));

__device__ __forceinline__ bf16x8 lds_tr_frag(LAS const unsigned char* base, int row_stride_bytes, int lane) {
    const int g = lane >> 4, idx = lane & 15, q = idx >> 2, p = idx & 3;
    LAS const unsigned char* a0 = base + (8 * g + q) * row_stride_bytes + 8 * p;
    const s16x4 r0 = __builtin_amdgcn_ds_read_tr16_b64_v4i16((LAS s16x4*)a0);
    const s16x4 r1 = __builtin_amdgcn_ds_read_tr16_b64_v4i16((LAS s16x4*)(a0 + 4 * row_stride_bytes));
    bf16x8 f; f[0] = r0[0]; f[1] = r0[1]; f[2] = r0[2]; f[3] = r0[3]; f[4] = r1[0]; f[5] = r1[1]; f[6] = r1[2]; f[7] = r1[3]; return f;
}
#define WGSYNC() do { asm volatile("s_waitcnt lgkmcnt(0)" ::: "memory"); __builtin_amdgcn_s_barrier(); asm volatile("" ::: "memory"); } while (0)

constexpr int GL_QD = 0, GL_KD = 9216, GL_KT = 18432, GL_V = 27648, GL_ST = 45056, GL_LAST = 63488, GL_RED = 63744, GL_RED2 = 64256;
struct GlaP { const bf16_t* P; const float* LA; const float* gain; const float* bias; bf16_t* O; float* SSEG; float* DSUM; };
__device__ __forceinline__ bf16x8 lds_tr_frag2(LAS const unsigned char* base, int row_stride_bytes, int lane, int mulg, int second_off) {
    const int g = lane >> 4, idx = lane & 15, q = idx >> 2, p = idx & 3;
    LAS const unsigned char* a0 = base + (mulg * g + q) * row_stride_bytes + 8 * p;
    const s16x4 r0 = __builtin_amdgcn_ds_read_tr16_b64_v4i16((LAS s16x4*)a0);
    const s16x4 r1 = __builtin_amdgcn_ds_read_tr16_b64_v4i16((LAS s16x4*)(a0 + second_off * row_stride_bytes));
    bf16x8 f; f[0] = r0[0]; f[1] = r0[1]; f[2] = r0[2]; f[3] = r0[3]; f[4] = r1[0]; f[5] = r1[1]; f[6] = r1[2]; f[7] = r1[3]; return f;
}
__device__ __forceinline__ bf16x8 pack8(const f32x4 a, const f32x4 b) { u32x4 w; w.x = cvt_pk_bf16(a[0], a[1]); w.y = cvt_pk_bf16(a[2], a[3]); w.z = cvt_pk_bf16(b[0], b[1]); w.w = cvt_pk_bf16(b[2], b[3]); return __builtin_bit_cast(bf16x8, w); }

template <bool PASSC>
__device__ __forceinline__ void glaret_item(LAS unsigned char* lds, const GlaP& gp, const bool gla, const int b, const int h, const int seg, const int sidx  ) {
    int tid = threadIdx.x; asm volatile("" : "+v"(tid));
    const int w = __builtin_amdgcn_readfirstlane(tid >> 6), l = tid & 63, fr = l & 15, fq = l >> 4;
    const int qoff = gla ? P_GQ : P_RQ, koff = gla ? P_GK : P_RK, voff = gla ? P_GV : P_RV, goff = gla ? P_GG : P_RG, ooff = gla ? 0 : 512;
    const float lg = __logf(1.f - exp2f(-5.f - (float)h));
    f32x4 accs[4];
#pragma unroll
    for (int dt = 0; dt < 4; ++dt) accs[dt] = (f32x4){0.f, 0.f, 0.f, 0.f};
    const int arow = 8 * w + (l >> 3), apart = l & 7;
    float dsum[8];
#pragma unroll
    for (int e = 0; e < 8; ++e) dsum[e] = 0.f;
    if (PASSC) {
        for (int sp = 0; sp < seg; ++sp) {
            const float* sg = gp.SSEG + (size_t)(sidx + sp) * 8192 + tid * 16; const float* dsm = gp.DSUM + (size_t)(sidx + sp) * 64;
#pragma unroll
            for (int dt = 0; dt < 4; ++dt) { const f32x4 dv = *(const f32x4*)(dsm + 16 * dt + 4 * fq), sv = *(const f32x4*)(sg + 4 * dt);
#pragma unroll
                for (int r = 0; r < 4; ++r) accs[dt][r] = accs[dt][r] * __expf(dv[r]) + sv[r]; }
        }
#pragma unroll
        for (int dt = 0; dt < 4; ++dt) { u32x2 wv; wv.x = cvt_pk_bf16(accs[dt][0], accs[dt][1]); wv.y = cvt_pk_bf16(accs[dt][2], accs[dt][3]);
            *(LAS u32x2*)(lds + GL_ST + (16 * w + fr) * 144 + 32 * dt + 8 * fq) = wv; }
    }
    const int it = w & 3, ch = w >> 2;
    f32x4 gnv[4], bsv[4];
#pragma unroll
    for (int ct = 0; ct < 4; ++ct) { const int c = 128 * h + 64 * ch + 16 * ct + 4 * fq; gnv[ct] = PASSC ? *(const f32x4*)(gp.gain + c) : (f32x4){0.f, 0.f, 0.f, 0.f};
        bsv[ct] = (PASSC && !gla) ? *(const f32x4*)(gp.bias + c) : (f32x4){0.f, 0.f, 0.f, 0.f}; }
    u32x4 rq = (u32x4){0u, 0u, 0u, 0u}, rk, rv[2]; f32x4 rla[2], rll[2]; u32x2 gnx[4];
    const float rq_s = __expf((float)(arow + 1) * lg), rk_s = __expf(-(float)(arow + 1) * lg), rt_s = __expf((float)(63 - arow) * lg);
#define GL_ISSUE(n_) do { const size_t r0_ = (size_t)b * SEQ + seg * 512 + (n_) * 64; \
        { const size_t ro_ = (r0_ + arow) * 64 + 8 * apart; if (PASSC) rq = *(const u32x4*)(gp.P + (size_t)(qoff + 64 * h) * TG + ro_); rk = *(const u32x4*)(gp.P + (size_t)(koff + 64 * h) * TG + ro_); \
          if (gla) { const float* lp_ = gp.LA + (size_t)h * TG * 64 + ro_; rla[0] = *(const f32x4*)lp_; rla[1] = *(const f32x4*)(lp_ + 4); const float* ll_ = gp.LA + ((size_t)h * TG + r0_ + 63) * 64 + 8 * apart; rll[0] = *(const f32x4*)ll_; rll[1] = *(const f32x4*)(ll_ + 4); } \
          else { rla[0] = (f32x4){0.f, 0.f, 0.f, 0.f}; rla[1] = rla[0]; rll[0] = rla[0]; rll[1] = rla[0]; } } \
        _Pragma("unroll") for (int e_ = 0; e_ < 2; ++e_) { const int p_ = tid + 512 * e_, i_ = p_ >> 4, part_ = p_ & 15; \
            rv[e_] = *(const u32x4*)(gp.P + (size_t)(voff + 128 * h) * TG + (r0_ + i_) * 128 + 8 * part_); } \
        if (PASSC) { _Pragma("unroll") for (int ct_ = 0; ct_ < 4; ++ct_) gnx[ct_] = *(const u32x2*)(gp.P + (size_t)(goff + 128 * h) * TG + (r0_ + 16 * it + fr) * 128 + 64 * ch + 16 * ct_ + 4 * fq); } } while (0)
    GL_ISSUE(0);
    for (int n = 0; n < 8; ++n) {
        const size_t row0 = (size_t)b * SEQ + seg * 512 + n * 64;
#pragma unroll
        for (int e = 0; e < 2; ++e) { const int p = tid + 512 * e, i = p >> 4, part = p & 15; *(LAS u32x4*)(lds + GL_V + i * 272 + part * 16) = rv[e]; }
        { float cum[8], lastv[8];
          const float kk[8] = {bflo(rk.x), bfhi(rk.x), bflo(rk.y), bfhi(rk.y), bflo(rk.z), bfhi(rk.z), bflo(rk.w), bfhi(rk.w)};
          float eq[8], ek[8], et[8];
          if (gla) {
#pragma unroll
              for (int e = 0; e < 8; ++e) { cum[e] = e < 4 ? rla[0][e] : rla[1][e - 4]; lastv[e] = e < 4 ? rll[0][e] : rll[1][e - 4];
                  eq[e] = __expf(cum[e]); ek[e] = __builtin_amdgcn_rcpf(eq[e]); et[e] = __expf(lastv[e]) * ek[e]; }
          } else {
#pragma unroll
              for (int e = 0; e < 8; ++e) { lastv[e] = 64.f * lg; eq[e] = rq_s; ek[e] = rk_s; et[e] = rt_s; } }
#pragma unroll
          for (int e = 0; e < 8; ++e) *(LAS bf16_t*)(lds + GL_KT + (8 * apart + e) * 144 + arow * 2) = f2bf(kk[e] * et[e]);
          if (PASSC) { const float qq[8] = {bflo(rq.x), bfhi(rq.x), bflo(rq.y), bfhi(rq.y), bflo(rq.z), bfhi(rq.z), bflo(rq.w), bfhi(rq.w)};
              u32x4 qw, kw;
              qw.x = cvt_pk_bf16(qq[0] * eq[0], qq[1] * eq[1]); qw.y = cvt_pk_bf16(qq[2] * eq[2], qq[3] * eq[3]); qw.z = cvt_pk_bf16(qq[4] * eq[4], qq[5] * eq[5]); qw.w = cvt_pk_bf16(qq[6] * eq[6], qq[7] * eq[7]);
              kw.x = cvt_pk_bf16(kk[0] * ek[0], kk[1] * ek[1]); kw.y = cvt_pk_bf16(kk[2] * ek[2], kk[3] * ek[3]); kw.z = cvt_pk_bf16(kk[4] * ek[4], kk[5] * ek[5]); kw.w = cvt_pk_bf16(kk[6] * ek[6], kk[7] * ek[7]);
              *(LAS u32x4*)(lds + GL_QD + arow * 144 + 16 * apart) = qw; *(LAS u32x4*)(lds + GL_KD + arow * 144 + 16 * apart) = kw; }
          if (arow == 63) {
#pragma unroll
              for (int e = 0; e < 8; ++e) *(LAS float*)(lds + GL_LAST + (8 * apart + e) * 4) = lastv[e]; }
#pragma unroll
          for (int e = 0; e < 8; ++e) dsum[e] += lastv[e]; }
        u32x2 gates[4];
        if (PASSC) {
#pragma unroll
            for (int ct = 0; ct < 4; ++ct) gates[ct] = gnx[ct]; }
        if (n < 7) GL_ISSUE(n + 1);
        WGSYNC();
        f32x4 acco[4];
        if (PASSC) {
            bf16x8 qf[2];
#pragma unroll
            for (int ks = 0; ks < 2; ++ks) qf[ks] = *(LAS const bf16x8*)(lds + GL_QD + (16 * it + fr) * 144 + 16 * fq + 64 * ks);
            f32x4 sc[4];
#pragma unroll
            for (int jt = 0; jt < 4; ++jt) { sc[jt] = (f32x4){0.f, 0.f, 0.f, 0.f};
                if (jt <= it) {
#pragma unroll
                    for (int ks = 0; ks < 2; ++ks) { const bf16x8 kf = *(LAS const bf16x8*)(lds + GL_KD + (16 * jt + fr) * 144 + 16 * fq + 64 * ks);
                        sc[jt] = __builtin_amdgcn_mfma_f32_16x16x32_bf16(kf, qf[ks], sc[jt], 0, 0, 0); }
                    if (jt == it) {
#pragma unroll
                        for (int r = 0; r < 4; ++r) sc[jt][r] = (4 * fq + r <= fr) ? sc[jt][r] : 0.f; } } }
            const bf16x8 pf0 = pack8(sc[0], sc[1]), pf1 = pack8(sc[2], sc[3]);
#pragma unroll
            for (int ct = 0; ct < 4; ++ct) { const int c0 = 64 * ch + 16 * ct; acco[ct] = (f32x4){0.f, 0.f, 0.f, 0.f};
                { const bf16x8 vf = lds_tr_frag2(lds + GL_V + c0 * 2, 272, l, 4, 16); acco[ct] = __builtin_amdgcn_mfma_f32_16x16x32_bf16(vf, pf0, acco[ct], 0, 0, 0); }
                if (it >= 2) { const bf16x8 vf = lds_tr_frag2(lds + GL_V + 32 * 272 + c0 * 2, 272, l, 4, 16); acco[ct] = __builtin_amdgcn_mfma_f32_16x16x32_bf16(vf, pf1, acco[ct], 0, 0, 0); }
#pragma unroll
                for (int ks = 0; ks < 2; ++ks) { const bf16x8 sf = *(LAS const bf16x8*)(lds + GL_ST + (c0 + fr) * 144 + 16 * fq + 64 * ks);
                    acco[ct] = __builtin_amdgcn_mfma_f32_16x16x32_bf16(sf, qf[ks], acco[ct], 0, 0, 0); } }
        }
#pragma unroll
        for (int dt = 0; dt < 4; ++dt) { const f32x4 lv = *(LAS const f32x4*)(lds + GL_LAST + (16 * dt + 4 * fq) * 4);
#pragma unroll
            for (int r = 0; r < 4; ++r) accs[dt][r] *= __expf(lv[r]); }
#pragma unroll
        for (int ks = 0; ks < 2; ++ks) { const bf16x8 vf = lds_tr_frag2(lds + GL_V + (32 * ks) * 272 + (16 * w) * 2, 272, l, 8, 4);
#pragma unroll
            for (int dt = 0; dt < 4; ++dt) { const bf16x8 kf = *(LAS const bf16x8*)(lds + GL_KT + (16 * dt + fr) * 144 + 16 * fq + 64 * ks);
                accs[dt] = __builtin_amdgcn_mfma_f32_16x16x32_bf16(kf, vf, accs[dt], 0, 0, 0); } }
        if (PASSC) {
            float ss = 0.f, sm_ = 0.f;
#pragma unroll
            for (int ct = 0; ct < 4; ++ct)
#pragma unroll
                for (int r = 0; r < 4; ++r) { ss += acco[ct][r] * acco[ct][r]; sm_ += acco[ct][r]; }
            ss += shfl_xor_f(ss, 16); ss += shfl_xor_f(ss, 32); sm_ += shfl_xor_f(sm_, 16); sm_ += shfl_xor_f(sm_, 32);
            if (fq == 0) { *(LAS float*)(lds + GL_RED + ((16 * it + fr) * 2 + ch) * 4) = ss; *(LAS float*)(lds + GL_RED2 + ((16 * it + fr) * 2 + ch) * 4) = sm_; }
        }
        WGSYNC();
        if (PASSC) {
            const int i = 16 * it + fr;
            const float ssum = *(LAS const float*)(lds + GL_RED + (i * 2) * 4) + *(LAS const float*)(lds + GL_RED + (i * 2 + 1) * 4);
            const float msum = *(LAS const float*)(lds + GL_RED2 + (i * 2) * 4) + *(LAS const float*)(lds + GL_RED2 + (i * 2 + 1) * 4);
            float mean, rstd;
            if (gla) { mean = 0.f; rstd = rsqrtf(ssum * (1.f / 128.f) + NORM_EPS); }
            else { mean = msum * (1.f / 128.f); const float var = fmaxf(ssum * (1.f / 128.f) - mean * mean, 0.f); rstd = rsqrtf(var + NORM_EPS); }
#pragma unroll
            for (int ct = 0; ct < 4; ++ct) { const int c = 128 * h + 64 * ch + 16 * ct + 4 * fq; const f32x4 gn = gnv[ct], bs = bsv[ct];
                const float g0 = bflo(gates[ct].x), g1 = bfhi(gates[ct].x), g2 = bflo(gates[ct].y), g3 = bfhi(gates[ct].y);
                u32x2 ow; ow.x = cvt_pk_bf16(((acco[ct][0] - mean) * rstd * gn[0] + bs[0]) * g0, ((acco[ct][1] - mean) * rstd * gn[1] + bs[1]) * g1);
                ow.y = cvt_pk_bf16(((acco[ct][2] - mean) * rstd * gn[2] + bs[2]) * g2, ((acco[ct][3] - mean) * rstd * gn[3] + bs[3]) * g3);
                *(u32x2*)(gp.O + (row0 + i) * OLD + ooff + c) = ow; }
#pragma unroll
            for (int dt = 0; dt < 4; ++dt) { u32x2 wv; wv.x = cvt_pk_bf16(accs[dt][0], accs[dt][1]); wv.y = cvt_pk_bf16(accs[dt][2], accs[dt][3]);
                *(LAS u32x2*)(lds + GL_ST + (16 * w + fr) * 144 + 32 * dt + 8 * fq) = wv; }
        }
    }
#undef GL_ISSUE
    if (!PASSC) {
        float* sg = gp.SSEG + (size_t)(sidx + seg) * 8192 + tid * 16;
#pragma unroll
        for (int dt = 0; dt < 4; ++dt) *(f32x4*)(sg + 4 * dt) = accs[dt];
        if (tid < 8) {
#pragma unroll
            for (int e = 0; e < 8; ++e) gp.DSUM[(size_t)(sidx + seg) * 64 + 8 * apart + e] = dsum[e]; }
    }
    WGSYNC();
}

constexpr int LR_XC = 0, LR_XCF = 2304, LR_AA = 6400, LR_GG = 10496, LR_WAVE = 14592;
struct LruP { const bf16_t* P; const float* cw; const float* cb; const float* ba; const float* bx; const float* sp8; const bf16_t* lw; bf16_t* O; float* LST; };
template <bool PASSC>
__device__ __forceinline__ void lru_wave(LAS unsigned char* lw_, const LruP& lp, const int b, const int seg, const int n, const int l_) {
    int l = l_; asm volatile("" : "+v"(l));
    const float NL2E = -1.4426950408889634f;
    const int fr = l & 15, fq = l >> 4, ch = 64 * n + l;
    bf16x8 wB[8][2];
#pragma unroll
    for (int jt = 0; jt < 8; ++jt)
#pragma unroll
        for (int ks = 0; ks < 2; ++ks) wB[jt][ks] = *(const bf16x8*)(lp.lw + ((size_t)(n * 128 + 16 * jt + fr)) * 64 + 8 * fq + 32 * ks);
    const float w0 = lp.cw[ch], w1 = lp.cw[512 + ch], w2 = lp.cw[1024 + ch], w3 = lp.cw[1536 + ch], cbv = lp.cb[ch];
    float bav[4], bxv[4], spv[4];
#pragma unroll
    for (int jt = 0; jt < 4; ++jt) { const int c2 = 64 * n + 16 * jt + fr; bav[jt] = lp.ba[c2] * NL2E; bxv[jt] = lp.bx[c2] * NL2E; spv[jt] = lp.sp8[c2] * NL2E; }
    const size_t rowb = (size_t)b * SEQ + seg * 128;
    const bf16_t* px = lp.P + (size_t)(P_LX + 64 * n) * TG + rowb * 64;
    const bf16_t* pg = lp.P + (size_t)(P_LG + 64 * n) * TG + rowb * 64;
    bf16_t* po = lp.O + rowb * OLD + 1024 + 64 * n;
    float xm3 = 0.f, xm2 = 0.f, xm1 = 0.f;
    if (seg > 0) { xm3 = bf2f(px[l - 3 * 64]); xm2 = bf2f(px[l - 2 * 64]); xm1 = bf2f(px[l - 64]); }
    float hst = 0.f, ap = 1.f;
    if (PASSC) { const float* st = lp.LST + ((size_t)b * NSEGL * 512 + ch) * 2;
        pg8::f32x2_ ah[31];
#pragma unroll
        for (int e = 0; e < 31; ++e) { const int sp = e < seg ? e : 0; ah[e] = *(const pg8::f32x2_*)(st + (size_t)sp * 1024); }
#pragma unroll
        for (int e = 0; e < 31; ++e) if (e < seg) hst = ah[e][0] * hst + ah[e][1]; }
#define LR_ROWLD(dst, base, t) do { dst = (base)[(t) * 64 + l]; } while (0)
    bf16_t xn[16], gn[16];
#pragma unroll
    for (int t = 0; t < 16; ++t) LR_ROWLD(xn[t], px, t);
    for (int sb = 0; sb < 8; ++sb) {
        float xc[16];
        if (PASSC) {
#pragma unroll
            for (int t = 0; t < 16; ++t) LR_ROWLD(gn[t], pg, sb * 16 + t); }
#pragma unroll
        for (int t = 0; t < 16; ++t) { const float x0 = bf2f(xn[t]); xc[t] = cbv + w0 * xm3 + w1 * xm2 + w2 * xm1 + w3 * x0; xm3 = xm2; xm2 = xm1; xm1 = x0;
            *(LAS bf16_t*)(lw_ + LR_XC + t * 144 + l * 2) = f2bf(xc[t]); }
        if (sb < 7) {
#pragma unroll
            for (int t = 0; t < 16; ++t) LR_ROWLD(xn[t], px, (sb + 1) * 16 + t); }
        __builtin_amdgcn_wave_barrier();
        f32x4 acc[8];
#pragma unroll
        for (int jt = 0; jt < 8; ++jt) { const float bz = jt < 4 ? bav[jt] : bxv[jt - 4]; acc[jt] = (f32x4){bz, bz, bz, bz}; }
#pragma unroll
        for (int ks = 0; ks < 2; ++ks) { const bf16x8 af = *(LAS const bf16x8*)(lw_ + LR_XC + fr * 144 + 16 * fq + 64 * ks);
#pragma unroll
            for (int jt = 0; jt < 8; ++jt) acc[jt] = __builtin_amdgcn_mfma_f32_16x16x32_bf16(af, wB[jt][ks], acc[jt], 0, 0, 0); }
#pragma unroll
        for (int jt = 0; jt < 4; ++jt)
#pragma unroll
            for (int r = 0; r < 4; ++r) { const int tok = 4 * fq + r, j = 16 * jt + fr;
                const float rg = __builtin_amdgcn_rcpf(1.f + __builtin_amdgcn_exp2f(acc[jt][r])), ig = __builtin_amdgcn_rcpf(1.f + __builtin_amdgcn_exp2f(acc[4 + jt][r]));
                const float av = __builtin_amdgcn_exp2f(rg * spv[jt]);
                *(LAS float*)(lw_ + LR_AA + tok * 256 + j * 4) = av; const float em = fmaf(-av, av, 1.f);
                *(LAS float*)(lw_ + LR_GG + tok * 256 + j * 4) = ig * __builtin_amdgcn_sqrtf(em); }
        __builtin_amdgcn_wave_barrier();
#pragma unroll
        for (int t = 0; t < 16; ++t) { const float av = *(LAS const float*)(lw_ + LR_AA + t * 256 + l * 4), gv = *(LAS const float*)(lw_ + LR_GG + t * 256 + l * 4);
            hst = av * hst + gv * xc[t]; ap *= av;
            if (PASSC) { bf16_t* p_ = po + (size_t)(sb * 16 + t) * OLD; asm volatile("" : "+s"(p_)); p_[l] = f2bf(hst * bf2f(gn[t])); } }
        __builtin_amdgcn_wave_barrier();
    }
#undef LR_ROWLD
    if (!PASSC) { float* st = lp.LST + (((size_t)b * NSEGL + seg) * 512 + ch) * 2; st[0] = ap; st[1] = hst; }
}

constexpr int S5_MG = 0, S5_MC = 32768, S5_MM = 65536, S5_MEND = 86016, S5W_STRIDE = 8448;
struct S5P { const bf16_t* P; const bf16_t* SU; const float* sm; const unsigned char* s5m; const float* a128; const float* dd; bf16_t* Y5; float* SST; };
__device__ __forceinline__ float gelu_t(float x) { const float t = x * __builtin_fmaf(x * x, -0.10294324f, -2.3022082f);
    return x * __builtin_amdgcn_rcpf(1.f + __builtin_amdgcn_exp2f(t)); }
template <bool PASSC>
__device__ __forceinline__ void s5_wave(LAS unsigned char* lds, LAS unsigned char* lw_, const S5P& sp_, const int b, const int seg, const int g, const int l_) {
    int l = l_; asm volatile("" : "+v"(l));
    const int fr = l & 15, fq = l >> 4;
    const float a8r = sp_.sm[SM_A8 + (g * 64 + l) * 2], a8i = sp_.sm[SM_A8 + (g * 64 + l) * 2 + 1];
    float xr = 0.f, xi = 0.f;
    f32x4 dv4 = (f32x4){0.f, 0.f, 0.f, 0.f};
    if (PASSC) {
        const float ar = sp_.a128[(g * 64 + l) * 2], ai = sp_.a128[(g * 64 + l) * 2 + 1];
        const float* st = sp_.SST + ((size_t)b * NSEGS * 32 + g) * 128 + l;
        for (int sp0 = 0; sp0 < seg; sp0 += 8) { float er[8], ei[8];
#pragma unroll
            for (int e = 0; e < 8; ++e) { const int sp = sp0 + e < seg ? sp0 + e : seg - 1; er[e] = st[(size_t)sp * 4096]; ei[e] = st[(size_t)sp * 4096 + 64]; }
#pragma unroll
            for (int e = 0; e < 8; ++e) if (sp0 + e < seg) { const float nr = ar * xr - ai * xi + er[e], ni = ar * xi + ai * xr + ei[e]; xr = nr; xi = ni; } }
        dv4 = *(const f32x4*)(sp_.dd + 16 * g + 4 * fq);
    }
    const size_t rowb = (size_t)b * SEQ + seg * 512;
    bf16x8 ufn[4];
#pragma unroll
    for (int ks = 0; ks < 4; ++ks) ufn[ks] = *(const bf16x8*)(sp_.SU + ((size_t)g * TG + rowb + 8 * fr + 2 * ks + (fq >> 1)) * 16 + 8 * (fq & 1));
    for (int sup = 0; sup < 4; ++sup) {
        const size_t r0 = rowb + sup * 128;
        bf16x8 uf[4];
#pragma unroll
        for (int ks = 0; ks < 4; ++ks) uf[ks] = ufn[ks];
        if (sup < 3) {
#pragma unroll
            for (int ks = 0; ks < 4; ++ks) ufn[ks] = *(const bf16x8*)(sp_.SU + ((size_t)g * TG + r0 + 128 + 8 * fr + 2 * ks + (fq >> 1)) * 16 + 8 * (fq & 1)); }
        u32x2 us[8];
        if (PASSC) {
#pragma unroll
            for (int mt = 0; mt < 8; ++mt) us[mt] = *(const u32x2*)(sp_.SU + ((size_t)g * TG + r0 + 8 * fr + mt) * 16 + 4 * fq); }
#pragma unroll
        for (int mt = 0; mt < 8; ++mt) { f32x4 ga = (f32x4){0.f, 0.f, 0.f, 0.f};
#pragma unroll
            for (int ks = 0; ks < 4; ++ks) ga = __builtin_amdgcn_mfma_f32_16x16x32_bf16(*(LAS const bf16x8*)(lds + S5_MG + ((mt * 4 + ks) * 64 + l) * 16), uf[ks], ga, 0, 0, 0);
            *(LAS f32x4*)(lw_ + fr * 528 + (16 * mt + 4 * fq) * 4) = ga; }
        __builtin_amdgcn_wave_barrier();
        pg8::f32x2_ gv[16];
#pragma unroll
        for (int t = 0; t < 16; ++t) gv[t] = *(LAS const pg8::f32x2_*)(lw_ + t * 528 + l * 8);
        __builtin_amdgcn_wave_barrier();
#pragma unroll
        for (int t = 0; t < 16; ++t) {
            if (PASSC) *(LAS unsigned*)(lw_ + t * 528 + l * 4) = cvt_pk_bf16(xr, xi);
            const float nr = __builtin_fmaf(a8r, xr, __builtin_fmaf(-a8i, xi, gv[t][0])), ni = __builtin_fmaf(a8r, xi, __builtin_fmaf(a8i, xr, gv[t][1])); xr = nr; xi = ni; }
        if (PASSC) {
            __builtin_amdgcn_wave_barrier();
            bf16x8 xf[4];
#pragma unroll
            for (int ks = 0; ks < 4; ++ks) xf[ks] = *(LAS const bf16x8*)(lw_ + fr * 528 + (32 * ks + 8 * fq) * 2);
#pragma unroll
            for (int mt = 0; mt < 8; ++mt) { f32x4 ya = (f32x4){0.f, 0.f, 0.f, 0.f}; const int cb = mt < 1 ? 0 : mt < 2 ? 1 : mt < 3 ? 2 : mt < 4 ? 4 : mt < 5 ? 6 : mt < 6 ? 9 : mt < 7 ? 12 : 16;
#pragma unroll
                for (int ks = 0; ks < 4; ++ks) if (2 * ks <= mt) ya = __builtin_amdgcn_mfma_f32_16x16x32_bf16(*(LAS const bf16x8*)(lds + S5_MM + ((cb + ks) * 64 + l) * 16), uf[ks], ya, 0, 0, 0);
#pragma unroll
                for (int ks = 0; ks < 4; ++ks) ya = __builtin_amdgcn_mfma_f32_16x16x32_bf16(*(LAS const bf16x8*)(lds + S5_MC + ((mt * 4 + ks) * 64 + l) * 16), xf[ks], ya, 0, 0, 0);
                u32x2 yw; yw.x = cvt_pk_bf16(gelu_t(ya[0] + dv4[0] * bflo(us[mt].x)), gelu_t(ya[1] + dv4[1] * bfhi(us[mt].x))); yw.y = cvt_pk_bf16(gelu_t(ya[2] + dv4[2] * bflo(us[mt].y)), gelu_t(ya[3] + dv4[3] * bfhi(us[mt].y)));
                *(u32x2*)(sp_.Y5 + (r0 + 8 * fr + mt) * BW + 16 * g + 4 * fq) = yw; }
        }
        __builtin_amdgcn_wave_barrier();
    }
    if (!PASSC) { float* st = sp_.SST + (((size_t)b * NSEGS + seg) * 32 + g) * 128 + l; st[0] = xr; st[64] = xi; }
}

template <bool PASSC>
__device__ __forceinline__ void phase_mixers(LAS unsigned char* lds, const Args& a, const int l, const int G) {
    const int mmask = a.mmask;
    unsigned char* ws = a.ws; const float* sm = (const float*)(ws + WS_SMALL + (size_t)l * SMALL_STRIDE);
    const bf16_t* P = (const bf16_t*)(ws + WS_P); float* ST = (float*)(ws + WS_ST);
    if (mmask & 1) { GlaP gp0{P, (const float*)(ws + WS_LA), a.in[I_GNG] + l * 512, nullptr, (bf16_t*)(ws + WS_O), ST + ST_GSEG, ST + ST_GDS};
      GlaP gp1{P, (const float*)(ws + WS_LA), a.in[I_RNG] + l * 512, a.in[I_RNB] + l * 512, (bf16_t*)(ws + WS_O), ST + ST_GSEG, ST + ST_GDS};
      for (int itx = blockIdx.x; itx < 2 * BG * 4 * NSEGG; itx += G) { const int mix = itx / (BG * 4 * NSEGG), rest = itx % (BG * 4 * NSEGG), b = rest / (4 * NSEGG), h = (rest / NSEGG) & 3, seg = rest % NSEGG;
          const int sidx = ((mix * BG + b) * 4 + h) * NSEGG;
          if (!PASSC && seg == NSEGG - 1) continue;
          if (mix == 0) glaret_item<PASSC>(lds, gp0, true, b, h, seg, sidx); else glaret_item<PASSC>(lds, gp1, false, b, h, seg, sidx); } }
    int tid = threadIdx.x; asm volatile("" : "+v"(tid));
    const int w = __builtin_amdgcn_readfirstlane(tid >> 6), ln = tid & 63;
    if (mmask & 2) { LruP lp{P, a.in[I_LCW] + l * 2048, a.in[I_LCB] + l * 512, a.in[I_LBA] + l * 512, a.in[I_LBX] + l * 512, sm + SM_SP8, (const bf16_t*)((const unsigned char*)sm + SM_LRUW_BYTES), (bf16_t*)(ws + WS_O), ST + ST_LRU};
      for (int itx = blockIdx.x; itx < BG * NSEGL; itx += G) { if (!PASSC && itx % NSEGL == NSEGL - 1) continue; lru_wave<PASSC>(lds + w * LR_WAVE, lp, itx / NSEGL, itx % NSEGL, w, ln); } }
    if (mmask & 4) { S5P sp_{P, (const bf16_t*)(ws + WS_SU2), sm, ws + WS_S5M + (size_t)l * 32 * S5M_BYTES, sm + SM_A128, a.in[I_SD] + l * 512, (bf16_t*)(ws + WS_Y5), ST + ST_S5};
      for (int itx = blockIdx.x; itx < 32 * 8; itx += G) { const int g = itx & 31, q = (itx >> 5) * 8 + w;
          WGSYNC();
          { const unsigned char* src = sp_.s5m + (size_t)g * S5M_BYTES; const int nb = PASSC ? S5_MEND : S5_MC;
            for (int o = tid * 16; o < nb; o += 8192) *(LAS u32x4*)(lds + o) = *(const u32x4*)(src + o); }
          WGSYNC();
          if (PASSC || (q & 7) != NSEGS - 1) s5_wave<PASSC>(lds, lds + S5_MEND + w * S5W_STRIDE, sp_, q >> 3, q & 7, g, ln); } }
    WGSYNC();
}

constexpr int NPH = 8, NSTEPS = 1 + NGRP * DEPTH * NPH;
constexpr int LDS_BYTES = 163840, LDS_MISC = 163840 - 512;
static_assert(S5_MEND + 8 * S5W_STRIDE <= LDS_MISC, "S5 LDS");

__global__ void __launch_bounds__(512, 2) mk_fwd(Args a) {
    __shared__ __attribute__((aligned(16))) unsigned char lds_raw[LDS_BYTES];
    LAS unsigned char* lds = (LAS unsigned char*)lds_raw;
    volatile LAS unsigned* MISC = (volatile LAS unsigned*)(lds + LDS_MISC);
    const int G = gridDim.x;
    if (threadIdx.x < 32) MISC[threadIdx.x] = 0u;
    wg_syncthreads();
    unsigned* ctl = (unsigned*)(a.ws + WS_CTL);
    XcdBarrier bar = xcd_barrier_post(ctl + CW_BAR + a.li * XCD_BAR_WORDS, MISC + 8);
    const int ngw = G * 8, gthreads = G * 512;
#define LTID(v) int v = threadIdx.x; asm volatile("" : "+v"(v))
#define IN(s) (a.s_lo <= (s) && (s) < a.s_hi)
#define SEAM(s) do { if ((s) + 1 < a.s_hi) xcd_barrier(bar); } while (0)
    if (IN(0)) { LTID(t_); phase_prologue(a, blockIdx.x * 512 + t_, gthreads); xcd_barrier(bar); phase_prologue2(a, blockIdx.x * 512 + t_, gthreads); SEAM(0); }
    for (int gl = 0; gl < NGRP * DEPTH; ++gl) {
        const int grp = gl >> 2, l = gl & 3, s0 = 1 + gl * NPH;
        if (a.s_hi <= s0 || a.s_lo >= s0 + NPH) continue;
        unsigned char* ws = a.ws;
        const bf16_t* Wl = (const bf16_t*)(ws + WS_W + (size_t)l * W_STRIDE);
        const float* sm = (const float*)(ws + WS_SMALL + (size_t)l * SMALL_STRIDE);
        bf16_t* U = (bf16_t*)(ws + WS_U); bf16_t* P = (bf16_t*)(ws + WS_P); float* LA = (float*)(ws + WS_LA);
        bf16_t* O = (bf16_t*)(ws + WS_O); bf16_t* Y5 = (bf16_t*)(ws + WS_Y5); unsigned char* PGb = ws + WS_PG;
        const float* xg = a.in[I_X] + (size_t)grp * TG * D; float* og = a.out + (size_t)grp * TG * D;
        const float* hin = (l <= 1) ? xg : og;
        bf16_t* DLT = (bf16_t*)(ws + WS_O);
        (void)sm;
        if (IN(s0 + 0)) { LTID(t_); const int gw_ = blockIdx.x * 8 + __builtin_amdgcn_readfirstlane(t_ >> 6);
            if (l == 0) phase_norm<false, false>(hin, DLT, og, a.in[I_NG] + l * D, U, gw_, ngw, t_ & 63); else phase_norm<false, true>(hin, DLT, og, a.in[I_NG] + l * D, U, gw_, ngw, t_ & 63);
            SEAM(s0 + 0); }
        if (IN(s0 + 1)) {
            pg8::Gemm g{U, Wl, TG, N_ALL, D, D, D, 0, 0}; pg8::StaticOrder S; S.init(TG, N_ALL, G, (int)blockIdx.x, 0, 256, WGM_G1);
            EpiIn E{P, LA, a.in[I_GBLR] + l * 256, (const float*)(ws + WS_ROT), PGb, (bf16_t*)(ws + WS_SU2)};
            GEMM_CALL(EpiIn);
            SEAM(s0 + 1);
        }
        if (IN(s0 + 2)) { phase_mixers<false>(lds, a, l, G); SEAM(s0 + 2); }
        if (IN(s0 + 3)) { phase_mixers<true>(lds, a, l, G); SEAM(s0 + 3); }
        if (IN(s0 + 4)) {
            { pg8::Gemm g{Y5, (const bf16_t*)((const unsigned char*)Wl + WO_GLU), TG, BW, BW, BW, BW, 0, 0}; pg8::StaticOrder S; S.init(TG, BW, G, (int)blockIdx.x, 0, 256, WGM_GLU);
              EpiGlu E{Y5, P, a.in[I_SGB] + l * BW, O};
              GEMM_CALL(EpiGlu); }
            SEAM(s0 + 4);
        }
        if (IN(s0 + 6)) {
            { pg8::Gemm g{O, (const bf16_t*)((const unsigned char*)Wl + WO_BR), TG, D, BW, OLD, BW, (size_t)BW * 2, (size_t)D * BW * 2}; pg8::StaticOrder S; S.init(TG, D, G, (int)blockIdx.x, 2, 128, WGM_G2);
              EpiBr E{PGb, U};
              pg8::gemm_phase<EpiBr, pg8::StaticOrder, true, true, true>(lds, g, S, E); }
            SEAM(s0 + 6);
        }
        if (IN(s0 + 7)) {
            if (a.fin != 2) { pg8::Gemm g{U, (const bf16_t*)((const unsigned char*)Wl + WO_OUT), TG, D, D, D, D, 0, 0}; pg8::StaticOrder S; S.init(TG, D, G, (int)blockIdx.x, 0, 256, WGM_G3);
              EpiOut E{DLT};
              GEMM_CALL(EpiOut); }
            if (l == 3 && a.fin) { if (a.fin == 1) xcd_barrier(bar); LTID(t_); phase_norm<true, true>(og, DLT, og, a.in[I_FNG], U, blockIdx.x * 8 + __builtin_amdgcn_readfirstlane(t_ >> 6), ngw, t_ & 63); }
            SEAM(s0 + 7);
        }
    }
#undef IN
#undef SEAM
}

extern "C" void kernel_launch(void* const* d_in, const int* in_sizes, int n_in, void* d_out, int out_size, void* d_ws, size_t ws_size, hipStream_t stream) {
    static int grid = 0;
    if (grid == 0) {
        static const int exp_sizes[29] = {67108864, 4096, 21037056, 16384, 1024, 2048, 2048, 2048, 8192, 2048, 131072, 2048, 131072, 2048, 2048, 8192, 8192, 131072, 131072, 131072, 131072, 2048, 128, 1048576, 2048, 16777216, 8388608, 4194304, 1024};
        bool ok_sizes = (n_in == 29); if (ok_sizes) for (int i = 0; i < 29; ++i) if (in_sizes[i] != exp_sizes[i]) { fprintf(stderr, "kernel_launch: input %d has %d elements, expected %d\n", i, in_sizes[i], exp_sizes[i]); ok_sizes = false; }
        if (!ok_sizes || out_size != NB * SEQ * D || ws_size < WS_END) { fprintf(stderr, "kernel_launch: unexpected shapes (n_in %d out %d ws %zu)\n", n_in, out_size, ws_size); grid = -1; return; }
        int dev = 0, cus = 0, per_cu = 0;
        hipGetDevice(&dev); hipDeviceGetAttribute(&cus, hipDeviceAttributeMultiprocessorCount, dev);
        hipOccupancyMaxActiveBlocksPerMultiprocessor(&per_cu, (const void*)mk_fwd, 512, 0);
        (void)hipGetLastError();
        grid = cus > 0 ? cus : 256;
        if (per_cu < 1) fprintf(stderr, "kernel_launch: occupancy query says %d\n", per_cu);
    }
    if (grid < 0) return;
    hipMemsetAsync((char*)d_ws + WS_CTL, 0, CTL_BYTES, stream);
    Args a{};
    for (int i = 0; i < 29; ++i) a.in[i] = (const float*)d_in[i];
    a.out = (float*)d_out; a.ws = (unsigned char*)d_ws;
    unsigned char* ws = (unsigned char*)d_ws;
    int li = 0;
    auto run = [&](int lo, int hi, int fin = 1, int mm = 7) { a.s_lo = lo; a.s_hi = hi; a.li = li++; a.fin = fin; a.mmask = mm; a.pad2 = 0; hipLaunchKernelGGL(mk_fwd, dim3(grid), dim3(512), 0, stream, a); };
    run(0, NSTEPS);
}
#if defined(__HIP_DEVICE_COMPILE__)
#pragma clang attribute pop
#endif
```

```cpp
#include <hip/hip_runtime.h>
#ifndef WGM_G1
#define WGM_G1 4
#endif
#ifndef WGM_G2
#define WGM_G2 8
#endif
#ifndef WGM_G3
#define WGM_G3 8
#endif
#ifndef WGM_GLU
#define WGM_GLU 8
#endif
#include <cstdio>
#include <cstdint>
#if defined(__HIP_DEVICE_COMPILE__)
#pragma clang attribute push(__attribute__((target("no-packed-fp32-ops"))), apply_to = function)
#endif


namespace pg8 {
#define PG8_LAS __attribute__((address_space(3)))
typedef unsigned short bf16_t;
typedef short bf16x8 __attribute__((ext_vector_type(8)));
typedef float f32x4 __attribute__((ext_vector_type(4)));
typedef unsigned u32x4 __attribute__((ext_vector_type(4)));
typedef unsigned u32x2 __attribute__((ext_vector_type(2)));
constexpr int BM = 256, BK = 64, HALF = 128, HTB = HALF * BK * 2, STAGE_BYTES = 8 * HTB, NXCD = 8;

__host__ __device__ __forceinline__ int lds_byte(int r, int c) { const int st = (r >> 4) * 2 + (c >> 5), rr = r & 15, cc = c & 31, ob = rr * 64 + cc * 2; return st * 1024 + (ob ^ (((ob >> 9) & 1) << 5)); }
__host__ __device__ __forceinline__ void stage_rc(int b, int& R, int& C) { const int st = b / 1024, sb = b % 1024, swz = sb ^ (((sb >> 9) & 1) << 5); R = (st >> 1) * 16 + swz / 64; C = (st & 1) * 32 + (swz % 64) / 2; }
__host__ __device__ __forceinline__ int perm32(int rho) { const int n = rho >> 4, i = rho & 15; return 8 * (i >> 2) + 4 * n + (i & 3); }

struct Unit { int pm, pn, z; };
struct Gemm { const bf16_t* A; const bf16_t* Bt; int M, N, K, lda, ldb; size_t zA, zB; };

struct StaticOrder {
    int nM, nN, nwg, G, c, zsh, WGM;
    __host__ __device__ void init(int M, int N, int G_, int c_, int zsh_ = 0, int bn_ = BM, int wgm_ = 4) { nM = M / BM; nN = N / bn_; nwg = nM * nN; G = G_; c = c_; zsh = zsh_; WGM = wgm_; }
    __host__ __device__ bool next(int i, Unit& u) const {
        const int ti = i >> zsh; u.z = i & ((1 << zsh) - 1);
        const long L = (long)ti * G + c; if (L >= nwg) return false;
        int wgid = (int)L; { const int q = nwg / NXCD, r = nwg % NXCD, xcd = wgid % NXCD, off = wgid / NXCD; wgid = (xcd < r ? xcd * (q + 1) : r * (q + 1) + (xcd - r) * q) + off; }
        const int nig = WGM * nN, gid = wgid / nig, fm = gid * WGM, gsz = (nM - fm) < WGM ? (nM - fm) : WGM;
        u.pm = fm + ((wgid % nig) % gsz); u.pn = (wgid % nig) / gsz; return true;
    }
    __device__ __forceinline__ void a_ready(const Unit&) const {}
    __device__ __forceinline__ void done(const Unit&) const {}
};

typedef float f32x2_ __attribute__((ext_vector_type(2)));
typedef __bf16 bf16x2_ __attribute__((ext_vector_type(2)));
__device__ __forceinline__ unsigned cvt_pk_bf16(float lo, float hi) { const f32x2_ v = {lo, hi}; const bf16x2_ b = __builtin_convertvector(v, bf16x2_); return __builtin_bit_cast(unsigned, b); }

template <class Epi, class Sched, bool ALIGN_EPI = false, bool SP2 = false, bool HALFN = false>
__device__ __forceinline__ void gemm_phase(PG8_LAS unsigned char* lds, const Gemm g, const Sched& S, const Epi& E) {
    int tid = threadIdx.x; asm volatile("" : "+v"(tid));
    const int wid = __builtin_amdgcn_readfirstlane(tid >> 6), lane = tid & 63, wr = wid >> 2, wc = wid & 3, fr = lane & 15, fq = lane >> 4;
    const int K = g.K, nt = K / BK;
    unsigned voffA[2], voffB[2];
#pragma unroll
    for (int i = 0; i < 2; ++i) { int R, C; stage_rc(tid * 16 + i * 8192, R, C); const int Rb = Epi::PERM ? ((R & ~31) + perm32(R & 31)) : R;
        voffA[i] = (unsigned)(R * g.lda + C) * 2u; voffB[i] = (unsigned)(Rb * g.ldb + C) * 2u; }
    const size_t kstep = (size_t)(BK * 2);
    const size_t hstepA = (size_t)HALF * g.lda * 2, hstepB = (size_t)HALF * g.ldb * 2;
    const size_t tstepA = 2 * hstepA, tstepB = HALFN ? hstepB : 2 * hstepB;
    const unsigned ldsw = (unsigned)wid * 1024u;
    unsigned aoff = (unsigned)lds_byte(wr * 64 + fr, fq * 8), boff = (unsigned)lds_byte(wc * 32 + fr, fq * 8) + 4u * HTB;
    asm volatile("" : "+v"(aoff), "+v"(boff));
#define PG8_SA(b, h) (((b) * 2 + (h)) * HTB)
#define PG8_SB(b, h) ((4 + (b) * 2 + (h)) * HTB)
#define PG8_STAGE(bufoff, gbase, voff) do { _Pragma("unroll") for (int _i = 0; _i < 2; ++_i) \
        __builtin_amdgcn_global_load_lds((const unsigned*)((const char*)(gbase) + (voff)[_i]), (PG8_LAS unsigned*)(lds + (bufoff) + ldsw + _i * 8192), 16, 0, 0); } while (0)
#define PG8_LDA(dst, b, h) do { _Pragma("unroll") for (int m = 0; m < 4; ++m) _Pragma("unroll") for (int k = 0; k < 2; ++k) dst[m][k] = *(const PG8_LAS bf16x8*)(lds + aoff + (PG8_SA(b, h) + m * 2048 + k * 1024)); } while (0)
#define PG8_LDB(dst, b, h) do { _Pragma("unroll") for (int n = 0; n < 2; ++n) _Pragma("unroll") for (int k = 0; k < 2; ++k) dst[n][k] = *(const PG8_LAS bf16x8*)(lds + boff + (((b) * 2 + (h)) * HTB + n * 2048 + k * 1024)); } while (0)
#define PG8_MMA(ai, bj, At, Bt) do { __builtin_amdgcn_s_setprio(1); _Pragma("unroll") for (int m = 0; m < 4; ++m) _Pragma("unroll") for (int n = 0; n < 2; ++n) _Pragma("unroll") for (int k = 0; k < 2; ++k) \
        acc[ai][bj][m][n] = __builtin_amdgcn_mfma_f32_16x16x32_bf16(Bt[n][k], At[m][k], acc[ai][bj][m][n], 0, 0, 0); __builtin_amdgcn_s_setprio(0); } while (0)
#define PG8_WAIT_V(n) asm volatile("s_waitcnt vmcnt(" #n ")" ::: "memory")
#define PG8_WAIT_L(n) asm volatile("s_waitcnt lgkmcnt(" #n ")" ::: "memory")
#define PG8_BAR __builtin_amdgcn_s_barrier()
#define PG8_SCHED __builtin_amdgcn_sched_barrier(0)
    Unit cur, nxt; int ui = 0;
    if (!S.next(0, cur)) return;
    f32x4 acc[2][2][4][2];
#pragma unroll
    for (int a = 0; a < 2; ++a)
#pragma unroll
        for (int b = 0; b < 2; ++b)
#pragma unroll
            for (int m = 0; m < 4; ++m)
#pragma unroll
                for (int n = 0; n < 2; ++n) acc[a][b][m][n] = (f32x4){0.f, 0.f, 0.f, 0.f};
    bf16x8 At[4][2], B0[2][2], B1[2][2];
    const char* cA = (const char*)g.A + (size_t)cur.pm * tstepA + (size_t)cur.z * g.zA; const char* cB = (const char*)g.Bt + (size_t)cur.pn * tstepB + (size_t)cur.z * g.zB;
    S.a_ready(cur);
    if constexpr (SP2 && HALFN) {
        PG8_STAGE(PG8_SB(0, 0), cB, voffB); PG8_STAGE(PG8_SA(0, 0), cA, voffA); PG8_STAGE(PG8_SA(0, 1), cA + hstepA, voffA);
        if (wr == 1) PG8_BAR;
        PG8_WAIT_V(2); PG8_BAR;
        PG8_STAGE(PG8_SB(1, 0), cB + kstep, voffB); PG8_STAGE(PG8_SA(1, 0), cA + kstep, voffA);
        PG8_WAIT_V(4); PG8_BAR;
    } else if constexpr (SP2) {
        PG8_STAGE(PG8_SB(0, 0), cB, voffB); PG8_STAGE(PG8_SB(0, 1), cB + hstepB, voffB); PG8_STAGE(PG8_SA(0, 0), cA, voffA); PG8_STAGE(PG8_SA(0, 1), cA + hstepA, voffA);
        if (wr == 1) PG8_BAR;
        PG8_WAIT_V(2); PG8_BAR;
        PG8_STAGE(PG8_SB(1, 0), cB + kstep, voffB); PG8_STAGE(PG8_SA(1, 0), cA + kstep, voffA); PG8_STAGE(PG8_SB(1, 1), cB + hstepB + kstep, voffB);
        PG8_WAIT_V(6); PG8_BAR;
    } else {
        PG8_STAGE(PG8_SB(0, 0), cB, voffB); PG8_STAGE(PG8_SA(0, 0), cA, voffA); PG8_STAGE(PG8_SB(0, 1), cB + hstepB, voffB); PG8_STAGE(PG8_SA(0, 1), cA + hstepA, voffA);
        if (wr == 1) PG8_BAR;
        PG8_WAIT_V(4); PG8_BAR;
        PG8_STAGE(PG8_SB(1, 0), cB + kstep, voffB); PG8_STAGE(PG8_SA(1, 0), cA + kstep, voffA); PG8_STAGE(PG8_SB(1, 1), cB + hstepB + kstep, voffB);
        PG8_WAIT_V(6); PG8_BAR;
    }
    for (;;) {
        const bool has_next = S.next(ui + 1, nxt);
        const char* nA = has_next ? (const char*)g.A + (size_t)nxt.pm * tstepA + (size_t)nxt.z * g.zA : cA; const char* nB = has_next ? (const char*)g.Bt + (size_t)nxt.pn * tstepB + (size_t)nxt.z * g.zB : cB;
        for (int t = 0; t < nt; t += 2) {
            const bool last = (t == nt - 2);
            const char* a1 = cA + (size_t)(t + 1) * kstep;
            const char* a2 = last ? nA : cA + (size_t)(t + 2) * kstep; const char* b2 = last ? nB : cB + (size_t)(t + 2) * kstep;
            const char* a3 = a2 + kstep; const char* b3 = b2 + kstep;
            if (last && has_next) S.a_ready(nxt);
            if constexpr (SP2 && HALFN) {
            PG8_LDB(B0, 0, 0); PG8_SCHED; PG8_LDA(At, 0, 0); PG8_STAGE(PG8_SA(1, 1), a1 + hstepA, voffA);
            PG8_WAIT_V(6); PG8_WAIT_L(0); PG8_BAR; PG8_MMA(0, 0, At, B0); PG8_BAR; PG8_SCHED;
            PG8_LDA(At, 0, 1); PG8_STAGE(PG8_SB(0, 0), b2, voffB); PG8_STAGE(PG8_SA(0, 0), a2, voffA);
            PG8_WAIT_V(6); PG8_WAIT_L(0); PG8_BAR; PG8_MMA(1, 0, At, B0); PG8_BAR; PG8_SCHED;
            PG8_LDB(B0, 1, 0); PG8_SCHED; PG8_LDA(At, 1, 0); PG8_STAGE(PG8_SA(0, 1), a2 + hstepA, voffA);
            PG8_WAIT_V(6); PG8_WAIT_L(0); PG8_BAR; PG8_MMA(0, 0, At, B0); PG8_BAR; PG8_SCHED;
            PG8_LDA(At, 1, 1); PG8_STAGE(PG8_SB(1, 0), b3, voffB); PG8_STAGE(PG8_SA(1, 0), a3, voffA);
            PG8_WAIT_V(6); PG8_WAIT_L(0); PG8_BAR; PG8_MMA(1, 0, At, B0); PG8_BAR; PG8_SCHED;
            } else if constexpr (SP2) {
            PG8_LDB(B0, 0, 0); PG8_LDB(B1, 0, 1); PG8_SCHED; PG8_LDA(At, 0, 0); PG8_STAGE(PG8_SA(1, 1), a1 + hstepA, voffA);
            PG8_WAIT_V(8); PG8_WAIT_L(0); PG8_BAR; PG8_MMA(0, 0, At, B0); PG8_MMA(0, 1, At, B1); PG8_BAR; PG8_SCHED;
            PG8_LDA(At, 0, 1); PG8_STAGE(PG8_SB(0, 0), b2, voffB); PG8_STAGE(PG8_SB(0, 1), b2 + hstepB, voffB); PG8_STAGE(PG8_SA(0, 0), a2, voffA);
            PG8_WAIT_V(8); PG8_WAIT_L(0); PG8_BAR; PG8_MMA(1, 0, At, B0); PG8_MMA(1, 1, At, B1); PG8_BAR; PG8_SCHED;
            PG8_LDB(B0, 1, 0); PG8_LDB(B1, 1, 1); PG8_SCHED; PG8_LDA(At, 1, 0); PG8_STAGE(PG8_SA(0, 1), a2 + hstepA, voffA);
            PG8_WAIT_V(8); PG8_WAIT_L(0); PG8_BAR; PG8_MMA(0, 0, At, B0); PG8_MMA(0, 1, At, B1); PG8_BAR; PG8_SCHED;
            PG8_LDA(At, 1, 1); PG8_STAGE(PG8_SB(1, 0), b3, voffB); PG8_STAGE(PG8_SB(1, 1), b3 + hstepB, voffB); PG8_STAGE(PG8_SA(1, 0), a3, voffA);
            PG8_WAIT_V(8); PG8_WAIT_L(0); PG8_BAR; PG8_MMA(1, 0, At, B0); PG8_MMA(1, 1, At, B1); PG8_BAR; PG8_SCHED;
            } else {
            PG8_LDB(B0, 0, 0); PG8_SCHED; PG8_LDA(At, 0, 0); PG8_STAGE(PG8_SA(1, 1), a1 + hstepA, voffA);
            PG8_WAIT_L(8); PG8_BAR; PG8_WAIT_L(0); PG8_MMA(0, 0, At, B0); PG8_BAR; PG8_SCHED;
            PG8_LDB(B1, 0, 1); PG8_STAGE(PG8_SB(0, 0), b2, voffB);
            PG8_BAR; PG8_WAIT_L(0); PG8_MMA(0, 1, At, B1); PG8_BAR;
            PG8_LDA(At, 0, 1); PG8_STAGE(PG8_SA(0, 0), a2, voffA);
            PG8_BAR; PG8_WAIT_L(0); PG8_MMA(1, 0, At, B0); PG8_BAR; PG8_SCHED;
            PG8_STAGE(PG8_SB(0, 1), b2 + hstepB, voffB);
            PG8_WAIT_V(6); PG8_BAR; PG8_MMA(1, 1, At, B1); PG8_BAR;
            PG8_LDB(B0, 1, 0); PG8_SCHED; PG8_LDA(At, 1, 0); PG8_STAGE(PG8_SA(0, 1), a2 + hstepA, voffA);
            PG8_WAIT_L(8); PG8_BAR; PG8_WAIT_L(0); PG8_MMA(0, 0, At, B0); PG8_BAR; PG8_SCHED;
            PG8_LDB(B1, 1, 1); PG8_STAGE(PG8_SB(1, 0), b3, voffB);
            PG8_BAR; PG8_WAIT_L(0); PG8_MMA(0, 1, At, B1); PG8_BAR;
            PG8_LDA(At, 1, 1); PG8_STAGE(PG8_SA(1, 0), a3, voffA);
            PG8_BAR; PG8_WAIT_L(0); PG8_MMA(1, 0, At, B0); PG8_BAR; PG8_SCHED;
            PG8_STAGE(PG8_SB(1, 1), b3 + hstepB, voffB);
            PG8_WAIT_V(6); PG8_BAR; PG8_MMA(1, 1, At, B1); PG8_BAR;
            }
        }
        if constexpr (ALIGN_EPI) { if (wr == 0) PG8_BAR; }
        { int fr_e = fr, fq_e = fq; asm volatile("" : "+v"(fr_e), "+v"(fq_e));
          E(acc, cur, wr, wc, fr_e, fq_e); }
        if (!has_next) break;
        if (!HALFN && !(Epi::KEEP && cur.z != 3)) {
#pragma unroll
        for (int a = 0; a < 2; ++a)
#pragma unroll
            for (int b = 0; b < 2; ++b)
#pragma unroll
                for (int m = 0; m < 4; ++m)
#pragma unroll
                    for (int n = 0; n < 2; ++n) acc[a][b][m][n] = (f32x4){0.f, 0.f, 0.f, 0.f};
        }
        cur = nxt; cA = nA; cB = nB; ++ui;
        if constexpr (ALIGN_EPI) { if (wr == 1) PG8_BAR; }
    }
    PG8_WAIT_V(0);
    if constexpr (!ALIGN_EPI) { if (wr == 0) PG8_BAR; }
    PG8_BAR;
#undef PG8_SA
#undef PG8_SB
#undef PG8_STAGE
#undef PG8_LDA
#undef PG8_LDB
#undef PG8_MMA
#undef PG8_WAIT_V
#undef PG8_WAIT_L
#undef PG8_BAR
#undef PG8_SCHED
}

}

using pg8::bf16_t; using pg8::f32x4; using pg8::u32x4; using pg8::u32x2; using pg8::bf16x8; using pg8::cvt_pk_bf16;
#define LAS __attribute__((address_space(3)))

constexpr int D = 1024, SEQ = 4096, NB = 16, DEPTH = 4, BW = 512;
constexpr int NGRP = 2, BG = NB / NGRP, TG = BG * SEQ;
constexpr int N_IN = 21 * 256, N_MG = 4096, N_ALL = N_IN + N_MG;
constexpr int PLD = 20 * 256;
constexpr int P_GQ = 0, P_GK = 256, P_GV = 512, P_GG = 1024, P_RQ = 1536, P_RK = 1792, P_RV = 2048, P_RG = 2560, P_LX = 3072, P_LG = 3584, P_SU = 4096, P_SG = 4608;
constexpr int OLD = 2048;
constexpr float NORM_EPS = 1e-6f;

constexpr size_t MiB = 1u << 20;
constexpr size_t WS_CTL = 0, CTL_BYTES = 2 * MiB;
constexpr size_t WS_ROT = 2 * MiB;
constexpr size_t WS_SMALL = 3 * MiB, SMALL_STRIDE = 1 * MiB;
constexpr size_t WS_W = 8 * MiB, W_STRIDE = 26 * MiB;
constexpr size_t WO_IN = 0, WO_BR = (size_t)N_ALL * D * 2, WO_OUT = WO_BR + (size_t)4 * D * BW * 2, WO_GLU = WO_OUT + (size_t)D * D * 2, WO_END = WO_GLU + (size_t)BW * BW * 2;
static_assert(WO_END <= W_STRIDE, "weights");
constexpr size_t WS_U = 112 * MiB;
constexpr size_t WS_P = 176 * MiB;
constexpr size_t WS_LA = 496 * MiB;
constexpr size_t WS_O = 528 * MiB;
constexpr size_t WS_Y5 = 656 * MiB;
constexpr size_t WS_PG = 688 * MiB;
constexpr size_t WS_S5D = 816 * MiB;
constexpr size_t WS_S5M = 820 * MiB, S5M_BYTES = 86016;
constexpr size_t WS_S5K = 831 * MiB;
constexpr size_t WS_SU2 = 832 * MiB;
constexpr size_t WS_ST = 944 * MiB;
constexpr size_t WS_END = 1008 * MiB;
constexpr int SM_ABR = 0, SM_ABI = 2048, SM_BBR = 4096, SM_BBI = 4096 + 32768, SM_SP8 = 4096 + 65536, SM_END_F = SM_SP8 + 512;
constexpr int SM_A128 = SM_END_F;
constexpr int SM_A8 = SM_A128 + 4096;
constexpr size_t SM_LRUW_BYTES = 512 * 1024, SM_CT_BYTES = 640 * 1024, SM_BBT_BYTES = 768 * 1024;
static_assert((size_t)(SM_END_F + 8192) * 4 <= SM_LRUW_BYTES, "small");

constexpr int CW_BAR = 4096;
#define XB_TMO      128
#define XB_XCNT(j)  (256  + 64 * (j))
#define XB_XSUB(j)  (1280 + 64 * (j))
#define XB_XGEN(j)  (2304 + 64 * (j))
#define XB_TOP      3328
#define XB_TOPGEN   3392
#define XCD_BAR_WORDS 3456
#define XB_SPIN_CAP (1u << 18)

__device__ __forceinline__ void wg_syncthreads() { __builtin_amdgcn_fence(__ATOMIC_RELEASE, "workgroup"); __builtin_amdgcn_s_barrier(); __builtin_amdgcn_fence(__ATOMIC_ACQUIRE, "workgroup"); }
__device__ __forceinline__ unsigned xb_ld(unsigned* p)              { return __hip_atomic_load(p, __ATOMIC_RELAXED, __HIP_MEMORY_SCOPE_AGENT); }
__device__ __forceinline__ unsigned xb_add(unsigned* p, unsigned v) { return __hip_atomic_fetch_add(p, v, __ATOMIC_RELAXED, __HIP_MEMORY_SCOPE_AGENT); }
__device__ __forceinline__ unsigned xb_xcc_id() { return (unsigned)__builtin_amdgcn_s_getreg((3 << 11) | 20) & 0xFu; }
#define XB_SPIN(cond, bar) do { unsigned _sp = 0; while (cond) { __builtin_amdgcn_s_sleep(1); \
    if ((++_sp & 255u) == 0u) { if (xb_ld(&(bar)[XB_TMO])) break; if (_sp > XB_SPIN_CAP) { (void)xb_add(&(bar)[XB_TMO], 1u); break; } } } } while (0)
struct XcdBarrier { unsigned* bar; unsigned x; volatile LAS unsigned* st; };
__device__ __forceinline__ XcdBarrier xcd_barrier_post(unsigned* bar, volatile LAS unsigned* st) {
    XcdBarrier b; b.bar = bar; b.x = xb_xcc_id(); b.st = st;
    if (threadIdx.x == 0) (void)xb_add(&bar[XB_XCNT(b.x)], 1u);
    return b;
}
__device__ __forceinline__ void xcd_barrier_complete(unsigned* bar, unsigned x, unsigned& nloc, unsigned& nx) {
    const unsigned G = gridDim.x * gridDim.y * gridDim.z;
    unsigned sum, cnt, mine, sp = 0u;
    for (;;) {
        sum = 0u; cnt = 0u; mine = 0u;
#pragma unroll
        for (unsigned j = 0; j < 16; ++j) { const unsigned c = xb_ld(&bar[XB_XCNT(j)]); sum += c; cnt += (c > 0u) ? 1u : 0u; mine = (j == x) ? c : mine; }
        if (sum == G) break;
        __builtin_amdgcn_s_sleep(1);
        if ((++sp & 255u) == 0u) { if (xb_ld(&bar[XB_TMO])) break; if (sp > XB_SPIN_CAP) { (void)xb_add(&bar[XB_TMO], 1u); break; } }
    }
    nloc = mine > 0u ? mine : 1u; nx = cnt > 0u ? cnt : 1u;
}
__device__ __forceinline__ void xcd_barrier(const XcdBarrier& b) {
    asm volatile("s_waitcnt vmcnt(0)" ::: "memory");
    wg_syncthreads();
    if (threadIdx.x == 0) {
        unsigned* bar = b.bar;
        __builtin_amdgcn_s_waitcnt(0);
        unsigned nloc = b.st[0], nx = b.st[1];
        if (nloc == 0u) { xcd_barrier_complete(bar, b.x, nloc, nx); b.st[0] = nloc; b.st[1] = nx; }
        const unsigned old = xb_add(&bar[XB_XSUB(b.x)], 1u);
        const unsigned gen = old / nloc;
        if (old + 1u == (gen + 1u) * nloc) {
            __builtin_amdgcn_fence(__ATOMIC_RELEASE, "agent");
            asm volatile("s_waitcnt vmcnt(0)" ::: "memory");
            const unsigned og = xb_add(&bar[XB_TOP], 1u);
            const unsigned tg = og / nx;
            if (og + 1u == (tg + 1u) * nx) xb_add(&bar[XB_TOPGEN], 1u);
            else XB_SPIN(xb_ld(&bar[XB_TOPGEN]) == tg, bar);
            __builtin_amdgcn_fence(__ATOMIC_ACQUIRE, "agent");
            xb_add(&bar[XB_XGEN(b.x)], 1u);
            asm volatile("s_waitcnt vmcnt(0)" ::: "memory");
        } else {
            XB_SPIN(xb_ld(&bar[XB_XGEN(b.x)]) == gen, bar);
            __builtin_amdgcn_fence(__ATOMIC_ACQUIRE, "agent");
            asm volatile("s_waitcnt vmcnt(0)" ::: "memory");
        }
    }
    wg_syncthreads();
}

__device__ __forceinline__ float bf2f(bf16_t b) { return __builtin_bit_cast(float, ((unsigned)b) << 16); }
__device__ __forceinline__ float bflo(unsigned w) { return __builtin_bit_cast(float, w << 16); }
__device__ __forceinline__ float bfhi(unsigned w) { return __builtin_bit_cast(float, w & 0xffff0000u); }
__device__ __forceinline__ bf16_t f2bf(float f) { return (bf16_t)(cvt_pk_bf16(f, 0.f) & 0xffffu); }
__device__ __forceinline__ float sigmoid_f(float x) { return __builtin_amdgcn_rcpf(1.f + __expf(-x)); }
__device__ __forceinline__ float silu_f(float x) { return x * sigmoid_f(x); }
__device__ __forceinline__ float silu_t(float t) { return t * __builtin_amdgcn_rcpf(__builtin_fmaf(__builtin_amdgcn_exp2f(t), -1.4426950408889634f, -1.4426950408889634f)); }
__device__ __forceinline__ float sig255(float t) { return __builtin_amdgcn_rcpf(__builtin_fmaf(__builtin_amdgcn_exp2f(t), 1.f / 255.f, 1.f / 255.f)); }
__device__ __forceinline__ float gelu_tanh_f(float x) { const float u = 0.7978845608028654f * (x + 0.044715f * x * x * x); const float t = 1.f - 2.f * __builtin_amdgcn_rcpf(1.f + __expf(2.f * u)); return 0.5f * x * (1.f + t); }
__device__ __forceinline__ float shfl_xor_f(float v, int m) { const int ln = (int)__builtin_amdgcn_mbcnt_hi(~0u, __builtin_amdgcn_mbcnt_lo(~0u, 0u)); return __builtin_bit_cast(float, __builtin_amdgcn_ds_bpermute((ln ^ m) << 2, __builtin_bit_cast(int, v))); }
__device__ __forceinline__ float wave_sum(float v) {
#pragma unroll
    for (int o = 1; o < 64; o <<= 1) v += shfl_xor_f(v, o);
    return v;
}

#define GEMM_CALL(EPI) pg8::gemm_phase<EPI, pg8::StaticOrder, true, true>(lds, g, S, E)
struct Args {
    const float* in[29]; float* out; unsigned char* ws;
    int s_lo, s_hi, li, fin, mmask, pad2;
};
enum { I_X = 0, I_NG, I_WIN, I_GWLR, I_GBLR, I_GNG, I_RNG, I_RNB, I_LCW, I_LCB, I_LWA, I_LBA, I_LWX, I_LBX, I_LLAM,
       I_SARE, I_SAIM, I_SBRE, I_SBIM, I_SCRE, I_SCIM, I_SD, I_SLDT, I_SGW, I_SGB, I_WMG, I_WBR, I_WOUT, I_FNG };

struct EpiIn {
    static constexpr bool PERM = true, AFTER_DRAIN = false, KEEP = false;
    bf16_t* P; float* LA; const float* blr; const float* rot; unsigned char* PG; bf16_t* SU;
    __device__ __forceinline__ void operator()(f32x4 (&acc)[2][2][4][2], const pg8::Unit& u, int wr, int wc, int fr, int fq) const {
        const int pn = u.pn, row0 = u.pm * 256 + wr * 64 + fr, cl = wc * 32 + 8 * fq;
        if (pn >= 21) {
#pragma unroll
            for (int ai = 0; ai < 2; ++ai)
#pragma unroll
                for (int m = 0; m < 4; ++m) { int row = row0 + ai * 128 + m * 16; asm volatile("" : "+v"(row));
                    u32x4 w;
#pragma unroll
                    for (int bj = 0; bj < 2; ++bj) { const f32x4 v0 = acc[ai][bj][m][0], v1 = acc[ai][bj][m][1]; unsigned lo = 0u, hi = 0u;
#pragma unroll
                        for (int j = 0; j < 4; ++j) { lo = __builtin_amdgcn_cvt_pk_u8_f32(sig255(v0[j]), j, lo); hi = __builtin_amdgcn_cvt_pk_u8_f32(sig255(v1[j]), j, hi); }
                        if (bj == 0) { w.x = lo; w.y = hi; } else { w.z = lo; w.w = hi; } }
                    __builtin_nontemporal_store(w, (u32x4*)(PG + (size_t)row * N_MG + (pn - 21) * 256 + 2 * cl)); }
        } else if (pn == 4) {
#pragma unroll
            for (int bj = 0; bj < 2; ++bj) { const int c = cl + bj * 128; const f32x4 b0 = *(const f32x4*)(blr + c), b1 = *(const f32x4*)(blr + c + 4);
#pragma unroll
                for (int ai = 0; ai < 2; ++ai) {
#pragma unroll
                    for (int n = 0; n < 2; ++n)
#pragma unroll
                        for (int j = 0; j < 4; ++j) { float run = 0.f; const float bb = n ? b1[j] : b0[j];
#pragma unroll
                            for (int m = 0; m < 4; ++m) { const float z = acc[ai][bj][m][n][j] + bb; const float x = -(fmaxf(-z, 0.f) + __logf(1.f + __expf(-fabsf(z)))) * 0.0625f; float ls = x, rs = x;
#define DPP_ADD(acc_, ctrl_) acc_ += __builtin_bit_cast(float, __builtin_amdgcn_update_dpp(0, __builtin_bit_cast(int, acc_), ctrl_, 0xf, 0xf, true))
                                DPP_ADD(ls, 0x111); DPP_ADD(ls, 0x112); DPP_ADD(ls, 0x114); DPP_ADD(ls, 0x118);
                                DPP_ADD(rs, 0x101); DPP_ADD(rs, 0x102); DPP_ADD(rs, 0x104); DPP_ADD(rs, 0x108);
#undef DPP_ADD
                                acc[ai][bj][m][n][j] = run + ls; run += ls + rs - x; } }
#pragma unroll
                    for (int m = 0; m < 4; ++m) { int row = row0 + ai * 128 + m * 16; asm volatile("" : "+v"(row)); float* d = LA + ((size_t)(c >> 6) * TG + row) * 64 + (c & 63); *(f32x4*)d = acc[ai][bj][m][0]; *(f32x4*)(d + 4) = acc[ai][bj][m][1]; } } }
        } else if (pn == 7 || pn == 8) {
            const int dcol = (pn - 1) * 256;
#pragma unroll
            for (int ai = 0; ai < 2; ++ai)
#pragma unroll
                for (int m = 0; m < 4; ++m) { int row = row0 + ai * 128 + m * 16; asm volatile("" : "+v"(row)); const int pos = row & (SEQ - 1);
#pragma unroll
                    for (int bj = 0; bj < 2; ++bj) { const int c = cl + bj * 128, i0 = (c & 63) >> 1; const float* rt = rot + ((size_t)pos * 32 + i0) * 2;
                        const f32x4 cs0 = *(const f32x4*)rt, cs1 = *(const f32x4*)(rt + 4); const f32x4 v0 = acc[ai][bj][m][0], v1 = acc[ai][bj][m][1];
                        u32x4 w; w.x = cvt_pk_bf16(v0[0] * cs0[0] - v0[1] * cs0[1], v0[0] * cs0[1] + v0[1] * cs0[0]); w.y = cvt_pk_bf16(v0[2] * cs0[2] - v0[3] * cs0[3], v0[2] * cs0[3] + v0[3] * cs0[2]);
                        w.z = cvt_pk_bf16(v1[0] * cs1[0] - v1[1] * cs1[1], v1[0] * cs1[1] + v1[1] * cs1[0]); w.w = cvt_pk_bf16(v1[2] * cs1[2] - v1[3] * cs1[3], v1[2] * cs1[3] + v1[3] * cs1[2]);
                        __builtin_nontemporal_store(w, (u32x4*)(P + (size_t)(dcol + (c & ~63)) * TG + (size_t)row * 64 + (c & 63))); } }
        } else {
            const bool silu = (pn == 5 || pn == 6 || pn == 11 || pn == 12 || pn == 15 || pn == 16 || pn == 19 || pn == 20);
            const int dcol = (pn < 4 ? pn : pn - 1) * 256;
            const int wsh = (pn >= 19) ? 9 : ((pn == 2 || pn == 3 || pn == 5 || pn == 6 || (pn >= 9 && pn <= 12)) ? 7 : 6);
#pragma unroll
            for (int ai = 0; ai < 2; ++ai)
#pragma unroll
                for (int m = 0; m < 4; ++m) { int row = row0 + ai * 128 + m * 16; asm volatile("" : "+v"(row));
#pragma unroll
                    for (int bj = 0; bj < 2; ++bj) { f32x4 v0 = acc[ai][bj][m][0], v1 = acc[ai][bj][m][1];
                        if (silu) {
#pragma unroll
                            for (int j = 0; j < 4; ++j) { v0[j] = silu_t(v0[j]); v1[j] = silu_t(v1[j]); } }
                        u32x4 w; w.x = cvt_pk_bf16(v0[0], v0[1]); w.y = cvt_pk_bf16(v0[2], v0[3]); w.z = cvt_pk_bf16(v1[0], v1[1]); w.w = cvt_pk_bf16(v1[2], v1[3]);
                        if (pn == 17 || pn == 18) { const int cc = (pn - 17) * 256 + cl + bj * 128;
                            __builtin_nontemporal_store(w, (u32x4*)(SU + ((size_t)(cc >> 4) * TG + row) * 16 + (cc & 15))); }
                        else { const int col = dcol + cl + bj * 128; __builtin_nontemporal_store(w, (u32x4*)(P + (size_t)(col >> wsh << wsh) * TG + ((size_t)row << wsh) + (col & ((1 << wsh) - 1)))); } } }
        }
    }
};
struct EpiSig {
    static constexpr bool PERM = true, AFTER_DRAIN = false, KEEP = false;
    bf16_t* PG;
    __device__ __forceinline__ void operator()(const f32x4 (&acc)[2][2][4][2], const pg8::Unit& u, int wr, int wc, int fr, int fq) const {
        const int row0 = u.pm * 256 + wr * 64 + fr, c0 = u.pn * 256 + wc * 32 + 8 * fq;
#pragma unroll
        for (int ai = 0; ai < 2; ++ai)
#pragma unroll
            for (int m = 0; m < 4; ++m) { const int row = row0 + ai * 128 + m * 16;
#pragma unroll
                for (int bj = 0; bj < 2; ++bj) { f32x4 v0 = acc[ai][bj][m][0], v1 = acc[ai][bj][m][1];
#pragma unroll
                    for (int j = 0; j < 4; ++j) { v0[j] = sigmoid_f(v0[j]); v1[j] = sigmoid_f(v1[j]); }
                    u32x4 w; w.x = cvt_pk_bf16(v0[0], v0[1]); w.y = cvt_pk_bf16(v0[2], v0[3]); w.z = cvt_pk_bf16(v1[0], v1[1]); w.w = cvt_pk_bf16(v1[2], v1[3]);
                    *(u32x4*)(PG + (size_t)row * N_MG + c0 + bj * 128) = w; } }
    }
};
struct EpiGlu {
    static constexpr bool PERM = true, AFTER_DRAIN = false, KEEP = false;
    const bf16_t* Y5; const bf16_t* P; const float* gb; bf16_t* O;
    __device__ __forceinline__ void operator()(const f32x4 (&acc)[2][2][4][2], const pg8::Unit& u, int wr, int wc, int fr, int fq) const {
        const int row0 = u.pm * 256 + wr * 64 + fr, c0 = u.pn * 256 + wc * 32 + 8 * fq;
#pragma unroll
        for (int bj = 0; bj < 2; ++bj) { const int c = c0 + bj * 128; const f32x4 b0 = *(const f32x4*)(gb + c), b1 = *(const f32x4*)(gb + c + 4);
#pragma unroll
            for (int ai = 0; ai < 2; ++ai)
#pragma unroll
                for (int m = 0; m < 4; ++m) { const int row = row0 + ai * 128 + m * 16;
                    const u32x4 y = *(const u32x4*)(Y5 + (size_t)row * BW + c), s = *(const u32x4*)(P + (size_t)P_SG * TG + (size_t)row * 512 + c);
                    const f32x4 v0 = acc[ai][bj][m][0] + b0, v1 = acc[ai][bj][m][1] + b1;
                    u32x4 w;
                    w.x = cvt_pk_bf16(bflo(y.x) * sigmoid_f(v0[0]) * bflo(s.x), bfhi(y.x) * sigmoid_f(v0[1]) * bfhi(s.x));
                    w.y = cvt_pk_bf16(bflo(y.y) * sigmoid_f(v0[2]) * bflo(s.y), bfhi(y.y) * sigmoid_f(v0[3]) * bfhi(s.y));
                    w.z = cvt_pk_bf16(bflo(y.z) * sigmoid_f(v1[0]) * bflo(s.z), bfhi(y.z) * sigmoid_f(v1[1]) * bfhi(s.z));
                    w.w = cvt_pk_bf16(bflo(y.w) * sigmoid_f(v1[2]) * bflo(s.w), bfhi(y.w) * sigmoid_f(v1[3]) * bfhi(s.w));
                    *(u32x4*)(O + (size_t)row * OLD + 1536 + c) = w; } }
    }
};
struct EpiBr {
    static constexpr bool PERM = true, AFTER_DRAIN = false, KEEP = false;
    const unsigned char* PG; bf16_t* MRG;
    __device__ __forceinline__ void operator()(f32x4 (&acc)[2][2][4][2], const pg8::Unit& u, int wr, int wc, int fr, int fq) const {
        const int row0 = u.pm * 256 + wr * 64 + fr, c = u.pn * 128 + wc * 32 + 8 * fq, z = u.z;
        const int gpos = (z * 4 + (u.pn >> 1)) * 256 + wc * 64 + fq * 16 + (u.pn & 1) * 8;
#pragma unroll
        for (int ai = 0; ai < 2; ++ai)
#pragma unroll
            for (int m = 0; m < 4; ++m) { const int row = row0 + ai * 128 + m * 16;
                const u32x2 gt = __builtin_nontemporal_load((const u32x2*)(PG + (size_t)row * N_MG + gpos));
                f32x4& p0 = acc[ai][0][m][0]; f32x4& p1 = acc[ai][0][m][1]; f32x4& s0 = acc[ai][1][m][0]; f32x4& s1 = acc[ai][1][m][1];
                if (z == 0) { s0 = (f32x4){0.f, 0.f, 0.f, 0.f}; s1 = s0; }
                s0[0] += p0[0] * (float)(gt.x & 255u); s0[1] += p0[1] * (float)((gt.x >> 8) & 255u); s0[2] += p0[2] * (float)((gt.x >> 16) & 255u); s0[3] += p0[3] * (float)(gt.x >> 24);
                s1[0] += p1[0] * (float)(gt.y & 255u); s1[1] += p1[1] * (float)((gt.y >> 8) & 255u); s1[2] += p1[2] * (float)((gt.y >> 16) & 255u); s1[3] += p1[3] * (float)(gt.y >> 24);
                p0 = (f32x4){0.f, 0.f, 0.f, 0.f}; p1 = p0;
                if (z == 3) { const float q = 1.f / 255.f; s0 *= q; s1 *= q;
                    u32x4 w; w.x = cvt_pk_bf16(s0[0], s0[1]); w.y = cvt_pk_bf16(s0[2], s0[3]); w.z = cvt_pk_bf16(s1[0], s1[1]); w.w = cvt_pk_bf16(s1[2], s1[3]);
                    *(u32x4*)(MRG + (size_t)row * D + c) = w; } }
    }
};
struct EpiOut {
    static constexpr bool PERM = true, AFTER_DRAIN = false, KEEP = false;
    bf16_t* DL;
    __device__ __forceinline__ void operator()(const f32x4 (&acc)[2][2][4][2], const pg8::Unit& u, int wr, int wc, int fr, int fq) const {
        const int row0 = u.pm * 256 + wr * 64 + fr, c0 = u.pn * 256 + wc * 32 + 8 * fq;
#pragma unroll
        for (int ai = 0; ai < 2; ++ai)
#pragma unroll
            for (int m = 0; m < 4; ++m) { const int row = row0 + ai * 128 + m * 16;
#pragma unroll
                for (int bj = 0; bj < 2; ++bj) { const f32x4 v0 = acc[ai][bj][m][0], v1 = acc[ai][bj][m][1];
                    u32x4 w; w.x = cvt_pk_bf16(v0[0], v0[1]); w.y = cvt_pk_bf16(v0[2], v0[3]); w.z = cvt_pk_bf16(v1[0], v1[1]); w.w = cvt_pk_bf16(v1[2], v1[3]);
                    *(u32x4*)(DL + (size_t)row * D + c0 + bj * 128) = w; } }
    }
};

__device__ __forceinline__ int win_src_col(int r) {
    const int pn = r >> 8, j = r & 255;
    switch (pn) {
        case 0: return j; case 1: return 256 + j; case 2: case 3: return 512 + (r - 512);
        case 4: return -1;
        case 5: case 6: return 1040 + (r - 1280);
        case 7: return 1552 + 64 * (j >> 6) + ((j & 63) >> 1) + 32 * (j & 1);
        case 8: return 1808 + 64 * (j >> 6) + ((j & 63) >> 1) + 32 * (j & 1);
        case 9: case 10: return 2064 + (r - 2304);
        case 11: case 12: return 2576 + (r - 2816);
        case 13: case 14: return 3088 + (r - 3328);
        case 15: case 16: return 3600 + (r - 3840);
        case 17: case 18: return 4112 + (r - 4352);
        default: return 4624 + (r - 4864);
    }
}
__device__ __forceinline__ void tr_store8(bf16_t* dst, const float (&v)[8]) {
    u32x4 w; w.x = cvt_pk_bf16(v[0], v[1]); w.y = cvt_pk_bf16(v[2], v[3]); w.z = cvt_pk_bf16(v[4], v[5]); w.w = cvt_pk_bf16(v[6], v[7]); *(u32x4*)dst = w;
}
__device__ __forceinline__ void phase_prologue(const Args& a, int gtid, int gthreads) {
    unsigned char* ws = a.ws;
    for (int l = 0; l < DEPTH; ++l) {
        bf16_t* Wl = (bf16_t*)(ws + WS_W + (size_t)l * W_STRIDE);
        const float* win = a.in[I_WIN] + (size_t)l * D * 5136;
        const float* wlr = a.in[I_GWLR] + (size_t)l * 16 * 256;
        for (int idx = gtid; idx < N_IN * (D / 8); idx += gthreads) { const int n = idx % N_IN, kc = idx / N_IN; const int sc = win_src_col(n); float v[8];
            if (sc >= 0) { const int pn_ = n >> 8; const float ws_ = (pn_ == 5 || pn_ == 6 || pn_ == 11 || pn_ == 12 || pn_ == 15 || pn_ == 16 || pn_ == 19 || pn_ == 20) ? -1.4426950408889634f : ((pn_ == 0 || pn_ == 8) ? 0.125f : 1.f);
#pragma unroll
                for (int i = 0; i < 8; ++i) v[i] = win[(size_t)(kc * 8 + i) * 5136 + sc] * ws_;
            } else { const int j = n & 255;
#pragma unroll
                for (int i = 0; i < 8; ++i) { float s = 0.f; const float* wr_ = win + (size_t)(kc * 8 + i) * 5136 + 1024;
#pragma unroll
                    for (int r = 0; r < 16; ++r) s += wr_[r] * wlr[r * 256 + j];
                    v[i] = s; } }
            tr_store8(Wl + (size_t)n * D + kc * 8, v); }
        const float* wmg = a.in[I_WMG] + (size_t)l * 4 * D * D;
        for (int idx = gtid; idx < N_MG * (D / 8); idx += gthreads) { const int n = idx % N_MG, kc = idx / N_MG, bi = n >> 10, c = n & 1023; float v[8];
#pragma unroll
            for (int i = 0; i < 8; ++i) v[i] = wmg[((size_t)bi * D + kc * 8 + i) * D + c] * -1.4426950408889634f;
            tr_store8(Wl + (size_t)(N_IN + n) * D + kc * 8, v); }
        const float* wbr = a.in[I_WBR] + (size_t)l * 4 * BW * D; bf16_t* Wb = (bf16_t*)((unsigned char*)Wl + WO_BR);
        for (int idx = gtid; idx < 4 * D * (BW / 8); idx += gthreads) { const int n = idx % (4 * D), kc = idx / (4 * D), bi = n >> 10, c = n & 1023; float v[8];
#pragma unroll
            for (int i = 0; i < 8; ++i) v[i] = wbr[((size_t)bi * BW + kc * 8 + i) * D + c];
            tr_store8(Wb + (size_t)n * BW + kc * 8, v); }
        const float* wout = a.in[I_WOUT] + (size_t)l * D * D; bf16_t* Wo = (bf16_t*)((unsigned char*)Wl + WO_OUT);
        for (int idx = gtid; idx < D * (D / 8); idx += gthreads) { const int n = idx % D, kc = idx / D; float v[8];
#pragma unroll
            for (int i = 0; i < 8; ++i) v[i] = wout[(size_t)(kc * 8 + i) * D + n];
            tr_store8(Wo + (size_t)n * D + kc * 8, v); }
        const float* wglu = a.in[I_SGW] + (size_t)l * BW * BW; bf16_t* Wg = (bf16_t*)((unsigned char*)Wl + WO_GLU);
        for (int idx = gtid; idx < BW * (BW / 8); idx += gthreads) { const int n = idx % BW, kc = idx / BW; float v[8];
#pragma unroll
            for (int i = 0; i < 8; ++i) v[i] = wglu[(size_t)(kc * 8 + i) * BW + n];
            tr_store8(Wg + (size_t)n * BW + kc * 8, v); }
        float* sm = (float*)(ws + WS_SMALL + (size_t)l * SMALL_STRIDE);
        for (int idx = gtid; idx < 2048; idx += gthreads) { const int g = idx >> 6;
            const double step = exp((double)a.in[I_SLDT][l * 32 + g]); const double are = a.in[I_SARE][l * 2048 + idx], aim = a.in[I_SAIM][l * 2048 + idx];
            const double mag = exp(step * are), abr = mag * cos(step * aim), abi = mag * sin(step * aim), den = are * are + aim * aim;
            const double fre = ((abr - 1.0) * are + abi * aim) / den, fim = (abi * are - (abr - 1.0) * aim) / den;
            sm[SM_ABR + idx] = (float)abr; sm[SM_ABI + idx] = (float)abi;
            double* s5d = (double*)(ws + WS_S5D) + ((size_t)l * 2048 + idx) * 50;
            { double pr = 1.0, pi = 0.0;
              for (int j = 0; j <= 8; ++j) { s5d[2 * j] = pr; s5d[2 * j + 1] = pi; const double nr = pr * abr - pi * abi, ni = pr * abi + pi * abr; pr = nr; pi = ni; }
              sm[SM_A8 + idx * 2] = (float)s5d[16]; sm[SM_A8 + idx * 2 + 1] = (float)s5d[17]; }
            { const double m128 = exp(512.0 * step * are); sm[SM_A128 + idx * 2] = (float)(m128 * cos(512.0 * step * aim)); sm[SM_A128 + idx * 2 + 1] = (float)(m128 * sin(512.0 * step * aim)); }
            bf16_t* bbt = (bf16_t*)((unsigned char*)sm + SM_BBT_BYTES); const int p_ = idx & 63;
            for (int i = 0; i < 16; ++i) { const double br = a.in[I_SBRE][(size_t)l * 32768 + idx * 16 + i], bi = a.in[I_SBIM][(size_t)l * 32768 + idx * 16 + i];
                s5d[18 + 2 * i] = fre * br - fim * bi; s5d[18 + 2 * i + 1] = fre * bi + fim * br;
                const float vr = (float)(fre * br - fim * bi), vi = (float)(fre * bi + fim * br);
                sm[SM_BBR + idx * 16 + i] = vr; sm[SM_BBI + idx * 16 + i] = vi; bbt[(g * 128 + 2 * p_) * 16 + i] = f2bf(vr); bbt[(g * 128 + 2 * p_ + 1) * 16 + i] = f2bf(vi); } }
        for (int idx = gtid; idx < 512; idx += gthreads) { const float lam = a.in[I_LLAM][l * 512 + idx]; const float nl = -lam;
            sm[SM_SP8 + idx] = 8.0f * (fmaxf(nl, 0.f) + log1pf(expf(-fabsf(nl)))); }
        { bf16_t* ct = (bf16_t*)((unsigned char*)sm + SM_CT_BYTES);
          for (int idx = gtid; idx < 32 * 16 * 128; idx += gthreads) { const int k = idx & 127, gi = idx >> 7;
              const float v = (k & 1) == 0 ? a.in[I_SCRE][(size_t)l * 32768 + gi * 64 + (k >> 1)] : -a.in[I_SCIM][(size_t)l * 32768 + gi * 64 + (k >> 1)]; ct[idx] = f2bf(v); } }
        bf16_t* lw = (bf16_t*)((unsigned char*)sm + SM_LRUW_BYTES);
        for (int idx = gtid; idx < 8 * 128 * 64; idx += gthreads) { const int i = idx & 63, jj = (idx >> 6) & 127, n = idx >> 13;
            const float v = jj < 64 ? a.in[I_LWA][(((size_t)l * 8 + n) * 64 + i) * 64 + jj] : a.in[I_LWX][(((size_t)l * 8 + n) * 64 + i) * 64 + (jj - 64)];
            lw[idx] = f2bf(v * -1.4426950408889634f); }
    }
    float* rot = (float*)(ws + WS_ROT);
    for (int idx = gtid; idx < SEQ * 32; idx += gthreads) { const int i = idx & 31, s = idx >> 5;
        const double inv = pow(10000.0, -(double)i / 32.0), ang = (double)s * inv; rot[idx * 2] = (float)cos(ang); rot[idx * 2 + 1] = (float)sin(ang); }
}

__device__ __forceinline__ void phase_prologue2(const Args& a, int gtid, int gthreads) {
    unsigned char* ws = a.ws;
    for (int l = 0; l < DEPTH; ++l) {
        const double* s5d = (const double*)(ws + WS_S5D) + (size_t)l * 2048 * 50;
        const float* scre = a.in[I_SCRE] + (size_t)l * 32768; const float* scim = a.in[I_SCIM] + (size_t)l * 32768;
        for (int it = gtid; it < 32 * 4096; it += gthreads) { const int g = it >> 12, r = it & 4095, f = r >> 6, ln = r & 63, fr = ln & 15, fq = ln >> 4;
            const int mat = f >> 5, mt = (f & 31) >> 2, ks = f & 3;
            const int m = 16 * mt + fr, k0 = 32 * ks + 8 * fq; float v[8];
            if (mat == 0) { const int p = m >> 1, ri = m & 1, sq = k0 >> 4, c0 = k0 & 15; const double* sd = s5d + (size_t)(g * 64 + p) * 50; const double ar = sd[2 * (7 - sq)], ai = sd[2 * (7 - sq) + 1];
#pragma unroll
                for (int e = 0; e < 8; ++e) { const double br = sd[18 + 2 * (c0 + e)], bi = sd[18 + 2 * (c0 + e) + 1]; v[e] = (float)(ri ? ar * bi + ai * br : ar * br - ai * bi); } }
            else { const int t = m >> 4, i = m & 15;
#pragma unroll
                for (int e = 0; e < 8; ++e) { const int k = k0 + e, p = k >> 1, ri = k & 1; const double* sd = s5d + (size_t)(g * 64 + p) * 50; const double ar = sd[2 * (t + 1)], ai = sd[2 * (t + 1) + 1];
                    const double cr = scre[(g * 16 + i) * 64 + p], ci = scim[(g * 16 + i) * 64 + p]; v[e] = (float)(ri ? -(cr * ai + ci * ar) : cr * ar - ci * ai); } }
            tr_store8((bf16_t*)(ws + WS_S5M + (size_t)(l * 32 + g) * S5M_BYTES + (size_t)r * 16), v); }
        float* kt = (float*)(ws + WS_S5K) + (size_t)l * 32 * 2048;
        for (int it = gtid; it < 32 * 2048; it += gthreads) { const int g = it >> 11, j = (it >> 8) & 7, i = (it >> 4) & 15, c = it & 15; double ac = 0.0;
#pragma unroll 8
            for (int p = 0; p < 64; ++p) { const double* sd = s5d + (size_t)(g * 64 + p) * 50; const double ar = sd[2 * j], ai = sd[2 * j + 1];
                const double cr = scre[(g * 16 + i) * 64 + p], ci = scim[(g * 16 + i) * 64 + p];
                ac += (cr * ar - ci * ai) * sd[18 + 2 * c] - (cr * ai + ci * ar) * sd[18 + 2 * c + 1]; }
            kt[it] = (float)ac; }
    }
}
__device__ __forceinline__ void phase_prologue3(const Args& a, int gtid, int gthreads) {
    unsigned char* ws = a.ws;
    for (int it = gtid; it < DEPTH * 32 * 1280; it += gthreads) { const int lg = it / 1280, r = it % 1280, ff = r >> 6, ln = r & 63, fr = ln & 15, fq = ln >> 4;
        const int mt = ff < 1 ? 0 : ff < 2 ? 1 : ff < 4 ? 2 : ff < 6 ? 3 : ff < 9 ? 4 : ff < 12 ? 5 : ff < 16 ? 6 : 7;
        const int cb = mt < 1 ? 0 : mt < 2 ? 1 : mt < 3 ? 2 : mt < 4 ? 4 : mt < 5 ? 6 : mt < 6 ? 9 : mt < 7 ? 12 : 16, ks = ff - cb;
        const int m = 16 * mt + fr, k0 = 32 * ks + 8 * fq, t = m >> 4, i = m & 15, sq = k0 >> 4, c0 = k0 & 15; float v[8];
        const float* kt = (const float*)(ws + WS_S5K) + (size_t)lg * 2048 + ((sq <= t ? t - sq : 0) * 16 + i) * 16 + c0;
#pragma unroll
        for (int e = 0; e < 8; ++e) v[e] = sq <= t ? kt[e] : 0.f;
        tr_store8((bf16_t*)(ws + WS_S5M + (size_t)lg * S5M_BYTES + 65536 + (size_t)r * 16), v); }
}

template <bool F32OUT, bool ADD>
__device__ __forceinline__ void phase_norm(const float* hin, const bf16_t* delta, float* hout, const float* gain, bf16_t* uout, int gw, int ngw, int lane) {
    f32x4 gv[4];
#pragma unroll
    for (int j = 0; j < 4; ++j) gv[j] = *(const f32x4*)(gain + 4 * lane + 256 * j);
    for (int row = gw; row < TG; row += ngw) {
        const f32x4* xr = (const f32x4*)(hin + (size_t)row * D) + lane; f32x4 v[4]; float s = 0.f;
#pragma unroll
        for (int j = 0; j < 4; ++j) v[j] = __builtin_nontemporal_load(xr + 64 * j);
        if (ADD) { const u32x2* dr = (const u32x2*)(delta + (size_t)row * D) + lane;
#pragma unroll
            for (int j = 0; j < 4; ++j) { const u32x2 dw = __builtin_nontemporal_load(dr + 64 * j); v[j].x += bflo(dw.x); v[j].y += bfhi(dw.x); v[j].z += bflo(dw.y); v[j].w += bfhi(dw.y); } }
#pragma unroll
        for (int j = 0; j < 4; ++j) s += (v[j].x * v[j].x + v[j].y * v[j].y) + (v[j].z * v[j].z + v[j].w * v[j].w);
        const float rstd = rsqrtf(wave_sum(s) * (1.f / D) + NORM_EPS);
        if (F32OUT) { f32x4* o = (f32x4*)(hout + (size_t)row * D) + lane;
#pragma unroll
            for (int j = 0; j < 4; ++j) o[64 * j] = v[j] * rstd * gv[j];
        } else {
            if (ADD) { f32x4* o = (f32x4*)(hout + (size_t)row * D) + lane;
#pragma unroll
                for (int j = 0; j < 4; ++j) o[64 * j] = v[j]; }
            u32x2* o = (u32x2*)(uout + (size_t)row * D) + lane;
#pragma unroll
            for (int j = 0; j < 4; ++j) { const f32x4 y = v[j] * rstd * gv[j]; u32x2 w; w.x = cvt_pk_bf16(y.x, y.y); w.y = cvt_pk_bf16(y.z, y.w); o[64 * j] = w; } }
    }
}

constexpr int NSEGG = 8;
constexpr int NSEGL = 32;
constexpr int NSEGS = 8;
constexpr size_t ST_GSEG = 0;
constexpr size_t ST_GDS = ST_GSEG + (size_t)2 * BG * 4 * NSEGG * 8192;
constexpr size_t ST_LRU = ST_GDS + (size_t)2 * BG * 4 * NSEGG * 64;
constexpr size_t ST_S5 = ST_LRU + (size_t)BG * NSEGL * 512 * 2;
constexpr size_t ST_END_F = ST_S5 + (size_t)BG * NSEGS * 32 * 128;
static_assert(ST_END_F * 4 <= 64 * MiB, "state scratch");
typedef short s16x4 __attribute__((ext_vector_type(4)));

__device__ __forceinline__ bf16x8 lds_tr_frag(LAS const unsigned char* base, int row_stride_bytes, int lane) {
    const int g = lane >> 4, idx = lane & 15, q = idx >> 2, p = idx & 3;
    LAS const unsigned char* a0 = base + (8 * g + q) * row_stride_bytes + 8 * p;
    const s16x4 r0 = __builtin_amdgcn_ds_read_tr16_b64_v4i16((LAS s16x4*)a0);
    const s16x4 r1 = __builtin_amdgcn_ds_read_tr16_b64_v4i16((LAS s16x4*)(a0 + 4 * row_stride_bytes));
    bf16x8 f; f[0] = r0[0]; f[1] = r0[1]; f[2] = r0[2]; f[3] = r0[3]; f[4] = r1[0]; f[5] = r1[1]; f[6] = r1[2]; f[7] = r1[3]; return f;
}
#define WGSYNC() do { asm volatile("s_waitcnt lgkmcnt(0)" ::: "memory"); __builtin_amdgcn_s_barrier(); asm volatile("" ::: "memory"); } while (0)

constexpr int GL_QD = 0, GL_KD = 9216, GL_KT = 18432, GL_V = 27648, GL_ST = 45056, GL_LAST = 63488, GL_RED = 63744, GL_RED2 = 64256;
struct GlaP { const bf16_t* P; const float* LA; const float* gain; const float* bias; bf16_t* O; float* SSEG; float* DSUM; };
__device__ __forceinline__ bf16x8 lds_tr_frag2(LAS const unsigned char* base, int row_stride_bytes, int lane, int mulg, int second_off) {
    const int g = lane >> 4, idx = lane & 15, q = idx >> 2, p = idx & 3;
    LAS const unsigned char* a0 = base + (mulg * g + q) * row_stride_bytes + 8 * p;
    const s16x4 r0 = __builtin_amdgcn_ds_read_tr16_b64_v4i16((LAS s16x4*)a0);
    const s16x4 r1 = __builtin_amdgcn_ds_read_tr16_b64_v4i16((LAS s16x4*)(a0 + second_off * row_stride_bytes));
    bf16x8 f; f[0] = r0[0]; f[1] = r0[1]; f[2] = r0[2]; f[3] = r0[3]; f[4] = r1[0]; f[5] = r1[1]; f[6] = r1[2]; f[7] = r1[3]; return f;
}
__device__ __forceinline__ bf16x8 pack8(const f32x4 a, const f32x4 b) { u32x4 w; w.x = cvt_pk_bf16(a[0], a[1]); w.y = cvt_pk_bf16(a[2], a[3]); w.z = cvt_pk_bf16(b[0], b[1]); w.w = cvt_pk_bf16(b[2], b[3]); return __builtin_bit_cast(bf16x8, w); }

template <bool PASSC>
__device__ __forceinline__ void glaret_item(LAS unsigned char* lds, const GlaP& gp, const bool gla, const int b, const int h, const int seg, const int sidx  ) {
    int tid = threadIdx.x; asm volatile("" : "+v"(tid));
    const int w = __builtin_amdgcn_readfirstlane(tid >> 6), l = tid & 63, fr = l & 15, fq = l >> 4;
    const int qoff = gla ? P_GQ : P_RQ, koff = gla ? P_GK : P_RK, voff = gla ? P_GV : P_RV, goff = gla ? P_GG : P_RG, ooff = gla ? 0 : 512;
    const float lg = __logf(1.f - exp2f(-5.f - (float)h));
    f32x4 accs[4];
#pragma unroll
    for (int dt = 0; dt < 4; ++dt) accs[dt] = (f32x4){0.f, 0.f, 0.f, 0.f};
    const int arow = 8 * w + (l >> 3), apart = l & 7;
    float dsum[8];
#pragma unroll
    for (int e = 0; e < 8; ++e) dsum[e] = 0.f;
    if (PASSC) {
        for (int sp = 0; sp < seg; ++sp) {
            const float* sg = gp.SSEG + (size_t)(sidx + sp) * 8192 + tid * 16; const float* dsm = gp.DSUM + (size_t)(sidx + sp) * 64;
#pragma unroll
            for (int dt = 0; dt < 4; ++dt) { const f32x4 dv = *(const f32x4*)(dsm + 16 * dt + 4 * fq), sv = *(const f32x4*)(sg + 4 * dt);
#pragma unroll
                for (int r = 0; r < 4; ++r) accs[dt][r] = accs[dt][r] * __expf(dv[r]) + sv[r]; }
        }
#pragma unroll
        for (int dt = 0; dt < 4; ++dt) { u32x2 wv; wv.x = cvt_pk_bf16(accs[dt][0], accs[dt][1]); wv.y = cvt_pk_bf16(accs[dt][2], accs[dt][3]);
            *(LAS u32x2*)(lds + GL_ST + (16 * w + fr) * 144 + 32 * dt + 8 * fq) = wv; }
    }
    const int it = w & 3, ch = w >> 2;
    f32x4 gnv[4], bsv[4];
#pragma unroll
    for (int ct = 0; ct < 4; ++ct) { const int c = 128 * h + 64 * ch + 16 * ct + 4 * fq; gnv[ct] = PASSC ? *(const f32x4*)(gp.gain + c) : (f32x4){0.f, 0.f, 0.f, 0.f};
        bsv[ct] = (PASSC && !gla) ? *(const f32x4*)(gp.bias + c) : (f32x4){0.f, 0.f, 0.f, 0.f}; }
    u32x4 rq = (u32x4){0u, 0u, 0u, 0u}, rk, rv[2]; f32x4 rla[2], rll[2]; u32x2 gnx[4];
    const float rq_s = __expf((float)(arow + 1) * lg), rk_s = __expf(-(float)(arow + 1) * lg), rt_s = __expf((float)(63 - arow) * lg);
#define GL_ISSUE(n_) do { const size_t r0_ = (size_t)b * SEQ + seg * 512 + (n_) * 64; \
        { const size_t ro_ = (r0_ + arow) * 64 + 8 * apart; if (PASSC) rq = *(const u32x4*)(gp.P + (size_t)(qoff + 64 * h) * TG + ro_); rk = *(const u32x4*)(gp.P + (size_t)(koff + 64 * h) * TG + ro_); \
          if (gla) { const float* lp_ = gp.LA + (size_t)h * TG * 64 + ro_; rla[0] = *(const f32x4*)lp_; rla[1] = *(const f32x4*)(lp_ + 4); const float* ll_ = gp.LA + ((size_t)h * TG + r0_ + 63) * 64 + 8 * apart; rll[0] = *(const f32x4*)ll_; rll[1] = *(const f32x4*)(ll_ + 4); } \
          else { rla[0] = (f32x4){0.f, 0.f, 0.f, 0.f}; rla[1] = rla[0]; rll[0] = rla[0]; rll[1] = rla[0]; } } \
        _Pragma("unroll") for (int e_ = 0; e_ < 2; ++e_) { const int p_ = tid + 512 * e_, i_ = p_ >> 4, part_ = p_ & 15; \
            rv[e_] = *(const u32x4*)(gp.P + (size_t)(voff + 128 * h) * TG + (r0_ + i_) * 128 + 8 * part_); } \
        if (PASSC) { _Pragma("unroll") for (int ct_ = 0; ct_ < 4; ++ct_) gnx[ct_] = *(const u32x2*)(gp.P + (size_t)(goff + 128 * h) * TG + (r0_ + 16 * it + fr) * 128 + 64 * ch + 16 * ct_ + 4 * fq); } } while (0)
    GL_ISSUE(0);
    for (int n = 0; n < 8; ++n) {
        const size_t row0 = (size_t)b * SEQ + seg * 512 + n * 64;
#pragma unroll
        for (int e = 0; e < 2; ++e) { const int p = tid + 512 * e, i = p >> 4, part = p & 15; *(LAS u32x4*)(lds + GL_V + i * 272 + part * 16) = rv[e]; }
        { float cum[8], lastv[8];
          const float kk[8] = {bflo(rk.x), bfhi(rk.x), bflo(rk.y), bfhi(rk.y), bflo(rk.z), bfhi(rk.z), bflo(rk.w), bfhi(rk.w)};
          float eq[8], ek[8], et[8];
          if (gla) {
#pragma unroll
              for (int e = 0; e < 8; ++e) { cum[e] = e < 4 ? rla[0][e] : rla[1][e - 4]; lastv[e] = e < 4 ? rll[0][e] : rll[1][e - 4];
                  eq[e] = __expf(cum[e]); ek[e] = __builtin_amdgcn_rcpf(eq[e]); et[e] = __expf(lastv[e]) * ek[e]; }
          } else {
#pragma unroll
              for (int e = 0; e < 8; ++e) { lastv[e] = 64.f * lg; eq[e] = rq_s; ek[e] = rk_s; et[e] = rt_s; } }
#pragma unroll
          for (int e = 0; e < 8; ++e) *(LAS bf16_t*)(lds + GL_KT + (8 * apart + e) * 144 + arow * 2) = f2bf(kk[e] * et[e]);
          if (PASSC) { const float qq[8] = {bflo(rq.x), bfhi(rq.x), bflo(rq.y), bfhi(rq.y), bflo(rq.z), bfhi(rq.z), bflo(rq.w), bfhi(rq.w)};
              u32x4 qw, kw;
              qw.x = cvt_pk_bf16(qq[0] * eq[0], qq[1] * eq[1]); qw.y = cvt_pk_bf16(qq[2] * eq[2], qq[3] * eq[3]); qw.z = cvt_pk_bf16(qq[4] * eq[4], qq[5] * eq[5]); qw.w = cvt_pk_bf16(qq[6] * eq[6], qq[7] * eq[7]);
              kw.x = cvt_pk_bf16(kk[0] * ek[0], kk[1] * ek[1]); kw.y = cvt_pk_bf16(kk[2] * ek[2], kk[3] * ek[3]); kw.z = cvt_pk_bf16(kk[4] * ek[4], kk[5] * ek[5]); kw.w = cvt_pk_bf16(kk[6] * ek[6], kk[7] * ek[7]);
              *(LAS u32x4*)(lds + GL_QD + arow * 144 + 16 * apart) = qw; *(LAS u32x4*)(lds + GL_KD + arow * 144 + 16 * apart) = kw; }
          if (arow == 63) {
#pragma unroll
              for (int e = 0; e < 8; ++e) *(LAS float*)(lds + GL_LAST + (8 * apart + e) * 4) = lastv[e]; }
#pragma unroll
          for (int e = 0; e < 8; ++e) dsum[e] += lastv[e]; }
        u32x2 gates[4];
        if (PASSC) {
#pragma unroll
            for (int ct = 0; ct < 4; ++ct) gates[ct] = gnx[ct]; }
        if (n < 7) GL_ISSUE(n + 1);
        WGSYNC();
        f32x4 acco[4];
        if (PASSC) {
            bf16x8 qf[2];
#pragma unroll
            for (int ks = 0; ks < 2; ++ks) qf[ks] = *(LAS const bf16x8*)(lds + GL_QD + (16 * it + fr) * 144 + 16 * fq + 64 * ks);
            f32x4 sc[4];
#pragma unroll
            for (int jt = 0; jt < 4; ++jt) { sc[jt] = (f32x4){0.f, 0.f, 0.f, 0.f};
                if (jt <= it) {
#pragma unroll
                    for (int ks = 0; ks < 2; ++ks) { const bf16x8 kf = *(LAS const bf16x8*)(lds + GL_KD + (16 * jt + fr) * 144 + 16 * fq + 64 * ks);
                        sc[jt] = __builtin_amdgcn_mfma_f32_16x16x32_bf16(kf, qf[ks], sc[jt], 0, 0, 0); }
                    if (jt == it) {
#pragma unroll
                        for (int r = 0; r < 4; ++r) sc[jt][r] = (4 * fq + r <= fr) ? sc[jt][r] : 0.f; } } }
            const bf16x8 pf0 = pack8(sc[0], sc[1]), pf1 = pack8(sc[2], sc[3]);
#pragma unroll
            for (int ct = 0; ct < 4; ++ct) { const int c0 = 64 * ch + 16 * ct; acco[ct] = (f32x4){0.f, 0.f, 0.f, 0.f};
                { const bf16x8 vf = lds_tr_frag2(lds + GL_V + c0 * 2, 272, l, 4, 16); acco[ct] = __builtin_amdgcn_mfma_f32_16x16x32_bf16(vf, pf0, acco[ct], 0, 0, 0); }
                if (it >= 2) { const bf16x8 vf = lds_tr_frag2(lds + GL_V + 32 * 272 + c0 * 2, 272, l, 4, 16); acco[ct] = __builtin_amdgcn_mfma_f32_16x16x32_bf16(vf, pf1, acco[ct], 0, 0, 0); }
#pragma unroll
                for (int ks = 0; ks < 2; ++ks) { const bf16x8 sf = *(LAS const bf16x8*)(lds + GL_ST + (c0 + fr) * 144 + 16 * fq + 64 * ks);
                    acco[ct] = __builtin_amdgcn_mfma_f32_16x16x32_bf16(sf, qf[ks], acco[ct], 0, 0, 0); } }
        }
#pragma unroll
        for (int dt = 0; dt < 4; ++dt) { const f32x4 lv = *(LAS const f32x4*)(lds + GL_LAST + (16 * dt + 4 * fq) * 4);
#pragma unroll
            for (int r = 0; r < 4; ++r) accs[dt][r] *= __expf(lv[r]); }
#pragma unroll
        for (int ks = 0; ks < 2; ++ks) { const bf16x8 vf = lds_tr_frag2(lds + GL_V + (32 * ks) * 272 + (16 * w) * 2, 272, l, 8, 4);
#pragma unroll
            for (int dt = 0; dt < 4; ++dt) { const bf16x8 kf = *(LAS const bf16x8*)(lds + GL_KT + (16 * dt + fr) * 144 + 16 * fq + 64 * ks);
                accs[dt] = __builtin_amdgcn_mfma_f32_16x16x32_bf16(kf, vf, accs[dt], 0, 0, 0); } }
        if (PASSC) {
            float ss = 0.f, sm_ = 0.f;
#pragma unroll
            for (int ct = 0; ct < 4; ++ct)
#pragma unroll
                for (int r = 0; r < 4; ++r) { ss += acco[ct][r] * acco[ct][r]; sm_ += acco[ct][r]; }
            ss += shfl_xor_f(ss, 16); ss += shfl_xor_f(ss, 32); sm_ += shfl_xor_f(sm_, 16); sm_ += shfl_xor_f(sm_, 32);
            if (fq == 0) { *(LAS float*)(lds + GL_RED + ((16 * it + fr) * 2 + ch) * 4) = ss; *(LAS float*)(lds + GL_RED2 + ((16 * it + fr) * 2 + ch) * 4) = sm_; }
        }
        WGSYNC();
        if (PASSC) {
            const int i = 16 * it + fr;
            const float ssum = *(LAS const float*)(lds + GL_RED + (i * 2) * 4) + *(LAS const float*)(lds + GL_RED + (i * 2 + 1) * 4);
            const float msum = *(LAS const float*)(lds + GL_RED2 + (i * 2) * 4) + *(LAS const float*)(lds + GL_RED2 + (i * 2 + 1) * 4);
            float mean, rstd;
            if (gla) { mean = 0.f; rstd = rsqrtf(ssum * (1.f / 128.f) + NORM_EPS); }
            else { mean = msum * (1.f / 128.f); const float var = fmaxf(ssum * (1.f / 128.f) - mean * mean, 0.f); rstd = rsqrtf(var + NORM_EPS); }
#pragma unroll
            for (int ct = 0; ct < 4; ++ct) { const int c = 128 * h + 64 * ch + 16 * ct + 4 * fq; const f32x4 gn = gnv[ct], bs = bsv[ct];
                const float g0 = bflo(gates[ct].x), g1 = bfhi(gates[ct].x), g2 = bflo(gates[ct].y), g3 = bfhi(gates[ct].y);
                u32x2 ow; ow.x = cvt_pk_bf16(((acco[ct][0] - mean) * rstd * gn[0] + bs[0]) * g0, ((acco[ct][1] - mean) * rstd * gn[1] + bs[1]) * g1);
                ow.y = cvt_pk_bf16(((acco[ct][2] - mean) * rstd * gn[2] + bs[2]) * g2, ((acco[ct][3] - mean) * rstd * gn[3] + bs[3]) * g3);
                *(u32x2*)(gp.O + (row0 + i) * OLD + ooff + c) = ow; }
#pragma unroll
            for (int dt = 0; dt < 4; ++dt) { u32x2 wv; wv.x = cvt_pk_bf16(accs[dt][0], accs[dt][1]); wv.y = cvt_pk_bf16(accs[dt][2], accs[dt][3]);
                *(LAS u32x2*)(lds + GL_ST + (16 * w + fr) * 144 + 32 * dt + 8 * fq) = wv; }
        }
    }
#undef GL_ISSUE
    if (!PASSC) {
        float* sg = gp.SSEG + (size_t)(sidx + seg) * 8192 + tid * 16;
#pragma unroll
        for (int dt = 0; dt < 4; ++dt) *(f32x4*)(sg + 4 * dt) = accs[dt];
        if (tid < 8) {
#pragma unroll
            for (int e = 0; e < 8; ++e) gp.DSUM[(size_t)(sidx + seg) * 64 + 8 * apart + e] = dsum[e]; }
    }
    WGSYNC();
}

constexpr int LR_XC = 0, LR_XCF = 2304, LR_AA = 6400, LR_GG = 10496, LR_WAVE = 14592;
struct LruP { const bf16_t* P; const float* cw; const float* cb; const float* ba; const float* bx; const float* sp8; const bf16_t* lw; bf16_t* O; float* LST; };
template <bool PASSC>
__device__ __forceinline__ void lru_wave(LAS unsigned char* lw_, const LruP& lp, const int b, const int seg, const int n, const int l_) {
    int l = l_; asm volatile("" : "+v"(l));
    const float NL2E = -1.4426950408889634f;
    const int fr = l & 15, fq = l >> 4, ch = 64 * n + l;
    bf16x8 wB[8][2];
#pragma unroll
    for (int jt = 0; jt < 8; ++jt)
#pragma unroll
        for (int ks = 0; ks < 2; ++ks) wB[jt][ks] = *(const bf16x8*)(lp.lw + ((size_t)(n * 128 + 16 * jt + fr)) * 64 + 8 * fq + 32 * ks);
    const float w0 = lp.cw[ch], w1 = lp.cw[512 + ch], w2 = lp.cw[1024 + ch], w3 = lp.cw[1536 + ch], cbv = lp.cb[ch];
    float bav[4], bxv[4], spv[4];
#pragma unroll
    for (int jt = 0; jt < 4; ++jt) { const int c2 = 64 * n + 16 * jt + fr; bav[jt] = lp.ba[c2] * NL2E; bxv[jt] = lp.bx[c2] * NL2E; spv[jt] = lp.sp8[c2] * NL2E; }
    const size_t rowb = (size_t)b * SEQ + seg * 128;
    const bf16_t* px = lp.P + (size_t)(P_LX + 64 * n) * TG + rowb * 64;
    const bf16_t* pg = lp.P + (size_t)(P_LG + 64 * n) * TG + rowb * 64;
    bf16_t* po = lp.O + rowb * OLD + 1024 + 64 * n;
    float xm3 = 0.f, xm2 = 0.f, xm1 = 0.f;
    if (seg > 0) { xm3 = bf2f(px[l - 3 * 64]); xm2 = bf2f(px[l - 2 * 64]); xm1 = bf2f(px[l - 64]); }
    float hst = 0.f, ap = 1.f;
    if (PASSC) { const float* st = lp.LST + ((size_t)b * NSEGL * 512 + ch) * 2;
        pg8::f32x2_ ah[31];
#pragma unroll
        for (int e = 0; e < 31; ++e) { const int sp = e < seg ? e : 0; ah[e] = *(const pg8::f32x2_*)(st + (size_t)sp * 1024); }
#pragma unroll
        for (int e = 0; e < 31; ++e) if (e < seg) hst = ah[e][0] * hst + ah[e][1]; }
#define LR_ROWLD(dst, base, t) do { dst = (base)[(t) * 64 + l]; } while (0)
    bf16_t xn[16], gn[16];
#pragma unroll
    for (int t = 0; t < 16; ++t) LR_ROWLD(xn[t], px, t);
    for (int sb = 0; sb < 8; ++sb) {
        float xc[16];
        if (PASSC) {
#pragma unroll
            for (int t = 0; t < 16; ++t) LR_ROWLD(gn[t], pg, sb * 16 + t); }
#pragma unroll
        for (int t = 0; t < 16; ++t) { const float x0 = bf2f(xn[t]); xc[t] = cbv + w0 * xm3 + w1 * xm2 + w2 * xm1 + w3 * x0; xm3 = xm2; xm2 = xm1; xm1 = x0;
            *(LAS bf16_t*)(lw_ + LR_XC + t * 144 + l * 2) = f2bf(xc[t]); }
        if (sb < 7) {
#pragma unroll
            for (int t = 0; t < 16; ++t) LR_ROWLD(xn[t], px, (sb + 1) * 16 + t); }
        __builtin_amdgcn_wave_barrier();
        f32x4 acc[8];
#pragma unroll
        for (int jt = 0; jt < 8; ++jt) { const float bz = jt < 4 ? bav[jt] : bxv[jt - 4]; acc[jt] = (f32x4){bz, bz, bz, bz}; }
#pragma unroll
        for (int ks = 0; ks < 2; ++ks) { const bf16x8 af = *(LAS const bf16x8*)(lw_ + LR_XC + fr * 144 + 16 * fq + 64 * ks);
#pragma unroll
            for (int jt = 0; jt < 8; ++jt) acc[jt] = __builtin_amdgcn_mfma_f32_16x16x32_bf16(af, wB[jt][ks], acc[jt], 0, 0, 0); }
#pragma unroll
        for (int jt = 0; jt < 4; ++jt)
#pragma unroll
            for (int r = 0; r < 4; ++r) { const int tok = 4 * fq + r, j = 16 * jt + fr;
                const float rg = __builtin_amdgcn_rcpf(1.f + __builtin_amdgcn_exp2f(acc[jt][r])), ig = __builtin_amdgcn_rcpf(1.f + __builtin_amdgcn_exp2f(acc[4 + jt][r]));
                const float av = __builtin_amdgcn_exp2f(rg * spv[jt]);
                *(LAS float*)(lw_ + LR_AA + tok * 256 + j * 4) = av; const float em = fmaf(-av, av, 1.f);
                *(LAS float*)(lw_ + LR_GG + tok * 256 + j * 4) = ig * __builtin_amdgcn_sqrtf(em); }
        __builtin_amdgcn_wave_barrier();
#pragma unroll
        for (int t = 0; t < 16; ++t) { const float av = *(LAS const float*)(lw_ + LR_AA + t * 256 + l * 4), gv = *(LAS const float*)(lw_ + LR_GG + t * 256 + l * 4);
            hst = av * hst + gv * xc[t]; ap *= av;
            if (PASSC) { bf16_t* p_ = po + (size_t)(sb * 16 + t) * OLD; asm volatile("" : "+s"(p_)); p_[l] = f2bf(hst * bf2f(gn[t])); } }
        __builtin_amdgcn_wave_barrier();
    }
#undef LR_ROWLD
    if (!PASSC) { float* st = lp.LST + (((size_t)b * NSEGL + seg) * 512 + ch) * 2; st[0] = ap; st[1] = hst; }
}

constexpr int S5_MG = 0, S5_MC = 32768, S5_MM = 65536, S5_MEND = 86016, S5W_STRIDE = 8448;
struct S5P { const bf16_t* P; const bf16_t* SU; const float* sm; const unsigned char* s5m; const float* a128; const float* dd; bf16_t* Y5; float* SST; };
__device__ __forceinline__ float gelu_t(float x) { const float t = x * __builtin_fmaf(x * x, -0.10294324f, -2.3022082f);
    return x * __builtin_amdgcn_rcpf(1.f + __builtin_amdgcn_exp2f(t)); }
template <bool PASSC>
__device__ __forceinline__ void s5_wave(LAS unsigned char* lds, LAS unsigned char* lw_, const S5P& sp_, const int b, const int seg, const int g, const int l_) {
    int l = l_; asm volatile("" : "+v"(l));
    const int fr = l & 15, fq = l >> 4;
    const float a8r = sp_.sm[SM_A8 + (g * 64 + l) * 2], a8i = sp_.sm[SM_A8 + (g * 64 + l) * 2 + 1];
    float xr = 0.f, xi = 0.f;
    f32x4 dv4 = (f32x4){0.f, 0.f, 0.f, 0.f};
    if (PASSC) {
        const float ar = sp_.a128[(g * 64 + l) * 2], ai = sp_.a128[(g * 64 + l) * 2 + 1];
        const float* st = sp_.SST + ((size_t)b * NSEGS * 32 + g) * 128 + l;
        for (int sp0 = 0; sp0 < seg; sp0 += 8) { float er[8], ei[8];
#pragma unroll
            for (int e = 0; e < 8; ++e) { const int sp = sp0 + e < seg ? sp0 + e : seg - 1; er[e] = st[(size_t)sp * 4096]; ei[e] = st[(size_t)sp * 4096 + 64]; }
#pragma unroll
            for (int e = 0; e < 8; ++e) if (sp0 + e < seg) { const float nr = ar * xr - ai * xi + er[e], ni = ar * xi + ai * xr + ei[e]; xr = nr; xi = ni; } }
        dv4 = *(const f32x4*)(sp_.dd + 16 * g + 4 * fq);
    }
    const size_t rowb = (size_t)b * SEQ + seg * 512;
    bf16x8 ufn[4];
#pragma unroll
    for (int ks = 0; ks < 4; ++ks) ufn[ks] = *(const bf16x8*)(sp_.SU + ((size_t)g * TG + rowb + 8 * fr + 2 * ks + (fq >> 1)) * 16 + 8 * (fq & 1));
    for (int sup = 0; sup < 4; ++sup) {
        const size_t r0 = rowb + sup * 128;
        bf16x8 uf[4];
#pragma unroll
        for (int ks = 0; ks < 4; ++ks) uf[ks] = ufn[ks];
        if (sup < 3) {
#pragma unroll
            for (int ks = 0; ks < 4; ++ks) ufn[ks] = *(const bf16x8*)(sp_.SU + ((size_t)g * TG + r0 + 128 + 8 * fr + 2 * ks + (fq >> 1)) * 16 + 8 * (fq & 1)); }
        u32x2 us[8];
        if (PASSC) {
#pragma unroll
            for (int mt = 0; mt < 8; ++mt) us[mt] = *(const u32x2*)(sp_.SU + ((size_t)g * TG + r0 + 8 * fr + mt) * 16 + 4 * fq); }
#pragma unroll
        for (int mt = 0; mt < 8; ++mt) { f32x4 ga = (f32x4){0.f, 0.f, 0.f, 0.f};
#pragma unroll
            for (int ks = 0; ks < 4; ++ks) ga = __builtin_amdgcn_mfma_f32_16x16x32_bf16(*(LAS const bf16x8*)(lds + S5_MG + ((mt * 4 + ks) * 64 + l) * 16), uf[ks], ga, 0, 0, 0);
            *(LAS f32x4*)(lw_ + fr * 528 + (16 * mt + 4 * fq) * 4) = ga; }
        __builtin_amdgcn_wave_barrier();
        pg8::f32x2_ gv[16];
#pragma unroll
        for (int t = 0; t < 16; ++t) gv[t] = *(LAS const pg8::f32x2_*)(lw_ + t * 528 + l * 8);
        __builtin_amdgcn_wave_barrier();
#pragma unroll
        for (int t = 0; t < 16; ++t) {
            if (PASSC) *(LAS unsigned*)(lw_ + t * 528 + l * 4) = cvt_pk_bf16(xr, xi);
            const float nr = __builtin_fmaf(a8r, xr, __builtin_fmaf(-a8i, xi, gv[t][0])), ni = __builtin_fmaf(a8r, xi, __builtin_fmaf(a8i, xr, gv[t][1])); xr = nr; xi = ni; }
        if (PASSC) {
            __builtin_amdgcn_wave_barrier();
            bf16x8 xf[4];
#pragma unroll
            for (int ks = 0; ks < 4; ++ks) xf[ks] = *(LAS const bf16x8*)(lw_ + fr * 528 + (32 * ks + 8 * fq) * 2);
#pragma unroll
            for (int mt = 0; mt < 8; ++mt) { f32x4 ya = (f32x4){0.f, 0.f, 0.f, 0.f}; const int cb = mt < 1 ? 0 : mt < 2 ? 1 : mt < 3 ? 2 : mt < 4 ? 4 : mt < 5 ? 6 : mt < 6 ? 9 : mt < 7 ? 12 : 16;
#pragma unroll
                for (int ks = 0; ks < 4; ++ks) if (2 * ks <= mt) ya = __builtin_amdgcn_mfma_f32_16x16x32_bf16(*(LAS const bf16x8*)(lds + S5_MM + ((cb + ks) * 64 + l) * 16), uf[ks], ya, 0, 0, 0);
#pragma unroll
                for (int ks = 0; ks < 4; ++ks) ya = __builtin_amdgcn_mfma_f32_16x16x32_bf16(*(LAS const bf16x8*)(lds + S5_MC + ((mt * 4 + ks) * 64 + l) * 16), xf[ks], ya, 0, 0, 0);
                u32x2 yw; yw.x = cvt_pk_bf16(gelu_t(ya[0] + dv4[0] * bflo(us[mt].x)), gelu_t(ya[1] + dv4[1] * bfhi(us[mt].x))); yw.y = cvt_pk_bf16(gelu_t(ya[2] + dv4[2] * bflo(us[mt].y)), gelu_t(ya[3] + dv4[3] * bfhi(us[mt].y)));
                *(u32x2*)(sp_.Y5 + (r0 + 8 * fr + mt) * BW + 16 * g + 4 * fq) = yw; }
        }
        __builtin_amdgcn_wave_barrier();
    }
    if (!PASSC) { float* st = sp_.SST + (((size_t)b * NSEGS + seg) * 32 + g) * 128 + l; st[0] = xr; st[64] = xi; }
}

template <bool PASSC>
__device__ __forceinline__ void phase_mixers(LAS unsigned char* lds, const Args& a, const int l, const int G) {
    const int mmask = a.mmask;
    unsigned char* ws = a.ws; const float* sm = (const float*)(ws + WS_SMALL + (size_t)l * SMALL_STRIDE);
    const bf16_t* P = (const bf16_t*)(ws + WS_P); float* ST = (float*)(ws + WS_ST);
    if (mmask & 1) { GlaP gp0{P, (const float*)(ws + WS_LA), a.in[I_GNG] + l * 512, nullptr, (bf16_t*)(ws + WS_O), ST + ST_GSEG, ST + ST_GDS};
      GlaP gp1{P, (const float*)(ws + WS_LA), a.in[I_RNG] + l * 512, a.in[I_RNB] + l * 512, (bf16_t*)(ws + WS_O), ST + ST_GSEG, ST + ST_GDS};
      for (int itx = blockIdx.x; itx < 2 * BG * 4 * NSEGG; itx += G) { const int mix = itx / (BG * 4 * NSEGG), rest = itx % (BG * 4 * NSEGG), b = rest / (4 * NSEGG), h = (rest / NSEGG) & 3, seg = rest % NSEGG;
          const int sidx = ((mix * BG + b) * 4 + h) * NSEGG;
          if (!PASSC && seg == NSEGG - 1) continue;
          if (mix == 0) glaret_item<PASSC>(lds, gp0, true, b, h, seg, sidx); else glaret_item<PASSC>(lds, gp1, false, b, h, seg, sidx); } }
    int tid = threadIdx.x; asm volatile("" : "+v"(tid));
    const int w = __builtin_amdgcn_readfirstlane(tid >> 6), ln = tid & 63;
    if (mmask & 2) { LruP lp{P, a.in[I_LCW] + l * 2048, a.in[I_LCB] + l * 512, a.in[I_LBA] + l * 512, a.in[I_LBX] + l * 512, sm + SM_SP8, (const bf16_t*)((const unsigned char*)sm + SM_LRUW_BYTES), (bf16_t*)(ws + WS_O), ST + ST_LRU};
      for (int itx = blockIdx.x; itx < BG * NSEGL; itx += G) { if (!PASSC && itx % NSEGL == NSEGL - 1) continue; lru_wave<PASSC>(lds + w * LR_WAVE, lp, itx / NSEGL, itx % NSEGL, w, ln); } }
    if (mmask & 4) { S5P sp_{P, (const bf16_t*)(ws + WS_SU2), sm, ws + WS_S5M + (size_t)l * 32 * S5M_BYTES, sm + SM_A128, a.in[I_SD] + l * 512, (bf16_t*)(ws + WS_Y5), ST + ST_S5};
      for (int itx = blockIdx.x; itx < 32 * 8; itx += G) { const int g = itx & 31, q = (itx >> 5) * 8 + w;
          WGSYNC();
          { const unsigned char* src = sp_.s5m + (size_t)g * S5M_BYTES; const int nb = PASSC ? S5_MEND : S5_MC;
            for (int o = tid * 16; o < nb; o += 8192) *(LAS u32x4*)(lds + o) = *(const u32x4*)(src + o); }
          WGSYNC();
          if (PASSC || (q & 7) != NSEGS - 1) s5_wave<PASSC>(lds, lds + S5_MEND + w * S5W_STRIDE, sp_, q >> 3, q & 7, g, ln); } }
    WGSYNC();
}

constexpr int NPH = 8, NSTEPS = 1 + NGRP * DEPTH * NPH;
constexpr int LDS_BYTES = 163840, LDS_MISC = 163840 - 512;
static_assert(S5_MEND + 8 * S5W_STRIDE <= LDS_MISC, "S5 LDS");

__global__ void __launch_bounds__(512, 2) mk_fwd(Args a) {
    __shared__ __attribute__((aligned(16))) unsigned char lds_raw[LDS_BYTES];
    LAS unsigned char* lds = (LAS unsigned char*)lds_raw;
    volatile LAS unsigned* MISC = (volatile LAS unsigned*)(lds + LDS_MISC);
    const int G = gridDim.x;
    if (threadIdx.x < 32) MISC[threadIdx.x] = 0u;
    wg_syncthreads();
    unsigned* ctl = (unsigned*)(a.ws + WS_CTL);
    XcdBarrier bar = xcd_barrier_post(ctl + CW_BAR + a.li * XCD_BAR_WORDS, MISC + 8);
    const int ngw = G * 8, gthreads = G * 512;
#define LTID(v) int v = threadIdx.x; asm volatile("" : "+v"(v))
#define IN(s) (a.s_lo <= (s) && (s) < a.s_hi)
#define SEAM(s) do { if ((s) + 1 < a.s_hi) xcd_barrier(bar); } while (0)
    if (IN(0)) { LTID(t_); phase_prologue(a, blockIdx.x * 512 + t_, gthreads); xcd_barrier(bar); phase_prologue2(a, blockIdx.x * 512 + t_, gthreads); xcd_barrier(bar); phase_prologue3(a, blockIdx.x * 512 + t_, gthreads); SEAM(0); }
    for (int gl = 0; gl < NGRP * DEPTH; ++gl) {
        const int grp = gl >> 2, l = gl & 3, s0 = 1 + gl * NPH;
        if (a.s_hi <= s0 || a.s_lo >= s0 + NPH) continue;
        unsigned char* ws = a.ws;
        const bf16_t* Wl = (const bf16_t*)(ws + WS_W + (size_t)l * W_STRIDE);
        const float* sm = (const float*)(ws + WS_SMALL + (size_t)l * SMALL_STRIDE);
        bf16_t* U = (bf16_t*)(ws + WS_U); bf16_t* P = (bf16_t*)(ws + WS_P); float* LA = (float*)(ws + WS_LA);
        bf16_t* O = (bf16_t*)(ws + WS_O); bf16_t* Y5 = (bf16_t*)(ws + WS_Y5); unsigned char* PGb = ws + WS_PG;
        const float* xg = a.in[I_X] + (size_t)grp * TG * D; float* og = a.out + (size_t)grp * TG * D;
        const float* hin = (l <= 1) ? xg : og;
        bf16_t* DLT = (bf16_t*)(ws + WS_O);
        (void)sm;
        if (IN(s0 + 0)) { LTID(t_); const int gw_ = blockIdx.x * 8 + __builtin_amdgcn_readfirstlane(t_ >> 6);
            if (l == 0) phase_norm<false, false>(hin, DLT, og, a.in[I_NG] + l * D, U, gw_, ngw, t_ & 63); else phase_norm<false, true>(hin, DLT, og, a.in[I_NG] + l * D, U, gw_, ngw, t_ & 63);
            SEAM(s0 + 0); }
        if (IN(s0 + 1)) {
            pg8::Gemm g{U, Wl, TG, N_ALL, D, D, D, 0, 0}; pg8::StaticOrder S; S.init(TG, N_ALL, G, (int)blockIdx.x, 0, 256, WGM_G1);
            EpiIn E{P, LA, a.in[I_GBLR] + l * 256, (const float*)(ws + WS_ROT), PGb, (bf16_t*)(ws + WS_SU2)};
            GEMM_CALL(EpiIn);
            SEAM(s0 + 1);
        }
        if (IN(s0 + 2)) { phase_mixers<false>(lds, a, l, G); SEAM(s0 + 2); }
        if (IN(s0 + 3)) { phase_mixers<true>(lds, a, l, G); SEAM(s0 + 3); }
        if (IN(s0 + 4)) {
            { pg8::Gemm g{Y5, (const bf16_t*)((const unsigned char*)Wl + WO_GLU), TG, BW, BW, BW, BW, 0, 0}; pg8::StaticOrder S; S.init(TG, BW, G, (int)blockIdx.x, 0, 256, WGM_GLU);
              EpiGlu E{Y5, P, a.in[I_SGB] + l * BW, O};
              GEMM_CALL(EpiGlu); }
            SEAM(s0 + 4);
        }
        if (IN(s0 + 6)) {
            { pg8::Gemm g{O, (const bf16_t*)((const unsigned char*)Wl + WO_BR), TG, D, BW, OLD, BW, (size_t)BW * 2, (size_t)D * BW * 2}; pg8::StaticOrder S; S.init(TG, D, G, (int)blockIdx.x, 2, 128, WGM_G2);
              EpiBr E{PGb, U};
              pg8::gemm_phase<EpiBr, pg8::StaticOrder, true, true, true>(lds, g, S, E); }
            SEAM(s0 + 6);
        }
        if (IN(s0 + 7)) {
            if (a.fin != 2) { pg8::Gemm g{U, (const bf16_t*)((const unsigned char*)Wl + WO_OUT), TG, D, D, D, D, 0, 0}; pg8::StaticOrder S; S.init(TG, D, G, (int)blockIdx.x, 0, 256, WGM_G3);
              EpiOut E{DLT};
              GEMM_CALL(EpiOut); }
            if (l == 3 && a.fin) { if (a.fin == 1) xcd_barrier(bar); LTID(t_); phase_norm<true, true>(og, DLT, og, a.in[I_FNG], U, blockIdx.x * 8 + __builtin_amdgcn_readfirstlane(t_ >> 6), ngw, t_ & 63); }
            SEAM(s0 + 7);
        }
    }
#undef IN
#undef SEAM
}

extern "C" void kernel_launch(void* const* d_in, const int* in_sizes, int n_in, void* d_out, int out_size, void* d_ws, size_t ws_size, hipStream_t stream) {
    static int grid = 0;
    if (grid == 0) {
        static const int exp_sizes[29] = {67108864, 4096, 21037056, 16384, 1024, 2048, 2048, 2048, 8192, 2048, 131072, 2048, 131072, 2048, 2048, 8192, 8192, 131072, 131072, 131072, 131072, 2048, 128, 1048576, 2048, 16777216, 8388608, 4194304, 1024};
        bool ok_sizes = (n_in == 29); if (ok_sizes) for (int i = 0; i < 29; ++i) if (in_sizes[i] != exp_sizes[i]) { fprintf(stderr, "kernel_launch: input %d has %d elements, expected %d\n", i, in_sizes[i], exp_sizes[i]); ok_sizes = false; }
        if (!ok_sizes || out_size != NB * SEQ * D || ws_size < WS_END) { fprintf(stderr, "kernel_launch: unexpected shapes (n_in %d out %d ws %zu)\n", n_in, out_size, ws_size); grid = -1; return; }
        int dev = 0, cus = 0, per_cu = 0;
        hipGetDevice(&dev); hipDeviceGetAttribute(&cus, hipDeviceAttributeMultiprocessorCount, dev);
        hipOccupancyMaxActiveBlocksPerMultiprocessor(&per_cu, (const void*)mk_fwd, 512, 0);
        (void)hipGetLastError();
        grid = cus > 0 ? cus : 256;
        if (per_cu < 1) fprintf(stderr, "kernel_launch: occupancy query says %d\n", per_cu);
    }
    if (grid < 0) return;
    hipMemsetAsync((char*)d_ws + WS_CTL, 0, CTL_BYTES, stream);
    Args a{};
    for (int i = 0; i < 29; ++i) a.in[i] = (const float*)d_in[i];
    a.out = (float*)d_out; a.ws = (unsigned char*)d_ws;
    unsigned char* ws = (unsigned char*)d_ws;
    int li = 0;
    auto run = [&](int lo, int hi, int fin = 1, int mm = 7) { a.s_lo = lo; a.s_hi = hi; a.li = li++; a.fin = fin; a.mmask = mm; a.pad2 = 0; hipLaunchKernelGGL(mk_fwd, dim3(grid), dim3(512), 0, stream, a); };
    run(0, NSTEPS);
}
#if defined(__HIP_DEVICE_COMPILE__)
#pragma clang attribute pop
#endif
```

```cpp
#include <hip/hip_runtime.h>
#ifndef WGM_G1
#define WGM_G1 4
#endif
#ifndef WGM_G2
#define WGM_G2 8
#endif
#ifndef WGM_G3
#define WGM_G3 8
#endif
#ifndef WGM_GLU
#define WGM_GLU 8
#endif
#include <cstdio>
#include <cstdint>
#if defined(__HIP_DEVICE_COMPILE__)
#pragma clang attribute push(__attribute__((target("no-packed-fp32-ops"))), apply_to = function)
#endif


namespace pg8 {
#define PG8_LAS __attribute__((address_space(3)))
typedef unsigned short bf16_t;
typedef short bf16x8 __attribute__((ext_vector_type(8)));
typedef float f32x4 __attribute__((ext_vector_type(4)));
typedef unsigned u32x4 __attribute__((ext_vector_type(4)));
typedef unsigned u32x2 __attribute__((ext_vector_type(2)));
constexpr int BM = 256, BK = 64, HALF = 128, HTB = HALF * BK * 2, STAGE_BYTES = 8 * HTB, NXCD = 8;

__host__ __device__ __forceinline__ int lds_byte(int r, int c) { const int st = (r >> 4) * 2 + (c >> 5), rr = r & 15, cc = c & 31, ob = rr * 64 + cc * 2; return st * 1024 + (ob ^ (((ob >> 9) & 1) << 5)); }
__host__ __device__ __forceinline__ void stage_rc(int b, int& R, int& C) { const int st = b / 1024, sb = b % 1024, swz = sb ^ (((sb >> 9) & 1) << 5); R = (st >> 1) * 16 + swz / 64; C = (st & 1) * 32 + (swz % 64) / 2; }
__host__ __device__ __forceinline__ int perm32(int rho) { const int n = rho >> 4, i = rho & 15; return 8 * (i >> 2) + 4 * n + (i & 3); }

struct Unit { int pm, pn, z; };
struct Gemm { const bf16_t* A; const bf16_t* Bt; int M, N, K, lda, ldb; size_t zA, zB; };

struct StaticOrder {
    int nM, nN, nwg, G, c, zsh, WGM;
    __host__ __device__ void init(int M, int N, int G_, int c_, int zsh_ = 0, int bn_ = BM, int wgm_ = 4) { nM = M / BM; nN = N / bn_; nwg = nM * nN; G = G_; c = c_; zsh = zsh_; WGM = wgm_; }
    __host__ __device__ bool next(int i, Unit& u) const {
        const int ti = i >> zsh; u.z = i & ((1 << zsh) - 1);
        const long L = (long)ti * G + c; if (L >= nwg) return false;
        int wgid = (int)L; { const int q = nwg / NXCD, r = nwg % NXCD, xcd = wgid % NXCD, off = wgid / NXCD; wgid = (xcd < r ? xcd * (q + 1) : r * (q + 1) + (xcd - r) * q) + off; }
        const int nig = WGM * nN, gid = wgid / nig, fm = gid * WGM, gsz = (nM - fm) < WGM ? (nM - fm) : WGM;
        u.pm = fm + ((wgid % nig) % gsz); u.pn = (wgid % nig) / gsz; return true;
    }
    __device__ __forceinline__ void a_ready(const Unit&) const {}
    __device__ __forceinline__ void done(const Unit&) const {}
};

typedef float f32x2_ __attribute__((ext_vector_type(2)));
typedef __bf16 bf16x2_ __attribute__((ext_vector_type(2)));
__device__ __forceinline__ unsigned cvt_pk_bf16(float lo, float hi) { const f32x2_ v = {lo, hi}; const bf16x2_ b = __builtin_convertvector(v, bf16x2_); return __builtin_bit_cast(unsigned, b); }

template <class Epi, class Sched, bool ALIGN_EPI = false, bool SP2 = false, bool HALFN = false>
__device__ __forceinline__ void gemm_phase(PG8_LAS unsigned char* lds, const Gemm g, const Sched& S, const Epi& E) {
    int tid = threadIdx.x; asm volatile("" : "+v"(tid));
    const int wid = __builtin_amdgcn_readfirstlane(tid >> 6), lane = tid & 63, wr = wid >> 2, wc = wid & 3, fr = lane & 15, fq = lane >> 4;
    const int K = g.K, nt = K / BK;
    unsigned voffA[2], voffB[2];
#pragma unroll
    for (int i = 0; i < 2; ++i) { int R, C; stage_rc(tid * 16 + i * 8192, R, C); const int Rb = Epi::PERM ? ((R & ~31) + perm32(R & 31)) : R;
        voffA[i] = (unsigned)(R * g.lda + C) * 2u; voffB[i] = (unsigned)(Rb * g.ldb + C) * 2u; }
    const size_t kstep = (size_t)(BK * 2);
    const size_t hstepA = (size_t)HALF * g.lda * 2, hstepB = (size_t)HALF * g.ldb * 2;
    const size_t tstepA = 2 * hstepA, tstepB = HALFN ? hstepB : 2 * hstepB;
    const unsigned ldsw = (unsigned)wid * 1024u;
    unsigned aoff = (unsigned)lds_byte(wr * 64 + fr, fq * 8), boff = (unsigned)lds_byte(wc * 32 + fr, fq * 8) + 4u * HTB;
    asm volatile("" : "+v"(aoff), "+v"(boff));
#define PG8_SA(b, h) (((b) * 2 + (h)) * HTB)
#define PG8_SB(b, h) ((4 + (b) * 2 + (h)) * HTB)
#define PG8_STAGE(bufoff, gbase, voff) do { _Pragma("unroll") for (int _i = 0; _i < 2; ++_i) \
        __builtin_amdgcn_global_load_lds((const unsigned*)((const char*)(gbase) + (voff)[_i]), (PG8_LAS unsigned*)(lds + (bufoff) + ldsw + _i * 8192), 16, 0, 0); } while (0)
#define PG8_LDA(dst, b, h) do { _Pragma("unroll") for (int m = 0; m < 4; ++m) _Pragma("unroll") for (int k = 0; k < 2; ++k) dst[m][k] = *(const PG8_LAS bf16x8*)(lds + aoff + (PG8_SA(b, h) + m * 2048 + k * 1024)); } while (0)
#define PG8_LDB(dst, b, h) do { _Pragma("unroll") for (int n = 0; n < 2; ++n) _Pragma("unroll") for (int k = 0; k < 2; ++k) dst[n][k] = *(const PG8_LAS bf16x8*)(lds + boff + (((b) * 2 + (h)) * HTB + n * 2048 + k * 1024)); } while (0)
#define PG8_MMA(ai, bj, At, Bt) do { __builtin_amdgcn_s_setprio(1); _Pragma("unroll") for (int m = 0; m < 4; ++m) _Pragma("unroll") for (int n = 0; n < 2; ++n) _Pragma("unroll") for (int k = 0; k < 2; ++k) \
        acc[ai][bj][m][n] = __builtin_amdgcn_mfma_f32_16x16x32_bf16(Bt[n][k], At[m][k], acc[ai][bj][m][n], 0, 0, 0); __builtin_amdgcn_s_setprio(0); } while (0)
#define PG8_WAIT_V(n) asm volatile("s_waitcnt vmcnt(" #n ")" ::: "memory")
#define PG8_WAIT_L(n) asm volatile("s_waitcnt lgkmcnt(" #n ")" ::: "memory")
#define PG8_BAR __builtin_amdgcn_s_barrier()
#define PG8_SCHED __builtin_amdgcn_sched_barrier(0)
    Unit cur, nxt; int ui = 0;
    if (!S.next(0, cur)) return;
    f32x4 acc[2][2][4][2];
#pragma unroll
    for (int a = 0; a < 2; ++a)
#pragma unroll
        for (int b = 0; b < 2; ++b)
#pragma unroll
            for (int m = 0; m < 4; ++m)
#pragma unroll
                for (int n = 0; n < 2; ++n) acc[a][b][m][n] = (f32x4){0.f, 0.f, 0.f, 0.f};
    bf16x8 At[4][2], B0[2][2], B1[2][2];
    const char* cA = (const char*)g.A + (size_t)cur.pm * tstepA + (size_t)cur.z * g.zA; const char* cB = (const char*)g.Bt + (size_t)cur.pn * tstepB + (size_t)cur.z * g.zB;
    S.a_ready(cur);
    if constexpr (SP2 && HALFN) {
        PG8_STAGE(PG8_SB(0, 0), cB, voffB); PG8_STAGE(PG8_SA(0, 0), cA, voffA); PG8_STAGE(PG8_SA(0, 1), cA + hstepA, voffA);
        if (wr == 1) PG8_BAR;
        PG8_WAIT_V(2); PG8_BAR;
        PG8_STAGE(PG8_SB(1, 0), cB + kstep, voffB); PG8_STAGE(PG8_SA(1, 0), cA + kstep, voffA);
        PG8_WAIT_V(4); PG8_BAR;
    } else if constexpr (SP2) {
        PG8_STAGE(PG8_SB(0, 0), cB, voffB); PG8_STAGE(PG8_SB(0, 1), cB + hstepB, voffB); PG8_STAGE(PG8_SA(0, 0), cA, voffA); PG8_STAGE(PG8_SA(0, 1), cA + hstepA, voffA);
        if (wr == 1) PG8_BAR;
        PG8_WAIT_V(2); PG8_BAR;
        PG8_STAGE(PG8_SB(1, 0), cB + kstep, voffB); PG8_STAGE(PG8_SA(1, 0), cA + kstep, voffA); PG8_STAGE(PG8_SB(1, 1), cB + hstepB + kstep, voffB);
        PG8_WAIT_V(6); PG8_BAR;
    } else {
        PG8_STAGE(PG8_SB(0, 0), cB, voffB); PG8_STAGE(PG8_SA(0, 0), cA, voffA); PG8_STAGE(PG8_SB(0, 1), cB + hstepB, voffB); PG8_STAGE(PG8_SA(0, 1), cA + hstepA, voffA);
        if (wr == 1) PG8_BAR;
        PG8_WAIT_V(4); PG8_BAR;
        PG8_STAGE(PG8_SB(1, 0), cB + kstep, voffB); PG8_STAGE(PG8_SA(1, 0), cA + kstep, voffA); PG8_STAGE(PG8_SB(1, 1), cB + hstepB + kstep, voffB);
        PG8_WAIT_V(6); PG8_BAR;
    }
    for (;;) {
        const bool has_next = S.next(ui + 1, nxt);
        const char* nA = has_next ? (const char*)g.A + (size_t)nxt.pm * tstepA + (size_t)nxt.z * g.zA : cA; const char* nB = has_next ? (const char*)g.Bt + (size_t)nxt.pn * tstepB + (size_t)nxt.z * g.zB : cB;
        for (int t = 0; t < nt; t += 2) {
            const bool last = (t == nt - 2);
            const char* a1 = cA + (size_t)(t + 1) * kstep;
            const char* a2 = last ? nA : cA + (size_t)(t + 2) * kstep; const char* b2 = last ? nB : cB + (size_t)(t + 2) * kstep;
            const char* a3 = a2 + kstep; const char* b3 = b2 + kstep;
            if (last && has_next) S.a_ready(nxt);
            if constexpr (SP2 && HALFN) {
            PG8_LDB(B0, 0, 0); PG8_SCHED; PG8_LDA(At, 0, 0); PG8_STAGE(PG8_SA(1, 1), a1 + hstepA, voffA);
            PG8_WAIT_V(6); PG8_WAIT_L(0); PG8_BAR; PG8_MMA(0, 0, At, B0); PG8_BAR; PG8_SCHED;
            PG8_LDA(At, 0, 1); PG8_STAGE(PG8_SB(0, 0), b2, voffB); PG8_STAGE(PG8_SA(0, 0), a2, voffA);
            PG8_WAIT_V(6); PG8_WAIT_L(0); PG8_BAR; PG8_MMA(1, 0, At, B0); PG8_BAR; PG8_SCHED;
            PG8_LDB(B0, 1, 0); PG8_SCHED; PG8_LDA(At, 1, 0); PG8_STAGE(PG8_SA(0, 1), a2 + hstepA, voffA);
            PG8_WAIT_V(6); PG8_WAIT_L(0); PG8_BAR; PG8_MMA(0, 0, At, B0); PG8_BAR; PG8_SCHED;
            PG8_LDA(At, 1, 1); PG8_STAGE(PG8_SB(1, 0), b3, voffB); PG8_STAGE(PG8_SA(1, 0), a3, voffA);
            PG8_WAIT_V(6); PG8_WAIT_L(0); PG8_BAR; PG8_MMA(1, 0, At, B0); PG8_BAR; PG8_SCHED;
            } else if constexpr (SP2) {
            PG8_LDB(B0, 0, 0); PG8_LDB(B1, 0, 1); PG8_SCHED; PG8_LDA(At, 0, 0); PG8_STAGE(PG8_SA(1, 1), a1 + hstepA, voffA);
            PG8_WAIT_V(8); PG8_WAIT_L(0); PG8_BAR; PG8_MMA(0, 0, At, B0); PG8_MMA(0, 1, At, B1); PG8_BAR; PG8_SCHED;
            PG8_LDA(At, 0, 1); PG8_STAGE(PG8_SB(0, 0), b2, voffB); PG8_STAGE(PG8_SB(0, 1), b2 + hstepB, voffB); PG8_STAGE(PG8_SA(0, 0), a2, voffA);
            PG8_WAIT_V(8); PG8_WAIT_L(0); PG8_BAR; PG8_MMA(1, 0, At, B0); PG8_MMA(1, 1, At, B1); PG8_BAR; PG8_SCHED;
            PG8_LDB(B0, 1, 0); PG8_LDB(B1, 1, 1); PG8_SCHED; PG8_LDA(At, 1, 0); PG8_STAGE(PG8_SA(0, 1), a2 + hstepA, voffA);
            PG8_WAIT_V(8); PG8_WAIT_L(0); PG8_BAR; PG8_MMA(0, 0, At, B0); PG8_MMA(0, 1, At, B1); PG8_BAR; PG8_SCHED;
            PG8_LDA(At, 1, 1); PG8_STAGE(PG8_SB(1, 0), b3, voffB); PG8_STAGE(PG8_SB(1, 1), b3 + hstepB, voffB); PG8_STAGE(PG8_SA(1, 0), a3, voffA);
            PG8_WAIT_V(8); PG8_WAIT_L(0); PG8_BAR; PG8_MMA(1, 0, At, B0); PG8_MMA(1, 1, At, B1); PG8_BAR; PG8_SCHED;
            } else {
            PG8_LDB(B0, 0, 0); PG8_SCHED; PG8_LDA(At, 0, 0); PG8_STAGE(PG8_SA(1, 1), a1 + hstepA, voffA);
            PG8_WAIT_L(8); PG8_BAR; PG8_WAIT_L(0); PG8_MMA(0, 0, At, B0); PG8_BAR; PG8_SCHED;
            PG8_LDB(B1, 0, 1); PG8_STAGE(PG8_SB(0, 0), b2, voffB);
            PG8_BAR; PG8_WAIT_L(0); PG8_MMA(0, 1, At, B1); PG8_BAR;
            PG8_LDA(At, 0, 1); PG8_STAGE(PG8_SA(0, 0), a2, voffA);
            PG8_BAR; PG8_WAIT_L(0); PG8_MMA(1, 0, At, B0); PG8_BAR; PG8_SCHED;
            PG8_STAGE(PG8_SB(0, 1), b2 + hstepB, voffB);
            PG8_WAIT_V(6); PG8_BAR; PG8_MMA(1, 1, At, B1); PG8_BAR;
            PG8_LDB(B0, 1, 0); PG8_SCHED; PG8_LDA(At, 1, 0); PG8_STAGE(PG8_SA(0, 1), a2 + hstepA, voffA);
            PG8_WAIT_L(8); PG8_BAR; PG8_WAIT_L(0); PG8_MMA(0, 0, At, B0); PG8_BAR; PG8_SCHED;
            PG8_LDB(B1, 1, 1); PG8_STAGE(PG8_SB(1, 0), b3, voffB);
            PG8_BAR; PG8_WAIT_L(0); PG8_MMA(0, 1, At, B1); PG8_BAR;
            PG8_LDA(At, 1, 1); PG8_STAGE(PG8_SA(1, 0), a3, voffA);
            PG8_BAR; PG8_WAIT_L(0); PG8_MMA(1, 0, At, B0); PG8_BAR; PG8_SCHED;
            PG8_STAGE(PG8_SB(1, 1), b3 + hstepB, voffB);
            PG8_WAIT_V(6); PG8_BAR; PG8_MMA(1, 1, At, B1); PG8_BAR;
            }
        }
        if constexpr (ALIGN_EPI) { if (wr == 0) PG8_BAR; }
        { int fr_e = fr, fq_e = fq; asm volatile("" : "+v"(fr_e), "+v"(fq_e));
          E(acc, cur, wr, wc, fr_e, fq_e); }
        if (!has_next) break;
        if (!HALFN && !(Epi::KEEP && cur.z != 3)) {
#pragma unroll
        for (int a = 0; a < 2; ++a)
#pragma unroll
            for (int b = 0; b < 2; ++b)
#pragma unroll
                for (int m = 0; m < 4; ++m)
#pragma unroll
                    for (int n = 0; n < 2; ++n) acc[a][b][m][n] = (f32x4){0.f, 0.f, 0.f, 0.f};
        }
        cur = nxt; cA = nA; cB = nB; ++ui;
        if constexpr (ALIGN_EPI) { if (wr == 1) PG8_BAR; }
    }
    PG8_WAIT_V(0);
    if constexpr (!ALIGN_EPI) { if (wr == 0) PG8_BAR; }
    PG8_BAR;
#undef PG8_SA
#undef PG8_SB
#undef PG8_STAGE
#undef PG8_LDA
#undef PG8_LDB
#undef PG8_MMA
#undef PG8_WAIT_V
#undef PG8_WAIT_L
#undef PG8_BAR
#undef PG8_SCHED
}

}

using pg8::bf16_t; using pg8::f32x4; using pg8::u32x4; using pg8::u32x2; using pg8::bf16x8; using pg8::cvt_pk_bf16;
#define LAS __attribute__((address_space(3)))

constexpr int D = 1024, SEQ = 4096, NB = 16, DEPTH = 4, BW = 512;
constexpr int NGRP = 2, BG = NB / NGRP, TG = BG * SEQ;
constexpr int N_IN = 21 * 256, N_MG = 4096, N_ALL = N_IN + N_MG;
constexpr int PLD = 20 * 256;
constexpr int P_GQ = 0, P_GK = 256, P_GV = 512, P_GG = 1024, P_RQ = 1536, P_RK = 1792, P_RV = 2048, P_RG = 2560, P_LX = 3072, P_LG = 3584, P_SU = 4096, P_SG = 4608;
constexpr int OLD = 2048;
constexpr float NORM_EPS = 1e-6f;

constexpr size_t MiB = 1u << 20;
constexpr size_t WS_CTL = 0, CTL_BYTES = 2 * MiB;
constexpr size_t WS_ROT = 2 * MiB;
constexpr size_t WS_SMALL = 3 * MiB, SMALL_STRIDE = 1 * MiB;
constexpr size_t WS_W = 8 * MiB, W_STRIDE = 26 * MiB;
constexpr size_t WO_IN = 0, WO_BR = (size_t)N_ALL * D * 2, WO_OUT = WO_BR + (size_t)4 * D * BW * 2, WO_GLU = WO_OUT + (size_t)D * D * 2, WO_END = WO_GLU + (size_t)BW * BW * 2;
static_assert(WO_END <= W_STRIDE, "weights");
constexpr size_t WS_U = 112 * MiB;
constexpr size_t WS_P = 176 * MiB;
constexpr size_t WS_LA = 496 * MiB;
constexpr size_t WS_O = 528 * MiB;
constexpr size_t WS_Y5 = 656 * MiB;
constexpr size_t WS_PG = 688 * MiB;
constexpr size_t WS_S5D = 816 * MiB;
constexpr size_t WS_S5M = 820 * MiB, S5M_BYTES = 86016;
constexpr size_t WS_S5K = 831 * MiB;
constexpr size_t WS_SU2 = 832 * MiB;
constexpr size_t WS_ST = 944 * MiB;
constexpr size_t WS_END = 1008 * MiB;
constexpr int SM_ABR = 0, SM_ABI = 2048, SM_BBR = 4096, SM_BBI = 4096 + 32768, SM_SP8 = 4096 + 65536, SM_END_F = SM_SP8 + 512;
constexpr int SM_A128 = SM_END_F;
constexpr int SM_A8 = SM_A128 + 4096;
constexpr size_t SM_LRUW_BYTES = 512 * 1024, SM_CT_BYTES = 640 * 1024, SM_BBT_BYTES = 768 * 1024;
static_assert((size_t)(SM_END_F + 8192) * 4 <= SM_LRUW_BYTES, "small");

constexpr int CW_BAR = 4096;
#define XB_TMO      128
#define XB_XCNT(j)  (256  + 64 * (j))
#define XB_XSUB(j)  (1280 + 64 * (j))
#define XB_XGEN(j)  (2304 + 64 * (j))
#define XB_TOP      3328
#define XB_TOPGEN   3392
#define XCD_BAR_WORDS 3456
#define XB_SPIN_CAP (1u << 18)

__device__ __forceinline__ void wg_syncthreads() { __builtin_amdgcn_fence(__ATOMIC_RELEASE, "workgroup"); __builtin_amdgcn_s_barrier(); __builtin_amdgcn_fence(__ATOMIC_ACQUIRE, "workgroup"); }
__device__ __forceinline__ unsigned xb_ld(unsigned* p)              { return __hip_atomic_load(p, __ATOMIC_RELAXED, __HIP_MEMORY_SCOPE_AGENT); }
__device__ __forceinline__ unsigned xb_add(unsigned* p, unsigned v) { return __hip_atomic_fetch_add(p, v, __ATOMIC_RELAXED, __HIP_MEMORY_SCOPE_AGENT); }
__device__ __forceinline__ unsigned xb_xcc_id() { return (unsigned)__builtin_amdgcn_s_getreg((3 << 11) | 20) & 0xFu; }
#define XB_SPIN(cond, bar) do { unsigned _sp = 0; while (cond) { __builtin_amdgcn_s_sleep(1); \
    if ((++_sp & 255u) == 0u) { if (xb_ld(&(bar)[XB_TMO])) break; if (_sp > XB_SPIN_CAP) { (void)xb_add(&(bar)[XB_TMO], 1u); break; } } } } while (0)
struct XcdBarrier { unsigned* bar; unsigned x; volatile LAS unsigned* st; };
__device__ __forceinline__ XcdBarrier xcd_barrier_post(unsigned* bar, volatile LAS unsigned* st) {
    XcdBarrier b; b.bar = bar; b.x = xb_xcc_id(); b.st = st;
    if (threadIdx.x == 0) (void)xb_add(&bar[XB_XCNT(b.x)], 1u);
    return b;
}
__device__ __forceinline__ void xcd_barrier_complete(unsigned* bar, unsigned x, unsigned& nloc, unsigned& nx) {
    const unsigned G = gridDim.x * gridDim.y * gridDim.z;
    unsigned sum, cnt, mine, sp = 0u;
    for (;;) {
        sum = 0u; cnt = 0u; mine = 0u;
#pragma unroll
        for (unsigned j = 0; j < 16; ++j) { const unsigned c = xb_ld(&bar[XB_XCNT(j)]); sum += c; cnt += (c > 0u) ? 1u : 0u; mine = (j == x) ? c : mine; }
        if (sum == G) break;
        __builtin_amdgcn_s_sleep(1);
        if ((++sp & 255u) == 0u) { if (xb_ld(&bar[XB_TMO])) break; if (sp > XB_SPIN_CAP) { (void)xb_add(&bar[XB_TMO], 1u); break; } }
    }
    nloc = mine > 0u ? mine : 1u; nx = cnt > 0u ? cnt : 1u;
}
__device__ __forceinline__ void xcd_barrier(const XcdBarrier& b) {
    asm volatile("s_waitcnt vmcnt(0)" ::: "memory");
    wg_syncthreads();
    if (threadIdx.x == 0) {
        unsigned* bar = b.bar;
        __builtin_amdgcn_s_waitcnt(0);
        unsigned nloc = b.st[0], nx = b.st[1];
        if (nloc == 0u) { xcd_barrier_complete(bar, b.x, nloc, nx); b.st[0] = nloc; b.st[1] = nx; }
        const unsigned old = xb_add(&bar[XB_XSUB(b.x)], 1u);
        const unsigned gen = old / nloc;
        if (old + 1u == (gen + 1u) * nloc) {
            __builtin_amdgcn_fence(__ATOMIC_RELEASE, "agent");
            asm volatile("s_waitcnt vmcnt(0)" ::: "memory");
            const unsigned og = xb_add(&bar[XB_TOP], 1u);
            const unsigned tg = og / nx;
            if (og + 1u == (tg + 1u) * nx) xb_add(&bar[XB_TOPGEN], 1u);
            else XB_SPIN(xb_ld(&bar[XB_TOPGEN]) == tg, bar);
            __builtin_amdgcn_fence(__ATOMIC_ACQUIRE, "agent");
            xb_add(&bar[XB_XGEN(b.x)], 1u);
            asm volatile("s_waitcnt vmcnt(0)" ::: "memory");
        } else {
            XB_SPIN(xb_ld(&bar[XB_XGEN(b.x)]) == gen, bar);
            __builtin_amdgcn_fence(__ATOMIC_ACQUIRE, "agent");
            asm volatile("s_waitcnt vmcnt(0)" ::: "memory");
        }
    }
    wg_syncthreads();
}

__device__ __forceinline__ float bf2f(bf16_t b) { return __builtin_bit_cast(float, ((unsigned)b) << 16); }
__device__ __forceinline__ float bflo(unsigned w) { return __builtin_bit_cast(float, w << 16); }
__device__ __forceinline__ float bfhi(unsigned w) { return __builtin_bit_cast(float, w & 0xffff0000u); }
__device__ __forceinline__ bf16_t f2bf(float f) { return (bf16_t)(cvt_pk_bf16(f, 0.f) & 0xffffu); }
__device__ __forceinline__ float sigmoid_f(float x) { return __builtin_amdgcn_rcpf(1.f + __expf(-x)); }
__device__ __forceinline__ float silu_f(float x) { return x * sigmoid_f(x); }
__device__ __forceinline__ float silu_t(float t) { return t * __builtin_amdgcn_rcpf(__builtin_fmaf(__builtin_amdgcn_exp2f(t), -1.4426950408889634f, -1.4426950408889634f)); }
__device__ __forceinline__ float sig255(float t) { return __builtin_amdgcn_rcpf(__builtin_fmaf(__builtin_amdgcn_exp2f(t), 1.f / 255.f, 1.f / 255.f)); }
__device__ __forceinline__ float gelu_tanh_f(float x) { const float u = 0.7978845608028654f * (x + 0.044715f * x * x * x); const float t = 1.f - 2.f * __builtin_amdgcn_rcpf(1.f + __expf(2.f * u)); return 0.5f * x * (1.f + t); }
__device__ __forceinline__ float shfl_xor_f(float v, int m) { const int ln = (int)__builtin_amdgcn_mbcnt_hi(~0u, __builtin_amdgcn_mbcnt_lo(~0u, 0u)); return __builtin_bit_cast(float, __builtin_amdgcn_ds_bpermute((ln ^ m) << 2, __builtin_bit_cast(int, v))); }
__device__ __forceinline__ float wave_sum(float v) {
#pragma unroll
    for (int o = 1; o < 64; o <<= 1) v += shfl_xor_f(v, o);
    return v;
}

#define GEMM_CALL(EPI) pg8::gemm_phase<EPI, pg8::StaticOrder, true, true>(lds, g, S, E)
struct Args {
    const float* in[29]; float* out; unsigned char* ws;
    int s_lo, s_hi, li, fin, mmask, pad2;
};
enum { I_X = 0, I_NG, I_WIN, I_GWLR, I_GBLR, I_GNG, I_RNG, I_RNB, I_LCW, I_LCB, I_LWA, I_LBA, I_LWX, I_LBX, I_LLAM,
       I_SARE, I_SAIM, I_SBRE, I_SBIM, I_SCRE, I_SCIM, I_SD, I_SLDT, I_SGW, I_SGB, I_WMG, I_WBR, I_WOUT, I_FNG };

struct EpiIn {
    static constexpr bool PERM = true, AFTER_DRAIN = false, KEEP = false;
    bf16_t* P; float* LA; const float* blr; const float* rot; unsigned char* PG; bf16_t* SU;
    __device__ __forceinline__ void operator()(f32x4 (&acc)[2][2][4][2], const pg8::Unit& u, int wr, int wc, int fr, int fq) const {
        const int pn = u.pn, row0 = u.pm * 256 + wr * 64 + fr, cl = wc * 32 + 8 * fq;
        if (pn >= 21) {
#pragma unroll
            for (int ai = 0; ai < 2; ++ai)
#pragma unroll
                for (int m = 0; m < 4; ++m) { int row = row0 + ai * 128 + m * 16; asm volatile("" : "+v"(row));
                    u32x4 w;
#pragma unroll
                    for (int bj = 0; bj < 2; ++bj) { const f32x4 v0 = acc[ai][bj][m][0], v1 = acc[ai][bj][m][1]; unsigned lo = 0u, hi = 0u;
#pragma unroll
                        for (int j = 0; j < 4; ++j) { lo = __builtin_amdgcn_cvt_pk_u8_f32(sig255(v0[j]), j, lo); hi = __builtin_amdgcn_cvt_pk_u8_f32(sig255(v1[j]), j, hi); }
                        if (bj == 0) { w.x = lo; w.y = hi; } else { w.z = lo; w.w = hi; } }
                    __builtin_nontemporal_store(w, (u32x4*)(PG + (size_t)row * N_MG + (pn - 21) * 256 + 2 * cl)); }
        } else if (pn == 4) {
#pragma unroll
            for (int bj = 0; bj < 2; ++bj) { const int c = cl + bj * 128; const f32x4 b0 = *(const f32x4*)(blr + c), b1 = *(const f32x4*)(blr + c + 4);
#pragma unroll
                for (int ai = 0; ai < 2; ++ai) {
#pragma unroll
                    for (int n = 0; n < 2; ++n)
#pragma unroll
                        for (int j = 0; j < 4; ++j) { float run = 0.f; const float bb = n ? b1[j] : b0[j];
#pragma unroll
                            for (int m = 0; m < 4; ++m) { const float z = acc[ai][bj][m][n][j] + bb; const float x = -(fmaxf(-z, 0.f) + __logf(1.f + __expf(-fabsf(z)))) * 0.0625f; float ls = x, rs = x;
#define DPP_ADD(acc_, ctrl_) acc_ += __builtin_bit_cast(float, __builtin_amdgcn_update_dpp(0, __builtin_bit_cast(int, acc_), ctrl_, 0xf, 0xf, true))
                                DPP_ADD(ls, 0x111); DPP_ADD(ls, 0x112); DPP_ADD(ls, 0x114); DPP_ADD(ls, 0x118);
                                DPP_ADD(rs, 0x101); DPP_ADD(rs, 0x102); DPP_ADD(rs, 0x104); DPP_ADD(rs, 0x108);
#undef DPP_ADD
                                acc[ai][bj][m][n][j] = run + ls; run += ls + rs - x; } }
#pragma unroll
                    for (int m = 0; m < 4; ++m) { int row = row0 + ai * 128 + m * 16; asm volatile("" : "+v"(row)); float* d = LA + ((size_t)(c >> 6) * TG + row) * 64 + (c & 63); *(f32x4*)d = acc[ai][bj][m][0]; *(f32x4*)(d + 4) = acc[ai][bj][m][1]; } } }
        } else if (pn == 7 || pn == 8) {
            const int dcol = (pn - 1) * 256;
#pragma unroll
            for (int ai = 0; ai < 2; ++ai)
#pragma unroll
                for (int m = 0; m < 4; ++m) { int row = row0 + ai * 128 + m * 16; asm volatile("" : "+v"(row)); const int pos = row & (SEQ - 1);
#pragma unroll
                    for (int bj = 0; bj < 2; ++bj) { const int c = cl + bj * 128, i0 = (c & 63) >> 1; const float* rt = rot + ((size_t)pos * 32 + i0) * 2;
                        const f32x4 cs0 = *(const f32x4*)rt, cs1 = *(const f32x4*)(rt + 4); const f32x4 v0 = acc[ai][bj][m][0], v1 = acc[ai][bj][m][1];
                        u32x4 w; w.x = cvt_pk_bf16(v0[0] * cs0[0] - v0[1] * cs0[1], v0[0] * cs0[1] + v0[1] * cs0[0]); w.y = cvt_pk_bf16(v0[2] * cs0[2] - v0[3] * cs0[3], v0[2] * cs0[3] + v0[3] * cs0[2]);
                        w.z = cvt_pk_bf16(v1[0] * cs1[0] - v1[1] * cs1[1], v1[0] * cs1[1] + v1[1] * cs1[0]); w.w = cvt_pk_bf16(v1[2] * cs1[2] - v1[3] * cs1[3], v1[2] * cs1[3] + v1[3] * cs1[2]);
                        __builtin_nontemporal_store(w, (u32x4*)(P + (size_t)(dcol + (c & ~63)) * TG + (size_t)row * 64 + (c & 63))); } }
        } else {
            const bool silu = (pn == 5 || pn == 6 || pn == 11 || pn == 12 || pn == 15 || pn == 16 || pn == 19 || pn == 20);
            const int dcol = (pn < 4 ? pn : pn - 1) * 256;
            const int wsh = (pn >= 19) ? 9 : ((pn == 2 || pn == 3 || pn == 5 || pn == 6 || (pn >= 9 && pn <= 12)) ? 7 : 6);
#pragma unroll
            for (int ai = 0; ai < 2; ++ai)
#pragma unroll
                for (int m = 0; m < 4; ++m) { int row = row0 + ai * 128 + m * 16; asm volatile("" : "+v"(row));
#pragma unroll
                    for (int bj = 0; bj < 2; ++bj) { f32x4 v0 = acc[ai][bj][m][0], v1 = acc[ai][bj][m][1];
                        if (silu) {
#pragma unroll
                            for (int j = 0; j < 4; ++j) { v0[j] = silu_t(v0[j]); v1[j] = silu_t(v1[j]); } }
                        u32x4 w; w.x = cvt_pk_bf16(v0[0], v0[1]); w.y = cvt_pk_bf16(v0[2], v0[3]); w.z = cvt_pk_bf16(v1[0], v1[1]); w.w = cvt_pk_bf16(v1[2], v1[3]);
                        if (pn == 17 || pn == 18) { const int cc = (pn - 17) * 256 + cl + bj * 128;
                            __builtin_nontemporal_store(w, (u32x4*)(SU + ((size_t)(cc >> 4) * TG + row) * 16 + (cc & 15))); }
                        else { const int col = dcol + cl + bj * 128; __builtin_nontemporal_store(w, (u32x4*)(P + (size_t)(col >> wsh << wsh) * TG + ((size_t)row << wsh) + (col & ((1 << wsh) - 1)))); } } }
        }
    }
};
struct EpiSig {
    static constexpr bool PERM = true, AFTER_DRAIN = false, KEEP = false;
    bf16_t* PG;
    __device__ __forceinline__ void operator()(const f32x4 (&acc)[2][2][4][2], const pg8::Unit& u, int wr, int wc, int fr, int fq) const {
        const int row0 = u.pm * 256 + wr * 64 + fr, c0 = u.pn * 256 + wc * 32 + 8 * fq;
#pragma unroll
        for (int ai = 0; ai < 2; ++ai)
#pragma unroll
            for (int m = 0; m < 4; ++m) { const int row = row0 + ai * 128 + m * 16;
#pragma unroll
                for (int bj = 0; bj < 2; ++bj) { f32x4 v0 = acc[ai][bj][m][0], v1 = acc[ai][bj][m][1];
#pragma unroll
                    for (int j = 0; j < 4; ++j) { v0[j] = sigmoid_f(v0[j]); v1[j] = sigmoid_f(v1[j]); }
                    u32x4 w; w.x = cvt_pk_bf16(v0[0], v0[1]); w.y = cvt_pk_bf16(v0[2], v0[3]); w.z = cvt_pk_bf16(v1[0], v1[1]); w.w = cvt_pk_bf16(v1[2], v1[3]);
                    *(u32x4*)(PG + (size_t)row * N_MG + c0 + bj * 128) = w; } }
    }
};
struct EpiGlu {
    static constexpr bool PERM = true, AFTER_DRAIN = false, KEEP = false;
    const bf16_t* Y5; const bf16_t* P; const float* gb; bf16_t* O;
    __device__ __forceinline__ void operator()(const f32x4 (&acc)[2][2][4][2], const pg8::Unit& u, int wr, int wc, int fr, int fq) const {
        const int row0 = u.pm * 256 + wr * 64 + fr, c0 = u.pn * 256 + wc * 32 + 8 * fq;
#pragma unroll
        for (int bj = 0; bj < 2; ++bj) { const int c = c0 + bj * 128; const f32x4 b0 = *(const f32x4*)(gb + c), b1 = *(const f32x4*)(gb + c + 4);
#pragma unroll
            for (int ai = 0; ai < 2; ++ai)
#pragma unroll
                for (int m = 0; m < 4; ++m) { const int row = row0 + ai * 128 + m * 16;
                    const u32x4 y = *(const u32x4*)(Y5 + (size_t)row * BW + c), s = *(const u32x4*)(P + (size_t)P_SG * TG + (size_t)row * 512 + c);
                    const f32x4 v0 = acc[ai][bj][m][0] + b0, v1 = acc[ai][bj][m][1] + b1;
                    u32x4 w;
                    w.x = cvt_pk_bf16(bflo(y.x) * sigmoid_f(v0[0]) * bflo(s.x), bfhi(y.x) * sigmoid_f(v0[1]) * bfhi(s.x));
                    w.y = cvt_pk_bf16(bflo(y.y) * sigmoid_f(v0[2]) * bflo(s.y), bfhi(y.y) * sigmoid_f(v0[3]) * bfhi(s.y));
                    w.z = cvt_pk_bf16(bflo(y.z) * sigmoid_f(v1[0]) * bflo(s.z), bfhi(y.z) * sigmoid_f(v1[1]) * bfhi(s.z));
                    w.w = cvt_pk_bf16(bflo(y.w) * sigmoid_f(v1[2]) * bflo(s.w), bfhi(y.w) * sigmoid_f(v1[3]) * bfhi(s.w));
                    *(u32x4*)(O + (size_t)row * OLD + 1536 + c) = w; } }
    }
};
struct EpiBr {
    static constexpr bool PERM = true, AFTER_DRAIN = false, KEEP = false;
    const unsigned char* PG; bf16_t* MRG;
    __device__ __forceinline__ void operator()(f32x4 (&acc)[2][2][4][2], const pg8::Unit& u, int wr, int wc, int fr, int fq) const {
        const int row0 = u.pm * 256 + wr * 64 + fr, c = u.pn * 128 + wc * 32 + 8 * fq, z = u.z;
        const int gpos = (z * 4 + (u.pn >> 1)) * 256 + wc * 64 + fq * 16 + (u.pn & 1) * 8;
#pragma unroll
        for (int ai = 0; ai < 2; ++ai)
#pragma unroll
            for (int m = 0; m < 4; ++m) { const int row = row0 + ai * 128 + m * 16;
                const u32x2 gt = __builtin_nontemporal_load((const u32x2*)(PG + (size_t)row * N_MG + gpos));
                f32x4& p0 = acc[ai][0][m][0]; f32x4& p1 = acc[ai][0][m][1]; f32x4& s0 = acc[ai][1][m][0]; f32x4& s1 = acc[ai][1][m][1];
                if (z == 0) { s0 = (f32x4){0.f, 0.f, 0.f, 0.f}; s1 = s0; }
                s0[0] += p0[0] * (float)(gt.x & 255u); s0[1] += p0[1] * (float)((gt.x >> 8) & 255u); s0[2] += p0[2] * (float)((gt.x >> 16) & 255u); s0[3] += p0[3] * (float)(gt.x >> 24);
                s1[0] += p1[0] * (float)(gt.y & 255u); s1[1] += p1[1] * (float)((gt.y >> 8) & 255u); s1[2] += p1[2] * (float)((gt.y >> 16) & 255u); s1[3] += p1[3] * (float)(gt.y >> 24);
                p0 = (f32x4){0.f, 0.f, 0.f, 0.f}; p1 = p0;
                if (z == 3) { const float q = 1.f / 255.f; s0 *= q; s1 *= q;
                    u32x4 w; w.x = cvt_pk_bf16(s0[0], s0[1]); w.y = cvt_pk_bf16(s0[2], s0[3]); w.z = cvt_pk_bf16(s1[0], s1[1]); w.w = cvt_pk_bf16(s1[2], s1[3]);
                    *(u32x4*)(MRG + (size_t)row * D + c) = w; } }
    }
};
struct EpiOut {
    static constexpr bool PERM = true, AFTER_DRAIN = false, KEEP = false;
    bf16_t* DL;
    __device__ __forceinline__ void operator()(const f32x4 (&acc)[2][2][4][2], const pg8::Unit& u, int wr, int wc, int fr, int fq) const {
        const int row0 = u.pm * 256 + wr * 64 + fr, c0 = u.pn * 256 + wc * 32 + 8 * fq;
#pragma unroll
        for (int ai = 0; ai < 2; ++ai)
#pragma unroll
            for (int m = 0; m < 4; ++m) { const int row = row0 + ai * 128 + m * 16;
#pragma unroll
                for (int bj = 0; bj < 2; ++bj) { const f32x4 v0 = acc[ai][bj][m][0], v1 = acc[ai][bj][m][1];
                    u32x4 w; w.x = cvt_pk_bf16(v0[0], v0[1]); w.y = cvt_pk_bf16(v0[2], v0[3]); w.z = cvt_pk_bf16(v1[0], v1[1]); w.w = cvt_pk_bf16(v1[2], v1[3]);
                    *(u32x4*)(DL + (size_t)row * D + c0 + bj * 128) = w; } }
    }
};

__device__ __forceinline__ int win_src_col(int r) {
    const int pn = r >> 8, j = r & 255;
    switch (pn) {
        case 0: return j; case 1: return 256 + j; case 2: case 3: return 512 + (r - 512);
        case 4: return -1;
        case 5: case 6: return 1040 + (r - 1280);
        case 7: return 1552 + 64 * (j >> 6) + ((j & 63) >> 1) + 32 * (j & 1);
        case 8: return 1808 + 64 * (j >> 6) + ((j & 63) >> 1) + 32 * (j & 1);
        case 9: case 10: return 2064 + (r - 2304);
        case 11: case 12: return 2576 + (r - 2816);
        case 13: case 14: return 3088 + (r - 3328);
        case 15: case 16: return 3600 + (r - 3840);
        case 17: case 18: return 4112 + (r - 4352);
        default: return 4624 + (r - 4864);
    }
}
__device__ __forceinline__ void tr_store8(bf16_t* dst, const float (&v)[8]) {
    u32x4 w; w.x = cvt_pk_bf16(v[0], v[1]); w.y = cvt_pk_bf16(v[2], v[3]); w.z = cvt_pk_bf16(v[4], v[5]); w.w = cvt_pk_bf16(v[6], v[7]); *(u32x4*)dst = w;
}
__device__ __forceinline__ void phase_prologue(const Args& a, int gtid, int gthreads) {
    unsigned char* ws = a.ws;
    for (int q = gtid; q < DEPTH * 2048; q += gthreads) { const int l = q >> 11, idx = q & 2047, g = idx >> 6;
        float* sm = (float*)(ws + WS_SMALL + (size_t)l * SMALL_STRIDE);
        const double step = exp((double)a.in[I_SLDT][l * 32 + g]); const double are = a.in[I_SARE][l * 2048 + idx], aim = a.in[I_SAIM][l * 2048 + idx];
        const double mag = exp(step * are), abr = mag * cos(step * aim), abi = mag * sin(step * aim), den = are * are + aim * aim;
        const double fre = ((abr - 1.0) * are + abi * aim) / den, fim = (abi * are - (abr - 1.0) * aim) / den;
        sm[SM_ABR + idx] = (float)abr; sm[SM_ABI + idx] = (float)abi;
        double* s5d = (double*)(ws + WS_S5D) + ((size_t)l * 2048 + idx) * 50;
        { double pr = 1.0, pi = 0.0;
          for (int j = 0; j <= 8; ++j) { s5d[2 * j] = pr; s5d[2 * j + 1] = pi; if (j == 8) { sm[SM_A8 + idx * 2] = (float)pr; sm[SM_A8 + idx * 2 + 1] = (float)pi; } const double nr = pr * abr - pi * abi, ni = pr * abi + pi * abr; pr = nr; pi = ni; } }
        { const double m128 = exp(512.0 * step * are); sm[SM_A128 + idx * 2] = (float)(m128 * cos(512.0 * step * aim)); sm[SM_A128 + idx * 2 + 1] = (float)(m128 * sin(512.0 * step * aim)); }
        for (int i = 0; i < 16; ++i) { const double br = a.in[I_SBRE][(size_t)l * 32768 + idx * 16 + i], bi = a.in[I_SBIM][(size_t)l * 32768 + idx * 16 + i];
            s5d[18 + 2 * i] = fre * br - fim * bi; s5d[18 + 2 * i + 1] = fre * bi + fim * br; } }
    for (int l = 0; l < DEPTH; ++l) {
        bf16_t* Wl = (bf16_t*)(ws + WS_W + (size_t)l * W_STRIDE);
        const float* win = a.in[I_WIN] + (size_t)l * D * 5136;
        const float* wlr = a.in[I_GWLR] + (size_t)l * 16 * 256;
        for (int idx = gtid; idx < N_IN * (D / 8); idx += gthreads) { const int n = idx % N_IN, kc = idx / N_IN; const int sc = win_src_col(n); float v[8];
            if (sc >= 0) { const int pn_ = n >> 8; const float ws_ = (pn_ == 5 || pn_ == 6 || pn_ == 11 || pn_ == 12 || pn_ == 15 || pn_ == 16 || pn_ == 19 || pn_ == 20) ? -1.4426950408889634f : ((pn_ == 0 || pn_ == 8) ? 0.125f : 1.f);
#pragma unroll
                for (int i = 0; i < 8; ++i) v[i] = win[(size_t)(kc * 8 + i) * 5136 + sc] * ws_;
            } else { const int j = n & 255;
#pragma unroll
                for (int i = 0; i < 8; ++i) { float s = 0.f; const float* wr_ = win + (size_t)(kc * 8 + i) * 5136 + 1024;
#pragma unroll
                    for (int r = 0; r < 16; ++r) s += wr_[r] * wlr[r * 256 + j];
                    v[i] = s; } }
            tr_store8(Wl + (size_t)n * D + kc * 8, v); }
        const float* wmg = a.in[I_WMG] + (size_t)l * 4 * D * D;
        for (int idx = gtid; idx < N_MG * (D / 8); idx += gthreads) { const int n = idx % N_MG, kc = idx / N_MG, bi = n >> 10, c = n & 1023; float v[8];
#pragma unroll
            for (int i = 0; i < 8; ++i) v[i] = wmg[((size_t)bi * D + kc * 8 + i) * D + c] * -1.4426950408889634f;
            tr_store8(Wl + (size_t)(N_IN + n) * D + kc * 8, v); }
        const float* wbr = a.in[I_WBR] + (size_t)l * 4 * BW * D; bf16_t* Wb = (bf16_t*)((unsigned char*)Wl + WO_BR);
        for (int idx = gtid; idx < 4 * D * (BW / 8); idx += gthreads) { const int n = idx % (4 * D), kc = idx / (4 * D), bi = n >> 10, c = n & 1023; float v[8];
#pragma unroll
            for (int i = 0; i < 8; ++i) v[i] = wbr[((size_t)bi * BW + kc * 8 + i) * D + c];
            tr_store8(Wb + (size_t)n * BW + kc * 8, v); }
        const float* wout = a.in[I_WOUT] + (size_t)l * D * D; bf16_t* Wo = (bf16_t*)((unsigned char*)Wl + WO_OUT);
        for (int idx = gtid; idx < D * (D / 8); idx += gthreads) { const int n = idx % D, kc = idx / D; float v[8];
#pragma unroll
            for (int i = 0; i < 8; ++i) v[i] = wout[(size_t)(kc * 8 + i) * D + n];
            tr_store8(Wo + (size_t)n * D + kc * 8, v); }
        const float* wglu = a.in[I_SGW] + (size_t)l * BW * BW; bf16_t* Wg = (bf16_t*)((unsigned char*)Wl + WO_GLU);
        for (int idx = gtid; idx < BW * (BW / 8); idx += gthreads) { const int n = idx % BW, kc = idx / BW; float v[8];
#pragma unroll
            for (int i = 0; i < 8; ++i) v[i] = wglu[(size_t)(kc * 8 + i) * BW + n];
            tr_store8(Wg + (size_t)n * BW + kc * 8, v); }
        float* sm = (float*)(ws + WS_SMALL + (size_t)l * SMALL_STRIDE);
        for (int idx = gtid; idx < 512; idx += gthreads) { const float lam = a.in[I_LLAM][l * 512 + idx]; const float nl = -lam;
            sm[SM_SP8 + idx] = 8.0f * (fmaxf(nl, 0.f) + log1pf(expf(-fabsf(nl)))); }
        bf16_t* lw = (bf16_t*)((unsigned char*)sm + SM_LRUW_BYTES);
        for (int idx = gtid; idx < 8 * 128 * 64; idx += gthreads) { const int i = idx & 63, jj = (idx >> 6) & 127, n = idx >> 13;
            const float v = jj < 64 ? a.in[I_LWA][(((size_t)l * 8 + n) * 64 + i) * 64 + jj] : a.in[I_LWX][(((size_t)l * 8 + n) * 64 + i) * 64 + (jj - 64)];
            lw[idx] = f2bf(v * -1.4426950408889634f); }
    }
    float* rot = (float*)(ws + WS_ROT);
    for (int idx = gtid; idx < SEQ * 32; idx += gthreads) { const int i = idx & 31, s = idx >> 5;
        const double inv = pow(10000.0, -(double)i / 32.0), ang = (double)s * inv; rot[idx * 2] = (float)cos(ang); rot[idx * 2 + 1] = (float)sin(ang); }
}

__device__ __forceinline__ void phase_prologue2(const Args& a, int gtid, int gthreads) {
    unsigned char* ws = a.ws;
    for (int l = 0; l < DEPTH; ++l) {
        const double* s5d = (const double*)(ws + WS_S5D) + (size_t)l * 2048 * 50;
        const float* scre = a.in[I_SCRE] + (size_t)l * 32768; const float* scim = a.in[I_SCIM] + (size_t)l * 32768;
        for (int it = gtid; it < 32 * 4096; it += gthreads) { const int g = it >> 12, r = it & 4095, f = r >> 6, ln = r & 63, fr = ln & 15, fq = ln >> 4;
            const int mat = f >> 5, mt = (f & 31) >> 2, ks = f & 3;
            const int m = 16 * mt + fr, k0 = 32 * ks + 8 * fq; float v[8];
            if (mat == 0) { const int p = m >> 1, ri = m & 1, sq = k0 >> 4, c0 = k0 & 15; const double* sd = s5d + (size_t)(g * 64 + p) * 50; const double ar = sd[2 * (7 - sq)], ai = sd[2 * (7 - sq) + 1];
#pragma unroll
                for (int e = 0; e < 8; ++e) { const double br = sd[18 + 2 * (c0 + e)], bi = sd[18 + 2 * (c0 + e) + 1]; v[e] = (float)(ri ? ar * bi + ai * br : ar * br - ai * bi); } }
            else { const int t = m >> 4, i = m & 15;
#pragma unroll
                for (int e = 0; e < 8; ++e) { const int k = k0 + e, p = k >> 1, ri = k & 1; const double* sd = s5d + (size_t)(g * 64 + p) * 50; const double ar = sd[2 * (t + 1)], ai = sd[2 * (t + 1) + 1];
                    const double cr = scre[(g * 16 + i) * 64 + p], ci = scim[(g * 16 + i) * 64 + p]; v[e] = (float)(ri ? -(cr * ai + ci * ar) : cr * ar - ci * ai); } }
            tr_store8((bf16_t*)(ws + WS_S5M + (size_t)(l * 32 + g) * S5M_BYTES + (size_t)r * 16), v); }
    }
    float* kt = (float*)(ws + WS_S5K);
    for (int it = gtid; it < DEPTH * 32 * 2048; it += gthreads) { const int l = it >> 16, g = (it >> 11) & 31, j = (it >> 8) & 7, i = (it >> 4) & 15, c = it & 15; double ac = 0.0;
        const double* s5d = (const double*)(ws + WS_S5D) + (size_t)l * 2048 * 50;
        const float* scre = a.in[I_SCRE] + (size_t)l * 32768; const float* scim = a.in[I_SCIM] + (size_t)l * 32768;
#pragma unroll 8
        for (int p = 0; p < 64; ++p) { const double* sd = s5d + (size_t)(g * 64 + p) * 50; const double ar = sd[2 * j], ai = sd[2 * j + 1];
            const double cr = scre[(g * 16 + i) * 64 + p], ci = scim[(g * 16 + i) * 64 + p];
            ac += (cr * ar - ci * ai) * sd[18 + 2 * c] - (cr * ai + ci * ar) * sd[18 + 2 * c + 1]; }
        kt[it] = (float)ac; }
}
__device__ __forceinline__ void phase_prologue3(const Args& a, int gtid, int gthreads) {
    unsigned char* ws = a.ws;
    for (int it = gtid; it < DEPTH * 32 * 1280; it += gthreads) { const int lg = it / 1280, r = it % 1280, ff = r >> 6, ln = r & 63, fr = ln & 15, fq = ln >> 4;
        const int mt = ff < 1 ? 0 : ff < 2 ? 1 : ff < 4 ? 2 : ff < 6 ? 3 : ff < 9 ? 4 : ff < 12 ? 5 : ff < 16 ? 6 : 7;
        const int cb = mt < 1 ? 0 : mt < 2 ? 1 : mt < 3 ? 2 : mt < 4 ? 4 : mt < 5 ? 6 : mt < 6 ? 9 : mt < 7 ? 12 : 16, ks = ff - cb;
        const int m = 16 * mt + fr, k0 = 32 * ks + 8 * fq, t = m >> 4, i = m & 15, sq = k0 >> 4, c0 = k0 & 15; float v[8];
        const float* kt = (const float*)(ws + WS_S5K) + (size_t)lg * 2048 + ((sq <= t ? t - sq : 0) * 16 + i) * 16 + c0;
#pragma unroll
        for (int e = 0; e < 8; ++e) v[e] = sq <= t ? kt[e] : 0.f;
        tr_store8((bf16_t*)(ws + WS_S5M + (size_t)lg * S5M_BYTES + 65536 + (size_t)r * 16), v); }
}

template <bool F32OUT, bool ADD>
__device__ __forceinline__ void phase_norm(const float* hin, const bf16_t* delta, float* hout, const float* gain, bf16_t* uout, int gw, int ngw, int lane) {
    f32x4 gv[4];
#pragma unroll
    for (int j = 0; j < 4; ++j) gv[j] = *(const f32x4*)(gain + 4 * lane + 256 * j);
    for (int row = gw; row < TG; row += ngw) {
        const f32x4* xr = (const f32x4*)(hin + (size_t)row * D) + lane; f32x4 v[4]; float s = 0.f;
#pragma unroll
        for (int j = 0; j < 4; ++j) v[j] = __builtin_nontemporal_load(xr + 64 * j);
        if (ADD) { const u32x2* dr = (const u32x2*)(delta + (size_t)row * D) + lane;
#pragma unroll
            for (int j = 0; j < 4; ++j) { const u32x2 dw = __builtin_nontemporal_load(dr + 64 * j); v[j].x += bflo(dw.x); v[j].y += bfhi(dw.x); v[j].z += bflo(dw.y); v[j].w += bfhi(dw.y); } }
#pragma unroll
        for (int j = 0; j < 4; ++j) s += (v[j].x * v[j].x + v[j].y * v[j].y) + (v[j].z * v[j].z + v[j].w * v[j].w);
        const float rstd = rsqrtf(wave_sum(s) * (1.f / D) + NORM_EPS);
        if (F32OUT) { f32x4* o = (f32x4*)(hout + (size_t)row * D) + lane;
#pragma unroll
            for (int j = 0; j < 4; ++j) o[64 * j] = v[j] * rstd * gv[j];
        } else {
            if (ADD) { f32x4* o = (f32x4*)(hout + (size_t)row * D) + lane;
#pragma unroll
                for (int j = 0; j < 4; ++j) o[64 * j] = v[j]; }
            u32x2* o = (u32x2*)(uout + (size_t)row * D) + lane;
#pragma unroll
            for (int j = 0; j < 4; ++j) { const f32x4 y = v[j] * rstd * gv[j]; u32x2 w; w.x = cvt_pk_bf16(y.x, y.y); w.y = cvt_pk_bf16(y.z, y.w); o[64 * j] = w; } }
    }
}

constexpr int NSEGG = 8;
constexpr int NSEGL = 32;
constexpr int NSEGS = 8;
constexpr size_t ST_GSEG = 0;
constexpr size_t ST_GDS = ST_GSEG + (size_t)2 * BG * 4 * NSEGG * 8192;
constexpr size_t ST_LRU = ST_GDS + (size_t)2 * BG * 4 * NSEGG * 64;
constexpr size_t ST_S5 = ST_LRU + (size_t)BG * NSEGL * 512 * 2;
constexpr size_t ST_END_F = ST_S5 + (size_t)BG * NSEGS * 32 * 128;
static_assert(ST_END_F * 4 <= 64 * MiB, "state scratch");
typedef short s16x4 __attribute__((ext_vector_type(4)));

__device__ __forceinline__ bf16x8 lds_tr_frag(LAS const unsigned char* base, int row_stride_bytes, int lane) {
    const int g = lane >> 4, idx = lane & 15, q = idx >> 2, p = idx & 3;
    LAS const unsigned char* a0 = base + (8 * g + q) * row_stride_bytes + 8 * p;
    const s16x4 r0 = __builtin_amdgcn_ds_read_tr16_b64_v4i16((LAS s16x4*)a0);
    const s16x4 r1 = __builtin_amdgcn_ds_read_tr16_b64_v4i16((LAS s16x4*)(a0 + 4 * row_stride_bytes));
    bf16x8 f; f[0] = r0[0]; f[1] = r0[1]; f[2] = r0[2]; f[3] = r0[3]; f[4] = r1[0]; f[5] = r1[1]; f[6] = r1[2]; f[7] = r1[3]; return f;
}
#define WGSYNC() do { asm volatile("s_waitcnt lgkmcnt(0)" ::: "memory"); __builtin_amdgcn_s_barrier(); asm volatile("" ::: "memory"); } while (0)

constexpr int GL_QD = 0, GL_KD = 9216, GL_KT = 18432, GL_V = 27648, GL_ST = 45056, GL_LAST = 63488, GL_RED = 63744, GL_RED2 = 64256;
struct GlaP { const bf16_t* P; const float* LA; const float* gain; const float* bias; bf16_t* O; float* SSEG; float* DSUM; };
__device__ __forceinline__ bf16x8 lds_tr_frag2(LAS const unsigned char* base, int row_stride_bytes, int lane, int mulg, int second_off) {
    const int g = lane >> 4, idx = lane & 15, q = idx >> 2, p = idx & 3;
    LAS const unsigned char* a0 = base + (mulg * g + q) * row_stride_bytes + 8 * p;
    const s16x4 r0 = __builtin_amdgcn_ds_read_tr16_b64_v4i16((LAS s16x4*)a0);
    const s16x4 r1 = __builtin_amdgcn_ds_read_tr16_b64_v4i16((LAS s16x4*)(a0 + second_off * row_stride_bytes));
    bf16x8 f; f[0] = r0[0]; f[1] = r0[1]; f[2] = r0[2]; f[3] = r0[3]; f[4] = r1[0]; f[5] = r1[1]; f[6] = r1[2]; f[7] = r1[3]; return f;
}
__device__ __forceinline__ bf16x8 pack8(const f32x4 a, const f32x4 b) { u32x4 w; w.x = cvt_pk_bf16(a[0], a[1]); w.y = cvt_pk_bf16(a[2], a[3]); w.z = cvt_pk_bf16(b[0], b[1]); w.w = cvt_pk_bf16(b[2], b[3]); return __builtin_bit_cast(bf16x8, w); }

template <bool PASSC>
__device__ __forceinline__ void glaret_item(LAS unsigned char* lds, const GlaP& gp, const bool gla, const int b, const int h, const int seg, const int sidx  ) {
    int tid = threadIdx.x; asm volatile("" : "+v"(tid));
    const int w = __builtin_amdgcn_readfirstlane(tid >> 6), l = tid & 63, fr = l & 15, fq = l >> 4;
    const int qoff = gla ? P_GQ : P_RQ, koff = gla ? P_GK : P_RK, voff = gla ? P_GV : P_RV, goff = gla ? P_GG : P_RG, ooff = gla ? 0 : 512;
    const float lg = __logf(1.f - exp2f(-5.f - (float)h));
    f32x4 accs[4];
#pragma unroll
    for (int dt = 0; dt < 4; ++dt) accs[dt] = (f32x4){0.f, 0.f, 0.f, 0.f};
    const int arow = 8 * w + (l >> 3), apart = l & 7;
    float dsum[8];
#pragma unroll
    for (int e = 0; e < 8; ++e) dsum[e] = 0.f;
    if (PASSC) {
        for (int sp = 0; sp < seg; ++sp) {
            const float* sg = gp.SSEG + (size_t)(sidx + sp) * 8192 + tid * 16; const float* dsm = gp.DSUM + (size_t)(sidx + sp) * 64;
#pragma unroll
            for (int dt = 0; dt < 4; ++dt) { const f32x4 dv = *(const f32x4*)(dsm + 16 * dt + 4 * fq), sv = *(const f32x4*)(sg + 4 * dt);
#pragma unroll
                for (int r = 0; r < 4; ++r) accs[dt][r] = accs[dt][r] * __expf(dv[r]) + sv[r]; }
        }
#pragma unroll
        for (int dt = 0; dt < 4; ++dt) { u32x2 wv; wv.x = cvt_pk_bf16(accs[dt][0], accs[dt][1]); wv.y = cvt_pk_bf16(accs[dt][2], accs[dt][3]);
            *(LAS u32x2*)(lds + GL_ST + (16 * w + fr) * 144 + 32 * dt + 8 * fq) = wv; }
    }
    const int it = w & 3, ch = w >> 2;
    f32x4 gnv[4], bsv[4];
#pragma unroll
    for (int ct = 0; ct < 4; ++ct) { const int c = 128 * h + 64 * ch + 16 * ct + 4 * fq; gnv[ct] = PASSC ? *(const f32x4*)(gp.gain + c) : (f32x4){0.f, 0.f, 0.f, 0.f};
        bsv[ct] = (PASSC && !gla) ? *(const f32x4*)(gp.bias + c) : (f32x4){0.f, 0.f, 0.f, 0.f}; }
    u32x4 rq = (u32x4){0u, 0u, 0u, 0u}, rk, rv[2]; f32x4 rla[2], rll[2]; u32x2 gnx[4];
    const float rq_s = __expf((float)(arow + 1) * lg), rk_s = __expf(-(float)(arow + 1) * lg), rt_s = __expf((float)(63 - arow) * lg);
#define GL_ISSUE(n_) do { const size_t r0_ = (size_t)b * SEQ + seg * 512 + (n_) * 64; \
        { const size_t ro_ = (r0_ + arow) * 64 + 8 * apart; if (PASSC) rq = *(const u32x4*)(gp.P + (size_t)(qoff + 64 * h) * TG + ro_); rk = *(const u32x4*)(gp.P + (size_t)(koff + 64 * h) * TG + ro_); \
          if (gla) { const float* lp_ = gp.LA + (size_t)h * TG * 64 + ro_; rla[0] = *(const f32x4*)lp_; rla[1] = *(const f32x4*)(lp_ + 4); const float* ll_ = gp.LA + ((size_t)h * TG + r0_ + 63) * 64 + 8 * apart; rll[0] = *(const f32x4*)ll_; rll[1] = *(const f32x4*)(ll_ + 4); } \
          else { rla[0] = (f32x4){0.f, 0.f, 0.f, 0.f}; rla[1] = rla[0]; rll[0] = rla[0]; rll[1] = rla[0]; } } \
        _Pragma("unroll") for (int e_ = 0; e_ < 2; ++e_) { const int p_ = tid + 512 * e_, i_ = p_ >> 4, part_ = p_ & 15; \
            rv[e_] = *(const u32x4*)(gp.P + (size_t)(voff + 128 * h) * TG + (r0_ + i_) * 128 + 8 * part_); } \
        if (PASSC) { _Pragma("unroll") for (int ct_ = 0; ct_ < 4; ++ct_) gnx[ct_] = *(const u32x2*)(gp.P + (size_t)(goff + 128 * h) * TG + (r0_ + 16 * it + fr) * 128 + 64 * ch + 16 * ct_ + 4 * fq); } } while (0)
    GL_ISSUE(0);
    for (int n = 0; n < 8; ++n) {
        const size_t row0 = (size_t)b * SEQ + seg * 512 + n * 64;
#pragma unroll
        for (int e = 0; e < 2; ++e) { const int p = tid + 512 * e, i = p >> 4, part = p & 15; *(LAS u32x4*)(lds + GL_V + i * 272 + part * 16) = rv[e]; }
        { float cum[8], lastv[8];
          const float kk[8] = {bflo(rk.x), bfhi(rk.x), bflo(rk.y), bfhi(rk.y), bflo(rk.z), bfhi(rk.z), bflo(rk.w), bfhi(rk.w)};
          float eq[8], ek[8], et[8];
          if (gla) {
#pragma unroll
              for (int e = 0; e < 8; ++e) { cum[e] = e < 4 ? rla[0][e] : rla[1][e - 4]; lastv[e] = e < 4 ? rll[0][e] : rll[1][e - 4];
                  eq[e] = __expf(cum[e]); ek[e] = __builtin_amdgcn_rcpf(eq[e]); et[e] = __expf(lastv[e]) * ek[e]; }
          } else {
#pragma unroll
              for (int e = 0; e < 8; ++e) { lastv[e] = 64.f * lg; eq[e] = rq_s; ek[e] = rk_s; et[e] = rt_s; } }
#pragma unroll
          for (int e = 0; e < 8; ++e) *(LAS bf16_t*)(lds + GL_KT + (8 * apart + e) * 144 + arow * 2) = f2bf(kk[e] * et[e]);
          if (PASSC) { const float qq[8] = {bflo(rq.x), bfhi(rq.x), bflo(rq.y), bfhi(rq.y), bflo(rq.z), bfhi(rq.z), bflo(rq.w), bfhi(rq.w)};
              u32x4 qw, kw;
              qw.x = cvt_pk_bf16(qq[0] * eq[0], qq[1] * eq[1]); qw.y = cvt_pk_bf16(qq[2] * eq[2], qq[3] * eq[3]); qw.z = cvt_pk_bf16(qq[4] * eq[4], qq[5] * eq[5]); qw.w = cvt_pk_bf16(qq[6] * eq[6], qq[7] * eq[7]);
              kw.x = cvt_pk_bf16(kk[0] * ek[0], kk[1] * ek[1]); kw.y = cvt_pk_bf16(kk[2] * ek[2], kk[3] * ek[3]); kw.z = cvt_pk_bf16(kk[4] * ek[4], kk[5] * ek[5]); kw.w = cvt_pk_bf16(kk[6] * ek[6], kk[7] * ek[7]);
              *(LAS u32x4*)(lds + GL_QD + arow * 144 + 16 * apart) = qw; *(LAS u32x4*)(lds + GL_KD + arow * 144 + 16 * apart) = kw; }
          if (arow == 63) {
#pragma unroll
              for (int e = 0; e < 8; ++e) *(LAS float*)(lds + GL_LAST + (8 * apart + e) * 4) = lastv[e]; }
#pragma unroll
          for (int e = 0; e < 8; ++e) dsum[e] += lastv[e]; }
        u32x2 gates[4];
        if (PASSC) {
#pragma unroll
            for (int ct = 0; ct < 4; ++ct) gates[ct] = gnx[ct]; }
        if (n < 7) GL_ISSUE(n + 1);
        WGSYNC();
        f32x4 acco[4];
        if (PASSC) {
            bf16x8 qf[2];
#pragma unroll
            for (int ks = 0; ks < 2; ++ks) qf[ks] = *(LAS const bf16x8*)(lds + GL_QD + (16 * it + fr) * 144 + 16 * fq + 64 * ks);
            f32x4 sc[4];
#pragma unroll
            for (int jt = 0; jt < 4; ++jt) { sc[jt] = (f32x4){0.f, 0.f, 0.f, 0.f};
                if (jt <= it) {
#pragma unroll
                    for (int ks = 0; ks < 2; ++ks) { const bf16x8 kf = *(LAS const bf16x8*)(lds + GL_KD + (16 * jt + fr) * 144 + 16 * fq + 64 * ks);
                        sc[jt] = __builtin_amdgcn_mfma_f32_16x16x32_bf16(kf, qf[ks], sc[jt], 0, 0, 0); }
                    if (jt == it) {
#pragma unroll
                        for (int r = 0; r < 4; ++r) sc[jt][r] = (4 * fq + r <= fr) ? sc[jt][r] : 0.f; } } }
            const bf16x8 pf0 = pack8(sc[0], sc[1]), pf1 = pack8(sc[2], sc[3]);
#pragma unroll
            for (int ct = 0; ct < 4; ++ct) { const int c0 = 64 * ch + 16 * ct; acco[ct] = (f32x4){0.f, 0.f, 0.f, 0.f};
                { const bf16x8 vf = lds_tr_frag2(lds + GL_V + c0 * 2, 272, l, 4, 16); acco[ct] = __builtin_amdgcn_mfma_f32_16x16x32_bf16(vf, pf0, acco[ct], 0, 0, 0); }
                if (it >= 2) { const bf16x8 vf = lds_tr_frag2(lds + GL_V + 32 * 272 + c0 * 2, 272, l, 4, 16); acco[ct] = __builtin_amdgcn_mfma_f32_16x16x32_bf16(vf, pf1, acco[ct], 0, 0, 0); }
#pragma unroll
                for (int ks = 0; ks < 2; ++ks) { const bf16x8 sf = *(LAS const bf16x8*)(lds + GL_ST + (c0 + fr) * 144 + 16 * fq + 64 * ks);
                    acco[ct] = __builtin_amdgcn_mfma_f32_16x16x32_bf16(sf, qf[ks], acco[ct], 0, 0, 0); } }
        }
#pragma unroll
        for (int dt = 0; dt < 4; ++dt) { const f32x4 lv = *(LAS const f32x4*)(lds + GL_LAST + (16 * dt + 4 * fq) * 4);
#pragma unroll
            for (int r = 0; r < 4; ++r) accs[dt][r] *= __expf(lv[r]); }
#pragma unroll
        for (int ks = 0; ks < 2; ++ks) { const bf16x8 vf = lds_tr_frag2(lds + GL_V + (32 * ks) * 272 + (16 * w) * 2, 272, l, 8, 4);
#pragma unroll
            for (int dt = 0; dt < 4; ++dt) { const bf16x8 kf = *(LAS const bf16x8*)(lds + GL_KT + (16 * dt + fr) * 144 + 16 * fq + 64 * ks);
                accs[dt] = __builtin_amdgcn_mfma_f32_16x16x32_bf16(kf, vf, accs[dt], 0, 0, 0); } }
        if (PASSC) {
            float ss = 0.f, sm_ = 0.f;
#pragma unroll
            for (int ct = 0; ct < 4; ++ct)
#pragma unroll
                for (int r = 0; r < 4; ++r) { ss += acco[ct][r] * acco[ct][r]; sm_ += acco[ct][r]; }
            ss += shfl_xor_f(ss, 16); ss += shfl_xor_f(ss, 32); sm_ += shfl_xor_f(sm_, 16); sm_ += shfl_xor_f(sm_, 32);
            if (fq == 0) { *(LAS float*)(lds + GL_RED + ((16 * it + fr) * 2 + ch) * 4) = ss; *(LAS float*)(lds + GL_RED2 + ((16 * it + fr) * 2 + ch) * 4) = sm_; }
        }
        WGSYNC();
        if (PASSC) {
            const int i = 16 * it + fr;
            const float ssum = *(LAS const float*)(lds + GL_RED + (i * 2) * 4) + *(LAS const float*)(lds + GL_RED + (i * 2 + 1) * 4);
            const float msum = *(LAS const float*)(lds + GL_RED2 + (i * 2) * 4) + *(LAS const float*)(lds + GL_RED2 + (i * 2 + 1) * 4);
            float mean, rstd;
            if (gla) { mean = 0.f; rstd = rsqrtf(ssum * (1.f / 128.f) + NORM_EPS); }
            else { mean = msum * (1.f / 128.f); const float var = fmaxf(ssum * (1.f / 128.f) - mean * mean, 0.f); rstd = rsqrtf(var + NORM_EPS); }
#pragma unroll
            for (int ct = 0; ct < 4; ++ct) { const int c = 128 * h + 64 * ch + 16 * ct + 4 * fq; const f32x4 gn = gnv[ct], bs = bsv[ct];
                const float g0 = bflo(gates[ct].x), g1 = bfhi(gates[ct].x), g2 = bflo(gates[ct].y), g3 = bfhi(gates[ct].y);
                u32x2 ow; ow.x = cvt_pk_bf16(((acco[ct][0] - mean) * rstd * gn[0] + bs[0]) * g0, ((acco[ct][1] - mean) * rstd * gn[1] + bs[1]) * g1);
                ow.y = cvt_pk_bf16(((acco[ct][2] - mean) * rstd * gn[2] + bs[2]) * g2, ((acco[ct][3] - mean) * rstd * gn[3] + bs[3]) * g3);
                *(u32x2*)(gp.O + (row0 + i) * OLD + ooff + c) = ow; }
#pragma unroll
            for (int dt = 0; dt < 4; ++dt) { u32x2 wv; wv.x = cvt_pk_bf16(accs[dt][0], accs[dt][1]); wv.y = cvt_pk_bf16(accs[dt][2], accs[dt][3]);
                *(LAS u32x2*)(lds + GL_ST + (16 * w + fr) * 144 + 32 * dt + 8 * fq) = wv; }
        }
    }
#undef GL_ISSUE
    if (!PASSC) {
        float* sg = gp.SSEG + (size_t)(sidx + seg) * 8192 + tid * 16;
#pragma unroll
        for (int dt = 0; dt < 4; ++dt) *(f32x4*)(sg + 4 * dt) = accs[dt];
        if (tid < 8) {
#pragma unroll
            for (int e = 0; e < 8; ++e) gp.DSUM[(size_t)(sidx + seg) * 64 + 8 * apart + e] = dsum[e]; }
    }
    WGSYNC();
}

constexpr int LR_XC = 0, LR_XCF = 2304, LR_AA = 6400, LR_GG = 10496, LR_WAVE = 14592;
struct LruP { const bf16_t* P; const float* cw; const float* cb; const float* ba; const float* bx; const float* sp8; const bf16_t* lw; bf16_t* O; float* LST; };
template <bool PASSC>
__device__ __forceinline__ void lru_wave(LAS unsigned char* lw_, const LruP& lp, const int b, const int seg, const int n, const int l_) {
    int l = l_; asm volatile("" : "+v"(l));
    const float NL2E = -1.4426950408889634f;
    const int fr = l & 15, fq = l >> 4, ch = 64 * n + l;
    bf16x8 wB[8][2];
#pragma unroll
    for (int jt = 0; jt < 8; ++jt)
#pragma unroll
        for (int ks = 0; ks < 2; ++ks) wB[jt][ks] = *(const bf16x8*)(lp.lw + ((size_t)(n * 128 + 16 * jt + fr)) * 64 + 8 * fq + 32 * ks);
    const float w0 = lp.cw[ch], w1 = lp.cw[512 + ch], w2 = lp.cw[1024 + ch], w3 = lp.cw[1536 + ch], cbv = lp.cb[ch];
    float bav[4], bxv[4], spv[4];
#pragma unroll
    for (int jt = 0; jt < 4; ++jt) { const int c2 = 64 * n + 16 * jt + fr; bav[jt] = lp.ba[c2] * NL2E; bxv[jt] = lp.bx[c2] * NL2E; spv[jt] = lp.sp8[c2] * NL2E; }
    const size_t rowb = (size_t)b * SEQ + seg * 128;
    const bf16_t* px = lp.P + (size_t)(P_LX + 64 * n) * TG + rowb * 64;
    const bf16_t* pg = lp.P + (size_t)(P_LG + 64 * n) * TG + rowb * 64;
    bf16_t* po = lp.O + rowb * OLD + 1024 + 64 * n;
    float xm3 = 0.f, xm2 = 0.f, xm1 = 0.f;
    if (seg > 0) { xm3 = bf2f(px[l - 3 * 64]); xm2 = bf2f(px[l - 2 * 64]); xm1 = bf2f(px[l - 64]); }
    float hst = 0.f, ap = 1.f;
    if (PASSC) { const float* st = lp.LST + ((size_t)b * NSEGL * 512 + ch) * 2;
        pg8::f32x2_ ah[31];
#pragma unroll
        for (int e = 0; e < 31; ++e) { const int sp = e < seg ? e : 0; ah[e] = *(const pg8::f32x2_*)(st + (size_t)sp * 1024); }
#pragma unroll
        for (int e = 0; e < 31; ++e) if (e < seg) hst = ah[e][0] * hst + ah[e][1]; }
#define LR_ROWLD(dst, base, t) do { dst = (base)[(t) * 64 + l]; } while (0)
    bf16_t xn[16], gn[16];
#pragma unroll
    for (int t = 0; t < 16; ++t) LR_ROWLD(xn[t], px, t);
    for (int sb = 0; sb < 8; ++sb) {
        float xc[16];
        if (PASSC) {
#pragma unroll
            for (int t = 0; t < 16; ++t) LR_ROWLD(gn[t], pg, sb * 16 + t); }
#pragma unroll
        for (int t = 0; t < 16; ++t) { const float x0 = bf2f(xn[t]); xc[t] = cbv + w0 * xm3 + w1 * xm2 + w2 * xm1 + w3 * x0; xm3 = xm2; xm2 = xm1; xm1 = x0;
            *(LAS bf16_t*)(lw_ + LR_XC + t * 144 + l * 2) = f2bf(xc[t]); }
        if (sb < 7) {
#pragma unroll
            for (int t = 0; t < 16; ++t) LR_ROWLD(xn[t], px, (sb + 1) * 16 + t); }
        __builtin_amdgcn_wave_barrier();
        f32x4 acc[8];
#pragma unroll
        for (int jt = 0; jt < 8; ++jt) { const float bz = jt < 4 ? bav[jt] : bxv[jt - 4]; acc[jt] = (f32x4){bz, bz, bz, bz}; }
#pragma unroll
        for (int ks = 0; ks < 2; ++ks) { const bf16x8 af = *(LAS const bf16x8*)(lw_ + LR_XC + fr * 144 + 16 * fq + 64 * ks);
#pragma unroll
            for (int jt = 0; jt < 8; ++jt) acc[jt] = __builtin_amdgcn_mfma_f32_16x16x32_bf16(af, wB[jt][ks], acc[jt], 0, 0, 0); }
#pragma unroll
        for (int jt = 0; jt < 4; ++jt)
#pragma unroll
            for (int r = 0; r < 4; ++r) { const int tok = 4 * fq + r, j = 16 * jt + fr;
                const float rg = __builtin_amdgcn_rcpf(1.f + __builtin_amdgcn_exp2f(acc[jt][r])), ig = __builtin_amdgcn_rcpf(1.f + __builtin_amdgcn_exp2f(acc[4 + jt][r]));
                const float av = __builtin_amdgcn_exp2f(rg * spv[jt]);
                *(LAS float*)(lw_ + LR_AA + tok * 256 + j * 4) = av; const float em = fmaf(-av, av, 1.f);
                *(LAS float*)(lw_ + LR_GG + tok * 256 + j * 4) = ig * __builtin_amdgcn_sqrtf(em); }
        __builtin_amdgcn_wave_barrier();
#pragma unroll
        for (int t = 0; t < 16; ++t) { const float av = *(LAS const float*)(lw_ + LR_AA + t * 256 + l * 4), gv = *(LAS const float*)(lw_ + LR_GG + t * 256 + l * 4);
            hst = av * hst + gv * xc[t]; ap *= av;
            if (PASSC) { bf16_t* p_ = po + (size_t)(sb * 16 + t) * OLD; asm volatile("" : "+s"(p_)); p_[l] = f2bf(hst * bf2f(gn[t])); } }
        __builtin_amdgcn_wave_barrier();
    }
#undef LR_ROWLD
    if (!PASSC) { float* st = lp.LST + (((size_t)b * NSEGL + seg) * 512 + ch) * 2; st[0] = ap; st[1] = hst; }
}

constexpr int S5_MG = 0, S5_MC = 32768, S5_MM = 65536, S5_MEND = 86016, S5W_STRIDE = 8448;
struct S5P { const bf16_t* P; const bf16_t* SU; const float* sm; const unsigned char* s5m; const float* a128; const float* dd; bf16_t* Y5; float* SST; };
__device__ __forceinline__ float gelu_t(float x) { const float t = x * __builtin_fmaf(x * x, -0.10294324f, -2.3022082f);
    return x * __builtin_amdgcn_rcpf(1.f + __builtin_amdgcn_exp2f(t)); }
template <bool PASSC>
__device__ __forceinline__ void s5_wave(LAS unsigned char* lds, LAS unsigned char* lw_, const S5P& sp_, const int b, const int seg, const int g, const int l_) {
    int l = l_; asm volatile("" : "+v"(l));
    const int fr = l & 15, fq = l >> 4;
    const float a8r = sp_.sm[SM_A8 + (g * 64 + l) * 2], a8i = sp_.sm[SM_A8 + (g * 64 + l) * 2 + 1];
    float xr = 0.f, xi = 0.f;
    f32x4 dv4 = (f32x4){0.f, 0.f, 0.f, 0.f};
    if (PASSC) {
        const float ar = sp_.a128[(g * 64 + l) * 2], ai = sp_.a128[(g * 64 + l) * 2 + 1];
        const float* st = sp_.SST + ((size_t)b * NSEGS * 32 + g) * 128 + l;
        for (int sp0 = 0; sp0 < seg; sp0 += 8) { float er[8], ei[8];
#pragma unroll
            for (int e = 0; e < 8; ++e) { const int sp = sp0 + e < seg ? sp0 + e : seg - 1; er[e] = st[(size_t)sp * 4096]; ei[e] = st[(size_t)sp * 4096 + 64]; }
#pragma unroll
            for (int e = 0; e < 8; ++e) if (sp0 + e < seg) { const float nr = ar * xr - ai * xi + er[e], ni = ar * xi + ai * xr + ei[e]; xr = nr; xi = ni; } }
        dv4 = *(const f32x4*)(sp_.dd + 16 * g + 4 * fq);
    }
    const size_t rowb = (size_t)b * SEQ + seg * 512;
    bf16x8 ufn[4];
#pragma unroll
    for (int ks = 0; ks < 4; ++ks) ufn[ks] = *(const bf16x8*)(sp_.SU + ((size_t)g * TG + rowb + 8 * fr + 2 * ks + (fq >> 1)) * 16 + 8 * (fq & 1));
    for (int sup = 0; sup < 4; ++sup) {
        const size_t r0 = rowb + sup * 128;
        bf16x8 uf[4];
#pragma unroll
        for (int ks = 0; ks < 4; ++ks) uf[ks] = ufn[ks];
        if (sup < 3) {
#pragma unroll
            for (int ks = 0; ks < 4; ++ks) ufn[ks] = *(const bf16x8*)(sp_.SU + ((size_t)g * TG + r0 + 128 + 8 * fr + 2 * ks + (fq >> 1)) * 16 + 8 * (fq & 1)); }
        u32x2 us[8];
        if (PASSC) {
#pragma unroll
            for (int mt = 0; mt < 8; ++mt) us[mt] = *(const u32x2*)(sp_.SU + ((size_t)g * TG + r0 + 8 * fr + mt) * 16 + 4 * fq); }
#pragma unroll
        for (int mt = 0; mt < 8; ++mt) { f32x4 ga = (f32x4){0.f, 0.f, 0.f, 0.f};
#pragma unroll
            for (int ks = 0; ks < 4; ++ks) ga = __builtin_amdgcn_mfma_f32_16x16x32_bf16(*(LAS const bf16x8*)(lds + S5_MG + ((mt * 4 + ks) * 64 + l) * 16), uf[ks], ga, 0, 0, 0);
            *(LAS f32x4*)(lw_ + fr * 528 + (16 * mt + 4 * fq) * 4) = ga; }
        __builtin_amdgcn_wave_barrier();
        pg8::f32x2_ gv[16];
#pragma unroll
        for (int t = 0; t < 16; ++t) gv[t] = *(LAS const pg8::f32x2_*)(lw_ + t * 528 + l * 8);
        __builtin_amdgcn_wave_barrier();
#pragma unroll
        for (int t = 0; t < 16; ++t) {
            if (PASSC) *(LAS unsigned*)(lw_ + t * 528 + l * 4) = cvt_pk_bf16(xr, xi);
            const float nr = __builtin_fmaf(a8r, xr, __builtin_fmaf(-a8i, xi, gv[t][0])), ni = __builtin_fmaf(a8r, xi, __builtin_fmaf(a8i, xr, gv[t][1])); xr = nr; xi = ni; }
        if (PASSC) {
            __builtin_amdgcn_wave_barrier();
            bf16x8 xf[4];
#pragma unroll
            for (int ks = 0; ks < 4; ++ks) xf[ks] = *(LAS const bf16x8*)(lw_ + fr * 528 + (32 * ks + 8 * fq) * 2);
#pragma unroll
            for (int mt = 0; mt < 8; ++mt) { f32x4 ya = (f32x4){0.f, 0.f, 0.f, 0.f}; const int cb = mt < 1 ? 0 : mt < 2 ? 1 : mt < 3 ? 2 : mt < 4 ? 4 : mt < 5 ? 6 : mt < 6 ? 9 : mt < 7 ? 12 : 16;
#pragma unroll
                for (int ks = 0; ks < 4; ++ks) if (2 * ks <= mt) ya = __builtin_amdgcn_mfma_f32_16x16x32_bf16(*(LAS const bf16x8*)(lds + S5_MM + ((cb + ks) * 64 + l) * 16), uf[ks], ya, 0, 0, 0);
#pragma unroll
                for (int ks = 0; ks < 4; ++ks) ya = __builtin_amdgcn_mfma_f32_16x16x32_bf16(*(LAS const bf16x8*)(lds + S5_MC + ((mt * 4 + ks) * 64 + l) * 16), xf[ks], ya, 0, 0, 0);
                u32x2 yw; yw.x = cvt_pk_bf16(gelu_t(ya[0] + dv4[0] * bflo(us[mt].x)), gelu_t(ya[1] + dv4[1] * bfhi(us[mt].x))); yw.y = cvt_pk_bf16(gelu_t(ya[2] + dv4[2] * bflo(us[mt].y)), gelu_t(ya[3] + dv4[3] * bfhi(us[mt].y)));
                *(u32x2*)(sp_.Y5 + (r0 + 8 * fr + mt) * BW + 16 * g + 4 * fq) = yw; }
        }
        __builtin_amdgcn_wave_barrier();
    }
    if (!PASSC) { float* st = sp_.SST + (((size_t)b * NSEGS + seg) * 32 + g) * 128 + l; st[0] = xr; st[64] = xi; }
}

template <bool PASSC>
__device__ __forceinline__ void phase_mixers(LAS unsigned char* lds, const Args& a, const int l, const int G) {
    const int mmask = a.mmask;
    unsigned char* ws = a.ws; const float* sm = (const float*)(ws + WS_SMALL + (size_t)l * SMALL_STRIDE);
    const bf16_t* P = (const bf16_t*)(ws + WS_P); float* ST = (float*)(ws + WS_ST);
    if (mmask & 1) { GlaP gp0{P, (const float*)(ws + WS_LA), a.in[I_GNG] + l * 512, nullptr, (bf16_t*)(ws + WS_O), ST + ST_GSEG, ST + ST_GDS};
      GlaP gp1{P, (const float*)(ws + WS_LA), a.in[I_RNG] + l * 512, a.in[I_RNB] + l * 512, (bf16_t*)(ws + WS_O), ST + ST_GSEG, ST + ST_GDS};
      for (int itx = blockIdx.x; itx < 2 * BG * 4 * NSEGG; itx += G) { const int mix = itx / (BG * 4 * NSEGG), rest = itx % (BG * 4 * NSEGG), b = rest / (4 * NSEGG), h = (rest / NSEGG) & 3, seg = rest % NSEGG;
          const int sidx = ((mix * BG + b) * 4 + h) * NSEGG;
          if (!PASSC && seg == NSEGG - 1) continue;
          if (mix == 0) glaret_item<PASSC>(lds, gp0, true, b, h, seg, sidx); else glaret_item<PASSC>(lds, gp1, false, b, h, seg, sidx); } }
    int tid = threadIdx.x; asm volatile("" : "+v"(tid));
    const int w = __builtin_amdgcn_readfirstlane(tid >> 6), ln = tid & 63;
    if (mmask & 2) { LruP lp{P, a.in[I_LCW] + l * 2048, a.in[I_LCB] + l * 512, a.in[I_LBA] + l * 512, a.in[I_LBX] + l * 512, sm + SM_SP8, (const bf16_t*)((const unsigned char*)sm + SM_LRUW_BYTES), (bf16_t*)(ws + WS_O), ST + ST_LRU};
      for (int itx = blockIdx.x; itx < BG * NSEGL; itx += G) { if (!PASSC && itx % NSEGL == NSEGL - 1) continue; lru_wave<PASSC>(lds + w * LR_WAVE, lp, itx / NSEGL, itx % NSEGL, w, ln); } }
    if (mmask & 4) { S5P sp_{P, (const bf16_t*)(ws + WS_SU2), sm, ws + WS_S5M + (size_t)l * 32 * S5M_BYTES, sm + SM_A128, a.in[I_SD] + l * 512, (bf16_t*)(ws + WS_Y5), ST + ST_S5};
      for (int itx = blockIdx.x; itx < 32 * 8; itx += G) { const int g = itx & 31, q = (itx >> 5) * 8 + w;
          WGSYNC();
          { const unsigned char* src = sp_.s5m + (size_t)g * S5M_BYTES; const int nb = PASSC ? S5_MEND : S5_MC;
            for (int o = tid * 16; o < nb; o += 8192) *(LAS u32x4*)(lds + o) = *(const u32x4*)(src + o); }
          WGSYNC();
          if (PASSC || (q & 7) != NSEGS - 1) s5_wave<PASSC>(lds, lds + S5_MEND + w * S5W_STRIDE, sp_, q >> 3, q & 7, g, ln); } }
    WGSYNC();
}

constexpr int NPH = 8, NSTEPS = 1 + NGRP * DEPTH * NPH;
constexpr int LDS_BYTES = 163840, LDS_MISC = 163840 - 512;
static_assert(S5_MEND + 8 * S5W_STRIDE <= LDS_MISC, "S5 LDS");

__global__ void __launch_bounds__(512, 2) mk_fwd(Args a) {
    __shared__ __attribute__((aligned(16))) unsigned char lds_raw[LDS_BYTES];
    LAS unsigned char* lds = (LAS unsigned char*)lds_raw;
    volatile LAS unsigned* MISC = (volatile LAS unsigned*)(lds + LDS_MISC);
    const int G = gridDim.x;
    if (threadIdx.x < 32) MISC[threadIdx.x] = 0u;
    wg_syncthreads();
    unsigned* ctl = (unsigned*)(a.ws + WS_CTL);
    XcdBarrier bar = xcd_barrier_post(ctl + CW_BAR + a.li * XCD_BAR_WORDS, MISC + 8);
    const int ngw = G * 8, gthreads = G * 512;
#define LTID(v) int v = threadIdx.x; asm volatile("" : "+v"(v))
#define IN(s) (a.s_lo <= (s) && (s) < a.s_hi)
#define SEAM(s) do { if ((s) + 1 < a.s_hi) xcd_barrier(bar); } while (0)
    if (IN(0)) { LTID(t_); phase_prologue(a, blockIdx.x * 512 + t_, gthreads); xcd_barrier(bar); phase_prologue2(a, blockIdx.x * 512 + t_, gthreads); xcd_barrier(bar); phase_prologue3(a, blockIdx.x * 512 + t_, gthreads); SEAM(0); }
    for (int gl = 0; gl < NGRP * DEPTH; ++gl) {
        const int grp = gl >> 2, l = gl & 3, s0 = 1 + gl * NPH;
        if (a.s_hi <= s0 || a.s_lo >= s0 + NPH) continue;
        unsigned char* ws = a.ws;
        const bf16_t* Wl = (const bf16_t*)(ws + WS_W + (size_t)l * W_STRIDE);
        const float* sm = (const float*)(ws + WS_SMALL + (size_t)l * SMALL_STRIDE);
        bf16_t* U = (bf16_t*)(ws + WS_U); bf16_t* P = (bf16_t*)(ws + WS_P); float* LA = (float*)(ws + WS_LA);
        bf16_t* O = (bf16_t*)(ws + WS_O); bf16_t* Y5 = (bf16_t*)(ws + WS_Y5); unsigned char* PGb = ws + WS_PG;
        const float* xg = a.in[I_X] + (size_t)grp * TG * D; float* og = a.out + (size_t)grp * TG * D;
        const float* hin = (l <= 1) ? xg : og;
        bf16_t* DLT = (bf16_t*)(ws + WS_O);
        (void)sm;
        if (IN(s0 + 0)) { LTID(t_); const int gw_ = blockIdx.x * 8 + __builtin_amdgcn_readfirstlane(t_ >> 6);
            if (l == 0) phase_norm<false, false>(hin, DLT, og, a.in[I_NG] + l * D, U, gw_, ngw, t_ & 63); else phase_norm<false, true>(hin, DLT, og, a.in[I_NG] + l * D, U, gw_, ngw, t_ & 63);
            SEAM(s0 + 0); }
        if (IN(s0 + 1)) {
            pg8::Gemm g{U, Wl, TG, N_ALL, D, D, D, 0, 0}; pg8::StaticOrder S; S.init(TG, N_ALL, G, (int)blockIdx.x, 0, 256, WGM_G1);
            EpiIn E{P, LA, a.in[I_GBLR] + l * 256, (const float*)(ws + WS_ROT), PGb, (bf16_t*)(ws + WS_SU2)};
            GEMM_CALL(EpiIn);
            SEAM(s0 + 1);
        }
        if (IN(s0 + 2)) { phase_mixers<false>(lds, a, l, G); SEAM(s0 + 2); }
        if (IN(s0 + 3)) { phase_mixers<true>(lds, a, l, G); SEAM(s0 + 3); }
        if (IN(s0 + 4)) {
            { pg8::Gemm g{Y5, (const bf16_t*)((const unsigned char*)Wl + WO_GLU), TG, BW, BW, BW, BW, 0, 0}; pg8::StaticOrder S; S.init(TG, BW, G, (int)blockIdx.x, 0, 256, WGM_GLU);
              EpiGlu E{Y5, P, a.in[I_SGB] + l * BW, O};
              GEMM_CALL(EpiGlu); }
            SEAM(s0 + 4);
        }
        if (IN(s0 + 6)) {
            { pg8::Gemm g{O, (const bf16_t*)((const unsigned char*)Wl + WO_BR), TG, D, BW, OLD, BW, (size_t)BW * 2, (size_t)D * BW * 2}; pg8::StaticOrder S; S.init(TG, D, G, (int)blockIdx.x, 2, 128, WGM_G2);
              EpiBr E{PGb, U};
              pg8::gemm_phase<EpiBr, pg8::StaticOrder, true, true, true>(lds, g, S, E); }
            SEAM(s0 + 6);
        }
        if (IN(s0 + 7)) {
            if (a.fin != 2) { pg8::Gemm g{U, (const bf16_t*)((const unsigned char*)Wl + WO_OUT), TG, D, D, D, D, 0, 0}; pg8::StaticOrder S; S.init(TG, D, G, (int)blockIdx.x, 0, 256, WGM_G3);
              EpiOut E{DLT};
              GEMM_CALL(EpiOut); }
            if (l == 3 && a.fin) { if (a.fin == 1) xcd_barrier(bar); LTID(t_); phase_norm<true, true>(og, DLT, og, a.in[I_FNG], U, blockIdx.x * 8 + __builtin_amdgcn_readfirstlane(t_ >> 6), ngw, t_ & 63); }
            SEAM(s0 + 7);
        }
    }
#undef IN
#undef SEAM
}

extern "C" void kernel_launch(void* const* d_in, const int* in_sizes, int n_in, void* d_out, int out_size, void* d_ws, size_t ws_size, hipStream_t stream) {
    static int grid = 0;
    if (grid == 0) {
        static const int exp_sizes[29] = {67108864, 4096, 21037056, 16384, 1024, 2048, 2048, 2048, 8192, 2048, 131072, 2048, 131072, 2048, 2048, 8192, 8192, 131072, 131072, 131072, 131072, 2048, 128, 1048576, 2048, 16777216, 8388608, 4194304, 1024};
        bool ok_sizes = (n_in == 29); if (ok_sizes) for (int i = 0; i < 29; ++i) if (in_sizes[i] != exp_sizes[i]) { fprintf(stderr, "kernel_launch: input %d has %d elements, expected %d\n", i, in_sizes[i], exp_sizes[i]); ok_sizes = false; }
        if (!ok_sizes || out_size != NB * SEQ * D || ws_size < WS_END) { fprintf(stderr, "kernel_launch: unexpected shapes (n_in %d out %d ws %zu)\n", n_in, out_size, ws_size); grid = -1; return; }
        int dev = 0, cus = 0, per_cu = 0;
        hipGetDevice(&dev); hipDeviceGetAttribute(&cus, hipDeviceAttributeMultiprocessorCount, dev);
        hipOccupancyMaxActiveBlocksPerMultiprocessor(&per_cu, (const void*)mk_fwd, 512, 0);
        (void)hipGetLastError();
        grid = cus > 0 ? cus : 256;
        if (per_cu < 1) fprintf(stderr, "kernel_launch: occupancy query says %d\n", per_cu);
    }
    if (grid < 0) return;
    hipMemsetAsync((char*)d_ws + WS_CTL, 0, CTL_BYTES, stream);
    Args a{};
    for (int i = 0; i < 29; ++i) a.in[i] = (const float*)d_in[i];
    a.out = (float*)d_out; a.ws = (unsigned char*)d_ws;
    unsigned char* ws = (unsigned char*)d_ws;
    int li = 0;
    auto run = [&](int lo, int hi, int fin = 1, int mm = 7) { a.s_lo = lo; a.s_hi = hi; a.li = li++; a.fin = fin; a.mmask = mm; a.pad2 = 0; hipLaunchKernelGGL(mk_fwd, dim3(grid), dim3(512), 0, stream, a); };
    run(0, NSTEPS);
}
#if defined(__HIP_DEVICE_COMPILE__)
#pragma clang attribute pop
#endif
```

```cpp
#include <hip/hip_runtime.h>
#ifndef WGM_G1
#define WGM_G1 4
#endif
#ifndef WGM_G2
#define WGM_G2 8
#endif
#ifndef WGM_G3
#define WGM_G3 8
#endif
#ifndef WGM_GLU
#define WGM_GLU 8
#endif
#include <cstdio>
#include <cstdint>
#if defined(__HIP_DEVICE_COMPILE__)
#pragma clang attribute push(__attribute__((target("no-packed-fp32-ops"))), apply_to = function)
#endif


namespace pg8 {
#define PG8_LAS __attribute__((address_space(3)))
typedef unsigned short bf16_t;
typedef short bf16x8 __attribute__((ext_vector_type(8)));
typedef float f32x4 __attribute__((ext_vector_type(4)));
typedef unsigned u32x4 __attribute__((ext_vector_type(4)));
typedef unsigned u32x2 __attribute__((ext_vector_type(2)));
constexpr int BM = 256, BK = 64, HALF = 128, HTB = HALF * BK * 2, STAGE_BYTES = 8 * HTB, NXCD = 8;

__host__ __device__ __forceinline__ int lds_byte(int r, int c) { const int st = (r >> 4) * 2 + (c >> 5), rr = r & 15, cc = c & 31, ob = rr * 64 + cc * 2; return st * 1024 + (ob ^ (((ob >> 9) & 1) << 5)); }
__host__ __device__ __forceinline__ void stage_rc(int b, int& R, int& C) { const int st = b / 1024, sb = b % 1024, swz = sb ^ (((sb >> 9) & 1) << 5); R = (st >> 1) * 16 + swz / 64; C = (st & 1) * 32 + (swz % 64) / 2; }
__host__ __device__ __forceinline__ int perm32(int rho) { const int n = rho >> 4, i = rho & 15; return 8 * (i >> 2) + 4 * n + (i & 3); }

struct Unit { int pm, pn, z; };
struct Gemm { const bf16_t* A; const bf16_t* Bt; int M, N, K, lda, ldb; size_t zA, zB; };

struct StaticOrder {
    int nM, nN, nwg, G, c, zsh, WGM;
    __host__ __device__ void init(int M, int N, int G_, int c_, int zsh_ = 0, int bn_ = BM, int wgm_ = 4) { nM = M / BM; nN = N / bn_; nwg = nM * nN; G = G_; c = c_; zsh = zsh_; WGM = wgm_; }
    __host__ __device__ bool next(int i, Unit& u) const {
        const int ti = i >> zsh; u.z = i & ((1 << zsh) - 1);
        const long L = (long)ti * G + c; if (L >= nwg) return false;
        int wgid = (int)L; { const int q = nwg / NXCD, r = nwg % NXCD, xcd = wgid % NXCD, off = wgid / NXCD; wgid = (xcd < r ? xcd * (q + 1) : r * (q + 1) + (xcd - r) * q) + off; }
        const int nig = WGM * nN, gid = wgid / nig, fm = gid * WGM, gsz = (nM - fm) < WGM ? (nM - fm) : WGM;
        u.pm = fm + ((wgid % nig) % gsz); u.pn = (wgid % nig) / gsz; return true;
    }
    __device__ __forceinline__ void a_ready(const Unit&) const {}
    __device__ __forceinline__ void done(const Unit&) const {}
};

typedef float f32x2_ __attribute__((ext_vector_type(2)));
typedef __bf16 bf16x2_ __attribute__((ext_vector_type(2)));
__device__ __forceinline__ unsigned cvt_pk_bf16(float lo, float hi) { const f32x2_ v = {lo, hi}; const bf16x2_ b = __builtin_convertvector(v, bf16x2_); return __builtin_bit_cast(unsigned, b); }

template <class Epi, class Sched, bool ALIGN_EPI = false, bool SP2 = false, bool HALFN = false>
__device__ __forceinline__ void gemm_phase(PG8_LAS unsigned char* lds, const Gemm g, const Sched& S, const Epi& E) {
    int tid = threadIdx.x; asm volatile("" : "+v"(tid));
    const int wid = __builtin_amdgcn_readfirstlane(tid >> 6), lane = tid & 63, wr = wid >> 2, wc = wid & 3, fr = lane & 15, fq = lane >> 4;
    const int K = g.K, nt = K / BK;
    unsigned voffA[2], voffB[2];
#pragma unroll
    for (int i = 0; i < 2; ++i) { int R, C; stage_rc(tid * 16 + i * 8192, R, C); const int Rb = Epi::PERM ? ((R & ~31) + perm32(R & 31)) : R;
        voffA[i] = (unsigned)(R * g.lda + C) * 2u; voffB[i] = (unsigned)(Rb * g.ldb + C) * 2u; }
    const size_t kstep = (size_t)(BK * 2);
    const size_t hstepA = (size_t)HALF * g.lda * 2, hstepB = (size_t)HALF * g.ldb * 2;
    const size_t tstepA = 2 * hstepA, tstepB = HALFN ? hstepB : 2 * hstepB;
    const unsigned ldsw = (unsigned)wid * 1024u;
    unsigned aoff = (unsigned)lds_byte(wr * 64 + fr, fq * 8), boff = (unsigned)lds_byte(wc * 32 + fr, fq * 8) + 4u * HTB;
    asm volatile("" : "+v"(aoff), "+v"(boff));
#define PG8_SA(b, h) (((b) * 2 + (h)) * HTB)
#define PG8_SB(b, h) ((4 + (b) * 2 + (h)) * HTB)
#define PG8_STAGE(bufoff, gbase, voff) do { _Pragma("unroll") for (int _i = 0; _i < 2; ++_i) \
        __builtin_amdgcn_global_load_lds((const unsigned*)((const char*)(gbase) + (voff)[_i]), (PG8_LAS unsigned*)(lds + (bufoff) + ldsw + _i * 8192), 16, 0, 0); } while (0)
#define PG8_LDA(dst, b, h) do { _Pragma("unroll") for (int m = 0; m < 4; ++m) _Pragma("unroll") for (int k = 0; k < 2; ++k) dst[m][k] = *(const PG8_LAS bf16x8*)(lds + aoff + (PG8_SA(b, h) + m * 2048 + k * 1024)); } while (0)
#define PG8_LDB(dst, b, h) do { _Pragma("unroll") for (int n = 0; n < 2; ++n) _Pragma("unroll") for (int k = 0; k < 2; ++k) dst[n][k] = *(const PG8_LAS bf16x8*)(lds + boff + (((b) * 2 + (h)) * HTB + n * 2048 + k * 1024)); } while (0)
#define PG8_MMA(ai, bj, At, Bt) do { __builtin_amdgcn_s_setprio(1); _Pragma("unroll") for (int m = 0; m < 4; ++m) _Pragma("unroll") for (int n = 0; n < 2; ++n) _Pragma("unroll") for (int k = 0; k < 2; ++k) \
        acc[ai][bj][m][n] = __builtin_amdgcn_mfma_f32_16x16x32_bf16(Bt[n][k], At[m][k], acc[ai][bj][m][n], 0, 0, 0); __builtin_amdgcn_s_setprio(0); } while (0)
#define PG8_WAIT_V(n) asm volatile("s_waitcnt vmcnt(" #n ")" ::: "memory")
#define PG8_WAIT_L(n) asm volatile("s_waitcnt lgkmcnt(" #n ")" ::: "memory")
#define PG8_BAR __builtin_amdgcn_s_barrier()
#define PG8_SCHED __builtin_amdgcn_sched_barrier(0)
    Unit cur, nxt; int ui = 0;
    if (!S.next(0, cur)) return;
    f32x4 acc[2][2][4][2];
#pragma unroll
    for (int a = 0; a < 2; ++a)
#pragma unroll
        for (int b = 0; b < 2; ++b)
#pragma unroll
            for (int m = 0; m < 4; ++m)
#pragma unroll
                for (int n = 0; n < 2; ++n) acc[a][b][m][n] = (f32x4){0.f, 0.f, 0.f, 0.f};
    bf16x8 At[4][2], B0[2][2], B1[2][2];
    const char* cA = (const char*)g.A + (size_t)cur.pm * tstepA + (size_t)cur.z * g.zA; const char* cB = (const char*)g.Bt + (size_t)cur.pn * tstepB + (size_t)cur.z * g.zB;
    S.a_ready(cur);
    if constexpr (SP2 && HALFN) {
        PG8_STAGE(PG8_SB(0, 0), cB, voffB); PG8_STAGE(PG8_SA(0, 0), cA, voffA); PG8_STAGE(PG8_SA(0, 1), cA + hstepA, voffA);
        if (wr == 1) PG8_BAR;
        PG8_WAIT_V(2); PG8_BAR;
        PG8_STAGE(PG8_SB(1, 0), cB + kstep, voffB); PG8_STAGE(PG8_SA(1, 0), cA + kstep, voffA);
        PG8_WAIT_V(4); PG8_BAR;
    } else if constexpr (SP2) {
        PG8_STAGE(PG8_SB(0, 0), cB, voffB); PG8_STAGE(PG8_SB(0, 1), cB + hstepB, voffB); PG8_STAGE(PG8_SA(0, 0), cA, voffA); PG8_STAGE(PG8_SA(0, 1), cA + hstepA, voffA);
        if (wr == 1) PG8_BAR;
        PG8_WAIT_V(2); PG8_BAR;
        PG8_STAGE(PG8_SB(1, 0), cB + kstep, voffB); PG8_STAGE(PG8_SA(1, 0), cA + kstep, voffA); PG8_STAGE(PG8_SB(1, 1), cB + hstepB + kstep, voffB);
        PG8_WAIT_V(6); PG8_BAR;
    } else {
        PG8_STAGE(PG8_SB(0, 0), cB, voffB); PG8_STAGE(PG8_SA(0, 0), cA, voffA); PG8_STAGE(PG8_SB(0, 1), cB + hstepB, voffB); PG8_STAGE(PG8_SA(0, 1), cA + hstepA, voffA);
        if (wr == 1) PG8_BAR;
        PG8_WAIT_V(4); PG8_BAR;
        PG8_STAGE(PG8_SB(1, 0), cB + kstep, voffB); PG8_STAGE(PG8_SA(1, 0), cA + kstep, voffA); PG8_STAGE(PG8_SB(1, 1), cB + hstepB + kstep, voffB);
        PG8_WAIT_V(6); PG8_BAR;
    }
    for (;;) {
        const bool has_next = S.next(ui + 1, nxt);
        const char* nA = has_next ? (const char*)g.A + (size_t)nxt.pm * tstepA + (size_t)nxt.z * g.zA : cA; const char* nB = has_next ? (const char*)g.Bt + (size_t)nxt.pn * tstepB + (size_t)nxt.z * g.zB : cB;
        for (int t = 0; t < nt; t += 2) {
            const bool last = (t == nt - 2);
            const char* a1 = cA + (size_t)(t + 1) * kstep;
            const char* a2 = last ? nA : cA + (size_t)(t + 2) * kstep; const char* b2 = last ? nB : cB + (size_t)(t + 2) * kstep;
            const char* a3 = a2 + kstep; const char* b3 = b2 + kstep;
            if (last && has_next) S.a_ready(nxt);
            if constexpr (SP2 && HALFN) {
            PG8_LDB(B0, 0, 0); PG8_SCHED; PG8_LDA(At, 0, 0); PG8_STAGE(PG8_SA(1, 1), a1 + hstepA, voffA);
            PG8_WAIT_V(6); PG8_WAIT_L(0); PG8_BAR; PG8_MMA(0, 0, At, B0); PG8_BAR; PG8_SCHED;
            PG8_LDA(At, 0, 1); PG8_STAGE(PG8_SB(0, 0), b2, voffB); PG8_STAGE(PG8_SA(0, 0), a2, voffA);
            PG8_WAIT_V(6); PG8_WAIT_L(0); PG8_BAR; PG8_MMA(1, 0, At, B0); PG8_BAR; PG8_SCHED;
            PG8_LDB(B0, 1, 0); PG8_SCHED; PG8_LDA(At, 1, 0); PG8_STAGE(PG8_SA(0, 1), a2 + hstepA, voffA);
            PG8_WAIT_V(6); PG8_WAIT_L(0); PG8_BAR; PG8_MMA(0, 0, At, B0); PG8_BAR; PG8_SCHED;
            PG8_LDA(At, 1, 1); PG8_STAGE(PG8_SB(1, 0), b3, voffB); PG8_STAGE(PG8_SA(1, 0), a3, voffA);
            PG8_WAIT_V(6); PG8_WAIT_L(0); PG8_BAR; PG8_MMA(1, 0, At, B0); PG8_BAR; PG8_SCHED;
            } else if constexpr (SP2) {
            PG8_LDB(B0, 0, 0); PG8_LDB(B1, 0, 1); PG8_SCHED; PG8_LDA(At, 0, 0); PG8_STAGE(PG8_SA(1, 1), a1 + hstepA, voffA);
            PG8_WAIT_V(8); PG8_WAIT_L(0); PG8_BAR; PG8_MMA(0, 0, At, B0); PG8_MMA(0, 1, At, B1); PG8_BAR; PG8_SCHED;
            PG8_LDA(At, 0, 1); PG8_STAGE(PG8_SB(0, 0), b2, voffB); PG8_STAGE(PG8_SB(0, 1), b2 + hstepB, voffB); PG8_STAGE(PG8_SA(0, 0), a2, voffA);
            PG8_WAIT_V(8); PG8_WAIT_L(0); PG8_BAR; PG8_MMA(1, 0, At, B0); PG8_MMA(1, 1, At, B1); PG8_BAR; PG8_SCHED;
            PG8_LDB(B0, 1, 0); PG8_LDB(B1, 1, 1); PG8_SCHED; PG8_LDA(At, 1, 0); PG8_STAGE(PG8_SA(0, 1), a2 + hstepA, voffA);
            PG8_WAIT_V(8); PG8_WAIT_L(0); PG8_BAR; PG8_MMA(0, 0, At, B0); PG8_MMA(0, 1, At, B1); PG8_BAR; PG8_SCHED;
            PG8_LDA(At, 1, 1); PG8_STAGE(PG8_SB(1, 0), b3, voffB); PG8_STAGE(PG8_SB(1, 1), b3 + hstepB, voffB); PG8_STAGE(PG8_SA(1, 0), a3, voffA);
            PG8_WAIT_V(8); PG8_WAIT_L(0); PG8_BAR; PG8_MMA(1, 0, At, B0); PG8_MMA(1, 1, At, B1); PG8_BAR; PG8_SCHED;
            } else {
            PG8_LDB(B0, 0, 0); PG8_SCHED; PG8_LDA(At, 0, 0); PG8_STAGE(PG8_SA(1, 1), a1 + hstepA, voffA);
            PG8_WAIT_L(8); PG8_BAR; PG8_WAIT_L(0); PG8_MMA(0, 0, At, B0); PG8_BAR; PG8_SCHED;
            PG8_LDB(B1, 0, 1); PG8_STAGE(PG8_SB(0, 0), b2, voffB);
            PG8_BAR; PG8_WAIT_L(0); PG8_MMA(0, 1, At, B1); PG8_BAR;
            PG8_LDA(At, 0, 1); PG8_STAGE(PG8_SA(0, 0), a2, voffA);
            PG8_BAR; PG8_WAIT_L(0); PG8_MMA(1, 0, At, B0); PG8_BAR; PG8_SCHED;
            PG8_STAGE(PG8_SB(0, 1), b2 + hstepB, voffB);
            PG8_WAIT_V(6); PG8_BAR; PG8_MMA(1, 1, At, B1); PG8_BAR;
            PG8_LDB(B0, 1, 0); PG8_SCHED; PG8_LDA(At, 1, 0); PG8_STAGE(PG8_SA(0, 1), a2 + hstepA, voffA);
            PG8_WAIT_L(8); PG8_BAR; PG8_WAIT_L(0); PG8_MMA(0, 0, At, B0); PG8_BAR; PG8_SCHED;
            PG8_LDB(B1, 1, 1); PG8_STAGE(PG8_SB(1, 0), b3, voffB);
            PG8_BAR; PG8_WAIT_L(0); PG8_MMA(0, 1, At, B1); PG8_BAR;
            PG8_LDA(At, 1, 1); PG8_STAGE(PG8_SA(1, 0), a3, voffA);
            PG8_BAR; PG8_WAIT_L(0); PG8_MMA(1, 0, At, B0); PG8_BAR; PG8_SCHED;
            PG8_STAGE(PG8_SB(1, 1), b3 + hstepB, voffB);
            PG8_WAIT_V(6); PG8_BAR; PG8_MMA(1, 1, At, B1); PG8_BAR;
            }
        }
        if constexpr (ALIGN_EPI) { if (wr == 0) PG8_BAR; }
        { int fr_e = fr, fq_e = fq; asm volatile("" : "+v"(fr_e), "+v"(fq_e));
          E(acc, cur, wr, wc, fr_e, fq_e); }
        if (!has_next) break;
        if (!HALFN && !(Epi::KEEP && cur.z != 3)) {
#pragma unroll
        for (int a = 0; a < 2; ++a)
#pragma unroll
            for (int b = 0; b < 2; ++b)
#pragma unroll
                for (int m = 0; m < 4; ++m)
#pragma unroll
                    for (int n = 0; n < 2; ++n) acc[a][b][m][n] = (f32x4){0.f, 0.f, 0.f, 0.f};
        }
        cur = nxt; cA = nA; cB = nB; ++ui;
        if constexpr (ALIGN_EPI) { if (wr == 1) PG8_BAR; }
    }
    PG8_WAIT_V(0);
    if constexpr (!ALIGN_EPI) { if (wr == 0) PG8_BAR; }
    PG8_BAR;
#undef PG8_SA
#undef PG8_SB
#undef PG8_STAGE
#undef PG8_LDA
#undef PG8_LDB
#undef PG8_MMA
#undef PG8_WAIT_V
#undef PG8_WAIT_L
#undef PG8_BAR
#undef PG8_SCHED
}

}

using pg8::bf16_t; using pg8::f32x4; using pg8::u32x4; using pg8::u32x2; using pg8::bf16x8; using pg8::cvt_pk_bf16;
#define LAS __attribute__((address_space(3)))

constexpr int D = 1024, SEQ = 4096, NB = 16, DEPTH = 4, BW = 512;
constexpr int NGRP = 2, BG = NB / NGRP, TG = BG * SEQ;
constexpr int N_IN = 21 * 256, N_MG = 4096, N_ALL = N_IN + N_MG;
constexpr int PLD = 20 * 256;
constexpr int P_GQ = 0, P_GK = 256, P_GV = 512, P_GG = 1024, P_RQ = 1536, P_RK = 1792, P_RV = 2048, P_RG = 2560, P_LX = 3072, P_LG = 3584, P_SU = 4096, P_SG = 4608;
constexpr int OLD = 2048;
constexpr float NORM_EPS = 1e-6f;

constexpr size_t MiB = 1u << 20;
constexpr size_t WS_CTL = 0, CTL_BYTES = 2 * MiB;
constexpr size_t WS_ROT = 2 * MiB;
constexpr size_t WS_SMALL = 3 * MiB, SMALL_STRIDE = 1 * MiB;
constexpr size_t WS_W = 8 * MiB, W_STRIDE = 26 * MiB;
constexpr size_t WO_IN = 0, WO_BR = (size_t)N_ALL * D * 2, WO_OUT = WO_BR + (size_t)4 * D * BW * 2, WO_GLU = WO_OUT + (size_t)D * D * 2, WO_END = WO_GLU + (size_t)BW * BW * 2;
static_assert(WO_END <= W_STRIDE, "weights");
constexpr size_t WS_U = 112 * MiB;
constexpr size_t WS_P = 176 * MiB;
constexpr size_t WS_LA = 496 * MiB;
constexpr size_t WS_O = 528 * MiB;
constexpr size_t WS_Y5 = 656 * MiB;
constexpr size_t WS_PG = 688 * MiB;
constexpr size_t WS_S5D = 816 * MiB;
constexpr size_t WS_S5M = 820 * MiB, S5M_BYTES = 86016;
constexpr size_t WS_S5K = 831 * MiB;
constexpr size_t WS_SU2 = 832 * MiB;
constexpr size_t WS_ST = 944 * MiB;
constexpr size_t WS_END = 1008 * MiB;
constexpr int SM_ABR = 0, SM_ABI = 2048, SM_BBR = 4096, SM_BBI = 4096 + 32768, SM_SP8 = 4096 + 65536, SM_END_F = SM_SP8 + 512;
constexpr int SM_A128 = SM_END_F;
constexpr int SM_A8 = SM_A128 + 4096;
constexpr size_t SM_LRUW_BYTES = 512 * 1024, SM_CT_BYTES = 640 * 1024, SM_BBT_BYTES = 768 * 1024;
static_assert((size_t)(SM_END_F + 8192) * 4 <= SM_LRUW_BYTES, "small");

constexpr int CW_BAR = 4096;
#define XB_TMO      128
#define XB_XCNT(j)  (256  + 64 * (j))
#define XB_XSUB(j)  (1280 + 64 * (j))
#define XB_XGEN(j)  (2304 + 64 * (j))
#define XB_TOP      3328
#define XB_TOPGEN   3392
#define XCD_BAR_WORDS 3456
#define XB_SPIN_CAP (1u << 18)

__device__ __forceinline__ void wg_syncthreads() { __builtin_amdgcn_fence(__ATOMIC_RELEASE, "workgroup"); __builtin_amdgcn_s_barrier(); __builtin_amdgcn_fence(__ATOMIC_ACQUIRE, "workgroup"); }
__device__ __forceinline__ unsigned xb_ld(unsigned* p)              { return __hip_atomic_load(p, __ATOMIC_RELAXED, __HIP_MEMORY_SCOPE_AGENT); }
__device__ __forceinline__ unsigned xb_add(unsigned* p, unsigned v) { return __hip_atomic_fetch_add(p, v, __ATOMIC_RELAXED, __HIP_MEMORY_SCOPE_AGENT); }
__device__ __forceinline__ unsigned xb_xcc_id() { return (unsigned)__builtin_amdgcn_s_getreg((3 << 11) | 20) & 0xFu; }
#define XB_SPIN(cond, bar) do { unsigned _sp = 0; while (cond) { __builtin_amdgcn_s_sleep(1); \
    if ((++_sp & 255u) == 0u) { if (xb_ld(&(bar)[XB_TMO])) break; if (_sp > XB_SPIN_CAP) { (void)xb_add(&(bar)[XB_TMO], 1u); break; } } } } while (0)
struct XcdBarrier { unsigned* bar; unsigned x; volatile LAS unsigned* st; };
__device__ __forceinline__ XcdBarrier xcd_barrier_post(unsigned* bar, volatile LAS unsigned* st) {
    XcdBarrier b; b.bar = bar; b.x = xb_xcc_id(); b.st = st;
    if (threadIdx.x == 0) (void)xb_add(&bar[XB_XCNT(b.x)], 1u);
    return b;
}
__device__ __forceinline__ void xcd_barrier_complete(unsigned* bar, unsigned x, unsigned& nloc, unsigned& nx) {
    const unsigned G = gridDim.x * gridDim.y * gridDim.z;
    unsigned sum, cnt, mine, sp = 0u;
    for (;;) {
        sum = 0u; cnt = 0u; mine = 0u;
#pragma unroll
        for (unsigned j = 0; j < 16; ++j) { const unsigned c = xb_ld(&bar[XB_XCNT(j)]); sum += c; cnt += (c > 0u) ? 1u : 0u; mine = (j == x) ? c : mine; }
        if (sum == G) break;
        __builtin_amdgcn_s_sleep(1);
        if ((++sp & 255u) == 0u) { if (xb_ld(&bar[XB_TMO])) break; if (sp > XB_SPIN_CAP) { (void)xb_add(&bar[XB_TMO], 1u); break; } }
    }
    nloc = mine > 0u ? mine : 1u; nx = cnt > 0u ? cnt : 1u;
}
__device__ __forceinline__ void xcd_barrier(const XcdBarrier& b) {
    asm volatile("s_waitcnt vmcnt(0)" ::: "memory");
    wg_syncthreads();
    if (threadIdx.x == 0) {
        unsigned* bar = b.bar;
        __builtin_amdgcn_s_waitcnt(0);
        unsigned nloc = b.st[0], nx = b.st[1];
        if (nloc == 0u) { xcd_barrier_complete(bar, b.x, nloc, nx); b.st[0] = nloc; b.st[1] = nx; }
        const unsigned old = xb_add(&bar[XB_XSUB(b.x)], 1u);
        const unsigned gen = old / nloc;
        if (old + 1u == (gen + 1u) * nloc) {
            __builtin_amdgcn_fence(__ATOMIC_RELEASE, "agent");
            asm volatile("s_waitcnt vmcnt(0)" ::: "memory");
            const unsigned og = xb_add(&bar[XB_TOP], 1u);
            const unsigned tg = og / nx;
            if (og + 1u == (tg + 1u) * nx) xb_add(&bar[XB_TOPGEN], 1u);
            else XB_SPIN(xb_ld(&bar[XB_TOPGEN]) == tg, bar);
            __builtin_amdgcn_fence(__ATOMIC_ACQUIRE, "agent");
            xb_add(&bar[XB_XGEN(b.x)], 1u);
            asm volatile("s_waitcnt vmcnt(0)" ::: "memory");
        } else {
            XB_SPIN(xb_ld(&bar[XB_XGEN(b.x)]) == gen, bar);
            __builtin_amdgcn_fence(__ATOMIC_ACQUIRE, "agent");
            asm volatile("s_waitcnt vmcnt(0)" ::: "memory");
        }
    }
    wg_syncthreads();
}

__device__ __forceinline__ float bf2f(bf16_t b) { return __builtin_bit_cast(float, ((unsigned)b) << 16); }
__device__ __forceinline__ float bflo(unsigned w) { return __builtin_bit_cast(float, w << 16); }
__device__ __forceinline__ float bfhi(unsigned w) { return __builtin_bit_cast(float, w & 0xffff0000u); }
__device__ __forceinline__ bf16_t f2bf(float f) { return (bf16_t)(cvt_pk_bf16(f, 0.f) & 0xffffu); }
__device__ __forceinline__ float sigmoid_f(float x) { return __builtin_amdgcn_rcpf(1.f + __expf(-x)); }
__device__ __forceinline__ float silu_f(float x) { return x * sigmoid_f(x); }
__device__ __forceinline__ float silu_t(float t) { return t * __builtin_amdgcn_rcpf(__builtin_fmaf(__builtin_amdgcn_exp2f(t), -1.4426950408889634f, -1.4426950408889634f)); }
__device__ __forceinline__ float sig255(float t) { return __builtin_amdgcn_rcpf(__builtin_fmaf(__builtin_amdgcn_exp2f(t), 1.f / 255.f, 1.f / 255.f)); }
__device__ __forceinline__ float gelu_tanh_f(float x) { const float u = 0.7978845608028654f * (x + 0.044715f * x * x * x); const float t = 1.f - 2.f * __builtin_amdgcn_rcpf(1.f + __expf(2.f * u)); return 0.5f * x * (1.f + t); }
__device__ __forceinline__ float shfl_xor_f(float v, int m) { const int ln = (int)__builtin_amdgcn_mbcnt_hi(~0u, __builtin_amdgcn_mbcnt_lo(~0u, 0u)); return __builtin_bit_cast(float, __builtin_amdgcn_ds_bpermute((ln ^ m) << 2, __builtin_bit_cast(int, v))); }
__device__ __forceinline__ float wave_sum(float v) {
#pragma unroll
    for (int o = 1; o < 64; o <<= 1) v += shfl_xor_f(v, o);
    return v;
}

#define GEMM_CALL(EPI) pg8::gemm_phase<EPI, pg8::StaticOrder, true, true>(lds, g, S, E)
struct Args {
    const float* in[29]; float* out; unsigned char* ws;
    int s_lo, s_hi, li, fin, mmask, pad2;
};
enum { I_X = 0, I_NG, I_WIN, I_GWLR, I_GBLR, I_GNG, I_RNG, I_RNB, I_LCW, I_LCB, I_LWA, I_LBA, I_LWX, I_LBX, I_LLAM,
       I_SARE, I_SAIM, I_SBRE, I_SBIM, I_SCRE, I_SCIM, I_SD, I_SLDT, I_SGW, I_SGB, I_WMG, I_WBR, I_WOUT, I_FNG };

struct EpiIn {
    static constexpr bool PERM = true, AFTER_DRAIN = false, KEEP = false;
    bf16_t* P; float* LA; const float* blr; const float* rot; unsigned char* PG; bf16_t* SU;
    __device__ __forceinline__ void operator()(f32x4 (&acc)[2][2][4][2], const pg8::Unit& u, int wr, int wc, int fr, int fq) const {
        const int pn = u.pn, row0 = u.pm * 256 + wr * 64 + fr, cl = wc * 32 + 8 * fq;
        if (pn >= 21) {
#pragma unroll
            for (int ai = 0; ai < 2; ++ai)
#pragma unroll
                for (int m = 0; m < 4; ++m) { int row = row0 + ai * 128 + m * 16; asm volatile("" : "+v"(row));
                    u32x4 w;
#pragma unroll
                    for (int bj = 0; bj < 2; ++bj) { const f32x4 v0 = acc[ai][bj][m][0], v1 = acc[ai][bj][m][1]; unsigned lo = 0u, hi = 0u;
#pragma unroll
                        for (int j = 0; j < 4; ++j) { lo = __builtin_amdgcn_cvt_pk_u8_f32(sig255(v0[j]), j, lo); hi = __builtin_amdgcn_cvt_pk_u8_f32(sig255(v1[j]), j, hi); }
                        if (bj == 0) { w.x = lo; w.y = hi; } else { w.z = lo; w.w = hi; } }
                    __builtin_nontemporal_store(w, (u32x4*)(PG + (size_t)row * N_MG + (pn - 21) * 256 + 2 * cl)); }
        } else if (pn == 4) {
#pragma unroll
            for (int bj = 0; bj < 2; ++bj) { const int c = cl + bj * 128; const f32x4 b0 = *(const f32x4*)(blr + c), b1 = *(const f32x4*)(blr + c + 4);
#pragma unroll
                for (int ai = 0; ai < 2; ++ai) {
#pragma unroll
                    for (int n = 0; n < 2; ++n)
#pragma unroll
                        for (int j = 0; j < 4; ++j) { float run = 0.f; const float bb = n ? b1[j] : b0[j];
#pragma unroll
                            for (int m = 0; m < 4; ++m) { const float z = acc[ai][bj][m][n][j] + bb; const float x = -(fmaxf(-z, 0.f) + __logf(1.f + __expf(-fabsf(z)))) * 0.0625f; float ls = x, rs = x;
#define DPP_ADD(acc_, ctrl_) acc_ += __builtin_bit_cast(float, __builtin_amdgcn_update_dpp(0, __builtin_bit_cast(int, acc_), ctrl_, 0xf, 0xf, true))
                                DPP_ADD(ls, 0x111); DPP_ADD(ls, 0x112); DPP_ADD(ls, 0x114); DPP_ADD(ls, 0x118);
                                DPP_ADD(rs, 0x101); DPP_ADD(rs, 0x102); DPP_ADD(rs, 0x104); DPP_ADD(rs, 0x108);
#undef DPP_ADD
                                acc[ai][bj][m][n][j] = run + ls; run += ls + rs - x; } }
#pragma unroll
                    for (int m = 0; m < 4; ++m) { int row = row0 + ai * 128 + m * 16; asm volatile("" : "+v"(row)); float* d = LA + ((size_t)(c >> 6) * TG + row) * 64 + (c & 63); *(f32x4*)d = acc[ai][bj][m][0]; *(f32x4*)(d + 4) = acc[ai][bj][m][1]; } } }
        } else if (pn == 7 || pn == 8) {
            const int dcol = (pn - 1) * 256;
#pragma unroll
            for (int ai = 0; ai < 2; ++ai)
#pragma unroll
                for (int m = 0; m < 4; ++m) { int row = row0 + ai * 128 + m * 16; asm volatile("" : "+v"(row)); const int pos = row & (SEQ - 1);
#pragma unroll
                    for (int bj = 0; bj < 2; ++bj) { const int c = cl + bj * 128, i0 = (c & 63) >> 1; const float* rt = rot + ((size_t)pos * 32 + i0) * 2;
                        const f32x4 cs0 = *(const f32x4*)rt, cs1 = *(const f32x4*)(rt + 4); const f32x4 v0 = acc[ai][bj][m][0], v1 = acc[ai][bj][m][1];
                        u32x4 w; w.x = cvt_pk_bf16(v0[0] * cs0[0] - v0[1] * cs0[1], v0[0] * cs0[1] + v0[1] * cs0[0]); w.y = cvt_pk_bf16(v0[2] * cs0[2] - v0[3] * cs0[3], v0[2] * cs0[3] + v0[3] * cs0[2]);
                        w.z = cvt_pk_bf16(v1[0] * cs1[0] - v1[1] * cs1[1], v1[0] * cs1[1] + v1[1] * cs1[0]); w.w = cvt_pk_bf16(v1[2] * cs1[2] - v1[3] * cs1[3], v1[2] * cs1[3] + v1[3] * cs1[2]);
                        __builtin_nontemporal_store(w, (u32x4*)(P + (size_t)(dcol + (c & ~63)) * TG + (size_t)row * 64 + (c & 63))); } }
        } else {
            const bool silu = (pn == 5 || pn == 6 || pn == 11 || pn == 12 || pn == 15 || pn == 16 || pn == 19 || pn == 20);
            const int dcol = (pn < 4 ? pn : pn - 1) * 256;
            const int wsh = (pn >= 19) ? 9 : ((pn == 2 || pn == 3 || pn == 5 || pn == 6 || (pn >= 9 && pn <= 12)) ? 7 : 6);
#pragma unroll
            for (int ai = 0; ai < 2; ++ai)
#pragma unroll
                for (int m = 0; m < 4; ++m) { int row = row0 + ai * 128 + m * 16; asm volatile("" : "+v"(row));
#pragma unroll
                    for (int bj = 0; bj < 2; ++bj) { f32x4 v0 = acc[ai][bj][m][0], v1 = acc[ai][bj][m][1];
                        if (silu) {
#pragma unroll
                            for (int j = 0; j < 4; ++j) { v0[j] = silu_t(v0[j]); v1[j] = silu_t(v1[j]); } }
                        u32x4 w; w.x = cvt_pk_bf16(v0[0], v0[1]); w.y = cvt_pk_bf16(v0[2], v0[3]); w.z = cvt_pk_bf16(v1[0], v1[1]); w.w = cvt_pk_bf16(v1[2], v1[3]);
                        if (pn == 17 || pn == 18) { const int cc = (pn - 17) * 256 + cl + bj * 128;
                            __builtin_nontemporal_store(w, (u32x4*)(SU + ((size_t)(cc >> 4) * TG + row) * 16 + (cc & 15))); }
                        else { const int col = dcol + cl + bj * 128; __builtin_nontemporal_store(w, (u32x4*)(P + (size_t)(col >> wsh << wsh) * TG + ((size_t)row << wsh) + (col & ((1 << wsh) - 1)))); } } }
        }
    }
};
struct EpiSig {
    static constexpr bool PERM = true, AFTER_DRAIN = false, KEEP = false;
    bf16_t* PG;
    __device__ __forceinline__ void operator()(const f32x4 (&acc)[2][2][4][2], const pg8::Unit& u, int wr, int wc, int fr, int fq) const {
        const int row0 = u.pm * 256 + wr * 64 + fr, c0 = u.pn * 256 + wc * 32 + 8 * fq;
#pragma unroll
        for (int ai = 0; ai < 2; ++ai)
#pragma unroll
            for (int m = 0; m < 4; ++m) { const int row = row0 + ai * 128 + m * 16;
#pragma unroll
                for (int bj = 0; bj < 2; ++bj) { f32x4 v0 = acc[ai][bj][m][0], v1 = acc[ai][bj][m][1];
#pragma unroll
                    for (int j = 0; j < 4; ++j) { v0[j] = sigmoid_f(v0[j]); v1[j] = sigmoid_f(v1[j]); }
                    u32x4 w; w.x = cvt_pk_bf16(v0[0], v0[1]); w.y = cvt_pk_bf16(v0[2], v0[3]); w.z = cvt_pk_bf16(v1[0], v1[1]); w.w = cvt_pk_bf16(v1[2], v1[3]);
                    *(u32x4*)(PG + (size_t)row * N_MG + c0 + bj * 128) = w; } }
    }
};
struct EpiGlu {
    static constexpr bool PERM = true, AFTER_DRAIN = false, KEEP = false;
    const bf16_t* Y5; const bf16_t* P; const float* gb; bf16_t* O;
    __device__ __forceinline__ void operator()(const f32x4 (&acc)[2][2][4][2], const pg8::Unit& u, int wr, int wc, int fr, int fq) const {
        const int row0 = u.pm * 256 + wr * 64 + fr, c0 = u.pn * 256 + wc * 32 + 8 * fq;
#pragma unroll
        for (int bj = 0; bj < 2; ++bj) { const int c = c0 + bj * 128; const f32x4 b0 = *(const f32x4*)(gb + c), b1 = *(const f32x4*)(gb + c + 4);
#pragma unroll
            for (int ai = 0; ai < 2; ++ai)
#pragma unroll
                for (int m = 0; m < 4; ++m) { const int row = row0 + ai * 128 + m * 16;
                    const u32x4 y = *(const u32x4*)(Y5 + (size_t)row * BW + c), s = *(const u32x4*)(P + (size_t)P_SG * TG + (size_t)row * 512 + c);
                    const f32x4 v0 = acc[ai][bj][m][0] + b0, v1 = acc[ai][bj][m][1] + b1;
                    u32x4 w;
                    w.x = cvt_pk_bf16(bflo(y.x) * sigmoid_f(v0[0]) * bflo(s.x), bfhi(y.x) * sigmoid_f(v0[1]) * bfhi(s.x));
                    w.y = cvt_pk_bf16(bflo(y.y) * sigmoid_f(v0[2]) * bflo(s.y), bfhi(y.y) * sigmoid_f(v0[3]) * bfhi(s.y));
                    w.z = cvt_pk_bf16(bflo(y.z) * sigmoid_f(v1[0]) * bflo(s.z), bfhi(y.z) * sigmoid_f(v1[1]) * bfhi(s.z));
                    w.w = cvt_pk_bf16(bflo(y.w) * sigmoid_f(v1[2]) * bflo(s.w), bfhi(y.w) * sigmoid_f(v1[3]) * bfhi(s.w));
                    *(u32x4*)(O + (size_t)row * OLD + 1536 + c) = w; } }
    }
};
struct EpiBr {
    static constexpr bool PERM = true, AFTER_DRAIN = false, KEEP = false;
    const unsigned char* PG; bf16_t* MRG;
    __device__ __forceinline__ void operator()(f32x4 (&acc)[2][2][4][2], const pg8::Unit& u, int wr, int wc, int fr, int fq) const {
        const int row0 = u.pm * 256 + wr * 64 + fr, c = u.pn * 128 + wc * 32 + 8 * fq, z = u.z;
        const int gpos = (z * 4 + (u.pn >> 1)) * 256 + wc * 64 + fq * 16 + (u.pn & 1) * 8;
#pragma unroll
        for (int ai = 0; ai < 2; ++ai)
#pragma unroll
            for (int m = 0; m < 4; ++m) { const int row = row0 + ai * 128 + m * 16;
                const u32x2 gt = __builtin_nontemporal_load((const u32x2*)(PG + (size_t)row * N_MG + gpos));
                f32x4& p0 = acc[ai][0][m][0]; f32x4& p1 = acc[ai][0][m][1]; f32x4& s0 = acc[ai][1][m][0]; f32x4& s1 = acc[ai][1][m][1];
                if (z == 0) { s0 = (f32x4){0.f, 0.f, 0.f, 0.f}; s1 = s0; }
                s0[0] += p0[0] * (float)(gt.x & 255u); s0[1] += p0[1] * (float)((gt.x >> 8) & 255u); s0[2] += p0[2] * (float)((gt.x >> 16) & 255u); s0[3] += p0[3] * (float)(gt.x >> 24);
                s1[0] += p1[0] * (float)(gt.y & 255u); s1[1] += p1[1] * (float)((gt.y >> 8) & 255u); s1[2] += p1[2] * (float)((gt.y >> 16) & 255u); s1[3] += p1[3] * (float)(gt.y >> 24);
                p0 = (f32x4){0.f, 0.f, 0.f, 0.f}; p1 = p0;
                if (z == 3) { const float q = 1.f / 255.f; s0 *= q; s1 *= q;
                    u32x4 w; w.x = cvt_pk_bf16(s0[0], s0[1]); w.y = cvt_pk_bf16(s0[2], s0[3]); w.z = cvt_pk_bf16(s1[0], s1[1]); w.w = cvt_pk_bf16(s1[2], s1[3]);
                    *(u32x4*)(MRG + (size_t)row * D + c) = w; } }
    }
};
struct EpiOut {
    static constexpr bool PERM = true, AFTER_DRAIN = false, KEEP = false;
    bf16_t* DL;
    __device__ __forceinline__ void operator()(const f32x4 (&acc)[2][2][4][2], const pg8::Unit& u, int wr, int wc, int fr, int fq) const {
        const int row0 = u.pm * 256 + wr * 64 + fr, c0 = u.pn * 256 + wc * 32 + 8 * fq;
#pragma unroll
        for (int ai = 0; ai < 2; ++ai)
#pragma unroll
            for (int m = 0; m < 4; ++m) { const int row = row0 + ai * 128 + m * 16;
#pragma unroll
                for (int bj = 0; bj < 2; ++bj) { const f32x4 v0 = acc[ai][bj][m][0], v1 = acc[ai][bj][m][1];
                    u32x4 w; w.x = cvt_pk_bf16(v0[0], v0[1]); w.y = cvt_pk_bf16(v0[2], v0[3]); w.z = cvt_pk_bf16(v1[0], v1[1]); w.w = cvt_pk_bf16(v1[2], v1[3]);
                    *(u32x4*)(DL + (size_t)row * D + c0 + bj * 128) = w; } }
    }
};

__device__ __forceinline__ int win_src_col(int r) {
    const int pn = r >> 8, j = r & 255;
    switch (pn) {
        case 0: return j; case 1: return 256 + j; case 2: case 3: return 512 + (r - 512);
        case 4: return -1;
        case 5: case 6: return 1040 + (r - 1280);
        case 7: return 1552 + 64 * (j >> 6) + ((j & 63) >> 1) + 32 * (j & 1);
        case 8: return 1808 + 64 * (j >> 6) + ((j & 63) >> 1) + 32 * (j & 1);
        case 9: case 10: return 2064 + (r - 2304);
        case 11: case 12: return 2576 + (r - 2816);
        case 13: case 14: return 3088 + (r - 3328);
        case 15: case 16: return 3600 + (r - 3840);
        case 17: case 18: return 4112 + (r - 4352);
        default: return 4624 + (r - 4864);
    }
}
__device__ __forceinline__ void tr_store8(bf16_t* dst, const float (&v)[8]) {
    u32x4 w; w.x = cvt_pk_bf16(v[0], v[1]); w.y = cvt_pk_bf16(v[2], v[3]); w.z = cvt_pk_bf16(v[4], v[5]); w.w = cvt_pk_bf16(v[6], v[7]); *(u32x4*)dst = w;
}
__device__ __forceinline__ void phase_prologue(LAS unsigned char* lds, const Args& a, int gtid, int gthreads) {
    unsigned char* ws = a.ws;
    for (int q = gtid; q < DEPTH * 2048; q += gthreads) { const int l = q >> 11, idx = q & 2047, g = idx >> 6;
        float* sm = (float*)(ws + WS_SMALL + (size_t)l * SMALL_STRIDE);
        const double step = exp((double)a.in[I_SLDT][l * 32 + g]); const double are = a.in[I_SARE][l * 2048 + idx], aim = a.in[I_SAIM][l * 2048 + idx];
        const double mag = exp(step * are), abr = mag * cos(step * aim), abi = mag * sin(step * aim), den = are * are + aim * aim;
        const double fre = ((abr - 1.0) * are + abi * aim) / den, fim = (abi * are - (abr - 1.0) * aim) / den;
        sm[SM_ABR + idx] = (float)abr; sm[SM_ABI + idx] = (float)abi;
        double* s5d = (double*)(ws + WS_S5D) + ((size_t)l * 2048 + idx) * 50;
        { double pr = 1.0, pi = 0.0;
          for (int j = 0; j <= 8; ++j) { s5d[2 * j] = pr; s5d[2 * j + 1] = pi; if (j == 8) { sm[SM_A8 + idx * 2] = (float)pr; sm[SM_A8 + idx * 2 + 1] = (float)pi; } const double nr = pr * abr - pi * abi, ni = pr * abi + pi * abr; pr = nr; pi = ni; } }
        { const double m128 = exp(512.0 * step * are); sm[SM_A128 + idx * 2] = (float)(m128 * cos(512.0 * step * aim)); sm[SM_A128 + idx * 2 + 1] = (float)(m128 * sin(512.0 * step * aim)); }
        for (int i = 0; i < 16; ++i) { const double br = a.in[I_SBRE][(size_t)l * 32768 + idx * 16 + i], bi = a.in[I_SBIM][(size_t)l * 32768 + idx * 16 + i];
            s5d[18 + 2 * i] = fre * br - fim * bi; s5d[18 + 2 * i + 1] = fre * bi + fim * br; } }
    { LAS float* T = (LAS float*)lds; const int tid = gtid & 511, G_ = gthreads >> 9, nn = tid & 63, kq = tid >> 6, nn2 = tid >> 3, kc = tid & 7;
      for (int tile = gtid >> 9; tile < DEPTH * 3200; tile += G_) { const int l = tile / 3200, r = tile % 3200;
          bf16_t* Wl = (bf16_t*)(ws + WS_W + (size_t)l * W_STRIDE);
          int nt, kt, dld; bf16_t* dst; const float* colp; int ld; float scale = 1.f; bool comp = false;
          if (r < 1344) { nt = r % 84; kt = r / 84; dst = Wl; dld = D; const int n = nt * 64 + nn, sc = win_src_col(n), pn_ = n >> 8; ld = 5136; comp = sc < 0;
              colp = a.in[I_WIN] + (size_t)l * D * 5136 + (comp ? 1024 : sc);
              scale = (pn_ == 5 || pn_ == 6 || pn_ == 11 || pn_ == 12 || pn_ == 15 || pn_ == 16 || pn_ == 19 || pn_ == 20) ? -1.4426950408889634f : ((pn_ == 0 || pn_ == 8) ? 0.125f : 1.f); }
          else if (r < 2368) { const int q = r - 1344; nt = q & 63; kt = q >> 6; dst = Wl + (size_t)N_IN * D; dld = D; const int n = nt * 64 + nn; ld = D;
              colp = a.in[I_WMG] + (size_t)l * 4 * D * D + (size_t)(n >> 10) * D * D + (n & 1023); scale = -1.4426950408889634f; }
          else if (r < 2880) { const int q = r - 2368; nt = q & 63; kt = q >> 6; dst = (bf16_t*)((unsigned char*)Wl + WO_BR); dld = BW; const int n = nt * 64 + nn; ld = D;
              colp = a.in[I_WBR] + (size_t)l * 4 * BW * D + (size_t)(n >> 10) * BW * D + (n & 1023); }
          else if (r < 3136) { const int q = r - 2880; nt = q & 15; kt = q >> 4; dst = (bf16_t*)((unsigned char*)Wl + WO_OUT); dld = D; ld = D; colp = a.in[I_WOUT] + (size_t)l * D * D + nt * 64 + nn; }
          else { const int q = r - 3136; nt = q & 7; kt = q >> 3; dst = (bf16_t*)((unsigned char*)Wl + WO_GLU); dld = BW; ld = BW; colp = a.in[I_SGW] + (size_t)l * BW * BW + nt * 64 + nn; }
          if (!comp) {
#pragma unroll
              for (int j = 0; j < 8; ++j) { const int kk = kq + 8 * j; T[kk * 65 + nn] = colp[(size_t)(kt * 64 + kk) * ld] * scale; }
          } else { const float* wlr = a.in[I_GWLR] + (size_t)l * 16 * 256 + ((nt * 64 + nn) & 255);
#pragma unroll
              for (int j = 0; j < 8; ++j) { const int kk = kq + 8 * j; const float* wr_ = colp + (size_t)(kt * 64 + kk) * ld; float sacc = 0.f;
#pragma unroll
                  for (int rr = 0; rr < 16; ++rr) sacc += wr_[rr] * wlr[rr * 256];
                  T[kk * 65 + nn] = sacc; } }
          wg_syncthreads();
          { float v[8];
#pragma unroll
            for (int i = 0; i < 8; ++i) v[i] = T[(kc * 8 + i) * 65 + nn2];
            tr_store8(dst + (size_t)(nt * 64 + nn2) * dld + kt * 64 + kc * 8, v); }
          wg_syncthreads();
      } }
    for (int l = 0; l < DEPTH; ++l) {
        float* sm = (float*)(ws + WS_SMALL + (size_t)l * SMALL_STRIDE);
        for (int idx = gtid; idx < 512; idx += gthreads) { const float lam = a.in[I_LLAM][l * 512 + idx]; const float nl = -lam;
            sm[SM_SP8 + idx] = 8.0f * (fmaxf(nl, 0.f) + log1pf(expf(-fabsf(nl)))); }
        bf16_t* lw = (bf16_t*)((unsigned char*)sm + SM_LRUW_BYTES);
        for (int idx = gtid; idx < 8 * 128 * 64; idx += gthreads) { const int i = idx & 63, jj = (idx >> 6) & 127, n = idx >> 13;
            const float v = jj < 64 ? a.in[I_LWA][(((size_t)l * 8 + n) * 64 + i) * 64 + jj] : a.in[I_LWX][(((size_t)l * 8 + n) * 64 + i) * 64 + (jj - 64)];
            lw[idx] = f2bf(v * -1.4426950408889634f); }
    }
    float* rot = (float*)(ws + WS_ROT);
    for (int idx = gtid; idx < SEQ * 32; idx += gthreads) { const int i = idx & 31, s = idx >> 5;
        const double inv = pow(10000.0, -(double)i / 32.0), ang = (double)s * inv; rot[idx * 2] = (float)cos(ang); rot[idx * 2 + 1] = (float)sin(ang); }
}

__device__ __forceinline__ void phase_prologue2(const Args& a, int gtid, int gthreads) {
    unsigned char* ws = a.ws;
    for (int l = 0; l < DEPTH; ++l) {
        const double* s5d = (const double*)(ws + WS_S5D) + (size_t)l * 2048 * 50;
        const float* scre = a.in[I_SCRE] + (size_t)l * 32768; const float* scim = a.in[I_SCIM] + (size_t)l * 32768;
        for (int it = gtid; it < 32 * 4096; it += gthreads) { const int g = it >> 12, r = it & 4095, f = r >> 6, ln = r & 63, fr = ln & 15, fq = ln >> 4;
            const int mat = f >> 5, mt = (f & 31) >> 2, ks = f & 3;
            const int m = 16 * mt + fr, k0 = 32 * ks + 8 * fq; float v[8];
            if (mat == 0) { const int p = m >> 1, ri = m & 1, sq = k0 >> 4, c0 = k0 & 15; const double* sd = s5d + (size_t)(g * 64 + p) * 50; const double ar = sd[2 * (7 - sq)], ai = sd[2 * (7 - sq) + 1];
#pragma unroll
                for (int e = 0; e < 8; ++e) { const double br = sd[18 + 2 * (c0 + e)], bi = sd[18 + 2 * (c0 + e) + 1]; v[e] = (float)(ri ? ar * bi + ai * br : ar * br - ai * bi); } }
            else { const int t = m >> 4, i = m & 15;
#pragma unroll
                for (int e = 0; e < 8; ++e) { const int k = k0 + e, p = k >> 1, ri = k & 1; const double* sd = s5d + (size_t)(g * 64 + p) * 50; const double ar = sd[2 * (t + 1)], ai = sd[2 * (t + 1) + 1];
                    const double cr = scre[(g * 16 + i) * 64 + p], ci = scim[(g * 16 + i) * 64 + p]; v[e] = (float)(ri ? -(cr * ai + ci * ar) : cr * ar - ci * ai); } }
            tr_store8((bf16_t*)(ws + WS_S5M + (size_t)(l * 32 + g) * S5M_BYTES + (size_t)r * 16), v); }
    }
    float* kt = (float*)(ws + WS_S5K);
    for (int it = gtid; it < DEPTH * 32 * 2048; it += gthreads) { const int l = it >> 16, g = (it >> 11) & 31, j = (it >> 8) & 7, i = (it >> 4) & 15, c = it & 15; double ac = 0.0;
        const double* s5d = (const double*)(ws + WS_S5D) + (size_t)l * 2048 * 50;
        const float* scre = a.in[I_SCRE] + (size_t)l * 32768; const float* scim = a.in[I_SCIM] + (size_t)l * 32768;
#pragma unroll 8
        for (int p = 0; p < 64; ++p) { const double* sd = s5d + (size_t)(g * 64 + p) * 50; const double ar = sd[2 * j], ai = sd[2 * j + 1];
            const double cr = scre[(g * 16 + i) * 64 + p], ci = scim[(g * 16 + i) * 64 + p];
            ac += (cr * ar - ci * ai) * sd[18 + 2 * c] - (cr * ai + ci * ar) * sd[18 + 2 * c + 1]; }
        kt[it] = (float)ac; }
}
__device__ __forceinline__ void phase_prologue3(const Args& a, int gtid, int gthreads) {
    unsigned char* ws = a.ws;
    for (int it = gtid; it < DEPTH * 32 * 1280; it += gthreads) { const int lg = it / 1280, r = it % 1280, ff = r >> 6, ln = r & 63, fr = ln & 15, fq = ln >> 4;
        const int mt = ff < 1 ? 0 : ff < 2 ? 1 : ff < 4 ? 2 : ff < 6 ? 3 : ff < 9 ? 4 : ff < 12 ? 5 : ff < 16 ? 6 : 7;
        const int cb = mt < 1 ? 0 : mt < 2 ? 1 : mt < 3 ? 2 : mt < 4 ? 4 : mt < 5 ? 6 : mt < 6 ? 9 : mt < 7 ? 12 : 16, ks = ff - cb;
        const int m = 16 * mt + fr, k0 = 32 * ks + 8 * fq, t = m >> 4, i = m & 15, sq = k0 >> 4, c0 = k0 & 15; float v[8];
        const float* kt = (const float*)(ws + WS_S5K) + (size_t)lg * 2048 + ((sq <= t ? t - sq : 0) * 16 + i) * 16 + c0;
#pragma unroll
        for (int e = 0; e < 8; ++e) v[e] = sq <= t ? kt[e] : 0.f;
        tr_store8((bf16_t*)(ws + WS_S5M + (size_t)lg * S5M_BYTES + 65536 + (size_t)r * 16), v); }
}

template <bool F32OUT, bool ADD>
__device__ __forceinline__ void phase_norm(const float* hin, const bf16_t* delta, float* hout, const float* gain, bf16_t* uout, int gw, int ngw, int lane) {
    f32x4 gv[4];
#pragma unroll
    for (int j = 0; j < 4; ++j) gv[j] = *(const f32x4*)(gain + 4 * lane + 256 * j);
    for (int row = gw; row < TG; row += ngw) {
        const f32x4* xr = (const f32x4*)(hin + (size_t)row * D) + lane; f32x4 v[4]; float s = 0.f;
#pragma unroll
        for (int j = 0; j < 4; ++j) v[j] = __builtin_nontemporal_load(xr + 64 * j);
        if (ADD) { const u32x2* dr = (const u32x2*)(delta + (size_t)row * D) + lane;
#pragma unroll
            for (int j = 0; j < 4; ++j) { const u32x2 dw = __builtin_nontemporal_load(dr + 64 * j); v[j].x += bflo(dw.x); v[j].y += bfhi(dw.x); v[j].z += bflo(dw.y); v[j].w += bfhi(dw.y); } }
#pragma unroll
        for (int j = 0; j < 4; ++j) s += (v[j].x * v[j].x + v[j].y * v[j].y) + (v[j].z * v[j].z + v[j].w * v[j].w);
        const float rstd = rsqrtf(wave_sum(s) * (1.f / D) + NORM_EPS);
        if (F32OUT) { f32x4* o = (f32x4*)(hout + (size_t)row * D) + lane;
#pragma unroll
            for (int j = 0; j < 4; ++j) o[64 * j] = v[j] * rstd * gv[j];
        } else {
            if (ADD) { f32x4* o = (f32x4*)(hout + (size_t)row * D) + lane;
#pragma unroll
                for (int j = 0; j < 4; ++j) o[64 * j] = v[j]; }
            u32x2* o = (u32x2*)(uout + (size_t)row * D) + lane;
#pragma unroll
            for (int j = 0; j < 4; ++j) { const f32x4 y = v[j] * rstd * gv[j]; u32x2 w; w.x = cvt_pk_bf16(y.x, y.y); w.y = cvt_pk_bf16(y.z, y.w); o[64 * j] = w; } }
    }
}

constexpr int NSEGG = 8;
constexpr int NSEGL = 32;
constexpr int NSEGS = 8;
constexpr size_t ST_GSEG = 0;
constexpr size_t ST_GDS = ST_GSEG + (size_t)2 * BG * 4 * NSEGG * 8192;
constexpr size_t ST_LRU = ST_GDS + (size_t)2 * BG * 4 * NSEGG * 64;
constexpr size_t ST_S5 = ST_LRU + (size_t)BG * NSEGL * 512 * 2;
constexpr size_t ST_END_F = ST_S5 + (size_t)BG * NSEGS * 32 * 128;
static_assert(ST_END_F * 4 <= 64 * MiB, "state scratch");
typedef short s16x4 __attribute__((ext_vector_type(4)));

__device__ __forceinline__ bf16x8 lds_tr_frag(LAS const unsigned char* base, int row_stride_bytes, int lane) {
    const int g = lane >> 4, idx = lane & 15, q = idx >> 2, p = idx & 3;
    LAS const unsigned char* a0 = base + (8 * g + q) * row_stride_bytes + 8 * p;
    const s16x4 r0 = __builtin_amdgcn_ds_read_tr16_b64_v4i16((LAS s16x4*)a0);
    const s16x4 r1 = __builtin_amdgcn_ds_read_tr16_b64_v4i16((LAS s16x4*)(a0 + 4 * row_stride_bytes));
    bf16x8 f; f[0] = r0[0]; f[1] = r0[1]; f[2] = r0[2]; f[3] = r0[3]; f[4] = r1[0]; f[5] = r1[1]; f[6] = r1[2]; f[7] = r1[3]; return f;
}
#define WGSYNC() do { asm volatile("s_waitcnt lgkmcnt(0)" ::: "memory"); __builtin_amdgcn_s_barrier(); asm volatile("" ::: "memory"); } while (0)

constexpr int GL_QD = 0, GL_KD = 9216, GL_KT = 18432, GL_V = 27648, GL_ST = 45056, GL_LAST = 63488, GL_RED = 63744, GL_RED2 = 64256;
struct GlaP { const bf16_t* P; const float* LA; const float* gain; const float* bias; bf16_t* O; float* SSEG; float* DSUM; };
__device__ __forceinline__ bf16x8 lds_tr_frag2(LAS const unsigned char* base, int row_stride_bytes, int lane, int mulg, int second_off) {
    const int g = lane >> 4, idx = lane & 15, q = idx >> 2, p = idx & 3;
    LAS const unsigned char* a0 = base + (mulg * g + q) * row_stride_bytes + 8 * p;
    const s16x4 r0 = __builtin_amdgcn_ds_read_tr16_b64_v4i16((LAS s16x4*)a0);
    const s16x4 r1 = __builtin_amdgcn_ds_read_tr16_b64_v4i16((LAS s16x4*)(a0 + second_off * row_stride_bytes));
    bf16x8 f; f[0] = r0[0]; f[1] = r0[1]; f[2] = r0[2]; f[3] = r0[3]; f[4] = r1[0]; f[5] = r1[1]; f[6] = r1[2]; f[7] = r1[3]; return f;
}
__device__ __forceinline__ bf16x8 pack8(const f32x4 a, const f32x4 b) { u32x4 w; w.x = cvt_pk_bf16(a[0], a[1]); w.y = cvt_pk_bf16(a[2], a[3]); w.z = cvt_pk_bf16(b[0], b[1]); w.w = cvt_pk_bf16(b[2], b[3]); return __builtin_bit_cast(bf16x8, w); }

__device__ __forceinline__ bf16x8 lds_tr_frag3(LAS const unsigned char* base, int row_stride_bytes, int lane, int pstride_bytes) {
    const int g = lane >> 4, idx = lane & 15, q = idx >> 2, p = idx & 3;
    LAS const unsigned char* a0 = base + (4 * g + q) * row_stride_bytes + pstride_bytes * p;
    const s16x4 r0 = __builtin_amdgcn_ds_read_tr16_b64_v4i16((LAS s16x4*)a0);
    const s16x4 r1 = __builtin_amdgcn_ds_read_tr16_b64_v4i16((LAS s16x4*)(a0 + 16 * row_stride_bytes));
    bf16x8 f; f[0] = r0[0]; f[1] = r0[1]; f[2] = r0[2]; f[3] = r0[3]; f[4] = r1[0]; f[5] = r1[1]; f[6] = r1[2]; f[7] = r1[3]; return f;
}
template <bool PASSC>
__device__ __forceinline__ void glaret_item(LAS unsigned char* lds, const GlaP& gp, const bool gla, const int b, const int h, const int seg, const int sidx  ) {
    int tid = threadIdx.x; asm volatile("" : "+v"(tid));
    const int w = __builtin_amdgcn_readfirstlane(tid >> 6), l = tid & 63, fr = l & 15, fq = l >> 4;
    const int qoff = gla ? P_GQ : P_RQ, koff = gla ? P_GK : P_RK, voff = gla ? P_GV : P_RV, goff = gla ? P_GG : P_RG, ooff = gla ? 0 : 512;
    const float lg = __logf(1.f - exp2f(-5.f - (float)h));
    f32x4 accs[4];
#pragma unroll
    for (int dt = 0; dt < 4; ++dt) accs[dt] = (f32x4){0.f, 0.f, 0.f, 0.f};
    const int arow = 8 * w + (l >> 3), apart = l & 7;
    float dsum[8];
#pragma unroll
    for (int e = 0; e < 8; ++e) dsum[e] = 0.f;
    if (PASSC) {
        for (int sp = 0; sp < seg; ++sp) {
            const float* sg = gp.SSEG + (size_t)(sidx + sp) * 8192 + tid * 16; const float* dsm = gp.DSUM + (size_t)(sidx + sp) * 64;
#pragma unroll
            for (int dt = 0; dt < 4; ++dt) { const f32x4 dv = *(const f32x4*)(dsm + 16 * dt + 4 * fq), sv = *(const f32x4*)(sg + 4 * dt);
#pragma unroll
                for (int r = 0; r < 4; ++r) accs[dt][r] = accs[dt][r] * __expf(dv[r]) + sv[r]; }
        }
#pragma unroll
        for (int dt = 0; dt < 4; ++dt) { u32x2 wv; wv.x = cvt_pk_bf16(accs[dt][0], accs[dt][1]); wv.y = cvt_pk_bf16(accs[dt][2], accs[dt][3]);
            *(LAS u32x2*)(lds + GL_ST + (16 * w + fr) * 144 + 32 * dt + 8 * fq) = wv; }
    }
    const int it = w & 3, ch = w >> 2;
    f32x4 gnv[4], bsv[4];
#pragma unroll
    for (int ct = 0; ct < 4; ++ct) { const int c = 128 * h + 64 * ch + 16 * fq + 4 * ct; gnv[ct] = PASSC ? *(const f32x4*)(gp.gain + c) : (f32x4){0.f, 0.f, 0.f, 0.f};
        bsv[ct] = (PASSC && !gla) ? *(const f32x4*)(gp.bias + c) : (f32x4){0.f, 0.f, 0.f, 0.f}; }
    u32x4 rq = (u32x4){0u, 0u, 0u, 0u}, rk, rv[2]; f32x4 rla[2], rll[2]; u32x4 gnx[2];
    const float rq_s = __expf((float)(arow + 1) * lg), rk_s = __expf(-(float)(arow + 1) * lg), rt_s = __expf((float)(63 - arow) * lg);
#define GL_ISSUE(n_) do { const size_t r0_ = (size_t)b * SEQ + seg * 512 + (n_) * 64; \
        { const size_t ro_ = (r0_ + arow) * 64 + 8 * apart; if (PASSC) rq = *(const u32x4*)(gp.P + (size_t)(qoff + 64 * h) * TG + ro_); rk = *(const u32x4*)(gp.P + (size_t)(koff + 64 * h) * TG + ro_); \
          if (gla) { const float* lp_ = gp.LA + (size_t)h * TG * 64 + ro_; rla[0] = *(const f32x4*)lp_; rla[1] = *(const f32x4*)(lp_ + 4); const float* ll_ = gp.LA + ((size_t)h * TG + r0_ + 63) * 64 + 8 * apart; rll[0] = *(const f32x4*)ll_; rll[1] = *(const f32x4*)(ll_ + 4); } \
          else { rla[0] = (f32x4){0.f, 0.f, 0.f, 0.f}; rla[1] = rla[0]; rll[0] = rla[0]; rll[1] = rla[0]; } } \
        _Pragma("unroll") for (int e_ = 0; e_ < 2; ++e_) { const int p_ = tid + 512 * e_, i_ = p_ >> 4, part_ = p_ & 15; \
            rv[e_] = *(const u32x4*)(gp.P + (size_t)(voff + 128 * h) * TG + (r0_ + i_) * 128 + 8 * part_); } \
        if (PASSC) { _Pragma("unroll") for (int j_ = 0; j_ < 2; ++j_) gnx[j_] = *(const u32x4*)(gp.P + (size_t)(goff + 128 * h) * TG + (r0_ + 16 * it + fr) * 128 + 64 * ch + 16 * fq + 8 * j_); } } while (0)
    GL_ISSUE(0);
    for (int n = 0; n < 8; ++n) {
        const size_t row0 = (size_t)b * SEQ + seg * 512 + n * 64;
#pragma unroll
        for (int e = 0; e < 2; ++e) { const int p = tid + 512 * e, i = p >> 4, part = p & 15; *(LAS u32x4*)(lds + GL_V + i * 272 + part * 16) = rv[e]; }
        { float cum[8], lastv[8];
          const float kk[8] = {bflo(rk.x), bfhi(rk.x), bflo(rk.y), bfhi(rk.y), bflo(rk.z), bfhi(rk.z), bflo(rk.w), bfhi(rk.w)};
          float eq[8], ek[8], et[8];
          if (gla) {
#pragma unroll
              for (int e = 0; e < 8; ++e) { cum[e] = e < 4 ? rla[0][e] : rla[1][e - 4]; lastv[e] = e < 4 ? rll[0][e] : rll[1][e - 4];
                  eq[e] = __expf(cum[e]); ek[e] = __builtin_amdgcn_rcpf(eq[e]); et[e] = __expf(lastv[e]) * ek[e]; }
          } else {
#pragma unroll
              for (int e = 0; e < 8; ++e) { lastv[e] = 64.f * lg; eq[e] = rq_s; ek[e] = rk_s; et[e] = rt_s; } }
#pragma unroll
          for (int e = 0; e < 8; ++e) *(LAS bf16_t*)(lds + GL_KT + (8 * apart + e) * 144 + arow * 2) = f2bf(kk[e] * et[e]);
          if (PASSC) { const float qq[8] = {bflo(rq.x), bfhi(rq.x), bflo(rq.y), bfhi(rq.y), bflo(rq.z), bfhi(rq.z), bflo(rq.w), bfhi(rq.w)};
              u32x4 qw, kw;
              qw.x = cvt_pk_bf16(qq[0] * eq[0], qq[1] * eq[1]); qw.y = cvt_pk_bf16(qq[2] * eq[2], qq[3] * eq[3]); qw.z = cvt_pk_bf16(qq[4] * eq[4], qq[5] * eq[5]); qw.w = cvt_pk_bf16(qq[6] * eq[6], qq[7] * eq[7]);
              kw.x = cvt_pk_bf16(kk[0] * ek[0], kk[1] * ek[1]); kw.y = cvt_pk_bf16(kk[2] * ek[2], kk[3] * ek[3]); kw.z = cvt_pk_bf16(kk[4] * ek[4], kk[5] * ek[5]); kw.w = cvt_pk_bf16(kk[6] * ek[6], kk[7] * ek[7]);
              *(LAS u32x4*)(lds + GL_QD + arow * 144 + 16 * apart) = qw; *(LAS u32x4*)(lds + GL_KD + arow * 144 + 16 * apart) = kw; }
          if (arow == 63) {
#pragma unroll
              for (int e = 0; e < 8; ++e) *(LAS float*)(lds + GL_LAST + (8 * apart + e) * 4) = lastv[e]; }
#pragma unroll
          for (int e = 0; e < 8; ++e) dsum[e] += lastv[e]; }
        u32x4 gates[2];
        if (PASSC) { gates[0] = gnx[0]; gates[1] = gnx[1]; }
        if (n < 7) GL_ISSUE(n + 1);
        WGSYNC();
        f32x4 acco[4];
        if (PASSC) {
            bf16x8 qf[2];
#pragma unroll
            for (int ks = 0; ks < 2; ++ks) qf[ks] = *(LAS const bf16x8*)(lds + GL_QD + (16 * it + fr) * 144 + 16 * fq + 64 * ks);
            f32x4 sc[4];
#pragma unroll
            for (int jt = 0; jt < 4; ++jt) { sc[jt] = (f32x4){0.f, 0.f, 0.f, 0.f};
                if (jt <= it) {
#pragma unroll
                    for (int ks = 0; ks < 2; ++ks) { const bf16x8 kf = *(LAS const bf16x8*)(lds + GL_KD + (16 * jt + fr) * 144 + 16 * fq + 64 * ks);
                        sc[jt] = __builtin_amdgcn_mfma_f32_16x16x32_bf16(kf, qf[ks], sc[jt], 0, 0, 0); }
                    if (jt == it) {
#pragma unroll
                        for (int r = 0; r < 4; ++r) sc[jt][r] = (4 * fq + r <= fr) ? sc[jt][r] : 0.f; } } }
            const bf16x8 pf0 = pack8(sc[0], sc[1]), pf1 = pack8(sc[2], sc[3]);
#pragma unroll
            for (int ct = 0; ct < 4; ++ct) { const int c0 = 64 * ch + 4 * ct; acco[ct] = (f32x4){0.f, 0.f, 0.f, 0.f};
                { const bf16x8 vf = lds_tr_frag3(lds + GL_V + c0 * 2, 272, l, 32); acco[ct] = __builtin_amdgcn_mfma_f32_16x16x32_bf16(vf, pf0, acco[ct], 0, 0, 0); }
                if (it >= 2) { const bf16x8 vf = lds_tr_frag3(lds + GL_V + 32 * 272 + c0 * 2, 272, l, 32); acco[ct] = __builtin_amdgcn_mfma_f32_16x16x32_bf16(vf, pf1, acco[ct], 0, 0, 0); }
#pragma unroll
                for (int ks = 0; ks < 2; ++ks) { const bf16x8 sf = *(LAS const bf16x8*)(lds + GL_ST + (c0 + 16 * (fr >> 2) + (fr & 3)) * 144 + 16 * fq + 64 * ks);
                    acco[ct] = __builtin_amdgcn_mfma_f32_16x16x32_bf16(sf, qf[ks], acco[ct], 0, 0, 0); } }
        }
#pragma unroll
        for (int dt = 0; dt < 4; ++dt) { const f32x4 lv = *(LAS const f32x4*)(lds + GL_LAST + (16 * dt + 4 * fq) * 4);
#pragma unroll
            for (int r = 0; r < 4; ++r) accs[dt][r] *= __expf(lv[r]); }
#pragma unroll
        for (int ks = 0; ks < 2; ++ks) { const bf16x8 vf = lds_tr_frag2(lds + GL_V + (32 * ks) * 272 + (16 * w) * 2, 272, l, 8, 4);
#pragma unroll
            for (int dt = 0; dt < 4; ++dt) { const bf16x8 kf = *(LAS const bf16x8*)(lds + GL_KT + (16 * dt + fr) * 144 + 16 * fq + 64 * ks);
                accs[dt] = __builtin_amdgcn_mfma_f32_16x16x32_bf16(kf, vf, accs[dt], 0, 0, 0); } }
        if (PASSC) {
            float ss = 0.f, sm_ = 0.f;
#pragma unroll
            for (int ct = 0; ct < 4; ++ct)
#pragma unroll
                for (int r = 0; r < 4; ++r) { ss += acco[ct][r] * acco[ct][r]; sm_ += acco[ct][r]; }
            ss += shfl_xor_f(ss, 16); ss += shfl_xor_f(ss, 32); sm_ += shfl_xor_f(sm_, 16); sm_ += shfl_xor_f(sm_, 32);
            if (fq == 0) { *(LAS float*)(lds + GL_RED + ((16 * it + fr) * 2 + ch) * 4) = ss; *(LAS float*)(lds + GL_RED2 + ((16 * it + fr) * 2 + ch) * 4) = sm_; }
        }
        WGSYNC();
        if (PASSC) {
            const int i = 16 * it + fr;
            const float ssum = *(LAS const float*)(lds + GL_RED + (i * 2) * 4) + *(LAS const float*)(lds + GL_RED + (i * 2 + 1) * 4);
            const float msum = *(LAS const float*)(lds + GL_RED2 + (i * 2) * 4) + *(LAS const float*)(lds + GL_RED2 + (i * 2 + 1) * 4);
            float mean, rstd;
            if (gla) { mean = 0.f; rstd = rsqrtf(ssum * (1.f / 128.f) + NORM_EPS); }
            else { mean = msum * (1.f / 128.f); const float var = fmaxf(ssum * (1.f / 128.f) - mean * mean, 0.f); rstd = rsqrtf(var + NORM_EPS); }
            u32x4 ow[2];
#pragma unroll
            for (int ct = 0; ct < 4; ++ct) { const f32x4 gn = gnv[ct], bs = bsv[ct]; const unsigned gw0 = gates[ct >> 1][(ct & 1) * 2], gw1 = gates[ct >> 1][(ct & 1) * 2 + 1];
                const float g0 = bflo(gw0), g1 = bfhi(gw0), g2 = bflo(gw1), g3 = bfhi(gw1);
                ow[ct >> 1][(ct & 1) * 2] = cvt_pk_bf16(((acco[ct][0] - mean) * rstd * gn[0] + bs[0]) * g0, ((acco[ct][1] - mean) * rstd * gn[1] + bs[1]) * g1);
                ow[ct >> 1][(ct & 1) * 2 + 1] = cvt_pk_bf16(((acco[ct][2] - mean) * rstd * gn[2] + bs[2]) * g2, ((acco[ct][3] - mean) * rstd * gn[3] + bs[3]) * g3); }
#pragma unroll
            for (int j = 0; j < 2; ++j) *(u32x4*)(gp.O + (row0 + i) * OLD + ooff + 128 * h + 64 * ch + 16 * fq + 8 * j) = ow[j];
#pragma unroll
            for (int dt = 0; dt < 4; ++dt) { u32x2 wv; wv.x = cvt_pk_bf16(accs[dt][0], accs[dt][1]); wv.y = cvt_pk_bf16(accs[dt][2], accs[dt][3]);
                *(LAS u32x2*)(lds + GL_ST + (16 * w + fr) * 144 + 32 * dt + 8 * fq) = wv; }
        }
    }
#undef GL_ISSUE
    if (!PASSC) {
        float* sg = gp.SSEG + (size_t)(sidx + seg) * 8192 + tid * 16;
#pragma unroll
        for (int dt = 0; dt < 4; ++dt) *(f32x4*)(sg + 4 * dt) = accs[dt];
        if (tid < 8) {
#pragma unroll
            for (int e = 0; e < 8; ++e) gp.DSUM[(size_t)(sidx + seg) * 64 + 8 * apart + e] = dsum[e]; }
    }
    WGSYNC();
}

constexpr int LR_XC = 0, LR_XCF = 2304, LR_AA = 6400, LR_GG = 10496, LR_WAVE = 14592;
struct LruP { const bf16_t* P; const float* cw; const float* cb; const float* ba; const float* bx; const float* sp8; const bf16_t* lw; bf16_t* O; float* LST; };
template <bool PASSC>
__device__ __forceinline__ void lru_wave(LAS unsigned char* lw_, const LruP& lp, const int b, const int seg, const int n, const int l_) {
    int l = l_; asm volatile("" : "+v"(l));
    const float NL2E = -1.4426950408889634f;
    const int fr = l & 15, fq = l >> 4, ch = 64 * n + l;
    bf16x8 wB[8][2];
#pragma unroll
    for (int jt = 0; jt < 8; ++jt)
#pragma unroll
        for (int ks = 0; ks < 2; ++ks) wB[jt][ks] = *(const bf16x8*)(lp.lw + ((size_t)(n * 128 + 16 * jt + fr)) * 64 + 8 * fq + 32 * ks);
    const float w0 = lp.cw[ch], w1 = lp.cw[512 + ch], w2 = lp.cw[1024 + ch], w3 = lp.cw[1536 + ch], cbv = lp.cb[ch];
    float bav[4], bxv[4], spv[4];
#pragma unroll
    for (int jt = 0; jt < 4; ++jt) { const int c2 = 64 * n + 16 * jt + fr; bav[jt] = lp.ba[c2] * NL2E; bxv[jt] = lp.bx[c2] * NL2E; spv[jt] = lp.sp8[c2] * NL2E; }
    const size_t rowb = (size_t)b * SEQ + seg * 128;
    const bf16_t* px = lp.P + (size_t)(P_LX + 64 * n) * TG + rowb * 64;
    const bf16_t* pg = lp.P + (size_t)(P_LG + 64 * n) * TG + rowb * 64;
    bf16_t* po = lp.O + rowb * OLD + 1024 + 64 * n;
    float xm3 = 0.f, xm2 = 0.f, xm1 = 0.f;
    if (seg > 0) { xm3 = bf2f(px[l - 3 * 64]); xm2 = bf2f(px[l - 2 * 64]); xm1 = bf2f(px[l - 64]); }
    float hst = 0.f, ap = 1.f;
    if (PASSC) { const float* st = lp.LST + ((size_t)b * NSEGL * 512 + ch) * 2;
        pg8::f32x2_ ah[31];
#pragma unroll
        for (int e = 0; e < 31; ++e) { const int sp = e < seg ? e : 0; ah[e] = *(const pg8::f32x2_*)(st + (size_t)sp * 1024); }
#pragma unroll
        for (int e = 0; e < 31; ++e) if (e < seg) hst = ah[e][0] * hst + ah[e][1]; }
#define LR_ROWLD(dst, base, t) do { dst = (base)[(t) * 64 + l]; } while (0)
    bf16_t xn[16], gn[16];
#pragma unroll
    for (int t = 0; t < 16; ++t) LR_ROWLD(xn[t], px, t);
    for (int sb = 0; sb < 8; ++sb) {
        float xc[16];
        if (PASSC) {
#pragma unroll
            for (int t = 0; t < 16; ++t) LR_ROWLD(gn[t], pg, sb * 16 + t); }
#pragma unroll
        for (int t = 0; t < 16; ++t) { const float x0 = bf2f(xn[t]); xc[t] = cbv + w0 * xm3 + w1 * xm2 + w2 * xm1 + w3 * x0; xm3 = xm2; xm2 = xm1; xm1 = x0;
            *(LAS bf16_t*)(lw_ + LR_XC + t * 144 + l * 2) = f2bf(xc[t]); }
        if (sb < 7) {
#pragma unroll
            for (int t = 0; t < 16; ++t) LR_ROWLD(xn[t], px, (sb + 1) * 16 + t); }
        __builtin_amdgcn_wave_barrier();
        f32x4 acc[8];
#pragma unroll
        for (int jt = 0; jt < 8; ++jt) { const float bz = jt < 4 ? bav[jt] : bxv[jt - 4]; acc[jt] = (f32x4){bz, bz, bz, bz}; }
#pragma unroll
        for (int ks = 0; ks < 2; ++ks) { const bf16x8 af = *(LAS const bf16x8*)(lw_ + LR_XC + fr * 144 + 16 * fq + 64 * ks);
#pragma unroll
            for (int jt = 0; jt < 8; ++jt) acc[jt] = __builtin_amdgcn_mfma_f32_16x16x32_bf16(af, wB[jt][ks], acc[jt], 0, 0, 0); }
#pragma unroll
        for (int jt = 0; jt < 4; ++jt)
#pragma unroll
            for (int r = 0; r < 4; ++r) { const int tok = 4 * fq + r, j = 16 * jt + fr;
                const float rg = __builtin_amdgcn_rcpf(1.f + __builtin_amdgcn_exp2f(acc[jt][r])), ig = __builtin_amdgcn_rcpf(1.f + __builtin_amdgcn_exp2f(acc[4 + jt][r]));
                const float av = __builtin_amdgcn_exp2f(rg * spv[jt]);
                *(LAS float*)(lw_ + LR_AA + tok * 256 + j * 4) = av; const float em = fmaf(-av, av, 1.f);
                *(LAS float*)(lw_ + LR_GG + tok * 256 + j * 4) = ig * __builtin_amdgcn_sqrtf(em); }
        __builtin_amdgcn_wave_barrier();
#pragma unroll
        for (int t = 0; t < 16; ++t) { const float av = *(LAS const float*)(lw_ + LR_AA + t * 256 + l * 4), gv = *(LAS const float*)(lw_ + LR_GG + t * 256 + l * 4);
            hst = av * hst + gv * xc[t]; ap *= av;
            if (PASSC) { bf16_t* p_ = po + (size_t)(sb * 16 + t) * OLD; asm volatile("" : "+s"(p_)); p_[l] = f2bf(hst * bf2f(gn[t])); } }
        __builtin_amdgcn_wave_barrier();
    }
#undef LR_ROWLD
    if (!PASSC) { float* st = lp.LST + (((size_t)b * NSEGL + seg) * 512 + ch) * 2; st[0] = ap; st[1] = hst; }
}

constexpr int S5_MG = 0, S5_MC = 32768, S5_MM = 65536, S5_MEND = 86016, S5W_STRIDE = 8448;
struct S5P { const bf16_t* P; const bf16_t* SU; const float* sm; const unsigned char* s5m; const float* a128; const float* dd; bf16_t* Y5; float* SST; };
__device__ __forceinline__ float gelu_t(float x) { const float t = x * __builtin_fmaf(x * x, -0.10294324f, -2.3022082f);
    return x * __builtin_amdgcn_rcpf(1.f + __builtin_amdgcn_exp2f(t)); }
template <bool PASSC>
__device__ __forceinline__ void s5_wave(LAS unsigned char* lds, LAS unsigned char* lw_, const S5P& sp_, const int b, const int seg, const int g, const int l_) {
    int l = l_; asm volatile("" : "+v"(l));
    const int fr = l & 15, fq = l >> 4;
    const float a8r = sp_.sm[SM_A8 + (g * 64 + l) * 2], a8i = sp_.sm[SM_A8 + (g * 64 + l) * 2 + 1];
    float xr = 0.f, xi = 0.f;
    f32x4 dv4 = (f32x4){0.f, 0.f, 0.f, 0.f};
    if (PASSC) {
        const float ar = sp_.a128[(g * 64 + l) * 2], ai = sp_.a128[(g * 64 + l) * 2 + 1];
        const float* st = sp_.SST + ((size_t)b * NSEGS * 32 + g) * 128 + l;
        for (int sp0 = 0; sp0 < seg; sp0 += 8) { float er[8], ei[8];
#pragma unroll
            for (int e = 0; e < 8; ++e) { const int sp = sp0 + e < seg ? sp0 + e : seg - 1; er[e] = st[(size_t)sp * 4096]; ei[e] = st[(size_t)sp * 4096 + 64]; }
#pragma unroll
            for (int e = 0; e < 8; ++e) if (sp0 + e < seg) { const float nr = ar * xr - ai * xi + er[e], ni = ar * xi + ai * xr + ei[e]; xr = nr; xi = ni; } }
        dv4 = *(const f32x4*)(sp_.dd + 16 * g + 4 * fq);
    }
    const size_t rowb = (size_t)b * SEQ + seg * 512;
    bf16x8 ufn[4];
#pragma unroll
    for (int ks = 0; ks < 4; ++ks) ufn[ks] = *(const bf16x8*)(sp_.SU + ((size_t)g * TG + rowb + 8 * fr + 2 * ks + (fq >> 1)) * 16 + 8 * (fq & 1));
    for (int sup = 0; sup < 4; ++sup) {
        const size_t r0 = rowb + sup * 128;
        bf16x8 uf[4];
#pragma unroll
        for (int ks = 0; ks < 4; ++ks) uf[ks] = ufn[ks];
        if (sup < 3) {
#pragma unroll
            for (int ks = 0; ks < 4; ++ks) ufn[ks] = *(const bf16x8*)(sp_.SU + ((size_t)g * TG + r0 + 128 + 8 * fr + 2 * ks + (fq >> 1)) * 16 + 8 * (fq & 1)); }
        u32x2 us[8];
        if (PASSC) {
#pragma unroll
            for (int mt = 0; mt < 8; ++mt) us[mt] = *(const u32x2*)(sp_.SU + ((size_t)g * TG + r0 + 8 * fr + mt) * 16 + 4 * fq); }
#pragma unroll
        for (int mt = 0; mt < 8; ++mt) { f32x4 ga = (f32x4){0.f, 0.f, 0.f, 0.f};
#pragma unroll
            for (int ks = 0; ks < 4; ++ks) ga = __builtin_amdgcn_mfma_f32_16x16x32_bf16(*(LAS const bf16x8*)(lds + S5_MG + ((mt * 4 + ks) * 64 + l) * 16), uf[ks], ga, 0, 0, 0);
            *(LAS f32x4*)(lw_ + fr * 528 + (16 * mt + 4 * fq) * 4) = ga; }
        __builtin_amdgcn_wave_barrier();
        pg8::f32x2_ gv[16];
#pragma unroll
        for (int t = 0; t < 16; ++t) gv[t] = *(LAS const pg8::f32x2_*)(lw_ + t * 528 + l * 8);
        __builtin_amdgcn_wave_barrier();
#pragma unroll
        for (int t = 0; t < 16; ++t) {
            if (PASSC) *(LAS unsigned*)(lw_ + t * 528 + l * 4) = cvt_pk_bf16(xr, xi);
            const float nr = __builtin_fmaf(a8r, xr, __builtin_fmaf(-a8i, xi, gv[t][0])), ni = __builtin_fmaf(a8r, xi, __builtin_fmaf(a8i, xr, gv[t][1])); xr = nr; xi = ni; }
        if (PASSC) {
            __builtin_amdgcn_wave_barrier();
            bf16x8 xf[4];
#pragma unroll
            for (int ks = 0; ks < 4; ++ks) xf[ks] = *(LAS const bf16x8*)(lw_ + fr * 528 + (32 * ks + 8 * fq) * 2);
#pragma unroll
            for (int mt = 0; mt < 8; ++mt) { f32x4 ya = (f32x4){0.f, 0.f, 0.f, 0.f}; const int cb = mt < 1 ? 0 : mt < 2 ? 1 : mt < 3 ? 2 : mt < 4 ? 4 : mt < 5 ? 6 : mt < 6 ? 9 : mt < 7 ? 12 : 16;
#pragma unroll
                for (int ks = 0; ks < 4; ++ks) if (2 * ks <= mt) ya = __builtin_amdgcn_mfma_f32_16x16x32_bf16(*(LAS const bf16x8*)(lds + S5_MM + ((cb + ks) * 64 + l) * 16), uf[ks], ya, 0, 0, 0);
#pragma unroll
                for (int ks = 0; ks < 4; ++ks) ya = __builtin_amdgcn_mfma_f32_16x16x32_bf16(*(LAS const bf16x8*)(lds + S5_MC + ((mt * 4 + ks) * 64 + l) * 16), xf[ks], ya, 0, 0, 0);
                u32x2 yw; yw.x = cvt_pk_bf16(gelu_t(ya[0] + dv4[0] * bflo(us[mt].x)), gelu_t(ya[1] + dv4[1] * bfhi(us[mt].x))); yw.y = cvt_pk_bf16(gelu_t(ya[2] + dv4[2] * bflo(us[mt].y)), gelu_t(ya[3] + dv4[3] * bfhi(us[mt].y)));
                *(u32x2*)(sp_.Y5 + (r0 + 8 * fr + mt) * BW + 16 * g + 4 * fq) = yw; }
        }
        __builtin_amdgcn_wave_barrier();
    }
    if (!PASSC) { float* st = sp_.SST + (((size_t)b * NSEGS + seg) * 32 + g) * 128 + l; st[0] = xr; st[64] = xi; }
}

template <bool PASSC>
__device__ __forceinline__ void phase_mixers(LAS unsigned char* lds, const Args& a, const int l, const int G) {
    const int mmask = a.mmask;
    unsigned char* ws = a.ws; const float* sm = (const float*)(ws + WS_SMALL + (size_t)l * SMALL_STRIDE);
    const bf16_t* P = (const bf16_t*)(ws + WS_P); float* ST = (float*)(ws + WS_ST);
    if (mmask & 1) { GlaP gp0{P, (const float*)(ws + WS_LA), a.in[I_GNG] + l * 512, nullptr, (bf16_t*)(ws + WS_O), ST + ST_GSEG, ST + ST_GDS};
      GlaP gp1{P, (const float*)(ws + WS_LA), a.in[I_RNG] + l * 512, a.in[I_RNB] + l * 512, (bf16_t*)(ws + WS_O), ST + ST_GSEG, ST + ST_GDS};
      for (int itx = blockIdx.x; itx < 2 * BG * 4 * NSEGG; itx += G) { const int mix = itx / (BG * 4 * NSEGG), rest = itx % (BG * 4 * NSEGG), b = rest / (4 * NSEGG), h = (rest / NSEGG) & 3, seg = rest % NSEGG;
          const int sidx = ((mix * BG + b) * 4 + h) * NSEGG;
          if (!PASSC && seg == NSEGG - 1) continue;
          if (mix == 0) glaret_item<PASSC>(lds, gp0, true, b, h, seg, sidx); else glaret_item<PASSC>(lds, gp1, false, b, h, seg, sidx); } }
    int tid = threadIdx.x; asm volatile("" : "+v"(tid));
    const int w = __builtin_amdgcn_readfirstlane(tid >> 6), ln = tid & 63;
    if (mmask & 2) { LruP lp{P, a.in[I_LCW] + l * 2048, a.in[I_LCB] + l * 512, a.in[I_LBA] + l * 512, a.in[I_LBX] + l * 512, sm + SM_SP8, (const bf16_t*)((const unsigned char*)sm + SM_LRUW_BYTES), (bf16_t*)(ws + WS_O), ST + ST_LRU};
      for (int itx = blockIdx.x; itx < BG * NSEGL; itx += G) { if (!PASSC && itx % NSEGL == NSEGL - 1) continue; lru_wave<PASSC>(lds + w * LR_WAVE, lp, itx / NSEGL, itx % NSEGL, w, ln); } }
    if (mmask & 4) { S5P sp_{P, (const bf16_t*)(ws + WS_SU2), sm, ws + WS_S5M + (size_t)l * 32 * S5M_BYTES, sm + SM_A128, a.in[I_SD] + l * 512, (bf16_t*)(ws + WS_Y5), ST + ST_S5};
      for (int itx = blockIdx.x; itx < 32 * 8; itx += G) { const int g = itx & 31, q = (itx >> 5) * 8 + w;
          WGSYNC();
          { const unsigned char* src = sp_.s5m + (size_t)g * S5M_BYTES; const int nb = PASSC ? S5_MEND : S5_MC;
            for (int o = tid * 16; o < nb; o += 8192) *(LAS u32x4*)(lds + o) = *(const u32x4*)(src + o); }
          WGSYNC();
          if (PASSC || (q & 7) != NSEGS - 1) s5_wave<PASSC>(lds, lds + S5_MEND + w * S5W_STRIDE, sp_, q >> 3, q & 7, g, ln); } }
    WGSYNC();
}

constexpr int NPH = 8, NSTEPS = 1 + NGRP * DEPTH * NPH;
constexpr int LDS_BYTES = 163840, LDS_MISC = 163840 - 512;
static_assert(S5_MEND + 8 * S5W_STRIDE <= LDS_MISC, "S5 LDS");

__global__ void __launch_bounds__(512, 2) mk_fwd(Args a) {
    __shared__ __attribute__((aligned(16))) unsigned char lds_raw[LDS_BYTES];
    LAS unsigned char* lds = (LAS unsigned char*)lds_raw;
    volatile LAS unsigned* MISC = (volatile LAS unsigned*)(lds + LDS_MISC);
    const int G = gridDim.x;
    if (threadIdx.x < 32) MISC[threadIdx.x] = 0u;
    wg_syncthreads();
    unsigned* ctl = (unsigned*)(a.ws + WS_CTL);
    XcdBarrier bar = xcd_barrier_post(ctl + CW_BAR + a.li * XCD_BAR_WORDS, MISC + 8);
    const int ngw = G * 8, gthreads = G * 512;
#define LTID(v) int v = threadIdx.x; asm volatile("" : "+v"(v))
#define IN(s) (a.s_lo <= (s) && (s) < a.s_hi)
#define SEAM(s) do { if ((s) + 1 < a.s_hi) xcd_barrier(bar); } while (0)
    if (IN(0)) { LTID(t_); phase_prologue(lds, a, blockIdx.x * 512 + t_, gthreads); xcd_barrier(bar); phase_prologue2(a, blockIdx.x * 512 + t_, gthreads); xcd_barrier(bar); phase_prologue3(a, blockIdx.x * 512 + t_, gthreads); SEAM(0); }
    for (int gl = 0; gl < NGRP * DEPTH; ++gl) {
        const int grp = gl >> 2, l = gl & 3, s0 = 1 + gl * NPH;
        if (a.s_hi <= s0 || a.s_lo >= s0 + NPH) continue;
        unsigned char* ws = a.ws;
        const bf16_t* Wl = (const bf16_t*)(ws + WS_W + (size_t)l * W_STRIDE);
        const float* sm = (const float*)(ws + WS_SMALL + (size_t)l * SMALL_STRIDE);
        bf16_t* U = (bf16_t*)(ws + WS_U); bf16_t* P = (bf16_t*)(ws + WS_P); float* LA = (float*)(ws + WS_LA);
        bf16_t* O = (bf16_t*)(ws + WS_O); bf16_t* Y5 = (bf16_t*)(ws + WS_Y5); unsigned char* PGb = ws + WS_PG;
        const float* xg = a.in[I_X] + (size_t)grp * TG * D; float* og = a.out + (size_t)grp * TG * D;
        const float* hin = (l <= 1) ? xg : og;
        bf16_t* DLT = (bf16_t*)(ws + WS_O);
        (void)sm;
        if (IN(s0 + 0)) { LTID(t_); const int gw_ = blockIdx.x * 8 + __builtin_amdgcn_readfirstlane(t_ >> 6);
            if (l == 0) phase_norm<false, false>(hin, DLT, og, a.in[I_NG] + l * D, U, gw_, ngw, t_ & 63); else phase_norm<false, true>(hin, DLT, og, a.in[I_NG] + l * D, U, gw_, ngw, t_ & 63);
            SEAM(s0 + 0); }
        if (IN(s0 + 1)) {
            pg8::Gemm g{U, Wl, TG, N_ALL, D, D, D, 0, 0}; pg8::StaticOrder S; S.init(TG, N_ALL, G, (int)blockIdx.x, 0, 256, WGM_G1);
            EpiIn E{P, LA, a.in[I_GBLR] + l * 256, (const float*)(ws + WS_ROT), PGb, (bf16_t*)(ws + WS_SU2)};
            GEMM_CALL(EpiIn);
            SEAM(s0 + 1);
        }
        if (IN(s0 + 2)) { phase_mixers<false>(lds, a, l, G); SEAM(s0 + 2); }
        if (IN(s0 + 3)) { phase_mixers<true>(lds, a, l, G); SEAM(s0 + 3); }
        if (IN(s0 + 4)) {
            { pg8::Gemm g{Y5, (const bf16_t*)((const unsigned char*)Wl + WO_GLU), TG, BW, BW, BW, BW, 0, 0}; pg8::StaticOrder S; S.init(TG, BW, G, (int)blockIdx.x, 0, 256, WGM_GLU);
              EpiGlu E{Y5, P, a.in[I_SGB] + l * BW, O};
              GEMM_CALL(EpiGlu); }
            SEAM(s0 + 4);
        }
        if (IN(s0 + 6)) {
            { pg8::Gemm g{O, (const bf16_t*)((const unsigned char*)Wl + WO_BR), TG, D, BW, OLD, BW, (size_t)BW * 2, (size_t)D * BW * 2}; pg8::StaticOrder S; S.init(TG, D, G, (int)blockIdx.x, 2, 128, WGM_G2);
              EpiBr E{PGb, U};
              pg8::gemm_phase<EpiBr, pg8::StaticOrder, true, true, true>(lds, g, S, E); }
            SEAM(s0 + 6);
        }
        if (IN(s0 + 7)) {
            if (a.fin != 2) { pg8::Gemm g{U, (const bf16_t*)((const unsigned char*)Wl + WO_OUT), TG, D, D, D, D, 0, 0}; pg8::StaticOrder S; S.init(TG, D, G, (int)blockIdx.x, 0, 256, WGM_G3);
              EpiOut E{DLT};
              GEMM_CALL(EpiOut); }
            if (l == 3 && a.fin) { if (a.fin == 1) xcd_barrier(bar); LTID(t_); phase_norm<true, true>(og, DLT, og, a.in[I_FNG], U, blockIdx.x * 8 + __builtin_amdgcn_readfirstlane(t_ >> 6), ngw, t_ & 63); }
            SEAM(s0 + 7);
        }
    }
#undef IN
#undef SEAM
}

extern "C" void kernel_launch(void* const* d_in, const int* in_sizes, int n_in, void* d_out, int out_size, void* d_ws, size_t ws_size, hipStream_t stream) {
    static int grid = 0;
    if (grid == 0) {
        static const int exp_sizes[29] = {67108864, 4096, 21037056, 16384, 1024, 2048, 2048, 2048, 8192, 2048, 131072, 2048, 131072, 2048, 2048, 8192, 8192, 131072, 131072, 131072, 131072, 2048, 128, 1048576, 2048, 16777216, 8388608, 4194304, 1024};
        bool ok_sizes = (n_in == 29); if (ok_sizes) for (int i = 0; i < 29; ++i) if (in_sizes[i] != exp_sizes[i]) { fprintf(stderr, "kernel_launch: input %d has %d elements, expected %d\n", i, in_sizes[i], exp_sizes[i]); ok_sizes = false; }
        if (!ok_sizes || out_size != NB * SEQ * D || ws_size < WS_END) { fprintf(stderr, "kernel_launch: unexpected shapes (n_in %d out %d ws %zu)\n", n_in, out_size, ws_size); grid = -1; return; }
        int dev = 0, cus = 0, per_cu = 0;
        hipGetDevice(&dev); hipDeviceGetAttribute(&cus, hipDeviceAttributeMultiprocessorCount, dev);
        hipOccupancyMaxActiveBlocksPerMultiprocessor(&per_cu, (const void*)mk_fwd, 512, 0);
        (void)hipGetLastError();
        grid = cus > 0 ? cus : 256;
        if (per_cu < 1) fprintf(stderr, "kernel_launch: occupancy query says %d\n", per_cu);
    }
    if (grid < 0) return;
    hipMemsetAsync((char*)d_ws + WS_CTL, 0, CTL_BYTES, stream);
    Args a{};
    for (int i = 0; i < 29; ++i) a.in[i] = (const float*)d_in[i];
    a.out = (float*)d_out; a.ws = (unsigned char*)d_ws;
    unsigned char* ws = (unsigned char*)d_ws;
    int li = 0;
    auto run = [&](int lo, int hi, int fin = 1, int mm = 7) { a.s_lo = lo; a.s_hi = hi; a.li = li++; a.fin = fin; a.mmask = mm; a.pad2 = 0; hipLaunchKernelGGL(mk_fwd, dim3(grid), dim3(512), 0, stream, a); };
    run(0, NSTEPS);
}
#if defined(__HIP_DEVICE_COMPILE__)
#pragma clang attribute pop
#endif
```

```cpp
#include <hip/hip_runtime.h>
#ifndef WGM_G1
#define WGM_G1 4
#endif
#ifndef WGM_G2
#define WGM_G2 8
#endif
#ifndef WGM_G3
#define WGM_G3 8
#endif
#ifndef WGM_GLU
#define WGM_GLU 8
#endif
#include <cstdio>
#include <cstdint>
#if defined(__HIP_DEVICE_COMPILE__)
#pragma clang attribute push(__attribute__((target("no-packed-fp32-ops"))), apply_to = function)
#endif


namespace pg8 {
#define PG8_LAS __attribute__((address_space(3)))
typedef unsigned short bf16_t;
typedef short bf16x8 __attribute__((ext_vector_type(8)));
typedef float f32x4 __attribute__((ext_vector_type(4)));
typedef unsigned u32x4 __attribute__((ext_vector_type(4)));
typedef unsigned u32x2 __attribute__((ext_vector_type(2)));
constexpr int BM = 256, BK = 64, HALF = 128, HTB = HALF * BK * 2, STAGE_BYTES = 8 * HTB, NXCD = 8;

__host__ __device__ __forceinline__ int lds_byte(int r, int c) { const int st = (r >> 4) * 2 + (c >> 5), rr = r & 15, cc = c & 31, ob = rr * 64 + cc * 2; return st * 1024 + (ob ^ (((ob >> 9) & 1) << 5)); }
__host__ __device__ __forceinline__ void stage_rc(int b, int& R, int& C) { const int st = b / 1024, sb = b % 1024, swz = sb ^ (((sb >> 9) & 1) << 5); R = (st >> 1) * 16 + swz / 64; C = (st & 1) * 32 + (swz % 64) / 2; }
__host__ __device__ __forceinline__ int perm32(int rho) { const int n = rho >> 4, i = rho & 15; return 8 * (i >> 2) + 4 * n + (i & 3); }

struct Unit { int pm, pn, z; };
struct Gemm { const bf16_t* A; const bf16_t* Bt; int M, N, K, lda, ldb; size_t zA, zB; };

struct StaticOrder {
    int nM, nN, nwg, G, c, zsh, WGM;
    __host__ __device__ void init(int M, int N, int G_, int c_, int zsh_ = 0, int bn_ = BM, int wgm_ = 4) { nM = M / BM; nN = N / bn_; nwg = nM * nN; G = G_; c = c_; zsh = zsh_; WGM = wgm_; }
    __host__ __device__ bool next(int i, Unit& u) const {
        const int ti = i >> zsh; u.z = i & ((1 << zsh) - 1);
        const long L = (long)ti * G + c; if (L >= nwg) return false;
        int wgid = (int)L; { const int q = nwg / NXCD, r = nwg % NXCD, xcd = wgid % NXCD, off = wgid / NXCD; wgid = (xcd < r ? xcd * (q + 1) : r * (q + 1) + (xcd - r) * q) + off; }
        const int nig = WGM * nN, gid = wgid / nig, fm = gid * WGM, gsz = (nM - fm) < WGM ? (nM - fm) : WGM;
        u.pm = fm + ((wgid % nig) % gsz); u.pn = (wgid % nig) / gsz; return true;
    }
    __device__ __forceinline__ void a_ready(const Unit&) const {}
    __device__ __forceinline__ void done(const Unit&) const {}
};

typedef float f32x2_ __attribute__((ext_vector_type(2)));
typedef __bf16 bf16x2_ __attribute__((ext_vector_type(2)));
__device__ __forceinline__ unsigned cvt_pk_bf16(float lo, float hi) { const f32x2_ v = {lo, hi}; const bf16x2_ b = __builtin_convertvector(v, bf16x2_); return __builtin_bit_cast(unsigned, b); }

template <class Epi, class Sched, bool ALIGN_EPI = false, bool SP2 = false, bool HALFN = false>
__device__ __forceinline__ void gemm_phase(PG8_LAS unsigned char* lds, const Gemm g, const Sched& S, const Epi& E) {
    int tid = threadIdx.x; asm volatile("" : "+v"(tid));
    const int wid = __builtin_amdgcn_readfirstlane(tid >> 6), lane = tid & 63, wr = wid >> 2, wc = wid & 3, fr = lane & 15, fq = lane >> 4;
    const int K = g.K, nt = K / BK;
    unsigned voffA[2], voffB[2];
#pragma unroll
    for (int i = 0; i < 2; ++i) { int R, C; stage_rc(tid * 16 + i * 8192, R, C); const int Rb = Epi::PERM ? ((R & ~31) + perm32(R & 31)) : R;
        voffA[i] = (unsigned)(R * g.lda + C) * 2u; voffB[i] = (unsigned)(Rb * g.ldb + C) * 2u; }
    const size_t kstep = (size_t)(BK * 2);
    const size_t hstepA = (size_t)HALF * g.lda * 2, hstepB = (size_t)HALF * g.ldb * 2;
    const size_t tstepA = 2 * hstepA, tstepB = HALFN ? hstepB : 2 * hstepB;
    const unsigned ldsw = (unsigned)wid * 1024u;
    unsigned aoff = (unsigned)lds_byte(wr * 64 + fr, fq * 8), boff = (unsigned)lds_byte(wc * 32 + fr, fq * 8) + 4u * HTB;
    asm volatile("" : "+v"(aoff), "+v"(boff));
#define PG8_SA(b, h) (((b) * 2 + (h)) * HTB)
#define PG8_SB(b, h) ((4 + (b) * 2 + (h)) * HTB)
#define PG8_STAGE(bufoff, gbase, voff) do { _Pragma("unroll") for (int _i = 0; _i < 2; ++_i) \
        __builtin_amdgcn_global_load_lds((const unsigned*)((const char*)(gbase) + (voff)[_i]), (PG8_LAS unsigned*)(lds + (bufoff) + ldsw + _i * 8192), 16, 0, 0); } while (0)
#define PG8_LDA(dst, b, h) do { _Pragma("unroll") for (int m = 0; m < 4; ++m) _Pragma("unroll") for (int k = 0; k < 2; ++k) dst[m][k] = *(const PG8_LAS bf16x8*)(lds + aoff + (PG8_SA(b, h) + m * 2048 + k * 1024)); } while (0)
#define PG8_LDB(dst, b, h) do { _Pragma("unroll") for (int n = 0; n < 2; ++n) _Pragma("unroll") for (int k = 0; k < 2; ++k) dst[n][k] = *(const PG8_LAS bf16x8*)(lds + boff + (((b) * 2 + (h)) * HTB + n * 2048 + k * 1024)); } while (0)
#define PG8_MMA(ai, bj, At, Bt) do { __builtin_amdgcn_s_setprio(1); _Pragma("unroll") for (int m = 0; m < 4; ++m) _Pragma("unroll") for (int n = 0; n < 2; ++n) _Pragma("unroll") for (int k = 0; k < 2; ++k) \
        acc[ai][bj][m][n] = __builtin_amdgcn_mfma_f32_16x16x32_bf16(Bt[n][k], At[m][k], acc[ai][bj][m][n], 0, 0, 0); __builtin_amdgcn_s_setprio(0); } while (0)
#define PG8_WAIT_V(n) asm volatile("s_waitcnt vmcnt(" #n ")" ::: "memory")
#define PG8_WAIT_L(n) asm volatile("s_waitcnt lgkmcnt(" #n ")" ::: "memory")
#define PG8_BAR __builtin_amdgcn_s_barrier()
#define PG8_SCHED __builtin_amdgcn_sched_barrier(0)
    Unit cur, nxt; int ui = 0;
    if (!S.next(0, cur)) return;
    f32x4 acc[2][2][4][2];
#pragma unroll
    for (int a = 0; a < 2; ++a)
#pragma unroll
        for (int b = 0; b < 2; ++b)
#pragma unroll
            for (int m = 0; m < 4; ++m)
#pragma unroll
                for (int n = 0; n < 2; ++n) acc[a][b][m][n] = (f32x4){0.f, 0.f, 0.f, 0.f};
    bf16x8 At[4][2], B0[2][2], B1[2][2];
    const char* cA = (const char*)g.A + (size_t)cur.pm * tstepA + (size_t)cur.z * g.zA; const char* cB = (const char*)g.Bt + (size_t)cur.pn * tstepB + (size_t)cur.z * g.zB;
    S.a_ready(cur);
    if constexpr (SP2 && HALFN) {
        PG8_STAGE(PG8_SB(0, 0), cB, voffB); PG8_STAGE(PG8_SA(0, 0), cA, voffA); PG8_STAGE(PG8_SA(0, 1), cA + hstepA, voffA);
        if (wr == 1) PG8_BAR;
        PG8_WAIT_V(2); PG8_BAR;
        PG8_STAGE(PG8_SB(1, 0), cB + kstep, voffB); PG8_STAGE(PG8_SA(1, 0), cA + kstep, voffA);
        PG8_WAIT_V(4); PG8_BAR;
    } else if constexpr (SP2) {
        PG8_STAGE(PG8_SB(0, 0), cB, voffB); PG8_STAGE(PG8_SB(0, 1), cB + hstepB, voffB); PG8_STAGE(PG8_SA(0, 0), cA, voffA); PG8_STAGE(PG8_SA(0, 1), cA + hstepA, voffA);
        if (wr == 1) PG8_BAR;
        PG8_WAIT_V(2); PG8_BAR;
        PG8_STAGE(PG8_SB(1, 0), cB + kstep, voffB); PG8_STAGE(PG8_SA(1, 0), cA + kstep, voffA); PG8_STAGE(PG8_SB(1, 1), cB + hstepB + kstep, voffB);
        PG8_WAIT_V(6); PG8_BAR;
    } else {
        PG8_STAGE(PG8_SB(0, 0), cB, voffB); PG8_STAGE(PG8_SA(0, 0), cA, voffA); PG8_STAGE(PG8_SB(0, 1), cB + hstepB, voffB); PG8_STAGE(PG8_SA(0, 1), cA + hstepA, voffA);
        if (wr == 1) PG8_BAR;
        PG8_WAIT_V(4); PG8_BAR;
        PG8_STAGE(PG8_SB(1, 0), cB + kstep, voffB); PG8_STAGE(PG8_SA(1, 0), cA + kstep, voffA); PG8_STAGE(PG8_SB(1, 1), cB + hstepB + kstep, voffB);
        PG8_WAIT_V(6); PG8_BAR;
    }
    for (;;) {
        const bool has_next = S.next(ui + 1, nxt);
        const char* nA = has_next ? (const char*)g.A + (size_t)nxt.pm * tstepA + (size_t)nxt.z * g.zA : cA; const char* nB = has_next ? (const char*)g.Bt + (size_t)nxt.pn * tstepB + (size_t)nxt.z * g.zB : cB;
        for (int t = 0; t < nt; t += 2) {
            const bool last = (t == nt - 2);
            const char* a1 = cA + (size_t)(t + 1) * kstep;
            const char* a2 = last ? nA : cA + (size_t)(t + 2) * kstep; const char* b2 = last ? nB : cB + (size_t)(t + 2) * kstep;
            const char* a3 = a2 + kstep; const char* b3 = b2 + kstep;
            if (last && has_next) S.a_ready(nxt);
            if constexpr (SP2 && HALFN) {
            PG8_LDB(B0, 0, 0); PG8_SCHED; PG8_LDA(At, 0, 0); PG8_STAGE(PG8_SA(1, 1), a1 + hstepA, voffA);
            PG8_WAIT_V(6); PG8_WAIT_L(0); PG8_BAR; PG8_MMA(0, 0, At, B0); PG8_BAR; PG8_SCHED;
            PG8_LDA(At, 0, 1); PG8_STAGE(PG8_SB(0, 0), b2, voffB); PG8_STAGE(PG8_SA(0, 0), a2, voffA);
            PG8_WAIT_V(6); PG8_WAIT_L(0); PG8_BAR; PG8_MMA(1, 0, At, B0); PG8_BAR; PG8_SCHED;
            PG8_LDB(B0, 1, 0); PG8_SCHED; PG8_LDA(At, 1, 0); PG8_STAGE(PG8_SA(0, 1), a2 + hstepA, voffA);
            PG8_WAIT_V(6); PG8_WAIT_L(0); PG8_BAR; PG8_MMA(0, 0, At, B0); PG8_BAR; PG8_SCHED;
            PG8_LDA(At, 1, 1); PG8_STAGE(PG8_SB(1, 0), b3, voffB); PG8_STAGE(PG8_SA(1, 0), a3, voffA);
            PG8_WAIT_V(6); PG8_WAIT_L(0); PG8_BAR; PG8_MMA(1, 0, At, B0); PG8_BAR; PG8_SCHED;
            } else if constexpr (SP2) {
            PG8_LDB(B0, 0, 0); PG8_LDB(B1, 0, 1); PG8_SCHED; PG8_LDA(At, 0, 0); PG8_STAGE(PG8_SA(1, 1), a1 + hstepA, voffA);
            PG8_WAIT_V(8); PG8_WAIT_L(0); PG8_BAR; PG8_MMA(0, 0, At, B0); PG8_MMA(0, 1, At, B1); PG8_BAR; PG8_SCHED;
            PG8_LDA(At, 0, 1); PG8_STAGE(PG8_SB(0, 0), b2, voffB); PG8_STAGE(PG8_SB(0, 1), b2 + hstepB, voffB); PG8_STAGE(PG8_SA(0, 0), a2, voffA);
            PG8_WAIT_V(8); PG8_WAIT_L(0); PG8_BAR; PG8_MMA(1, 0, At, B0); PG8_MMA(1, 1, At, B1); PG8_BAR; PG8_SCHED;
            PG8_LDB(B0, 1, 0); PG8_LDB(B1, 1, 1); PG8_SCHED; PG8_LDA(At, 1, 0); PG8_STAGE(PG8_SA(0, 1), a2 + hstepA, voffA);
            PG8_WAIT_V(8); PG8_WAIT_L(0); PG8_BAR; PG8_MMA(0, 0, At, B0); PG8_MMA(0, 1, At, B1); PG8_BAR; PG8_SCHED;
            PG8_LDA(At, 1, 1); PG8_STAGE(PG8_SB(1, 0), b3, voffB); PG8_STAGE(PG8_SB(1, 1), b3 + hstepB, voffB); PG8_STAGE(PG8_SA(1, 0), a3, voffA);
            PG8_WAIT_V(8); PG8_WAIT_L(0); PG8_BAR; PG8_MMA(1, 0, At, B0); PG8_MMA(1, 1, At, B1); PG8_BAR; PG8_SCHED;
            } else {
            PG8_LDB(B0, 0, 0); PG8_SCHED; PG8_LDA(At, 0, 0); PG8_STAGE(PG8_SA(1, 1), a1 + hstepA, voffA);
            PG8_WAIT_L(8); PG8_BAR; PG8_WAIT_L(0); PG8_MMA(0, 0, At, B0); PG8_BAR; PG8_SCHED;
            PG8_LDB(B1, 0, 1); PG8_STAGE(PG8_SB(0, 0), b2, voffB);
            PG8_BAR; PG8_WAIT_L(0); PG8_MMA(0, 1, At, B1); PG8_BAR;
            PG8_LDA(At, 0, 1); PG8_STAGE(PG8_SA(0, 0), a2, voffA);
            PG8_BAR; PG8_WAIT_L(0); PG8_MMA(1, 0, At, B0); PG8_BAR; PG8_SCHED;
            PG8_STAGE(PG8_SB(0, 1), b2 + hstepB, voffB);
            PG8_WAIT_V(6); PG8_BAR; PG8_MMA(1, 1, At, B1); PG8_BAR;
            PG8_LDB(B0, 1, 0); PG8_SCHED; PG8_LDA(At, 1, 0); PG8_STAGE(PG8_SA(0, 1), a2 + hstepA, voffA);
            PG8_WAIT_L(8); PG8_BAR; PG8_WAIT_L(0); PG8_MMA(0, 0, At, B0); PG8_BAR; PG8_SCHED;
            PG8_LDB(B1, 1, 1); PG8_STAGE(PG8_SB(1, 0), b3, voffB);
            PG8_BAR; PG8_WAIT_L(0); PG8_MMA(0, 1, At, B1); PG8_BAR;
            PG8_LDA(At, 1, 1); PG8_STAGE(PG8_SA(1, 0), a3, voffA);
            PG8_BAR; PG8_WAIT_L(0); PG8_MMA(1, 0, At, B0); PG8_BAR; PG8_SCHED;
            PG8_STAGE(PG8_SB(1, 1), b3 + hstepB, voffB);
            PG8_WAIT_V(6); PG8_BAR; PG8_MMA(1, 1, At, B1); PG8_BAR;
            }
        }
        if constexpr (ALIGN_EPI) { if (wr == 0) PG8_BAR; }
        { int fr_e = fr, fq_e = fq; asm volatile("" : "+v"(fr_e), "+v"(fq_e));
          E(acc, cur, wr, wc, fr_e, fq_e); }
        if (!has_next) break;
        if (!HALFN && !(Epi::KEEP && cur.z != 3)) {
#pragma unroll
        for (int a = 0; a < 2; ++a)
#pragma unroll
            for (int b = 0; b < 2; ++b)
#pragma unroll
                for (int m = 0; m < 4; ++m)
#pragma unroll
                    for (int n = 0; n < 2; ++n) acc[a][b][m][n] = (f32x4){0.f, 0.f, 0.f, 0.f};
        }
        cur = nxt; cA = nA; cB = nB; ++ui;
        if constexpr (ALIGN_EPI) { if (wr == 1) PG8_BAR; }
    }
    PG8_WAIT_V(0);
    if constexpr (!ALIGN_EPI) { if (wr == 0) PG8_BAR; }
    PG8_BAR;
#undef PG8_SA
#undef PG8_SB
#undef PG8_STAGE
#undef PG8_LDA
#undef PG8_LDB
#undef PG8_MMA
#undef PG8_WAIT_V
#undef PG8_WAIT_L
#undef PG8_BAR
#undef PG8_SCHED
}

}

using pg8::bf16_t; using pg8::f32x4; using pg8::u32x4; using pg8::u32x2; using pg8::bf16x8; using pg8::cvt_pk_bf16;
#define LAS __attribute__((address_space(3)))

constexpr int D = 1024, SEQ = 4096, NB = 16, DEPTH = 4, BW = 512;
constexpr int NGRP = 2, BG = NB / NGRP, TG = BG * SEQ;
constexpr int N_IN = 21 * 256, N_MG = 4096, N_ALL = N_IN + N_MG;
constexpr int PLD = 20 * 256;
constexpr int P_GQ = 0, P_GK = 256, P_GV = 512, P_GG = 1024, P_RQ = 1536, P_RK = 1792, P_RV = 2048, P_RG = 2560, P_LX = 3072, P_LG = 3584, P_SU = 4096, P_SG = 4608;
constexpr int OLD = 2048;
constexpr float NORM_EPS = 1e-6f;

constexpr size_t MiB = 1u << 20;
constexpr size_t WS_CTL = 0, CTL_BYTES = 2 * MiB;
constexpr size_t WS_ROT = 2 * MiB;
constexpr size_t WS_SMALL = 3 * MiB, SMALL_STRIDE = 1 * MiB;
constexpr size_t WS_W = 8 * MiB, W_STRIDE = 26 * MiB;
constexpr size_t WO_IN = 0, WO_BR = (size_t)N_ALL * D * 2, WO_OUT = WO_BR + (size_t)4 * D * BW * 2, WO_GLU = WO_OUT + (size_t)D * D * 2, WO_END = WO_GLU + (size_t)BW * BW * 2;
static_assert(WO_END <= W_STRIDE, "weights");
constexpr size_t WS_U = 112 * MiB;
constexpr size_t WS_P = 176 * MiB;
constexpr size_t WS_LA = 496 * MiB;
constexpr size_t WS_O = 528 * MiB;
constexpr size_t WS_Y5 = 656 * MiB;
constexpr size_t WS_PG = 688 * MiB;
constexpr size_t WS_S5D = 816 * MiB;
constexpr size_t WS_S5M = 820 * MiB, S5M_BYTES = 86016;
constexpr size_t WS_S5K = 831 * MiB;
constexpr size_t WS_SU2 = 832 * MiB;
constexpr size_t WS_ST = 944 * MiB;
constexpr size_t WS_END = 1008 * MiB;
constexpr int SM_ABR = 0, SM_ABI = 2048, SM_BBR = 4096, SM_BBI = 4096 + 32768, SM_SP8 = 4096 + 65536, SM_END_F = SM_SP8 + 512;
constexpr int SM_A128 = SM_END_F;
constexpr int SM_A8 = SM_A128 + 4096;
constexpr size_t SM_LRUW_BYTES = 512 * 1024, SM_CT_BYTES = 640 * 1024, SM_BBT_BYTES = 768 * 1024;
static_assert((size_t)(SM_END_F + 8192) * 4 <= SM_LRUW_BYTES, "small");

constexpr int CW_BAR = 4096;
#define XB_TMO      128
#define XB_XCNT(j)  (256  + 64 * (j))
#define XB_XSUB(j)  (1280 + 64 * (j))
#define XB_XGEN(j)  (2304 + 64 * (j))
#define XB_TOP      3328
#define XB_TOPGEN   3392
#define XCD_BAR_WORDS 3456
#define XB_SPIN_CAP (1u << 18)

__device__ __forceinline__ void wg_syncthreads() { __builtin_amdgcn_fence(__ATOMIC_RELEASE, "workgroup"); __builtin_amdgcn_s_barrier(); __builtin_amdgcn_fence(__ATOMIC_ACQUIRE, "workgroup"); }
__device__ __forceinline__ unsigned xb_ld(unsigned* p)              { return __hip_atomic_load(p, __ATOMIC_RELAXED, __HIP_MEMORY_SCOPE_AGENT); }
__device__ __forceinline__ unsigned xb_add(unsigned* p, unsigned v) { return __hip_atomic_fetch_add(p, v, __ATOMIC_RELAXED, __HIP_MEMORY_SCOPE_AGENT); }
__device__ __forceinline__ unsigned xb_xcc_id() { return (unsigned)__builtin_amdgcn_s_getreg((3 << 11) | 20) & 0xFu; }
#define XB_SPIN(cond, bar) do { unsigned _sp = 0; while (cond) { __builtin_amdgcn_s_sleep(1); \
    if ((++_sp & 255u) == 0u) { if (xb_ld(&(bar)[XB_TMO])) break; if (_sp > XB_SPIN_CAP) { (void)xb_add(&(bar)[XB_TMO], 1u); break; } } } } while (0)
struct XcdBarrier { unsigned* bar; unsigned x; volatile LAS unsigned* st; };
__device__ __forceinline__ XcdBarrier xcd_barrier_post(unsigned* bar, volatile LAS unsigned* st) {
    XcdBarrier b; b.bar = bar; b.x = xb_xcc_id(); b.st = st;
    if (threadIdx.x == 0) (void)xb_add(&bar[XB_XCNT(b.x)], 1u);
    return b;
}
__device__ __forceinline__ void xcd_barrier_complete(unsigned* bar, unsigned x, unsigned& nloc, unsigned& nx) {
    const unsigned G = gridDim.x * gridDim.y * gridDim.z;
    unsigned sum, cnt, mine, sp = 0u;
    for (;;) {
        sum = 0u; cnt = 0u; mine = 0u;
#pragma unroll
        for (unsigned j = 0; j < 16; ++j) { const unsigned c = xb_ld(&bar[XB_XCNT(j)]); sum += c; cnt += (c > 0u) ? 1u : 0u; mine = (j == x) ? c : mine; }
        if (sum == G) break;
        __builtin_amdgcn_s_sleep(1);
        if ((++sp & 255u) == 0u) { if (xb_ld(&bar[XB_TMO])) break; if (sp > XB_SPIN_CAP) { (void)xb_add(&bar[XB_TMO], 1u); break; } }
    }
    nloc = mine > 0u ? mine : 1u; nx = cnt > 0u ? cnt : 1u;
}
__device__ __forceinline__ void xcd_barrier(const XcdBarrier& b) {
    asm volatile("s_waitcnt vmcnt(0)" ::: "memory");
    wg_syncthreads();
    if (threadIdx.x == 0) {
        unsigned* bar = b.bar;
        __builtin_amdgcn_s_waitcnt(0);
        unsigned nloc = b.st[0], nx = b.st[1];
        if (nloc == 0u) { xcd_barrier_complete(bar, b.x, nloc, nx); b.st[0] = nloc; b.st[1] = nx; }
        const unsigned old = xb_add(&bar[XB_XSUB(b.x)], 1u);
        const unsigned gen = old / nloc;
        if (old + 1u == (gen + 1u) * nloc) {
            __builtin_amdgcn_fence(__ATOMIC_RELEASE, "agent");
            asm volatile("s_waitcnt vmcnt(0)" ::: "memory");
            const unsigned og = xb_add(&bar[XB_TOP], 1u);
            const unsigned tg = og / nx;
            if (og + 1u == (tg + 1u) * nx) xb_add(&bar[XB_TOPGEN], 1u);
            else XB_SPIN(xb_ld(&bar[XB_TOPGEN]) == tg, bar);
            __builtin_amdgcn_fence(__ATOMIC_ACQUIRE, "agent");
            xb_add(&bar[XB_XGEN(b.x)], 1u);
            asm volatile("s_waitcnt vmcnt(0)" ::: "memory");
        } else {
            XB_SPIN(xb_ld(&bar[XB_XGEN(b.x)]) == gen, bar);
            __builtin_amdgcn_fence(__ATOMIC_ACQUIRE, "agent");
            asm volatile("s_waitcnt vmcnt(0)" ::: "memory");
        }
    }
    wg_syncthreads();
}

__device__ __forceinline__ float bf2f(bf16_t b) { return __builtin_bit_cast(float, ((unsigned)b) << 16); }
__device__ __forceinline__ float bflo(unsigned w) { return __builtin_bit_cast(float, w << 16); }
__device__ __forceinline__ float bfhi(unsigned w) { return __builtin_bit_cast(float, w & 0xffff0000u); }
__device__ __forceinline__ bf16_t f2bf(float f) { return (bf16_t)(cvt_pk_bf16(f, 0.f) & 0xffffu); }
__device__ __forceinline__ float sigmoid_f(float x) { return __builtin_amdgcn_rcpf(1.f + __expf(-x)); }
__device__ __forceinline__ float silu_f(float x) { return x * sigmoid_f(x); }
__device__ __forceinline__ float silu_t(float t) { return t * __builtin_amdgcn_rcpf(__builtin_fmaf(__builtin_amdgcn_exp2f(t), -1.4426950408889634f, -1.4426950408889634f)); }
__device__ __forceinline__ float sig255(float t) { return __builtin_amdgcn_rcpf(__builtin_fmaf(__builtin_amdgcn_exp2f(t), 1.f / 255.f, 1.f / 255.f)); }
__device__ __forceinline__ float gelu_tanh_f(float x) { const float u = 0.7978845608028654f * (x + 0.044715f * x * x * x); const float t = 1.f - 2.f * __builtin_amdgcn_rcpf(1.f + __expf(2.f * u)); return 0.5f * x * (1.f + t); }
__device__ __forceinline__ float shfl_xor_f(float v, int m) { const int ln = (int)__builtin_amdgcn_mbcnt_hi(~0u, __builtin_amdgcn_mbcnt_lo(~0u, 0u)); return __builtin_bit_cast(float, __builtin_amdgcn_ds_bpermute((ln ^ m) << 2, __builtin_bit_cast(int, v))); }
__device__ __forceinline__ float wave_sum(float v) {
#pragma unroll
    for (int o = 1; o < 64; o <<= 1) v += shfl_xor_f(v, o);
    return v;
}

#define GEMM_CALL(EPI) pg8::gemm_phase<EPI, pg8::StaticOrder, true, true>(lds, g, S, E)
struct Args {
    const float* in[29]; float* out; unsigned char* ws;
    int s_lo, s_hi, li, fin, mmask, pad2;
};
enum { I_X = 0, I_NG, I_WIN, I_GWLR, I_GBLR, I_GNG, I_RNG, I_RNB, I_LCW, I_LCB, I_LWA, I_LBA, I_LWX, I_LBX, I_LLAM,
       I_SARE, I_SAIM, I_SBRE, I_SBIM, I_SCRE, I_SCIM, I_SD, I_SLDT, I_SGW, I_SGB, I_WMG, I_WBR, I_WOUT, I_FNG };

struct EpiIn {
    static constexpr bool PERM = true, AFTER_DRAIN = false, KEEP = false;
    bf16_t* P; float* LA; const float* blr; const float* rot; unsigned char* PG; bf16_t* SU;
    __device__ __forceinline__ void operator()(f32x4 (&acc)[2][2][4][2], const pg8::Unit& u, int wr, int wc, int fr, int fq) const {
        const int pn = u.pn, row0 = u.pm * 256 + wr * 64 + fr, cl = wc * 32 + 8 * fq;
        if (pn >= 21) {
#pragma unroll
            for (int ai = 0; ai < 2; ++ai)
#pragma unroll
                for (int m = 0; m < 4; ++m) { int row = row0 + ai * 128 + m * 16; asm volatile("" : "+v"(row));
                    u32x4 w;
#pragma unroll
                    for (int bj = 0; bj < 2; ++bj) { const f32x4 v0 = acc[ai][bj][m][0], v1 = acc[ai][bj][m][1]; unsigned lo = 0u, hi = 0u;
#pragma unroll
                        for (int j = 0; j < 4; ++j) { lo = __builtin_amdgcn_cvt_pk_u8_f32(sig255(v0[j]), j, lo); hi = __builtin_amdgcn_cvt_pk_u8_f32(sig255(v1[j]), j, hi); }
                        if (bj == 0) { w.x = lo; w.y = hi; } else { w.z = lo; w.w = hi; } }
                    __builtin_nontemporal_store(w, (u32x4*)(PG + (size_t)row * N_MG + (pn - 21) * 256 + 2 * cl)); }
        } else if (pn == 4) {
#pragma unroll
            for (int bj = 0; bj < 2; ++bj) { const int c = cl + bj * 128; const f32x4 b0 = *(const f32x4*)(blr + c), b1 = *(const f32x4*)(blr + c + 4);
#pragma unroll
                for (int ai = 0; ai < 2; ++ai) {
#pragma unroll
                    for (int n = 0; n < 2; ++n)
#pragma unroll
                        for (int j = 0; j < 4; ++j) { float run = 0.f; const float bb = n ? b1[j] : b0[j];
#pragma unroll
                            for (int m = 0; m < 4; ++m) { const float z = acc[ai][bj][m][n][j] + bb; const float x = -(fmaxf(-z, 0.f) + __logf(1.f + __expf(-fabsf(z)))) * 0.0625f; float ls = x, rs = x;
#define DPP_ADD(acc_, ctrl_) acc_ += __builtin_bit_cast(float, __builtin_amdgcn_update_dpp(0, __builtin_bit_cast(int, acc_), ctrl_, 0xf, 0xf, true))
                                DPP_ADD(ls, 0x111); DPP_ADD(ls, 0x112); DPP_ADD(ls, 0x114); DPP_ADD(ls, 0x118);
                                DPP_ADD(rs, 0x101); DPP_ADD(rs, 0x102); DPP_ADD(rs, 0x104); DPP_ADD(rs, 0x108);
#undef DPP_ADD
                                acc[ai][bj][m][n][j] = run + ls; run += ls + rs - x; } }
#pragma unroll
                    for (int m = 0; m < 4; ++m) { int row = row0 + ai * 128 + m * 16; asm volatile("" : "+v"(row)); float* d = LA + ((size_t)(c >> 6) * TG + row) * 64 + (c & 63); *(f32x4*)d = acc[ai][bj][m][0]; *(f32x4*)(d + 4) = acc[ai][bj][m][1]; } } }
        } else if (pn == 7 || pn == 8) {
            const int dcol = (pn - 1) * 256;
#pragma unroll
            for (int ai = 0; ai < 2; ++ai)
#pragma unroll
                for (int m = 0; m < 4; ++m) { int row = row0 + ai * 128 + m * 16; asm volatile("" : "+v"(row)); const int pos = row & (SEQ - 1);
#pragma unroll
                    for (int bj = 0; bj < 2; ++bj) { const int c = cl + bj * 128, i0 = (c & 63) >> 1; const float* rt = rot + ((size_t)pos * 32 + i0) * 2;
                        const f32x4 cs0 = *(const f32x4*)rt, cs1 = *(const f32x4*)(rt + 4); const f32x4 v0 = acc[ai][bj][m][0], v1 = acc[ai][bj][m][1];
                        u32x4 w; w.x = cvt_pk_bf16(v0[0] * cs0[0] - v0[1] * cs0[1], v0[0] * cs0[1] + v0[1] * cs0[0]); w.y = cvt_pk_bf16(v0[2] * cs0[2] - v0[3] * cs0[3], v0[2] * cs0[3] + v0[3] * cs0[2]);
                        w.z = cvt_pk_bf16(v1[0] * cs1[0] - v1[1] * cs1[1], v1[0] * cs1[1] + v1[1] * cs1[0]); w.w = cvt_pk_bf16(v1[2] * cs1[2] - v1[3] * cs1[3], v1[2] * cs1[3] + v1[3] * cs1[2]);
                        __builtin_nontemporal_store(w, (u32x4*)(P + (size_t)(dcol + (c & ~63)) * TG + (size_t)row * 64 + (c & 63))); } }
        } else {
            const bool silu = (pn == 5 || pn == 6 || pn == 11 || pn == 12 || pn == 15 || pn == 16 || pn == 19 || pn == 20);
            const int dcol = (pn < 4 ? pn : pn - 1) * 256;
            const int wsh = (pn >= 19) ? 9 : ((pn == 2 || pn == 3 || pn == 5 || pn == 6 || (pn >= 9 && pn <= 12)) ? 7 : 6);
#pragma unroll
            for (int ai = 0; ai < 2; ++ai)
#pragma unroll
                for (int m = 0; m < 4; ++m) { int row = row0 + ai * 128 + m * 16; asm volatile("" : "+v"(row));
#pragma unroll
                    for (int bj = 0; bj < 2; ++bj) { f32x4 v0 = acc[ai][bj][m][0], v1 = acc[ai][bj][m][1];
                        if (silu) {
#pragma unroll
                            for (int j = 0; j < 4; ++j) { v0[j] = silu_t(v0[j]); v1[j] = silu_t(v1[j]); } }
                        u32x4 w; w.x = cvt_pk_bf16(v0[0], v0[1]); w.y = cvt_pk_bf16(v0[2], v0[3]); w.z = cvt_pk_bf16(v1[0], v1[1]); w.w = cvt_pk_bf16(v1[2], v1[3]);
                        if (pn == 17 || pn == 18) { const int cc = (pn - 17) * 256 + cl + bj * 128;
                            __builtin_nontemporal_store(w, (u32x4*)(SU + ((size_t)(cc >> 4) * TG + row) * 16 + (cc & 15))); }
                        else { const int col = dcol + cl + bj * 128; __builtin_nontemporal_store(w, (u32x4*)(P + (size_t)(col >> wsh << wsh) * TG + ((size_t)row << wsh) + (col & ((1 << wsh) - 1)))); } } }
        }
    }
};
struct EpiSig {
    static constexpr bool PERM = true, AFTER_DRAIN = false, KEEP = false;
    bf16_t* PG;
    __device__ __forceinline__ void operator()(const f32x4 (&acc)[2][2][4][2], const pg8::Unit& u, int wr, int wc, int fr, int fq) const {
        const int row0 = u.pm * 256 + wr * 64 + fr, c0 = u.pn * 256 + wc * 32 + 8 * fq;
#pragma unroll
        for (int ai = 0; ai < 2; ++ai)
#pragma unroll
            for (int m = 0; m < 4; ++m) { const int row = row0 + ai * 128 + m * 16;
#pragma unroll
                for (int bj = 0; bj < 2; ++bj) { f32x4 v0 = acc[ai][bj][m][0], v1 = acc[ai][bj][m][1];
#pragma unroll
                    for (int j = 0; j < 4; ++j) { v0[j] = sigmoid_f(v0[j]); v1[j] = sigmoid_f(v1[j]); }
                    u32x4 w; w.x = cvt_pk_bf16(v0[0], v0[1]); w.y = cvt_pk_bf16(v0[2], v0[3]); w.z = cvt_pk_bf16(v1[0], v1[1]); w.w = cvt_pk_bf16(v1[2], v1[3]);
                    *(u32x4*)(PG + (size_t)row * N_MG + c0 + bj * 128) = w; } }
    }
};
struct EpiGlu {
    static constexpr bool PERM = true, AFTER_DRAIN = false, KEEP = false;
    const bf16_t* Y5; const bf16_t* P; const float* gb; bf16_t* O;
    __device__ __forceinline__ void operator()(const f32x4 (&acc)[2][2][4][2], const pg8::Unit& u, int wr, int wc, int fr, int fq) const {
        const int row0 = u.pm * 256 + wr * 64 + fr, c0 = u.pn * 256 + wc * 32 + 8 * fq;
#pragma unroll
        for (int bj = 0; bj < 2; ++bj) { const int c = c0 + bj * 128; const f32x4 b0 = *(const f32x4*)(gb + c), b1 = *(const f32x4*)(gb + c + 4);
#pragma unroll
            for (int ai = 0; ai < 2; ++ai)
#pragma unroll
                for (int m = 0; m < 4; ++m) { const int row = row0 + ai * 128 + m * 16;
                    const u32x4 y = *(const u32x4*)(Y5 + (size_t)row * BW + c), s = *(const u32x4*)(P + (size_t)P_SG * TG + (size_t)row * 512 + c);
                    const f32x4 v0 = acc[ai][bj][m][0] + b0, v1 = acc[ai][bj][m][1] + b1;
                    u32x4 w;
                    w.x = cvt_pk_bf16(bflo(y.x) * sigmoid_f(v0[0]) * bflo(s.x), bfhi(y.x) * sigmoid_f(v0[1]) * bfhi(s.x));
                    w.y = cvt_pk_bf16(bflo(y.y) * sigmoid_f(v0[2]) * bflo(s.y), bfhi(y.y) * sigmoid_f(v0[3]) * bfhi(s.y));
                    w.z = cvt_pk_bf16(bflo(y.z) * sigmoid_f(v1[0]) * bflo(s.z), bfhi(y.z) * sigmoid_f(v1[1]) * bfhi(s.z));
                    w.w = cvt_pk_bf16(bflo(y.w) * sigmoid_f(v1[2]) * bflo(s.w), bfhi(y.w) * sigmoid_f(v1[3]) * bfhi(s.w));
                    *(u32x4*)(O + (size_t)row * OLD + 1536 + c) = w; } }
    }
};
struct EpiBr {
    static constexpr bool PERM = true, AFTER_DRAIN = false, KEEP = false;
    const unsigned char* PG; bf16_t* MRG;
    __device__ __forceinline__ void operator()(f32x4 (&acc)[2][2][4][2], const pg8::Unit& u, int wr, int wc, int fr, int fq) const {
        const int row0 = u.pm * 256 + wr * 64 + fr, c = u.pn * 128 + wc * 32 + 8 * fq, z = u.z;
        const int gpos = (z * 4 + (u.pn >> 1)) * 256 + wc * 64 + fq * 16 + (u.pn & 1) * 8;
#pragma unroll
        for (int ai = 0; ai < 2; ++ai)
#pragma unroll
            for (int m = 0; m < 4; ++m) { const int row = row0 + ai * 128 + m * 16;
                const u32x2 gt = __builtin_nontemporal_load((const u32x2*)(PG + (size_t)row * N_MG + gpos));
                f32x4& p0 = acc[ai][0][m][0]; f32x4& p1 = acc[ai][0][m][1]; f32x4& s0 = acc[ai][1][m][0]; f32x4& s1 = acc[ai][1][m][1];
                if (z == 0) { s0 = (f32x4){0.f, 0.f, 0.f, 0.f}; s1 = s0; }
                s0[0] += p0[0] * (float)(gt.x & 255u); s0[1] += p0[1] * (float)((gt.x >> 8) & 255u); s0[2] += p0[2] * (float)((gt.x >> 16) & 255u); s0[3] += p0[3] * (float)(gt.x >> 24);
                s1[0] += p1[0] * (float)(gt.y & 255u); s1[1] += p1[1] * (float)((gt.y >> 8) & 255u); s1[2] += p1[2] * (float)((gt.y >> 16) & 255u); s1[3] += p1[3] * (float)(gt.y >> 24);
                p0 = (f32x4){0.f, 0.f, 0.f, 0.f}; p1 = p0;
                if (z == 3) { const float q = 1.f / 255.f; s0 *= q; s1 *= q;
                    u32x4 w; w.x = cvt_pk_bf16(s0[0], s0[1]); w.y = cvt_pk_bf16(s0[2], s0[3]); w.z = cvt_pk_bf16(s1[0], s1[1]); w.w = cvt_pk_bf16(s1[2], s1[3]);
                    *(u32x4*)(MRG + (size_t)row * D + c) = w; } }
    }
};
struct EpiOut {
    static constexpr bool PERM = true, AFTER_DRAIN = false, KEEP = false;
    bf16_t* DL;
    __device__ __forceinline__ void operator()(const f32x4 (&acc)[2][2][4][2], const pg8::Unit& u, int wr, int wc, int fr, int fq) const {
        const int row0 = u.pm * 256 + wr * 64 + fr, c0 = u.pn * 256 + wc * 32 + 8 * fq;
#pragma unroll
        for (int ai = 0; ai < 2; ++ai)
#pragma unroll
            for (int m = 0; m < 4; ++m) { const int row = row0 + ai * 128 + m * 16;
#pragma unroll
                for (int bj = 0; bj < 2; ++bj) { const f32x4 v0 = acc[ai][bj][m][0], v1 = acc[ai][bj][m][1];
                    u32x4 w; w.x = cvt_pk_bf16(v0[0], v0[1]); w.y = cvt_pk_bf16(v0[2], v0[3]); w.z = cvt_pk_bf16(v1[0], v1[1]); w.w = cvt_pk_bf16(v1[2], v1[3]);
                    *(u32x4*)(DL + (size_t)row * D + c0 + bj * 128) = w; } }
    }
};

__device__ __forceinline__ int win_src_col(int r) {
    const int pn = r >> 8, j = r & 255;
    switch (pn) {
        case 0: return j; case 1: return 256 + j; case 2: case 3: return 512 + (r - 512);
        case 4: return -1;
        case 5: case 6: return 1040 + (r - 1280);
        case 7: return 1552 + 64 * (j >> 6) + ((j & 63) >> 1) + 32 * (j & 1);
        case 8: return 1808 + 64 * (j >> 6) + ((j & 63) >> 1) + 32 * (j & 1);
        case 9: case 10: return 2064 + (r - 2304);
        case 11: case 12: return 2576 + (r - 2816);
        case 13: case 14: return 3088 + (r - 3328);
        case 15: case 16: return 3600 + (r - 3840);
        case 17: case 18: return 4112 + (r - 4352);
        default: return 4624 + (r - 4864);
    }
}
__device__ __forceinline__ void tr_store8(bf16_t* dst, const float (&v)[8]) {
    u32x4 w; w.x = cvt_pk_bf16(v[0], v[1]); w.y = cvt_pk_bf16(v[2], v[3]); w.z = cvt_pk_bf16(v[4], v[5]); w.w = cvt_pk_bf16(v[6], v[7]); *(u32x4*)dst = w;
}
__device__ __forceinline__ void phase_prologue(LAS unsigned char* lds, const Args& a, int gtid, int gthreads) {
    unsigned char* ws = a.ws;
    for (int q = gtid; q < DEPTH * 2048; q += gthreads) { const int l = q >> 11, idx = q & 2047, g = idx >> 6;
        float* sm = (float*)(ws + WS_SMALL + (size_t)l * SMALL_STRIDE);
        const double step = exp((double)a.in[I_SLDT][l * 32 + g]); const double are = a.in[I_SARE][l * 2048 + idx], aim = a.in[I_SAIM][l * 2048 + idx];
        const double mag = exp(step * are), abr = mag * cos(step * aim), abi = mag * sin(step * aim), den = are * are + aim * aim;
        const double fre = ((abr - 1.0) * are + abi * aim) / den, fim = (abi * are - (abr - 1.0) * aim) / den;
        sm[SM_ABR + idx] = (float)abr; sm[SM_ABI + idx] = (float)abi;
        double* s5d = (double*)(ws + WS_S5D) + ((size_t)l * 2048 + idx) * 50;
        { double pr = 1.0, pi = 0.0;
          for (int j = 0; j <= 8; ++j) { s5d[2 * j] = pr; s5d[2 * j + 1] = pi; if (j == 8) { sm[SM_A8 + idx * 2] = (float)pr; sm[SM_A8 + idx * 2 + 1] = (float)pi; } const double nr = pr * abr - pi * abi, ni = pr * abi + pi * abr; pr = nr; pi = ni; } }
        { const double m128 = exp(512.0 * step * are); sm[SM_A128 + idx * 2] = (float)(m128 * cos(512.0 * step * aim)); sm[SM_A128 + idx * 2 + 1] = (float)(m128 * sin(512.0 * step * aim)); }
        for (int i = 0; i < 16; ++i) { const double br = a.in[I_SBRE][(size_t)l * 32768 + idx * 16 + i], bi = a.in[I_SBIM][(size_t)l * 32768 + idx * 16 + i];
            s5d[18 + 2 * i] = fre * br - fim * bi; s5d[18 + 2 * i + 1] = fre * bi + fim * br; } }
    { LAS float* T = (LAS float*)lds; const int tid = gtid & 511, G_ = gthreads >> 9, nn = tid & 63, kq = tid >> 6, nn2 = tid >> 3, kc = tid & 7;
      for (int tile = gtid >> 9; tile < DEPTH * 3200; tile += G_) { const int l = tile / 3200, r = tile % 3200;
          bf16_t* Wl = (bf16_t*)(ws + WS_W + (size_t)l * W_STRIDE);
          int nt, kt, dld; bf16_t* dst; const float* colp; int ld; float scale = 1.f; bool comp = false;
          if (r < 1344) { nt = r % 84; kt = r / 84; dst = Wl; dld = D; const int n = nt * 64 + nn, sc = win_src_col(n), pn_ = n >> 8; ld = 5136; comp = sc < 0;
              colp = a.in[I_WIN] + (size_t)l * D * 5136 + (comp ? 1024 : sc);
              scale = (pn_ == 5 || pn_ == 6 || pn_ == 11 || pn_ == 12 || pn_ == 15 || pn_ == 16 || pn_ == 19 || pn_ == 20) ? -1.4426950408889634f : ((pn_ == 0 || pn_ == 8) ? 0.125f : 1.f); }
          else if (r < 2368) { const int q = r - 1344; nt = q & 63; kt = q >> 6; dst = Wl + (size_t)N_IN * D; dld = D; const int n = nt * 64 + nn; ld = D;
              colp = a.in[I_WMG] + (size_t)l * 4 * D * D + (size_t)(n >> 10) * D * D + (n & 1023); scale = -1.4426950408889634f; }
          else if (r < 2880) { const int q = r - 2368; nt = q & 63; kt = q >> 6; dst = (bf16_t*)((unsigned char*)Wl + WO_BR); dld = BW; const int n = nt * 64 + nn; ld = D;
              colp = a.in[I_WBR] + (size_t)l * 4 * BW * D + (size_t)(n >> 10) * BW * D + (n & 1023); }
          else if (r < 3136) { const int q = r - 2880; nt = q & 15; kt = q >> 4; dst = (bf16_t*)((unsigned char*)Wl + WO_OUT); dld = D; ld = D; colp = a.in[I_WOUT] + (size_t)l * D * D + nt * 64 + nn; }
          else { const int q = r - 3136; nt = q & 7; kt = q >> 3; dst = (bf16_t*)((unsigned char*)Wl + WO_GLU); dld = BW; ld = BW; colp = a.in[I_SGW] + (size_t)l * BW * BW + nt * 64 + nn; }
          if (!comp) {
#pragma unroll
              for (int j = 0; j < 8; ++j) { const int kk = kq + 8 * j; T[kk * 65 + nn] = colp[(size_t)(kt * 64 + kk) * ld] * scale; }
          } else { const float* wlr = a.in[I_GWLR] + (size_t)l * 16 * 256 + ((nt * 64 + nn) & 255);
#pragma unroll
              for (int j = 0; j < 8; ++j) { const int kk = kq + 8 * j; const float* wr_ = colp + (size_t)(kt * 64 + kk) * ld; float sacc = 0.f;
#pragma unroll
                  for (int rr = 0; rr < 16; ++rr) sacc += wr_[rr] * wlr[rr * 256];
                  T[kk * 65 + nn] = sacc; } }
          wg_syncthreads();
          { float v[8];
#pragma unroll
            for (int i = 0; i < 8; ++i) v[i] = T[(kc * 8 + i) * 65 + nn2];
            tr_store8(dst + (size_t)(nt * 64 + nn2) * dld + kt * 64 + kc * 8, v); }
          wg_syncthreads();
      } }
    for (int l = 0; l < DEPTH; ++l) {
        float* sm = (float*)(ws + WS_SMALL + (size_t)l * SMALL_STRIDE);
        for (int idx = gtid; idx < 512; idx += gthreads) { const float lam = a.in[I_LLAM][l * 512 + idx]; const float nl = -lam;
            sm[SM_SP8 + idx] = 8.0f * (fmaxf(nl, 0.f) + log1pf(expf(-fabsf(nl)))); }
        bf16_t* lw = (bf16_t*)((unsigned char*)sm + SM_LRUW_BYTES);
        for (int idx = gtid; idx < 8 * 128 * 64; idx += gthreads) { const int i = idx & 63, jj = (idx >> 6) & 127, n = idx >> 13;
            const float v = jj < 64 ? a.in[I_LWA][(((size_t)l * 8 + n) * 64 + i) * 64 + jj] : a.in[I_LWX][(((size_t)l * 8 + n) * 64 + i) * 64 + (jj - 64)];
            lw[idx] = f2bf(v * -1.4426950408889634f); }
    }
    float* rot = (float*)(ws + WS_ROT);
    for (int idx = gtid; idx < SEQ * 32; idx += gthreads) { const int i = idx & 31, s = idx >> 5;
        const double inv = pow(10000.0, -(double)i / 32.0), ang = (double)s * inv; rot[idx * 2] = (float)cos(ang); rot[idx * 2 + 1] = (float)sin(ang); }
}

__device__ __forceinline__ void phase_prologue2(const Args& a, int gtid, int gthreads) {
    unsigned char* ws = a.ws;
    for (int l = 0; l < DEPTH; ++l) {
        const double* s5d = (const double*)(ws + WS_S5D) + (size_t)l * 2048 * 50;
        const float* scre = a.in[I_SCRE] + (size_t)l * 32768; const float* scim = a.in[I_SCIM] + (size_t)l * 32768;
        for (int it = gtid; it < 32 * 4096; it += gthreads) { const int g = it >> 12, r = it & 4095, f = r >> 6, ln = r & 63, fr = ln & 15, fq = ln >> 4;
            const int mat = f >> 5, mt = (f & 31) >> 2, ks = f & 3;
            const int m = 16 * mt + fr, k0 = 32 * ks + 8 * fq; float v[8];
            if (mat == 0) { const int p = m >> 1, ri = m & 1, sq = k0 >> 4, c0 = k0 & 15; const double* sd = s5d + (size_t)(g * 64 + p) * 50; const double ar = sd[2 * (7 - sq)], ai = sd[2 * (7 - sq) + 1];
#pragma unroll
                for (int e = 0; e < 8; ++e) { const double br = sd[18 + 2 * (c0 + e)], bi = sd[18 + 2 * (c0 + e) + 1]; v[e] = (float)(ri ? ar * bi + ai * br : ar * br - ai * bi); } }
            else { const int t = m >> 4, i = m & 15;
#pragma unroll
                for (int e = 0; e < 8; ++e) { const int k = k0 + e, p = k >> 1, ri = k & 1; const double* sd = s5d + (size_t)(g * 64 + p) * 50; const double ar = sd[2 * (t + 1)], ai = sd[2 * (t + 1) + 1];
                    const double cr = scre[(g * 16 + i) * 64 + p], ci = scim[(g * 16 + i) * 64 + p]; v[e] = (float)(ri ? -(cr * ai + ci * ar) : cr * ar - ci * ai); } }
            tr_store8((bf16_t*)(ws + WS_S5M + (size_t)(l * 32 + g) * S5M_BYTES + (size_t)r * 16), v); }
    }
    float* kt = (float*)(ws + WS_S5K);
    for (int it = gtid; it < DEPTH * 32 * 2048; it += gthreads) { const int l = it >> 16, g = (it >> 11) & 31, j = (it >> 8) & 7, i = (it >> 4) & 15, c = it & 15; double ac = 0.0;
        const double* s5d = (const double*)(ws + WS_S5D) + (size_t)l * 2048 * 50;
        const float* scre = a.in[I_SCRE] + (size_t)l * 32768; const float* scim = a.in[I_SCIM] + (size_t)l * 32768;
#pragma unroll 8
        for (int p = 0; p < 64; ++p) { const double* sd = s5d + (size_t)(g * 64 + p) * 50; const double ar = sd[2 * j], ai = sd[2 * j + 1];
            const double cr = scre[(g * 16 + i) * 64 + p], ci = scim[(g * 16 + i) * 64 + p];
            ac += (cr * ar - ci * ai) * sd[18 + 2 * c] - (cr * ai + ci * ar) * sd[18 + 2 * c + 1]; }
        kt[it] = (float)ac; }
}
__device__ __forceinline__ void phase_prologue3(const Args& a, int gtid, int gthreads) {
    unsigned char* ws = a.ws;
    for (int it = gtid; it < DEPTH * 32 * 1280; it += gthreads) { const int lg = it / 1280, r = it % 1280, ff = r >> 6, ln = r & 63, fr = ln & 15, fq = ln >> 4;
        const int mt = ff < 1 ? 0 : ff < 2 ? 1 : ff < 4 ? 2 : ff < 6 ? 3 : ff < 9 ? 4 : ff < 12 ? 5 : ff < 16 ? 6 : 7;
        const int cb = mt < 1 ? 0 : mt < 2 ? 1 : mt < 3 ? 2 : mt < 4 ? 4 : mt < 5 ? 6 : mt < 6 ? 9 : mt < 7 ? 12 : 16, ks = ff - cb;
        const int m = 16 * mt + fr, k0 = 32 * ks + 8 * fq, t = m >> 4, i = m & 15, sq = k0 >> 4, c0 = k0 & 15; float v[8];
        const float* kt = (const float*)(ws + WS_S5K) + (size_t)lg * 2048 + ((sq <= t ? t - sq : 0) * 16 + i) * 16 + c0;
#pragma unroll
        for (int e = 0; e < 8; ++e) v[e] = sq <= t ? kt[e] : 0.f;
        tr_store8((bf16_t*)(ws + WS_S5M + (size_t)lg * S5M_BYTES + 65536 + (size_t)r * 16), v); }
}

template <bool F32OUT, bool ADD>
__device__ __forceinline__ void phase_norm(const float* hin, const bf16_t* delta, float* hout, const float* gain, bf16_t* uout, int gw, int ngw, int lane) {
    f32x4 gv[4];
#pragma unroll
    for (int j = 0; j < 4; ++j) gv[j] = *(const f32x4*)(gain + 4 * lane + 256 * j);
    for (int row = gw; row < TG; row += ngw) {
        const f32x4* xr = (const f32x4*)(hin + (size_t)row * D) + lane; f32x4 v[4]; float s = 0.f;
#pragma unroll
        for (int j = 0; j < 4; ++j) v[j] = __builtin_nontemporal_load(xr + 64 * j);
        if (ADD) { const u32x2* dr = (const u32x2*)(delta + (size_t)row * D) + lane;
#pragma unroll
            for (int j = 0; j < 4; ++j) { const u32x2 dw = __builtin_nontemporal_load(dr + 64 * j); v[j].x += bflo(dw.x); v[j].y += bfhi(dw.x); v[j].z += bflo(dw.y); v[j].w += bfhi(dw.y); } }
#pragma unroll
        for (int j = 0; j < 4; ++j) s += (v[j].x * v[j].x + v[j].y * v[j].y) + (v[j].z * v[j].z + v[j].w * v[j].w);
        const float rstd = rsqrtf(wave_sum(s) * (1.f / D) + NORM_EPS);
        if (F32OUT) { f32x4* o = (f32x4*)(hout + (size_t)row * D) + lane;
#pragma unroll
            for (int j = 0; j < 4; ++j) o[64 * j] = v[j] * rstd * gv[j];
        } else {
            if (ADD) { f32x4* o = (f32x4*)(hout + (size_t)row * D) + lane;
#pragma unroll
                for (int j = 0; j < 4; ++j) o[64 * j] = v[j]; }
            u32x2* o = (u32x2*)(uout + (size_t)row * D) + lane;
#pragma unroll
            for (int j = 0; j < 4; ++j) { const f32x4 y = v[j] * rstd * gv[j]; u32x2 w; w.x = cvt_pk_bf16(y.x, y.y); w.y = cvt_pk_bf16(y.z, y.w); o[64 * j] = w; } }
    }
}

constexpr int NSEGG = 8;
constexpr int NSEGL = 32;
constexpr int NSEGS = 8;
constexpr size_t ST_GSEG = 0;
constexpr size_t ST_GDS = ST_GSEG + (size_t)2 * BG * 4 * NSEGG * 8192;
constexpr size_t ST_LRU = ST_GDS + (size_t)2 * BG * 4 * NSEGG * 64;
constexpr size_t ST_S5 = ST_LRU + (size_t)BG * NSEGL * 512 * 2;
constexpr size_t ST_END_F = ST_S5 + (size_t)BG * NSEGS * 32 * 128;
static_assert(ST_END_F * 4 <= 64 * MiB, "state scratch");
typedef short s16x4 __attribute__((ext_vector_type(4)));

__device__ __forceinline__ bf16x8 lds_tr_frag(LAS const unsigned char* base, int row_stride_bytes, int lane) {
    const int g = lane >> 4, idx = lane & 15, q = idx >> 2, p = idx & 3;
    LAS const unsigned char* a0 = base + (8 * g + q) * row_stride_bytes + 8 * p;
    const s16x4 r0 = __builtin_amdgcn_ds_read_tr16_b64_v4i16((LAS s16x4*)a0);
    const s16x4 r1 = __builtin_amdgcn_ds_read_tr16_b64_v4i16((LAS s16x4*)(a0 + 4 * row_stride_bytes));
    bf16x8 f; f[0] = r0[0]; f[1] = r0[1]; f[2] = r0[2]; f[3] = r0[3]; f[4] = r1[0]; f[5] = r1[1]; f[6] = r1[2]; f[7] = r1[3]; return f;
}
#define WGSYNC() do { asm volatile("s_waitcnt lgkmcnt(0)" ::: "memory"); __builtin_amdgcn_s_barrier(); asm volatile("" ::: "memory"); } while (0)

constexpr int GL_QD = 0, GL_KD = 9216, GL_KT = 18432, GL_V = 27648, GL_ST = 45056, GL_LAST = 63488, GL_RED = 63744, GL_RED2 = 64256;
struct GlaP { const bf16_t* P; const float* LA; const float* gain; const float* bias; bf16_t* O; float* SSEG; float* DSUM; };
__device__ __forceinline__ bf16x8 lds_tr_frag2(LAS const unsigned char* base, int row_stride_bytes, int lane, int mulg, int second_off) {
    const int g = lane >> 4, idx = lane & 15, q = idx >> 2, p = idx & 3;
    LAS const unsigned char* a0 = base + (mulg * g + q) * row_stride_bytes + 8 * p;
    const s16x4 r0 = __builtin_amdgcn_ds_read_tr16_b64_v4i16((LAS s16x4*)a0);
    const s16x4 r1 = __builtin_amdgcn_ds_read_tr16_b64_v4i16((LAS s16x4*)(a0 + second_off * row_stride_bytes));
    bf16x8 f; f[0] = r0[0]; f[1] = r0[1]; f[2] = r0[2]; f[3] = r0[3]; f[4] = r1[0]; f[5] = r1[1]; f[6] = r1[2]; f[7] = r1[3]; return f;
}
__device__ __forceinline__ bf16x8 pack8(const f32x4 a, const f32x4 b) { u32x4 w; w.x = cvt_pk_bf16(a[0], a[1]); w.y = cvt_pk_bf16(a[2], a[3]); w.z = cvt_pk_bf16(b[0], b[1]); w.w = cvt_pk_bf16(b[2], b[3]); return __builtin_bit_cast(bf16x8, w); }

__device__ __forceinline__ bf16x8 lds_tr_frag3(LAS const unsigned char* base, int row_stride_bytes, int lane, int pstride_bytes) {
    const int g = lane >> 4, idx = lane & 15, q = idx >> 2, p = idx & 3;
    LAS const unsigned char* a0 = base + (4 * g + q) * row_stride_bytes + pstride_bytes * p;
    const s16x4 r0 = __builtin_amdgcn_ds_read_tr16_b64_v4i16((LAS s16x4*)a0);
    const s16x4 r1 = __builtin_amdgcn_ds_read_tr16_b64_v4i16((LAS s16x4*)(a0 + 16 * row_stride_bytes));
    bf16x8 f; f[0] = r0[0]; f[1] = r0[1]; f[2] = r0[2]; f[3] = r0[3]; f[4] = r1[0]; f[5] = r1[1]; f[6] = r1[2]; f[7] = r1[3]; return f;
}
template <bool PASSC>
__device__ __forceinline__ void glaret_item(LAS unsigned char* lds, const GlaP& gp, const bool gla, const int b, const int h, const int seg, const int sidx  ) {
    int tid = threadIdx.x; asm volatile("" : "+v"(tid));
    const int w = __builtin_amdgcn_readfirstlane(tid >> 6), l = tid & 63, fr = l & 15, fq = l >> 4;
    const int qoff = gla ? P_GQ : P_RQ, koff = gla ? P_GK : P_RK, voff = gla ? P_GV : P_RV, goff = gla ? P_GG : P_RG, ooff = gla ? 0 : 512;
    const float lg = __logf(1.f - exp2f(-5.f - (float)h));
    f32x4 accs[4];
#pragma unroll
    for (int dt = 0; dt < 4; ++dt) accs[dt] = (f32x4){0.f, 0.f, 0.f, 0.f};
    const int arow = 8 * w + (l >> 3), apart = l & 7;
    float dsum[8];
#pragma unroll
    for (int e = 0; e < 8; ++e) dsum[e] = 0.f;
    if (PASSC) {
        for (int sp = 0; sp < seg; ++sp) {
            const float* sg = gp.SSEG + (size_t)(sidx + sp) * 8192 + tid * 16; const float* dsm = gp.DSUM + (size_t)(sidx + sp) * 64;
#pragma unroll
            for (int dt = 0; dt < 4; ++dt) { const f32x4 dv = *(const f32x4*)(dsm + 16 * dt + 4 * fq), sv = *(const f32x4*)(sg + 4 * dt);
#pragma unroll
                for (int r = 0; r < 4; ++r) accs[dt][r] = accs[dt][r] * __expf(dv[r]) + sv[r]; }
        }
#pragma unroll
        for (int dt = 0; dt < 4; ++dt) { u32x2 wv; wv.x = cvt_pk_bf16(accs[dt][0], accs[dt][1]); wv.y = cvt_pk_bf16(accs[dt][2], accs[dt][3]);
            *(LAS u32x2*)(lds + GL_ST + (16 * w + fr) * 144 + 32 * dt + 8 * fq) = wv; }
    }
    const int it = w & 3, ch = w >> 2;
    f32x4 gnv[4], bsv[4];
#pragma unroll
    for (int ct = 0; ct < 4; ++ct) { const int c = 128 * h + 64 * ch + 16 * fq + 4 * ct; gnv[ct] = PASSC ? *(const f32x4*)(gp.gain + c) : (f32x4){0.f, 0.f, 0.f, 0.f};
        bsv[ct] = (PASSC && !gla) ? *(const f32x4*)(gp.bias + c) : (f32x4){0.f, 0.f, 0.f, 0.f}; }
    u32x4 rq = (u32x4){0u, 0u, 0u, 0u}, rk, rv[2]; f32x4 rla[2], rll[2]; u32x4 gnx[2];
    const float rq_s = __expf((float)(arow + 1) * lg), rk_s = __expf(-(float)(arow + 1) * lg), rt_s = __expf((float)(63 - arow) * lg);
#define GL_ISSUE(n_) do { const size_t r0_ = (size_t)b * SEQ + seg * 512 + (n_) * 64; \
        { const size_t ro_ = (r0_ + arow) * 64 + 8 * apart; if (PASSC) rq = *(const u32x4*)(gp.P + (size_t)(qoff + 64 * h) * TG + ro_); rk = *(const u32x4*)(gp.P + (size_t)(koff + 64 * h) * TG + ro_); \
          if (gla) { const float* lp_ = gp.LA + (size_t)h * TG * 64 + ro_; rla[0] = *(const f32x4*)lp_; rla[1] = *(const f32x4*)(lp_ + 4); const float* ll_ = gp.LA + ((size_t)h * TG + r0_ + 63) * 64 + 8 * apart; rll[0] = *(const f32x4*)ll_; rll[1] = *(const f32x4*)(ll_ + 4); } \
          else { rla[0] = (f32x4){0.f, 0.f, 0.f, 0.f}; rla[1] = rla[0]; rll[0] = rla[0]; rll[1] = rla[0]; } } \
        _Pragma("unroll") for (int e_ = 0; e_ < 2; ++e_) { const int p_ = tid + 512 * e_, i_ = p_ >> 4, part_ = p_ & 15; \
            rv[e_] = *(const u32x4*)(gp.P + (size_t)(voff + 128 * h) * TG + (r0_ + i_) * 128 + 8 * part_); } \
        if (PASSC) { _Pragma("unroll") for (int j_ = 0; j_ < 2; ++j_) gnx[j_] = *(const u32x4*)(gp.P + (size_t)(goff + 128 * h) * TG + (r0_ + 16 * it + fr) * 128 + 64 * ch + 16 * fq + 8 * j_); } } while (0)
    GL_ISSUE(0);
    for (int n = 0; n < 8; ++n) {
        const size_t row0 = (size_t)b * SEQ + seg * 512 + n * 64;
#pragma unroll
        for (int e = 0; e < 2; ++e) { const int p = tid + 512 * e, i = p >> 4, part = p & 15; *(LAS u32x4*)(lds + GL_V + i * 272 + part * 16) = rv[e]; }
        { float cum[8], lastv[8];
          const float kk[8] = {bflo(rk.x), bfhi(rk.x), bflo(rk.y), bfhi(rk.y), bflo(rk.z), bfhi(rk.z), bflo(rk.w), bfhi(rk.w)};
          float eq[8], ek[8], et[8];
          if (gla) {
#pragma unroll
              for (int e = 0; e < 8; ++e) { cum[e] = e < 4 ? rla[0][e] : rla[1][e - 4]; lastv[e] = e < 4 ? rll[0][e] : rll[1][e - 4];
                  eq[e] = __expf(cum[e]); ek[e] = __builtin_amdgcn_rcpf(eq[e]); et[e] = __expf(lastv[e]) * ek[e]; }
          } else {
#pragma unroll
              for (int e = 0; e < 8; ++e) { lastv[e] = 64.f * lg; eq[e] = rq_s; ek[e] = rk_s; et[e] = rt_s; } }
#pragma unroll
          for (int e = 0; e < 8; ++e) *(LAS bf16_t*)(lds + GL_KT + (8 * apart + e) * 144 + arow * 2) = f2bf(kk[e] * et[e]);
          if (PASSC) { const float qq[8] = {bflo(rq.x), bfhi(rq.x), bflo(rq.y), bfhi(rq.y), bflo(rq.z), bfhi(rq.z), bflo(rq.w), bfhi(rq.w)};
              u32x4 qw, kw;
              qw.x = cvt_pk_bf16(qq[0] * eq[0], qq[1] * eq[1]); qw.y = cvt_pk_bf16(qq[2] * eq[2], qq[3] * eq[3]); qw.z = cvt_pk_bf16(qq[4] * eq[4], qq[5] * eq[5]); qw.w = cvt_pk_bf16(qq[6] * eq[6], qq[7] * eq[7]);
              kw.x = cvt_pk_bf16(kk[0] * ek[0], kk[1] * ek[1]); kw.y = cvt_pk_bf16(kk[2] * ek[2], kk[3] * ek[3]); kw.z = cvt_pk_bf16(kk[4] * ek[4], kk[5] * ek[5]); kw.w = cvt_pk_bf16(kk[6] * ek[6], kk[7] * ek[7]);
              *(LAS u32x4*)(lds + GL_QD + arow * 144 + 16 * apart) = qw; *(LAS u32x4*)(lds + GL_KD + arow * 144 + 16 * apart) = kw; }
          if (arow == 63) {
#pragma unroll
              for (int e = 0; e < 8; ++e) *(LAS float*)(lds + GL_LAST + (8 * apart + e) * 4) = lastv[e]; }
#pragma unroll
          for (int e = 0; e < 8; ++e) dsum[e] += lastv[e]; }
        u32x4 gates[2];
        if (PASSC) { gates[0] = gnx[0]; gates[1] = gnx[1]; }
        if (n < 7) GL_ISSUE(n + 1);
        WGSYNC();
        f32x4 acco[4];
        if (PASSC) {
            bf16x8 qf[2];
#pragma unroll
            for (int ks = 0; ks < 2; ++ks) qf[ks] = *(LAS const bf16x8*)(lds + GL_QD + (16 * it + fr) * 144 + 16 * fq + 64 * ks);
            f32x4 sc[4];
#pragma unroll
            for (int jt = 0; jt < 4; ++jt) { sc[jt] = (f32x4){0.f, 0.f, 0.f, 0.f};
                if (jt <= it) {
#pragma unroll
                    for (int ks = 0; ks < 2; ++ks) { const bf16x8 kf = *(LAS const bf16x8*)(lds + GL_KD + (16 * jt + fr) * 144 + 16 * fq + 64 * ks);
                        sc[jt] = __builtin_amdgcn_mfma_f32_16x16x32_bf16(kf, qf[ks], sc[jt], 0, 0, 0); }
                    if (jt == it) {
#pragma unroll
                        for (int r = 0; r < 4; ++r) sc[jt][r] = (4 * fq + r <= fr) ? sc[jt][r] : 0.f; } } }
            const bf16x8 pf0 = pack8(sc[0], sc[1]), pf1 = pack8(sc[2], sc[3]);
#pragma unroll
            for (int ct = 0; ct < 4; ++ct) { const int c0 = 64 * ch + 4 * ct; acco[ct] = (f32x4){0.f, 0.f, 0.f, 0.f};
                { const bf16x8 vf = lds_tr_frag3(lds + GL_V + c0 * 2, 272, l, 32); acco[ct] = __builtin_amdgcn_mfma_f32_16x16x32_bf16(vf, pf0, acco[ct], 0, 0, 0); }
                if (it >= 2) { const bf16x8 vf = lds_tr_frag3(lds + GL_V + 32 * 272 + c0 * 2, 272, l, 32); acco[ct] = __builtin_amdgcn_mfma_f32_16x16x32_bf16(vf, pf1, acco[ct], 0, 0, 0); }
#pragma unroll
                for (int ks = 0; ks < 2; ++ks) { const bf16x8 sf = *(LAS const bf16x8*)(lds + GL_ST + (c0 + 16 * (fr >> 2) + (fr & 3)) * 144 + 16 * fq + 64 * ks);
                    acco[ct] = __builtin_amdgcn_mfma_f32_16x16x32_bf16(sf, qf[ks], acco[ct], 0, 0, 0); } }
        }
#pragma unroll
        for (int dt = 0; dt < 4; ++dt) { const f32x4 lv = *(LAS const f32x4*)(lds + GL_LAST + (16 * dt + 4 * fq) * 4);
#pragma unroll
            for (int r = 0; r < 4; ++r) accs[dt][r] *= __expf(lv[r]); }
#pragma unroll
        for (int ks = 0; ks < 2; ++ks) { const bf16x8 vf = lds_tr_frag2(lds + GL_V + (32 * ks) * 272 + (16 * w) * 2, 272, l, 8, 4);
#pragma unroll
            for (int dt = 0; dt < 4; ++dt) { const bf16x8 kf = *(LAS const bf16x8*)(lds + GL_KT + (16 * dt + fr) * 144 + 16 * fq + 64 * ks);
                accs[dt] = __builtin_amdgcn_mfma_f32_16x16x32_bf16(kf, vf, accs[dt], 0, 0, 0); } }
        if (PASSC) {
            float ss = 0.f, sm_ = 0.f;
#pragma unroll
            for (int ct = 0; ct < 4; ++ct)
#pragma unroll
                for (int r = 0; r < 4; ++r) { ss += acco[ct][r] * acco[ct][r]; sm_ += acco[ct][r]; }
            ss += shfl_xor_f(ss, 16); ss += shfl_xor_f(ss, 32); sm_ += shfl_xor_f(sm_, 16); sm_ += shfl_xor_f(sm_, 32);
            if (fq == 0) { *(LAS float*)(lds + GL_RED + ((16 * it + fr) * 2 + ch) * 4) = ss; *(LAS float*)(lds + GL_RED2 + ((16 * it + fr) * 2 + ch) * 4) = sm_; }
        }
        WGSYNC();
        if (PASSC) {
            const int i = 16 * it + fr;
            const float ssum = *(LAS const float*)(lds + GL_RED + (i * 2) * 4) + *(LAS const float*)(lds + GL_RED + (i * 2 + 1) * 4);
            const float msum = *(LAS const float*)(lds + GL_RED2 + (i * 2) * 4) + *(LAS const float*)(lds + GL_RED2 + (i * 2 + 1) * 4);
            float mean, rstd;
            if (gla) { mean = 0.f; rstd = rsqrtf(ssum * (1.f / 128.f) + NORM_EPS); }
            else { mean = msum * (1.f / 128.f); const float var = fmaxf(ssum * (1.f / 128.f) - mean * mean, 0.f); rstd = rsqrtf(var + NORM_EPS); }
            u32x4 ow[2];
#pragma unroll
            for (int ct = 0; ct < 4; ++ct) { const f32x4 gn = gnv[ct], bs = bsv[ct]; const unsigned gw0 = gates[ct >> 1][(ct & 1) * 2], gw1 = gates[ct >> 1][(ct & 1) * 2 + 1];
                const float g0 = bflo(gw0), g1 = bfhi(gw0), g2 = bflo(gw1), g3 = bfhi(gw1);
                ow[ct >> 1][(ct & 1) * 2] = cvt_pk_bf16(((acco[ct][0] - mean) * rstd * gn[0] + bs[0]) * g0, ((acco[ct][1] - mean) * rstd * gn[1] + bs[1]) * g1);
                ow[ct >> 1][(ct & 1) * 2 + 1] = cvt_pk_bf16(((acco[ct][2] - mean) * rstd * gn[2] + bs[2]) * g2, ((acco[ct][3] - mean) * rstd * gn[3] + bs[3]) * g3); }
#pragma unroll
            for (int j = 0; j < 2; ++j) *(u32x4*)(gp.O + (row0 + i) * OLD + ooff + 128 * h + 64 * ch + 16 * fq + 8 * j) = ow[j];
#pragma unroll
            for (int dt = 0; dt < 4; ++dt) { u32x2 wv; wv.x = cvt_pk_bf16(accs[dt][0], accs[dt][1]); wv.y = cvt_pk_bf16(accs[dt][2], accs[dt][3]);
                *(LAS u32x2*)(lds + GL_ST + (16 * w + fr) * 144 + 32 * dt + 8 * fq) = wv; }
        }
    }
#undef GL_ISSUE
    if (!PASSC) {
        float* sg = gp.SSEG + (size_t)(sidx + seg) * 8192 + tid * 16;
#pragma unroll
        for (int dt = 0; dt < 4; ++dt) *(f32x4*)(sg + 4 * dt) = accs[dt];
        if (tid < 8) {
#pragma unroll
            for (int e = 0; e < 8; ++e) gp.DSUM[(size_t)(sidx + seg) * 64 + 8 * apart + e] = dsum[e]; }
    }
    WGSYNC();
}

constexpr int LR_XC = 0, LR_XCF = 2304, LR_AA = 6400, LR_GG = 10496, LR_WAVE = 14592;
struct LruP { const bf16_t* P; const float* cw; const float* cb; const float* ba; const float* bx; const float* sp8; const bf16_t* lw; bf16_t* O; float* LST; };
template <bool PASSC>
__device__ __forceinline__ void lru_wave(LAS unsigned char* lw_, const LruP& lp, const int b, const int seg, const int n, const int l_) {
    int l = l_; asm volatile("" : "+v"(l));
    const float NL2E = -1.4426950408889634f;
    const int fr = l & 15, fq = l >> 4, ch = 64 * n + l;
    bf16x8 wB[8][2];
#pragma unroll
    for (int jt = 0; jt < 8; ++jt)
#pragma unroll
        for (int ks = 0; ks < 2; ++ks) wB[jt][ks] = *(const bf16x8*)(lp.lw + ((size_t)(n * 128 + 16 * jt + fr)) * 64 + 8 * fq + 32 * ks);
    const float w0 = lp.cw[ch], w1 = lp.cw[512 + ch], w2 = lp.cw[1024 + ch], w3 = lp.cw[1536 + ch], cbv = lp.cb[ch];
    float bav[4], bxv[4], spv[4];
#pragma unroll
    for (int jt = 0; jt < 4; ++jt) { const int c2 = 64 * n + 16 * jt + fr; bav[jt] = lp.ba[c2] * NL2E; bxv[jt] = lp.bx[c2] * NL2E; spv[jt] = lp.sp8[c2] * NL2E; }
    const size_t rowb = (size_t)b * SEQ + seg * 128;
    const bf16_t* px = lp.P + (size_t)(P_LX + 64 * n) * TG + rowb * 64;
    const bf16_t* pg = lp.P + (size_t)(P_LG + 64 * n) * TG + rowb * 64;
    bf16_t* po = lp.O + rowb * OLD + 1024 + 64 * n;
    float xm3 = 0.f, xm2 = 0.f, xm1 = 0.f;
    if (seg > 0) { xm3 = bf2f(px[l - 3 * 64]); xm2 = bf2f(px[l - 2 * 64]); xm1 = bf2f(px[l - 64]); }
    float hst = 0.f, ap = 1.f;
    if (PASSC) { const float* st = lp.LST + ((size_t)b * NSEGL * 512 + ch) * 2;
        pg8::f32x2_ ah[31];
#pragma unroll
        for (int e = 0; e < 31; ++e) { const int sp = e < seg ? e : 0; ah[e] = *(const pg8::f32x2_*)(st + (size_t)sp * 1024); }
#pragma unroll
        for (int e = 0; e < 31; ++e) if (e < seg) hst = ah[e][0] * hst + ah[e][1]; }
#define LR_ROWLD(dst, base, t) do { dst = (base)[(t) * 64 + l]; } while (0)
    bf16_t xn[16], gn[16];
#pragma unroll
    for (int t = 0; t < 16; ++t) LR_ROWLD(xn[t], px, t);
    for (int sb = 0; sb < 8; ++sb) {
        float xc[16];
        if (PASSC) {
#pragma unroll
            for (int t = 0; t < 16; ++t) LR_ROWLD(gn[t], pg, sb * 16 + t); }
#pragma unroll
        for (int t = 0; t < 16; ++t) { const float x0 = bf2f(xn[t]); xc[t] = cbv + w0 * xm3 + w1 * xm2 + w2 * xm1 + w3 * x0; xm3 = xm2; xm2 = xm1; xm1 = x0;
            *(LAS bf16_t*)(lw_ + LR_XC + t * 144 + l * 2) = f2bf(xc[t]); }
        if (sb < 7) {
#pragma unroll
            for (int t = 0; t < 16; ++t) LR_ROWLD(xn[t], px, (sb + 1) * 16 + t); }
        __builtin_amdgcn_wave_barrier();
        f32x4 acc[8];
#pragma unroll
        for (int jt = 0; jt < 8; ++jt) { const float bz = jt < 4 ? bav[jt] : bxv[jt - 4]; acc[jt] = (f32x4){bz, bz, bz, bz}; }
#pragma unroll
        for (int ks = 0; ks < 2; ++ks) { const bf16x8 af = *(LAS const bf16x8*)(lw_ + LR_XC + fr * 144 + 16 * fq + 64 * ks);
#pragma unroll
            for (int jt = 0; jt < 8; ++jt) acc[jt] = __builtin_amdgcn_mfma_f32_16x16x32_bf16(af, wB[jt][ks], acc[jt], 0, 0, 0); }
#pragma unroll
        for (int jt = 0; jt < 4; ++jt)
#pragma unroll
            for (int r = 0; r < 4; ++r) { const int tok = 4 * fq + r, j = 16 * jt + fr;
                const float rg = __builtin_amdgcn_rcpf(1.f + __builtin_amdgcn_exp2f(acc[jt][r])), ig = __builtin_amdgcn_rcpf(1.f + __builtin_amdgcn_exp2f(acc[4 + jt][r]));
                const float av = __builtin_amdgcn_exp2f(rg * spv[jt]);
                *(LAS float*)(lw_ + LR_AA + tok * 256 + j * 4) = av; const float em = fmaf(-av, av, 1.f);
                *(LAS float*)(lw_ + LR_GG + tok * 256 + j * 4) = ig * __builtin_amdgcn_sqrtf(em); }
        __builtin_amdgcn_wave_barrier();
#pragma unroll
        for (int t = 0; t < 16; ++t) { const float av = *(LAS const float*)(lw_ + LR_AA + t * 256 + l * 4), gv = *(LAS const float*)(lw_ + LR_GG + t * 256 + l * 4);
            hst = av * hst + gv * xc[t]; ap *= av;
            if (PASSC) { bf16_t* p_ = po + (size_t)(sb * 16 + t) * OLD; asm volatile("" : "+s"(p_)); p_[l] = f2bf(hst * bf2f(gn[t])); } }
        __builtin_amdgcn_wave_barrier();
    }
#undef LR_ROWLD
    if (!PASSC) { float* st = lp.LST + (((size_t)b * NSEGL + seg) * 512 + ch) * 2; st[0] = ap; st[1] = hst; }
}

constexpr int S5_MG = 0, S5_MC = 32768, S5_MM = 65536, S5_MEND = 86016, S5W_STRIDE = 8448;
struct S5P { const bf16_t* P; const bf16_t* SU; const float* sm; const unsigned char* s5m; const float* a128; const float* dd; bf16_t* Y5; float* SST; };
__device__ __forceinline__ float gelu_t(float x) { const float t = x * __builtin_fmaf(x * x, -0.10294324f, -2.3022082f);
    return x * __builtin_amdgcn_rcpf(1.f + __builtin_amdgcn_exp2f(t)); }
template <bool PASSC>
__device__ __forceinline__ void s5_wave(LAS unsigned char* lds, LAS unsigned char* lw_, const S5P& sp_, const int b, const int seg, const int g, const int l_) {
    int l = l_; asm volatile("" : "+v"(l));
    const int fr = l & 15, fq = l >> 4;
    const float a8r = sp_.sm[SM_A8 + (g * 64 + l) * 2], a8i = sp_.sm[SM_A8 + (g * 64 + l) * 2 + 1];
    float xr = 0.f, xi = 0.f;
    f32x4 dv4 = (f32x4){0.f, 0.f, 0.f, 0.f};
    if (PASSC) {
        const float ar = sp_.a128[(g * 64 + l) * 2], ai = sp_.a128[(g * 64 + l) * 2 + 1];
        const float* st = sp_.SST + ((size_t)b * NSEGS * 32 + g) * 128 + l;
        for (int sp0 = 0; sp0 < seg; sp0 += 8) { float er[8], ei[8];
#pragma unroll
            for (int e = 0; e < 8; ++e) { const int sp = sp0 + e < seg ? sp0 + e : seg - 1; er[e] = st[(size_t)sp * 4096]; ei[e] = st[(size_t)sp * 4096 + 64]; }
#pragma unroll
            for (int e = 0; e < 8; ++e) if (sp0 + e < seg) { const float nr = ar * xr - ai * xi + er[e], ni = ar * xi + ai * xr + ei[e]; xr = nr; xi = ni; } }
        dv4 = *(const f32x4*)(sp_.dd + 16 * g + 4 * fq);
    }
    const size_t rowb = (size_t)b * SEQ + seg * 512;
    bf16x8 ufn[4];
#pragma unroll
    for (int ks = 0; ks < 4; ++ks) ufn[ks] = *(const bf16x8*)(sp_.SU + ((size_t)g * TG + rowb + 8 * fr + 2 * ks + (fq >> 1)) * 16 + 8 * (fq & 1));
    for (int sup = 0; sup < 4; ++sup) {
        const size_t r0 = rowb + sup * 128;
        bf16x8 uf[4];
#pragma unroll
        for (int ks = 0; ks < 4; ++ks) uf[ks] = ufn[ks];
        if (sup < 3) {
#pragma unroll
            for (int ks = 0; ks < 4; ++ks) ufn[ks] = *(const bf16x8*)(sp_.SU + ((size_t)g * TG + r0 + 128 + 8 * fr + 2 * ks + (fq >> 1)) * 16 + 8 * (fq & 1)); }
        u32x2 us[8];
        if (PASSC) {
#pragma unroll
            for (int mt = 0; mt < 8; ++mt) us[mt] = *(const u32x2*)(sp_.SU + ((size_t)g * TG + r0 + 8 * fr + mt) * 16 + 4 * fq); }
#pragma unroll
        for (int mt = 0; mt < 8; ++mt) { f32x4 ga = (f32x4){0.f, 0.f, 0.f, 0.f};
#pragma unroll
            for (int ks = 0; ks < 4; ++ks) ga = __builtin_amdgcn_mfma_f32_16x16x32_bf16(*(LAS const bf16x8*)(lds + S5_MG + ((mt * 4 + ks) * 64 + l) * 16), uf[ks], ga, 0, 0, 0);
            *(LAS f32x4*)(lw_ + fr * 528 + (16 * mt + 4 * fq) * 4) = ga; }
        __builtin_amdgcn_wave_barrier();
        pg8::f32x2_ gv[16];
#pragma unroll
        for (int t = 0; t < 16; ++t) gv[t] = *(LAS const pg8::f32x2_*)(lw_ + t * 528 + l * 8);
        __builtin_amdgcn_wave_barrier();
#pragma unroll
        for (int t = 0; t < 16; ++t) {
            if (PASSC) *(LAS unsigned*)(lw_ + t * 528 + l * 4) = cvt_pk_bf16(xr, xi);
            const float nr = __builtin_fmaf(a8r, xr, __builtin_fmaf(-a8i, xi, gv[t][0])), ni = __builtin_fmaf(a8r, xi, __builtin_fmaf(a8i, xr, gv[t][1])); xr = nr; xi = ni; }
        if (PASSC) {
            __builtin_amdgcn_wave_barrier();
            bf16x8 xf[4];
#pragma unroll
            for (int ks = 0; ks < 4; ++ks) xf[ks] = *(LAS const bf16x8*)(lw_ + fr * 528 + (32 * ks + 8 * fq) * 2);
#pragma unroll
            for (int mt = 0; mt < 8; ++mt) { f32x4 ya = (f32x4){0.f, 0.f, 0.f, 0.f}; const int cb = mt < 1 ? 0 : mt < 2 ? 1 : mt < 3 ? 2 : mt < 4 ? 4 : mt < 5 ? 6 : mt < 6 ? 9 : mt < 7 ? 12 : 16;
#pragma unroll
                for (int ks = 0; ks < 4; ++ks) if (2 * ks <= mt) ya = __builtin_amdgcn_mfma_f32_16x16x32_bf16(*(LAS const bf16x8*)(lds + S5_MM + ((cb + ks) * 64 + l) * 16), uf[ks], ya, 0, 0, 0);
#pragma unroll
                for (int ks = 0; ks < 4; ++ks) ya = __builtin_amdgcn_mfma_f32_16x16x32_bf16(*(LAS const bf16x8*)(lds + S5_MC + ((mt * 4 + ks) * 64 + l) * 16), xf[ks], ya, 0, 0, 0);
                u32x2 yw; yw.x = cvt_pk_bf16(gelu_t(ya[0] + dv4[0] * bflo(us[mt].x)), gelu_t(ya[1] + dv4[1] * bfhi(us[mt].x))); yw.y = cvt_pk_bf16(gelu_t(ya[2] + dv4[2] * bflo(us[mt].y)), gelu_t(ya[3] + dv4[3] * bfhi(us[mt].y)));
                *(u32x2*)(sp_.Y5 + (r0 + 8 * fr + mt) * BW + 16 * g + 4 * fq) = yw; }
        }
        __builtin_amdgcn_wave_barrier();
    }
    if (!PASSC) { float* st = sp_.SST + (((size_t)b * NSEGS + seg) * 32 + g) * 128 + l; st[0] = xr; st[64] = xi; }
}

template <bool PASSC>
__device__ __forceinline__ void phase_mixers(LAS unsigned char* lds, const Args& a, const int l, const int G) {
    const int mmask = a.mmask;
    unsigned char* ws = a.ws; const float* sm = (const float*)(ws + WS_SMALL + (size_t)l * SMALL_STRIDE);
    const bf16_t* P = (const bf16_t*)(ws + WS_P); float* ST = (float*)(ws + WS_ST);
    if (mmask & 1) { GlaP gp0{P, (const float*)(ws + WS_LA), a.in[I_GNG] + l * 512, nullptr, (bf16_t*)(ws + WS_O), ST + ST_GSEG, ST + ST_GDS};
      GlaP gp1{P, (const float*)(ws + WS_LA), a.in[I_RNG] + l * 512, a.in[I_RNB] + l * 512, (bf16_t*)(ws + WS_O), ST + ST_GSEG, ST + ST_GDS};
      for (int itx = blockIdx.x; itx < 2 * BG * 4 * NSEGG; itx += G) { const int mix = itx / (BG * 4 * NSEGG), rest = itx % (BG * 4 * NSEGG), b = rest / (4 * NSEGG), h = (rest / NSEGG) & 3, seg = rest % NSEGG;
          const int sidx = ((mix * BG + b) * 4 + h) * NSEGG;
          if (!PASSC && seg == NSEGG - 1) continue;
          if (mix == 0) glaret_item<PASSC>(lds, gp0, true, b, h, seg, sidx); else glaret_item<PASSC>(lds, gp1, false, b, h, seg, sidx); } }
    int tid = threadIdx.x; asm volatile("" : "+v"(tid));
    const int w = __builtin_amdgcn_readfirstlane(tid >> 6), ln = tid & 63;
    if (mmask & 2) { LruP lp{P, a.in[I_LCW] + l * 2048, a.in[I_LCB] + l * 512, a.in[I_LBA] + l * 512, a.in[I_LBX] + l * 512, sm + SM_SP8, (const bf16_t*)((const unsigned char*)sm + SM_LRUW_BYTES), (bf16_t*)(ws + WS_O), ST + ST_LRU};
      for (int itx = blockIdx.x; itx < BG * NSEGL; itx += G) { if (!PASSC && itx % NSEGL == NSEGL - 1) continue; lru_wave<PASSC>(lds + w * LR_WAVE, lp, itx / NSEGL, itx % NSEGL, w, ln); } }
    if (mmask & 4) { S5P sp_{P, (const bf16_t*)(ws + WS_SU2), sm, ws + WS_S5M + (size_t)l * 32 * S5M_BYTES, sm + SM_A128, a.in[I_SD] + l * 512, (bf16_t*)(ws + WS_Y5), ST + ST_S5};
      for (int itx = blockIdx.x; itx < 32 * 8; itx += G) { const int g = 4 * (itx & 7) + ((itx >> 3) & 3), q = (itx >> 5) * 8 + w;
          WGSYNC();
          { const unsigned char* src = sp_.s5m + (size_t)g * S5M_BYTES; const int nb = PASSC ? S5_MEND : S5_MC;
            for (int o = tid * 16; o < nb; o += 8192) *(LAS u32x4*)(lds + o) = *(const u32x4*)(src + o); }
          WGSYNC();
          if (PASSC || (q & 7) != NSEGS - 1) s5_wave<PASSC>(lds, lds + S5_MEND + w * S5W_STRIDE, sp_, q >> 3, q & 7, g, ln); } }
    WGSYNC();
}

constexpr int NPH = 8, NSTEPS = 1 + NGRP * DEPTH * NPH;
constexpr int LDS_BYTES = 163840, LDS_MISC = 163840 - 512;
static_assert(S5_MEND + 8 * S5W_STRIDE <= LDS_MISC, "S5 LDS");

__global__ void __launch_bounds__(512, 2) mk_fwd(Args a) {
    __shared__ __attribute__((aligned(16))) unsigned char lds_raw[LDS_BYTES];
    LAS unsigned char* lds = (LAS unsigned char*)lds_raw;
    volatile LAS unsigned* MISC = (volatile LAS unsigned*)(lds + LDS_MISC);
    const int G = gridDim.x;
    if (threadIdx.x < 32) MISC[threadIdx.x] = 0u;
    wg_syncthreads();
    unsigned* ctl = (unsigned*)(a.ws + WS_CTL);
    XcdBarrier bar = xcd_barrier_post(ctl + CW_BAR + a.li * XCD_BAR_WORDS, MISC + 8);
    const int ngw = G * 8, gthreads = G * 512;
#define LTID(v) int v = threadIdx.x; asm volatile("" : "+v"(v))
#define IN(s) (a.s_lo <= (s) && (s) < a.s_hi)
#define SEAM(s) do { if ((s) + 1 < a.s_hi) xcd_barrier(bar); } while (0)
    if (IN(0)) { LTID(t_); phase_prologue(lds, a, blockIdx.x * 512 + t_, gthreads); xcd_barrier(bar); phase_prologue2(a, blockIdx.x * 512 + t_, gthreads); xcd_barrier(bar); phase_prologue3(a, blockIdx.x * 512 + t_, gthreads); SEAM(0); }
    for (int gl = 0; gl < NGRP * DEPTH; ++gl) {
        const int grp = gl >> 2, l = gl & 3, s0 = 1 + gl * NPH;
        if (a.s_hi <= s0 || a.s_lo >= s0 + NPH) continue;
        unsigned char* ws = a.ws;
        const bf16_t* Wl = (const bf16_t*)(ws + WS_W + (size_t)l * W_STRIDE);
        const float* sm = (const float*)(ws + WS_SMALL + (size_t)l * SMALL_STRIDE);
        bf16_t* U = (bf16_t*)(ws + WS_U); bf16_t* P = (bf16_t*)(ws + WS_P); float* LA = (float*)(ws + WS_LA);
        bf16_t* O = (bf16_t*)(ws + WS_O); bf16_t* Y5 = (bf16_t*)(ws + WS_Y5); unsigned char* PGb = ws + WS_PG;
        const float* xg = a.in[I_X] + (size_t)grp * TG * D; float* og = a.out + (size_t)grp * TG * D;
        const float* hin = (l <= 1) ? xg : og;
        bf16_t* DLT = (bf16_t*)(ws + WS_O);
        (void)sm;
        if (IN(s0 + 0)) { LTID(t_); const int gw_ = blockIdx.x * 8 + __builtin_amdgcn_readfirstlane(t_ >> 6);
            if (l == 0) phase_norm<false, false>(hin, DLT, og, a.in[I_NG] + l * D, U, gw_, ngw, t_ & 63); else phase_norm<false, true>(hin, DLT, og, a.in[I_NG] + l * D, U, gw_, ngw, t_ & 63);
            SEAM(s0 + 0); }
        if (IN(s0 + 1)) {
            pg8::Gemm g{U, Wl, TG, N_ALL, D, D, D, 0, 0}; pg8::StaticOrder S; S.init(TG, N_ALL, G, (int)blockIdx.x, 0, 256, WGM_G1);
            EpiIn E{P, LA, a.in[I_GBLR] + l * 256, (const float*)(ws + WS_ROT), PGb, (bf16_t*)(ws + WS_SU2)};
            GEMM_CALL(EpiIn);
            SEAM(s0 + 1);
        }
        if (IN(s0 + 2)) { phase_mixers<false>(lds, a, l, G); SEAM(s0 + 2); }
        if (IN(s0 + 3)) { phase_mixers<true>(lds, a, l, G); SEAM(s0 + 3); }
        if (IN(s0 + 4)) {
            { pg8::Gemm g{Y5, (const bf16_t*)((const unsigned char*)Wl + WO_GLU), TG, BW, BW, BW, BW, 0, 0}; pg8::StaticOrder S; S.init(TG, BW, G, (int)blockIdx.x, 0, 256, WGM_GLU);
              EpiGlu E{Y5, P, a.in[I_SGB] + l * BW, O};
              GEMM_CALL(EpiGlu); }
            SEAM(s0 + 4);
        }
        if (IN(s0 + 6)) {
            { pg8::Gemm g{O, (const bf16_t*)((const unsigned char*)Wl + WO_BR), TG, D, BW, OLD, BW, (size_t)BW * 2, (size_t)D * BW * 2}; pg8::StaticOrder S; S.init(TG, D, G, (int)blockIdx.x, 2, 128, WGM_G2);
              EpiBr E{PGb, U};
              pg8::gemm_phase<EpiBr, pg8::StaticOrder, true, true, true>(lds, g, S, E); }
            SEAM(s0 + 6);
        }
        if (IN(s0 + 7)) {
            if (a.fin != 2) { pg8::Gemm g{U, (const bf16_t*)((const unsigned char*)Wl + WO_OUT), TG, D, D, D, D, 0, 0}; pg8::StaticOrder S; S.init(TG, D, G, (int)blockIdx.x, 0, 256, WGM_G3);
              EpiOut E{DLT};
              GEMM_CALL(EpiOut); }
            if (l == 3 && a.fin) { if (a.fin == 1) xcd_barrier(bar); LTID(t_); phase_norm<true, true>(og, DLT, og, a.in[I_FNG], U, blockIdx.x * 8 + __builtin_amdgcn_readfirstlane(t_ >> 6), ngw, t_ & 63); }
            SEAM(s0 + 7);
        }
    }
#undef IN
#undef SEAM
}

extern "C" void kernel_launch(void* const* d_in, const int* in_sizes, int n_in, void* d_out, int out_size, void* d_ws, size_t ws_size, hipStream_t stream) {
    static int grid = 0;
    if (grid == 0) {
        static const int exp_sizes[29] = {67108864, 4096, 21037056, 16384, 1024, 2048, 2048, 2048, 8192, 2048, 131072, 2048, 131072, 2048, 2048, 8192, 8192, 131072, 131072, 131072, 131072, 2048, 128, 1048576, 2048, 16777216, 8388608, 4194304, 1024};
        bool ok_sizes = (n_in == 29); if (ok_sizes) for (int i = 0; i < 29; ++i) if (in_sizes[i] != exp_sizes[i]) { fprintf(stderr, "kernel_launch: input %d has %d elements, expected %d\n", i, in_sizes[i], exp_sizes[i]); ok_sizes = false; }
        if (!ok_sizes || out_size != NB * SEQ * D || ws_size < WS_END) { fprintf(stderr, "kernel_launch: unexpected shapes (n_in %d out %d ws %zu)\n", n_in, out_size, ws_size); grid = -1; return; }
        int dev = 0, cus = 0, per_cu = 0;
        hipGetDevice(&dev); hipDeviceGetAttribute(&cus, hipDeviceAttributeMultiprocessorCount, dev);
        hipOccupancyMaxActiveBlocksPerMultiprocessor(&per_cu, (const void*)mk_fwd, 512, 0);
        (void)hipGetLastError();
        grid = cus > 0 ? cus : 256;
        if (per_cu < 1) fprintf(stderr, "kernel_launch: occupancy query says %d\n", per_cu);
    }
    if (grid < 0) return;
    hipMemsetAsync((char*)d_ws + WS_CTL, 0, CTL_BYTES, stream);
    Args a{};
    for (int i = 0; i < 29; ++i) a.in[i] = (const float*)d_in[i];
    a.out = (float*)d_out; a.ws = (unsigned char*)d_ws;
    unsigned char* ws = (unsigned char*)d_ws;
    int li = 0;
    auto run = [&](int lo, int hi, int fin = 1, int mm = 7) { a.s_lo = lo; a.s_hi = hi; a.li = li++; a.fin = fin; a.mmask = mm; a.pad2 = 0; hipLaunchKernelGGL(mk_fwd, dim3(grid), dim3(512), 0, stream, a); };
    run(0, NSTEPS);
}
#if defined(__HIP_DEVICE_COMPILE__)
#pragma clang attribute pop
#endif
```

```cpp
#include <hip/hip_runtime.h>
#ifndef WGM_G1
#define WGM_G1 4
#endif
#ifndef WGM_G2
#define WGM_G2 8
#endif
#ifndef WGM_G3
#define WGM_G3 8
#endif
#ifndef WGM_GLU
#define WGM_GLU 8
#endif
#include <cstdio>
#include <cstdint>
#if defined(__HIP_DEVICE_COMPILE__)
#pragma clang attribute push(__attribute__((target("no-packed-fp32-ops"))), apply_to = function)
#endif


namespace pg8 {
#define PG8_LAS __attribute__((address_space(3)))
typedef unsigned short bf16_t;
typedef short bf16x8 __attribute__((ext_vector_type(8)));
typedef float f32x4 __attribute__((ext_vector_type(4)));
typedef unsigned u32x4 __attribute__((ext_vector_type(4)));
typedef unsigned u32x2 __attribute__((ext_vector_type(2)));
constexpr int BM = 256, BK = 64, HALF = 128, HTB = HALF * BK * 2, STAGE_BYTES = 8 * HTB, NXCD = 8;

__host__ __device__ __forceinline__ int lds_byte(int r, int c) { const int st = (r >> 4) * 2 + (c >> 5), rr = r & 15, cc = c & 31, ob = rr * 64 + cc * 2; return st * 1024 + (ob ^ (((ob >> 9) & 1) << 5)); }
__host__ __device__ __forceinline__ void stage_rc(int b, int& R, int& C) { const int st = b / 1024, sb = b % 1024, swz = sb ^ (((sb >> 9) & 1) << 5); R = (st >> 1) * 16 + swz / 64; C = (st & 1) * 32 + (swz % 64) / 2; }
__host__ __device__ __forceinline__ int perm32(int rho) { const int n = rho >> 4, i = rho & 15; return 8 * (i >> 2) + 4 * n + (i & 3); }

struct Unit { int pm, pn, z; };
struct Gemm { const bf16_t* A; const bf16_t* Bt; int M, N, K, lda, ldb; size_t zA, zB; };

struct StaticOrder {
    int nM, nN, nwg, G, c, zsh, WGM;
    __host__ __device__ void init(int M, int N, int G_, int c_, int zsh_ = 0, int bn_ = BM, int wgm_ = 4) { nM = M / BM; nN = N / bn_; nwg = nM * nN; G = G_; c = c_; zsh = zsh_; WGM = wgm_; }
    __host__ __device__ bool next(int i, Unit& u) const {
        const int ti = i >> zsh; u.z = i & ((1 << zsh) - 1);
        const long L = (long)ti * G + c; if (L >= nwg) return false;
        int wgid = (int)L; { const int q = nwg / NXCD, r = nwg % NXCD, xcd = wgid % NXCD, off = wgid / NXCD; wgid = (xcd < r ? xcd * (q + 1) : r * (q + 1) + (xcd - r) * q) + off; }
        const int nig = WGM * nN, gid = wgid / nig, fm = gid * WGM, gsz = (nM - fm) < WGM ? (nM - fm) : WGM;
        u.pm = fm + ((wgid % nig) % gsz); u.pn = (wgid % nig) / gsz; return true;
    }
    __device__ __forceinline__ void a_ready(const Unit&) const {}
    __device__ __forceinline__ void done(const Unit&) const {}
};

typedef float f32x2_ __attribute__((ext_vector_type(2)));
typedef __bf16 bf16x2_ __attribute__((ext_vector_type(2)));
__device__ __forceinline__ unsigned cvt_pk_bf16(float lo, float hi) { const f32x2_ v = {lo, hi}; const bf16x2_ b = __builtin_convertvector(v, bf16x2_); return __builtin_bit_cast(unsigned, b); }

template <class Epi, class Sched, bool ALIGN_EPI = false, bool SP2 = false, bool HALFN = false>
__device__ __forceinline__ void gemm_phase(PG8_LAS unsigned char* lds, const Gemm g, const Sched& S, const Epi& E) {
    int tid = threadIdx.x; asm volatile("" : "+v"(tid));
    const int wid = __builtin_amdgcn_readfirstlane(tid >> 6), lane = tid & 63, wr = wid >> 2, wc = wid & 3, fr = lane & 15, fq = lane >> 4;
    const int K = g.K, nt = K / BK;
    unsigned voffA[2], voffB[2];
#pragma unroll
    for (int i = 0; i < 2; ++i) { int R, C; stage_rc(tid * 16 + i * 8192, R, C); const int Rb = Epi::PERM ? ((R & ~31) + perm32(R & 31)) : R;
        voffA[i] = (unsigned)(R * g.lda + C) * 2u; voffB[i] = (unsigned)(Rb * g.ldb + C) * 2u; }
    const size_t kstep = (size_t)(BK * 2);
    const size_t hstepA = (size_t)HALF * g.lda * 2, hstepB = (size_t)HALF * g.ldb * 2;
    const size_t tstepA = 2 * hstepA, tstepB = HALFN ? hstepB : 2 * hstepB;
    const unsigned ldsw = (unsigned)wid * 1024u;
    unsigned aoff = (unsigned)lds_byte(wr * 64 + fr, fq * 8), boff = (unsigned)lds_byte(wc * 32 + fr, fq * 8) + 4u * HTB;
    asm volatile("" : "+v"(aoff), "+v"(boff));
#define PG8_SA(b, h) (((b) * 2 + (h)) * HTB)
#define PG8_SB(b, h) ((4 + (b) * 2 + (h)) * HTB)
#define PG8_STAGE(bufoff, gbase, voff) do { _Pragma("unroll") for (int _i = 0; _i < 2; ++_i) \
        __builtin_amdgcn_global_load_lds((const unsigned*)((const char*)(gbase) + (voff)[_i]), (PG8_LAS unsigned*)(lds + (bufoff) + ldsw + _i * 8192), 16, 0, 0); } while (0)
#define PG8_LDA(dst, b, h) do { _Pragma("unroll") for (int m = 0; m < 4; ++m) _Pragma("unroll") for (int k = 0; k < 2; ++k) dst[m][k] = *(const PG8_LAS bf16x8*)(lds + aoff + (PG8_SA(b, h) + m * 2048 + k * 1024)); } while (0)
#define PG8_LDB(dst, b, h) do { _Pragma("unroll") for (int n = 0; n < 2; ++n) _Pragma("unroll") for (int k = 0; k < 2; ++k) dst[n][k] = *(const PG8_LAS bf16x8*)(lds + boff + (((b) * 2 + (h)) * HTB + n * 2048 + k * 1024)); } while (0)
#define PG8_MMA(ai, bj, At, Bt) do { __builtin_amdgcn_s_setprio(1); _Pragma("unroll") for (int m = 0; m < 4; ++m) _Pragma("unroll") for (int n = 0; n < 2; ++n) _Pragma("unroll") for (int k = 0; k < 2; ++k) \
        acc[ai][bj][m][n] = __builtin_amdgcn_mfma_f32_16x16x32_bf16(Bt[n][k], At[m][k], acc[ai][bj][m][n], 0, 0, 0); __builtin_amdgcn_s_setprio(0); } while (0)
#define PG8_WAIT_V(n) asm volatile("s_waitcnt vmcnt(" #n ")" ::: "memory")
#define PG8_WAIT_L(n) asm volatile("s_waitcnt lgkmcnt(" #n ")" ::: "memory")
#define PG8_BAR __builtin_amdgcn_s_barrier()
#define PG8_SCHED __builtin_amdgcn_sched_barrier(0)
    Unit cur, nxt; int ui = 0;
    if (!S.next(0, cur)) return;
    f32x4 acc[2][2][4][2];
#pragma unroll
    for (int a = 0; a < 2; ++a)
#pragma unroll
        for (int b = 0; b < 2; ++b)
#pragma unroll
            for (int m = 0; m < 4; ++m)
#pragma unroll
                for (int n = 0; n < 2; ++n) acc[a][b][m][n] = (f32x4){0.f, 0.f, 0.f, 0.f};
    bf16x8 At[4][2], B0[2][2], B1[2][2];
    const char* cA = (const char*)g.A + (size_t)cur.pm * tstepA + (size_t)cur.z * g.zA; const char* cB = (const char*)g.Bt + (size_t)cur.pn * tstepB + (size_t)cur.z * g.zB;
    S.a_ready(cur);
    if constexpr (SP2 && HALFN) {
        PG8_STAGE(PG8_SB(0, 0), cB, voffB); PG8_STAGE(PG8_SA(0, 0), cA, voffA); PG8_STAGE(PG8_SA(0, 1), cA + hstepA, voffA);
        if (wr == 1) PG8_BAR;
        PG8_WAIT_V(2); PG8_BAR;
        PG8_STAGE(PG8_SB(1, 0), cB + kstep, voffB); PG8_STAGE(PG8_SA(1, 0), cA + kstep, voffA);
        PG8_WAIT_V(4); PG8_BAR;
    } else if constexpr (SP2) {
        PG8_STAGE(PG8_SB(0, 0), cB, voffB); PG8_STAGE(PG8_SB(0, 1), cB + hstepB, voffB); PG8_STAGE(PG8_SA(0, 0), cA, voffA); PG8_STAGE(PG8_SA(0, 1), cA + hstepA, voffA);
        if (wr == 1) PG8_BAR;
        PG8_WAIT_V(2); PG8_BAR;
        PG8_STAGE(PG8_SB(1, 0), cB + kstep, voffB); PG8_STAGE(PG8_SA(1, 0), cA + kstep, voffA); PG8_STAGE(PG8_SB(1, 1), cB + hstepB + kstep, voffB);
        PG8_WAIT_V(6); PG8_BAR;
    } else {
        PG8_STAGE(PG8_SB(0, 0), cB, voffB); PG8_STAGE(PG8_SA(0, 0), cA, voffA); PG8_STAGE(PG8_SB(0, 1), cB + hstepB, voffB); PG8_STAGE(PG8_SA(0, 1), cA + hstepA, voffA);
        if (wr == 1) PG8_BAR;
        PG8_WAIT_V(4); PG8_BAR;
        PG8_STAGE(PG8_SB(1, 0), cB + kstep, voffB); PG8_STAGE(PG8_SA(1, 0), cA + kstep, voffA); PG8_STAGE(PG8_SB(1, 1), cB + hstepB + kstep, voffB);
        PG8_WAIT_V(6); PG8_BAR;
    }
    for (;;) {
        const bool has_next = S.next(ui + 1, nxt);
        const char* nA = has_next ? (const char*)g.A + (size_t)nxt.pm * tstepA + (size_t)nxt.z * g.zA : cA; const char* nB = has_next ? (const char*)g.Bt + (size_t)nxt.pn * tstepB + (size_t)nxt.z * g.zB : cB;
        for (int t = 0; t < nt; t += 2) {
            const bool last = (t == nt - 2);
            const char* a1 = cA + (size_t)(t + 1) * kstep;
            const char* a2 = last ? nA : cA + (size_t)(t + 2) * kstep; const char* b2 = last ? nB : cB + (size_t)(t + 2) * kstep;
            const char* a3 = a2 + kstep; const char* b3 = b2 + kstep;
            if (last && has_next) S.a_ready(nxt);
            if constexpr (SP2 && HALFN) {
            PG8_LDB(B0, 0, 0); PG8_SCHED; PG8_LDA(At, 0, 0); PG8_STAGE(PG8_SA(1, 1), a1 + hstepA, voffA);
            PG8_WAIT_V(6); PG8_WAIT_L(0); PG8_BAR; PG8_MMA(0, 0, At, B0); PG8_BAR; PG8_SCHED;
            PG8_LDA(At, 0, 1); PG8_STAGE(PG8_SB(0, 0), b2, voffB); PG8_STAGE(PG8_SA(0, 0), a2, voffA);
            PG8_WAIT_V(6); PG8_WAIT_L(0); PG8_BAR; PG8_MMA(1, 0, At, B0); PG8_BAR; PG8_SCHED;
            PG8_LDB(B0, 1, 0); PG8_SCHED; PG8_LDA(At, 1, 0); PG8_STAGE(PG8_SA(0, 1), a2 + hstepA, voffA);
            PG8_WAIT_V(6); PG8_WAIT_L(0); PG8_BAR; PG8_MMA(0, 0, At, B0); PG8_BAR; PG8_SCHED;
            PG8_LDA(At, 1, 1); PG8_STAGE(PG8_SB(1, 0), b3, voffB); PG8_STAGE(PG8_SA(1, 0), a3, voffA);
            PG8_WAIT_V(6); PG8_WAIT_L(0); PG8_BAR; PG8_MMA(1, 0, At, B0); PG8_BAR; PG8_SCHED;
            } else if constexpr (SP2) {
            PG8_LDB(B0, 0, 0); PG8_LDB(B1, 0, 1); PG8_SCHED; PG8_LDA(At, 0, 0); PG8_STAGE(PG8_SA(1, 1), a1 + hstepA, voffA);
            PG8_WAIT_V(8); PG8_WAIT_L(0); PG8_BAR; PG8_MMA(0, 0, At, B0); PG8_MMA(0, 1, At, B1); PG8_BAR; PG8_SCHED;
            PG8_LDA(At, 0, 1); PG8_STAGE(PG8_SB(0, 0), b2, voffB); PG8_STAGE(PG8_SB(0, 1), b2 + hstepB, voffB); PG8_STAGE(PG8_SA(0, 0), a2, voffA);
            PG8_WAIT_V(8); PG8_WAIT_L(0); PG8_BAR; PG8_MMA(1, 0, At, B0); PG8_MMA(1, 1, At, B1); PG8_BAR; PG8_SCHED;
            PG8_LDB(B0, 1, 0); PG8_LDB(B1, 1, 1); PG8_SCHED; PG8_LDA(At, 1, 0); PG8_STAGE(PG8_SA(0, 1), a2 + hstepA, voffA);
            PG8_WAIT_V(8); PG8_WAIT_L(0); PG8_BAR; PG8_MMA(0, 0, At, B0); PG8_MMA(0, 1, At, B1); PG8_BAR; PG8_SCHED;
            PG8_LDA(At, 1, 1); PG8_STAGE(PG8_SB(1, 0), b3, voffB); PG8_STAGE(PG8_SB(1, 1), b3 + hstepB, voffB); PG8_STAGE(PG8_SA(1, 0), a3, voffA);
            PG8_WAIT_V(8); PG8_WAIT_L(0); PG8_BAR; PG8_MMA(1, 0, At, B0); PG8_MMA(1, 1, At, B1); PG8_BAR; PG8_SCHED;
            } else {
            PG8_LDB(B0, 0, 0); PG8_SCHED; PG8_LDA(At, 0, 0); PG8_STAGE(PG8_SA(1, 1), a1 + hstepA, voffA);
            PG8_WAIT_L(8); PG8_BAR; PG8_WAIT_L(0); PG8_MMA(0, 0, At, B0); PG8_BAR; PG8_SCHED;
            PG8_LDB(B1, 0, 1); PG8_STAGE(PG8_SB(0, 0), b2, voffB);
            PG8_BAR; PG8_WAIT_L(0); PG8_MMA(0, 1, At, B1); PG8_BAR;
            PG8_LDA(At, 0, 1); PG8_STAGE(PG8_SA(0, 0), a2, voffA);
            PG8_BAR; PG8_WAIT_L(0); PG8_MMA(1, 0, At, B0); PG8_BAR; PG8_SCHED;
            PG8_STAGE(PG8_SB(0, 1), b2 + hstepB, voffB);
            PG8_WAIT_V(6); PG8_BAR; PG8_MMA(1, 1, At, B1); PG8_BAR;
            PG8_LDB(B0, 1, 0); PG8_SCHED; PG8_LDA(At, 1, 0); PG8_STAGE(PG8_SA(0, 1), a2 + hstepA, voffA);
            PG8_WAIT_L(8); PG8_BAR; PG8_WAIT_L(0); PG8_MMA(0, 0, At, B0); PG8_BAR; PG8_SCHED;
            PG8_LDB(B1, 1, 1); PG8_STAGE(PG8_SB(1, 0), b3, voffB);
            PG8_BAR; PG8_WAIT_L(0); PG8_MMA(0, 1, At, B1); PG8_BAR;
            PG8_LDA(At, 1, 1); PG8_STAGE(PG8_SA(1, 0), a3, voffA);
            PG8_BAR; PG8_WAIT_L(0); PG8_MMA(1, 0, At, B0); PG8_BAR; PG8_SCHED;
            PG8_STAGE(PG8_SB(1, 1), b3 + hstepB, voffB);
            PG8_WAIT_V(6); PG8_BAR; PG8_MMA(1, 1, At, B1); PG8_BAR;
            }
        }
        if constexpr (ALIGN_EPI) { if (wr == 0) PG8_BAR; }
        { int fr_e = fr, fq_e = fq; asm volatile("" : "+v"(fr_e), "+v"(fq_e));
          E(acc, cur, wr, wc, fr_e, fq_e); }
        if (!has_next) break;
        if (!HALFN && !(Epi::KEEP && cur.z != 3)) {
#pragma unroll
        for (int a = 0; a < 2; ++a)
#pragma unroll
            for (int b = 0; b < 2; ++b)
#pragma unroll
                for (int m = 0; m < 4; ++m)
#pragma unroll
                    for (int n = 0; n < 2; ++n) acc[a][b][m][n] = (f32x4){0.f, 0.f, 0.f, 0.f};
        }
        cur = nxt; cA = nA; cB = nB; ++ui;
        if constexpr (ALIGN_EPI) { if (wr == 1) PG8_BAR; }
    }
    PG8_WAIT_V(0);
    if constexpr (!ALIGN_EPI) { if (wr == 0) PG8_BAR; }
    PG8_BAR;
#undef PG8_SA
#undef PG8_SB
#undef PG8_STAGE
#undef PG8_LDA
#undef PG8_LDB
#undef PG8_MMA
#undef PG8_WAIT_V
#undef PG8_WAIT_L
#undef PG8_BAR
#undef PG8_SCHED
}

template <class Epi, class Sched>
__device__ __forceinline__ void gemm_phase_hn(PG8_LAS unsigned char* lds, const Gemm g, const Sched& S, const Epi& E) {
    int tid = threadIdx.x; asm volatile("" : "+v"(tid));
    const int wid = __builtin_amdgcn_readfirstlane(tid >> 6), lane = tid & 63, wr = wid >> 2, wc = wid & 3, fr = lane & 15, fq = lane >> 4;
    const int K = g.K, nt = K / BK;
    unsigned voffA[2], voffB[2];
#pragma unroll
    for (int i = 0; i < 2; ++i) { int R, C; stage_rc(tid * 16 + i * 8192, R, C); const int Rb = Epi::PERM ? ((R & ~31) + perm32(R & 31)) : R;
        voffA[i] = (unsigned)(R * g.lda + C) * 2u; voffB[i] = (unsigned)(Rb * g.ldb + C) * 2u; }
    const size_t kstep = (size_t)(BK * 2);
    const size_t hstepA = (size_t)HALF * g.lda * 2, hstepB = (size_t)HALF * g.ldb * 2;
    const size_t tstepA = 2 * hstepA, tstepB = hstepB;
    const unsigned ldsw = (unsigned)wid * 1024u;
    unsigned aoff = (unsigned)lds_byte(wr * 64 + fr, fq * 8), boff = (unsigned)lds_byte(wc * 32 + fr, fq * 8) + 6u * HTB;
    asm volatile("" : "+v"(aoff), "+v"(boff));
#define HN_STAGE(bufoff, gbase, voff) do { _Pragma("unroll") for (int _i = 0; _i < 2; ++_i) \
        __builtin_amdgcn_global_load_lds((const unsigned*)((const char*)(gbase) + (voff)[_i]), (PG8_LAS unsigned*)(lds + (bufoff) + ldsw + _i * 8192), 16, 0, 0); } while (0)
#define HN_STAGE_TILE(r_, pa, pb) do { const unsigned ro_ = (unsigned)(r_) * (2u * HTB); const char* pa0_ = (pa); const char* pa1_ = pa0_ + hstepA; const char* pb_ = (pb); asm volatile("" : "+s"(pa0_), "+s"(pa1_), "+s"(pb_)); \
        HN_STAGE(6u * HTB + (unsigned)(r_) * HTB, pb_, voffB); HN_STAGE(ro_, pa0_, voffA); HN_STAGE(ro_ + HTB, pa1_, voffA); } while (0)
#define HN_LDA(dst, base_) do { _Pragma("unroll") for (int m = 0; m < 4; ++m) _Pragma("unroll") for (int k = 0; k < 2; ++k) dst[m][k] = *(const PG8_LAS bf16x8*)(lds + (base_) + (m * 2048 + k * 1024)); } while (0)
#define HN_LDB(dst, base_) do { _Pragma("unroll") for (int n = 0; n < 2; ++n) _Pragma("unroll") for (int k = 0; k < 2; ++k) dst[n][k] = *(const PG8_LAS bf16x8*)(lds + (base_) + (n * 2048 + k * 1024)); } while (0)
#define HN_MMA(ai, At, Bt) do { __builtin_amdgcn_s_setprio(1); _Pragma("unroll") for (int m = 0; m < 4; ++m) _Pragma("unroll") for (int n = 0; n < 2; ++n) _Pragma("unroll") for (int k = 0; k < 2; ++k) \
        acc[ai][0][m][n] = __builtin_amdgcn_mfma_f32_16x16x32_bf16(Bt[n][k], At[m][k], acc[ai][0][m][n], 0, 0, 0); __builtin_amdgcn_s_setprio(0); } while (0)
#define HN_WAIT_V(n) asm volatile("s_waitcnt vmcnt(" #n ")" ::: "memory")
#define HN_WAIT_L(n) asm volatile("s_waitcnt lgkmcnt(" #n ")" ::: "memory")
#define HN_BAR __builtin_amdgcn_s_barrier()
    Unit cur, nxt; int ui = 0;
    if (!S.next(0, cur)) return;
    f32x4 acc[2][2][4][2];
#pragma unroll
    for (int a = 0; a < 2; ++a)
#pragma unroll
        for (int b = 0; b < 2; ++b)
#pragma unroll
            for (int m = 0; m < 4; ++m)
#pragma unroll
                for (int n = 0; n < 2; ++n) acc[a][b][m][n] = (f32x4){0.f, 0.f, 0.f, 0.f};
    bf16x8 At0[4][2], At1[4][2], B0[2][2];
    const char* cA = (const char*)g.A + (size_t)cur.pm * tstepA + (size_t)cur.z * g.zA; const char* cB = (const char*)g.Bt + (size_t)cur.pn * tstepB + (size_t)cur.z * g.zB;
    int r = 0;
    HN_STAGE_TILE(0, cA, cB); HN_STAGE_TILE(1, cA + kstep, cB + kstep);
    if (wr == 1) HN_BAR;
    HN_WAIT_V(6); HN_BAR; HN_BAR;
    for (;;) {
        const bool has_next = S.next(ui + 1, nxt);
        const char* nA = has_next ? (const char*)g.A + (size_t)nxt.pm * tstepA + (size_t)nxt.z * g.zA : cA; const char* nB = has_next ? (const char*)g.Bt + (size_t)nxt.pn * tstepB + (size_t)nxt.z * g.zB : cB;
        for (int t = 0; t < nt; ++t) {
            const int t2 = t + 2; const char* sa = t2 < nt ? cA + (size_t)t2 * kstep : nA + (size_t)(t2 - nt) * kstep; const char* sb = t2 < nt ? cB + (size_t)t2 * kstep : nB + (size_t)(t2 - nt) * kstep;
            const int r2 = r == 0 ? 2 : r - 1;
            HN_STAGE_TILE(r2, sa, sb);
            if (t == 0) { int t_p = threadIdx.x; asm volatile("" : "+v"(t_p)); E.prefetch(cur, wr, wc, t_p & 15, (t_p >> 4) & 3); }
            { const unsigned ab = aoff + (unsigned)r * (2u * HTB), bb = boff + (unsigned)r * HTB;
              HN_LDB(B0, bb); __builtin_amdgcn_sched_barrier(0); HN_LDA(At0, ab); HN_LDA(At1, ab + HTB); }
            if (t == 0) HN_WAIT_V(10); else if (t == 1) { HN_WAIT_V(10); } else HN_WAIT_V(6);
            HN_WAIT_L(0); HN_BAR;
            HN_MMA(0, At0, B0); HN_MMA(1, At1, B0);
            HN_BAR; __builtin_amdgcn_sched_barrier(0);
            r = r == 2 ? 0 : r + 1;
        }
        if (wr == 0) HN_BAR;
        { int t_e = threadIdx.x; asm volatile("" : "+v"(t_e));
          E(acc, cur, wr, wc, t_e & 15, (t_e >> 4) & 3); }
        if (!has_next) break;
        cur = nxt; cA = nA; cB = nB; ++ui;
        if (wr == 1) HN_BAR;
    }
    HN_WAIT_V(0);
    HN_BAR;
#undef HN_STAGE
#undef HN_STAGE_TILE
#undef HN_LDA
#undef HN_LDB
#undef HN_MMA
#undef HN_WAIT_V
#undef HN_WAIT_L
#undef HN_BAR
}

}

using pg8::bf16_t; using pg8::f32x4; using pg8::u32x4; using pg8::u32x2; using pg8::bf16x8; using pg8::cvt_pk_bf16;
#define LAS __attribute__((address_space(3)))

constexpr int D = 1024, SEQ = 4096, NB = 16, DEPTH = 4, BW = 512;
constexpr int NGRP = 2, BG = NB / NGRP, TG = BG * SEQ;
constexpr int N_IN = 21 * 256, N_MG = 4096, N_ALL = N_IN + N_MG;
constexpr int PLD = 20 * 256;
constexpr int P_GQ = 0, P_GK = 256, P_GV = 512, P_GG = 1024, P_RQ = 1536, P_RK = 1792, P_RV = 2048, P_RG = 2560, P_LX = 3072, P_LG = 3584, P_SU = 4096, P_SG = 4608;
constexpr int OLD = 2048;
constexpr float NORM_EPS = 1e-6f;

constexpr size_t MiB = 1u << 20;
constexpr size_t WS_CTL = 0, CTL_BYTES = 2 * MiB;
constexpr size_t WS_ROT = 2 * MiB;
constexpr size_t WS_SMALL = 3 * MiB, SMALL_STRIDE = 1 * MiB;
constexpr size_t WS_W = 8 * MiB, W_STRIDE = 26 * MiB;
constexpr size_t WO_IN = 0, WO_BR = (size_t)N_ALL * D * 2, WO_OUT = WO_BR + (size_t)4 * D * BW * 2, WO_GLU = WO_OUT + (size_t)D * D * 2, WO_END = WO_GLU + (size_t)BW * BW * 2;
static_assert(WO_END <= W_STRIDE, "weights");
constexpr size_t WS_U = 112 * MiB;
constexpr size_t WS_P = 176 * MiB;
constexpr size_t WS_LA = 496 * MiB;
constexpr size_t WS_O = 528 * MiB;
constexpr size_t WS_Y5 = 656 * MiB;
constexpr size_t WS_PG = 688 * MiB;
constexpr size_t WS_S5D = 816 * MiB;
constexpr size_t WS_S5M = 820 * MiB, S5M_BYTES = 86016;
constexpr size_t WS_S5K = 831 * MiB;
constexpr size_t WS_SU2 = 832 * MiB;
constexpr size_t WS_ST = 944 * MiB;
constexpr size_t WS_END = 1008 * MiB;
constexpr int SM_ABR = 0, SM_ABI = 2048, SM_BBR = 4096, SM_BBI = 4096 + 32768, SM_SP8 = 4096 + 65536, SM_END_F = SM_SP8 + 512;
constexpr int SM_A128 = SM_END_F;
constexpr int SM_A8 = SM_A128 + 4096;
constexpr size_t SM_LRUW_BYTES = 512 * 1024, SM_CT_BYTES = 640 * 1024, SM_BBT_BYTES = 768 * 1024;
static_assert((size_t)(SM_END_F + 8192) * 4 <= SM_LRUW_BYTES, "small");

constexpr int CW_BAR = 4096;
#define XB_TMO      128
#define XB_XCNT(j)  (256  + 64 * (j))
#define XB_XSUB(j)  (1280 + 64 * (j))
#define XB_XGEN(j)  (2304 + 64 * (j))
#define XB_TOP      3328
#define XB_TOPGEN   3392
#define XCD_BAR_WORDS 3456
#define XB_SPIN_CAP (1u << 18)

__device__ __forceinline__ void wg_syncthreads() { __builtin_amdgcn_fence(__ATOMIC_RELEASE, "workgroup"); __builtin_amdgcn_s_barrier(); __builtin_amdgcn_fence(__ATOMIC_ACQUIRE, "workgroup"); }
__device__ __forceinline__ unsigned xb_ld(unsigned* p)              { return __hip_atomic_load(p, __ATOMIC_RELAXED, __HIP_MEMORY_SCOPE_AGENT); }
__device__ __forceinline__ unsigned xb_add(unsigned* p, unsigned v) { return __hip_atomic_fetch_add(p, v, __ATOMIC_RELAXED, __HIP_MEMORY_SCOPE_AGENT); }
__device__ __forceinline__ unsigned xb_xcc_id() { return (unsigned)__builtin_amdgcn_s_getreg((3 << 11) | 20) & 0xFu; }
#define XB_SPIN(cond, bar) do { unsigned _sp = 0; while (cond) { __builtin_amdgcn_s_sleep(1); \
    if ((++_sp & 255u) == 0u) { if (xb_ld(&(bar)[XB_TMO])) break; if (_sp > XB_SPIN_CAP) { (void)xb_add(&(bar)[XB_TMO], 1u); break; } } } } while (0)
struct XcdBarrier { unsigned* bar; unsigned x; volatile LAS unsigned* st; };
__device__ __forceinline__ XcdBarrier xcd_barrier_post(unsigned* bar, volatile LAS unsigned* st) {
    XcdBarrier b; b.bar = bar; b.x = xb_xcc_id(); b.st = st;
    if (threadIdx.x == 0) (void)xb_add(&bar[XB_XCNT(b.x)], 1u);
    return b;
}
__device__ __forceinline__ void xcd_barrier_complete(unsigned* bar, unsigned x, unsigned& nloc, unsigned& nx) {
    const unsigned G = gridDim.x * gridDim.y * gridDim.z;
    unsigned sum, cnt, mine, sp = 0u;
    for (;;) {
        sum = 0u; cnt = 0u; mine = 0u;
#pragma unroll
        for (unsigned j = 0; j < 16; ++j) { const unsigned c = xb_ld(&bar[XB_XCNT(j)]); sum += c; cnt += (c > 0u) ? 1u : 0u; mine = (j == x) ? c : mine; }
        if (sum == G) break;
        __builtin_amdgcn_s_sleep(1);
        if ((++sp & 255u) == 0u) { if (xb_ld(&bar[XB_TMO])) break; if (sp > XB_SPIN_CAP) { (void)xb_add(&bar[XB_TMO], 1u); break; } }
    }
    nloc = mine > 0u ? mine : 1u; nx = cnt > 0u ? cnt : 1u;
}
__device__ __forceinline__ void xcd_barrier(const XcdBarrier& b) {
    asm volatile("s_waitcnt vmcnt(0)" ::: "memory");
    wg_syncthreads();
    if (threadIdx.x == 0) {
        unsigned* bar = b.bar;
        __builtin_amdgcn_s_waitcnt(0);
        unsigned nloc = b.st[0], nx = b.st[1];
        if (nloc == 0u) { xcd_barrier_complete(bar, b.x, nloc, nx); b.st[0] = nloc; b.st[1] = nx; }
        const unsigned old = xb_add(&bar[XB_XSUB(b.x)], 1u);
        const unsigned gen = old / nloc;
        if (old + 1u == (gen + 1u) * nloc) {
            __builtin_amdgcn_fence(__ATOMIC_RELEASE, "agent");
            asm volatile("s_waitcnt vmcnt(0)" ::: "memory");
            const unsigned og = xb_add(&bar[XB_TOP], 1u);
            const unsigned tg = og / nx;
            if (og + 1u == (tg + 1u) * nx) xb_add(&bar[XB_TOPGEN], 1u);
            else XB_SPIN(xb_ld(&bar[XB_TOPGEN]) == tg, bar);
            __builtin_amdgcn_fence(__ATOMIC_ACQUIRE, "agent");
            xb_add(&bar[XB_XGEN(b.x)], 1u);
            asm volatile("s_waitcnt vmcnt(0)" ::: "memory");
        } else {
            XB_SPIN(xb_ld(&bar[XB_XGEN(b.x)]) == gen, bar);
            __builtin_amdgcn_fence(__ATOMIC_ACQUIRE, "agent");
            asm volatile("s_waitcnt vmcnt(0)" ::: "memory");
        }
    }
    wg_syncthreads();
}

__device__ __forceinline__ float bf2f(bf16_t b) { return __builtin_bit_cast(float, ((unsigned)b) << 16); }
__device__ __forceinline__ float bflo(unsigned w) { return __builtin_bit_cast(float, w << 16); }
__device__ __forceinline__ float bfhi(unsigned w) { return __builtin_bit_cast(float, w & 0xffff0000u); }
__device__ __forceinline__ bf16_t f2bf(float f) { return (bf16_t)(cvt_pk_bf16(f, 0.f) & 0xffffu); }
__device__ __forceinline__ float sigmoid_f(float x) { return __builtin_amdgcn_rcpf(1.f + __expf(-x)); }
__device__ __forceinline__ float silu_f(float x) { return x * sigmoid_f(x); }
__device__ __forceinline__ float silu_t(float t) { return t * __builtin_amdgcn_rcpf(__builtin_fmaf(__builtin_amdgcn_exp2f(t), -1.4426950408889634f, -1.4426950408889634f)); }
__device__ __forceinline__ float sig255(float t) { return __builtin_amdgcn_rcpf(__builtin_fmaf(__builtin_amdgcn_exp2f(t), 1.f / 255.f, 1.f / 255.f)); }
__device__ __forceinline__ float gelu_tanh_f(float x) { const float u = 0.7978845608028654f * (x + 0.044715f * x * x * x); const float t = 1.f - 2.f * __builtin_amdgcn_rcpf(1.f + __expf(2.f * u)); return 0.5f * x * (1.f + t); }
__device__ __forceinline__ float shfl_xor_f(float v, int m) { const int ln = (int)__builtin_amdgcn_mbcnt_hi(~0u, __builtin_amdgcn_mbcnt_lo(~0u, 0u)); return __builtin_bit_cast(float, __builtin_amdgcn_ds_bpermute((ln ^ m) << 2, __builtin_bit_cast(int, v))); }
__device__ __forceinline__ float wave_sum(float v) {
#pragma unroll
    for (int o = 1; o < 64; o <<= 1) v += shfl_xor_f(v, o);
    return v;
}

#define GEMM_CALL(EPI) pg8::gemm_phase<EPI, pg8::StaticOrder, true, true>(lds, g, S, E)
struct Args {
    const float* in[29]; float* out; unsigned char* ws;
    int s_lo, s_hi, li, fin, mmask, pad2;
};
enum { I_X = 0, I_NG, I_WIN, I_GWLR, I_GBLR, I_GNG, I_RNG, I_RNB, I_LCW, I_LCB, I_LWA, I_LBA, I_LWX, I_LBX, I_LLAM,
       I_SARE, I_SAIM, I_SBRE, I_SBIM, I_SCRE, I_SCIM, I_SD, I_SLDT, I_SGW, I_SGB, I_WMG, I_WBR, I_WOUT, I_FNG };

struct EpiIn {
    static constexpr bool PERM = true, AFTER_DRAIN = false, KEEP = false;
    bf16_t* P; float* LA; const float* blr; const float* rot; unsigned char* PG; bf16_t* SU;
    __device__ __forceinline__ void operator()(f32x4 (&acc)[2][2][4][2], const pg8::Unit& u, int wr, int wc, int fr, int fq) const {
        const int pn = u.pn, row0 = u.pm * 256 + wr * 64 + fr, cl = wc * 32 + 8 * fq;
        if (pn >= 21) {
#pragma unroll
            for (int ai = 0; ai < 2; ++ai)
#pragma unroll
                for (int m = 0; m < 4; ++m) { int row = row0 + ai * 128 + m * 16; asm volatile("" : "+v"(row));
                    u32x4 w;
#pragma unroll
                    for (int bj = 0; bj < 2; ++bj) { const f32x4 v0 = acc[ai][bj][m][0], v1 = acc[ai][bj][m][1]; unsigned lo = 0u, hi = 0u;
#pragma unroll
                        for (int j = 0; j < 4; ++j) { lo = __builtin_amdgcn_cvt_pk_u8_f32(sig255(v0[j]), j, lo); hi = __builtin_amdgcn_cvt_pk_u8_f32(sig255(v1[j]), j, hi); }
                        if (bj == 0) { w.x = lo; w.y = hi; } else { w.z = lo; w.w = hi; } }
                    __builtin_nontemporal_store(w, (u32x4*)(PG + (size_t)row * N_MG + (pn - 21) * 256 + 2 * cl)); }
        } else if (pn == 4) {
#pragma unroll
            for (int bj = 0; bj < 2; ++bj) { const int c = cl + bj * 128; const f32x4 b0 = *(const f32x4*)(blr + c), b1 = *(const f32x4*)(blr + c + 4);
#pragma unroll
                for (int ai = 0; ai < 2; ++ai) {
#pragma unroll
                    for (int n = 0; n < 2; ++n)
#pragma unroll
                        for (int j = 0; j < 4; ++j) { float run = 0.f; const float bb = n ? b1[j] : b0[j];
#pragma unroll
                            for (int m = 0; m < 4; ++m) { const float z = acc[ai][bj][m][n][j] + bb; const float x = -(fmaxf(-z, 0.f) + __logf(1.f + __expf(-fabsf(z)))) * 0.0625f; float ls = x, rs = x;
#define DPP_ADD(acc_, ctrl_) acc_ += __builtin_bit_cast(float, __builtin_amdgcn_update_dpp(0, __builtin_bit_cast(int, acc_), ctrl_, 0xf, 0xf, true))
                                DPP_ADD(ls, 0x111); DPP_ADD(ls, 0x112); DPP_ADD(ls, 0x114); DPP_ADD(ls, 0x118);
                                DPP_ADD(rs, 0x101); DPP_ADD(rs, 0x102); DPP_ADD(rs, 0x104); DPP_ADD(rs, 0x108);
#undef DPP_ADD
                                acc[ai][bj][m][n][j] = run + ls; run += ls + rs - x; } }
#pragma unroll
                    for (int m = 0; m < 4; ++m) { int row = row0 + ai * 128 + m * 16; asm volatile("" : "+v"(row)); float* d = LA + ((size_t)(c >> 6) * TG + row) * 64 + (c & 63); *(f32x4*)d = acc[ai][bj][m][0]; *(f32x4*)(d + 4) = acc[ai][bj][m][1]; } } }
        } else if (pn == 7 || pn == 8) {
            const int dcol = (pn - 1) * 256;
#pragma unroll
            for (int ai = 0; ai < 2; ++ai)
#pragma unroll
                for (int m = 0; m < 4; ++m) { int row = row0 + ai * 128 + m * 16; asm volatile("" : "+v"(row)); const int pos = row & (SEQ - 1);
#pragma unroll
                    for (int bj = 0; bj < 2; ++bj) { const int c = cl + bj * 128, i0 = (c & 63) >> 1; const float* rt = rot + ((size_t)pos * 32 + i0) * 2;
                        const f32x4 cs0 = *(const f32x4*)rt, cs1 = *(const f32x4*)(rt + 4); const f32x4 v0 = acc[ai][bj][m][0], v1 = acc[ai][bj][m][1];
                        u32x4 w; w.x = cvt_pk_bf16(v0[0] * cs0[0] - v0[1] * cs0[1], v0[0] * cs0[1] + v0[1] * cs0[0]); w.y = cvt_pk_bf16(v0[2] * cs0[2] - v0[3] * cs0[3], v0[2] * cs0[3] + v0[3] * cs0[2]);
                        w.z = cvt_pk_bf16(v1[0] * cs1[0] - v1[1] * cs1[1], v1[0] * cs1[1] + v1[1] * cs1[0]); w.w = cvt_pk_bf16(v1[2] * cs1[2] - v1[3] * cs1[3], v1[2] * cs1[3] + v1[3] * cs1[2]);
                        __builtin_nontemporal_store(w, (u32x4*)(P + (size_t)(dcol + (c & ~63)) * TG + (size_t)row * 64 + (c & 63))); } }
        } else {
            const bool silu = (pn == 5 || pn == 6 || pn == 11 || pn == 12 || pn == 15 || pn == 16 || pn == 19 || pn == 20);
            const int dcol = (pn < 4 ? pn : pn - 1) * 256;
            const int wsh = (pn >= 19) ? 9 : ((pn == 2 || pn == 3 || pn == 5 || pn == 6 || (pn >= 9 && pn <= 12)) ? 7 : 6);
#pragma unroll
            for (int ai = 0; ai < 2; ++ai)
#pragma unroll
                for (int m = 0; m < 4; ++m) { int row = row0 + ai * 128 + m * 16; asm volatile("" : "+v"(row));
#pragma unroll
                    for (int bj = 0; bj < 2; ++bj) { f32x4 v0 = acc[ai][bj][m][0], v1 = acc[ai][bj][m][1];
                        if (silu) {
#pragma unroll
                            for (int j = 0; j < 4; ++j) { v0[j] = silu_t(v0[j]); v1[j] = silu_t(v1[j]); } }
                        u32x4 w; w.x = cvt_pk_bf16(v0[0], v0[1]); w.y = cvt_pk_bf16(v0[2], v0[3]); w.z = cvt_pk_bf16(v1[0], v1[1]); w.w = cvt_pk_bf16(v1[2], v1[3]);
                        if (pn == 17 || pn == 18) { const int cc = (pn - 17) * 256 + cl + bj * 128;
                            __builtin_nontemporal_store(w, (u32x4*)(SU + ((size_t)(cc >> 4) * TG + row) * 16 + (cc & 15))); }
                        else { const int col = dcol + cl + bj * 128; __builtin_nontemporal_store(w, (u32x4*)(P + (size_t)(col >> wsh << wsh) * TG + ((size_t)row << wsh) + (col & ((1 << wsh) - 1)))); } } }
        }
    }
};
struct EpiSig {
    static constexpr bool PERM = true, AFTER_DRAIN = false, KEEP = false;
    bf16_t* PG;
    __device__ __forceinline__ void operator()(const f32x4 (&acc)[2][2][4][2], const pg8::Unit& u, int wr, int wc, int fr, int fq) const {
        const int row0 = u.pm * 256 + wr * 64 + fr, c0 = u.pn * 256 + wc * 32 + 8 * fq;
#pragma unroll
        for (int ai = 0; ai < 2; ++ai)
#pragma unroll
            for (int m = 0; m < 4; ++m) { const int row = row0 + ai * 128 + m * 16;
#pragma unroll
                for (int bj = 0; bj < 2; ++bj) { f32x4 v0 = acc[ai][bj][m][0], v1 = acc[ai][bj][m][1];
#pragma unroll
                    for (int j = 0; j < 4; ++j) { v0[j] = sigmoid_f(v0[j]); v1[j] = sigmoid_f(v1[j]); }
                    u32x4 w; w.x = cvt_pk_bf16(v0[0], v0[1]); w.y = cvt_pk_bf16(v0[2], v0[3]); w.z = cvt_pk_bf16(v1[0], v1[1]); w.w = cvt_pk_bf16(v1[2], v1[3]);
                    *(u32x4*)(PG + (size_t)row * N_MG + c0 + bj * 128) = w; } }
    }
};
struct EpiGlu {
    static constexpr bool PERM = true, AFTER_DRAIN = false, KEEP = false;
    const bf16_t* Y5; const bf16_t* P; const float* gb; bf16_t* O;
    __device__ __forceinline__ void operator()(const f32x4 (&acc)[2][2][4][2], const pg8::Unit& u, int wr, int wc, int fr, int fq) const {
        const int row0 = u.pm * 256 + wr * 64 + fr, c0 = u.pn * 256 + wc * 32 + 8 * fq;
#pragma unroll
        for (int bj = 0; bj < 2; ++bj) { const int c = c0 + bj * 128; const f32x4 b0 = *(const f32x4*)(gb + c), b1 = *(const f32x4*)(gb + c + 4);
#pragma unroll
            for (int ai = 0; ai < 2; ++ai)
#pragma unroll
                for (int m = 0; m < 4; ++m) { const int row = row0 + ai * 128 + m * 16;
                    const u32x4 y = *(const u32x4*)(Y5 + (size_t)row * BW + c), s = *(const u32x4*)(P + (size_t)P_SG * TG + (size_t)row * 512 + c);
                    const f32x4 v0 = acc[ai][bj][m][0] + b0, v1 = acc[ai][bj][m][1] + b1;
                    u32x4 w;
                    w.x = cvt_pk_bf16(bflo(y.x) * sigmoid_f(v0[0]) * bflo(s.x), bfhi(y.x) * sigmoid_f(v0[1]) * bfhi(s.x));
                    w.y = cvt_pk_bf16(bflo(y.y) * sigmoid_f(v0[2]) * bflo(s.y), bfhi(y.y) * sigmoid_f(v0[3]) * bfhi(s.y));
                    w.z = cvt_pk_bf16(bflo(y.z) * sigmoid_f(v1[0]) * bflo(s.z), bfhi(y.z) * sigmoid_f(v1[1]) * bfhi(s.z));
                    w.w = cvt_pk_bf16(bflo(y.w) * sigmoid_f(v1[2]) * bflo(s.w), bfhi(y.w) * sigmoid_f(v1[3]) * bfhi(s.w));
                    *(u32x4*)(O + (size_t)row * OLD + 1536 + c) = w; } }
    }
};
struct EpiBr {
    static constexpr bool PERM = true, AFTER_DRAIN = false, KEEP = false;
    const unsigned char* PG; bf16_t* MRG; mutable u32x2 gpre[4];
    __device__ __forceinline__ void prefetch(const pg8::Unit& u, int wr, int wc, int fr, int fq) const {
        const int row0 = u.pm * 256 + wr * 64 + fr, gpos = (u.z * 4 + (u.pn >> 1)) * 256 + wc * 64 + fq * 16 + (u.pn & 1) * 8;
#pragma unroll
        for (int m = 0; m < 4; ++m) gpre[m] = __builtin_nontemporal_load((const u32x2*)(PG + (size_t)(row0 + m * 16) * N_MG + gpos));
    }
    __device__ __forceinline__ void operator()(f32x4 (&acc)[2][2][4][2], const pg8::Unit& u, int wr, int wc, int fr, int fq) const {
        const int row0 = u.pm * 256 + wr * 64 + fr, c = u.pn * 128 + wc * 32 + 8 * fq, z = u.z;
        const int gpos = (z * 4 + (u.pn >> 1)) * 256 + wc * 64 + fq * 16 + (u.pn & 1) * 8;
        u32x2 glo[4];
#pragma unroll
        for (int m = 0; m < 4; ++m) glo[m] = __builtin_nontemporal_load((const u32x2*)(PG + (size_t)(row0 + 128 + m * 16) * N_MG + gpos));
#pragma unroll
        for (int ai = 0; ai < 2; ++ai)
#pragma unroll
            for (int m = 0; m < 4; ++m) { const int row = row0 + ai * 128 + m * 16;
                const u32x2 gt = ai == 0 ? gpre[m] : glo[m];
                f32x4& p0 = acc[ai][0][m][0]; f32x4& p1 = acc[ai][0][m][1]; f32x4& s0 = acc[ai][1][m][0]; f32x4& s1 = acc[ai][1][m][1];
                if (z == 0) { s0 = (f32x4){0.f, 0.f, 0.f, 0.f}; s1 = s0; }
                s0[0] += p0[0] * (float)(gt.x & 255u); s0[1] += p0[1] * (float)((gt.x >> 8) & 255u); s0[2] += p0[2] * (float)((gt.x >> 16) & 255u); s0[3] += p0[3] * (float)(gt.x >> 24);
                s1[0] += p1[0] * (float)(gt.y & 255u); s1[1] += p1[1] * (float)((gt.y >> 8) & 255u); s1[2] += p1[2] * (float)((gt.y >> 16) & 255u); s1[3] += p1[3] * (float)(gt.y >> 24);
                p0 = (f32x4){0.f, 0.f, 0.f, 0.f}; p1 = p0;
                if (z == 3) { const float q = 1.f / 255.f; s0 *= q; s1 *= q;
                    u32x4 w; w.x = cvt_pk_bf16(s0[0], s0[1]); w.y = cvt_pk_bf16(s0[2], s0[3]); w.z = cvt_pk_bf16(s1[0], s1[1]); w.w = cvt_pk_bf16(s1[2], s1[3]);
                    *(u32x4*)(MRG + (size_t)row * D + c) = w; } }
    }
};
struct EpiOut {
    static constexpr bool PERM = true, AFTER_DRAIN = false, KEEP = false;
    bf16_t* DL;
    __device__ __forceinline__ void operator()(const f32x4 (&acc)[2][2][4][2], const pg8::Unit& u, int wr, int wc, int fr, int fq) const {
        const int row0 = u.pm * 256 + wr * 64 + fr, c0 = u.pn * 256 + wc * 32 + 8 * fq;
#pragma unroll
        for (int ai = 0; ai < 2; ++ai)
#pragma unroll
            for (int m = 0; m < 4; ++m) { const int row = row0 + ai * 128 + m * 16;
#pragma unroll
                for (int bj = 0; bj < 2; ++bj) { const f32x4 v0 = acc[ai][bj][m][0], v1 = acc[ai][bj][m][1];
                    u32x4 w; w.x = cvt_pk_bf16(v0[0], v0[1]); w.y = cvt_pk_bf16(v0[2], v0[3]); w.z = cvt_pk_bf16(v1[0], v1[1]); w.w = cvt_pk_bf16(v1[2], v1[3]);
                    *(u32x4*)(DL + (size_t)row * D + c0 + bj * 128) = w; } }
    }
};

__device__ __forceinline__ int win_src_col(int r) {
    const int pn = r >> 8, j = r & 255;
    switch (pn) {
        case 0: return j; case 1: return 256 + j; case 2: case 3: return 512 + (r - 512);
        case 4: return -1;
        case 5: case 6: return 1040 + (r - 1280);
        case 7: return 1552 + 64 * (j >> 6) + ((j & 63) >> 1) + 32 * (j & 1);
        case 8: return 1808 + 64 * (j >> 6) + ((j & 63) >> 1) + 32 * (j & 1);
        case 9: case 10: return 2064 + (r - 2304);
        case 11: case 12: return 2576 + (r - 2816);
        case 13: case 14: return 3088 + (r - 3328);
        case 15: case 16: return 3600 + (r - 3840);
        case 17: case 18: return 4112 + (r - 4352);
        default: return 4624 + (r - 4864);
    }
}
__device__ __forceinline__ void tr_store8(bf16_t* dst, const float (&v)[8]) {
    u32x4 w; w.x = cvt_pk_bf16(v[0], v[1]); w.y = cvt_pk_bf16(v[2], v[3]); w.z = cvt_pk_bf16(v[4], v[5]); w.w = cvt_pk_bf16(v[6], v[7]); *(u32x4*)dst = w;
}
__device__ __forceinline__ void phase_prologue(LAS unsigned char* lds, const Args& a, int gtid, int gthreads) {
    unsigned char* ws = a.ws;
    for (int q = gtid; q < DEPTH * 2048; q += gthreads) { const int l = q >> 11, idx = q & 2047, g = idx >> 6;
        float* sm = (float*)(ws + WS_SMALL + (size_t)l * SMALL_STRIDE);
        const double step = exp((double)a.in[I_SLDT][l * 32 + g]); const double are = a.in[I_SARE][l * 2048 + idx], aim = a.in[I_SAIM][l * 2048 + idx];
        const double mag = exp(step * are), abr = mag * cos(step * aim), abi = mag * sin(step * aim), den = are * are + aim * aim;
        const double fre = ((abr - 1.0) * are + abi * aim) / den, fim = (abi * are - (abr - 1.0) * aim) / den;
        sm[SM_ABR + idx] = (float)abr; sm[SM_ABI + idx] = (float)abi;
        double* s5d = (double*)(ws + WS_S5D) + ((size_t)l * 2048 + idx) * 50;
        { double pr = 1.0, pi = 0.0;
          for (int j = 0; j <= 8; ++j) { s5d[2 * j] = pr; s5d[2 * j + 1] = pi; if (j == 8) { sm[SM_A8 + idx * 2] = (float)pr; sm[SM_A8 + idx * 2 + 1] = (float)pi; } const double nr = pr * abr - pi * abi, ni = pr * abi + pi * abr; pr = nr; pi = ni; } }
        { const double m128 = exp(512.0 * step * are); sm[SM_A128 + idx * 2] = (float)(m128 * cos(512.0 * step * aim)); sm[SM_A128 + idx * 2 + 1] = (float)(m128 * sin(512.0 * step * aim)); }
        for (int i = 0; i < 16; ++i) { const double br = a.in[I_SBRE][(size_t)l * 32768 + idx * 16 + i], bi = a.in[I_SBIM][(size_t)l * 32768 + idx * 16 + i];
            s5d[18 + 2 * i] = fre * br - fim * bi; s5d[18 + 2 * i + 1] = fre * bi + fim * br; } }
    { LAS float* T = (LAS float*)lds; const int tid = gtid & 511, G_ = gthreads >> 9, nn = tid & 63, kq = tid >> 6, nn2 = tid >> 3, kc = tid & 7;
      for (int tile = gtid >> 9; tile < DEPTH * 3200; tile += G_) { const int l = tile / 3200, r = tile % 3200;
          bf16_t* Wl = (bf16_t*)(ws + WS_W + (size_t)l * W_STRIDE);
          int nt, kt, dld; bf16_t* dst; const float* colp; int ld; float scale = 1.f; bool comp = false;
          if (r < 1344) { nt = r % 84; kt = r / 84; dst = Wl; dld = D; const int n = nt * 64 + nn, sc = win_src_col(n), pn_ = n >> 8; ld = 5136; comp = sc < 0;
              colp = a.in[I_WIN] + (size_t)l * D * 5136 + (comp ? 1024 : sc);
              scale = (pn_ == 5 || pn_ == 6 || pn_ == 11 || pn_ == 12 || pn_ == 15 || pn_ == 16 || pn_ == 19 || pn_ == 20) ? -1.4426950408889634f : ((pn_ == 0 || pn_ == 8) ? 0.125f : 1.f); }
          else if (r < 2368) { const int q = r - 1344; nt = q & 63; kt = q >> 6; dst = Wl + (size_t)N_IN * D; dld = D; const int n = nt * 64 + nn; ld = D;
              colp = a.in[I_WMG] + (size_t)l * 4 * D * D + (size_t)(n >> 10) * D * D + (n & 1023); scale = -1.4426950408889634f; }
          else if (r < 2880) { const int q = r - 2368; nt = q & 63; kt = q >> 6; dst = (bf16_t*)((unsigned char*)Wl + WO_BR); dld = BW; const int n = nt * 64 + nn; ld = D;
              colp = a.in[I_WBR] + (size_t)l * 4 * BW * D + (size_t)(n >> 10) * BW * D + (n & 1023); }
          else if (r < 3136) { const int q = r - 2880; nt = q & 15; kt = q >> 4; dst = (bf16_t*)((unsigned char*)Wl + WO_OUT); dld = D; ld = D; colp = a.in[I_WOUT] + (size_t)l * D * D + nt * 64 + nn; }
          else { const int q = r - 3136; nt = q & 7; kt = q >> 3; dst = (bf16_t*)((unsigned char*)Wl + WO_GLU); dld = BW; ld = BW; colp = a.in[I_SGW] + (size_t)l * BW * BW + nt * 64 + nn; }
          if (!comp) {
#pragma unroll
              for (int j = 0; j < 8; ++j) { const int kk = kq + 8 * j; T[kk * 65 + nn] = colp[(size_t)(kt * 64 + kk) * ld] * scale; }
          } else { const float* wlr = a.in[I_GWLR] + (size_t)l * 16 * 256 + ((nt * 64 + nn) & 255);
#pragma unroll
              for (int j = 0; j < 8; ++j) { const int kk = kq + 8 * j; const float* wr_ = colp + (size_t)(kt * 64 + kk) * ld; float sacc = 0.f;
#pragma unroll
                  for (int rr = 0; rr < 16; ++rr) sacc += wr_[rr] * wlr[rr * 256];
                  T[kk * 65 + nn] = sacc; } }
          wg_syncthreads();
          { float v[8];
#pragma unroll
            for (int i = 0; i < 8; ++i) v[i] = T[(kc * 8 + i) * 65 + nn2];
            tr_store8(dst + (size_t)(nt * 64 + nn2) * dld + kt * 64 + kc * 8, v); }
          wg_syncthreads();
      } }
    for (int l = 0; l < DEPTH; ++l) {
        float* sm = (float*)(ws + WS_SMALL + (size_t)l * SMALL_STRIDE);
        for (int idx = gtid; idx < 512; idx += gthreads) { const float lam = a.in[I_LLAM][l * 512 + idx]; const float nl = -lam;
            sm[SM_SP8 + idx] = 8.0f * (fmaxf(nl, 0.f) + log1pf(expf(-fabsf(nl)))); }
        bf16_t* lw = (bf16_t*)((unsigned char*)sm + SM_LRUW_BYTES);
        for (int idx = gtid; idx < 8 * 128 * 64; idx += gthreads) { const int i = idx & 63, jj = (idx >> 6) & 127, n = idx >> 13;
            const float v = jj < 64 ? a.in[I_LWA][(((size_t)l * 8 + n) * 64 + i) * 64 + jj] : a.in[I_LWX][(((size_t)l * 8 + n) * 64 + i) * 64 + (jj - 64)];
            lw[idx] = f2bf(v * -1.4426950408889634f); }
    }
    float* rot = (float*)(ws + WS_ROT);
    for (int idx = gtid; idx < SEQ * 32; idx += gthreads) { const int i = idx & 31, s = idx >> 5;
        const double inv = pow(10000.0, -(double)i / 32.0), ang = (double)s * inv; rot[idx * 2] = (float)cos(ang); rot[idx * 2 + 1] = (float)sin(ang); }
}

__device__ __forceinline__ void phase_prologue2(const Args& a, int gtid, int gthreads) {
    unsigned char* ws = a.ws;
    for (int l = 0; l < DEPTH; ++l) {
        const double* s5d = (const double*)(ws + WS_S5D) + (size_t)l * 2048 * 50;
        const float* scre = a.in[I_SCRE] + (size_t)l * 32768; const float* scim = a.in[I_SCIM] + (size_t)l * 32768;
        for (int it = gtid; it < 32 * 4096; it += gthreads) { const int g = it >> 12, r = it & 4095, f = r >> 6, ln = r & 63, fr = ln & 15, fq = ln >> 4;
            const int mat = f >> 5, mt = (f & 31) >> 2, ks = f & 3;
            const int m = 16 * mt + fr, k0 = 32 * ks + 8 * fq; float v[8];
            if (mat == 0) { const int p = m >> 1, ri = m & 1, sq = k0 >> 4, c0 = k0 & 15; const double* sd = s5d + (size_t)(g * 64 + p) * 50; const double ar = sd[2 * (7 - sq)], ai = sd[2 * (7 - sq) + 1];
#pragma unroll
                for (int e = 0; e < 8; ++e) { const double br = sd[18 + 2 * (c0 + e)], bi = sd[18 + 2 * (c0 + e) + 1]; v[e] = (float)(ri ? ar * bi + ai * br : ar * br - ai * bi); } }
            else { const int t = m >> 4, i = m & 15;
#pragma unroll
                for (int e = 0; e < 8; ++e) { const int k = k0 + e, p = k >> 1, ri = k & 1; const double* sd = s5d + (size_t)(g * 64 + p) * 50; const double ar = sd[2 * (t + 1)], ai = sd[2 * (t + 1) + 1];
                    const double cr = scre[(g * 16 + i) * 64 + p], ci = scim[(g * 16 + i) * 64 + p]; v[e] = (float)(ri ? -(cr * ai + ci * ar) : cr * ar - ci * ai); } }
            tr_store8((bf16_t*)(ws + WS_S5M + (size_t)(l * 32 + g) * S5M_BYTES + (size_t)r * 16), v); }
    }
    float* kt = (float*)(ws + WS_S5K);
    for (int it = gtid; it < DEPTH * 32 * 2048; it += gthreads) { const int l = it >> 16, g = (it >> 11) & 31, j = (it >> 8) & 7, i = (it >> 4) & 15, c = it & 15; double ac = 0.0;
        const double* s5d = (const double*)(ws + WS_S5D) + (size_t)l * 2048 * 50;
        const float* scre = a.in[I_SCRE] + (size_t)l * 32768; const float* scim = a.in[I_SCIM] + (size_t)l * 32768;
#pragma unroll 8
        for (int p = 0; p < 64; ++p) { const double* sd = s5d + (size_t)(g * 64 + p) * 50; const double ar = sd[2 * j], ai = sd[2 * j + 1];
            const double cr = scre[(g * 16 + i) * 64 + p], ci = scim[(g * 16 + i) * 64 + p];
            ac += (cr * ar - ci * ai) * sd[18 + 2 * c] - (cr * ai + ci * ar) * sd[18 + 2 * c + 1]; }
        kt[it] = (float)ac; }
}
__device__ __forceinline__ void phase_prologue3(const Args& a, int gtid, int gthreads) {
    unsigned char* ws = a.ws;
    for (int it = gtid; it < DEPTH * 32 * 1280; it += gthreads) { const int lg = it / 1280, r = it % 1280, ff = r >> 6, ln = r & 63, fr = ln & 15, fq = ln >> 4;
        const int mt = ff < 1 ? 0 : ff < 2 ? 1 : ff < 4 ? 2 : ff < 6 ? 3 : ff < 9 ? 4 : ff < 12 ? 5 : ff < 16 ? 6 : 7;
        const int cb = mt < 1 ? 0 : mt < 2 ? 1 : mt < 3 ? 2 : mt < 4 ? 4 : mt < 5 ? 6 : mt < 6 ? 9 : mt < 7 ? 12 : 16, ks = ff - cb;
        const int m = 16 * mt + fr, k0 = 32 * ks + 8 * fq, t = m >> 4, i = m & 15, sq = k0 >> 4, c0 = k0 & 15; float v[8];
        const float* kt = (const float*)(ws + WS_S5K) + (size_t)lg * 2048 + ((sq <= t ? t - sq : 0) * 16 + i) * 16 + c0;
#pragma unroll
        for (int e = 0; e < 8; ++e) v[e] = sq <= t ? kt[e] : 0.f;
        tr_store8((bf16_t*)(ws + WS_S5M + (size_t)lg * S5M_BYTES + 65536 + (size_t)r * 16), v); }
}

template <bool F32OUT, bool ADD>
__device__ __forceinline__ void phase_norm(const float* hin, const bf16_t* delta, float* hout, const float* gain, bf16_t* uout, int gw, int ngw, int lane) {
    f32x4 gv[4];
#pragma unroll
    for (int j = 0; j < 4; ++j) gv[j] = *(const f32x4*)(gain + 4 * lane + 256 * j);
    for (int row = gw; row < TG; row += ngw) {
        const f32x4* xr = (const f32x4*)(hin + (size_t)row * D) + lane; f32x4 v[4]; float s = 0.f;
#pragma unroll
        for (int j = 0; j < 4; ++j) v[j] = __builtin_nontemporal_load(xr + 64 * j);
        if (ADD) { const u32x2* dr = (const u32x2*)(delta + (size_t)row * D) + lane;
#pragma unroll
            for (int j = 0; j < 4; ++j) { const u32x2 dw = __builtin_nontemporal_load(dr + 64 * j); v[j].x += bflo(dw.x); v[j].y += bfhi(dw.x); v[j].z += bflo(dw.y); v[j].w += bfhi(dw.y); } }
#pragma unroll
        for (int j = 0; j < 4; ++j) s += (v[j].x * v[j].x + v[j].y * v[j].y) + (v[j].z * v[j].z + v[j].w * v[j].w);
        const float rstd = rsqrtf(wave_sum(s) * (1.f / D) + NORM_EPS);
        if (F32OUT) { f32x4* o = (f32x4*)(hout + (size_t)row * D) + lane;
#pragma unroll
            for (int j = 0; j < 4; ++j) o[64 * j] = v[j] * rstd * gv[j];
        } else {
            if (ADD) { f32x4* o = (f32x4*)(hout + (size_t)row * D) + lane;
#pragma unroll
                for (int j = 0; j < 4; ++j) o[64 * j] = v[j]; }
            u32x2* o = (u32x2*)(uout + (size_t)row * D) + lane;
#pragma unroll
            for (int j = 0; j < 4; ++j) { const f32x4 y = v[j] * rstd * gv[j]; u32x2 w; w.x = cvt_pk_bf16(y.x, y.y); w.y = cvt_pk_bf16(y.z, y.w); o[64 * j] = w; } }
    }
}

constexpr int NSEGG = 8;
constexpr int NSEGL = 32;
constexpr int NSEGS = 8;
constexpr size_t ST_GSEG = 0;
constexpr size_t ST_GDS = ST_GSEG + (size_t)2 * BG * 4 * NSEGG * 8192;
constexpr size_t ST_LRU = ST_GDS + (size_t)2 * BG * 4 * NSEGG * 64;
constexpr size_t ST_S5 = ST_LRU + (size_t)BG * NSEGL * 512 * 2;
constexpr size_t ST_END_F = ST_S5 + (size_t)BG * NSEGS * 32 * 128;
static_assert(ST_END_F * 4 <= 64 * MiB, "state scratch");
typedef short s16x4 __attribute__((ext_vector_type(4)));

__device__ __forceinline__ bf16x8 lds_tr_frag(LAS const unsigned char* base, int row_stride_bytes, int lane) {
    const int g = lane >> 4, idx = lane & 15, q = idx >> 2, p = idx & 3;
    LAS const unsigned char* a0 = base + (8 * g + q) * row_stride_bytes + 8 * p;
    const s16x4 r0 = __builtin_amdgcn_ds_read_tr16_b64_v4i16((LAS s16x4*)a0);
    const s16x4 r1 = __builtin_amdgcn_ds_read_tr16_b64_v4i16((LAS s16x4*)(a0 + 4 * row_stride_bytes));
    bf16x8 f; f[0] = r0[0]; f[1] = r0[1]; f[2] = r0[2]; f[3] = r0[3]; f[4] = r1[0]; f[5] = r1[1]; f[6] = r1[2]; f[7] = r1[3]; return f;
}
#define WGSYNC() do { asm volatile("s_waitcnt lgkmcnt(0)" ::: "memory"); __builtin_amdgcn_s_barrier(); asm volatile("" ::: "memory"); } while (0)

constexpr int GL_QD = 0, GL_KD = 9216, GL_KT = 18432, GL_V = 27648, GL_ST = 45056, GL_LAST = 63488, GL_RED = 63744, GL_RED2 = 64256;
struct GlaP { const bf16_t* P; const float* LA; const float* gain; const float* bias; bf16_t* O; float* SSEG; float* DSUM; };
__device__ __forceinline__ bf16x8 lds_tr_frag2(LAS const unsigned char* base, int row_stride_bytes, int lane, int mulg, int second_off) {
    const int g = lane >> 4, idx = lane & 15, q = idx >> 2, p = idx & 3;
    LAS const unsigned char* a0 = base + (mulg * g + q) * row_stride_bytes + 8 * p;
    const s16x4 r0 = __builtin_amdgcn_ds_read_tr16_b64_v4i16((LAS s16x4*)a0);
    const s16x4 r1 = __builtin_amdgcn_ds_read_tr16_b64_v4i16((LAS s16x4*)(a0 + second_off * row_stride_bytes));
    bf16x8 f; f[0] = r0[0]; f[1] = r0[1]; f[2] = r0[2]; f[3] = r0[3]; f[4] = r1[0]; f[5] = r1[1]; f[6] = r1[2]; f[7] = r1[3]; return f;
}
__device__ __forceinline__ bf16x8 pack8(const f32x4 a, const f32x4 b) { u32x4 w; w.x = cvt_pk_bf16(a[0], a[1]); w.y = cvt_pk_bf16(a[2], a[3]); w.z = cvt_pk_bf16(b[0], b[1]); w.w = cvt_pk_bf16(b[2], b[3]); return __builtin_bit_cast(bf16x8, w); }

__device__ __forceinline__ bf16x8 lds_tr_frag3(LAS const unsigned char* base, int row_stride_bytes, int lane, int pstride_bytes) {
    const int g = lane >> 4, idx = lane & 15, q = idx >> 2, p = idx & 3;
    LAS const unsigned char* a0 = base + (4 * g + q) * row_stride_bytes + pstride_bytes * p;
    const s16x4 r0 = __builtin_amdgcn_ds_read_tr16_b64_v4i16((LAS s16x4*)a0);
    const s16x4 r1 = __builtin_amdgcn_ds_read_tr16_b64_v4i16((LAS s16x4*)(a0 + 16 * row_stride_bytes));
    bf16x8 f; f[0] = r0[0]; f[1] = r0[1]; f[2] = r0[2]; f[3] = r0[3]; f[4] = r1[0]; f[5] = r1[1]; f[6] = r1[2]; f[7] = r1[3]; return f;
}
template <bool PASSC>
__device__ __forceinline__ void glaret_item(LAS unsigned char* lds, const GlaP& gp, const bool gla, const int b, const int h, const int seg, const int sidx  ) {
    int tid = threadIdx.x; asm volatile("" : "+v"(tid));
    const int w = __builtin_amdgcn_readfirstlane(tid >> 6), l = tid & 63, fr = l & 15, fq = l >> 4;
    const int qoff = gla ? P_GQ : P_RQ, koff = gla ? P_GK : P_RK, voff = gla ? P_GV : P_RV, goff = gla ? P_GG : P_RG, ooff = gla ? 0 : 512;
    const float lg = __logf(1.f - exp2f(-5.f - (float)h));
    f32x4 accs[4];
#pragma unroll
    for (int dt = 0; dt < 4; ++dt) accs[dt] = (f32x4){0.f, 0.f, 0.f, 0.f};
    const int arow = 8 * w + (l >> 3), apart = l & 7;
    float dsum[8];
#pragma unroll
    for (int e = 0; e < 8; ++e) dsum[e] = 0.f;
    if (PASSC) {
        for (int sp = 0; sp < seg; ++sp) {
            const float* sg = gp.SSEG + (size_t)(sidx + sp) * 8192 + tid * 16; const float* dsm = gp.DSUM + (size_t)(sidx + sp) * 64;
#pragma unroll
            for (int dt = 0; dt < 4; ++dt) { const f32x4 dv = *(const f32x4*)(dsm + 16 * dt + 4 * fq), sv = *(const f32x4*)(sg + 4 * dt);
#pragma unroll
                for (int r = 0; r < 4; ++r) accs[dt][r] = accs[dt][r] * __expf(dv[r]) + sv[r]; }
        }
#pragma unroll
        for (int dt = 0; dt < 4; ++dt) { u32x2 wv; wv.x = cvt_pk_bf16(accs[dt][0], accs[dt][1]); wv.y = cvt_pk_bf16(accs[dt][2], accs[dt][3]);
            *(LAS u32x2*)(lds + GL_ST + (16 * w + fr) * 144 + 32 * dt + 8 * fq) = wv; }
    }
    const int it = w & 3, ch = w >> 2;
    f32x4 gnv[4], bsv[4];
#pragma unroll
    for (int ct = 0; ct < 4; ++ct) { const int c = 128 * h + 64 * ch + 16 * fq + 4 * ct; gnv[ct] = PASSC ? *(const f32x4*)(gp.gain + c) : (f32x4){0.f, 0.f, 0.f, 0.f};
        bsv[ct] = (PASSC && !gla) ? *(const f32x4*)(gp.bias + c) : (f32x4){0.f, 0.f, 0.f, 0.f}; }
    u32x4 rq = (u32x4){0u, 0u, 0u, 0u}, rk, rv[2]; f32x4 rla[2], rll[2]; u32x4 gnx[2];
    const float rq_s = __expf((float)(arow + 1) * lg), rk_s = __expf(-(float)(arow + 1) * lg), rt_s = __expf((float)(63 - arow) * lg);
#define GL_ISSUE(n_) do { const size_t r0_ = (size_t)b * SEQ + seg * 512 + (n_) * 64; \
        { const size_t ro_ = (r0_ + arow) * 64 + 8 * apart; if (PASSC) rq = *(const u32x4*)(gp.P + (size_t)(qoff + 64 * h) * TG + ro_); rk = *(const u32x4*)(gp.P + (size_t)(koff + 64 * h) * TG + ro_); \
          if (gla) { const float* lp_ = gp.LA + (size_t)h * TG * 64 + ro_; rla[0] = *(const f32x4*)lp_; rla[1] = *(const f32x4*)(lp_ + 4); const float* ll_ = gp.LA + ((size_t)h * TG + r0_ + 63) * 64 + 8 * apart; rll[0] = *(const f32x4*)ll_; rll[1] = *(const f32x4*)(ll_ + 4); } \
          else { rla[0] = (f32x4){0.f, 0.f, 0.f, 0.f}; rla[1] = rla[0]; rll[0] = rla[0]; rll[1] = rla[0]; } } \
        _Pragma("unroll") for (int e_ = 0; e_ < 2; ++e_) { const int p_ = tid + 512 * e_, i_ = p_ >> 4, part_ = p_ & 15; \
            rv[e_] = *(const u32x4*)(gp.P + (size_t)(voff + 128 * h) * TG + (r0_ + i_) * 128 + 8 * part_); } \
        if (PASSC) { _Pragma("unroll") for (int j_ = 0; j_ < 2; ++j_) gnx[j_] = *(const u32x4*)(gp.P + (size_t)(goff + 128 * h) * TG + (r0_ + 16 * it + fr) * 128 + 64 * ch + 16 * fq + 8 * j_); } } while (0)
    GL_ISSUE(0);
    for (int n = 0; n < 8; ++n) {
        const size_t row0 = (size_t)b * SEQ + seg * 512 + n * 64;
#pragma unroll
        for (int e = 0; e < 2; ++e) { const int p = tid + 512 * e, i = p >> 4, part = p & 15; *(LAS u32x4*)(lds + GL_V + i * 272 + part * 16) = rv[e]; }
        { float cum[8], lastv[8];
          const float kk[8] = {bflo(rk.x), bfhi(rk.x), bflo(rk.y), bfhi(rk.y), bflo(rk.z), bfhi(rk.z), bflo(rk.w), bfhi(rk.w)};
          float eq[8], ek[8], et[8];
          if (gla) {
#pragma unroll
              for (int e = 0; e < 8; ++e) { cum[e] = e < 4 ? rla[0][e] : rla[1][e - 4]; lastv[e] = e < 4 ? rll[0][e] : rll[1][e - 4];
                  eq[e] = __expf(cum[e]); ek[e] = __builtin_amdgcn_rcpf(eq[e]); et[e] = __expf(lastv[e]) * ek[e]; }
          } else {
#pragma unroll
              for (int e = 0; e < 8; ++e) { lastv[e] = 64.f * lg; eq[e] = rq_s; ek[e] = rk_s; et[e] = rt_s; } }
#pragma unroll
          for (int e = 0; e < 8; ++e) *(LAS bf16_t*)(lds + GL_KT + (8 * apart + e) * 144 + arow * 2) = f2bf(kk[e] * et[e]);
          if (PASSC) { const float qq[8] = {bflo(rq.x), bfhi(rq.x), bflo(rq.y), bfhi(rq.y), bflo(rq.z), bfhi(rq.z), bflo(rq.w), bfhi(rq.w)};
              u32x4 qw, kw;
              qw.x = cvt_pk_bf16(qq[0] * eq[0], qq[1] * eq[1]); qw.y = cvt_pk_bf16(qq[2] * eq[2], qq[3] * eq[3]); qw.z = cvt_pk_bf16(qq[4] * eq[4], qq[5] * eq[5]); qw.w = cvt_pk_bf16(qq[6] * eq[6], qq[7] * eq[7]);
              kw.x = cvt_pk_bf16(kk[0] * ek[0], kk[1] * ek[1]); kw.y = cvt_pk_bf16(kk[2] * ek[2], kk[3] * ek[3]); kw.z = cvt_pk_bf16(kk[4] * ek[4], kk[5] * ek[5]); kw.w = cvt_pk_bf16(kk[6] * ek[6], kk[7] * ek[7]);
              *(LAS u32x4*)(lds + GL_QD + arow * 144 + 16 * apart) = qw; *(LAS u32x4*)(lds + GL_KD + arow * 144 + 16 * apart) = kw; }
          if (arow == 63) {
#pragma unroll
              for (int e = 0; e < 8; ++e) *(LAS float*)(lds + GL_LAST + (8 * apart + e) * 4) = lastv[e]; }
#pragma unroll
          for (int e = 0; e < 8; ++e) dsum[e] += lastv[e]; }
        u32x4 gates[2];
        if (PASSC) { gates[0] = gnx[0]; gates[1] = gnx[1]; }
        if (n < 7) GL_ISSUE(n + 1);
        WGSYNC();
        f32x4 acco[4];
        if (PASSC) {
            bf16x8 qf[2];
#pragma unroll
            for (int ks = 0; ks < 2; ++ks) qf[ks] = *(LAS const bf16x8*)(lds + GL_QD + (16 * it + fr) * 144 + 16 * fq + 64 * ks);
            f32x4 sc[4];
#pragma unroll
            for (int jt = 0; jt < 4; ++jt) { sc[jt] = (f32x4){0.f, 0.f, 0.f, 0.f};
                if (jt <= it) {
#pragma unroll
                    for (int ks = 0; ks < 2; ++ks) { const bf16x8 kf = *(LAS const bf16x8*)(lds + GL_KD + (16 * jt + fr) * 144 + 16 * fq + 64 * ks);
                        sc[jt] = __builtin_amdgcn_mfma_f32_16x16x32_bf16(kf, qf[ks], sc[jt], 0, 0, 0); }
                    if (jt == it) {
#pragma unroll
                        for (int r = 0; r < 4; ++r) sc[jt][r] = (4 * fq + r <= fr) ? sc[jt][r] : 0.f; } } }
            const bf16x8 pf0 = pack8(sc[0], sc[1]), pf1 = pack8(sc[2], sc[3]);
#pragma unroll
            for (int ct = 0; ct < 4; ++ct) { const int c0 = 64 * ch + 4 * ct; acco[ct] = (f32x4){0.f, 0.f, 0.f, 0.f};
                { const bf16x8 vf = lds_tr_frag3(lds + GL_V + c0 * 2, 272, l, 32); acco[ct] = __builtin_amdgcn_mfma_f32_16x16x32_bf16(vf, pf0, acco[ct], 0, 0, 0); }
                if (it >= 2) { const bf16x8 vf = lds_tr_frag3(lds + GL_V + 32 * 272 + c0 * 2, 272, l, 32); acco[ct] = __builtin_amdgcn_mfma_f32_16x16x32_bf16(vf, pf1, acco[ct], 0, 0, 0); }
#pragma unroll
                for (int ks = 0; ks < 2; ++ks) { const bf16x8 sf = *(LAS const bf16x8*)(lds + GL_ST + (c0 + 16 * (fr >> 2) + (fr & 3)) * 144 + 16 * fq + 64 * ks);
                    acco[ct] = __builtin_amdgcn_mfma_f32_16x16x32_bf16(sf, qf[ks], acco[ct], 0, 0, 0); } }
        }
#pragma unroll
        for (int dt = 0; dt < 4; ++dt) { const f32x4 lv = *(LAS const f32x4*)(lds + GL_LAST + (16 * dt + 4 * fq) * 4);
#pragma unroll
            for (int r = 0; r < 4; ++r) accs[dt][r] *= __expf(lv[r]); }
#pragma unroll
        for (int ks = 0; ks < 2; ++ks) { const bf16x8 vf = lds_tr_frag2(lds + GL_V + (32 * ks) * 272 + (16 * w) * 2, 272, l, 8, 4);
#pragma unroll
            for (int dt = 0; dt < 4; ++dt) { const bf16x8 kf = *(LAS const bf16x8*)(lds + GL_KT + (16 * dt + fr) * 144 + 16 * fq + 64 * ks);
                accs[dt] = __builtin_amdgcn_mfma_f32_16x16x32_bf16(kf, vf, accs[dt], 0, 0, 0); } }
        if (PASSC) {
            float ss = 0.f, sm_ = 0.f;
#pragma unroll
            for (int ct = 0; ct < 4; ++ct)
#pragma unroll
                for (int r = 0; r < 4; ++r) { ss += acco[ct][r] * acco[ct][r]; sm_ += acco[ct][r]; }
            ss += shfl_xor_f(ss, 16); ss += shfl_xor_f(ss, 32); sm_ += shfl_xor_f(sm_, 16); sm_ += shfl_xor_f(sm_, 32);
            if (fq == 0) { *(LAS float*)(lds + GL_RED + ((16 * it + fr) * 2 + ch) * 4) = ss; *(LAS float*)(lds + GL_RED2 + ((16 * it + fr) * 2 + ch) * 4) = sm_; }
        }
        WGSYNC();
        if (PASSC) {
            const int i = 16 * it + fr;
            const float ssum = *(LAS const float*)(lds + GL_RED + (i * 2) * 4) + *(LAS const float*)(lds + GL_RED + (i * 2 + 1) * 4);
            const float msum = *(LAS const float*)(lds + GL_RED2 + (i * 2) * 4) + *(LAS const float*)(lds + GL_RED2 + (i * 2 + 1) * 4);
            float mean, rstd;
            if (gla) { mean = 0.f; rstd = rsqrtf(ssum * (1.f / 128.f) + NORM_EPS); }
            else { mean = msum * (1.f / 128.f); const float var = fmaxf(ssum * (1.f / 128.f) - mean * mean, 0.f); rstd = rsqrtf(var + NORM_EPS); }
            u32x4 ow[2];
#pragma unroll
            for (int ct = 0; ct < 4; ++ct) { const f32x4 gn = gnv[ct], bs = bsv[ct]; const unsigned gw0 = gates[ct >> 1][(ct & 1) * 2], gw1 = gates[ct >> 1][(ct & 1) * 2 + 1];
                const float g0 = bflo(gw0), g1 = bfhi(gw0), g2 = bflo(gw1), g3 = bfhi(gw1);
                ow[ct >> 1][(ct & 1) * 2] = cvt_pk_bf16(((acco[ct][0] - mean) * rstd * gn[0] + bs[0]) * g0, ((acco[ct][1] - mean) * rstd * gn[1] + bs[1]) * g1);
                ow[ct >> 1][(ct & 1) * 2 + 1] = cvt_pk_bf16(((acco[ct][2] - mean) * rstd * gn[2] + bs[2]) * g2, ((acco[ct][3] - mean) * rstd * gn[3] + bs[3]) * g3); }
#pragma unroll
            for (int j = 0; j < 2; ++j) *(u32x4*)(gp.O + (row0 + i) * OLD + ooff + 128 * h + 64 * ch + 16 * fq + 8 * j) = ow[j];
#pragma unroll
            for (int dt = 0; dt < 4; ++dt) { u32x2 wv; wv.x = cvt_pk_bf16(accs[dt][0], accs[dt][1]); wv.y = cvt_pk_bf16(accs[dt][2], accs[dt][3]);
                *(LAS u32x2*)(lds + GL_ST + (16 * w + fr) * 144 + 32 * dt + 8 * fq) = wv; }
        }
    }
#undef GL_ISSUE
    if (!PASSC) {
        float* sg = gp.SSEG + (size_t)(sidx + seg) * 8192 + tid * 16;
#pragma unroll
        for (int dt = 0; dt < 4; ++dt) *(f32x4*)(sg + 4 * dt) = accs[dt];
        if (tid < 8) {
#pragma unroll
            for (int e = 0; e < 8; ++e) gp.DSUM[(size_t)(sidx + seg) * 64 + 8 * apart + e] = dsum[e]; }
    }
    WGSYNC();
}

constexpr int LR_XC = 0, LR_XCF = 2304, LR_AA = 6400, LR_GG = 10496, LR_WAVE = 14592;
struct LruP { const bf16_t* P; const float* cw; const float* cb; const float* ba; const float* bx; const float* sp8; const bf16_t* lw; bf16_t* O; float* LST; };
template <bool PASSC>
__device__ __forceinline__ void lru_wave(LAS unsigned char* lw_, const LruP& lp, const int b, const int seg, const int n, const int l_) {
    int l = l_; asm volatile("" : "+v"(l));
    const float NL2E = -1.4426950408889634f;
    const int fr = l & 15, fq = l >> 4, ch = 64 * n + l;
    bf16x8 wB[8][2];
#pragma unroll
    for (int jt = 0; jt < 8; ++jt)
#pragma unroll
        for (int ks = 0; ks < 2; ++ks) wB[jt][ks] = *(const bf16x8*)(lp.lw + ((size_t)(n * 128 + 16 * jt + fr)) * 64 + 8 * fq + 32 * ks);
    const float w0 = lp.cw[ch], w1 = lp.cw[512 + ch], w2 = lp.cw[1024 + ch], w3 = lp.cw[1536 + ch], cbv = lp.cb[ch];
    float bav[4], bxv[4], spv[4];
#pragma unroll
    for (int jt = 0; jt < 4; ++jt) { const int c2 = 64 * n + 16 * jt + fr; bav[jt] = lp.ba[c2] * NL2E; bxv[jt] = lp.bx[c2] * NL2E; spv[jt] = lp.sp8[c2] * NL2E; }
    const size_t rowb = (size_t)b * SEQ + seg * 128;
    const bf16_t* px = lp.P + (size_t)(P_LX + 64 * n) * TG + rowb * 64;
    const bf16_t* pg = lp.P + (size_t)(P_LG + 64 * n) * TG + rowb * 64;
    bf16_t* po = lp.O + rowb * OLD + 1024 + 64 * n;
    float xm3 = 0.f, xm2 = 0.f, xm1 = 0.f;
    if (seg > 0) { xm3 = bf2f(px[l - 3 * 64]); xm2 = bf2f(px[l - 2 * 64]); xm1 = bf2f(px[l - 64]); }
    float hst = 0.f, ap = 1.f;
    if (PASSC) { const float* st = lp.LST + ((size_t)b * NSEGL * 512 + ch) * 2;
        pg8::f32x2_ ah[31];
#pragma unroll
        for (int e = 0; e < 31; ++e) { const int sp = e < seg ? e : 0; ah[e] = *(const pg8::f32x2_*)(st + (size_t)sp * 1024); }
#pragma unroll
        for (int e = 0; e < 31; ++e) if (e < seg) hst = ah[e][0] * hst + ah[e][1]; }
#define LR_ROWLD(dst, base, t) do { dst = (base)[(t) * 64 + l]; } while (0)
    bf16_t xn[16], gn[16];
#pragma unroll
    for (int t = 0; t < 16; ++t) LR_ROWLD(xn[t], px, t);
    for (int sb = 0; sb < 8; ++sb) {
        float xc[16];
        if (PASSC) {
#pragma unroll
            for (int t = 0; t < 16; ++t) LR_ROWLD(gn[t], pg, sb * 16 + t); }
#pragma unroll
        for (int t = 0; t < 16; ++t) { const float x0 = bf2f(xn[t]); xc[t] = cbv + w0 * xm3 + w1 * xm2 + w2 * xm1 + w3 * x0; xm3 = xm2; xm2 = xm1; xm1 = x0;
            *(LAS bf16_t*)(lw_ + LR_XC + t * 144 + l * 2) = f2bf(xc[t]); }
        if (sb < 7) {
#pragma unroll
            for (int t = 0; t < 16; ++t) LR_ROWLD(xn[t], px, (sb + 1) * 16 + t); }
        __builtin_amdgcn_wave_barrier();
        f32x4 acc[8];
#pragma unroll
        for (int jt = 0; jt < 8; ++jt) { const float bz = jt < 4 ? bav[jt] : bxv[jt - 4]; acc[jt] = (f32x4){bz, bz, bz, bz}; }
#pragma unroll
        for (int ks = 0; ks < 2; ++ks) { const bf16x8 af = *(LAS const bf16x8*)(lw_ + LR_XC + fr * 144 + 16 * fq + 64 * ks);
#pragma unroll
            for (int jt = 0; jt < 8; ++jt) acc[jt] = __builtin_amdgcn_mfma_f32_16x16x32_bf16(af, wB[jt][ks], acc[jt], 0, 0, 0); }
#pragma unroll
        for (int jt = 0; jt < 4; ++jt)
#pragma unroll
            for (int r = 0; r < 4; ++r) { const int tok = 4 * fq + r, j = 16 * jt + fr;
                const float rg = __builtin_amdgcn_rcpf(1.f + __builtin_amdgcn_exp2f(acc[jt][r])), ig = __builtin_amdgcn_rcpf(1.f + __builtin_amdgcn_exp2f(acc[4 + jt][r]));
                const float av = __builtin_amdgcn_exp2f(rg * spv[jt]);
                *(LAS float*)(lw_ + LR_AA + tok * 256 + j * 4) = av; const float em = fmaf(-av, av, 1.f);
                *(LAS float*)(lw_ + LR_GG + tok * 256 + j * 4) = ig * __builtin_amdgcn_sqrtf(em); }
        __builtin_amdgcn_wave_barrier();
#pragma unroll
        for (int t = 0; t < 16; ++t) { const float av = *(LAS const float*)(lw_ + LR_AA + t * 256 + l * 4), gv = *(LAS const float*)(lw_ + LR_GG + t * 256 + l * 4);
            hst = av * hst + gv * xc[t]; ap *= av;
            if (PASSC) { bf16_t* p_ = po + (size_t)(sb * 16 + t) * OLD; asm volatile("" : "+s"(p_)); p_[l] = f2bf(hst * bf2f(gn[t])); } }
        __builtin_amdgcn_wave_barrier();
    }
#undef LR_ROWLD
    if (!PASSC) { float* st = lp.LST + (((size_t)b * NSEGL + seg) * 512 + ch) * 2; st[0] = ap; st[1] = hst; }
}

constexpr int S5_MG = 0, S5_MC = 32768, S5_MM = 65536, S5_MEND = 86016, S5W_STRIDE = 8448;
struct S5P { const bf16_t* P; const bf16_t* SU; const float* sm; const unsigned char* s5m; const float* a128; const float* dd; bf16_t* Y5; float* SST; };
__device__ __forceinline__ float gelu_t(float x) { const float t = x * __builtin_fmaf(x * x, -0.10294324f, -2.3022082f);
    return x * __builtin_amdgcn_rcpf(1.f + __builtin_amdgcn_exp2f(t)); }
template <bool PASSC>
__device__ __forceinline__ void s5_wave(LAS unsigned char* lds, LAS unsigned char* lw_, const S5P& sp_, const int b, const int seg, const int g, const int l_) {
    int l = l_; asm volatile("" : "+v"(l));
    const int fr = l & 15, fq = l >> 4;
    const float a8r = sp_.sm[SM_A8 + (g * 64 + l) * 2], a8i = sp_.sm[SM_A8 + (g * 64 + l) * 2 + 1];
    float xr = 0.f, xi = 0.f;
    f32x4 dv4 = (f32x4){0.f, 0.f, 0.f, 0.f};
    if (PASSC) {
        const float ar = sp_.a128[(g * 64 + l) * 2], ai = sp_.a128[(g * 64 + l) * 2 + 1];
        const float* st = sp_.SST + ((size_t)b * NSEGS * 32 + g) * 128 + l;
        for (int sp0 = 0; sp0 < seg; sp0 += 8) { float er[8], ei[8];
#pragma unroll
            for (int e = 0; e < 8; ++e) { const int sp = sp0 + e < seg ? sp0 + e : seg - 1; er[e] = st[(size_t)sp * 4096]; ei[e] = st[(size_t)sp * 4096 + 64]; }
#pragma unroll
            for (int e = 0; e < 8; ++e) if (sp0 + e < seg) { const float nr = ar * xr - ai * xi + er[e], ni = ar * xi + ai * xr + ei[e]; xr = nr; xi = ni; } }
        dv4 = *(const f32x4*)(sp_.dd + 16 * g + 4 * fq);
    }
    const size_t rowb = (size_t)b * SEQ + seg * 512;
    bf16x8 ufn[4];
#pragma unroll
    for (int ks = 0; ks < 4; ++ks) ufn[ks] = *(const bf16x8*)(sp_.SU + ((size_t)g * TG + rowb + 8 * fr + 2 * ks + (fq >> 1)) * 16 + 8 * (fq & 1));
    for (int sup = 0; sup < 4; ++sup) {
        const size_t r0 = rowb + sup * 128;
        bf16x8 uf[4];
#pragma unroll
        for (int ks = 0; ks < 4; ++ks) uf[ks] = ufn[ks];
        if (sup < 3) {
#pragma unroll
            for (int ks = 0; ks < 4; ++ks) ufn[ks] = *(const bf16x8*)(sp_.SU + ((size_t)g * TG + r0 + 128 + 8 * fr + 2 * ks + (fq >> 1)) * 16 + 8 * (fq & 1)); }
        u32x2 us[8];
        if (PASSC) {
#pragma unroll
            for (int mt = 0; mt < 8; ++mt) us[mt] = *(const u32x2*)(sp_.SU + ((size_t)g * TG + r0 + 8 * fr + mt) * 16 + 4 * fq); }
#pragma unroll
        for (int mt = 0; mt < 8; ++mt) { f32x4 ga = (f32x4){0.f, 0.f, 0.f, 0.f};
#pragma unroll
            for (int ks = 0; ks < 4; ++ks) ga = __builtin_amdgcn_mfma_f32_16x16x32_bf16(*(LAS const bf16x8*)(lds + S5_MG + ((mt * 4 + ks) * 64 + l) * 16), uf[ks], ga, 0, 0, 0);
            *(LAS f32x4*)(lw_ + fr * 528 + (16 * mt + 4 * fq) * 4) = ga; }
        __builtin_amdgcn_wave_barrier();
        pg8::f32x2_ gv[16];
#pragma unroll
        for (int t = 0; t < 16; ++t) gv[t] = *(LAS const pg8::f32x2_*)(lw_ + t * 528 + l * 8);
        __builtin_amdgcn_wave_barrier();
#pragma unroll
        for (int t = 0; t < 16; ++t) {
            if (PASSC) *(LAS unsigned*)(lw_ + t * 528 + l * 4) = cvt_pk_bf16(xr, xi);
            const float nr = __builtin_fmaf(a8r, xr, __builtin_fmaf(-a8i, xi, gv[t][0])), ni = __builtin_fmaf(a8r, xi, __builtin_fmaf(a8i, xr, gv[t][1])); xr = nr; xi = ni; }
        if (PASSC) {
            __builtin_amdgcn_wave_barrier();
            bf16x8 xf[4];
#pragma unroll
            for (int ks = 0; ks < 4; ++ks) xf[ks] = *(LAS const bf16x8*)(lw_ + fr * 528 + (32 * ks + 8 * fq) * 2);
#pragma unroll
            for (int mt = 0; mt < 8; ++mt) { f32x4 ya = (f32x4){0.f, 0.f, 0.f, 0.f}; const int cb = mt < 1 ? 0 : mt < 2 ? 1 : mt < 3 ? 2 : mt < 4 ? 4 : mt < 5 ? 6 : mt < 6 ? 9 : mt < 7 ? 12 : 16;
#pragma unroll
                for (int ks = 0; ks < 4; ++ks) if (2 * ks <= mt) ya = __builtin_amdgcn_mfma_f32_16x16x32_bf16(*(LAS const bf16x8*)(lds + S5_MM + ((cb + ks) * 64 + l) * 16), uf[ks], ya, 0, 0, 0);
#pragma unroll
                for (int ks = 0; ks < 4; ++ks) ya = __builtin_amdgcn_mfma_f32_16x16x32_bf16(*(LAS const bf16x8*)(lds + S5_MC + ((mt * 4 + ks) * 64 + l) * 16), xf[ks], ya, 0, 0, 0);
                u32x2 yw; yw.x = cvt_pk_bf16(gelu_t(ya[0] + dv4[0] * bflo(us[mt].x)), gelu_t(ya[1] + dv4[1] * bfhi(us[mt].x))); yw.y = cvt_pk_bf16(gelu_t(ya[2] + dv4[2] * bflo(us[mt].y)), gelu_t(ya[3] + dv4[3] * bfhi(us[mt].y)));
                *(u32x2*)(sp_.Y5 + (r0 + 8 * fr + mt) * BW + 16 * g + 4 * fq) = yw; }
        }
        __builtin_amdgcn_wave_barrier();
    }
    if (!PASSC) { float* st = sp_.SST + (((size_t)b * NSEGS + seg) * 32 + g) * 128 + l; st[0] = xr; st[64] = xi; }
}

template <bool PASSC>
__device__ __forceinline__ void phase_mixers(LAS unsigned char* lds, const Args& a, const int l, const int G) {
    const int mmask = a.mmask; int bx = blockIdx.x; asm volatile("" : "+s"(bx));
    unsigned char* ws = a.ws; const float* sm = (const float*)(ws + WS_SMALL + (size_t)l * SMALL_STRIDE);
    const bf16_t* P = (const bf16_t*)(ws + WS_P); float* ST = (float*)(ws + WS_ST);
    if (mmask & 1) { GlaP gp0{P, (const float*)(ws + WS_LA), a.in[I_GNG] + l * 512, nullptr, (bf16_t*)(ws + WS_O), ST + ST_GSEG, ST + ST_GDS};
      GlaP gp1{P, (const float*)(ws + WS_LA), a.in[I_RNG] + l * 512, a.in[I_RNB] + l * 512, (bf16_t*)(ws + WS_O), ST + ST_GSEG, ST + ST_GDS};
      for (int itx = bx; itx < 2 * BG * 4 * NSEGG; itx += G) { const int mix = itx / (BG * 4 * NSEGG), rest = itx % (BG * 4 * NSEGG), b = rest / (4 * NSEGG), h = (rest / NSEGG) & 3, seg = rest % NSEGG;
          const int sidx = ((mix * BG + b) * 4 + h) * NSEGG;
          if (!PASSC && seg == NSEGG - 1) continue;
          if (mix == 0) glaret_item<PASSC>(lds, gp0, true, b, h, seg, sidx); else glaret_item<PASSC>(lds, gp1, false, b, h, seg, sidx); } }
    int tid = threadIdx.x; asm volatile("" : "+v"(tid));
    const int w = __builtin_amdgcn_readfirstlane(tid >> 6), ln = tid & 63;
    if (mmask & 2) { LruP lp{P, a.in[I_LCW] + l * 2048, a.in[I_LCB] + l * 512, a.in[I_LBA] + l * 512, a.in[I_LBX] + l * 512, sm + SM_SP8, (const bf16_t*)((const unsigned char*)sm + SM_LRUW_BYTES), (bf16_t*)(ws + WS_O), ST + ST_LRU};
      for (int itx = bx; itx < BG * NSEGL; itx += G) { if (!PASSC && itx % NSEGL == NSEGL - 1) continue; lru_wave<PASSC>(lds + w * LR_WAVE, lp, itx / NSEGL, itx % NSEGL, w, ln); } }
    if (mmask & 4) { S5P sp_{P, (const bf16_t*)(ws + WS_SU2), sm, ws + WS_S5M + (size_t)l * 32 * S5M_BYTES, sm + SM_A128, a.in[I_SD] + l * 512, (bf16_t*)(ws + WS_Y5), ST + ST_S5};
      for (int itx = bx; itx < 32 * 8; itx += G) { const int g = 4 * (itx & 7) + ((itx >> 3) & 3), q = (itx >> 5) * 8 + w;
          WGSYNC();
          { const unsigned char* src = sp_.s5m + (size_t)g * S5M_BYTES; const int nb = PASSC ? S5_MEND : S5_MC;
            for (int o = tid * 16; o < nb; o += 8192) *(LAS u32x4*)(lds + o) = *(const u32x4*)(src + o); }
          WGSYNC();
          if (PASSC || (q & 7) != NSEGS - 1) s5_wave<PASSC>(lds, lds + S5_MEND + w * S5W_STRIDE, sp_, q >> 3, q & 7, g, ln); } }
    WGSYNC();
}

constexpr int NPH = 8, NSTEPS = 1 + NGRP * DEPTH * NPH;
constexpr int LDS_BYTES = 163840, LDS_MISC = 163840 - 512;
static_assert(S5_MEND + 8 * S5W_STRIDE <= LDS_MISC, "S5 LDS");

__global__ void __launch_bounds__(512, 2) mk_fwd(Args a) {
    __shared__ __attribute__((aligned(16))) unsigned char lds_raw[LDS_BYTES];
    LAS unsigned char* lds = (LAS unsigned char*)lds_raw;
    volatile LAS unsigned* MISC = (volatile LAS unsigned*)(lds + LDS_MISC);
    const int G = gridDim.x;
    if (threadIdx.x < 32) MISC[threadIdx.x] = 0u;
    wg_syncthreads();
    unsigned* ctl = (unsigned*)(a.ws + WS_CTL);
    XcdBarrier bar = xcd_barrier_post(ctl + CW_BAR + a.li * XCD_BAR_WORDS, MISC + 8);
    const int ngw = G * 8, gthreads = G * 512;
#define LTID(v) int v = threadIdx.x; asm volatile("" : "+v"(v))
#define LBID(v) int v = blockIdx.x; asm volatile("" : "+s"(v))
#define IN(s) (a.s_lo <= (s) && (s) < a.s_hi)
#define SEAM(s) do { if ((s) + 1 < a.s_hi) xcd_barrier(bar); } while (0)
    if (IN(0)) { LTID(t_); phase_prologue(lds, a, blockIdx.x * 512 + t_, gthreads); xcd_barrier(bar); phase_prologue2(a, blockIdx.x * 512 + t_, gthreads); xcd_barrier(bar); phase_prologue3(a, blockIdx.x * 512 + t_, gthreads); SEAM(0); }
    for (int gl = 0; gl < NGRP * DEPTH; ++gl) {
        const int grp = gl >> 2, l = gl & 3, s0 = 1 + gl * NPH;
        if (a.s_hi <= s0 || a.s_lo >= s0 + NPH) continue;
        unsigned char* ws = a.ws;
        const bf16_t* Wl = (const bf16_t*)(ws + WS_W + (size_t)l * W_STRIDE);
        const float* sm = (const float*)(ws + WS_SMALL + (size_t)l * SMALL_STRIDE);
        bf16_t* U = (bf16_t*)(ws + WS_U); bf16_t* P = (bf16_t*)(ws + WS_P); float* LA = (float*)(ws + WS_LA);
        bf16_t* O = (bf16_t*)(ws + WS_O); bf16_t* Y5 = (bf16_t*)(ws + WS_Y5); unsigned char* PGb = ws + WS_PG;
        const float* xg = a.in[I_X] + (size_t)grp * TG * D; float* og = a.out + (size_t)grp * TG * D;
        const float* hin = (l <= 1) ? xg : og;
        bf16_t* DLT = (bf16_t*)(ws + WS_O);
        (void)sm;
        if (IN(s0 + 0)) { LTID(t_); LBID(bx_); const int gw_ = bx_ * 8 + __builtin_amdgcn_readfirstlane(t_ >> 6);
            if (l == 0) phase_norm<false, false>(hin, DLT, og, a.in[I_NG] + l * D, U, gw_, ngw, t_ & 63); else phase_norm<false, true>(hin, DLT, og, a.in[I_NG] + l * D, U, gw_, ngw, t_ & 63);
            SEAM(s0 + 0); }
        if (IN(s0 + 1)) {
            pg8::Gemm g{U, Wl, TG, N_ALL, D, D, D, 0, 0}; pg8::StaticOrder S; LBID(bx_); S.init(TG, N_ALL, G, bx_, 0, 256, WGM_G1);
            EpiIn E{P, LA, a.in[I_GBLR] + l * 256, (const float*)(ws + WS_ROT), PGb, (bf16_t*)(ws + WS_SU2)};
            GEMM_CALL(EpiIn);
            SEAM(s0 + 1);
        }
        if (IN(s0 + 2)) { phase_mixers<false>(lds, a, l, G); SEAM(s0 + 2); }
        if (IN(s0 + 3)) { phase_mixers<true>(lds, a, l, G); SEAM(s0 + 3); }
        if (IN(s0 + 4)) {
            { pg8::Gemm g{Y5, (const bf16_t*)((const unsigned char*)Wl + WO_GLU), TG, BW, BW, BW, BW, 0, 0}; pg8::StaticOrder S; LBID(bx_); S.init(TG, BW, G, bx_, 0, 256, WGM_GLU);
              EpiGlu E{Y5, P, a.in[I_SGB] + l * BW, O};
              GEMM_CALL(EpiGlu); }
            SEAM(s0 + 4);
        }
        if (IN(s0 + 6)) {
            { pg8::Gemm g{O, (const bf16_t*)((const unsigned char*)Wl + WO_BR), TG, D, BW, OLD, BW, (size_t)BW * 2, (size_t)D * BW * 2}; pg8::StaticOrder S; LBID(bx_); S.init(TG, D, G, bx_, 2, 128, WGM_G2);
              EpiBr E{PGb, U};
              pg8::gemm_phase_hn<EpiBr, pg8::StaticOrder>(lds, g, S, E); }
            SEAM(s0 + 6);
        }
        if (IN(s0 + 7)) {
            if (a.fin != 2) { pg8::Gemm g{U, (const bf16_t*)((const unsigned char*)Wl + WO_OUT), TG, D, D, D, D, 0, 0}; pg8::StaticOrder S; LBID(bx_); S.init(TG, D, G, bx_, 0, 256, WGM_G3);
              EpiOut E{DLT};
              GEMM_CALL(EpiOut); }
            if (l == 3 && a.fin) { if (a.fin == 1) xcd_barrier(bar); LTID(t_); phase_norm<true, true>(og, DLT, og, a.in[I_FNG], U, blockIdx.x * 8 + __builtin_amdgcn_readfirstlane(t_ >> 6), ngw, t_ & 63); }
            SEAM(s0 + 7);
        }
    }
#undef IN
#undef SEAM
}

extern "C" void kernel_launch(void* const* d_in, const int* in_sizes, int n_in, void* d_out, int out_size, void* d_ws, size_t ws_size, hipStream_t stream) {
    static int grid = 0;
    if (grid == 0) {
        static const int exp_sizes[29] = {67108864, 4096, 21037056, 16384, 1024, 2048, 2048, 2048, 8192, 2048, 131072, 2048, 131072, 2048, 2048, 8192, 8192, 131072, 131072, 131072, 131072, 2048, 128, 1048576, 2048, 16777216, 8388608, 4194304, 1024};
        bool ok_sizes = (n_in == 29); if (ok_sizes) for (int i = 0; i < 29; ++i) if (in_sizes[i] != exp_sizes[i]) { fprintf(stderr, "kernel_launch: input %d has %d elements, expected %d\n", i, in_sizes[i], exp_sizes[i]); ok_sizes = false; }
        if (!ok_sizes || out_size != NB * SEQ * D || ws_size < WS_END) { fprintf(stderr, "kernel_launch: unexpected shapes (n_in %d out %d ws %zu)\n", n_in, out_size, ws_size); grid = -1; return; }
        int dev = 0, cus = 0, per_cu = 0;
        hipGetDevice(&dev); hipDeviceGetAttribute(&cus, hipDeviceAttributeMultiprocessorCount, dev);
        hipOccupancyMaxActiveBlocksPerMultiprocessor(&per_cu, (const void*)mk_fwd, 512, 0);
        (void)hipGetLastError();
        grid = cus > 0 ? cus : 256;
        if (per_cu < 1) fprintf(stderr, "kernel_launch: occupancy query says %d\n", per_cu);
    }
    if (grid < 0) return;
    hipMemsetAsync((char*)d_ws + WS_CTL, 0, CTL_BYTES, stream);
    Args a{};
    for (int i = 0; i < 29; ++i) a.in[i] = (const float*)d_in[i];
    a.out = (float*)d_out; a.ws = (unsigned char*)d_ws;
    unsigned char* ws = (unsigned char*)d_ws;
    int li = 0;
    auto run = [&](int lo, int hi, int fin = 1, int mm = 7) { a.s_lo = lo; a.s_hi = hi; a.li = li++; a.fin = fin; a.mmask = mm; a.pad2 = 0; hipLaunchKernelGGL(mk_fwd, dim3(grid), dim3(512), 0, stream, a); };
    run(0, NSTEPS);
}
#if defined(__HIP_DEVICE_COMPILE__)
#pragma clang attribute pop
#endif
```

```cpp
#include <hip/hip_runtime.h>
#ifndef WGM_G1
#define WGM_G1 4
#endif
#ifndef WGM_G2
#define WGM_G2 8
#endif
#ifndef WGM_G3
#define WGM_G3 8
#endif
#ifndef WGM_GLU
#define WGM_GLU 8
#endif
#include <cstdio>
#include <cstdint>
#if defined(__HIP_DEVICE_COMPILE__)
#pragma clang attribute push(__attribute__((target("no-packed-fp32-ops"))), apply_to = function)
#endif


namespace pg8 {
#define PG8_LAS __attribute__((address_space(3)))
typedef unsigned short bf16_t;
typedef short bf16x8 __attribute__((ext_vector_type(8)));
typedef float f32x4 __attribute__((ext_vector_type(4)));
typedef unsigned u32x4 __attribute__((ext_vector_type(4)));
typedef unsigned u32x2 __attribute__((ext_vector_type(2)));
constexpr int BM = 256, BK = 64, HALF = 128, HTB = HALF * BK * 2, STAGE_BYTES = 8 * HTB, NXCD = 8;

__host__ __device__ __forceinline__ int lds_byte(int r, int c) { const int st = (r >> 4) * 2 + (c >> 5), rr = r & 15, cc = c & 31, ob = rr * 64 + cc * 2; return st * 1024 + (ob ^ (((ob >> 9) & 1) << 5)); }
__host__ __device__ __forceinline__ void stage_rc(int b, int& R, int& C) { const int st = b / 1024, sb = b % 1024, swz = sb ^ (((sb >> 9) & 1) << 5); R = (st >> 1) * 16 + swz / 64; C = (st & 1) * 32 + (swz % 64) / 2; }
__host__ __device__ __forceinline__ int perm32(int rho) { const int n = rho >> 4, i = rho & 15; return 8 * (i >> 2) + 4 * n + (i & 3); }

struct Unit { int pm, pn, z; };
struct Gemm { const bf16_t* A; const bf16_t* Bt; int M, N, K, lda, ldb; size_t zA, zB; };

struct StaticOrder {
    int nM, nN, nwg, G, c, zsh, WGM;
    __host__ __device__ void init(int M, int N, int G_, int c_, int zsh_ = 0, int bn_ = BM, int wgm_ = 4) { nM = M / BM; nN = N / bn_; nwg = nM * nN; G = G_; c = c_; zsh = zsh_; WGM = wgm_; }
    __host__ __device__ bool next(int i, Unit& u) const {
        const int ti = i >> zsh; u.z = i & ((1 << zsh) - 1);
        const long L = (long)ti * G + c; if (L >= nwg) return false;
        int wgid = (int)L; { const int q = nwg / NXCD, r = nwg % NXCD, xcd = wgid % NXCD, off = wgid / NXCD; wgid = (xcd < r ? xcd * (q + 1) : r * (q + 1) + (xcd - r) * q) + off; }
        const int nig = WGM * nN, gid = wgid / nig, fm = gid * WGM, gsz = (nM - fm) < WGM ? (nM - fm) : WGM;
        u.pm = fm + ((wgid % nig) % gsz); u.pn = (wgid % nig) / gsz; return true;
    }
    __device__ __forceinline__ void a_ready(const Unit&) const {}
    __device__ __forceinline__ void done(const Unit&) const {}
};

typedef float f32x2_ __attribute__((ext_vector_type(2)));
typedef __bf16 bf16x2_ __attribute__((ext_vector_type(2)));
__device__ __forceinline__ unsigned cvt_pk_bf16(float lo, float hi) { const f32x2_ v = {lo, hi}; const bf16x2_ b = __builtin_convertvector(v, bf16x2_); return __builtin_bit_cast(unsigned, b); }

template <class Epi, class Sched, bool ALIGN_EPI = false, bool SP2 = false, bool HALFN = false>
__device__ __forceinline__ void gemm_phase(PG8_LAS unsigned char* lds, const Gemm g, const Sched& S, const Epi& E) {
    int tid = threadIdx.x; asm volatile("" : "+v"(tid));
    const int wid = __builtin_amdgcn_readfirstlane(tid >> 6), lane = tid & 63, wr = wid >> 2, wc = wid & 3, fr = lane & 15, fq = lane >> 4;
    const int K = g.K, nt = K / BK;
    unsigned voffA[2], voffB[2];
#pragma unroll
    for (int i = 0; i < 2; ++i) { int R, C; stage_rc(tid * 16 + i * 8192, R, C); const int Rb = Epi::PERM ? ((R & ~31) + perm32(R & 31)) : R;
        voffA[i] = (unsigned)(R * g.lda + C) * 2u; voffB[i] = (unsigned)(Rb * g.ldb + C) * 2u; }
    const size_t kstep = (size_t)(BK * 2);
    const size_t hstepA = (size_t)HALF * g.lda * 2, hstepB = (size_t)HALF * g.ldb * 2;
    const size_t tstepA = 2 * hstepA, tstepB = HALFN ? hstepB : 2 * hstepB;
    const unsigned ldsw = (unsigned)wid * 1024u;
    unsigned aoff = (unsigned)lds_byte(wr * 64 + fr, fq * 8), boff = (unsigned)lds_byte(wc * 32 + fr, fq * 8) + 4u * HTB;
    asm volatile("" : "+v"(aoff), "+v"(boff));
#define PG8_SA(b, h) (((b) * 2 + (h)) * HTB)
#define PG8_SB(b, h) ((4 + (b) * 2 + (h)) * HTB)
#define PG8_STAGE(bufoff, gbase, voff) do { _Pragma("unroll") for (int _i = 0; _i < 2; ++_i) \
        __builtin_amdgcn_global_load_lds((const unsigned*)((const char*)(gbase) + (voff)[_i]), (PG8_LAS unsigned*)(lds + (bufoff) + ldsw + _i * 8192), 16, 0, 0); } while (0)
#define PG8_LDA(dst, b, h) do { _Pragma("unroll") for (int m = 0; m < 4; ++m) _Pragma("unroll") for (int k = 0; k < 2; ++k) dst[m][k] = *(const PG8_LAS bf16x8*)(lds + aoff + (PG8_SA(b, h) + m * 2048 + k * 1024)); } while (0)
#define PG8_LDB(dst, b, h) do { _Pragma("unroll") for (int n = 0; n < 2; ++n) _Pragma("unroll") for (int k = 0; k < 2; ++k) dst[n][k] = *(const PG8_LAS bf16x8*)(lds + boff + (((b) * 2 + (h)) * HTB + n * 2048 + k * 1024)); } while (0)
#define PG8_MMA(ai, bj, At, Bt) do { __builtin_amdgcn_s_setprio(1); _Pragma("unroll") for (int m = 0; m < 4; ++m) _Pragma("unroll") for (int n = 0; n < 2; ++n) _Pragma("unroll") for (int k = 0; k < 2; ++k) \
        acc[ai][bj][m][n] = __builtin_amdgcn_mfma_f32_16x16x32_bf16(Bt[n][k], At[m][k], acc[ai][bj][m][n], 0, 0, 0); __builtin_amdgcn_s_setprio(0); } while (0)
#define PG8_WAIT_V(n) asm volatile("s_waitcnt vmcnt(" #n ")" ::: "memory")
#define PG8_WAIT_L(n) asm volatile("s_waitcnt lgkmcnt(" #n ")" ::: "memory")
#define PG8_BAR __builtin_amdgcn_s_barrier()
#define PG8_SCHED __builtin_amdgcn_sched_barrier(0)
    Unit cur, nxt; int ui = 0;
    if (!S.next(0, cur)) return;
    f32x4 acc[2][2][4][2];
#pragma unroll
    for (int a = 0; a < 2; ++a)
#pragma unroll
        for (int b = 0; b < 2; ++b)
#pragma unroll
            for (int m = 0; m < 4; ++m)
#pragma unroll
                for (int n = 0; n < 2; ++n) acc[a][b][m][n] = (f32x4){0.f, 0.f, 0.f, 0.f};
    bf16x8 At[4][2], B0[2][2], B1[2][2];
    const char* cA = (const char*)g.A + (size_t)cur.pm * tstepA + (size_t)cur.z * g.zA; const char* cB = (const char*)g.Bt + (size_t)cur.pn * tstepB + (size_t)cur.z * g.zB;
    S.a_ready(cur);
    if constexpr (SP2 && HALFN) {
        PG8_STAGE(PG8_SB(0, 0), cB, voffB); PG8_STAGE(PG8_SA(0, 0), cA, voffA); PG8_STAGE(PG8_SA(0, 1), cA + hstepA, voffA);
        if (wr == 1) PG8_BAR;
        PG8_WAIT_V(2); PG8_BAR;
        PG8_STAGE(PG8_SB(1, 0), cB + kstep, voffB); PG8_STAGE(PG8_SA(1, 0), cA + kstep, voffA);
        PG8_WAIT_V(4); PG8_BAR;
    } else if constexpr (SP2) {
        PG8_STAGE(PG8_SB(0, 0), cB, voffB); PG8_STAGE(PG8_SB(0, 1), cB + hstepB, voffB); PG8_STAGE(PG8_SA(0, 0), cA, voffA); PG8_STAGE(PG8_SA(0, 1), cA + hstepA, voffA);
        if (wr == 1) PG8_BAR;
        PG8_WAIT_V(2); PG8_BAR;
        PG8_STAGE(PG8_SB(1, 0), cB + kstep, voffB); PG8_STAGE(PG8_SA(1, 0), cA + kstep, voffA); PG8_STAGE(PG8_SB(1, 1), cB + hstepB + kstep, voffB);
        PG8_WAIT_V(6); PG8_BAR;
    } else {
        PG8_STAGE(PG8_SB(0, 0), cB, voffB); PG8_STAGE(PG8_SA(0, 0), cA, voffA); PG8_STAGE(PG8_SB(0, 1), cB + hstepB, voffB); PG8_STAGE(PG8_SA(0, 1), cA + hstepA, voffA);
        if (wr == 1) PG8_BAR;
        PG8_WAIT_V(4); PG8_BAR;
        PG8_STAGE(PG8_SB(1, 0), cB + kstep, voffB); PG8_STAGE(PG8_SA(1, 0), cA + kstep, voffA); PG8_STAGE(PG8_SB(1, 1), cB + hstepB + kstep, voffB);
        PG8_WAIT_V(6); PG8_BAR;
    }
    for (;;) {
        const bool has_next = S.next(ui + 1, nxt);
        const char* nA = has_next ? (const char*)g.A + (size_t)nxt.pm * tstepA + (size_t)nxt.z * g.zA : cA; const char* nB = has_next ? (const char*)g.Bt + (size_t)nxt.pn * tstepB + (size_t)nxt.z * g.zB : cB;
        for (int t = 0; t < nt; t += 2) {
            const bool last = (t == nt - 2);
            const char* a1 = cA + (size_t)(t + 1) * kstep;
            const char* a2 = last ? nA : cA + (size_t)(t + 2) * kstep; const char* b2 = last ? nB : cB + (size_t)(t + 2) * kstep;
            const char* a3 = a2 + kstep; const char* b3 = b2 + kstep;
            if (last && has_next) S.a_ready(nxt);
            if constexpr (SP2 && HALFN) {
            PG8_LDB(B0, 0, 0); PG8_SCHED; PG8_LDA(At, 0, 0); PG8_STAGE(PG8_SA(1, 1), a1 + hstepA, voffA);
            PG8_WAIT_V(6); PG8_WAIT_L(0); PG8_BAR; PG8_MMA(0, 0, At, B0); PG8_BAR; PG8_SCHED;
            PG8_LDA(At, 0, 1); PG8_STAGE(PG8_SB(0, 0), b2, voffB); PG8_STAGE(PG8_SA(0, 0), a2, voffA);
            PG8_WAIT_V(6); PG8_WAIT_L(0); PG8_BAR; PG8_MMA(1, 0, At, B0); PG8_BAR; PG8_SCHED;
            PG8_LDB(B0, 1, 0); PG8_SCHED; PG8_LDA(At, 1, 0); PG8_STAGE(PG8_SA(0, 1), a2 + hstepA, voffA);
            PG8_WAIT_V(6); PG8_WAIT_L(0); PG8_BAR; PG8_MMA(0, 0, At, B0); PG8_BAR; PG8_SCHED;
            PG8_LDA(At, 1, 1); PG8_STAGE(PG8_SB(1, 0), b3, voffB); PG8_STAGE(PG8_SA(1, 0), a3, voffA);
            PG8_WAIT_V(6); PG8_WAIT_L(0); PG8_BAR; PG8_MMA(1, 0, At, B0); PG8_BAR; PG8_SCHED;
            } else if constexpr (SP2) {
            PG8_LDB(B0, 0, 0); PG8_LDB(B1, 0, 1); PG8_SCHED; PG8_LDA(At, 0, 0); PG8_STAGE(PG8_SA(1, 1), a1 + hstepA, voffA);
            PG8_WAIT_V(8); PG8_WAIT_L(0); PG8_BAR; PG8_MMA(0, 0, At, B0); PG8_MMA(0, 1, At, B1); PG8_BAR; PG8_SCHED;
            PG8_LDA(At, 0, 1); PG8_STAGE(PG8_SB(0, 0), b2, voffB); PG8_STAGE(PG8_SB(0, 1), b2 + hstepB, voffB); PG8_STAGE(PG8_SA(0, 0), a2, voffA);
            PG8_WAIT_V(8); PG8_WAIT_L(0); PG8_BAR; PG8_MMA(1, 0, At, B0); PG8_MMA(1, 1, At, B1); PG8_BAR; PG8_SCHED;
            PG8_LDB(B0, 1, 0); PG8_LDB(B1, 1, 1); PG8_SCHED; PG8_LDA(At, 1, 0); PG8_STAGE(PG8_SA(0, 1), a2 + hstepA, voffA);
            PG8_WAIT_V(8); PG8_WAIT_L(0); PG8_BAR; PG8_MMA(0, 0, At, B0); PG8_MMA(0, 1, At, B1); PG8_BAR; PG8_SCHED;
            PG8_LDA(At, 1, 1); PG8_STAGE(PG8_SB(1, 0), b3, voffB); PG8_STAGE(PG8_SB(1, 1), b3 + hstepB, voffB); PG8_STAGE(PG8_SA(1, 0), a3, voffA);
            PG8_WAIT_V(8); PG8_WAIT_L(0); PG8_BAR; PG8_MMA(1, 0, At, B0); PG8_MMA(1, 1, At, B1); PG8_BAR; PG8_SCHED;
            } else {
            PG8_LDB(B0, 0, 0); PG8_SCHED; PG8_LDA(At, 0, 0); PG8_STAGE(PG8_SA(1, 1), a1 + hstepA, voffA);
            PG8_WAIT_L(8); PG8_BAR; PG8_WAIT_L(0); PG8_MMA(0, 0, At, B0); PG8_BAR; PG8_SCHED;
            PG8_LDB(B1, 0, 1); PG8_STAGE(PG8_SB(0, 0), b2, voffB);
            PG8_BAR; PG8_WAIT_L(0); PG8_MMA(0, 1, At, B1); PG8_BAR;
            PG8_LDA(At, 0, 1); PG8_STAGE(PG8_SA(0, 0), a2, voffA);
            PG8_BAR; PG8_WAIT_L(0); PG8_MMA(1, 0, At, B0); PG8_BAR; PG8_SCHED;
            PG8_STAGE(PG8_SB(0, 1), b2 + hstepB, voffB);
            PG8_WAIT_V(6); PG8_BAR; PG8_MMA(1, 1, At, B1); PG8_BAR;
            PG8_LDB(B0, 1, 0); PG8_SCHED; PG8_LDA(At, 1, 0); PG8_STAGE(PG8_SA(0, 1), a2 + hstepA, voffA);
            PG8_WAIT_L(8); PG8_BAR; PG8_WAIT_L(0); PG8_MMA(0, 0, At, B0); PG8_BAR; PG8_SCHED;
            PG8_LDB(B1, 1, 1); PG8_STAGE(PG8_SB(1, 0), b3, voffB);
            PG8_BAR; PG8_WAIT_L(0); PG8_MMA(0, 1, At, B1); PG8_BAR;
            PG8_LDA(At, 1, 1); PG8_STAGE(PG8_SA(1, 0), a3, voffA);
            PG8_BAR; PG8_WAIT_L(0); PG8_MMA(1, 0, At, B0); PG8_BAR; PG8_SCHED;
            PG8_STAGE(PG8_SB(1, 1), b3 + hstepB, voffB);
            PG8_WAIT_V(6); PG8_BAR; PG8_MMA(1, 1, At, B1); PG8_BAR;
            }
        }
        if constexpr (ALIGN_EPI) { if (wr == 0) PG8_BAR; }
        { int fr_e = fr, fq_e = fq; asm volatile("" : "+v"(fr_e), "+v"(fq_e));
          E(acc, cur, wr, wc, fr_e, fq_e); }
        if (!has_next) break;
        if (!HALFN && !(Epi::KEEP && cur.z != 3)) {
#pragma unroll
        for (int a = 0; a < 2; ++a)
#pragma unroll
            for (int b = 0; b < 2; ++b)
#pragma unroll
                for (int m = 0; m < 4; ++m)
#pragma unroll
                    for (int n = 0; n < 2; ++n) acc[a][b][m][n] = (f32x4){0.f, 0.f, 0.f, 0.f};
        }
        cur = nxt; cA = nA; cB = nB; ++ui;
        if constexpr (ALIGN_EPI) { if (wr == 1) PG8_BAR; }
    }
    PG8_WAIT_V(0);
    if constexpr (!ALIGN_EPI) { if (wr == 0) PG8_BAR; }
    PG8_BAR;
#undef PG8_SA
#undef PG8_SB
#undef PG8_STAGE
#undef PG8_LDA
#undef PG8_LDB
#undef PG8_MMA
#undef PG8_WAIT_V
#undef PG8_WAIT_L
#undef PG8_BAR
#undef PG8_SCHED
}

template <class Epi, class Sched>
__device__ __forceinline__ void gemm_phase_hn(PG8_LAS unsigned char* lds, const Gemm g, const Sched& S, const Epi& E) {
    int tid = threadIdx.x; asm volatile("" : "+v"(tid));
    const int wid = __builtin_amdgcn_readfirstlane(tid >> 6), lane = tid & 63, wr = wid >> 2, wc = wid & 3, fr = lane & 15, fq = lane >> 4;
    const int K = g.K, nt = K / BK;
    unsigned voffA[2], voffB[2];
#pragma unroll
    for (int i = 0; i < 2; ++i) { int R, C; stage_rc(tid * 16 + i * 8192, R, C); const int Rb = Epi::PERM ? ((R & ~31) + perm32(R & 31)) : R;
        voffA[i] = (unsigned)(R * g.lda + C) * 2u; voffB[i] = (unsigned)(Rb * g.ldb + C) * 2u; }
    const size_t kstep = (size_t)(BK * 2);
    const size_t hstepA = (size_t)HALF * g.lda * 2, hstepB = (size_t)HALF * g.ldb * 2;
    const size_t tstepA = 2 * hstepA, tstepB = hstepB;
    const unsigned ldsw = (unsigned)wid * 1024u;
    unsigned aoff = (unsigned)lds_byte(wr * 64 + fr, fq * 8), boff = (unsigned)lds_byte(wc * 32 + fr, fq * 8) + 6u * HTB;
    asm volatile("" : "+v"(aoff), "+v"(boff));
#define HN_STAGE(bufoff, gbase, voff) do { _Pragma("unroll") for (int _i = 0; _i < 2; ++_i) \
        __builtin_amdgcn_global_load_lds((const unsigned*)((const char*)(gbase) + (voff)[_i]), (PG8_LAS unsigned*)(lds + (bufoff) + ldsw + _i * 8192), 16, 0, 0); } while (0)
#define HN_STAGE_TILE(r_, pa, pb) do { const unsigned ro_ = (unsigned)(r_) * (2u * HTB); const char* pa0_ = (pa); const char* pa1_ = pa0_ + hstepA; const char* pb_ = (pb); asm volatile("" : "+s"(pa0_), "+s"(pa1_), "+s"(pb_)); \
        HN_STAGE(6u * HTB + (unsigned)(r_) * HTB, pb_, voffB); HN_STAGE(ro_, pa0_, voffA); HN_STAGE(ro_ + HTB, pa1_, voffA); } while (0)
#define HN_LDA(dst, base_) do { _Pragma("unroll") for (int m = 0; m < 4; ++m) _Pragma("unroll") for (int k = 0; k < 2; ++k) dst[m][k] = *(const PG8_LAS bf16x8*)(lds + (base_) + (m * 2048 + k * 1024)); } while (0)
#define HN_LDB(dst, base_) do { _Pragma("unroll") for (int n = 0; n < 2; ++n) _Pragma("unroll") for (int k = 0; k < 2; ++k) dst[n][k] = *(const PG8_LAS bf16x8*)(lds + (base_) + (n * 2048 + k * 1024)); } while (0)
#define HN_MMA(ai, At, Bt) do { __builtin_amdgcn_s_setprio(1); _Pragma("unroll") for (int m = 0; m < 4; ++m) _Pragma("unroll") for (int n = 0; n < 2; ++n) _Pragma("unroll") for (int k = 0; k < 2; ++k) \
        acc[ai][0][m][n] = __builtin_amdgcn_mfma_f32_16x16x32_bf16(Bt[n][k], At[m][k], acc[ai][0][m][n], 0, 0, 0); __builtin_amdgcn_s_setprio(0); } while (0)
#define HN_WAIT_V(n) asm volatile("s_waitcnt vmcnt(" #n ")" ::: "memory")
#define HN_WAIT_L(n) asm volatile("s_waitcnt lgkmcnt(" #n ")" ::: "memory")
#define HN_BAR __builtin_amdgcn_s_barrier()
    Unit cur, nxt; int ui = 0;
    if (!S.next(0, cur)) return;
    f32x4 acc[2][2][4][2];
#pragma unroll
    for (int a = 0; a < 2; ++a)
#pragma unroll
        for (int b = 0; b < 2; ++b)
#pragma unroll
            for (int m = 0; m < 4; ++m)
#pragma unroll
                for (int n = 0; n < 2; ++n) acc[a][b][m][n] = (f32x4){0.f, 0.f, 0.f, 0.f};
    bf16x8 At0[4][2], At1[4][2], B0[2][2];
    const char* cA = (const char*)g.A + (size_t)cur.pm * tstepA + (size_t)cur.z * g.zA; const char* cB = (const char*)g.Bt + (size_t)cur.pn * tstepB + (size_t)cur.z * g.zB;
    int r = 0;
    HN_STAGE_TILE(0, cA, cB); HN_STAGE_TILE(1, cA + kstep, cB + kstep);
    if (wr == 1) HN_BAR;
    HN_WAIT_V(6); HN_BAR; HN_BAR;
    for (;;) {
        const bool has_next = S.next(ui + 1, nxt);
        const char* nA = has_next ? (const char*)g.A + (size_t)nxt.pm * tstepA + (size_t)nxt.z * g.zA : cA; const char* nB = has_next ? (const char*)g.Bt + (size_t)nxt.pn * tstepB + (size_t)nxt.z * g.zB : cB;
        for (int t = 0; t < nt; ++t) {
            const int t2 = t + 2; const char* sa = t2 < nt ? cA + (size_t)t2 * kstep : nA + (size_t)(t2 - nt) * kstep; const char* sb = t2 < nt ? cB + (size_t)t2 * kstep : nB + (size_t)(t2 - nt) * kstep;
            const int r2 = r == 0 ? 2 : r - 1;
            HN_STAGE_TILE(r2, sa, sb);
            if (t == 0) { int t_p = threadIdx.x; asm volatile("" : "+v"(t_p)); E.prefetch(cur, wr, wc, t_p & 15, (t_p >> 4) & 3); }
            { const unsigned ab = aoff + (unsigned)r * (2u * HTB), bb = boff + (unsigned)r * HTB;
              HN_LDB(B0, bb); __builtin_amdgcn_sched_barrier(0); HN_LDA(At0, ab); HN_LDA(At1, ab + HTB); }
            if (t < 2) HN_WAIT_V(8); else HN_WAIT_V(6);
            HN_WAIT_L(0); HN_BAR;
            HN_MMA(0, At0, B0); HN_MMA(1, At1, B0);
            HN_BAR; __builtin_amdgcn_sched_barrier(0);
            r = r == 2 ? 0 : r + 1;
        }
        if (wr == 0) HN_BAR;
        { int t_e = threadIdx.x; asm volatile("" : "+v"(t_e));
          E(acc, cur, wr, wc, t_e & 15, (t_e >> 4) & 3); }
        if (!has_next) break;
        cur = nxt; cA = nA; cB = nB; ++ui;
        if (wr == 1) HN_BAR;
    }
    HN_WAIT_V(0);
    HN_BAR;
#undef HN_STAGE
#undef HN_STAGE_TILE
#undef HN_LDA
#undef HN_LDB
#undef HN_MMA
#undef HN_WAIT_V
#undef HN_WAIT_L
#undef HN_BAR
}

}

using pg8::bf16_t; using pg8::f32x4; using pg8::u32x4; using pg8::u32x2; using pg8::bf16x8; using pg8::cvt_pk_bf16;
#define LAS __attribute__((address_space(3)))

constexpr int D = 1024, SEQ = 4096, NB = 16, DEPTH = 4, BW = 512;
constexpr int NGRP = 2, BG = NB / NGRP, TG = BG * SEQ;
constexpr int N_IN = 21 * 256, N_MG = 4096, N_ALL = N_IN + N_MG;
constexpr int PLD = 20 * 256;
constexpr int P_GQ = 0, P_GK = 256, P_GV = 512, P_GG = 1024, P_RQ = 1536, P_RK = 1792, P_RV = 2048, P_RG = 2560, P_LX = 3072, P_LG = 3584, P_SU = 4096, P_SG = 4608;
constexpr int OLD = 2048;
constexpr float NORM_EPS = 1e-6f;

constexpr size_t MiB = 1u << 20;
constexpr size_t WS_CTL = 0, CTL_BYTES = 2 * MiB;
constexpr size_t WS_ROT = 2 * MiB;
constexpr size_t WS_SMALL = 3 * MiB, SMALL_STRIDE = 1 * MiB;
constexpr size_t WS_W = 8 * MiB, W_STRIDE = 26 * MiB;
constexpr size_t WO_IN = 0, WO_BR = (size_t)N_ALL * D * 2, WO_OUT = WO_BR + (size_t)4 * D * BW * 2, WO_GLU = WO_OUT + (size_t)D * D * 2, WO_END = WO_GLU + (size_t)BW * BW * 2;
static_assert(WO_END <= W_STRIDE, "weights");
constexpr size_t WS_U = 112 * MiB;
constexpr size_t WS_P = 176 * MiB;
constexpr size_t WS_LA = 496 * MiB;
constexpr size_t WS_O = 528 * MiB;
constexpr size_t WS_Y5 = 656 * MiB;
constexpr size_t WS_PG = 688 * MiB;
constexpr size_t WS_S5D = 816 * MiB;
constexpr size_t WS_S5M = 820 * MiB, S5M_BYTES = 86016;
constexpr size_t WS_S5K = 831 * MiB;
constexpr size_t WS_SU2 = 832 * MiB;
constexpr size_t WS_ST = 944 * MiB;
constexpr size_t WS_END = 1008 * MiB;
constexpr int SM_ABR = 0, SM_ABI = 2048, SM_BBR = 4096, SM_BBI = 4096 + 32768, SM_SP8 = 4096 + 65536, SM_END_F = SM_SP8 + 512;
constexpr int SM_A128 = SM_END_F;
constexpr int SM_A8 = SM_A128 + 4096;
constexpr size_t SM_LRUW_BYTES = 512 * 1024, SM_CT_BYTES = 640 * 1024, SM_BBT_BYTES = 768 * 1024;
static_assert((size_t)(SM_END_F + 8192) * 4 <= SM_LRUW_BYTES, "small");

constexpr int CW_BAR = 4096;
#define XB_TMO      128
#define XB_XCNT(j)  (256  + 64 * (j))
#define XB_XSUB(j)  (1280 + 64 * (j))
#define XB_XGEN(j)  (2304 + 64 * (j))
#define XB_TOP      3328
#define XB_TOPGEN   3392
#define XCD_BAR_WORDS 3456
#define XB_SPIN_CAP (1u << 18)

__device__ __forceinline__ void wg_syncthreads() { __builtin_amdgcn_fence(__ATOMIC_RELEASE, "workgroup"); __builtin_amdgcn_s_barrier(); __builtin_amdgcn_fence(__ATOMIC_ACQUIRE, "workgroup"); }
__device__ __forceinline__ unsigned xb_ld(unsigned* p)              { return __hip_atomic_load(p, __ATOMIC_RELAXED, __HIP_MEMORY_SCOPE_AGENT); }
__device__ __forceinline__ unsigned xb_add(unsigned* p, unsigned v) { return __hip_atomic_fetch_add(p, v, __ATOMIC_RELAXED, __HIP_MEMORY_SCOPE_AGENT); }
__device__ __forceinline__ unsigned xb_xcc_id() { return (unsigned)__builtin_amdgcn_s_getreg((3 << 11) | 20) & 0xFu; }
#define XB_SPIN(cond, bar) do { unsigned _sp = 0; while (cond) { __builtin_amdgcn_s_sleep(1); \
    if ((++_sp & 255u) == 0u) { if (xb_ld(&(bar)[XB_TMO])) break; if (_sp > XB_SPIN_CAP) { (void)xb_add(&(bar)[XB_TMO], 1u); break; } } } } while (0)
struct XcdBarrier { unsigned* bar; unsigned x; volatile LAS unsigned* st; };
__device__ __forceinline__ XcdBarrier xcd_barrier_post(unsigned* bar, volatile LAS unsigned* st) {
    XcdBarrier b; b.bar = bar; b.x = xb_xcc_id(); b.st = st;
    if (threadIdx.x == 0) (void)xb_add(&bar[XB_XCNT(b.x)], 1u);
    return b;
}
__device__ __forceinline__ void xcd_barrier_complete(unsigned* bar, unsigned x, unsigned& nloc, unsigned& nx) {
    const unsigned G = gridDim.x * gridDim.y * gridDim.z;
    unsigned sum, cnt, mine, sp = 0u;
    for (;;) {
        sum = 0u; cnt = 0u; mine = 0u;
#pragma unroll
        for (unsigned j = 0; j < 16; ++j) { const unsigned c = xb_ld(&bar[XB_XCNT(j)]); sum += c; cnt += (c > 0u) ? 1u : 0u; mine = (j == x) ? c : mine; }
        if (sum == G) break;
        __builtin_amdgcn_s_sleep(1);
        if ((++sp & 255u) == 0u) { if (xb_ld(&bar[XB_TMO])) break; if (sp > XB_SPIN_CAP) { (void)xb_add(&bar[XB_TMO], 1u); break; } }
    }
    nloc = mine > 0u ? mine : 1u; nx = cnt > 0u ? cnt : 1u;
}
__device__ __forceinline__ void xcd_barrier(const XcdBarrier& b) {
    asm volatile("s_waitcnt vmcnt(0)" ::: "memory");
    wg_syncthreads();
    if (threadIdx.x == 0) {
        unsigned* bar = b.bar;
        __builtin_amdgcn_s_waitcnt(0);
        unsigned nloc = b.st[0], nx = b.st[1];
        if (nloc == 0u) { xcd_barrier_complete(bar, b.x, nloc, nx); b.st[0] = nloc; b.st[1] = nx; }
        const unsigned old = xb_add(&bar[XB_XSUB(b.x)], 1u);
        const unsigned gen = old / nloc;
        if (old + 1u == (gen + 1u) * nloc) {
            __builtin_amdgcn_fence(__ATOMIC_RELEASE, "agent");
            asm volatile("s_waitcnt vmcnt(0)" ::: "memory");
            const unsigned og = xb_add(&bar[XB_TOP], 1u);
            const unsigned tg = og / nx;
            if (og + 1u == (tg + 1u) * nx) xb_add(&bar[XB_TOPGEN], 1u);
            else XB_SPIN(xb_ld(&bar[XB_TOPGEN]) == tg, bar);
            __builtin_amdgcn_fence(__ATOMIC_ACQUIRE, "agent");
            xb_add(&bar[XB_XGEN(b.x)], 1u);
            asm volatile("s_waitcnt vmcnt(0)" ::: "memory");
        } else {
            XB_SPIN(xb_ld(&bar[XB_XGEN(b.x)]) == gen, bar);
            __builtin_amdgcn_fence(__ATOMIC_ACQUIRE, "agent");
            asm volatile("s_waitcnt vmcnt(0)" ::: "memory");
        }
    }
    wg_syncthreads();
}

__device__ __forceinline__ float bf2f(bf16_t b) { return __builtin_bit_cast(float, ((unsigned)b) << 16); }
__device__ __forceinline__ float bflo(unsigned w) { return __builtin_bit_cast(float, w << 16); }
__device__ __forceinline__ float bfhi(unsigned w) { return __builtin_bit_cast(float, w & 0xffff0000u); }
__device__ __forceinline__ bf16_t f2bf(float f) { return (bf16_t)(cvt_pk_bf16(f, 0.f) & 0xffffu); }
__device__ __forceinline__ float sigmoid_f(float x) { return __builtin_amdgcn_rcpf(1.f + __expf(-x)); }
__device__ __forceinline__ float silu_f(float x) { return x * sigmoid_f(x); }
__device__ __forceinline__ float silu_t(float t) { return t * __builtin_amdgcn_rcpf(__builtin_fmaf(__builtin_amdgcn_exp2f(t), -1.4426950408889634f, -1.4426950408889634f)); }
__device__ __forceinline__ float sig255(float t) { return __builtin_amdgcn_rcpf(__builtin_fmaf(__builtin_amdgcn_exp2f(t), 1.f / 255.f, 1.f / 255.f)); }
__device__ __forceinline__ float gelu_tanh_f(float x) { const float u = 0.7978845608028654f * (x + 0.044715f * x * x * x); const float t = 1.f - 2.f * __builtin_amdgcn_rcpf(1.f + __expf(2.f * u)); return 0.5f * x * (1.f + t); }
__device__ __forceinline__ float shfl_xor_f(float v, int m) { const int ln = (int)__builtin_amdgcn_mbcnt_hi(~0u, __builtin_amdgcn_mbcnt_lo(~0u, 0u)); return __builtin_bit_cast(float, __builtin_amdgcn_ds_bpermute((ln ^ m) << 2, __builtin_bit_cast(int, v))); }
__device__ __forceinline__ float wave_sum(float v) {
#pragma unroll
    for (int o = 1; o < 64; o <<= 1) v += shfl_xor_f(v, o);
    return v;
}

#define GEMM_CALL(EPI) pg8::gemm_phase<EPI, pg8::StaticOrder, true, true>(lds, g, S, E)
struct Args {
    const float* in[29]; float* out; unsigned char* ws;
    int s_lo, s_hi, li, fin, mmask, pad2;
};
enum { I_X = 0, I_NG, I_WIN, I_GWLR, I_GBLR, I_GNG, I_RNG, I_RNB, I_LCW, I_LCB, I_LWA, I_LBA, I_LWX, I_LBX, I_LLAM,
       I_SARE, I_SAIM, I_SBRE, I_SBIM, I_SCRE, I_SCIM, I_SD, I_SLDT, I_SGW, I_SGB, I_WMG, I_WBR, I_WOUT, I_FNG };

struct EpiIn {
    static constexpr bool PERM = true, AFTER_DRAIN = false, KEEP = false;
    bf16_t* P; float* LA; const float* blr; const float* rot; unsigned char* PG; bf16_t* SU;
    __device__ __forceinline__ void operator()(f32x4 (&acc)[2][2][4][2], const pg8::Unit& u, int wr, int wc, int fr, int fq) const {
        const int pn = u.pn, row0 = u.pm * 256 + wr * 64 + fr, cl = wc * 32 + 8 * fq;
        if (pn >= 21) {
#pragma unroll
            for (int ai = 0; ai < 2; ++ai)
#pragma unroll
                for (int m = 0; m < 4; ++m) { int row = row0 + ai * 128 + m * 16; asm volatile("" : "+v"(row));
                    u32x4 w;
#pragma unroll
                    for (int bj = 0; bj < 2; ++bj) { const f32x4 v0 = acc[ai][bj][m][0], v1 = acc[ai][bj][m][1]; unsigned lo = 0u, hi = 0u;
#pragma unroll
                        for (int j = 0; j < 4; ++j) { lo = __builtin_amdgcn_cvt_pk_u8_f32(sig255(v0[j]), j, lo); hi = __builtin_amdgcn_cvt_pk_u8_f32(sig255(v1[j]), j, hi); }
                        if (bj == 0) { w.x = lo; w.y = hi; } else { w.z = lo; w.w = hi; } }
                    __builtin_nontemporal_store(w, (u32x4*)(PG + (size_t)row * N_MG + (pn - 21) * 256 + 2 * cl)); }
        } else if (pn == 4) {
#pragma unroll
            for (int bj = 0; bj < 2; ++bj) { const int c = cl + bj * 128; const f32x4 b0 = *(const f32x4*)(blr + c), b1 = *(const f32x4*)(blr + c + 4);
#pragma unroll
                for (int ai = 0; ai < 2; ++ai) {
#pragma unroll
                    for (int n = 0; n < 2; ++n)
#pragma unroll
                        for (int j = 0; j < 4; ++j) { float run = 0.f; const float bb = n ? b1[j] : b0[j];
#pragma unroll
                            for (int m = 0; m < 4; ++m) { const float z = acc[ai][bj][m][n][j] + bb; const float x = -(fmaxf(-z, 0.f) + __logf(1.f + __expf(-fabsf(z)))) * 0.0625f; float ls = x, rs = x;
#define DPP_ADD(acc_, ctrl_) acc_ += __builtin_bit_cast(float, __builtin_amdgcn_update_dpp(0, __builtin_bit_cast(int, acc_), ctrl_, 0xf, 0xf, true))
                                DPP_ADD(ls, 0x111); DPP_ADD(ls, 0x112); DPP_ADD(ls, 0x114); DPP_ADD(ls, 0x118);
                                DPP_ADD(rs, 0x101); DPP_ADD(rs, 0x102); DPP_ADD(rs, 0x104); DPP_ADD(rs, 0x108);
#undef DPP_ADD
                                acc[ai][bj][m][n][j] = run + ls; run += ls + rs - x; } }
#pragma unroll
                    for (int m = 0; m < 4; ++m) { int row = row0 + ai * 128 + m * 16; asm volatile("" : "+v"(row)); float* d = LA + ((size_t)(c >> 6) * TG + row) * 64 + (c & 63); *(f32x4*)d = acc[ai][bj][m][0]; *(f32x4*)(d + 4) = acc[ai][bj][m][1]; } } }
        } else if (pn == 7 || pn == 8) {
            const int dcol = (pn - 1) * 256;
#pragma unroll
            for (int ai = 0; ai < 2; ++ai)
#pragma unroll
                for (int m = 0; m < 4; ++m) { int row = row0 + ai * 128 + m * 16; asm volatile("" : "+v"(row)); const int pos = row & (SEQ - 1);
#pragma unroll
                    for (int bj = 0; bj < 2; ++bj) { const int c = cl + bj * 128, i0 = (c & 63) >> 1; const float* rt = rot + ((size_t)pos * 32 + i0) * 2;
                        const f32x4 cs0 = *(const f32x4*)rt, cs1 = *(const f32x4*)(rt + 4); const f32x4 v0 = acc[ai][bj][m][0], v1 = acc[ai][bj][m][1];
                        u32x4 w; w.x = cvt_pk_bf16(v0[0] * cs0[0] - v0[1] * cs0[1], v0[0] * cs0[1] + v0[1] * cs0[0]); w.y = cvt_pk_bf16(v0[2] * cs0[2] - v0[3] * cs0[3], v0[2] * cs0[3] + v0[3] * cs0[2]);
                        w.z = cvt_pk_bf16(v1[0] * cs1[0] - v1[1] * cs1[1], v1[0] * cs1[1] + v1[1] * cs1[0]); w.w = cvt_pk_bf16(v1[2] * cs1[2] - v1[3] * cs1[3], v1[2] * cs1[3] + v1[3] * cs1[2]);
                        __builtin_nontemporal_store(w, (u32x4*)(P + (size_t)(dcol + (c & ~63)) * TG + (size_t)row * 64 + (c & 63))); } }
        } else {
            const bool silu = (pn == 5 || pn == 6 || pn == 11 || pn == 12 || pn == 15 || pn == 16 || pn == 19 || pn == 20);
            const int dcol = (pn < 4 ? pn : pn - 1) * 256;
            const int wsh = (pn >= 19) ? 9 : ((pn == 2 || pn == 3 || pn == 5 || pn == 6 || (pn >= 9 && pn <= 12)) ? 7 : 6);
#pragma unroll
            for (int ai = 0; ai < 2; ++ai)
#pragma unroll
                for (int m = 0; m < 4; ++m) { int row = row0 + ai * 128 + m * 16; asm volatile("" : "+v"(row));
#pragma unroll
                    for (int bj = 0; bj < 2; ++bj) { f32x4 v0 = acc[ai][bj][m][0], v1 = acc[ai][bj][m][1];
                        if (silu) {
#pragma unroll
                            for (int j = 0; j < 4; ++j) { v0[j] = silu_t(v0[j]); v1[j] = silu_t(v1[j]); } }
                        u32x4 w; w.x = cvt_pk_bf16(v0[0], v0[1]); w.y = cvt_pk_bf16(v0[2], v0[3]); w.z = cvt_pk_bf16(v1[0], v1[1]); w.w = cvt_pk_bf16(v1[2], v1[3]);
                        if (pn == 17 || pn == 18) { const int cc = (pn - 17) * 256 + cl + bj * 128;
                            __builtin_nontemporal_store(w, (u32x4*)(SU + ((size_t)(cc >> 4) * TG + row) * 16 + (cc & 15))); }
                        else { const int col = dcol + cl + bj * 128; __builtin_nontemporal_store(w, (u32x4*)(P + (size_t)(col >> wsh << wsh) * TG + ((size_t)row << wsh) + (col & ((1 << wsh) - 1)))); } } }
        }
    }
};
struct EpiSig {
    static constexpr bool PERM = true, AFTER_DRAIN = false, KEEP = false;
    bf16_t* PG;
    __device__ __forceinline__ void operator()(const f32x4 (&acc)[2][2][4][2], const pg8::Unit& u, int wr, int wc, int fr, int fq) const {
        const int row0 = u.pm * 256 + wr * 64 + fr, c0 = u.pn * 256 + wc * 32 + 8 * fq;
#pragma unroll
        for (int ai = 0; ai < 2; ++ai)
#pragma unroll
            for (int m = 0; m < 4; ++m) { const int row = row0 + ai * 128 + m * 16;
#pragma unroll
                for (int bj = 0; bj < 2; ++bj) { f32x4 v0 = acc[ai][bj][m][0], v1 = acc[ai][bj][m][1];
#pragma unroll
                    for (int j = 0; j < 4; ++j) { v0[j] = sigmoid_f(v0[j]); v1[j] = sigmoid_f(v1[j]); }
                    u32x4 w; w.x = cvt_pk_bf16(v0[0], v0[1]); w.y = cvt_pk_bf16(v0[2], v0[3]); w.z = cvt_pk_bf16(v1[0], v1[1]); w.w = cvt_pk_bf16(v1[2], v1[3]);
                    *(u32x4*)(PG + (size_t)row * N_MG + c0 + bj * 128) = w; } }
    }
};
struct EpiGlu {
    static constexpr bool PERM = true, AFTER_DRAIN = false, KEEP = false;
    const bf16_t* Y5; const bf16_t* P; const float* gb; bf16_t* O;
    __device__ __forceinline__ void operator()(const f32x4 (&acc)[2][2][4][2], const pg8::Unit& u, int wr, int wc, int fr, int fq) const {
        const int row0 = u.pm * 256 + wr * 64 + fr, c0 = u.pn * 256 + wc * 32 + 8 * fq;
#pragma unroll
        for (int bj = 0; bj < 2; ++bj) { const int c = c0 + bj * 128; const f32x4 b0 = *(const f32x4*)(gb + c), b1 = *(const f32x4*)(gb + c + 4);
#pragma unroll
            for (int ai = 0; ai < 2; ++ai)
#pragma unroll
                for (int m = 0; m < 4; ++m) { const int row = row0 + ai * 128 + m * 16;
                    const u32x4 y = *(const u32x4*)(Y5 + (size_t)row * BW + c), s = *(const u32x4*)(P + (size_t)P_SG * TG + (size_t)row * 512 + c);
                    const f32x4 v0 = acc[ai][bj][m][0] + b0, v1 = acc[ai][bj][m][1] + b1;
                    u32x4 w;
                    w.x = cvt_pk_bf16(bflo(y.x) * sigmoid_f(v0[0]) * bflo(s.x), bfhi(y.x) * sigmoid_f(v0[1]) * bfhi(s.x));
                    w.y = cvt_pk_bf16(bflo(y.y) * sigmoid_f(v0[2]) * bflo(s.y), bfhi(y.y) * sigmoid_f(v0[3]) * bfhi(s.y));
                    w.z = cvt_pk_bf16(bflo(y.z) * sigmoid_f(v1[0]) * bflo(s.z), bfhi(y.z) * sigmoid_f(v1[1]) * bfhi(s.z));
                    w.w = cvt_pk_bf16(bflo(y.w) * sigmoid_f(v1[2]) * bflo(s.w), bfhi(y.w) * sigmoid_f(v1[3]) * bfhi(s.w));
                    *(u32x4*)(O + (size_t)row * OLD + 1536 + c) = w; } }
    }
};
struct EpiBr {
    static constexpr bool PERM = true, AFTER_DRAIN = false, KEEP = false;
    const unsigned char* PG; bf16_t* MRG; mutable u32x2 gpre[2];
    __device__ __forceinline__ void prefetch(const pg8::Unit& u, int wr, int wc, int fr, int fq) const {
        const int row0 = u.pm * 256 + wr * 64 + fr, gpos = (u.z * 4 + (u.pn >> 1)) * 256 + wc * 64 + fq * 16 + (u.pn & 1) * 8;
#pragma unroll
        for (int m = 0; m < 2; ++m) gpre[m] = __builtin_nontemporal_load((const u32x2*)(PG + (size_t)(row0 + m * 16) * N_MG + gpos));
    }
    __device__ __forceinline__ void operator()(f32x4 (&acc)[2][2][4][2], const pg8::Unit& u, int wr, int wc, int fr, int fq) const {
        const int row0 = u.pm * 256 + wr * 64 + fr, c = u.pn * 128 + wc * 32 + 8 * fq, z = u.z;
        const int gpos = (z * 4 + (u.pn >> 1)) * 256 + wc * 64 + fq * 16 + (u.pn & 1) * 8;
        u32x2 glo[6];
#pragma unroll
        for (int m = 2; m < 8; ++m) glo[m - 2] = __builtin_nontemporal_load((const u32x2*)(PG + (size_t)(row0 + (m >> 2) * 128 + (m & 3) * 16) * N_MG + gpos));
#pragma unroll
        for (int ai = 0; ai < 2; ++ai)
#pragma unroll
            for (int m = 0; m < 4; ++m) { const int row = row0 + ai * 128 + m * 16;
                const u32x2 gt = (ai * 4 + m < 2) ? gpre[ai * 4 + m] : glo[ai * 4 + m - 2];
                f32x4& p0 = acc[ai][0][m][0]; f32x4& p1 = acc[ai][0][m][1]; f32x4& s0 = acc[ai][1][m][0]; f32x4& s1 = acc[ai][1][m][1];
                if (z == 0) { s0 = (f32x4){0.f, 0.f, 0.f, 0.f}; s1 = s0; }
                s0[0] += p0[0] * (float)(gt.x & 255u); s0[1] += p0[1] * (float)((gt.x >> 8) & 255u); s0[2] += p0[2] * (float)((gt.x >> 16) & 255u); s0[3] += p0[3] * (float)(gt.x >> 24);
                s1[0] += p1[0] * (float)(gt.y & 255u); s1[1] += p1[1] * (float)((gt.y >> 8) & 255u); s1[2] += p1[2] * (float)((gt.y >> 16) & 255u); s1[3] += p1[3] * (float)(gt.y >> 24);
                p0 = (f32x4){0.f, 0.f, 0.f, 0.f}; p1 = p0;
                if (z == 3) { const float q = 1.f / 255.f; s0 *= q; s1 *= q;
                    u32x4 w; w.x = cvt_pk_bf16(s0[0], s0[1]); w.y = cvt_pk_bf16(s0[2], s0[3]); w.z = cvt_pk_bf16(s1[0], s1[1]); w.w = cvt_pk_bf16(s1[2], s1[3]);
                    *(u32x4*)(MRG + (size_t)row * D + c) = w; } }
    }
};
struct EpiOut {
    static constexpr bool PERM = true, AFTER_DRAIN = false, KEEP = false;
    bf16_t* DL;
    __device__ __forceinline__ void operator()(const f32x4 (&acc)[2][2][4][2], const pg8::Unit& u, int wr, int wc, int fr, int fq) const {
        const int row0 = u.pm * 256 + wr * 64 + fr, c0 = u.pn * 256 + wc * 32 + 8 * fq;
#pragma unroll
        for (int ai = 0; ai < 2; ++ai)
#pragma unroll
            for (int m = 0; m < 4; ++m) { const int row = row0 + ai * 128 + m * 16;
#pragma unroll
                for (int bj = 0; bj < 2; ++bj) { const f32x4 v0 = acc[ai][bj][m][0], v1 = acc[ai][bj][m][1];
                    u32x4 w; w.x = cvt_pk_bf16(v0[0], v0[1]); w.y = cvt_pk_bf16(v0[2], v0[3]); w.z = cvt_pk_bf16(v1[0], v1[1]); w.w = cvt_pk_bf16(v1[2], v1[3]);
                    *(u32x4*)(DL + (size_t)row * D + c0 + bj * 128) = w; } }
    }
};

__device__ __forceinline__ int win_src_col(int r) {
    const int pn = r >> 8, j = r & 255;
    switch (pn) {
        case 0: return j; case 1: return 256 + j; case 2: case 3: return 512 + (r - 512);
        case 4: return -1;
        case 5: case 6: return 1040 + (r - 1280);
        case 7: return 1552 + 64 * (j >> 6) + ((j & 63) >> 1) + 32 * (j & 1);
        case 8: return 1808 + 64 * (j >> 6) + ((j & 63) >> 1) + 32 * (j & 1);
        case 9: case 10: return 2064 + (r - 2304);
        case 11: case 12: return 2576 + (r - 2816);
        case 13: case 14: return 3088 + (r - 3328);
        case 15: case 16: return 3600 + (r - 3840);
        case 17: case 18: return 4112 + (r - 4352);
        default: return 4624 + (r - 4864);
    }
}
__device__ __forceinline__ void tr_store8(bf16_t* dst, const float (&v)[8]) {
    u32x4 w; w.x = cvt_pk_bf16(v[0], v[1]); w.y = cvt_pk_bf16(v[2], v[3]); w.z = cvt_pk_bf16(v[4], v[5]); w.w = cvt_pk_bf16(v[6], v[7]); *(u32x4*)dst = w;
}
__device__ __forceinline__ void phase_prologue(LAS unsigned char* lds, const Args& a, int gtid, int gthreads) {
    unsigned char* ws = a.ws;
    for (int q = gtid; q < DEPTH * 2048; q += gthreads) { const int l = q >> 11, idx = q & 2047, g = idx >> 6;
        float* sm = (float*)(ws + WS_SMALL + (size_t)l * SMALL_STRIDE);
        const double step = exp((double)a.in[I_SLDT][l * 32 + g]); const double are = a.in[I_SARE][l * 2048 + idx], aim = a.in[I_SAIM][l * 2048 + idx];
        const double mag = exp(step * are), abr = mag * cos(step * aim), abi = mag * sin(step * aim), den = are * are + aim * aim;
        const double fre = ((abr - 1.0) * are + abi * aim) / den, fim = (abi * are - (abr - 1.0) * aim) / den;
        sm[SM_ABR + idx] = (float)abr; sm[SM_ABI + idx] = (float)abi;
        double* s5d = (double*)(ws + WS_S5D) + ((size_t)l * 2048 + idx) * 50;
        { double pr = 1.0, pi = 0.0;
          for (int j = 0; j <= 8; ++j) { s5d[2 * j] = pr; s5d[2 * j + 1] = pi; if (j == 8) { sm[SM_A8 + idx * 2] = (float)pr; sm[SM_A8 + idx * 2 + 1] = (float)pi; } const double nr = pr * abr - pi * abi, ni = pr * abi + pi * abr; pr = nr; pi = ni; } }
        { const double m128 = exp(512.0 * step * are); sm[SM_A128 + idx * 2] = (float)(m128 * cos(512.0 * step * aim)); sm[SM_A128 + idx * 2 + 1] = (float)(m128 * sin(512.0 * step * aim)); }
        for (int i = 0; i < 16; ++i) { const double br = a.in[I_SBRE][(size_t)l * 32768 + idx * 16 + i], bi = a.in[I_SBIM][(size_t)l * 32768 + idx * 16 + i];
            s5d[18 + 2 * i] = fre * br - fim * bi; s5d[18 + 2 * i + 1] = fre * bi + fim * br; } }
    { LAS float* T = (LAS float*)lds; const int tid = gtid & 511, G_ = gthreads >> 9, nn = tid & 63, kq = tid >> 6, nn2 = tid >> 3, kc = tid & 7;
      for (int tile = gtid >> 9; tile < DEPTH * 3200; tile += G_) { const int l = tile / 3200, r = tile % 3200;
          bf16_t* Wl = (bf16_t*)(ws + WS_W + (size_t)l * W_STRIDE);
          int nt, kt, dld; bf16_t* dst; const float* colp; int ld; float scale = 1.f; bool comp = false;
          if (r < 1344) { nt = r % 84; kt = r / 84; dst = Wl; dld = D; const int n = nt * 64 + nn, sc = win_src_col(n), pn_ = n >> 8; ld = 5136; comp = sc < 0;
              colp = a.in[I_WIN] + (size_t)l * D * 5136 + (comp ? 1024 : sc);
              scale = (pn_ == 5 || pn_ == 6 || pn_ == 11 || pn_ == 12 || pn_ == 15 || pn_ == 16 || pn_ == 19 || pn_ == 20) ? -1.4426950408889634f : ((pn_ == 0 || pn_ == 8) ? 0.125f : 1.f); }
          else if (r < 2368) { const int q = r - 1344; nt = q & 63; kt = q >> 6; dst = Wl + (size_t)N_IN * D; dld = D; const int n = nt * 64 + nn; ld = D;
              colp = a.in[I_WMG] + (size_t)l * 4 * D * D + (size_t)(n >> 10) * D * D + (n & 1023); scale = -1.4426950408889634f; }
          else if (r < 2880) { const int q = r - 2368; nt = q & 63; kt = q >> 6; dst = (bf16_t*)((unsigned char*)Wl + WO_BR); dld = BW; const int n = nt * 64 + nn; ld = D;
              colp = a.in[I_WBR] + (size_t)l * 4 * BW * D + (size_t)(n >> 10) * BW * D + (n & 1023); }
          else if (r < 3136) { const int q = r - 2880; nt = q & 15; kt = q >> 4; dst = (bf16_t*)((unsigned char*)Wl + WO_OUT); dld = D; ld = D; colp = a.in[I_WOUT] + (size_t)l * D * D + nt * 64 + nn; }
          else { const int q = r - 3136; nt = q & 7; kt = q >> 3; dst = (bf16_t*)((unsigned char*)Wl + WO_GLU); dld = BW; ld = BW; colp = a.in[I_SGW] + (size_t)l * BW * BW + nt * 64 + nn; }
          if (!comp) {
#pragma unroll
              for (int j = 0; j < 8; ++j) { const int kk = kq + 8 * j; T[kk * 65 + nn] = colp[(size_t)(kt * 64 + kk) * ld] * scale; }
          } else { const float* wlr = a.in[I_GWLR] + (size_t)l * 16 * 256 + ((nt * 64 + nn) & 255);
#pragma unroll
              for (int j = 0; j < 8; ++j) { const int kk = kq + 8 * j; const float* wr_ = colp + (size_t)(kt * 64 + kk) * ld; float sacc = 0.f;
#pragma unroll
                  for (int rr = 0; rr < 16; ++rr) sacc += wr_[rr] * wlr[rr * 256];
                  T[kk * 65 + nn] = sacc; } }
          wg_syncthreads();
          { float v[8];
#pragma unroll
            for (int i = 0; i < 8; ++i) v[i] = T[(kc * 8 + i) * 65 + nn2];
            tr_store8(dst + (size_t)(nt * 64 + nn2) * dld + kt * 64 + kc * 8, v); }
          wg_syncthreads();
      } }
    for (int l = 0; l < DEPTH; ++l) {
        float* sm = (float*)(ws + WS_SMALL + (size_t)l * SMALL_STRIDE);
        for (int idx = gtid; idx < 512; idx += gthreads) { const float lam = a.in[I_LLAM][l * 512 + idx]; const float nl = -lam;
            sm[SM_SP8 + idx] = 8.0f * (fmaxf(nl, 0.f) + log1pf(expf(-fabsf(nl)))); }
        bf16_t* lw = (bf16_t*)((unsigned char*)sm + SM_LRUW_BYTES);
        for (int idx = gtid; idx < 8 * 128 * 64; idx += gthreads) { const int i = idx & 63, jj = (idx >> 6) & 127, n = idx >> 13;
            const float v = jj < 64 ? a.in[I_LWA][(((size_t)l * 8 + n) * 64 + i) * 64 + jj] : a.in[I_LWX][(((size_t)l * 8 + n) * 64 + i) * 64 + (jj - 64)];
            lw[idx] = f2bf(v * -1.4426950408889634f); }
    }
    float* rot = (float*)(ws + WS_ROT);
    for (int idx = gtid; idx < SEQ * 32; idx += gthreads) { const int i = idx & 31, s = idx >> 5;
        const double inv = pow(10000.0, -(double)i / 32.0), ang = (double)s * inv; rot[idx * 2] = (float)cos(ang); rot[idx * 2 + 1] = (float)sin(ang); }
}

__device__ __forceinline__ void phase_prologue2(const Args& a, int gtid, int gthreads) {
    unsigned char* ws = a.ws;
    for (int l = 0; l < DEPTH; ++l) {
        const double* s5d = (const double*)(ws + WS_S5D) + (size_t)l * 2048 * 50;
        const float* scre = a.in[I_SCRE] + (size_t)l * 32768; const float* scim = a.in[I_SCIM] + (size_t)l * 32768;
        for (int it = gtid; it < 32 * 4096; it += gthreads) { const int g = it >> 12, r = it & 4095, f = r >> 6, ln = r & 63, fr = ln & 15, fq = ln >> 4;
            const int mat = f >> 5, mt = (f & 31) >> 2, ks = f & 3;
            const int m = 16 * mt + fr, k0 = 32 * ks + 8 * fq; float v[8];
            if (mat == 0) { const int p = m >> 1, ri = m & 1, sq = k0 >> 4, c0 = k0 & 15; const double* sd = s5d + (size_t)(g * 64 + p) * 50; const double ar = sd[2 * (7 - sq)], ai = sd[2 * (7 - sq) + 1];
#pragma unroll
                for (int e = 0; e < 8; ++e) { const double br = sd[18 + 2 * (c0 + e)], bi = sd[18 + 2 * (c0 + e) + 1]; v[e] = (float)(ri ? ar * bi + ai * br : ar * br - ai * bi); } }
            else { const int t = m >> 4, i = m & 15;
#pragma unroll
                for (int e = 0; e < 8; ++e) { const int k = k0 + e, p = k >> 1, ri = k & 1; const double* sd = s5d + (size_t)(g * 64 + p) * 50; const double ar = sd[2 * (t + 1)], ai = sd[2 * (t + 1) + 1];
                    const double cr = scre[(g * 16 + i) * 64 + p], ci = scim[(g * 16 + i) * 64 + p]; v[e] = (float)(ri ? -(cr * ai + ci * ar) : cr * ar - ci * ai); } }
            tr_store8((bf16_t*)(ws + WS_S5M + (size_t)(l * 32 + g) * S5M_BYTES + (size_t)r * 16), v); }
    }
    float* kt = (float*)(ws + WS_S5K);
    for (int it = gtid; it < DEPTH * 32 * 2048; it += gthreads) { const int l = it >> 16, g = (it >> 11) & 31, j = (it >> 8) & 7, i = (it >> 4) & 15, c = it & 15; double ac = 0.0;
        const double* s5d = (const double*)(ws + WS_S5D) + (size_t)l * 2048 * 50;
        const float* scre = a.in[I_SCRE] + (size_t)l * 32768; const float* scim = a.in[I_SCIM] + (size_t)l * 32768;
#pragma unroll 8
        for (int p = 0; p < 64; ++p) { const double* sd = s5d + (size_t)(g * 64 + p) * 50; const double ar = sd[2 * j], ai = sd[2 * j + 1];
            const double cr = scre[(g * 16 + i) * 64 + p], ci = scim[(g * 16 + i) * 64 + p];
            ac += (cr * ar - ci * ai) * sd[18 + 2 * c] - (cr * ai + ci * ar) * sd[18 + 2 * c + 1]; }
        kt[it] = (float)ac; }
}
__device__ __forceinline__ void phase_prologue3(const Args& a, int gtid, int gthreads) {
    unsigned char* ws = a.ws;
    for (int it = gtid; it < DEPTH * 32 * 1280; it += gthreads) { const int lg = it / 1280, r = it % 1280, ff = r >> 6, ln = r & 63, fr = ln & 15, fq = ln >> 4;
        const int mt = ff < 1 ? 0 : ff < 2 ? 1 : ff < 4 ? 2 : ff < 6 ? 3 : ff < 9 ? 4 : ff < 12 ? 5 : ff < 16 ? 6 : 7;
        const int cb = mt < 1 ? 0 : mt < 2 ? 1 : mt < 3 ? 2 : mt < 4 ? 4 : mt < 5 ? 6 : mt < 6 ? 9 : mt < 7 ? 12 : 16, ks = ff - cb;
        const int m = 16 * mt + fr, k0 = 32 * ks + 8 * fq, t = m >> 4, i = m & 15, sq = k0 >> 4, c0 = k0 & 15; float v[8];
        const float* kt = (const float*)(ws + WS_S5K) + (size_t)lg * 2048 + ((sq <= t ? t - sq : 0) * 16 + i) * 16 + c0;
#pragma unroll
        for (int e = 0; e < 8; ++e) v[e] = sq <= t ? kt[e] : 0.f;
        tr_store8((bf16_t*)(ws + WS_S5M + (size_t)lg * S5M_BYTES + 65536 + (size_t)r * 16), v); }
}

template <bool F32OUT, bool ADD>
__device__ __forceinline__ void phase_norm(const float* hin, const bf16_t* delta, float* hout, const float* gain, bf16_t* uout, int gw, int ngw, int lane) {
    f32x4 gv[4];
#pragma unroll
    for (int j = 0; j < 4; ++j) gv[j] = *(const f32x4*)(gain + 4 * lane + 256 * j);
    for (int row = gw; row < TG; row += ngw) {
        const f32x4* xr = (const f32x4*)(hin + (size_t)row * D) + lane; f32x4 v[4]; float s = 0.f;
#pragma unroll
        for (int j = 0; j < 4; ++j) v[j] = __builtin_nontemporal_load(xr + 64 * j);
        if (ADD) { const u32x2* dr = (const u32x2*)(delta + (size_t)row * D) + lane;
#pragma unroll
            for (int j = 0; j < 4; ++j) { const u32x2 dw = __builtin_nontemporal_load(dr + 64 * j); v[j].x += bflo(dw.x); v[j].y += bfhi(dw.x); v[j].z += bflo(dw.y); v[j].w += bfhi(dw.y); } }
#pragma unroll
        for (int j = 0; j < 4; ++j) s += (v[j].x * v[j].x + v[j].y * v[j].y) + (v[j].z * v[j].z + v[j].w * v[j].w);
        const float rstd = rsqrtf(wave_sum(s) * (1.f / D) + NORM_EPS);
        if (F32OUT) { f32x4* o = (f32x4*)(hout + (size_t)row * D) + lane;
#pragma unroll
            for (int j = 0; j < 4; ++j) o[64 * j] = v[j] * rstd * gv[j];
        } else {
            if (ADD) { f32x4* o = (f32x4*)(hout + (size_t)row * D) + lane;
#pragma unroll
                for (int j = 0; j < 4; ++j) o[64 * j] = v[j]; }
            u32x2* o = (u32x2*)(uout + (size_t)row * D) + lane;
#pragma unroll
            for (int j = 0; j < 4; ++j) { const f32x4 y = v[j] * rstd * gv[j]; u32x2 w; w.x = cvt_pk_bf16(y.x, y.y); w.y = cvt_pk_bf16(y.z, y.w); o[64 * j] = w; } }
    }
}

constexpr int NSEGG = 8;
constexpr int NSEGL = 32;
constexpr int NSEGS = 8;
constexpr size_t ST_GSEG = 0;
constexpr size_t ST_GDS = ST_GSEG + (size_t)2 * BG * 4 * NSEGG * 8192;
constexpr size_t ST_LRU = ST_GDS + (size_t)2 * BG * 4 * NSEGG * 64;
constexpr size_t ST_S5 = ST_LRU + (size_t)BG * NSEGL * 512 * 2;
constexpr size_t ST_END_F = ST_S5 + (size_t)BG * NSEGS * 32 * 128;
static_assert(ST_END_F * 4 <= 64 * MiB, "state scratch");
typedef short s16x4 __attribute__((ext_vector_type(4)));

__device__ __forceinline__ bf16x8 lds_tr_frag(LAS const unsigned char* base, int row_stride_bytes, int lane) {
    const int g = lane >> 4, idx = lane & 15, q = idx >> 2, p = idx & 3;
    LAS const unsigned char* a0 = base + (8 * g + q) * row_stride_bytes + 8 * p;
    const s16x4 r0 = __builtin_amdgcn_ds_read_tr16_b64_v4i16((LAS s16x4*)a0);
    const s16x4 r1 = __builtin_amdgcn_ds_read_tr16_b64_v4i16((LAS s16x4*)(a0 + 4 * row_stride_bytes));
    bf16x8 f; f[0] = r0[0]; f[1] = r0[1]; f[2] = r0[2]; f[3] = r0[3]; f[4] = r1[0]; f[5] = r1[1]; f[6] = r1[2]; f[7] = r1[3]; return f;
}
#define WGSYNC() do { asm volatile("s_waitcnt lgkmcnt(0)" ::: "memory"); __builtin_amdgcn_s_barrier(); asm volatile("" ::: "memory"); } while (0)

constexpr int GL_QD = 0, GL_KD = 9216, GL_KT = 18432, GL_V = 27648, GL_ST = 45056, GL_LAST = 63488, GL_RED = 63744, GL_RED2 = 64256;
struct GlaP { const bf16_t* P; const float* LA; const float* gain; const float* bias; bf16_t* O; float* SSEG; float* DSUM; };
__device__ __forceinline__ bf16x8 lds_tr_frag2(LAS const unsigned char* base, int row_stride_bytes, int lane, int mulg, int second_off) {
    const int g = lane >> 4, idx = lane & 15, q = idx >> 2, p = idx & 3;
    LAS const unsigned char* a0 = base + (mulg * g + q) * row_stride_bytes + 8 * p;
    const s16x4 r0 = __builtin_amdgcn_ds_read_tr16_b64_v4i16((LAS s16x4*)a0);
    const s16x4 r1 = __builtin_amdgcn_ds_read_tr16_b64_v4i16((LAS s16x4*)(a0 + second_off * row_stride_bytes));
    bf16x8 f; f[0] = r0[0]; f[1] = r0[1]; f[2] = r0[2]; f[3] = r0[3]; f[4] = r1[0]; f[5] = r1[1]; f[6] = r1[2]; f[7] = r1[3]; return f;
}
__device__ __forceinline__ bf16x8 pack8(const f32x4 a, const f32x4 b) { u32x4 w; w.x = cvt_pk_bf16(a[0], a[1]); w.y = cvt_pk_bf16(a[2], a[3]); w.z = cvt_pk_bf16(b[0], b[1]); w.w = cvt_pk_bf16(b[2], b[3]); return __builtin_bit_cast(bf16x8, w); }

__device__ __forceinline__ bf16x8 lds_tr_frag3(LAS const unsigned char* base, int row_stride_bytes, int lane, int pstride_bytes) {
    const int g = lane >> 4, idx = lane & 15, q = idx >> 2, p = idx & 3;
    LAS const unsigned char* a0 = base + (4 * g + q) * row_stride_bytes + pstride_bytes * p;
    const s16x4 r0 = __builtin_amdgcn_ds_read_tr16_b64_v4i16((LAS s16x4*)a0);
    const s16x4 r1 = __builtin_amdgcn_ds_read_tr16_b64_v4i16((LAS s16x4*)(a0 + 16 * row_stride_bytes));
    bf16x8 f; f[0] = r0[0]; f[1] = r0[1]; f[2] = r0[2]; f[3] = r0[3]; f[4] = r1[0]; f[5] = r1[1]; f[6] = r1[2]; f[7] = r1[3]; return f;
}
template <bool PASSC>
__device__ __forceinline__ void glaret_item(LAS unsigned char* lds, const GlaP& gp, const bool gla, const int b, const int h, const int seg, const int sidx  ) {
    int tid = threadIdx.x; asm volatile("" : "+v"(tid));
    const int w = __builtin_amdgcn_readfirstlane(tid >> 6), l = tid & 63, fr = l & 15, fq = l >> 4;
    const int qoff = gla ? P_GQ : P_RQ, koff = gla ? P_GK : P_RK, voff = gla ? P_GV : P_RV, goff = gla ? P_GG : P_RG, ooff = gla ? 0 : 512;
    const float lg = __logf(1.f - exp2f(-5.f - (float)h));
    f32x4 accs[4];
#pragma unroll
    for (int dt = 0; dt < 4; ++dt) accs[dt] = (f32x4){0.f, 0.f, 0.f, 0.f};
    const int arow = 8 * w + (l >> 3), apart = l & 7;
    float dsum[8];
#pragma unroll
    for (int e = 0; e < 8; ++e) dsum[e] = 0.f;
    if (PASSC) {
        for (int sp = 0; sp < seg; ++sp) {
            const float* sg = gp.SSEG + (size_t)(sidx + sp) * 8192 + tid * 16; const float* dsm = gp.DSUM + (size_t)(sidx + sp) * 64;
#pragma unroll
            for (int dt = 0; dt < 4; ++dt) { const f32x4 dv = *(const f32x4*)(dsm + 16 * dt + 4 * fq), sv = *(const f32x4*)(sg + 4 * dt);
#pragma unroll
                for (int r = 0; r < 4; ++r) accs[dt][r] = accs[dt][r] * __expf(dv[r]) + sv[r]; }
        }
#pragma unroll
        for (int dt = 0; dt < 4; ++dt) { u32x2 wv; wv.x = cvt_pk_bf16(accs[dt][0], accs[dt][1]); wv.y = cvt_pk_bf16(accs[dt][2], accs[dt][3]);
            *(LAS u32x2*)(lds + GL_ST + (16 * w + fr) * 144 + 32 * dt + 8 * fq) = wv; }
    }
    const int it = w & 3, ch = w >> 2;
    f32x4 gnv[4], bsv[4];
#pragma unroll
    for (int ct = 0; ct < 4; ++ct) { const int c = 128 * h + 64 * ch + 16 * fq + 4 * ct; gnv[ct] = PASSC ? *(const f32x4*)(gp.gain + c) : (f32x4){0.f, 0.f, 0.f, 0.f};
        bsv[ct] = (PASSC && !gla) ? *(const f32x4*)(gp.bias + c) : (f32x4){0.f, 0.f, 0.f, 0.f}; }
    u32x4 rq = (u32x4){0u, 0u, 0u, 0u}, rk, rv[2]; f32x4 rla[2], rll[2]; u32x4 gnx[2];
    const float rq_s = __expf((float)(arow + 1) * lg), rk_s = __expf(-(float)(arow + 1) * lg), rt_s = __expf((float)(63 - arow) * lg);
#define GL_ISSUE(n_) do { const size_t r0_ = (size_t)b * SEQ + seg * 512 + (n_) * 64; \
        { const size_t ro_ = (r0_ + arow) * 64 + 8 * apart; if (PASSC) rq = *(const u32x4*)(gp.P + (size_t)(qoff + 64 * h) * TG + ro_); rk = *(const u32x4*)(gp.P + (size_t)(koff + 64 * h) * TG + ro_); \
          if (gla) { const float* lp_ = gp.LA + (size_t)h * TG * 64 + ro_; rla[0] = *(const f32x4*)lp_; rla[1] = *(const f32x4*)(lp_ + 4); const float* ll_ = gp.LA + ((size_t)h * TG + r0_ + 63) * 64 + 8 * apart; rll[0] = *(const f32x4*)ll_; rll[1] = *(const f32x4*)(ll_ + 4); } \
          else { rla[0] = (f32x4){0.f, 0.f, 0.f, 0.f}; rla[1] = rla[0]; rll[0] = rla[0]; rll[1] = rla[0]; } } \
        _Pragma("unroll") for (int e_ = 0; e_ < 2; ++e_) { const int p_ = tid + 512 * e_, i_ = p_ >> 4, part_ = p_ & 15; \
            rv[e_] = *(const u32x4*)(gp.P + (size_t)(voff + 128 * h) * TG + (r0_ + i_) * 128 + 8 * part_); } \
        if (PASSC) { _Pragma("unroll") for (int j_ = 0; j_ < 2; ++j_) gnx[j_] = *(const u32x4*)(gp.P + (size_t)(goff + 128 * h) * TG + (r0_ + 16 * it + fr) * 128 + 64 * ch + 16 * fq + 8 * j_); } } while (0)
    GL_ISSUE(0);
    for (int n = 0; n < 8; ++n) {
        const size_t row0 = (size_t)b * SEQ + seg * 512 + n * 64;
#pragma unroll
        for (int e = 0; e < 2; ++e) { const int p = tid + 512 * e, i = p >> 4, part = p & 15; *(LAS u32x4*)(lds + GL_V + i * 272 + part * 16) = rv[e]; }
        { float cum[8], lastv[8];
          const float kk[8] = {bflo(rk.x), bfhi(rk.x), bflo(rk.y), bfhi(rk.y), bflo(rk.z), bfhi(rk.z), bflo(rk.w), bfhi(rk.w)};
          float eq[8], ek[8], et[8];
          if (gla) {
#pragma unroll
              for (int e = 0; e < 8; ++e) { cum[e] = e < 4 ? rla[0][e] : rla[1][e - 4]; lastv[e] = e < 4 ? rll[0][e] : rll[1][e - 4];
                  eq[e] = __expf(cum[e]); ek[e] = __builtin_amdgcn_rcpf(eq[e]); et[e] = __expf(lastv[e]) * ek[e]; }
          } else {
#pragma unroll
              for (int e = 0; e < 8; ++e) { lastv[e] = 64.f * lg; eq[e] = rq_s; ek[e] = rk_s; et[e] = rt_s; } }
#pragma unroll
          for (int e = 0; e < 8; ++e) *(LAS bf16_t*)(lds + GL_KT + (8 * apart + e) * 144 + arow * 2) = f2bf(kk[e] * et[e]);
          if (PASSC) { const float qq[8] = {bflo(rq.x), bfhi(rq.x), bflo(rq.y), bfhi(rq.y), bflo(rq.z), bfhi(rq.z), bflo(rq.w), bfhi(rq.w)};
              u32x4 qw, kw;
              qw.x = cvt_pk_bf16(qq[0] * eq[0], qq[1] * eq[1]); qw.y = cvt_pk_bf16(qq[2] * eq[2], qq[3] * eq[3]); qw.z = cvt_pk_bf16(qq[4] * eq[4], qq[5] * eq[5]); qw.w = cvt_pk_bf16(qq[6] * eq[6], qq[7] * eq[7]);
              kw.x = cvt_pk_bf16(kk[0] * ek[0], kk[1] * ek[1]); kw.y = cvt_pk_bf16(kk[2] * ek[2], kk[3] * ek[3]); kw.z = cvt_pk_bf16(kk[4] * ek[4], kk[5] * ek[5]); kw.w = cvt_pk_bf16(kk[6] * ek[6], kk[7] * ek[7]);
              *(LAS u32x4*)(lds + GL_QD + arow * 144 + 16 * apart) = qw; *(LAS u32x4*)(lds + GL_KD + arow * 144 + 16 * apart) = kw; }
          if (arow == 63) {
#pragma unroll
              for (int e = 0; e < 8; ++e) *(LAS float*)(lds + GL_LAST + (8 * apart + e) * 4) = lastv[e]; }
#pragma unroll
          for (int e = 0; e < 8; ++e) dsum[e] += lastv[e]; }
        u32x4 gates[2];
        if (PASSC) { gates[0] = gnx[0]; gates[1] = gnx[1]; }
        if (n < 7) GL_ISSUE(n + 1);
        WGSYNC();
        f32x4 acco[4];
        if (PASSC) {
            bf16x8 qf[2];
#pragma unroll
            for (int ks = 0; ks < 2; ++ks) qf[ks] = *(LAS const bf16x8*)(lds + GL_QD + (16 * it + fr) * 144 + 16 * fq + 64 * ks);
            f32x4 sc[4];
#pragma unroll
            for (int jt = 0; jt < 4; ++jt) { sc[jt] = (f32x4){0.f, 0.f, 0.f, 0.f};
                if (jt <= it) {
#pragma unroll
                    for (int ks = 0; ks < 2; ++ks) { const bf16x8 kf = *(LAS const bf16x8*)(lds + GL_KD + (16 * jt + fr) * 144 + 16 * fq + 64 * ks);
                        sc[jt] = __builtin_amdgcn_mfma_f32_16x16x32_bf16(kf, qf[ks], sc[jt], 0, 0, 0); }
                    if (jt == it) {
#pragma unroll
                        for (int r = 0; r < 4; ++r) sc[jt][r] = (4 * fq + r <= fr) ? sc[jt][r] : 0.f; } } }
            const bf16x8 pf0 = pack8(sc[0], sc[1]), pf1 = pack8(sc[2], sc[3]);
#pragma unroll
            for (int ct = 0; ct < 4; ++ct) { const int c0 = 64 * ch + 4 * ct; acco[ct] = (f32x4){0.f, 0.f, 0.f, 0.f};
                { const bf16x8 vf = lds_tr_frag3(lds + GL_V + c0 * 2, 272, l, 32); acco[ct] = __builtin_amdgcn_mfma_f32_16x16x32_bf16(vf, pf0, acco[ct], 0, 0, 0); }
                if (it >= 2) { const bf16x8 vf = lds_tr_frag3(lds + GL_V + 32 * 272 + c0 * 2, 272, l, 32); acco[ct] = __builtin_amdgcn_mfma_f32_16x16x32_bf16(vf, pf1, acco[ct], 0, 0, 0); }
#pragma unroll
                for (int ks = 0; ks < 2; ++ks) { const bf16x8 sf = *(LAS const bf16x8*)(lds + GL_ST + (c0 + 16 * (fr >> 2) + (fr & 3)) * 144 + 16 * fq + 64 * ks);
                    acco[ct] = __builtin_amdgcn_mfma_f32_16x16x32_bf16(sf, qf[ks], acco[ct], 0, 0, 0); } }
        }
#pragma unroll
        for (int dt = 0; dt < 4; ++dt) { const f32x4 lv = *(LAS const f32x4*)(lds + GL_LAST + (16 * dt + 4 * fq) * 4);
#pragma unroll
            for (int r = 0; r < 4; ++r) accs[dt][r] *= __expf(lv[r]); }
#pragma unroll
        for (int ks = 0; ks < 2; ++ks) { const bf16x8 vf = lds_tr_frag2(lds + GL_V + (32 * ks) * 272 + (16 * w) * 2, 272, l, 8, 4);
#pragma unroll
            for (int dt = 0; dt < 4; ++dt) { const bf16x8 kf = *(LAS const bf16x8*)(lds + GL_KT + (16 * dt + fr) * 144 + 16 * fq + 64 * ks);
                accs[dt] = __builtin_amdgcn_mfma_f32_16x16x32_bf16(kf, vf, accs[dt], 0, 0, 0); } }
        if (PASSC) {
            float ss = 0.f, sm_ = 0.f;
#pragma unroll
            for (int ct = 0; ct < 4; ++ct)
#pragma unroll
                for (int r = 0; r < 4; ++r) { ss += acco[ct][r] * acco[ct][r]; sm_ += acco[ct][r]; }
            ss += shfl_xor_f(ss, 16); ss += shfl_xor_f(ss, 32); sm_ += shfl_xor_f(sm_, 16); sm_ += shfl_xor_f(sm_, 32);
            if (fq == 0) { *(LAS float*)(lds + GL_RED + ((16 * it + fr) * 2 + ch) * 4) = ss; *(LAS float*)(lds + GL_RED2 + ((16 * it + fr) * 2 + ch) * 4) = sm_; }
        }
        WGSYNC();
        if (PASSC) {
            const int i = 16 * it + fr;
            const float ssum = *(LAS const float*)(lds + GL_RED + (i * 2) * 4) + *(LAS const float*)(lds + GL_RED + (i * 2 + 1) * 4);
            const float msum = *(LAS const float*)(lds + GL_RED2 + (i * 2) * 4) + *(LAS const float*)(lds + GL_RED2 + (i * 2 + 1) * 4);
            float mean, rstd;
            if (gla) { mean = 0.f; rstd = rsqrtf(ssum * (1.f / 128.f) + NORM_EPS); }
            else { mean = msum * (1.f / 128.f); const float var = fmaxf(ssum * (1.f / 128.f) - mean * mean, 0.f); rstd = rsqrtf(var + NORM_EPS); }
            u32x4 ow[2];
#pragma unroll
            for (int ct = 0; ct < 4; ++ct) { const f32x4 gn = gnv[ct], bs = bsv[ct]; const unsigned gw0 = gates[ct >> 1][(ct & 1) * 2], gw1 = gates[ct >> 1][(ct & 1) * 2 + 1];
                const float g0 = bflo(gw0), g1 = bfhi(gw0), g2 = bflo(gw1), g3 = bfhi(gw1);
                ow[ct >> 1][(ct & 1) * 2] = cvt_pk_bf16(((acco[ct][0] - mean) * rstd * gn[0] + bs[0]) * g0, ((acco[ct][1] - mean) * rstd * gn[1] + bs[1]) * g1);
                ow[ct >> 1][(ct & 1) * 2 + 1] = cvt_pk_bf16(((acco[ct][2] - mean) * rstd * gn[2] + bs[2]) * g2, ((acco[ct][3] - mean) * rstd * gn[3] + bs[3]) * g3); }
#pragma unroll
            for (int j = 0; j < 2; ++j) *(u32x4*)(gp.O + (row0 + i) * OLD + ooff + 128 * h + 64 * ch + 16 * fq + 8 * j) = ow[j];
#pragma unroll
            for (int dt = 0; dt < 4; ++dt) { u32x2 wv; wv.x = cvt_pk_bf16(accs[dt][0], accs[dt][1]); wv.y = cvt_pk_bf16(accs[dt][2], accs[dt][3]);
                *(LAS u32x2*)(lds + GL_ST + (16 * w + fr) * 144 + 32 * dt + 8 * fq) = wv; }
        }
    }
#undef GL_ISSUE
    if (!PASSC) {
        float* sg = gp.SSEG + (size_t)(sidx + seg) * 8192 + tid * 16;
#pragma unroll
        for (int dt = 0; dt < 4; ++dt) *(f32x4*)(sg + 4 * dt) = accs[dt];
        if (tid < 8) {
#pragma unroll
            for (int e = 0; e < 8; ++e) gp.DSUM[(size_t)(sidx + seg) * 64 + 8 * apart + e] = dsum[e]; }
    }
    WGSYNC();
}

constexpr int LR_XC = 0, LR_XCF = 2304, LR_AA = 6400, LR_GG = 10496, LR_WAVE = 14592;
struct LruP { const bf16_t* P; const float* cw; const float* cb; const float* ba; const float* bx; const float* sp8; const bf16_t* lw; bf16_t* O; float* LST; };
template <bool PASSC>
__device__ __forceinline__ void lru_wave(LAS unsigned char* lw_, const LruP& lp, const int b, const int seg, const int n, const int l_) {
    int l = l_; asm volatile("" : "+v"(l));
    const float NL2E = -1.4426950408889634f;
    const int fr = l & 15, fq = l >> 4, ch = 64 * n + l;
    bf16x8 wB[8][2];
#pragma unroll
    for (int jt = 0; jt < 8; ++jt)
#pragma unroll
        for (int ks = 0; ks < 2; ++ks) wB[jt][ks] = *(const bf16x8*)(lp.lw + ((size_t)(n * 128 + 16 * jt + fr)) * 64 + 8 * fq + 32 * ks);
    const float w0 = lp.cw[ch], w1 = lp.cw[512 + ch], w2 = lp.cw[1024 + ch], w3 = lp.cw[1536 + ch], cbv = lp.cb[ch];
    float bav[4], bxv[4], spv[4];
#pragma unroll
    for (int jt = 0; jt < 4; ++jt) { const int c2 = 64 * n + 16 * jt + fr; bav[jt] = lp.ba[c2] * NL2E; bxv[jt] = lp.bx[c2] * NL2E; spv[jt] = lp.sp8[c2] * NL2E; }
    const size_t rowb = (size_t)b * SEQ + seg * 128;
    const bf16_t* px = lp.P + (size_t)(P_LX + 64 * n) * TG + rowb * 64;
    const bf16_t* pg = lp.P + (size_t)(P_LG + 64 * n) * TG + rowb * 64;
    bf16_t* po = lp.O + rowb * OLD + 1024 + 64 * n;
    float xm3 = 0.f, xm2 = 0.f, xm1 = 0.f;
    if (seg > 0) { xm3 = bf2f(px[l - 3 * 64]); xm2 = bf2f(px[l - 2 * 64]); xm1 = bf2f(px[l - 64]); }
    float hst = 0.f, ap = 1.f;
    if (PASSC) { const float* st = lp.LST + ((size_t)b * NSEGL * 512 + ch) * 2;
        pg8::f32x2_ ah[31];
#pragma unroll
        for (int e = 0; e < 31; ++e) { const int sp = e < seg ? e : 0; ah[e] = *(const pg8::f32x2_*)(st + (size_t)sp * 1024); }
#pragma unroll
        for (int e = 0; e < 31; ++e) if (e < seg) hst = ah[e][0] * hst + ah[e][1]; }
#define LR_ROWLD(dst, base, t) do { dst = (base)[(t) * 64 + l]; } while (0)
    bf16_t xn[16], gn[16];
#pragma unroll
    for (int t = 0; t < 16; ++t) LR_ROWLD(xn[t], px, t);
    for (int sb = 0; sb < 8; ++sb) {
        float xc[16];
        if (PASSC) {
#pragma unroll
            for (int t = 0; t < 16; ++t) LR_ROWLD(gn[t], pg, sb * 16 + t); }
#pragma unroll
        for (int t = 0; t < 16; ++t) { const float x0 = bf2f(xn[t]); xc[t] = cbv + w0 * xm3 + w1 * xm2 + w2 * xm1 + w3 * x0; xm3 = xm2; xm2 = xm1; xm1 = x0;
            *(LAS bf16_t*)(lw_ + LR_XC + t * 144 + l * 2) = f2bf(xc[t]); }
        if (sb < 7) {
#pragma unroll
            for (int t = 0; t < 16; ++t) LR_ROWLD(xn[t], px, (sb + 1) * 16 + t); }
        __builtin_amdgcn_wave_barrier();
        f32x4 acc[8];
#pragma unroll
        for (int jt = 0; jt < 8; ++jt) { const float bz = jt < 4 ? bav[jt] : bxv[jt - 4]; acc[jt] = (f32x4){bz, bz, bz, bz}; }
#pragma unroll
        for (int ks = 0; ks < 2; ++ks) { const bf16x8 af = *(LAS const bf16x8*)(lw_ + LR_XC + fr * 144 + 16 * fq + 64 * ks);
#pragma unroll
            for (int jt = 0; jt < 8; ++jt) acc[jt] = __builtin_amdgcn_mfma_f32_16x16x32_bf16(af, wB[jt][ks], acc[jt], 0, 0, 0); }
#pragma unroll
        for (int jt = 0; jt < 4; ++jt)
#pragma unroll
            for (int r = 0; r < 4; ++r) { const int tok = 4 * fq + r, j = 16 * jt + fr;
                const float rg = __builtin_amdgcn_rcpf(1.f + __builtin_amdgcn_exp2f(acc[jt][r])), ig = __builtin_amdgcn_rcpf(1.f + __builtin_amdgcn_exp2f(acc[4 + jt][r]));
                const float av = __builtin_amdgcn_exp2f(rg * spv[jt]);
                *(LAS float*)(lw_ + LR_AA + tok * 256 + j * 4) = av; const float em = fmaf(-av, av, 1.f);
                *(LAS float*)(lw_ + LR_GG + tok * 256 + j * 4) = ig * __builtin_amdgcn_sqrtf(em); }
        __builtin_amdgcn_wave_barrier();
#pragma unroll
        for (int t = 0; t < 16; ++t) { const float av = *(LAS const float*)(lw_ + LR_AA + t * 256 + l * 4), gv = *(LAS const float*)(lw_ + LR_GG + t * 256 + l * 4);
            hst = av * hst + gv * xc[t]; ap *= av;
            if (PASSC) { bf16_t* p_ = po + (size_t)(sb * 16 + t) * OLD; asm volatile("" : "+s"(p_)); p_[l] = f2bf(hst * bf2f(gn[t])); } }
        __builtin_amdgcn_wave_barrier();
    }
#undef LR_ROWLD
    if (!PASSC) { float* st = lp.LST + (((size_t)b * NSEGL + seg) * 512 + ch) * 2; st[0] = ap; st[1] = hst; }
}

constexpr int S5_MG = 0, S5_MC = 32768, S5_MM = 65536, S5_MEND = 86016, S5W_STRIDE = 8448;
struct S5P { const bf16_t* P; const bf16_t* SU; const float* sm; const unsigned char* s5m; const float* a128; const float* dd; bf16_t* Y5; float* SST; };
__device__ __forceinline__ float gelu_t(float x) { const float t = x * __builtin_fmaf(x * x, -0.10294324f, -2.3022082f);
    return x * __builtin_amdgcn_rcpf(1.f + __builtin_amdgcn_exp2f(t)); }
template <bool PASSC>
__device__ __forceinline__ void s5_wave(LAS unsigned char* lds, LAS unsigned char* lw_, const S5P& sp_, const int b, const int seg, const int g, const int l_) {
    int l = l_; asm volatile("" : "+v"(l));
    const int fr = l & 15, fq = l >> 4;
    const float a8r = sp_.sm[SM_A8 + (g * 64 + l) * 2], a8i = sp_.sm[SM_A8 + (g * 64 + l) * 2 + 1];
    float xr = 0.f, xi = 0.f;
    f32x4 dv4 = (f32x4){0.f, 0.f, 0.f, 0.f};
    if (PASSC) {
        const float ar = sp_.a128[(g * 64 + l) * 2], ai = sp_.a128[(g * 64 + l) * 2 + 1];
        const float* st = sp_.SST + ((size_t)b * NSEGS * 32 + g) * 128 + l;
        for (int sp0 = 0; sp0 < seg; sp0 += 8) { float er[8], ei[8];
#pragma unroll
            for (int e = 0; e < 8; ++e) { const int sp = sp0 + e < seg ? sp0 + e : seg - 1; er[e] = st[(size_t)sp * 4096]; ei[e] = st[(size_t)sp * 4096 + 64]; }
#pragma unroll
            for (int e = 0; e < 8; ++e) if (sp0 + e < seg) { const float nr = ar * xr - ai * xi + er[e], ni = ar * xi + ai * xr + ei[e]; xr = nr; xi = ni; } }
        dv4 = *(const f32x4*)(sp_.dd + 16 * g + 4 * fq);
    }
    const size_t rowb = (size_t)b * SEQ + seg * 512;
    bf16x8 ufn[4];
#pragma unroll
    for (int ks = 0; ks < 4; ++ks) ufn[ks] = *(const bf16x8*)(sp_.SU + ((size_t)g * TG + rowb + 8 * fr + 2 * ks + (fq >> 1)) * 16 + 8 * (fq & 1));
    for (int sup = 0; sup < 4; ++sup) {
        const size_t r0 = rowb + sup * 128;
        bf16x8 uf[4];
#pragma unroll
        for (int ks = 0; ks < 4; ++ks) uf[ks] = ufn[ks];
        if (sup < 3) {
#pragma unroll
            for (int ks = 0; ks < 4; ++ks) ufn[ks] = *(const bf16x8*)(sp_.SU + ((size_t)g * TG + r0 + 128 + 8 * fr + 2 * ks + (fq >> 1)) * 16 + 8 * (fq & 1)); }
        u32x2 us[8];
        if (PASSC) {
#pragma unroll
            for (int mt = 0; mt < 8; ++mt) us[mt] = *(const u32x2*)(sp_.SU + ((size_t)g * TG + r0 + 8 * fr + mt) * 16 + 4 * fq); }
#pragma unroll
        for (int mt = 0; mt < 8; ++mt) { f32x4 ga = (f32x4){0.f, 0.f, 0.f, 0.f};
#pragma unroll
            for (int ks = 0; ks < 4; ++ks) ga = __builtin_amdgcn_mfma_f32_16x16x32_bf16(*(LAS const bf16x8*)(lds + S5_MG + ((mt * 4 + ks) * 64 + l) * 16), uf[ks], ga, 0, 0, 0);
            *(LAS f32x4*)(lw_ + fr * 528 + (16 * mt + 4 * fq) * 4) = ga; }
        __builtin_amdgcn_wave_barrier();
        pg8::f32x2_ gv[16];
#pragma unroll
        for (int t = 0; t < 16; ++t) gv[t] = *(LAS const pg8::f32x2_*)(lw_ + t * 528 + l * 8);
        __builtin_amdgcn_wave_barrier();
#pragma unroll
        for (int t = 0; t < 16; ++t) {
            if (PASSC) *(LAS unsigned*)(lw_ + t * 528 + l * 4) = cvt_pk_bf16(xr, xi);
            const float nr = __builtin_fmaf(a8r, xr, __builtin_fmaf(-a8i, xi, gv[t][0])), ni = __builtin_fmaf(a8r, xi, __builtin_fmaf(a8i, xr, gv[t][1])); xr = nr; xi = ni; }
        if (PASSC) {
            __builtin_amdgcn_wave_barrier();
            bf16x8 xf[4];
#pragma unroll
            for (int ks = 0; ks < 4; ++ks) xf[ks] = *(LAS const bf16x8*)(lw_ + fr * 528 + (32 * ks + 8 * fq) * 2);
#pragma unroll
            for (int mt = 0; mt < 8; ++mt) { f32x4 ya = (f32x4){0.f, 0.f, 0.f, 0.f}; const int cb = mt < 1 ? 0 : mt < 2 ? 1 : mt < 3 ? 2 : mt < 4 ? 4 : mt < 5 ? 6 : mt < 6 ? 9 : mt < 7 ? 12 : 16;
#pragma unroll
                for (int ks = 0; ks < 4; ++ks) if (2 * ks <= mt) ya = __builtin_amdgcn_mfma_f32_16x16x32_bf16(*(LAS const bf16x8*)(lds + S5_MM + ((cb + ks) * 64 + l) * 16), uf[ks], ya, 0, 0, 0);
#pragma unroll
                for (int ks = 0; ks < 4; ++ks) ya = __builtin_amdgcn_mfma_f32_16x16x32_bf16(*(LAS const bf16x8*)(lds + S5_MC + ((mt * 4 + ks) * 64 + l) * 16), xf[ks], ya, 0, 0, 0);
                u32x2 yw; yw.x = cvt_pk_bf16(gelu_t(ya[0] + dv4[0] * bflo(us[mt].x)), gelu_t(ya[1] + dv4[1] * bfhi(us[mt].x))); yw.y = cvt_pk_bf16(gelu_t(ya[2] + dv4[2] * bflo(us[mt].y)), gelu_t(ya[3] + dv4[3] * bfhi(us[mt].y)));
                *(u32x2*)(sp_.Y5 + (r0 + 8 * fr + mt) * BW + 16 * g + 4 * fq) = yw; }
        }
        __builtin_amdgcn_wave_barrier();
    }
    if (!PASSC) { float* st = sp_.SST + (((size_t)b * NSEGS + seg) * 32 + g) * 128 + l; st[0] = xr; st[64] = xi; }
}

template <bool PASSC>
__device__ __forceinline__ void phase_mixers(LAS unsigned char* lds, const Args& a, const int l, const int G) {
    const int mmask = a.mmask; int bx = blockIdx.x; asm volatile("" : "+s"(bx));
    unsigned char* ws = a.ws; const float* sm = (const float*)(ws + WS_SMALL + (size_t)l * SMALL_STRIDE);
    const bf16_t* P = (const bf16_t*)(ws + WS_P); float* ST = (float*)(ws + WS_ST);
    if (mmask & 1) { GlaP gp0{P, (const float*)(ws + WS_LA), a.in[I_GNG] + l * 512, nullptr, (bf16_t*)(ws + WS_O), ST + ST_GSEG, ST + ST_GDS};
      GlaP gp1{P, (const float*)(ws + WS_LA), a.in[I_RNG] + l * 512, a.in[I_RNB] + l * 512, (bf16_t*)(ws + WS_O), ST + ST_GSEG, ST + ST_GDS};
      for (int itx = bx; itx < 2 * BG * 4 * NSEGG; itx += G) { const int mix = itx / (BG * 4 * NSEGG), rest = itx % (BG * 4 * NSEGG), b = rest / (4 * NSEGG), h = (rest / NSEGG) & 3, seg = rest % NSEGG;
          const int sidx = ((mix * BG + b) * 4 + h) * NSEGG;
          if (!PASSC && seg == NSEGG - 1) continue;
          if (mix == 0) glaret_item<PASSC>(lds, gp0, true, b, h, seg, sidx); else glaret_item<PASSC>(lds, gp1, false, b, h, seg, sidx); } }
    int tid = threadIdx.x; asm volatile("" : "+v"(tid));
    const int w = __builtin_amdgcn_readfirstlane(tid >> 6), ln = tid & 63;
    if (mmask & 2) { LruP lp{P, a.in[I_LCW] + l * 2048, a.in[I_LCB] + l * 512, a.in[I_LBA] + l * 512, a.in[I_LBX] + l * 512, sm + SM_SP8, (const bf16_t*)((const unsigned char*)sm + SM_LRUW_BYTES), (bf16_t*)(ws + WS_O), ST + ST_LRU};
      for (int itx = bx; itx < BG * NSEGL; itx += G) { if (!PASSC && itx % NSEGL == NSEGL - 1) continue; lru_wave<PASSC>(lds + w * LR_WAVE, lp, itx / NSEGL, itx % NSEGL, w, ln); } }
    if (mmask & 4) { S5P sp_{P, (const bf16_t*)(ws + WS_SU2), sm, ws + WS_S5M + (size_t)l * 32 * S5M_BYTES, sm + SM_A128, a.in[I_SD] + l * 512, (bf16_t*)(ws + WS_Y5), ST + ST_S5};
      for (int itx = bx; itx < 32 * 8; itx += G) { const int g = 4 * (itx & 7) + ((itx >> 3) & 3), q = (itx >> 5) * 8 + w;
          WGSYNC();
          { const unsigned char* src = sp_.s5m + (size_t)g * S5M_BYTES; const int nb = PASSC ? S5_MEND : S5_MC;
            for (int o = tid * 16; o < nb; o += 8192) *(LAS u32x4*)(lds + o) = *(const u32x4*)(src + o); }
          WGSYNC();
          if (PASSC || (q & 7) != NSEGS - 1) s5_wave<PASSC>(lds, lds + S5_MEND + w * S5W_STRIDE, sp_, q >> 3, q & 7, g, ln); } }
    WGSYNC();
}

constexpr int NPH = 8, NSTEPS = 1 + NGRP * DEPTH * NPH;
constexpr int LDS_BYTES = 163840, LDS_MISC = 163840 - 512;
static_assert(S5_MEND + 8 * S5W_STRIDE <= LDS_MISC, "S5 LDS");

__global__ void __launch_bounds__(512, 2) mk_fwd(Args a) {
    __shared__ __attribute__((aligned(16))) unsigned char lds_raw[LDS_BYTES];
    LAS unsigned char* lds = (LAS unsigned char*)lds_raw;
    volatile LAS unsigned* MISC = (volatile LAS unsigned*)(lds + LDS_MISC);
    const int G = gridDim.x;
    if (threadIdx.x < 32) MISC[threadIdx.x] = 0u;
    wg_syncthreads();
    unsigned* ctl = (unsigned*)(a.ws + WS_CTL);
    XcdBarrier bar = xcd_barrier_post(ctl + CW_BAR + a.li * XCD_BAR_WORDS, MISC + 8);
    const int ngw = G * 8, gthreads = G * 512;
#define LTID(v) int v = threadIdx.x; asm volatile("" : "+v"(v))
#define LBID(v) int v = blockIdx.x; asm volatile("" : "+s"(v))
#define IN(s) (a.s_lo <= (s) && (s) < a.s_hi)
#define SEAM(s) do { if ((s) + 1 < a.s_hi) xcd_barrier(bar); } while (0)
    if (IN(0)) { LTID(t_); phase_prologue(lds, a, blockIdx.x * 512 + t_, gthreads); xcd_barrier(bar); phase_prologue2(a, blockIdx.x * 512 + t_, gthreads); xcd_barrier(bar); phase_prologue3(a, blockIdx.x * 512 + t_, gthreads); SEAM(0); }
    for (int gl = 0; gl < NGRP * DEPTH; ++gl) {
        const int grp = gl >> 2, l = gl & 3, s0 = 1 + gl * NPH;
        if (a.s_hi <= s0 || a.s_lo >= s0 + NPH) continue;
        unsigned char* ws = a.ws;
        const bf16_t* Wl = (const bf16_t*)(ws + WS_W + (size_t)l * W_STRIDE);
        const float* sm = (const float*)(ws + WS_SMALL + (size_t)l * SMALL_STRIDE);
        bf16_t* U = (bf16_t*)(ws + WS_U); bf16_t* P = (bf16_t*)(ws + WS_P); float* LA = (float*)(ws + WS_LA);
        bf16_t* O = (bf16_t*)(ws + WS_O); bf16_t* Y5 = (bf16_t*)(ws + WS_Y5); unsigned char* PGb = ws + WS_PG;
        const float* xg = a.in[I_X] + (size_t)grp * TG * D; float* og = a.out + (size_t)grp * TG * D;
        const float* hin = (l <= 1) ? xg : og;
        bf16_t* DLT = (bf16_t*)(ws + WS_O);
        (void)sm;
        if (IN(s0 + 0)) { LTID(t_); LBID(bx_); const int gw_ = bx_ * 8 + __builtin_amdgcn_readfirstlane(t_ >> 6);
            if (l == 0) phase_norm<false, false>(hin, DLT, og, a.in[I_NG] + l * D, U, gw_, ngw, t_ & 63); else phase_norm<false, true>(hin, DLT, og, a.in[I_NG] + l * D, U, gw_, ngw, t_ & 63);
            SEAM(s0 + 0); }
        if (IN(s0 + 1)) {
            pg8::Gemm g{U, Wl, TG, N_ALL, D, D, D, 0, 0}; pg8::StaticOrder S; LBID(bx_); S.init(TG, N_ALL, G, bx_, 0, 256, WGM_G1);
            EpiIn E{P, LA, a.in[I_GBLR] + l * 256, (const float*)(ws + WS_ROT), PGb, (bf16_t*)(ws + WS_SU2)};
            GEMM_CALL(EpiIn);
            SEAM(s0 + 1);
        }
        if (IN(s0 + 2)) { phase_mixers<false>(lds, a, l, G); SEAM(s0 + 2); }
        if (IN(s0 + 3)) { phase_mixers<true>(lds, a, l, G); SEAM(s0 + 3); }
        if (IN(s0 + 4)) {
            { pg8::Gemm g{Y5, (const bf16_t*)((const unsigned char*)Wl + WO_GLU), TG, BW, BW, BW, BW, 0, 0}; pg8::StaticOrder S; LBID(bx_); S.init(TG, BW, G, bx_, 0, 256, WGM_GLU);
              EpiGlu E{Y5, P, a.in[I_SGB] + l * BW, O};
              GEMM_CALL(EpiGlu); }
            SEAM(s0 + 4);
        }
        if (IN(s0 + 6)) {
            { pg8::Gemm g{O, (const bf16_t*)((const unsigned char*)Wl + WO_BR), TG, D, BW, OLD, BW, (size_t)BW * 2, (size_t)D * BW * 2}; pg8::StaticOrder S; LBID(bx_); S.init(TG, D, G, bx_, 2, 128, WGM_G2);
              EpiBr E{PGb, U};
              pg8::gemm_phase_hn<EpiBr, pg8::StaticOrder>(lds, g, S, E); }
            SEAM(s0 + 6);
        }
        if (IN(s0 + 7)) {
            if (a.fin != 2) { pg8::Gemm g{U, (const bf16_t*)((const unsigned char*)Wl + WO_OUT), TG, D, D, D, D, 0, 0}; pg8::StaticOrder S; LBID(bx_); S.init(TG, D, G, bx_, 0, 256, WGM_G3);
              EpiOut E{DLT};
              GEMM_CALL(EpiOut); }
            if (l == 3 && a.fin) { if (a.fin == 1) xcd_barrier(bar); LTID(t_); phase_norm<true, true>(og, DLT, og, a.in[I_FNG], U, blockIdx.x * 8 + __builtin_amdgcn_readfirstlane(t_ >> 6), ngw, t_ & 63); }
            SEAM(s0 + 7);
        }
    }
#undef IN
#undef SEAM
}

extern "C" void kernel_launch(void* const* d_in, const int* in_sizes, int n_in, void* d_out, int out_size, void* d_ws, size_t ws_size, hipStream_t stream) {
    static int grid = 0;
    if (grid == 0) {
        static const int exp_sizes[29] = {67108864, 4096, 21037056, 16384, 1024, 2048, 2048, 2048, 8192, 2048, 131072, 2048, 131072, 2048, 2048, 8192, 8192, 131072, 131072, 131072, 131072, 2048, 128, 1048576, 2048, 16777216, 8388608, 4194304, 1024};
        bool ok_sizes = (n_in == 29); if (ok_sizes) for (int i = 0; i < 29; ++i) if (in_sizes[i] != exp_sizes[i]) { fprintf(stderr, "kernel_launch: input %d has %d elements, expected %d\n", i, in_sizes[i], exp_sizes[i]); ok_sizes = false; }
        if (!ok_sizes || out_size != NB * SEQ * D || ws_size < WS_END) { fprintf(stderr, "kernel_launch: unexpected shapes (n_in %d out %d ws %zu)\n", n_in, out_size, ws_size); grid = -1; return; }
        int dev = 0, cus = 0, per_cu = 0;
        hipGetDevice(&dev); hipDeviceGetAttribute(&cus, hipDeviceAttributeMultiprocessorCount, dev);
        hipOccupancyMaxActiveBlocksPerMultiprocessor(&per_cu, (const void*)mk_fwd, 512, 0);
        (void)hipGetLastError();
        grid = cus > 0 ? cus : 256;
        if (per_cu < 1) fprintf(stderr, "kernel_launch: occupancy query says %d\n", per_cu);
    }
    if (grid < 0) return;
    hipMemsetAsync((char*)d_ws + WS_CTL, 0, CTL_BYTES, stream);
    Args a{};
    for (int i = 0; i < 29; ++i) a.in[i] = (const float*)d_in[i];
    a.out = (float*)d_out; a.ws = (unsigned char*)d_ws;
    unsigned char* ws = (unsigned char*)d_ws;
    int li = 0;
    auto run = [&](int lo, int hi, int fin = 1, int mm = 7) { a.s_lo = lo; a.s_hi = hi; a.li = li++; a.fin = fin; a.mmask = mm; a.pad2 = 0; hipLaunchKernelGGL(mk_fwd, dim3(grid), dim3(512), 0, stream, a); };
    run(0, NSTEPS);
}
#if defined(__HIP_DEVICE_COMPILE__)
#pragma clang attribute pop
#endif
```
